# Optimizing an MI355X kernel written in HIP

```python
import math
import jax, jax.numpy as jnp
from jax import lax
import numpy as np

D_MODEL = 1024
BATCH = 4
SEQ = 4096
DEPTH = 2

D_A = 512
D_B = 512
N_HEADS = 8
HEAD_DIM = 64
D_C = N_HEADS * HEAD_DIM
CONV_WIDTH = 31
CHUNK = 128
N_GROUPS_B = 4
GROUP_DIM_B = D_B // N_GROUPS_B
Q_BLOCK = 128
N_BRANCHES = 3
EPS = 1e-6
SPLIT_SIZES = (N_BRANCHES * D_MODEL, 2 * D_A, D_A, 2 * D_B, D_B, D_C, D_C, D_C, D_C, N_HEADS)
N_IN = N_BRANCHES * D_MODEL + 3 * D_A + 3 * D_B + 4 * D_C + N_HEADS

kernel_name = "hybrid_gated_conformer_gmlp_fox"


def rmsnorm(x, g):
    x32 = x.astype(jnp.float32)
    y = x32 * lax.rsqrt(jnp.mean(x32 * x32, axis=-1, keepdims=True) + EPS)
    return (y * g.astype(jnp.float32)).astype(x.dtype)


def layernorm(x, g, b):
    x32 = x.astype(jnp.float32)
    mu = jnp.mean(x32, axis=-1, keepdims=True)
    xc = x32 - mu
    y = xc * lax.rsqrt(jnp.mean(xc * xc, axis=-1, keepdims=True) + EPS)
    return (y * g.astype(jnp.float32) + b.astype(jnp.float32)).astype(x.dtype)


def split_columns(p):
    idx = []
    acc = 0
    for s in SPLIT_SIZES[:-1]:
        acc += s
        idx.append(acc)
    return jnp.split(p, idx, axis=-1)


def causal_depthwise_conv(a, w, b):
    out = lax.conv_general_dilated(
        a, w[:, None, :].astype(a.dtype), window_strides=(1,),
        padding=[(CONV_WIDTH - 1, 0)],
        dimension_numbers=("NWC", "WIO", "NWC"),
        feature_group_count=a.shape[-1])
    return out + b.astype(a.dtype)


def conformer_branch(a_in, a_z, conv_w, conv_b, cn_g, cn_b, w_a):
    a = a_in[..., :D_A] * jax.nn.sigmoid(a_in[..., D_A:])
    a = causal_depthwise_conv(a, conv_w, conv_b)
    a = jax.nn.silu(layernorm(a, cn_g, cn_b))
    a = a * jax.nn.silu(a_z)
    return a @ w_a


def gmlp_branch(b_uv, b_z, gn_g, w_s, b_s, w_b):
    bsz, seq, _ = b_uv.shape
    u, v = b_uv[..., :D_B], b_uv[..., D_B:]
    v = rmsnorm(v, gn_g)
    v = v.reshape(bsz, seq // CHUNK, CHUNK, N_GROUPS_B, GROUP_DIM_B)
    tril = jnp.tril(jnp.ones((CHUNK, CHUNK), dtype=bool))
    ws = jnp.where(tril[None], w_s, jnp.zeros_like(w_s))
    mixed = jnp.einsum("gts,bnsgc->bntgc", ws, v) + b_s.T[None, None, :, :, None]
    y = u * mixed.reshape(bsz, seq, D_B)
    y = y * jax.nn.silu(b_z)
    return y @ w_b


def fox_attention(q, k, v, logf):
    bsz, seq = q.shape[0], q.shape[1]
    n_blocks = seq // Q_BLOCK
    scale = 1.0 / math.sqrt(HEAD_DIM)
    c = jnp.cumsum(logf, axis=1).transpose(0, 2, 1)
    qb = q.reshape(bsz, n_blocks, Q_BLOCK, N_HEADS, HEAD_DIM).transpose(1, 0, 2, 3, 4)
    cb = c.reshape(bsz, N_HEADS, n_blocks, Q_BLOCK).transpose(2, 0, 1, 3)
    kpos = jnp.arange(seq)

    def one_block(args):
        i, qi, ci = args
        s = jnp.einsum("bqhd,bkhd->bhqk", qi, k).astype(jnp.float32) * scale
        s = s + ci[..., :, None] - c[:, :, None, :]
        qpos = i * Q_BLOCK + jnp.arange(Q_BLOCK)
        mask = kpos[None, :] <= qpos[:, None]
        s = jnp.where(mask[None, None], s, -jnp.inf)
        p = jax.nn.softmax(s, axis=-1)
        return jnp.einsum("bhqk,bkhd->bqhd", p.astype(v.dtype), v)

    out = lax.map(one_block, (jnp.arange(n_blocks), qb, cb))
    return out.transpose(1, 0, 2, 3, 4).reshape(bsz, seq, N_HEADS, HEAD_DIM)


def fox_branch(q, k, v, c_z, f_pre, qn_g, kn_g, b_f, w_c):
    bsz, seq, _ = q.shape
    q = rmsnorm(q.reshape(bsz, seq, N_HEADS, HEAD_DIM), qn_g)
    k = rmsnorm(k.reshape(bsz, seq, N_HEADS, HEAD_DIM), kn_g)
    v = v.reshape(bsz, seq, N_HEADS, HEAD_DIM)
    logf = jax.nn.log_sigmoid(f_pre.astype(jnp.float32) + b_f.astype(jnp.float32))
    o = fox_attention(q, k, v, logf).reshape(bsz, seq, D_C)
    o = o * jax.nn.silu(c_z)
    return o @ w_c


def setup_inputs(seed: int = 0) -> dict:
    key = jax.random.key(seed)
    ks = jax.random.split(key, 20)
    n = jax.random.normal
    L = DEPTH
    return {
        "x": n(ks[0], (BATCH, SEQ, D_MODEL), jnp.float32),
        "norm_g": 1.0 + 0.02 * n(ks[1], (L, D_MODEL), jnp.float32),
        "w_in": n(ks[2], (L, D_MODEL, N_IN), jnp.float32) * D_MODEL ** -0.5,
        "b_gate": 0.02 * n(ks[3], (L, N_BRANCHES * D_MODEL), jnp.float32),
        "conv_w": n(ks[4], (L, CONV_WIDTH, D_A), jnp.float32) * CONV_WIDTH ** -0.5,
        "conv_b": 0.02 * n(ks[5], (L, D_A), jnp.float32),
        "conv_norm_g": 1.0 + 0.02 * n(ks[6], (L, D_A), jnp.float32),
        "conv_norm_b": 0.02 * n(ks[7], (L, D_A), jnp.float32),
        "w_a": n(ks[8], (L, D_A, D_MODEL), jnp.float32) * D_A ** -0.5,
        "gmlp_norm_g": 1.0 + 0.02 * n(ks[9], (L, D_B), jnp.float32),
        "w_s": n(ks[10], (L, N_GROUPS_B, CHUNK, CHUNK), jnp.float32) * CHUNK ** -0.5,
        "b_s": 1.0 + 0.1 * n(ks[11], (L, N_GROUPS_B, CHUNK), jnp.float32),
        "w_b": n(ks[12], (L, D_B, D_MODEL), jnp.float32) * D_B ** -0.5,
        "q_norm_g": 1.0 + 0.02 * n(ks[13], (L, HEAD_DIM), jnp.float32),
        "k_norm_g": 1.0 + 0.02 * n(ks[14], (L, HEAD_DIM), jnp.float32),
        "b_f": 2.0 + 0.1 * n(ks[15], (L, N_HEADS), jnp.float32),
        "w_c": n(ks[16], (L, D_C, D_MODEL), jnp.float32) * D_C ** -0.5,
        "w_out": n(ks[17], (L, D_MODEL, D_MODEL), jnp.float32) * D_MODEL ** -0.5,
    }


def reference(x, norm_g, w_in, b_gate, conv_w, conv_b, conv_norm_g, conv_norm_b, w_a,
              gmlp_norm_g, w_s, b_s, w_b, q_norm_g, k_norm_g, b_f, w_c, w_out):
    for l in range(DEPTH):
        h = rmsnorm(x, norm_g[l])
        p = h @ w_in[l]
        gate_pre, a_in, a_z, b_uv, b_z, q, k, v, c_z, f_pre = split_columns(p)
        gates = jax.nn.sigmoid(gate_pre + b_gate[l])
        g_a = gates[..., :D_MODEL]
        g_b = gates[..., D_MODEL:2 * D_MODEL]
        g_c = gates[..., 2 * D_MODEL:]
        y_a = conformer_branch(a_in, a_z, conv_w[l], conv_b[l], conv_norm_g[l],
                               conv_norm_b[l], w_a[l])
        y_b = gmlp_branch(b_uv, b_z, gmlp_norm_g[l], w_s[l], b_s[l], w_b[l])
        y_c = fox_branch(q, k, v, c_z, f_pre, q_norm_g[l], k_norm_g[l], b_f[l], w_c[l])
        merged = g_a * y_a + g_b * y_b + g_c * y_c
        x = x + merged @ w_out[l]
    return x
```

```cpp
#include <hip/hip_runtime.h>
#include <cstdio>
#include <cstdint>
#include <cmath>

constexpr int NL = 2, NB = 4, SEQ = 4096, M = NB * SEQ, D = 1024;
constexpr int DA = 512, DB = 512, NH = 8, HD = 64, DC = 512, CW = 31, CHK = 128, NG = 4, GD = 128, NIN = 8200;
constexpr float EPS = 1e-6f;
constexpr float LOG2E = 1.4426950408889634f;
constexpr float C2 = 0.125f * LOG2E;
constexpr int N1 = 5120;
constexpr int OC_GATE = 0, OC_AIN = 3072, OC_AZ = 4096, OC_U = 4608, OC_V = 5120, OC_BZ = 5632, OC_Q = 6144, OC_K = 6656, OC_VA = 7168, OC_CZ = 7680, OC_F = 8192;

constexpr size_t MiB = 1u << 20;
constexpr size_t WS_CTL = 0, CTL_ZERO_BYTES = 1 * MiB;
constexpr size_t WS_VSS = 1 * MiB;
constexpr size_t WS_LOGF = WS_VSS + 512 * 1024;
constexpr size_t WS_CS = 2 * MiB;
constexpr size_t WS_WSB = WS_CS + 512 * 1024;
constexpr size_t WS_W = 4 * MiB, W_LAYER = 22 * MiB;
constexpr size_t WO_W1 = 0, WO_WG = 10 * MiB, WO_WAB = 16 * MiB, WO_WC = 18 * MiB, WO_WO = 20 * MiB;
constexpr size_t WS_H = 48 * MiB;
constexpr size_t WS_B0 = 80 * MiB;
constexpr size_t WS_B1 = 112 * MiB;
constexpr size_t WS_B2 = 144 * MiB;
constexpr size_t WS_B3 = 176 * MiB;
constexpr size_t WS_B4 = 208 * MiB;
constexpr size_t WS_GT = WS_B2, WS_MG = WS_B3;
constexpr size_t WS_END = 256 * MiB;

typedef unsigned short bf16_t;
typedef short bf16x8 __attribute__((ext_vector_type(8)));
typedef float f32x4 __attribute__((ext_vector_type(4)));
typedef unsigned u32x4 __attribute__((ext_vector_type(4)));

__host__ __device__ __forceinline__ float bf2f(bf16_t v) { union { unsigned u; float f; } c; c.u = (unsigned)v << 16; return c.f; }
__host__ __device__ __forceinline__ bf16_t f2bf(float f) { union { unsigned u; float f; } c; c.f = f; unsigned u = c.u; return (bf16_t)((u + 0x7fffu + ((u >> 16) & 1u)) >> 16); }
__device__ __forceinline__ float bfr(float f) { return bf2f(f2bf(f)); }
__device__ __forceinline__ float sigm(float x) { return 1.f / (1.f + __expf(-x)); }
__device__ __forceinline__ float siluf(float x) { return x * sigm(x); }

__host__ __device__ __forceinline__ int g1_col(int n) {
    const int j = n >> 8, lc = n & 255;
    if (j < 4) return lc < 128 ? OC_AIN + 128 * j + lc : OC_AIN + 512 + 128 * j + (lc - 128);
    if (j < 6) return OC_AZ + 256 * (j - 4) + lc;
    if (j < 8) return OC_U + 256 * (j - 6) + lc;
    if (j < 10) return OC_V + 256 * (j - 8) + lc;
    if (j < 12) return OC_BZ + 256 * (j - 10) + lc;
    if (j < 16) { const int isk = j >= 14, jj = (j - 12) & 1, head = 4 * jj + ((lc >> 5) & 3), d = 32 * (lc >> 7) + (lc & 31); return (isk ? OC_K : OC_Q) + 64 * head + d; }
    if (j < 18) return OC_VA + 256 * (j - 16) + lc;
    return OC_CZ + 256 * (j - 18) + lc;
}

struct Ptrs {
    const float *x, *norm_g, *w_in, *b_gate, *conv_w, *conv_b, *cn_g, *cn_b, *w_a, *gn_g, *w_s, *b_s, *w_b, *qn_g, *kn_g, *b_f, *w_c, *w_out;
    float* out; unsigned char* ws;
};

__global__ void nv_prep(Ptrs P) {
    const size_t gid = (size_t)blockIdx.x * blockDim.x + threadIdx.x, gsz = (size_t)gridDim.x * blockDim.x;
    for (int l = 0; l < NL; ++l) {
        unsigned char* wl = P.ws + WS_W + (size_t)l * W_LAYER;
        bf16_t* W1 = (bf16_t*)(wl + WO_W1); bf16_t* WG = (bf16_t*)(wl + WO_WG); bf16_t* WAB = (bf16_t*)(wl + WO_WAB); bf16_t* WC = (bf16_t*)(wl + WO_WC); bf16_t* WO = (bf16_t*)(wl + WO_WO);
        const float* win = P.w_in + (size_t)l * D * NIN;
        for (size_t i = gid; i < (size_t)N1 * D; i += gsz) { const int n = (int)(i >> 10), k = (int)(i & 1023); W1[i] = f2bf(win[(size_t)k * NIN + g1_col(n)]); }
        for (size_t i = gid; i < (size_t)3072 * D; i += gsz) { const int n = (int)(i >> 10), k = (int)(i & 1023); WG[i] = f2bf(win[(size_t)k * NIN + n]); }
        for (size_t i = gid; i < (size_t)1024 * 1024; i += gsz) { const int n = (int)(i >> 10), k = (int)(i & 1023);
            WAB[i] = f2bf(k < 512 ? P.w_a[((size_t)l * DA + k) * D + n] : P.w_b[((size_t)l * DB + (k - 512)) * D + n]);
            WC[i] = k < 512 ? f2bf(P.w_c[((size_t)l * DC + k) * D + n]) : (bf16_t)0;
            WO[i] = f2bf(P.w_out[((size_t)l * D + k) * D + n]); }
        bf16_t* WSB = (bf16_t*)(P.ws + WS_WSB) + (size_t)l * NG * CHK * CHK;
        for (size_t i = gid; i < (size_t)NG * CHK * CHK; i += gsz) { const int s = (int)(i & 127), t = (int)((i >> 7) & 127); WSB[i] = s <= t ? f2bf(P.w_s[(size_t)l * NG * CHK * CHK + i]) : (bf16_t)0; }
    }
}

__device__ __forceinline__ float wave_sum(float v) {
#pragma unroll
    for (int o = 1; o < 64; o <<= 1) v += __shfl_xor(v, o);
    return v;
}

__global__ void nv_ln(Ptrs P, int l, const float* xin) {
    const int lane = threadIdx.x & 63, row = blockIdx.x * 4 + (threadIdx.x >> 6);
    const float* xr = xin + (size_t)row * D; const float* g = P.norm_g + (size_t)l * D; const float* win = P.w_in + (size_t)l * D * NIN;
    float v[16]; float ss = 0.f;
#pragma unroll
    for (int j = 0; j < 16; ++j) { v[j] = xr[lane + 64 * j]; ss += v[j] * v[j]; }
    ss = wave_sum(ss);
    const float r = rsqrtf(ss * (1.f / D) + EPS);
    bf16_t* h = (bf16_t*)(P.ws + WS_H) + (size_t)row * D;
    float f[8] = {0, 0, 0, 0, 0, 0, 0, 0};
#pragma unroll
    for (int j = 0; j < 16; ++j) { const int k = lane + 64 * j; const float hv = v[j] * r * g[k]; h[k] = f2bf(hv);
#pragma unroll
        for (int e = 0; e < 8; ++e) f[e] += hv * win[(size_t)k * NIN + OC_F + e]; }
#pragma unroll
    for (int e = 0; e < 8; ++e) f[e] = wave_sum(f[e]);
    if (lane < 8) { float z = 0.f;
#pragma unroll
        for (int e = 0; e < 8; ++e) if (lane == e) z = f[e];
        z += P.b_f[l * NH + lane];
        const float lf = fminf(z, 0.f) - log1pf(expf(-fabsf(z)));
        ((float*)(P.ws + WS_LOGF))[(size_t)row * 8 + lane] = lf; }
}

__global__ void nv_scan(Ptrs P) {
    __shared__ float buf[SEQ];
    const int bh = blockIdx.x, b = bh / NH, h = bh % NH;
    const float* lf = (const float*)(P.ws + WS_LOGF);
    for (int t = threadIdx.x; t < SEQ; t += blockDim.x) buf[t] = lf[((size_t)b * SEQ + t) * 8 + h];
    __syncthreads();
    if (threadIdx.x == 0) { float c = 0.f; for (int t = 0; t < SEQ; ++t) { c += buf[t]; buf[t] = c * LOG2E; } }
    __syncthreads();
    float* cs = (float*)(P.ws + WS_CS) + (size_t)bh * SEQ;
    for (int t = threadIdx.x; t < SEQ; t += blockDim.x) cs[t] = buf[t];
}

constexpr int TLD = 257;
__device__ __forceinline__ void nv_gemm_acc(const bf16_t* A, int lda, const bf16_t* Bt, int ldb, int K, f32x4 (&acc)[4][4]) {
    const int tid = threadIdx.x, w = tid >> 6, l = tid & 63, fr = l & 15, fq = l >> 4;
#pragma unroll
    for (int m = 0; m < 4; ++m)
#pragma unroll
        for (int n = 0; n < 4; ++n) acc[m][n] = (f32x4){0.f, 0.f, 0.f, 0.f};
    for (int k0 = 0; k0 < K; k0 += 32) {
        bf16x8 a[4], b[4];
#pragma unroll
        for (int m = 0; m < 4; ++m) a[m] = *(const bf16x8*)(A + (size_t)(16 * m + fr) * lda + k0 + 8 * fq);
#pragma unroll
        for (int n = 0; n < 4; ++n) b[n] = *(const bf16x8*)(Bt + (size_t)(64 * w + 16 * n + fr) * ldb + k0 + 8 * fq);
#pragma unroll
        for (int m = 0; m < 4; ++m)
#pragma unroll
            for (int n = 0; n < 4; ++n) acc[m][n] = __builtin_amdgcn_mfma_f32_16x16x32_bf16(a[m], b[n], acc[m][n], 0, 0, 0);
    }
}
__device__ __forceinline__ void nv_gemm_tile(const bf16_t* A, int lda, const bf16_t* Bt, int ldb, int K, float* T) {
    const int tid = threadIdx.x, w = tid >> 6, l = tid & 63, fr = l & 15, fq = l >> 4;
    f32x4 acc[4][4];
    nv_gemm_acc(A, lda, Bt, ldb, K, acc);
#pragma unroll
    for (int m = 0; m < 4; ++m)
#pragma unroll
        for (int n = 0; n < 4; ++n)
#pragma unroll
            for (int r = 0; r < 4; ++r) T[(16 * m + 4 * fq + r) * TLD + 64 * w + 16 * n + fr] = acc[m][n][r];
}

__global__ void __launch_bounds__(256) nv_gemm1(Ptrs P, int l) {
    extern __shared__ float T[];
    __shared__ float R[64 * 4];
    const int j = blockIdx.x, row0 = blockIdx.y * 64, tid = threadIdx.x;
    const bf16_t* H = (const bf16_t*)(P.ws + WS_H);
    const bf16_t* W1 = (const bf16_t*)(P.ws + WS_W + (size_t)l * W_LAYER + WO_W1);
    nv_gemm_tile(H + (size_t)row0 * D, D, W1 + (size_t)j * 256 * D, D, D, T);
    __syncthreads();
    bf16_t* B0 = (bf16_t*)(P.ws + WS_B0); bf16_t* B1 = (bf16_t*)(P.ws + WS_B1); bf16_t* B2 = (bf16_t*)(P.ws + WS_B2); bf16_t* B3 = (bf16_t*)(P.ws + WS_B3); bf16_t* B4 = (bf16_t*)(P.ws + WS_B4);
    if (j < 4) {
        for (int e = tid; e < 64 * 128; e += 256) { const int r = e >> 7, c = e & 127; B3[(size_t)(row0 + r) * 1024 + 128 * j + c] = f2bf(T[r * TLD + c] * sigm(T[r * TLD + c + 128])); }
    } else if (j < 12 || j >= 16) {
        bf16_t* dst; int pitch, coff; bool act;
        if (j < 6) { dst = B0; pitch = 1024; coff = 256 * (j - 4); act = true; }
        else if (j < 8) { dst = B0; pitch = 1024; coff = 512 + 256 * (j - 6); act = false; }
        else if (j < 10) { dst = B3; pitch = 1024; coff = 512 + 256 * (j - 8); act = false; }
        else if (j < 12) { dst = B4; pitch = 512; coff = 256 * (j - 10); act = true; }
        else if (j < 18) { dst = B2; pitch = 1024; coff = 256 * (j - 16); act = false; }
        else { dst = B2; pitch = 1024; coff = 512 + 256 * (j - 18); act = true; }
        for (int e = tid; e < 64 * 256; e += 256) { const int r = e >> 8, c = e & 255; const float v = T[r * TLD + c]; dst[(size_t)(row0 + r) * pitch + coff + c] = f2bf(act ? siluf(v) : v); }
        if (j == 8 || j == 9) { const int r = tid >> 2, wc = tid & 3; float s = 0.f;
            for (int bj = 0; bj < 2; ++bj) for (int i = 0; i < 32; ++i) { const float v = T[r * TLD + 128 * bj + 32 * wc + i]; s += v * v; }
            ((float*)(P.ws + WS_VSS))[(size_t)(row0 + r) * 8 + (j - 8) * 4 + wc] = s; }
    } else {
        const bool isk = j >= 14; const int jj = (j - 12) & 1;
        { const int r = tid >> 2, hh = tid & 3; float s = 0.f;
          for (int d = 0; d < 64; ++d) { const float v = T[r * TLD + 128 * (d >> 5) + 32 * hh + (d & 31)]; s += v * v; }
          R[r * 4 + hh] = rsqrtf(s * (1.f / 64.f) + EPS); }
        __syncthreads();
        const float* gq = (isk ? P.kn_g : P.qn_g) + (size_t)l * HD;
        for (int e = tid; e < 64 * 256; e += 256) { const int r = e >> 8, c = e & 255, hh = (c >> 5) & 3, d = 32 * (c >> 7) + (c & 31);
            float v = T[r * TLD + c] * R[r * 4 + hh] * gq[d]; if (!isk) v *= C2;
            B1[(size_t)(row0 + r) * 1024 + (isk ? 512 : 0) + 64 * (4 * jj + hh) + d] = f2bf(v); }
    }
}

__global__ void __launch_bounds__(512) nv_conv(Ptrs P, int l) {
    __shared__ float red[16];
    const int row = blockIdx.x, t = row % SEQ, c = threadIdx.x, lane = c & 63, w = c >> 6;
    const bf16_t* AG = (const bf16_t*)(P.ws + WS_B3); bf16_t* B0 = (bf16_t*)(P.ws + WS_B0);
    const float* cw = P.conv_w + (size_t)l * CW * DA;
    float a = P.conv_b[l * DA + c];
    for (int j = 0; j < CW; ++j) { const int tt = t - (CW - 1) + j; if (tt >= 0) a += cw[j * DA + c] * bf2f(AG[(size_t)(row - (CW - 1) + j) * 1024 + c]); }
    float s = wave_sum(a); if (lane == 0) red[w] = s; __syncthreads();
    float mu = 0.f; for (int i = 0; i < 8; ++i) mu += red[i]; mu *= (1.f / DA);
    const float d = a - mu; s = wave_sum(d * d); if (lane == 0) red[8 + w] = s; __syncthreads();
    float var = 0.f; for (int i = 0; i < 8; ++i) var += red[8 + i]; var *= (1.f / DA);
    const float y = d * rsqrtf(var + EPS) * P.cn_g[l * DA + c] + P.cn_b[l * DA + c];
    const float az = bf2f(B0[(size_t)row * 1024 + c]);
    B0[(size_t)row * 1024 + c] = f2bf(siluf(y) * az);
}

__global__ void __launch_bounds__(256) nv_gmlp(Ptrs P, int l) {
    extern __shared__ float vn[];
    const int ch = blockIdx.x, g = blockIdx.y, tid = threadIdx.x; const size_t row0 = (size_t)ch * CHK;
    const bf16_t* V = (const bf16_t*)(P.ws + WS_B3); bf16_t* B0 = (bf16_t*)(P.ws + WS_B0); const bf16_t* BZ = (const bf16_t*)(P.ws + WS_B4);
    const float* vss = (const float*)(P.ws + WS_VSS);
    const bf16_t* WSB = (const bf16_t*)(P.ws + WS_WSB) + ((size_t)l * NG + g) * CHK * CHK;
    for (int e = tid; e < 128 * 128; e += 256) { const int s = e >> 7, c = e & 127; const float* q = vss + (row0 + s) * 8;
        const float ss = ((q[0] + q[1]) + (q[2] + q[3])) + ((q[4] + q[5]) + (q[6] + q[7])); const float rv = rsqrtf(ss * (1.f / DB) + EPS);
        vn[s * 129 + c] = bfr(bf2f(V[(row0 + s) * 1024 + 512 + 128 * g + c]) * rv * P.gn_g[l * DB + 128 * g + c]); }
    __syncthreads();
    for (int e = tid; e < 128 * 128; e += 256) { const int t = e >> 7, c = e & 127; float acc = 0.f;
        for (int s = 0; s <= t; ++s) acc += bf2f(WSB[t * 128 + s]) * vn[s * 129 + c];
        acc += P.b_s[((size_t)l * NG + g) * CHK + t];
        const size_t o = (row0 + t) * 1024 + 512 + 128 * g + c;
        B0[o] = f2bf(bf2f(B0[o]) * acc * bf2f(BZ[(row0 + t) * 512 + 128 * g + c])); }
}

__global__ void __launch_bounds__(256) nv_attn(Ptrs P) {
    extern __shared__ float sc[];
    const int lane = threadIdx.x & 63, w = threadIdx.x >> 6; const int item = blockIdx.x * 4 + w, row = item >> 3, h = item & 7, b = row / SEQ, t = row % SEQ;
    float* s = sc + w * SEQ;
    bf16_t* B1 = (bf16_t*)(P.ws + WS_B1); const bf16_t* B2 = (const bf16_t*)(P.ws + WS_B2);
    const float* cs = (const float*)(P.ws + WS_CS) + (size_t)(b * NH + h) * SEQ;
    float q[64];
#pragma unroll
    for (int d = 0; d < 64; ++d) q[d] = bf2f(B1[(size_t)row * 1024 + 64 * h + d]);
    const float cq = cs[t]; float mx = -INFINITY;
    for (int k = lane; k <= t; k += 64) { const bf16_t* kr = B1 + ((size_t)b * SEQ + k) * 1024 + 512 + 64 * h; float dot = 0.f;
#pragma unroll
        for (int d8 = 0; d8 < 8; ++d8) { const bf16x8 kv = *(const bf16x8*)(kr + 8 * d8);
#pragma unroll
            for (int e = 0; e < 8; ++e) dot += q[8 * d8 + e] * bf2f((bf16_t)kv[e]); }
        const float v = dot + (cq - cs[k]); s[k] = v; mx = fmaxf(mx, v); }
#pragma unroll
    for (int o = 1; o < 64; o <<= 1) mx = fmaxf(mx, __shfl_xor(mx, o));
    float lsum = 0.f;
    for (int k = lane; k <= t; k += 64) { const float p = exp2f(s[k] - mx); lsum += p; s[k] = bfr(p); }
    lsum = wave_sum(lsum);
    __builtin_amdgcn_s_waitcnt(0); __builtin_amdgcn_wave_barrier();
    float o = 0.f; const bf16_t* vb = B2 + (size_t)b * SEQ * 1024 + 64 * h + lane;
    for (int k = 0; k <= t; ++k) o += s[k] * bf2f(vb[(size_t)k * 1024]);
    const float cz = bf2f(B2[(size_t)row * 1024 + 512 + 64 * h + lane]);
    B1[(size_t)row * 1024 + 64 * h + lane] = f2bf(o / lsum * cz);
}

__global__ void __launch_bounds__(256) nv_merge(Ptrs P, int l) {
    extern __shared__ float T[];
    const int pn = blockIdx.x, row0 = blockIdx.y * 64, tid = threadIdx.x, w = tid >> 6, ln = tid & 63, fr = ln & 15, fq = ln >> 4;
    const unsigned char* wl = P.ws + WS_W + (size_t)l * W_LAYER;
    const bf16_t* H = (const bf16_t*)(P.ws + WS_H); const bf16_t* WG = (const bf16_t*)(wl + WO_WG); const bf16_t* WAB = (const bf16_t*)(wl + WO_WAB); const bf16_t* WC = (const bf16_t*)(wl + WO_WC);
    const bf16_t* B0 = (const bf16_t*)(P.ws + WS_B0); const bf16_t* B1 = (const bf16_t*)(P.ws + WS_B1);
    float* G = T; float* MGs = T + 64 * 256;
    f32x4 acc[4][4];
    for (int br = 0; br < 3; ++br) {
        nv_gemm_acc(H + (size_t)row0 * D, D, WG + ((size_t)br * 1024 + 256 * pn) * D, D, D, acc);
#pragma unroll
        for (int m = 0; m < 4; ++m)
#pragma unroll
            for (int n = 0; n < 4; ++n)
#pragma unroll
                for (int r = 0; r < 4; ++r) { const int c = 64 * w + 16 * n + fr; G[((m * 4 + n) * 4 + r) * 256 + tid] = bfr(sigm(acc[m][n][r] + P.b_gate[(size_t)l * 3072 + br * 1024 + 256 * pn + c])); }
        const bf16_t* A = br == 0 ? B0 : (br == 1 ? B0 + 512 : B1); const bf16_t* Bt = br == 0 ? WAB : (br == 1 ? WAB + 512 : WC);
        nv_gemm_acc(A + (size_t)row0 * 1024, 1024, Bt + (size_t)256 * pn * 1024, 1024, 512, acc);
#pragma unroll
        for (int m = 0; m < 4; ++m)
#pragma unroll
            for (int n = 0; n < 4; ++n)
#pragma unroll
                for (int r = 0; r < 4; ++r) { const int s = ((m * 4 + n) * 4 + r) * 256 + tid; const float v = G[s] * acc[m][n][r]; MGs[s] = bfr(br == 0 ? v : MGs[s] + v); }
    }
    bf16_t* MG = (bf16_t*)(P.ws + WS_MG);
#pragma unroll
    for (int m = 0; m < 4; ++m)
#pragma unroll
        for (int n = 0; n < 4; ++n)
#pragma unroll
            for (int r = 0; r < 4; ++r) MG[(size_t)(row0 + 16 * m + 4 * fq + r) * 1024 + 256 * pn + 64 * w + 16 * n + fr] = f2bf(MGs[((m * 4 + n) * 4 + r) * 256 + tid]);
}

__global__ void __launch_bounds__(256) nv_out(Ptrs P, int l, const float* xin, float* xout) {
    const int pn = blockIdx.x, row0 = blockIdx.y * 64, tid = threadIdx.x, w = tid >> 6, ln = tid & 63, fr = ln & 15, fq = ln >> 4;
    const bf16_t* MG = (const bf16_t*)(P.ws + WS_MG); const bf16_t* WO = (const bf16_t*)(P.ws + WS_W + (size_t)l * W_LAYER + WO_WO);
    f32x4 acc[4][4];
    nv_gemm_acc(MG + (size_t)row0 * 1024, 1024, WO + (size_t)256 * pn * 1024, 1024, 1024, acc);
#pragma unroll
    for (int m = 0; m < 4; ++m)
#pragma unroll
        for (int n = 0; n < 4; ++n)
#pragma unroll
            for (int r = 0; r < 4; ++r) { const size_t o = (size_t)(row0 + 16 * m + 4 * fq + r) * D + 256 * pn + 64 * w + 16 * n + fr; xout[o] = xin[o] + acc[m][n][r]; }
}

extern "C" void kernel_launch(void* const* d_in, const int* in_sizes, int n_in, void* d_out, int out_size, void* d_ws, size_t ws_size, hipStream_t stream) {
    static int ok = 0;
    if (ok == 0) {
        if (n_in != 18 || in_sizes[0] != M * D || out_size != M * D || ws_size < WS_END) { fprintf(stderr, "kernel_launch: unexpected shapes (n_in %d in0 %d out %d ws %zu)\n", n_in, n_in > 0 ? in_sizes[0] : -1, out_size, ws_size); ok = -1; return; }
        const int tl = 64 * TLD * 4;
        (void)hipFuncSetAttribute((const void*)nv_gemm1, hipFuncAttributeMaxDynamicSharedMemorySize, tl);
        (void)hipFuncSetAttribute((const void*)nv_merge, hipFuncAttributeMaxDynamicSharedMemorySize, 2 * 64 * 256 * 4);
        (void)hipFuncSetAttribute((const void*)nv_gmlp, hipFuncAttributeMaxDynamicSharedMemorySize, 128 * 129 * 4);
        (void)hipFuncSetAttribute((const void*)nv_attn, hipFuncAttributeMaxDynamicSharedMemorySize, 4 * SEQ * 4);
        ok = 1;
    }
    if (ok < 0) return;
    Ptrs P{};
    const float** pp = (const float**)&P;
    for (int i = 0; i < 18; ++i) pp[i] = (const float*)d_in[i];
    P.out = (float*)d_out; P.ws = (unsigned char*)d_ws;
    const int tl = 64 * TLD * 4;
    nv_prep<<<2048, 256, 0, stream>>>(P);
    for (int l = 0; l < NL; ++l) {
        const float* xin = l == 0 ? P.x : P.out;
        nv_ln<<<M / 4, 256, 0, stream>>>(P, l, xin);
        nv_scan<<<NB * NH, 256, 0, stream>>>(P);
        nv_gemm1<<<dim3(20, 256), 256, tl, stream>>>(P, l);
        nv_conv<<<M, 512, 0, stream>>>(P, l);
        nv_gmlp<<<dim3(128, 4), 256, 128 * 129 * 4, stream>>>(P, l);
        nv_attn<<<M * NH / 4, 256, 4 * SEQ * 4, stream>>>(P);
        nv_merge<<<dim3(4, 256), 256, 2 * 64 * 256 * 4, stream>>>(P, l);
        nv_out<<<dim3(4, 256), 256, 0, stream>>>(P, l, xin, P.out);
    }
}
```

```cpp
#include <hip/hip_runtime.h>
#include <cstdio>
#include <cstdint>
#include <cmath>

constexpr int NL = 2, NB = 4, SEQ = 4096, M = NB * SEQ, D = 1024;
constexpr int DA = 512, DB = 512, NH = 8, HD = 64, DC = 512, CW = 31, CHK = 128, NG = 4, GD = 128, NIN = 8200;
constexpr float EPS = 1e-6f;
constexpr float LOG2E = 1.4426950408889634f;
constexpr float C2 = 0.125f * LOG2E;
constexpr int N1 = 5120;
constexpr int OC_GATE = 0, OC_AIN = 3072, OC_AZ = 4096, OC_U = 4608, OC_V = 5120, OC_BZ = 5632, OC_Q = 6144, OC_K = 6656, OC_VA = 7168, OC_CZ = 7680, OC_F = 8192;

constexpr size_t MiB = 1u << 20;
constexpr size_t WS_CTL = 0, CTL_ZERO_BYTES = 1 * MiB;
constexpr size_t WS_VSS = 1 * MiB;
constexpr size_t WS_LOGF = WS_VSS + 512 * 1024;
constexpr size_t WS_CS = 2 * MiB;
constexpr size_t WS_WSB = WS_CS + 512 * 1024;
constexpr size_t WS_W = 4 * MiB, W_LAYER = 22 * MiB;
constexpr size_t WO_W1 = 0, WO_WG = 10 * MiB, WO_WAB = 16 * MiB, WO_WC = 18 * MiB, WO_WO = 20 * MiB;
constexpr size_t WS_H = 48 * MiB;
constexpr size_t WS_B0 = 80 * MiB;
constexpr size_t WS_B1 = 112 * MiB;
constexpr size_t WS_B2 = 144 * MiB;
constexpr size_t WS_B3 = 176 * MiB;
constexpr size_t WS_B4 = 208 * MiB;
constexpr size_t WS_GT = WS_B2, WS_MG = WS_B3;
constexpr size_t WS_END = 256 * MiB;

typedef unsigned short bf16_t;
typedef short bf16x8 __attribute__((ext_vector_type(8)));
typedef float f32x4 __attribute__((ext_vector_type(4)));
typedef unsigned u32x4 __attribute__((ext_vector_type(4)));

__host__ __device__ __forceinline__ float bf2f(bf16_t v) { union { unsigned u; float f; } c; c.u = (unsigned)v << 16; return c.f; }
__host__ __device__ __forceinline__ bf16_t f2bf(float f) { union { unsigned u; float f; } c; c.f = f; unsigned u = c.u; return (bf16_t)((u + 0x7fffu + ((u >> 16) & 1u)) >> 16); }
__device__ __forceinline__ float bfr(float f) { return bf2f(f2bf(f)); }
__device__ __forceinline__ float sigm(float x) { return 1.f / (1.f + __expf(-x)); }
__device__ __forceinline__ float siluf(float x) { return x * sigm(x); }

__host__ __device__ __forceinline__ int g1_col(int n) {
    const int j = n >> 8, lc = n & 255;
    if (j < 4) return lc < 128 ? OC_AIN + 128 * j + lc : OC_AIN + 512 + 128 * j + (lc - 128);
    if (j < 6) return OC_AZ + 256 * (j - 4) + lc;
    if (j < 8) return OC_U + 256 * (j - 6) + lc;
    if (j < 10) return OC_V + 256 * (j - 8) + lc;
    if (j < 12) return OC_BZ + 256 * (j - 10) + lc;
    if (j < 16) { const int isk = j >= 14, jj = (j - 12) & 1, head = 4 * jj + ((lc >> 5) & 3), d = 32 * (lc >> 7) + (lc & 31); return (isk ? OC_K : OC_Q) + 64 * head + d; }
    if (j < 18) return OC_VA + 256 * (j - 16) + lc;
    return OC_CZ + 256 * (j - 18) + lc;
}

struct Ptrs {
    const float *x, *norm_g, *w_in, *b_gate, *conv_w, *conv_b, *cn_g, *cn_b, *w_a, *gn_g, *w_s, *b_s, *w_b, *qn_g, *kn_g, *b_f, *w_c, *w_out;
    float* out; unsigned char* ws;
};

__global__ void nv_prep(Ptrs P) {
    const size_t gid = (size_t)blockIdx.x * blockDim.x + threadIdx.x, gsz = (size_t)gridDim.x * blockDim.x;
    for (int l = 0; l < NL; ++l) {
        unsigned char* wl = P.ws + WS_W + (size_t)l * W_LAYER;
        bf16_t* W1 = (bf16_t*)(wl + WO_W1); bf16_t* WG = (bf16_t*)(wl + WO_WG); bf16_t* WAB = (bf16_t*)(wl + WO_WAB); bf16_t* WC = (bf16_t*)(wl + WO_WC); bf16_t* WO = (bf16_t*)(wl + WO_WO);
        const float* win = P.w_in + (size_t)l * D * NIN;
        for (size_t i = gid; i < (size_t)N1 * D; i += gsz) { const int n = (int)(i >> 10), k = (int)(i & 1023); W1[i] = f2bf(win[(size_t)k * NIN + g1_col(n)]); }
        for (size_t i = gid; i < (size_t)3072 * D; i += gsz) { const int n = (int)(i >> 10), k = (int)(i & 1023); WG[i] = f2bf(win[(size_t)k * NIN + n]); }
        for (size_t i = gid; i < (size_t)1024 * 1024; i += gsz) { const int n = (int)(i >> 10), k = (int)(i & 1023);
            WAB[i] = f2bf(k < 512 ? P.w_a[((size_t)l * DA + k) * D + n] : P.w_b[((size_t)l * DB + (k - 512)) * D + n]);
            WC[i] = k < 512 ? f2bf(P.w_c[((size_t)l * DC + k) * D + n]) : (bf16_t)0;
            WO[i] = f2bf(P.w_out[((size_t)l * D + k) * D + n]); }
        bf16_t* WSB = (bf16_t*)(P.ws + WS_WSB) + (size_t)l * NG * CHK * CHK;
        for (size_t i = gid; i < (size_t)NG * CHK * CHK; i += gsz) { const int s = (int)(i & 127), t = (int)((i >> 7) & 127); WSB[i] = s <= t ? f2bf(P.w_s[(size_t)l * NG * CHK * CHK + i]) : (bf16_t)0; }
    }
}

__device__ __forceinline__ float wave_sum(float v) {
#pragma unroll
    for (int o = 1; o < 64; o <<= 1) v += __shfl_xor(v, o);
    return v;
}

__global__ void nv_ln(Ptrs P, int l, const float* xin) {
    const int lane = threadIdx.x & 63, row = blockIdx.x * 4 + (threadIdx.x >> 6);
    const float* xr = xin + (size_t)row * D; const float* g = P.norm_g + (size_t)l * D; const float* win = P.w_in + (size_t)l * D * NIN;
    float v[16]; float ss = 0.f;
#pragma unroll
    for (int j = 0; j < 16; ++j) { v[j] = xr[lane + 64 * j]; ss += v[j] * v[j]; }
    ss = wave_sum(ss);
    const float r = rsqrtf(ss * (1.f / D) + EPS);
    bf16_t* h = (bf16_t*)(P.ws + WS_H) + (size_t)row * D;
    float f[8] = {0, 0, 0, 0, 0, 0, 0, 0};
#pragma unroll
    for (int j = 0; j < 16; ++j) { const int k = lane + 64 * j; const float hv = v[j] * r * g[k]; h[k] = f2bf(hv);
#pragma unroll
        for (int e = 0; e < 8; ++e) f[e] += hv * win[(size_t)k * NIN + OC_F + e]; }
#pragma unroll
    for (int e = 0; e < 8; ++e) f[e] = wave_sum(f[e]);
    if (lane < 8) { float z = 0.f;
#pragma unroll
        for (int e = 0; e < 8; ++e) if (lane == e) z = f[e];
        z += P.b_f[l * NH + lane];
        const float lf = fminf(z, 0.f) - log1pf(expf(-fabsf(z)));
        ((float*)(P.ws + WS_LOGF))[(size_t)row * 8 + lane] = lf; }
}

__global__ void nv_scan(Ptrs P) {
    __shared__ float buf[SEQ];
    const int bh = blockIdx.x, b = bh / NH, h = bh % NH;
    const float* lf = (const float*)(P.ws + WS_LOGF);
    for (int t = threadIdx.x; t < SEQ; t += blockDim.x) buf[t] = lf[((size_t)b * SEQ + t) * 8 + h];
    __syncthreads();
    if (threadIdx.x == 0) { float c = 0.f; for (int t = 0; t < SEQ; ++t) { c += buf[t]; buf[t] = c * LOG2E; } }
    __syncthreads();
    float* cs = (float*)(P.ws + WS_CS) + (size_t)bh * SEQ;
    for (int t = threadIdx.x; t < SEQ; t += blockDim.x) cs[t] = buf[t];
}

constexpr int TLD = 257;
__device__ __forceinline__ void nv_gemm_acc(const bf16_t* A, int lda, const bf16_t* Bt, int ldb, int K, f32x4 (&acc)[4][4]) {
    const int tid = threadIdx.x, w = tid >> 6, l = tid & 63, fr = l & 15, fq = l >> 4;
#pragma unroll
    for (int m = 0; m < 4; ++m)
#pragma unroll
        for (int n = 0; n < 4; ++n) acc[m][n] = (f32x4){0.f, 0.f, 0.f, 0.f};
    for (int k0 = 0; k0 < K; k0 += 32) {
        bf16x8 a[4], b[4];
#pragma unroll
        for (int m = 0; m < 4; ++m) a[m] = *(const bf16x8*)(A + (size_t)(16 * m + fr) * lda + k0 + 8 * fq);
#pragma unroll
        for (int n = 0; n < 4; ++n) b[n] = *(const bf16x8*)(Bt + (size_t)(64 * w + 16 * n + fr) * ldb + k0 + 8 * fq);
#pragma unroll
        for (int m = 0; m < 4; ++m)
#pragma unroll
            for (int n = 0; n < 4; ++n) acc[m][n] = __builtin_amdgcn_mfma_f32_16x16x32_bf16(a[m], b[n], acc[m][n], 0, 0, 0);
    }
}
__device__ __forceinline__ void nv_gemm_tile(const bf16_t* A, int lda, const bf16_t* Bt, int ldb, int K, float* T) {
    const int tid = threadIdx.x, w = tid >> 6, l = tid & 63, fr = l & 15, fq = l >> 4;
    f32x4 acc[4][4];
    nv_gemm_acc(A, lda, Bt, ldb, K, acc);
#pragma unroll
    for (int m = 0; m < 4; ++m)
#pragma unroll
        for (int n = 0; n < 4; ++n)
#pragma unroll
            for (int r = 0; r < 4; ++r) T[(16 * m + 4 * fq + r) * TLD + 64 * w + 16 * n + fr] = acc[m][n][r];
}

__global__ void __launch_bounds__(256) nv_gemm1(Ptrs P, int l) {
    extern __shared__ float T[];
    __shared__ float R[64 * 4];
    const int j = blockIdx.x, row0 = blockIdx.y * 64, tid = threadIdx.x;
    const bf16_t* H = (const bf16_t*)(P.ws + WS_H);
    const bf16_t* W1 = (const bf16_t*)(P.ws + WS_W + (size_t)l * W_LAYER + WO_W1);
    nv_gemm_tile(H + (size_t)row0 * D, D, W1 + (size_t)j * 256 * D, D, D, T);
    __syncthreads();
    bf16_t* B0 = (bf16_t*)(P.ws + WS_B0); bf16_t* B1 = (bf16_t*)(P.ws + WS_B1); bf16_t* B2 = (bf16_t*)(P.ws + WS_B2); bf16_t* B3 = (bf16_t*)(P.ws + WS_B3); bf16_t* B4 = (bf16_t*)(P.ws + WS_B4);
    if (j < 4) {
        for (int e = tid; e < 64 * 128; e += 256) { const int r = e >> 7, c = e & 127; B3[(size_t)(row0 + r) * 1024 + 128 * j + c] = f2bf(T[r * TLD + c] * sigm(T[r * TLD + c + 128])); }
    } else if (j < 12 || j >= 16) {
        bf16_t* dst; int pitch, coff; bool act;
        if (j < 6) { dst = B0; pitch = 1024; coff = 256 * (j - 4); act = true; }
        else if (j < 8) { dst = B0; pitch = 1024; coff = 512 + 256 * (j - 6); act = false; }
        else if (j < 10) { dst = B3; pitch = 1024; coff = 512 + 256 * (j - 8); act = false; }
        else if (j < 12) { dst = B4; pitch = 512; coff = 256 * (j - 10); act = true; }
        else if (j < 18) { dst = B2; pitch = 1024; coff = 256 * (j - 16); act = false; }
        else { dst = B2; pitch = 1024; coff = 512 + 256 * (j - 18); act = true; }
        for (int e = tid; e < 64 * 256; e += 256) { const int r = e >> 8, c = e & 255; const float v = T[r * TLD + c]; dst[(size_t)(row0 + r) * pitch + coff + c] = f2bf(act ? siluf(v) : v); }
        if (j == 8 || j == 9) { const int r = tid >> 2, wc = tid & 3; float s = 0.f;
            for (int bj = 0; bj < 2; ++bj) for (int i = 0; i < 32; ++i) { const float v = T[r * TLD + 128 * bj + 32 * wc + i]; s += v * v; }
            ((float*)(P.ws + WS_VSS))[(size_t)(row0 + r) * 8 + (j - 8) * 4 + wc] = s; }
    } else {
        const bool isk = j >= 14; const int jj = (j - 12) & 1;
        { const int r = tid >> 2, hh = tid & 3; float s = 0.f;
          for (int d = 0; d < 64; ++d) { const float v = T[r * TLD + 128 * (d >> 5) + 32 * hh + (d & 31)]; s += v * v; }
          R[r * 4 + hh] = rsqrtf(s * (1.f / 64.f) + EPS); }
        __syncthreads();
        const float* gq = (isk ? P.kn_g : P.qn_g) + (size_t)l * HD;
        for (int e = tid; e < 64 * 256; e += 256) { const int r = e >> 8, c = e & 255, hh = (c >> 5) & 3, d = 32 * (c >> 7) + (c & 31);
            float v = T[r * TLD + c] * R[r * 4 + hh] * gq[d]; if (!isk) v *= C2;
            B1[(size_t)(row0 + r) * 1024 + (isk ? 512 : 0) + 64 * (4 * jj + hh) + d] = f2bf(v); }
    }
}

__global__ void __launch_bounds__(512) nv_conv(Ptrs P, int l) {
    __shared__ float red[16];
    const int row = blockIdx.x, t = row % SEQ, c = threadIdx.x, lane = c & 63, w = c >> 6;
    const bf16_t* AG = (const bf16_t*)(P.ws + WS_B3); bf16_t* B0 = (bf16_t*)(P.ws + WS_B0);
    const float* cw = P.conv_w + (size_t)l * CW * DA;
    float a = P.conv_b[l * DA + c];
    for (int j = 0; j < CW; ++j) { const int tt = t - (CW - 1) + j; if (tt >= 0) a += cw[j * DA + c] * bf2f(AG[(size_t)(row - (CW - 1) + j) * 1024 + c]); }
    float s = wave_sum(a); if (lane == 0) red[w] = s; __syncthreads();
    float mu = 0.f; for (int i = 0; i < 8; ++i) mu += red[i]; mu *= (1.f / DA);
    const float d = a - mu; s = wave_sum(d * d); if (lane == 0) red[8 + w] = s; __syncthreads();
    float var = 0.f; for (int i = 0; i < 8; ++i) var += red[8 + i]; var *= (1.f / DA);
    const float y = d * rsqrtf(var + EPS) * P.cn_g[l * DA + c] + P.cn_b[l * DA + c];
    const float az = bf2f(B0[(size_t)row * 1024 + c]);
    B0[(size_t)row * 1024 + c] = f2bf(siluf(y) * az);
}

__global__ void __launch_bounds__(256) nv_gmlp(Ptrs P, int l) {
    extern __shared__ float vn[];
    const int ch = blockIdx.x, g = blockIdx.y, tid = threadIdx.x; const size_t row0 = (size_t)ch * CHK;
    const bf16_t* V = (const bf16_t*)(P.ws + WS_B3); bf16_t* B0 = (bf16_t*)(P.ws + WS_B0); const bf16_t* BZ = (const bf16_t*)(P.ws + WS_B4);
    const float* vss = (const float*)(P.ws + WS_VSS);
    const bf16_t* WSB = (const bf16_t*)(P.ws + WS_WSB) + ((size_t)l * NG + g) * CHK * CHK;
    for (int e = tid; e < 128 * 128; e += 256) { const int s = e >> 7, c = e & 127; const float* q = vss + (row0 + s) * 8;
        const float ss = ((q[0] + q[1]) + (q[2] + q[3])) + ((q[4] + q[5]) + (q[6] + q[7])); const float rv = rsqrtf(ss * (1.f / DB) + EPS);
        vn[s * 129 + c] = bfr(bf2f(V[(row0 + s) * 1024 + 512 + 128 * g + c]) * rv * P.gn_g[l * DB + 128 * g + c]); }
    __syncthreads();
    for (int e = tid; e < 128 * 128; e += 256) { const int t = e >> 7, c = e & 127; float acc = 0.f;
        for (int s = 0; s <= t; ++s) acc += bf2f(WSB[t * 128 + s]) * vn[s * 129 + c];
        acc += P.b_s[((size_t)l * NG + g) * CHK + t];
        const size_t o = (row0 + t) * 1024 + 512 + 128 * g + c;
        B0[o] = f2bf(bf2f(B0[o]) * acc * bf2f(BZ[(row0 + t) * 512 + 128 * g + c])); }
}

__global__ void __launch_bounds__(256) nv_attn(Ptrs P) {
    extern __shared__ float sc[];
    const int lane = threadIdx.x & 63, w = threadIdx.x >> 6; const int item = blockIdx.x * 4 + w, row = item >> 3, h = item & 7, b = row / SEQ, t = row % SEQ;
    float* s = sc + w * SEQ;
    bf16_t* B1 = (bf16_t*)(P.ws + WS_B1); const bf16_t* B2 = (const bf16_t*)(P.ws + WS_B2);
    const float* cs = (const float*)(P.ws + WS_CS) + (size_t)(b * NH + h) * SEQ;
    float q[64];
#pragma unroll
    for (int d = 0; d < 64; ++d) q[d] = bf2f(B1[(size_t)row * 1024 + 64 * h + d]);
    const float cq = cs[t]; float mx = -INFINITY;
    for (int k = lane; k <= t; k += 64) { const bf16_t* kr = B1 + ((size_t)b * SEQ + k) * 1024 + 512 + 64 * h; float dot = 0.f;
#pragma unroll
        for (int d8 = 0; d8 < 8; ++d8) { const bf16x8 kv = *(const bf16x8*)(kr + 8 * d8);
#pragma unroll
            for (int e = 0; e < 8; ++e) dot += q[8 * d8 + e] * bf2f((bf16_t)kv[e]); }
        const float v = dot + (cq - cs[k]); s[k] = v; mx = fmaxf(mx, v); }
#pragma unroll
    for (int o = 1; o < 64; o <<= 1) mx = fmaxf(mx, __shfl_xor(mx, o));
    float lsum = 0.f;
    for (int k = lane; k <= t; k += 64) { const float p = exp2f(s[k] - mx); lsum += p; s[k] = bfr(p); }
    lsum = wave_sum(lsum);
    __builtin_amdgcn_s_waitcnt(0); __builtin_amdgcn_wave_barrier();
    float o = 0.f; const bf16_t* vb = B2 + (size_t)b * SEQ * 1024 + 64 * h + lane;
    for (int k = 0; k <= t; ++k) o += s[k] * bf2f(vb[(size_t)k * 1024]);
    const float cz = bf2f(B2[(size_t)row * 1024 + 512 + 64 * h + lane]);
    B1[(size_t)row * 1024 + 64 * h + lane] = f2bf(o / lsum * cz);
}

__global__ void __launch_bounds__(256) nv_merge(Ptrs P, int l) {
    extern __shared__ float T[];
    const int pn = blockIdx.x, row0 = blockIdx.y * 64, tid = threadIdx.x, w = tid >> 6, ln = tid & 63, fr = ln & 15, fq = ln >> 4;
    const unsigned char* wl = P.ws + WS_W + (size_t)l * W_LAYER;
    const bf16_t* H = (const bf16_t*)(P.ws + WS_H); const bf16_t* WG = (const bf16_t*)(wl + WO_WG); const bf16_t* WAB = (const bf16_t*)(wl + WO_WAB); const bf16_t* WC = (const bf16_t*)(wl + WO_WC);
    const bf16_t* B0 = (const bf16_t*)(P.ws + WS_B0); const bf16_t* B1 = (const bf16_t*)(P.ws + WS_B1);
    float* G = T; float* MGs = T + 64 * 256;
    f32x4 acc[4][4];
    for (int br = 0; br < 3; ++br) {
        nv_gemm_acc(H + (size_t)row0 * D, D, WG + ((size_t)br * 1024 + 256 * pn) * D, D, D, acc);
#pragma unroll
        for (int m = 0; m < 4; ++m)
#pragma unroll
            for (int n = 0; n < 4; ++n)
#pragma unroll
                for (int r = 0; r < 4; ++r) { const int c = 64 * w + 16 * n + fr; G[((m * 4 + n) * 4 + r) * 256 + tid] = bfr(sigm(acc[m][n][r] + P.b_gate[(size_t)l * 3072 + br * 1024 + 256 * pn + c])); }
        const bf16_t* A = br == 0 ? B0 : (br == 1 ? B0 + 512 : B1); const bf16_t* Bt = br == 0 ? WAB : (br == 1 ? WAB + 512 : WC);
        nv_gemm_acc(A + (size_t)row0 * 1024, 1024, Bt + (size_t)256 * pn * 1024, 1024, 512, acc);
#pragma unroll
        for (int m = 0; m < 4; ++m)
#pragma unroll
            for (int n = 0; n < 4; ++n)
#pragma unroll
                for (int r = 0; r < 4; ++r) { const int s = ((m * 4 + n) * 4 + r) * 256 + tid; const float v = G[s] * acc[m][n][r]; MGs[s] = bfr(br == 0 ? v : MGs[s] + v); }
    }
    bf16_t* MG = (bf16_t*)(P.ws + WS_MG);
#pragma unroll
    for (int m = 0; m < 4; ++m)
#pragma unroll
        for (int n = 0; n < 4; ++n)
#pragma unroll
            for (int r = 0; r < 4; ++r) MG[(size_t)(row0 + 16 * m + 4 * fq + r) * 1024 + 256 * pn + 64 * w + 16 * n + fr] = f2bf(MGs[((m * 4 + n) * 4 + r) * 256 + tid]);
}

__global__ void __launch_bounds__(256) nv_out(Ptrs P, int l, const float* xin, float* xout) {
    const int pn = blockIdx.x, row0 = blockIdx.y * 64, tid = threadIdx.x, w = tid >> 6, ln = tid & 63, fr = ln & 15, fq = ln >> 4;
    const bf16_t* MG = (const bf16_t*)(P.ws + WS_MG); const bf16_t* WO = (const bf16_t*)(P.ws + WS_W + (size_t)l * W_LAYER + WO_WO);
    f32x4 acc[4][4];
    nv_gemm_acc(MG + (size_t)row0 * 1024, 1024, WO + (size_t)256 * pn * 1024, 1024, 1024, acc);
#pragma unroll
    for (int m = 0; m < 4; ++m)
#pragma unroll
        for (int n = 0; n < 4; ++n)
#pragma unroll
            for (int r = 0; r < 4; ++r) { const size_t o = (size_t)(row0 + 16 * m + 4 * fq + r) * D + 256 * pn + 64 * w + 16 * n + fr; xout[o] = xin[o] + acc[m][n][r]; }
}


#define LAS __attribute__((address_space(3)))
#define GAS __attribute__((address_space(1)))
typedef GAS unsigned gu32;
#define RLX_AGENT __ATOMIC_RELAXED, __HIP_MEMORY_SCOPE_AGENT
#define LDS_WAIT() asm volatile("s_waitcnt lgkmcnt(0)" ::: "memory")
#define VM_WAIT() asm volatile("s_waitcnt vmcnt(0)" ::: "memory")
constexpr int NWAVES = 8;
constexpr int RING_OFF = 0, RING_BYTES = 131072;
constexpr int LDSCTL_OFF = RING_BYTES, MISC_OFF = LDSCTL_OFF + 320;
constexpr int LDS_BYTES = 147456;
constexpr int CW_TMO = 0, CW_CODE = 1, CW_BAR = 4096;
constexpr int NPH = 10;

__device__ __forceinline__ unsigned cvt_pk_bf16(float lo, float hi) { unsigned r; asm volatile("v_cvt_pk_bf16_f32 %0, %1, %2" : "=v"(r) : "v"(lo), "v"(hi)); return r; }
__device__ __forceinline__ float fsigm(float x) { return __builtin_amdgcn_rcpf(1.f + __builtin_amdgcn_exp2f(-LOG2E * x)); }
__device__ __forceinline__ u32x4 pack8(const f32x4& a, const f32x4& b) { u32x4 w; w.x = cvt_pk_bf16(a[0], a[1]); w.y = cvt_pk_bf16(a[2], a[3]); w.z = cvt_pk_bf16(b[0], b[1]); w.w = cvt_pk_bf16(b[2], b[3]); return w; }
__device__ __forceinline__ void unpack8(const u32x4& w, f32x4& a, f32x4& b) {
    a[0] = __uint_as_float(w.x << 16); a[1] = __uint_as_float(w.x & 0xffff0000u); a[2] = __uint_as_float(w.y << 16); a[3] = __uint_as_float(w.y & 0xffff0000u);
    b[0] = __uint_as_float(w.z << 16); b[1] = __uint_as_float(w.z & 0xffff0000u); b[2] = __uint_as_float(w.w << 16); b[3] = __uint_as_float(w.w & 0xffff0000u); }

namespace pg8 {
constexpr int BM = 256, BK = 64, HALF = 128, HTB = HALF * BK * 2, STAGE_BYTES = 8 * HTB, NXCD = 8, WGM = 8, PITCH = 1024;
__host__ __device__ __forceinline__ int lds_byte(int r, int c) { const int st = (r >> 4) * 2 + (c >> 5), rr = r & 15, cc = c & 31, ob = rr * 64 + cc * 2; return st * 1024 + (ob ^ (((ob >> 9) & 1) << 5)); }
__host__ __device__ __forceinline__ void stage_rc(int b, int& R, int& C) { const int st = b / 1024, sb = b % 1024, swz = sb ^ (((sb >> 9) & 1) << 5); R = (st >> 1) * 16 + swz / 64; C = (st & 1) * 32 + (swz % 64) / 2; }
__host__ __device__ __forceinline__ int perm32(int rho) { const int n = rho >> 4, i = rho & 15; return 8 * (i >> 2) + 4 * n + (i & 3); }

struct Unit { const char* A; const char* B; int nt, pm, pn, tag; };

struct TileOrder {
    int nM, nN, nwg, G, c;
    __device__ __forceinline__ void init(int Mr, int N, int G_, int c_) { nM = Mr / BM; nN = N / BM; nwg = nM * nN; G = G_; c = c_; }
    __device__ __forceinline__ bool tile(int i, int& pm, int& pn) const {
        const long L = (long)i * G + c; if (L >= nwg) return false;
        int wgid = (int)L; { const int q = nwg / NXCD, r = nwg % NXCD, xcd = wgid % NXCD, off = wgid / NXCD; wgid = (xcd < r ? xcd * (q + 1) : r * (q + 1) + (xcd - r) * q) + off; }
        const int nig = WGM * nN, gid = wgid / nig, fm = gid * WGM, gsz = (nM - fm) < WGM ? (nM - fm) : WGM;
        pm = fm + ((wgid % nig) % gsz); pn = (wgid % nig) / gsz; return true;
    }
};

template <class Epi, class Sched>
__device__ __forceinline__ void gemm_phase(LAS unsigned char* lds, const Sched& S, const Epi& E) {
    int tid = threadIdx.x; asm volatile("" : "+v"(tid));
    const int wid = __builtin_amdgcn_readfirstlane(tid >> 6), lane = tid & 63, wr = wid >> 2, wc = wid & 3, fr = lane & 15, fq = lane >> 4;
    unsigned voffA[2], voffB[2];
#pragma unroll
    for (int i = 0; i < 2; ++i) { int R, C; stage_rc(tid * 16 + i * 8192, R, C); const int Rb = (R & ~31) + perm32(R & 31);
        voffA[i] = (unsigned)(R * PITCH + C) * 2u; voffB[i] = (unsigned)(Rb * PITCH + C) * 2u; }
    const size_t kstep = (size_t)(BK * 2);
    const size_t hstep = (size_t)HALF * PITCH * 2;
    const unsigned ldsw = (unsigned)wid * 1024u;
    const int aoff = lds_byte(wr * 64 + fr, fq * 8), boff = lds_byte(wc * 32 + fr, fq * 8);
#define PG8_SA(b, h) (((b) * 2 + (h)) * HTB)
#define PG8_SB(b, h) ((4 + (b) * 2 + (h)) * HTB)
#define PG8_STAGE(bufoff, gbase, voff) do { _Pragma("unroll") for (int _i = 0; _i < 2; ++_i) \
        __builtin_amdgcn_global_load_lds((const unsigned*)((const char*)(gbase) + (voff)[_i]), (LAS unsigned*)(lds + (bufoff) + ldsw + _i * 8192), 16, 0, 0); } while (0)
#define PG8_LDA(dst, b, h) do { _Pragma("unroll") for (int m = 0; m < 4; ++m) _Pragma("unroll") for (int k = 0; k < 2; ++k) dst[m][k] = *(const LAS bf16x8*)(lds + PG8_SA(b, h) + aoff + m * 2048 + k * 1024); } while (0)
#define PG8_LDB(dst, b, h) do { _Pragma("unroll") for (int n = 0; n < 2; ++n) _Pragma("unroll") for (int k = 0; k < 2; ++k) dst[n][k] = *(const LAS bf16x8*)(lds + PG8_SB(b, h) + boff + n * 2048 + k * 1024); } while (0)
#define PG8_MMA(ai, bj, At, Bt) do { __builtin_amdgcn_s_setprio(1); _Pragma("unroll") for (int m = 0; m < 4; ++m) _Pragma("unroll") for (int n = 0; n < 2; ++n) _Pragma("unroll") for (int k = 0; k < 2; ++k) \
        acc[ai][bj][m][n] = __builtin_amdgcn_mfma_f32_16x16x32_bf16(Bt[n][k], At[m][k], acc[ai][bj][m][n], 0, 0, 0); __builtin_amdgcn_s_setprio(0); } while (0)
#define PG8_WAIT_V(n) asm volatile("s_waitcnt vmcnt(" #n ")" ::: "memory")
#define PG8_WAIT_L(n) asm volatile("s_waitcnt lgkmcnt(" #n ")" ::: "memory")
#define PG8_BAR __builtin_amdgcn_s_barrier()
#define PG8_SCHED __builtin_amdgcn_sched_barrier(0)
    Unit cur, nxt; int ui = 0;
    if (!S.next(0, cur)) return;
    f32x4 acc[2][2][4][2];
#pragma unroll
    for (int a = 0; a < 2; ++a)
#pragma unroll
        for (int b = 0; b < 2; ++b)
#pragma unroll
            for (int m = 0; m < 4; ++m)
#pragma unroll
                for (int n = 0; n < 2; ++n) acc[a][b][m][n] = (f32x4){0.f, 0.f, 0.f, 0.f};
    bf16x8 At[4][2], B0[2][2], B1[2][2];
    const char* cA = cur.A; const char* cB = cur.B;
    PG8_STAGE(PG8_SB(0, 0), cB, voffB); PG8_STAGE(PG8_SB(0, 1), cB + hstep, voffB); PG8_STAGE(PG8_SA(0, 0), cA, voffA); PG8_STAGE(PG8_SA(0, 1), cA + hstep, voffA);
    if (wr == 1) PG8_BAR;
    PG8_WAIT_V(2); PG8_BAR;
    PG8_STAGE(PG8_SB(1, 0), cB + kstep, voffB); PG8_STAGE(PG8_SA(1, 0), cA + kstep, voffA); PG8_STAGE(PG8_SB(1, 1), cB + hstep + kstep, voffB);
    PG8_WAIT_V(6); PG8_BAR;
    for (;;) {
        const bool has_next = S.next(ui + 1, nxt);
        const char* nA = has_next ? nxt.A : cA; const char* nB = has_next ? nxt.B : cB;
        const int nt = cur.nt;
        for (int t = 0; t < nt; t += 2) {
            const bool last = (t == nt - 2);
            const char* a1 = cA + (size_t)(t + 1) * kstep;
            const char* a2 = last ? nA : cA + (size_t)(t + 2) * kstep; const char* b2 = last ? nB : cB + (size_t)(t + 2) * kstep;
            const char* a3 = a2 + kstep; const char* b3 = b2 + kstep;
            PG8_LDB(B0, 0, 0); PG8_LDB(B1, 0, 1); PG8_SCHED; PG8_LDA(At, 0, 0); PG8_STAGE(PG8_SA(1, 1), a1 + hstep, voffA);
            PG8_WAIT_V(8); PG8_WAIT_L(0); PG8_BAR; PG8_MMA(0, 0, At, B0); PG8_MMA(0, 1, At, B1); PG8_BAR; PG8_SCHED;
            PG8_LDA(At, 0, 1); PG8_STAGE(PG8_SB(0, 0), b2, voffB); PG8_STAGE(PG8_SB(0, 1), b2 + hstep, voffB); PG8_STAGE(PG8_SA(0, 0), a2, voffA);
            PG8_WAIT_V(8); PG8_WAIT_L(0); PG8_BAR; PG8_MMA(1, 0, At, B0); PG8_MMA(1, 1, At, B1); PG8_BAR; PG8_SCHED;
            PG8_LDB(B0, 1, 0); PG8_LDB(B1, 1, 1); PG8_SCHED; PG8_LDA(At, 1, 0); PG8_STAGE(PG8_SA(0, 1), a2 + hstep, voffA);
            PG8_WAIT_V(8); PG8_WAIT_L(0); PG8_BAR; PG8_MMA(0, 0, At, B0); PG8_MMA(0, 1, At, B1); PG8_BAR; PG8_SCHED;
            PG8_LDA(At, 1, 1); PG8_STAGE(PG8_SB(1, 0), b3, voffB); PG8_STAGE(PG8_SB(1, 1), b3 + hstep, voffB); PG8_STAGE(PG8_SA(1, 0), a3, voffA);
            PG8_WAIT_V(8); PG8_WAIT_L(0); PG8_BAR; PG8_MMA(1, 0, At, B0); PG8_MMA(1, 1, At, B1); PG8_BAR; PG8_SCHED;
        }
        if (wr == 0) PG8_BAR;
        E(acc, cur, wr, wc, fr, fq);
        if (!has_next) break;
#pragma unroll
        for (int a = 0; a < 2; ++a)
#pragma unroll
            for (int b = 0; b < 2; ++b)
#pragma unroll
                for (int m = 0; m < 4; ++m)
#pragma unroll
                    for (int n = 0; n < 2; ++n) acc[a][b][m][n] = (f32x4){0.f, 0.f, 0.f, 0.f};
        cur = nxt; cA = nA; cB = nB; ++ui;
        if (wr == 1) PG8_BAR;
    }
    PG8_WAIT_V(0);
    PG8_BAR;
#undef PG8_SA
#undef PG8_SB
#undef PG8_STAGE
#undef PG8_LDA
#undef PG8_LDB
#undef PG8_MMA
#undef PG8_WAIT_V
#undef PG8_WAIT_L
#undef PG8_BAR
#undef PG8_SCHED
}

struct EpiG1 {
    bf16_t *B0, *B1, *B2, *B3, *B4; float* vss; const float *gq, *gk;
    __device__ __forceinline__ void operator()(const f32x4 (&acc)[2][2][4][2], const Unit& u, int wr, int wc, int fr, int fq) const {
        const int j = u.pn; const size_t rowb = (size_t)u.pm * BM + wr * 64 + fr; const int cl = 32 * wc + 8 * fq;
        if (j < 4) {
#pragma unroll
            for (int ai = 0; ai < 2; ++ai)
#pragma unroll
                for (int m = 0; m < 4; ++m) { f32x4 o0, o1;
#pragma unroll
                    for (int e = 0; e < 4; ++e) { o0[e] = acc[ai][0][m][0][e] * fsigm(acc[ai][1][m][0][e]); o1[e] = acc[ai][0][m][1][e] * fsigm(acc[ai][1][m][1][e]); }
                    *(u32x4*)(B3 + (rowb + ai * HALF + m * 16) * 1024 + 128 * j + cl) = pack8(o0, o1); }
        } else if (j < 12 || j >= 16) {
            bf16_t* dst; int pitch, coff; bool act;
            if (j < 6) { dst = B0; pitch = 1024; coff = 256 * (j - 4); act = true; }
            else if (j < 8) { dst = B0; pitch = 1024; coff = 512 + 256 * (j - 6); act = false; }
            else if (j < 10) { dst = B3; pitch = 1024; coff = 512 + 256 * (j - 8); act = false; }
            else if (j < 12) { dst = B4; pitch = 512; coff = 256 * (j - 10); act = true; }
            else if (j < 18) { dst = B2; pitch = 1024; coff = 256 * (j - 16); act = false; }
            else { dst = B2; pitch = 1024; coff = 512 + 256 * (j - 18); act = true; }
            const bool stat = (j == 8 || j == 9);
#pragma unroll
            for (int ai = 0; ai < 2; ++ai)
#pragma unroll
                for (int m = 0; m < 4; ++m) { const size_t row = rowb + ai * HALF + m * 16; float s = 0.f;
#pragma unroll
                    for (int bj = 0; bj < 2; ++bj) { f32x4 v0 = acc[ai][bj][m][0], v1 = acc[ai][bj][m][1];
                        if (act) {
#pragma unroll
                            for (int e = 0; e < 4; ++e) { v0[e] = v0[e] * fsigm(v0[e]); v1[e] = v1[e] * fsigm(v1[e]); } }
                        s += (v0[0] * v0[0] + v0[1] * v0[1]) + (v0[2] * v0[2] + v0[3] * v0[3]) + (v1[0] * v1[0] + v1[1] * v1[1]) + (v1[2] * v1[2] + v1[3] * v1[3]);
                        *(u32x4*)(dst + row * pitch + coff + 128 * bj + cl) = pack8(v0, v1); }
                    if (stat) { s += __shfl_xor(s, 16); s += __shfl_xor(s, 32); if (fq == 0) vss[row * 8 + (j - 8) * 4 + wc] = s; } }
        } else {
            const bool isk = j >= 14; const int jj = (j - 12) & 1; const float* g = isk ? gk : gq; const float sc = isk ? 1.f : C2;
            f32x4 gv[2][2];
#pragma unroll
            for (int bj = 0; bj < 2; ++bj) { gv[bj][0] = *(const f32x4*)(g + 32 * bj + 8 * fq) * sc; gv[bj][1] = *(const f32x4*)(g + 32 * bj + 8 * fq + 4) * sc; }
            bf16_t* dst = B1 + (isk ? 512 : 0) + 64 * (4 * jj + wc) + 8 * fq;
#pragma unroll
            for (int ai = 0; ai < 2; ++ai)
#pragma unroll
                for (int m = 0; m < 4; ++m) { const size_t row = rowb + ai * HALF + m * 16; float s = 0.f;
#pragma unroll
                    for (int bj = 0; bj < 2; ++bj) { const f32x4 v0 = acc[ai][bj][m][0], v1 = acc[ai][bj][m][1];
                        s += (v0[0] * v0[0] + v0[1] * v0[1]) + (v0[2] * v0[2] + v0[3] * v0[3]) + (v1[0] * v1[0] + v1[1] * v1[1]) + (v1[2] * v1[2] + v1[3] * v1[3]); }
                    s += __shfl_xor(s, 16); s += __shfl_xor(s, 32);
                    const float r = __builtin_amdgcn_rsqf(s * (1.f / 64.f) + EPS);
#pragma unroll
                    for (int bj = 0; bj < 2; ++bj) *(u32x4*)(dst + row * 1024 + 32 * bj) = pack8(acc[ai][bj][m][0] * r * gv[bj][0], acc[ai][bj][m][1] * r * gv[bj][1]); }
        }
    }
};
struct EpiMerge {
    unsigned char* gt; bf16_t* MG; const float* bgate;
    __device__ __forceinline__ void operator()(const f32x4 (&acc)[2][2][4][2], const Unit& u, int wr, int wc, int fr, int fq) const {
        const int tag = u.tag, br = tag >> 1; const size_t rowb = (size_t)u.pm * BM + wr * 64 + fr; const int col0 = u.pn * BM + 32 * wc + 8 * fq;
        u32x4* slots_ = (u32x4*)gt + ((wr * 4 + wc) * 64 + fq * 16 + fr); asm volatile("" : "+v"(slots_)); __attribute__((address_space(1))) u32x4* slots = (__attribute__((address_space(1))) u32x4*)slots_;
        if ((tag & 1) == 0) {
            f32x4 bv[2][2];
#pragma unroll
            for (int bj = 0; bj < 2; ++bj) { bv[bj][0] = *(const f32x4*)(bgate + br * 1024 + col0 + 128 * bj); bv[bj][1] = *(const f32x4*)(bgate + br * 1024 + col0 + 128 * bj + 4); }
#pragma unroll
            for (int ai = 0; ai < 2; ++ai)
#pragma unroll
                for (int m = 0; m < 4; ++m)
#pragma unroll
                    for (int bj = 0; bj < 2; ++bj) { f32x4 v0 = acc[ai][bj][m][0] + bv[bj][0], v1 = acc[ai][bj][m][1] + bv[bj][1];
#pragma unroll
                        for (int e = 0; e < 4; ++e) { v0[e] = fsigm(v0[e]); v1[e] = fsigm(v1[e]); }
                        slots[(size_t)(((ai * 4 + m) * 2 + bj) * 512)] = pack8(v0, v1); }
        } else {
#pragma unroll
            for (int ai = 0; ai < 2; ++ai)
#pragma unroll
                for (int m = 0; m < 4; ++m) {
#pragma unroll
                    for (int bj = 0; bj < 2; ++bj) { const u32x4 gw = slots[(size_t)(((ai * 4 + m) * 2 + bj) * 512)]; f32x4 g0, g1; unpack8(gw, g0, g1);
                        f32x4 v0 = g0 * acc[ai][bj][m][0], v1 = g1 * acc[ai][bj][m][1];
                        u32x4* p = (u32x4*)(MG + (rowb + ai * HALF + m * 16) * 1024 + col0 + 128 * bj);
                        if (br > 0) { const u32x4 ow = *p; f32x4 p0, p1; unpack8(ow, p0, p1); v0 += p0; v1 += p1; }
                        *p = pack8(v0, v1); }
                    if (m & 1) asm volatile("" ::: "memory"); }
        }
    }
};
struct EpiOut {
    const float* base; float* out;
    __device__ __forceinline__ void operator()(const f32x4 (&acc)[2][2][4][2], const Unit& u, int wr, int wc, int fr, int fq) const {
        const size_t rowb = (size_t)u.pm * BM + wr * 64 + fr; const int col0 = u.pn * BM + 32 * wc + 8 * fq;
#pragma unroll
        for (int ai = 0; ai < 2; ++ai)
#pragma unroll
            for (int m = 0; m < 4; ++m) {
#pragma unroll
                for (int bj = 0; bj < 2; ++bj) { const size_t o = (rowb + ai * HALF + m * 16) * D + col0 + 128 * bj;
                    const f32x4 b0 = *(const f32x4*)(base + o), b1 = *(const f32x4*)(base + o + 4);
                    *(f32x4*)(out + o) = b0 + acc[ai][bj][m][0]; *(f32x4*)(out + o + 4) = b1 + acc[ai][bj][m][1]; }
                if (m & 1) asm volatile("" ::: "memory"); }
    }
};
struct SchedG1 { TileOrder T; const char* A; const char* B;
    __device__ __forceinline__ bool next(int i, Unit& u) const { int pm, pn; if (!T.tile(i, pm, pn)) return false; u.pm = pm; u.pn = pn; u.tag = 0; u.nt = 16; u.A = A + (size_t)pm * (BM * PITCH * 2); u.B = B + (size_t)pn * (BM * PITCH * 2); return true; } };
struct SchedMerge { int pm, pn; bool ok; const char *ws, *wl;
    __device__ __forceinline__ bool next(int i, Unit& u) const { if (!ok || i >= 6) return false; const int br = i >> 1; u.pm = pm; u.pn = pn; u.tag = i;
        const size_t ro = (size_t)pm * (BM * PITCH * 2), co = (size_t)pn * (BM * PITCH * 2);
        if ((i & 1) == 0) { u.nt = 16; u.A = ws + WS_H + ro; u.B = wl + WO_WG + (size_t)br * (1024 * PITCH * 2) + co; }
        else { u.nt = 8; const size_t ao = br == 0 ? WS_B0 : (br == 1 ? WS_B0 + 1024 : WS_B1), bo = br == 0 ? WO_WAB : (br == 1 ? WO_WAB + 1024 : WO_WC); u.A = ws + ao + ro; u.B = wl + bo + co; }
        return true; } };
}

#define XB_TMO      128
#define XB_XCNT(j)  (256  + 64 * (j))
#define XB_XSUB(j)  (1280 + 64 * (j))
#define XB_XGEN(j)  (2304 + 64 * (j))
#define XB_TOP      3328
#define XB_TOPGEN   3392
#define XCD_BAR_WORDS 3456
#define XB_SPIN_CAP (1u << 18)
__device__ __forceinline__ unsigned xb_ld(unsigned* p)              { return __hip_atomic_load(p, __ATOMIC_RELAXED, __HIP_MEMORY_SCOPE_AGENT); }
__device__ __forceinline__ unsigned xb_add(unsigned* p, unsigned v) { return __hip_atomic_fetch_add(p, v, __ATOMIC_RELAXED, __HIP_MEMORY_SCOPE_AGENT); }
__device__ __forceinline__ unsigned xb_xcc_id() { return (unsigned)__builtin_amdgcn_s_getreg((3 << 11) | 20) & 0xFu; }
#define XB_SPIN(cond, bar) do { unsigned _sp = 0; while (cond) { __builtin_amdgcn_s_sleep(1); \
    if ((++_sp & 255u) == 0u) { if (xb_ld(&(bar)[XB_TMO])) break; if (_sp > XB_SPIN_CAP) { atomicAdd(&(bar)[XB_TMO], 1u); break; } } } } while (0)
struct XcdBarrier { unsigned* bar; unsigned x; volatile LAS unsigned* st; };
__device__ __forceinline__ XcdBarrier xcd_barrier_post(unsigned* bar, volatile LAS unsigned* st) {
    XcdBarrier b; b.bar = bar; b.x = xb_xcc_id(); b.st = st;
    if (threadIdx.x == 0) (void)xb_add(&bar[XB_XCNT(b.x)], 1u);
    return b;
}
__device__ __forceinline__ void xcd_barrier_complete(unsigned* bar, unsigned x, unsigned& nloc, unsigned& nx) {
    const unsigned G = gridDim.x * gridDim.y * gridDim.z;
    unsigned sum, cnt, mine, sp = 0u;
    for (;;) {
        sum = 0u; cnt = 0u; mine = 0u;
#pragma unroll
        for (unsigned j = 0; j < 16; ++j) { const unsigned c = xb_ld(&bar[XB_XCNT(j)]); sum += c; cnt += (c > 0u) ? 1u : 0u; mine = (j == x) ? c : mine; }
        if (sum == G) break;
        __builtin_amdgcn_s_sleep(1);
        if ((++sp & 255u) == 0u) { if (xb_ld(&bar[XB_TMO])) break; if (sp > XB_SPIN_CAP) { atomicAdd(&bar[XB_TMO], 1u); break; } }
    }
    nloc = mine > 0u ? mine : 1u; nx = cnt > 0u ? cnt : 1u;
}
__device__ __forceinline__ void xcd_barrier(const XcdBarrier& b) {
    asm volatile("s_waitcnt vmcnt(0)" ::: "memory");
    __syncthreads();
    if (threadIdx.x == 0) {
        unsigned* bar = b.bar;
        __builtin_amdgcn_s_waitcnt(0);
        unsigned nloc = b.st[0], nx = b.st[1];
        if (nloc == 0u) { xcd_barrier_complete(bar, b.x, nloc, nx); b.st[0] = nloc; b.st[1] = nx; }
        const unsigned old = xb_add(&bar[XB_XSUB(b.x)], 1u);
        const unsigned gen = old / nloc;
        if (old + 1u == (gen + 1u) * nloc) {
            __builtin_amdgcn_fence(__ATOMIC_RELEASE, "agent");
            asm volatile("s_waitcnt vmcnt(0)" ::: "memory");
            const unsigned og = xb_add(&bar[XB_TOP], 1u);
            const unsigned tg = og / nx;
            if (og + 1u == (tg + 1u) * nx) xb_add(&bar[XB_TOPGEN], 1u);
            else XB_SPIN(xb_ld(&bar[XB_TOPGEN]) == tg, bar);
            __builtin_amdgcn_fence(__ATOMIC_ACQUIRE, "agent");
            xb_add(&bar[XB_XGEN(b.x)], 1u);
            asm volatile("s_waitcnt vmcnt(0)" ::: "memory");
        } else {
            XB_SPIN(xb_ld(&bar[XB_XGEN(b.x)]) == gen, bar);
            __builtin_amdgcn_fence(__ATOMIC_ACQUIRE, "agent");
            asm volatile("s_waitcnt vmcnt(0)" ::: "memory");
        }
    }
    __syncthreads();
}

struct Args { const float* in[18]; float* out; unsigned char* ws; int ph_lo, ph_hi, li, pad; };
struct Frame { LAS unsigned char* lds; int tid, lane, wave, vcu, G; Ptrs P; };

__device__ __forceinline__ unsigned pk2(float lo, float hi) { return (unsigned)f2bf(lo) | ((unsigned)f2bf(hi) << 16); }
__device__ __forceinline__ void p0_transpose_item(const float* W, int ldw, int src_col, int k0, bf16_t* WT, size_t dst_row, int dst_col, LAS float* scr, int lane) {
#pragma unroll 8
    for (int i = 0; i < 32; ++i) { const int kk = 2 * i + (lane >> 5); scr[kk * 33 + (lane & 31)] = W[(size_t)(k0 + kk) * ldw + src_col + (lane & 31)]; }
    LDS_WAIT(); asm volatile("" ::: "memory");
    const int c = lane & 7;
#pragma unroll
    for (int j = 0; j < 4; ++j) { const int n = (lane >> 3) + 8 * j; const LAS float* s = scr + (8 * c) * 33 + n;
        u32x4 o; o.x = pk2(s[0 * 33], s[1 * 33]); o.y = pk2(s[2 * 33], s[3 * 33]); o.z = pk2(s[4 * 33], s[5 * 33]); o.w = pk2(s[6 * 33], s[7 * 33]);
        *(GAS u32x4*)(WT + (dst_row + n) * 1024 + dst_col + k0 + 8 * c) = o; }
    LDS_WAIT(); asm volatile("" ::: "memory");
}
__device__ __forceinline__ void p0_weights(Frame& F) {
    LAS float* scr = (LAS float*)(F.lds + RING_OFF + F.wave * 16384);
    const int gw = F.vcu * NWAVES + F.wave, NGW = F.G * NWAVES;
    constexpr int I_W1 = 16 * (N1 / 32), I_WG = 16 * 96, I_Y = 8 * 32, I_WO = 16 * 32, I_L = I_W1 + I_WG + 3 * I_Y + I_WO;
    for (int it = gw; it < NL * I_L; it += NGW) {
        const int l = it / I_L; int r = it % I_L;
        unsigned char* wl = F.P.ws + WS_W + (size_t)l * W_LAYER; const float* win = F.P.w_in + (size_t)l * D * NIN;
        if (r < I_W1) { const int kb = r / (N1 / 32), nb = r % (N1 / 32); p0_transpose_item(win, NIN, g1_col(32 * nb), 64 * kb, (bf16_t*)(wl + WO_W1), 32 * nb, 0, scr, F.lane); continue; } r -= I_W1;
        if (r < I_WG) { const int kb = r / 96, nb = r % 96; p0_transpose_item(win, NIN, 32 * nb, 64 * kb, (bf16_t*)(wl + WO_WG), 32 * nb, 0, scr, F.lane); continue; } r -= I_WG;
        if (r < I_Y) { const int kb = r / 32, nb = r % 32; p0_transpose_item(F.P.w_a + (size_t)l * DA * D, D, 32 * nb, 64 * kb, (bf16_t*)(wl + WO_WAB), 32 * nb, 0, scr, F.lane); continue; } r -= I_Y;
        if (r < I_Y) { const int kb = r / 32, nb = r % 32; p0_transpose_item(F.P.w_b + (size_t)l * DB * D, D, 32 * nb, 64 * kb, (bf16_t*)(wl + WO_WAB), 32 * nb, 512, scr, F.lane); continue; } r -= I_Y;
        if (r < I_Y) { const int kb = r / 32, nb = r % 32; p0_transpose_item(F.P.w_c + (size_t)l * DC * D, D, 32 * nb, 64 * kb, (bf16_t*)(wl + WO_WC), 32 * nb, 0, scr, F.lane); continue; } r -= I_Y;
        { const int kb = r / 32, nb = r % 32; p0_transpose_item(F.P.w_out + (size_t)l * D * D, D, 32 * nb, 64 * kb, (bf16_t*)(wl + WO_WO), 32 * nb, 0, scr, F.lane); }
    }
    bf16_t* WSB = (bf16_t*)(F.P.ws + WS_WSB);
    for (int i = (int)blockIdx.x * 512 + F.tid; i < NL * NG * CHK * CHK; i += F.G * 512) { const int s = i & 127, t = (i >> 7) & 127; WSB[i] = s <= t ? f2bf(F.P.w_s[i]) : (bf16_t)0; }
}
__device__ __forceinline__ void p0_ln(Frame& F, int l, const float* xin) {
    LAS float* wf = (LAS float*)(F.lds + RING_OFF);
    const float* g = F.P.norm_g + (size_t)l * D; const float* win = F.P.w_in + (size_t)l * D * NIN;
    __syncthreads();
    for (int i = F.tid; i < D * 8; i += 512) { const int k = i >> 3, e = i & 7; wf[i] = g[k] * win[(size_t)k * NIN + OC_F + e]; }
    __syncthreads();
    const int gw = F.vcu * NWAVES + F.wave, NGW = F.G * NWAVES;
    bf16_t* H = (bf16_t*)(F.P.ws + WS_H); float* LOGF = (float*)(F.P.ws + WS_LOGF);
    f32x4 gv[4];
#pragma unroll
    for (int j = 0; j < 4; ++j) gv[j] = ((const f32x4*)g)[64 * j + F.lane];
    for (int m = gw; m < M; m += NGW) {
        const GAS f32x4* xr = (const GAS f32x4*)(xin + (size_t)m * D) + F.lane;
        f32x4 v[4]; float ss = 0.f;
#pragma unroll
        for (int j = 0; j < 4; ++j) { v[j] = xr[64 * j]; ss += (v[j].x * v[j].x + v[j].y * v[j].y) + (v[j].z * v[j].z + v[j].w * v[j].w); }
        ss = wave_sum(ss);
        const float r = rsqrtf(ss * (1.f / D) + EPS);
        float f[8] = {0.f, 0.f, 0.f, 0.f, 0.f, 0.f, 0.f, 0.f};
        GAS unsigned long long* o8 = (GAS unsigned long long*)(H + (size_t)m * D) + F.lane;
#pragma unroll
        for (int j = 0; j < 4; ++j) {
            const f32x4 hv = v[j] * r * gv[j];
            o8[64 * j] = (unsigned long long)pk2(hv.x, hv.y) | ((unsigned long long)pk2(hv.z, hv.w) << 32);
#pragma unroll
            for (int i = 0; i < 4; ++i) { const LAS f32x4* w4 = (const LAS f32x4*)(wf + (256 * j + 4 * F.lane + i) * 8); const f32x4 wa = w4[0], wb = w4[1]; const float xv = v[j][i];
                f[0] += xv * wa.x; f[1] += xv * wa.y; f[2] += xv * wa.z; f[3] += xv * wa.w; f[4] += xv * wb.x; f[5] += xv * wb.y; f[6] += xv * wb.z; f[7] += xv * wb.w; }
        }
#pragma unroll
        for (int e = 0; e < 8; ++e) f[e] = wave_sum(f[e]);
        if (F.lane < 8) { float z = 0.f;
#pragma unroll
            for (int e = 0; e < 8; ++e) if (F.lane == e) z = f[e];
            z = z * r + F.P.b_f[l * NH + F.lane];
            LOGF[(size_t)m * 8 + F.lane] = fminf(z, 0.f) - log1pf(expf(-fabsf(z))); }
    }
    __syncthreads();
}
__device__ __forceinline__ void p1_scan(Frame& F, int bh) {
    LAS float* sh = (LAS float*)(F.lds + RING_OFF);
    const int b = bh / NH, h = bh % NH, t0 = F.tid * 8;
    const float* lf = (const float*)(F.P.ws + WS_LOGF) + ((size_t)b * SEQ + t0) * 8 + h;
    float c[8]; float run = 0.f;
#pragma unroll
    for (int i = 0; i < 8; ++i) { run += lf[i * 8]; c[i] = run; }
    float inc = run;
#pragma unroll
    for (int o = 1; o < 64; o <<= 1) { const float n = __shfl_up(inc, o); if (F.lane >= o) inc += n; }
    if (F.lane == 63) sh[F.wave] = inc;
    __syncthreads();
    float base = inc - run;
    for (int w = 0; w < F.wave; ++w) base += sh[w];
    float* cs = (float*)(F.P.ws + WS_CS) + (size_t)bh * SEQ + t0;
    *(f32x4*)cs = (f32x4){(base + c[0]) * LOG2E, (base + c[1]) * LOG2E, (base + c[2]) * LOG2E, (base + c[3]) * LOG2E};
    *(f32x4*)(cs + 4) = (f32x4){(base + c[4]) * LOG2E, (base + c[5]) * LOG2E, (base + c[6]) * LOG2E, (base + c[7]) * LOG2E};
    __syncthreads();
}


#include <hip/hip_bf16.h>
namespace attn_body {
using bf16=__hip_bfloat16;
using s16x4=__attribute__((ext_vector_type(4)))short;
using f32x16=__attribute__((ext_vector_type(16)))float;
constexpr int NHEAD=NH,D=64,DM=1024;
constexpr int NW=8,QBLK=32,QB=QBLK*NW,KVBLK=64,NQB=SEQ/QB;
__device__ __forceinline__ int crow(int r,int hi){return (r&3)+8*(r>>2)+4*hi;}
#define SBAR() __builtin_amdgcn_sched_barrier(0)
__device__ __forceinline__ void cmask(f32x16&p0,f32x16&p1,int jb,int qrel,int hi){
  const float NEG=-INFINITY; int kb=64*jb+4*hi;
  #pragma unroll
  for(int r=0;r<16;++r){int kv=kb+(r&3)+8*(r>>2); if(kv>qrel)p0[r]=NEG; if(kv+32>qrel)p1[r]=NEG;}
}
constexpr int NSLOT=3, SLOTB=8192;
constexpr int LDS_K=0, LDS_V=NSLOT*SLOTB, LDS_WS=2*NSLOT*SLOTB, LDS_OST=LDS_WS+NW*64*4, LDS_C2=LDS_OST+NW*4096, LDS_BYTES=LDS_C2+SEQ*4+512;
__device__ __forceinline__ void glds16(const void*gsrc,unsigned lds_dst){unsigned keep;
  asm volatile("s_mov_b32 %0, m0\n\ts_mov_b32 m0, %2\n\ts_nop 0\n\tglobal_load_lds_dwordx4 %1, off\n\ts_mov_b32 m0, %0":"=&s"(keep):"v"(gsrc),"s"(lds_dst):"memory");}
__device__ __forceinline__ float max3f(float a,float b,float c){float r;asm("v_max3_f32 %0, %1, %2, %3":"=v"(r):"v"(a),"v"(b),"v"(c));return r;}
__device__ __forceinline__ float max2f(float a,float b){float r;asm("v_max_f32_e32 %0, %1, %2":"=v"(r):"v"(a),"v"(b));return r;}
__device__ __forceinline__ float fadd_s(float a,float b){float r;asm("v_add_f32_e32 %0, %1, %2":"=v"(r):"v"(a),"v"(b));return r;}
__device__ __forceinline__ float fsub_s(float a,float b){float r;asm("v_sub_f32_e32 %0, %1, %2":"=v"(r):"v"(a),"v"(b));return r;}
typedef float f32x2_t __attribute__((ext_vector_type(2))); typedef __bf16 bf16x2_t __attribute__((ext_vector_type(2)));
__device__ __forceinline__ unsigned cvtpk_s(float lo,float hi){f32x2_t v={lo,hi};bf16x2_t b=__builtin_convertvector(v,bf16x2_t);return __builtin_bit_cast(unsigned,b);}
#define WAIT_BAR(N) asm volatile("s_waitcnt vmcnt(" #N ") lgkmcnt(0)\n\ts_barrier":::"memory")
__device__ __forceinline__ void split3(float x,unsigned&h,unsigned&m,unsigned&l){
  const unsigned u=__float_as_uint(x)&0xffff0000u; const float r1=x-__uint_as_float(u);
  const unsigned u1=__float_as_uint(r1)&0xffff0000u; const float r2=r1-__uint_as_float(u1);
  h=u>>16; m=u1>>16; l=__float_as_uint(r2)>>16; }
__device__ __forceinline__ bf16x8 make_qx(float base,int hi){ unsigned h,m,l; split3(base,h,m,l); u32x4 w; w.x=h|(m<<16); w.y=l|0x3f800000u; w.z=0x3f803f80u; w.w=0u; if(hi){w.x=0u;w.y=0u;w.z=0u;} return __builtin_bit_cast(bf16x8,w); }
__device__ __forceinline__ bf16x8 make_kx(float ck,int hi){ unsigned h,m,l; split3(-ck,h,m,l); u32x4 w; w.x=0x3f803f80u; w.y=0x3f80u|(h<<16); w.z=m|(l<<16); w.w=0u; if(hi){w.x=0u;w.y=0u;w.z=0u;} return __builtin_bit_cast(bf16x8,w); }

__device__ __forceinline__ void qkt(f32x16&p0,f32x16&p1,const char*Kslot,const bf16x8*qr,bf16x8 qx,bf16x8 kx0,bf16x8 kx1,int r32,int hi){
  const char*kb=Kslot+hi*1024+r32*16; const f32x16 z=f32x16{};
  p0=__builtin_amdgcn_mfma_f32_32x32x16_bf16(kx0,qx,z,0,0,0);p1=__builtin_amdgcn_mfma_f32_32x32x16_bf16(kx1,qx,z,0,0,0);
  #pragma unroll
  for(int d0=0;d0<4;++d0){
    const bf16x8 b0=*reinterpret_cast<const bf16x8*>(kb+d0*2048);
    const bf16x8 b1=*reinterpret_cast<const bf16x8*>(kb+d0*2048+512);
    p0=__builtin_amdgcn_mfma_f32_32x32x16_bf16(b0,qr[d0],p0,0,0,0);p1=__builtin_amdgcn_mfma_f32_32x32x16_bf16(b1,qr[d0],p1,0,0,0);}
}
typedef __attribute__((address_space(3))) const char* lds_cptr;
typedef short v4i16_t __attribute__((ext_vector_type(4)));
__device__ __forceinline__ void kload8(bf16x8*kf,lds_cptr kp){
  kf[0]=*(const __attribute__((address_space(3))) bf16x8*)(kp);      kf[1]=*(const __attribute__((address_space(3))) bf16x8*)(kp+512);
  kf[2]=*(const __attribute__((address_space(3))) bf16x8*)(kp+2048); kf[3]=*(const __attribute__((address_space(3))) bf16x8*)(kp+2560);
  kf[4]=*(const __attribute__((address_space(3))) bf16x8*)(kp+4096); kf[5]=*(const __attribute__((address_space(3))) bf16x8*)(kp+4608);
  kf[6]=*(const __attribute__((address_space(3))) bf16x8*)(kp+6144); kf[7]=*(const __attribute__((address_space(3))) bf16x8*)(kp+6656);
}
__device__ __forceinline__ void kload2(bf16x8*kf,lds_cptr kp,int j){ kf[2*j]=*(const __attribute__((address_space(3))) bf16x8*)(kp+j*2048); kf[2*j+1]=*(const __attribute__((address_space(3))) bf16x8*)(kp+j*2048+512); }
__device__ __forceinline__ s16x4 vtr(lds_cptr p){ return __builtin_bit_cast(s16x4,__builtin_amdgcn_ds_read_tr16_b64_v4i16((__attribute__((address_space(3))) v4i16_t*)p)); }
__device__ __forceinline__ float rowmax(const f32x16&p0,const f32x16&p1){
  float a=max3f(p0[0],p0[1],p1[0]),b=max3f(p0[2],p0[3],p1[1]);a=max3f(a,p1[2],p1[3]);
  #pragma unroll
  for(int r=4;r<16;r+=4){a=max3f(a,p0[r],p0[r+1]);b=max3f(b,p0[r+2],p0[r+3]);a=max3f(a,p1[r],p1[r+1]);b=max3f(b,p1[r+2],p1[r+3]);}
  const float m=max2f(a,b);
  auto rr=__builtin_amdgcn_permlane32_swap(__float_as_uint(m),__float_as_uint(m),false,false);
  return max2f(__uint_as_float(rr[0]),__uint_as_float(rr[1]));
}
__device__ __forceinline__ void pv(f32x16*o,int vb,bf16x8 pa0,bf16x8 pa1,bf16x8 pa2,bf16x8 pa3){
  #pragma unroll
  for(int d0=0;d0<2;++d0){s16x4 lo[4],hi[4];
    #pragma unroll
    for(int ks=0;ks<4;++ks){
      asm volatile("ds_read_b64_tr_b16 %0,%1 offset:%c2":"=&v"(lo[ks]):"v"(vb),"i"(d0*4096+ks*1024):"memory");
      asm volatile("ds_read_b64_tr_b16 %0,%1 offset:%c2":"=&v"(hi[ks]):"v"(vb),"i"(d0*4096+ks*1024+512):"memory");}
    asm volatile("s_waitcnt lgkmcnt(0)":::"memory");SBAR();
    #define PK(k) (bf16x8){lo[k][0],lo[k][1],lo[k][2],lo[k][3],hi[k][0],hi[k][1],hi[k][2],hi[k][3]}
    o[d0]=__builtin_amdgcn_mfma_f32_32x32x16_bf16(pa0,PK(0),o[d0],0,0,0);
    o[d0]=__builtin_amdgcn_mfma_f32_32x32x16_bf16(pa1,PK(1),o[d0],0,0,0);
    o[d0]=__builtin_amdgcn_mfma_f32_32x32x16_bf16(pa2,PK(2),o[d0],0,0,0);
    o[d0]=__builtin_amdgcn_mfma_f32_32x32x16_bf16(pa3,PK(3),o[d0],0,0,0);
    #undef PK
  }
}
#define ATTN_STORE16(p,v) (*(u32x4*)(p)=(v))
template<int THRL> __device__ __forceinline__ void attn_unit(int b,int h,int qb,const bf16*Q,const bf16*__restrict__ K,const bf16*__restrict__ V,const bf16*__restrict__ CZ,bf16*O,const float*__restrict__ c2g,char*shm){
  int tid=threadIdx.x; asm volatile("":"+v"(tid));
  const int lane=tid&63,r32=lane&31,hi=lane>>5; const int wid=__builtin_amdgcn_readfirstlane(tid>>6);
  const long rowbase=(long)b*SEQ; const int q0=qb*QB;
  const bf16*Qw=Q+(rowbase+q0+wid*QBLK)*DM+h*D;
  const bf16*Kh=K+rowbase*DM+h*D,*Vh=V+rowbase*DM+h*D;
  const unsigned lds0=(unsigned)(uintptr_t)shm;
  float*wsf=(float*)(shm+LDS_WS)+wid*64;
  float*c2l=(float*)(shm+LDS_C2);
  for(int i=tid*4;i<q0+QB;i+=NW*64*4)*(f32x4*)(c2l+i)=*(const f32x4*)(c2g+i);
  const bf16*ksrc=Kh+(long)lane*DM+wid*8;
  const bf16*vsrc=Vh+(long)(16*(wid&3)+(lane>>2))*DM+(wid>>2)*32+(lane&3)*8;
  const unsigned kdst=lds0+LDS_K+wid*1024, vdst=lds0+LDS_V+wid*1024;
  #define DMA_K(t,slot) glds16(ksrc+(long)(t)*KVBLK*DM,(unsigned)__builtin_amdgcn_readfirstlane(kdst+(slot)))
  #define DMA_V(t,slot) glds16(vsrc+(long)(t)*KVBLK*DM,(unsigned)__builtin_amdgcn_readfirstlane(vdst+(slot)))
  const int vb0=(int)(lds0+LDS_V)+((lane>>4)&1)*32+(lane&3)*8+(4*hi+((lane&15)>>2))*64;
  const char*Kbase=shm+LDS_K; bf16x8 kf[8];
  const lds_cptr shm3=(lds_cptr)shm; const lds_cptr kp0=shm3+LDS_K+hi*1024+r32*16; const lds_cptr vp0=shm3+LDS_V+((lane>>4)&1)*32+(lane&3)*8+(4*hi+((lane&15)>>2))*64;
  const int NT=(q0+QB)/KVBLK;
  DMA_K(0,0);DMA_V(0,0);DMA_K(1,SLOTB);
  bf16x8 qr[4];
  #pragma unroll
  for(int d0=0;d0<4;++d0)qr[d0]=*reinterpret_cast<const bf16x8*>(&Qw[(long)r32*DM+d0*16+hi*8]);
  float mhat=0.f,l_reg=0.f;f32x16 o[2];o[0]=f32x16{};o[1]=f32x16{};
  const int qrel=wid*QBLK+r32;
  #define CMASK(P0,P1,t) do{int jb_=(t)-(NT-4); if(jb_>=0)cmask(P0,P1,jb_,qrel,hi);}while(0)
  bool resc=false;
  bf16x8 qx; float cq2;
  #define START(P0,P1) do{ const float rm=rowmax(P0,P1); resc=false; \
    { const float dl=rm; mhat=fadd_s(mhat,dl); \
      _Pragma("unroll") for(int r=0;r<16;++r){P0[r]=fsub_s(P0[r],dl);P1[r]=fsub_s(P1[r],dl);} \
      qx=make_qx(cq2-mhat,hi); asm volatile("":"+v"(qx)); } \
    _Pragma("unroll") for(int r=0;r<16;++r)P0[r]=__builtin_amdgcn_exp2f(P0[r]); }while(0)
  #define RESC() do{ if(resc){ asm volatile("s_waitcnt lgkmcnt(0)":::"memory"); \
      _Pragma("unroll") for(int d_=0;d_<2;++d_) _Pragma("unroll") for(int r=0;r<16;++r)o[d_][r]*=wsf[crow(r,hi)]; } }while(0)
  f32x16 pA0,pA1,pB0,pB1;
  int sl_prev=0,sl_cur=0,sl_next=SLOTB;
  #define ROT() do{sl_prev=sl_cur;sl_cur=sl_next;sl_next=(sl_next==(NSLOT-1)*SLOTB)?0:sl_next+SLOTB;}while(0)
  DMA_K(2,2*SLOTB);
  WAIT_BAR(3);
  cq2=c2l[q0+qrel]; qx=make_qx(cq2,hi);
  float ck0=c2l[r32],ck1=c2l[32+r32];
  { const bf16x8 kx0=make_kx(ck0,hi),kx1=make_kx(ck1,hi);
    qkt(pA0,pA1,Kbase,qr,qx,kx0,kx1,r32,hi); }
  asm volatile("s_nop 15\n\ts_nop 7":"+v"(pA0),"+v"(pA1));CMASK(pA0,pA1,0);
  ck0=c2l[64+r32];ck1=c2l[96+r32];
  START(pA0,pA1);
  _Pragma("unroll") for(int r=0;r<16;++r)pA1[r]=__builtin_amdgcn_exp2f(pA1[r]);
  WAIT_BAR(0);
  DMA_K(3,0);DMA_V(1,SLOTB);
  ROT();
  kload8(kf,kp0+sl_cur);
  WAIT_BAR(2);
  s16x4 vlo[8],vhi[8]; u32x4 pw0,pw1,pw2,pw3;
  #define PKW(P,B) cvtpk_s(P[B],P[B+1])
  #define PAF(k) __builtin_bit_cast(bf16x8,pw##k)
  #define VFR(i) (bf16x8){vlo[i][0],vlo[i][1],vlo[i][2],vlo[i][3],vhi[i][0],vhi[i][1],vhi[i][2],vhi[i][3]}
  #define PIN(x) asm volatile("":"+v"(x))
  #define MX3(a,b,c) __builtin_fmaxf(__builtin_fmaxf((a),(b)),(c))
  #define GAPA(MF,A0,A1,A2,A3,W0,W1,PW) do{ MF; sacc+=A0; sacc+=A1; sacc+=A2; sacc+=A3; PIN(sacc); W0; W1; PIN(PW); SBAR(); }while(0)
  #define EX(v) __builtin_amdgcn_exp2f(v)
  #define GAPB(MF,X,B) do{ MF; X[B]=EX(X[B]); X[B+1]=EX(X[B+1]); X[B+2]=EX(X[B+2]); X[B+3]=EX(X[B+3]); PIN(X); SBAR(); }while(0)
  #define VRD(i) do{ vlo[i]=vtr(vp_+(((i)>>2)*4096+((i)&3)*1024)); vhi[i]=vtr(vp_+(((i)>>2)*4096+((i)&3)*1024+512)); }while(0)
  #define KRD(G,j) do{ if(G){ kload2(kf,kp0+sl_next,j); SBAR(); } }while(0)
  #define STEP(C0,C1,P0,P1,t,GK,GV,GL) do{ SBAR(); \
    const lds_cptr vp_=vp0+sl_prev; \
    { const bf16x8 kx0_=make_kx(ck0,hi),kx1_=make_kx(ck1,hi); const f32x16 z_=f32x16{}; \
      C0=__builtin_amdgcn_mfma_f32_32x32x16_bf16(kx0_,qx,z_,0,0,0); C1=__builtin_amdgcn_mfma_f32_32x32x16_bf16(kx1_,qx,z_,0,0,0); } SBAR(); \
    VRD(0); SBAR(); float sacc=(P0[0]+P0[1]); \
    GAPA(C0=__builtin_amdgcn_mfma_f32_32x32x16_bf16(kf[0],qr[0],C0,0,0,0), P0[2],P0[3],P0[4],P0[5],     pw0[0]=PKW(P0,0), pw0[1]=PKW(P0,2), pw0); \
    VRD(4); SBAR(); GAPA(C1=__builtin_amdgcn_mfma_f32_32x32x16_bf16(kf[1],qr[0],C1,0,0,0), P0[6],P0[7],P0[8],P0[9],     pw0[2]=PKW(P0,4), pw0[3]=PKW(P0,6), pw0); \
    VRD(1); SBAR(); GAPA(C0=__builtin_amdgcn_mfma_f32_32x32x16_bf16(kf[2],qr[1],C0,0,0,0),   P0[10],P0[11],P0[12],P0[13], pw1[0]=PKW(P0,8), pw1[1]=PKW(P0,10), pw1); \
    VRD(5); SBAR(); GAPA(C1=__builtin_amdgcn_mfma_f32_32x32x16_bf16(kf[3],qr[1],C1,0,0,0),   P0[14],P0[15],P1[0],P1[1],   pw1[2]=PKW(P0,12),pw1[3]=PKW(P0,14), pw1); \
    VRD(2); SBAR(); GAPA(C0=__builtin_amdgcn_mfma_f32_32x32x16_bf16(kf[4],qr[2],C0,0,0,0),   P1[2],P1[3],P1[4],P1[5],     pw2[0]=PKW(P1,0), pw2[1]=PKW(P1,2), pw2); \
    VRD(6); SBAR(); GAPA(C1=__builtin_amdgcn_mfma_f32_32x32x16_bf16(kf[5],qr[2],C1,0,0,0),   P1[6],P1[7],P1[8],P1[9],     pw2[2]=PKW(P1,4), pw2[3]=PKW(P1,6), pw2); \
    VRD(3); SBAR(); GAPA(C0=__builtin_amdgcn_mfma_f32_32x32x16_bf16(kf[6],qr[3],C0,0,0,0),   P1[10],P1[11],P1[12],P1[13], pw3[0]=PKW(P1,8), pw3[1]=PKW(P1,10), pw3); \
    VRD(7); SBAR(); GAPA(C1=__builtin_amdgcn_mfma_f32_32x32x16_bf16(kf[7],qr[3],C1,0,0,0),   P1[14],P1[15],0.f,0.f,       pw3[2]=PKW(P1,12),pw3[3]=PKW(P1,14), pw3); \
    l_reg+=sacc; \
    if(GK){DMA_K((t)+3,sl_cur);} if(GV){DMA_V((t)+1,sl_next);} \
    if(GL){ ck0=c2l[64*((t)+1)+r32]; ck1=c2l[64*((t)+1)+32+r32]; } \
    CMASK(C0,C1,t); \
    { float a=MX3(C0[0],C0[1],C1[0]),b=MX3(C0[2],C0[3],C1[1]); a=MX3(a,C1[2],C1[3]); \
      _Pragma("unroll") for(int r=4;r<16;r+=4){a=MX3(a,C0[r],C0[r+1]);b=MX3(b,C0[r+2],C0[r+3]);a=MX3(a,C1[r],C1[r+1]);b=MX3(b,C1[r+2],C1[r+3]);} \
      float rm=__builtin_fmaxf(a,b); { auto rr=__builtin_amdgcn_permlane32_swap(__float_as_uint(rm),__float_as_uint(rm),false,false); rm=__builtin_fmaxf(__uint_as_float(rr[0]),__uint_as_float(rr[1])); } \
      resc=false; \
      if(__builtin_expect(__any(rm>(float)THRL),0)){ const float dl=__builtin_fmaxf(rm,0.f); mhat+=dl; \
        _Pragma("unroll") for(int r=0;r<16;++r){C0[r]-=dl;C1[r]-=dl;} \
        qx=make_qx(cq2-mhat,hi); asm volatile("":"+v"(qx)); \
        const float f=__builtin_amdgcn_exp2f(-dl); l_reg*=f; if(hi==0)wsf[r32]=f; resc=true; } } \
    SBAR(); \
    GAPB(o[0]=__builtin_amdgcn_mfma_f32_32x32x16_bf16(PAF(0),VFR(0),o[0],0,0,0), C0,0); \
    GAPB(o[1]=__builtin_amdgcn_mfma_f32_32x32x16_bf16(PAF(0),VFR(4),o[1],0,0,0), C0,4); \
    KRD(GL,0); GAPB(o[0]=__builtin_amdgcn_mfma_f32_32x32x16_bf16(PAF(1),VFR(1),o[0],0,0,0), C0,8); \
    KRD(GL,1); GAPB(o[1]=__builtin_amdgcn_mfma_f32_32x32x16_bf16(PAF(1),VFR(5),o[1],0,0,0), C0,12); \
    KRD(GL,2); GAPB(o[0]=__builtin_amdgcn_mfma_f32_32x32x16_bf16(PAF(2),VFR(2),o[0],0,0,0), C1,0); \
    KRD(GL,3); GAPB(o[1]=__builtin_amdgcn_mfma_f32_32x32x16_bf16(PAF(2),VFR(6),o[1],0,0,0), C1,4); \
    GAPB(o[0]=__builtin_amdgcn_mfma_f32_32x32x16_bf16(PAF(3),VFR(3),o[0],0,0,0), C1,8); \
    GAPB(o[1]=__builtin_amdgcn_mfma_f32_32x32x16_bf16(PAF(3),VFR(7),o[1],0,0,0), C1,12); \
    }while(0)
  int t=1;
  #undef CMASK
  #define CMASK(P0,P1,t) do{}while(0)
  for(;t+5<NT;t+=2){
    STEP(pB0,pB1,pA0,pA1,t,true,true,true);     WAIT_BAR(2); RESC(); ROT();
    STEP(pA0,pA1,pB0,pB1,t+1,true,true,true);   WAIT_BAR(2); RESC(); ROT();
  }
  #undef CMASK
  #define CMASK(P0,P1,t) do{int jb_=(t)-(NT-4); if(jb_>=0)cmask(P0,P1,jb_,qrel,hi);}while(0)
  #define ENDW(tt) do{ if((tt)+3<NT){WAIT_BAR(2);} else if((tt)+2<NT){WAIT_BAR(1);} else {WAIT_BAR(0);} }while(0)
  for(;t+1<NT;t+=2){
    STEP(pB0,pB1,pA0,pA1,t,(t+3<NT),(t+1<NT),(t+1<NT));       ENDW(t);   RESC(); ROT();
    STEP(pA0,pA1,pB0,pB1,t+1,(t+4<NT),(t+2<NT),(t+2<NT));     ENDW(t+1); RESC(); ROT();
  }
  STEP(pB0,pB1,pA0,pA1,NT-1,false,false,false); RESC();
  { float sacc=pB0[0]+pB0[1]; _Pragma("unroll") for(int r=2;r<16;++r)sacc+=pB0[r]; _Pragma("unroll") for(int r=0;r<16;++r)sacc+=pB1[r]; l_reg+=sacc;
    pw0=(u32x4){PKW(pB0,0),PKW(pB0,2),PKW(pB0,4),PKW(pB0,6)};pw1=(u32x4){PKW(pB0,8),PKW(pB0,10),PKW(pB0,12),PKW(pB0,14)};pw2=(u32x4){PKW(pB1,0),PKW(pB1,2),PKW(pB1,4),PKW(pB1,6)};pw3=(u32x4){PKW(pB1,8),PKW(pB1,10),PKW(pB1,12),PKW(pB1,14)};
    SBAR(); pv(o,vb0+sl_cur,PAF(0),PAF(1),PAF(2),PAF(3)); }
  #undef PKW
  #undef PAF
  #undef VFR
  #undef PIN
  #undef MX3
  #undef GAPA
  #undef GAPB
  #undef EX
  #undef VRD
  #undef KRD
  #undef STEP
  #undef ENDW
  {auto rr=__builtin_amdgcn_permlane32_swap(__float_as_uint(l_reg),__float_as_uint(l_reg),false,false);l_reg=__uint_as_float(rr[0])+__uint_as_float(rr[1]);}
  if(hi==0)wsf[32+r32]=l_reg;asm volatile("s_waitcnt lgkmcnt(0)":::"memory");
  bf16*Ow=O+(rowbase+q0+wid*QBLK)*DM+h*D;
  const unsigned short*Cw=(const unsigned short*)(CZ+(rowbase+q0+wid*QBLK)*DM+h*D);
  { bf16*stg=(bf16*)(shm+LDS_OST)+wid*2048;
    #pragma unroll
    for(int r=0;r<16;++r){const int orow=crow(r,hi); const float rl=__builtin_amdgcn_rcpf(wsf[32+orow]);
      #pragma unroll
      for(int d0=0;d0<2;++d0){ const float cz=__uint_as_float((unsigned)Cw[(long)orow*DM+d0*32+r32]<<16); stg[orow*64+d0*32+r32]=__float2bfloat16(o[d0][r]*rl*cz);} }
    asm volatile("s_waitcnt lgkmcnt(0)":::"memory");
    #pragma unroll
    for(int i=0;i<4;++i){const int row=i*8+(lane>>3),ch=lane&7; const u32x4 v=*(const u32x4*)(stg+row*64+ch*8); ATTN_STORE16(Ow+(long)row*DM+ch*8,v);} }
  asm volatile("s_waitcnt lgkmcnt(0)\n\ts_barrier":::"memory");
  #undef DMA_K
  #undef DMA_V
  #undef CMASK
  #undef START
  #undef RESC
  #undef ROT
}
#undef SBAR
#undef WAIT_BAR
}

typedef float f32x2 __attribute__((ext_vector_type(2)));
__device__ __forceinline__ void p2_conv(Frame& F, int l, int unit) {
    const int tid = F.tid, cp = tid & 255, th = tid >> 8, lane = F.lane, wq = F.wave & 3;
    const size_t row0 = (size_t)unit * 64; const int tseq0 = (int)(row0 % SEQ);
    const bf16_t* AG = (const bf16_t*)(F.P.ws + WS_B3); bf16_t* B0 = (bf16_t*)(F.P.ws + WS_B0);
    const float* cw = F.P.conv_w + (size_t)l * CW * DA + 2 * cp;
    f32x2 w[CW];
#pragma unroll
    for (int j = 0; j < CW; ++j) w[j] = *(const f32x2*)(cw + j * DA);
    const f32x2 cb = *(const f32x2*)(F.P.conv_b + l * DA + 2 * cp), gg = *(const f32x2*)(F.P.cn_g + l * DA + 2 * cp), be = *(const f32x2*)(F.P.cn_b + l * DA + 2 * cp);
    LAS float* red = (LAS float*)(F.lds + RING_OFF);
    for (int sb = 0; sb < 4; ++sb) {
        const int tl0 = th * 32 + sb * 8;
        f32x2 in[38];
#pragma unroll
        for (int i = 0; i < 38; ++i) { const int tr = tl0 - (CW - 1) + i; const bool valid = tseq0 + tr >= 0;
            const unsigned wv = valid ? *(const unsigned*)(AG + (size_t)((long)row0 + (valid ? tr : 0)) * 1024 + 2 * cp) : 0u;
            in[i] = (f32x2){__uint_as_float(wv << 16), __uint_as_float(wv & 0xffff0000u)}; }
        f32x2 out[8];
#pragma unroll
        for (int o = 0; o < 8; ++o) out[o] = cb;
#pragma unroll
        for (int j = 0; j < CW; ++j)
#pragma unroll
            for (int o = 0; o < 8; ++o) out[o] += w[j] * in[o + j];
        LAS float* rp = red + (sb & 1) * 256 + th * 128;
#pragma unroll
        for (int o = 0; o < 8; ++o) { float s1 = out[o].x + out[o].y, s2 = out[o].x * out[o].x + out[o].y * out[o].y; s1 = wave_sum(s1); s2 = wave_sum(s2);
            if (lane == 0) { rp[(o * 4 + wq) * 2] = s1; rp[(o * 4 + wq) * 2 + 1] = s2; } }
        __syncthreads();
#pragma unroll
        for (int o = 0; o < 8; ++o) { const LAS f32x4* q = (const LAS f32x4*)(rp + o * 8); const f32x4 a = q[0], b = q[1];
            const float mu = ((a.x + a.z) + (b.x + b.z)) * (1.f / DA), ex2 = ((a.y + a.w) + (b.y + b.w)) * (1.f / DA); const float rstd = rsqrtf(fmaxf(ex2 - mu * mu, 0.f) + EPS);
            f32x2 y = (out[o] - mu) * rstd * gg + be; y.x = y.x * fsigm(y.x); y.y = y.y * fsigm(y.y);
            unsigned* ap = (unsigned*)(B0 + (row0 + tl0 + o) * 1024 + 2 * cp); const unsigned az = *ap;
            *ap = cvt_pk_bf16(y.x * __uint_as_float(az << 16), y.y * __uint_as_float(az & 0xffff0000u)); }
    }
    __syncthreads();
}
__device__ __forceinline__ void p2_gmlp(Frame& F, int l, int unit) {
    constexpr int VTP = 136;
    const int tid = F.tid, lane = F.lane, w = F.wave, fr = lane & 15, fq = lane >> 4, ch = unit >> 2, g = unit & 3; const size_t row0 = (size_t)ch * CHK;
    LAS bf16_t* vt = (LAS bf16_t*)(F.lds + RING_OFF);
    const bf16_t* V = (const bf16_t*)(F.P.ws + WS_B3) + 512 + 128 * g; bf16_t* U = (bf16_t*)(F.P.ws + WS_B0) + 512 + 128 * g; const bf16_t* BZ = (const bf16_t*)(F.P.ws + WS_B4) + 128 * g;
    const float* vss = (const float*)(F.P.ws + WS_VSS); const float* gn = F.P.gn_g + l * DB + 128 * g;
    for (int it = tid; it < 2048; it += 512) { const int s = it & 127, c8 = (it >> 7) * 8;
        const u32x4 raw = *(const u32x4*)(V + (row0 + s) * 1024 + c8); const f32x4 qa = *(const f32x4*)(vss + (row0 + s) * 8), qb = *(const f32x4*)(vss + (row0 + s) * 8 + 4);
        const float ss = ((qa.x + qa.y) + (qa.z + qa.w)) + ((qb.x + qb.y) + (qb.z + qb.w)); const float rv = rsqrtf(ss * (1.f / DB) + EPS);
        f32x4 v0, v1; unpack8(raw, v0, v1); const f32x4 g0 = *(const f32x4*)(gn + c8), g1 = *(const f32x4*)(gn + c8 + 4);
        v0 = v0 * rv * g0; v1 = v1 * rv * g1;
#pragma unroll
        for (int e = 0; e < 4; ++e) { vt[(c8 + e) * VTP + s] = f2bf(v0[e]); vt[(c8 + 4 + e) * VTP + s] = f2bf(v1[e]); } }
    __syncthreads();
    f32x4 acc[8];
#pragma unroll
    for (int n = 0; n < 8; ++n) acc[n] = (f32x4){0.f, 0.f, 0.f, 0.f};
    const bf16_t* Wg = (const bf16_t*)(F.P.ws + WS_WSB) + ((size_t)(l * NG + g) * CHK + 16 * w + fr) * CHK + 8 * fq;
#pragma unroll
    for (int ks = 0; ks < 4; ++ks) {
        const bf16x8 wf = *(const bf16x8*)(Wg + 32 * ks);
#pragma unroll
        for (int n = 0; n < 8; ++n) { const bf16x8 vf = *(const LAS bf16x8*)(vt + (16 * n + fr) * VTP + 32 * ks + 8 * fq); acc[n] = __builtin_amdgcn_mfma_f32_16x16x32_bf16(vf, wf, acc[n], 0, 0, 0); }
    }
    const size_t t = row0 + 16 * w + fr; const float bs = F.P.b_s[(size_t)(l * NG + g) * CHK + 16 * w + fr];
#pragma unroll
    for (int n = 0; n < 8; ++n) { const int c = 16 * n + 4 * fq;
        unsigned long long* up = (unsigned long long*)(U + t * 1024 + c); const unsigned long long uu = *up, zz = *(const unsigned long long*)(BZ + t * 512 + c);
        const unsigned u0 = (unsigned)uu, u1 = (unsigned)(uu >> 32), z0 = (unsigned)zz, z1 = (unsigned)(zz >> 32);
        const float o0 = __uint_as_float(u0 << 16) * (acc[n][0] + bs) * __uint_as_float(z0 << 16), o1 = __uint_as_float(u0 & 0xffff0000u) * (acc[n][1] + bs) * __uint_as_float(z0 & 0xffff0000u);
        const float o2 = __uint_as_float(u1 << 16) * (acc[n][2] + bs) * __uint_as_float(z1 << 16), o3 = __uint_as_float(u1 & 0xffff0000u) * (acc[n][3] + bs) * __uint_as_float(z1 & 0xffff0000u);
        *up = (unsigned long long)cvt_pk_bf16(o0, o1) | ((unsigned long long)cvt_pk_bf16(o2, o3) << 32); }
    __syncthreads();
}

__global__ void __launch_bounds__(NWAVES * 64, 2) mk_fwd(Args args) {
    extern __shared__ __attribute__((aligned(16))) unsigned char lds[];
    Frame F;
    F.lds = (LAS unsigned char*)lds;
    volatile LAS unsigned* MISC = (volatile LAS unsigned*)(F.lds + MISC_OFF);
    F.tid = threadIdx.x; F.lane = F.tid & 63; F.wave = __builtin_amdgcn_readfirstlane(F.tid >> 6);
    F.G = gridDim.x; { const int bx = blockIdx.x; F.vcu = (F.G % 8 == 0) ? (bx % 8) * (F.G / 8) + bx / 8 : bx; }
    F.P.x = args.in[0]; F.P.norm_g = args.in[1]; F.P.w_in = args.in[2]; F.P.b_gate = args.in[3]; F.P.conv_w = args.in[4]; F.P.conv_b = args.in[5]; F.P.cn_g = args.in[6]; F.P.cn_b = args.in[7]; F.P.w_a = args.in[8];
    F.P.gn_g = args.in[9]; F.P.w_s = args.in[10]; F.P.b_s = args.in[11]; F.P.w_b = args.in[12]; F.P.qn_g = args.in[13]; F.P.kn_g = args.in[14]; F.P.b_f = args.in[15]; F.P.w_c = args.in[16]; F.P.w_out = args.in[17];
    F.P.out = args.out; F.P.ws = args.ws;
    gu32* ctl = (gu32*)(args.ws + WS_CTL);
    for (int u = F.tid; u < (LDS_BYTES - LDSCTL_OFF) / 4; u += NWAVES * 64) ((LAS unsigned*)(F.lds + LDSCTL_OFF))[u] = 0u;
    __syncthreads();
    XcdBarrier bar = xcd_barrier_post((unsigned*)(ctl + CW_BAR) + args.li * XCD_BAR_WORDS, MISC + 8);

    for (int ph = args.ph_lo; ph < args.ph_hi; ++ph) {
        const int l = ph / 5, p = ph % 5;
        asm volatile("" : "+v"(F.tid)); F.lane = F.tid & 63;
        unsigned char* ws = F.P.ws; unsigned char* wl = ws + WS_W + (size_t)l * W_LAYER;
        const float* xin = l == 0 ? F.P.x : F.P.out;
        if (p == 0) {
            if (l == 0) p0_weights(F);
            p0_ln(F, l, xin);
        } else if (p == 1) {
            if (blockIdx.x < NB * NH) p1_scan(F, (int)blockIdx.x);
            pg8::SchedG1 S; S.T.init(M, N1, F.G, (int)blockIdx.x); S.A = (const char*)(ws + WS_H); S.B = (const char*)(wl + WO_W1);
            pg8::EpiG1 E{(bf16_t*)(ws + WS_B0), (bf16_t*)(ws + WS_B1), (bf16_t*)(ws + WS_B2), (bf16_t*)(ws + WS_B3), (bf16_t*)(ws + WS_B4), (float*)(ws + WS_VSS), F.P.qn_g + l * HD, F.P.kn_g + l * HD};
            pg8::gemm_phase<pg8::EpiG1, pg8::SchedG1>(F.lds + RING_OFF, S, E);
        } else if (p == 2) {
            p2_conv(F, l, (int)blockIdx.x);
            p2_gmlp(F, l, 2 * (int)blockIdx.x); p2_gmlp(F, l, 2 * (int)blockIdx.x + 1);
            { const int bh = F.vcu >> 3, sq = F.vcu & 7; const attn_body::bf16* b1 = (const attn_body::bf16*)(ws + WS_B1); const attn_body::bf16* b2 = (const attn_body::bf16*)(ws + WS_B2);
              const float* c2g = (const float*)(ws + WS_CS) + (size_t)bh * SEQ;
              for (int i = 0; i < 2; ++i) attn_body::attn_unit<8>(bh / NH, bh % NH, i == 0 ? 15 - sq : sq, b1, b1 + 512, b2, b2 + 512, (attn_body::bf16*)(ws + WS_B1), c2g, (char*)lds + RING_OFF); }
        } else if (p == 3) {
            pg8::TileOrder T; T.init(M, D, F.G, (int)blockIdx.x);
            pg8::SchedMerge S; { int pm_ = 0, pn_ = 0; S.ok = T.tile(0, pm_, pn_); S.pm = pm_; S.pn = pn_; }
            S.ws = (const char*)ws; S.wl = (const char*)wl;
            pg8::EpiMerge E{ws + WS_GT + (size_t)blockIdx.x * 131072, (bf16_t*)(ws + WS_MG), F.P.b_gate + (size_t)l * 3072};
            pg8::gemm_phase<pg8::EpiMerge, pg8::SchedMerge>(F.lds + RING_OFF, S, E);
        } else {
            pg8::SchedG1 S; S.T.init(M, D, F.G, (int)blockIdx.x); S.A = (const char*)(ws + WS_MG); S.B = (const char*)(wl + WO_WO);
            pg8::EpiOut E{xin, F.P.out};
            pg8::gemm_phase<pg8::EpiOut, pg8::SchedG1>(F.lds + RING_OFF, S, E);
        }
        if (ph + 1 < args.ph_hi) xcd_barrier(bar);
    }
}

#ifndef MK_MODE
#define MK_MODE 2
#endif
extern "C" void kernel_launch(void* const* d_in, const int* in_sizes, int n_in, void* d_out, int out_size, void* d_ws, size_t ws_size, hipStream_t stream) {
    static int ok = 0;
    if (ok == 0) {
        if (n_in != 18 || in_sizes[0] != M * D || out_size != M * D || ws_size < WS_END) { fprintf(stderr, "kernel_launch: unexpected shapes (n_in %d in0 %d out %d ws %zu)\n", n_in, n_in > 0 ? in_sizes[0] : -1, out_size, ws_size); ok = -1; return; }
        const int tl = 64 * TLD * 4;
        (void)hipFuncSetAttribute((const void*)nv_gemm1, hipFuncAttributeMaxDynamicSharedMemorySize, tl);
        (void)hipFuncSetAttribute((const void*)nv_merge, hipFuncAttributeMaxDynamicSharedMemorySize, 2 * 64 * 256 * 4);
        (void)hipFuncSetAttribute((const void*)nv_gmlp, hipFuncAttributeMaxDynamicSharedMemorySize, 128 * 129 * 4);
        (void)hipFuncSetAttribute((const void*)nv_attn, hipFuncAttributeMaxDynamicSharedMemorySize, 4 * SEQ * 4);
        if (hipFuncSetAttribute((const void*)mk_fwd, hipFuncAttributeMaxDynamicSharedMemorySize, LDS_BYTES) != hipSuccess) { fprintf(stderr, "kernel_launch: hipFuncSetAttribute(mk_fwd) failed\n"); ok = -1; return; }
        int dev = 0, cus = 0; (void)hipGetDevice(&dev); (void)hipDeviceGetAttribute(&cus, hipDeviceAttributeMultiprocessorCount, dev);
        if (cus != 256) fprintf(stderr, "kernel_launch: note: %d CUs (built for 256)\n", cus);
        (void)hipGetLastError();
        ok = 1;
    }
    if (ok < 0) return;
    Ptrs P{};
    const float** pp = (const float**)&P;
    for (int i = 0; i < 18; ++i) pp[i] = (const float*)d_in[i];
    P.out = (float*)d_out; P.ws = (unsigned char*)d_ws;
    const int tl = 64 * TLD * 4;
#if MK_MODE == 0
    nv_prep<<<2048, 256, 0, stream>>>(P);
    for (int l = 0; l < NL; ++l) {
        const float* xin = l == 0 ? P.x : P.out;
        nv_ln<<<M / 4, 256, 0, stream>>>(P, l, xin);
        nv_scan<<<NB * NH, 256, 0, stream>>>(P);
        nv_gemm1<<<dim3(20, 256), 256, tl, stream>>>(P, l);
        nv_conv<<<M, 512, 0, stream>>>(P, l);
        nv_gmlp<<<dim3(128, 4), 256, 128 * 129 * 4, stream>>>(P, l);
        nv_attn<<<M * NH / 4, 256, 4 * SEQ * 4, stream>>>(P);
        nv_merge<<<dim3(4, 256), 256, 2 * 64 * 256 * 4, stream>>>(P, l);
        nv_out<<<dim3(4, 256), 256, 0, stream>>>(P, l, xin, P.out);
    }
#else
    (void)tl;
    if (hipMemsetAsync((char*)d_ws + WS_CTL, 0, CTL_ZERO_BYTES, stream) != hipSuccess) { fprintf(stderr, "kernel_launch: memset failed\n"); return; }
    Args a{};
    for (int i = 0; i < 18; ++i) a.in[i] = (const float*)d_in[i];
    a.out = (float*)d_out; a.ws = (unsigned char*)d_ws;
    auto mk = [&](int lo, int hi, int li) { a.ph_lo = lo; a.ph_hi = hi; a.li = li; hipLaunchKernelGGL(mk_fwd, dim3(256), dim3(NWAVES * 64), LDS_BYTES, stream, a);
        const hipError_t le = hipPeekAtLastError(); if (le != hipSuccess) fprintf(stderr, "kernel_launch: mk launch [%d,%d) failed: %s\n", lo, hi, hipGetErrorName(le)); };
#if MK_MODE == 1
    auto mixers = [&](int l) { nv_conv<<<M, 512, 0, stream>>>(P, l); nv_gmlp<<<dim3(128, 4), 256, 128 * 129 * 4, stream>>>(P, l); nv_attn<<<M * NH / 4, 256, 4 * SEQ * 4, stream>>>(P); };
    mk(0, 2, 0); mixers(0); mk(3, 7, 1); mixers(1); mk(8, 10, 2);
#else
    mk(0, NPH, 0);
#endif
#endif
}
```

```cpp
#include <hip/hip_runtime.h>
#include <cstdio>
#include <cstdint>
#include <cmath>

constexpr int NL = 2, NB = 4, SEQ = 4096, M = NB * SEQ, D = 1024;
constexpr int DA = 512, DB = 512, NH = 8, HD = 64, DC = 512, CW = 31, CHK = 128, NG = 4, GD = 128, NIN = 8200;
constexpr float EPS = 1e-6f;
constexpr float LOG2E = 1.4426950408889634f;
constexpr float C2 = 0.125f * LOG2E;
constexpr int N1 = 5120;
constexpr int OC_GATE = 0, OC_AIN = 3072, OC_AZ = 4096, OC_U = 4608, OC_V = 5120, OC_BZ = 5632, OC_Q = 6144, OC_K = 6656, OC_VA = 7168, OC_CZ = 7680, OC_F = 8192;

constexpr size_t MiB = 1u << 20;
constexpr size_t WS_CTL = 0, CTL_ZERO_BYTES = 1 * MiB;
constexpr size_t WS_VSS = 1 * MiB;
constexpr size_t WS_LOGF = WS_VSS + 512 * 1024;
constexpr size_t WS_CS = 2 * MiB;
constexpr size_t WS_WSB = WS_CS + 512 * 1024;
constexpr size_t WS_TS = 3 * MiB;
constexpr size_t WS_W = 4 * MiB, W_LAYER = 22 * MiB;
constexpr size_t WO_W1 = 0, WO_WG = 10 * MiB, WO_WAB = 16 * MiB, WO_WC = 18 * MiB, WO_WO = 20 * MiB;
constexpr size_t WS_H = 48 * MiB;
constexpr size_t WS_B0 = 80 * MiB;
constexpr size_t WS_B1 = 112 * MiB;
constexpr size_t WS_B2 = 144 * MiB;
constexpr size_t WS_B3 = 176 * MiB;
constexpr size_t WS_B4 = 208 * MiB;
constexpr size_t WS_GT = WS_B2, WS_MG = WS_B3;
constexpr size_t WS_DUMMY = 224 * MiB;
constexpr size_t WS_END = 256 * MiB;
#ifndef PROBE_DUP
#define PROBE_DUP -1
#endif

typedef unsigned short bf16_t;
typedef short bf16x8 __attribute__((ext_vector_type(8)));
typedef float f32x4 __attribute__((ext_vector_type(4)));
typedef unsigned u32x4 __attribute__((ext_vector_type(4)));

__host__ __device__ __forceinline__ float bf2f(bf16_t v) { union { unsigned u; float f; } c; c.u = (unsigned)v << 16; return c.f; }
__host__ __device__ __forceinline__ bf16_t f2bf(float f) { union { unsigned u; float f; } c; c.f = f; unsigned u = c.u; return (bf16_t)((u + 0x7fffu + ((u >> 16) & 1u)) >> 16); }
__device__ __forceinline__ float bfr(float f) { return bf2f(f2bf(f)); }
__device__ __forceinline__ float sigm(float x) { return 1.f / (1.f + __expf(-x)); }
__device__ __forceinline__ float siluf(float x) { return x * sigm(x); }

__host__ __device__ __forceinline__ int g1_col(int n) {
    const int j = n >> 8, lc = n & 255;
    if (j < 4) return lc < 128 ? OC_AIN + 128 * j + lc : OC_AIN + 512 + 128 * j + (lc - 128);
    if (j < 6) return OC_AZ + 256 * (j - 4) + lc;
    if (j < 8) return OC_U + 256 * (j - 6) + lc;
    if (j < 10) return OC_V + 256 * (j - 8) + lc;
    if (j < 12) return OC_BZ + 256 * (j - 10) + lc;
    if (j < 16) { const int isk = j >= 14, jj = (j - 12) & 1, head = 4 * jj + ((lc >> 5) & 3), d = 32 * (lc >> 7) + (lc & 31); return (isk ? OC_K : OC_Q) + 64 * head + d; }
    if (j < 18) return OC_VA + 256 * (j - 16) + lc;
    return OC_CZ + 256 * (j - 18) + lc;
}

struct Ptrs {
    const float *x, *norm_g, *w_in, *b_gate, *conv_w, *conv_b, *cn_g, *cn_b, *w_a, *gn_g, *w_s, *b_s, *w_b, *qn_g, *kn_g, *b_f, *w_c, *w_out;
    float* out; unsigned char* ws;
};

__global__ void nv_prep(Ptrs P) {
    const size_t gid = (size_t)blockIdx.x * blockDim.x + threadIdx.x, gsz = (size_t)gridDim.x * blockDim.x;
    for (int l = 0; l < NL; ++l) {
        unsigned char* wl = P.ws + WS_W + (size_t)l * W_LAYER;
        bf16_t* W1 = (bf16_t*)(wl + WO_W1); bf16_t* WG = (bf16_t*)(wl + WO_WG); bf16_t* WAB = (bf16_t*)(wl + WO_WAB); bf16_t* WC = (bf16_t*)(wl + WO_WC); bf16_t* WO = (bf16_t*)(wl + WO_WO);
        const float* win = P.w_in + (size_t)l * D * NIN;
        for (size_t i = gid; i < (size_t)N1 * D; i += gsz) { const int n = (int)(i >> 10), k = (int)(i & 1023); W1[i] = f2bf(win[(size_t)k * NIN + g1_col(n)]); }
        for (size_t i = gid; i < (size_t)3072 * D; i += gsz) { const int n = (int)(i >> 10), k = (int)(i & 1023); WG[i] = f2bf(win[(size_t)k * NIN + n]); }
        for (size_t i = gid; i < (size_t)1024 * 1024; i += gsz) { const int n = (int)(i >> 10), k = (int)(i & 1023);
            WAB[i] = f2bf(k < 512 ? P.w_a[((size_t)l * DA + k) * D + n] : P.w_b[((size_t)l * DB + (k - 512)) * D + n]);
            WC[i] = k < 512 ? f2bf(P.w_c[((size_t)l * DC + k) * D + n]) : (bf16_t)0;
            WO[i] = f2bf(P.w_out[((size_t)l * D + k) * D + n]); }
        bf16_t* WSB = (bf16_t*)(P.ws + WS_WSB) + (size_t)l * NG * CHK * CHK;
        for (size_t i = gid; i < (size_t)NG * CHK * CHK; i += gsz) { const int s = (int)(i & 127), t = (int)((i >> 7) & 127); WSB[i] = s <= t ? f2bf(P.w_s[(size_t)l * NG * CHK * CHK + i]) : (bf16_t)0; }
    }
}

__device__ __forceinline__ float wave_sum(float v) {
#pragma unroll
    for (int o = 1; o < 64; o <<= 1) v += __shfl_xor(v, o);
    return v;
}

__global__ void nv_ln(Ptrs P, int l, const float* xin) {
    const int lane = threadIdx.x & 63, row = blockIdx.x * 4 + (threadIdx.x >> 6);
    const float* xr = xin + (size_t)row * D; const float* g = P.norm_g + (size_t)l * D; const float* win = P.w_in + (size_t)l * D * NIN;
    float v[16]; float ss = 0.f;
#pragma unroll
    for (int j = 0; j < 16; ++j) { v[j] = xr[lane + 64 * j]; ss += v[j] * v[j]; }
    ss = wave_sum(ss);
    const float r = rsqrtf(ss * (1.f / D) + EPS);
    bf16_t* h = (bf16_t*)(P.ws + WS_H) + (size_t)row * D;
    float f[8] = {0, 0, 0, 0, 0, 0, 0, 0};
#pragma unroll
    for (int j = 0; j < 16; ++j) { const int k = lane + 64 * j; const float hv = v[j] * r * g[k]; h[k] = f2bf(hv);
#pragma unroll
        for (int e = 0; e < 8; ++e) f[e] += hv * win[(size_t)k * NIN + OC_F + e]; }
#pragma unroll
    for (int e = 0; e < 8; ++e) f[e] = wave_sum(f[e]);
    if (lane < 8) { float z = 0.f;
#pragma unroll
        for (int e = 0; e < 8; ++e) if (lane == e) z = f[e];
        z += P.b_f[l * NH + lane];
        const float lf = fminf(z, 0.f) - log1pf(expf(-fabsf(z)));
        ((float*)(P.ws + WS_LOGF))[(size_t)row * 8 + lane] = lf; }
}

__global__ void nv_scan(Ptrs P) {
    __shared__ float buf[SEQ];
    const int bh = blockIdx.x, b = bh / NH, h = bh % NH;
    const float* lf = (const float*)(P.ws + WS_LOGF);
    for (int t = threadIdx.x; t < SEQ; t += blockDim.x) buf[t] = lf[((size_t)b * SEQ + t) * 8 + h];
    __syncthreads();
    if (threadIdx.x == 0) { float c = 0.f; for (int t = 0; t < SEQ; ++t) { c += buf[t]; buf[t] = c * LOG2E; } }
    __syncthreads();
    float* cs = (float*)(P.ws + WS_CS) + (size_t)bh * SEQ;
    for (int t = threadIdx.x; t < SEQ; t += blockDim.x) cs[t] = buf[t];
}

constexpr int TLD = 257;
__device__ __forceinline__ void nv_gemm_acc(const bf16_t* A, int lda, const bf16_t* Bt, int ldb, int K, f32x4 (&acc)[4][4]) {
    const int tid = threadIdx.x, w = tid >> 6, l = tid & 63, fr = l & 15, fq = l >> 4;
#pragma unroll
    for (int m = 0; m < 4; ++m)
#pragma unroll
        for (int n = 0; n < 4; ++n) acc[m][n] = (f32x4){0.f, 0.f, 0.f, 0.f};
    for (int k0 = 0; k0 < K; k0 += 32) {
        bf16x8 a[4], b[4];
#pragma unroll
        for (int m = 0; m < 4; ++m) a[m] = *(const bf16x8*)(A + (size_t)(16 * m + fr) * lda + k0 + 8 * fq);
#pragma unroll
        for (int n = 0; n < 4; ++n) b[n] = *(const bf16x8*)(Bt + (size_t)(64 * w + 16 * n + fr) * ldb + k0 + 8 * fq);
#pragma unroll
        for (int m = 0; m < 4; ++m)
#pragma unroll
            for (int n = 0; n < 4; ++n) acc[m][n] = __builtin_amdgcn_mfma_f32_16x16x32_bf16(a[m], b[n], acc[m][n], 0, 0, 0);
    }
}
__device__ __forceinline__ void nv_gemm_tile(const bf16_t* A, int lda, const bf16_t* Bt, int ldb, int K, float* T) {
    const int tid = threadIdx.x, w = tid >> 6, l = tid & 63, fr = l & 15, fq = l >> 4;
    f32x4 acc[4][4];
    nv_gemm_acc(A, lda, Bt, ldb, K, acc);
#pragma unroll
    for (int m = 0; m < 4; ++m)
#pragma unroll
        for (int n = 0; n < 4; ++n)
#pragma unroll
            for (int r = 0; r < 4; ++r) T[(16 * m + 4 * fq + r) * TLD + 64 * w + 16 * n + fr] = acc[m][n][r];
}

__global__ void __launch_bounds__(256) nv_gemm1(Ptrs P, int l) {
    extern __shared__ float T[];
    __shared__ float R[64 * 4];
    const int j = blockIdx.x, row0 = blockIdx.y * 64, tid = threadIdx.x;
    const bf16_t* H = (const bf16_t*)(P.ws + WS_H);
    const bf16_t* W1 = (const bf16_t*)(P.ws + WS_W + (size_t)l * W_LAYER + WO_W1);
    nv_gemm_tile(H + (size_t)row0 * D, D, W1 + (size_t)j * 256 * D, D, D, T);
    __syncthreads();
    bf16_t* B0 = (bf16_t*)(P.ws + WS_B0); bf16_t* B1 = (bf16_t*)(P.ws + WS_B1); bf16_t* B2 = (bf16_t*)(P.ws + WS_B2); bf16_t* B3 = (bf16_t*)(P.ws + WS_B3); bf16_t* B4 = (bf16_t*)(P.ws + WS_B4);
    if (j < 4) {
        for (int e = tid; e < 64 * 128; e += 256) { const int r = e >> 7, c = e & 127; B3[(size_t)(row0 + r) * 1024 + 128 * j + c] = f2bf(T[r * TLD + c] * sigm(T[r * TLD + c + 128])); }
    } else if (j < 12 || j >= 16) {
        bf16_t* dst; int pitch, coff; bool act;
        if (j < 6) { dst = B0; pitch = 1024; coff = 256 * (j - 4); act = true; }
        else if (j < 8) { dst = B0; pitch = 1024; coff = 512 + 256 * (j - 6); act = false; }
        else if (j < 10) { dst = B3; pitch = 1024; coff = 512 + 256 * (j - 8); act = false; }
        else if (j < 12) { dst = B4; pitch = 512; coff = 256 * (j - 10); act = true; }
        else if (j < 18) { dst = B2; pitch = 1024; coff = 256 * (j - 16); act = false; }
        else { dst = B2; pitch = 1024; coff = 512 + 256 * (j - 18); act = true; }
        for (int e = tid; e < 64 * 256; e += 256) { const int r = e >> 8, c = e & 255; const float v = T[r * TLD + c]; dst[(size_t)(row0 + r) * pitch + coff + c] = f2bf(act ? siluf(v) : v); }
        if (j == 8 || j == 9) { const int r = tid >> 2, wc = tid & 3; float s = 0.f;
            for (int bj = 0; bj < 2; ++bj) for (int i = 0; i < 32; ++i) { const float v = T[r * TLD + 128 * bj + 32 * wc + i]; s += v * v; }
            ((float*)(P.ws + WS_VSS))[(size_t)(row0 + r) * 8 + (j - 8) * 4 + wc] = s; }
    } else {
        const bool isk = j >= 14; const int jj = (j - 12) & 1;
        { const int r = tid >> 2, hh = tid & 3; float s = 0.f;
          for (int d = 0; d < 64; ++d) { const float v = T[r * TLD + 128 * (d >> 5) + 32 * hh + (d & 31)]; s += v * v; }
          R[r * 4 + hh] = rsqrtf(s * (1.f / 64.f) + EPS); }
        __syncthreads();
        const float* gq = (isk ? P.kn_g : P.qn_g) + (size_t)l * HD;
        for (int e = tid; e < 64 * 256; e += 256) { const int r = e >> 8, c = e & 255, hh = (c >> 5) & 3, d = 32 * (c >> 7) + (c & 31);
            float v = T[r * TLD + c] * R[r * 4 + hh] * gq[d]; if (!isk) v *= C2;
            B1[(size_t)(row0 + r) * 1024 + (isk ? 512 : 0) + 64 * (4 * jj + hh) + d] = f2bf(v); }
    }
}

__global__ void __launch_bounds__(512) nv_conv(Ptrs P, int l) {
    __shared__ float red[16];
    const int row = blockIdx.x, t = row % SEQ, c = threadIdx.x, lane = c & 63, w = c >> 6;
    const bf16_t* AG = (const bf16_t*)(P.ws + WS_B3); bf16_t* B0 = (bf16_t*)(P.ws + WS_B0);
    const float* cw = P.conv_w + (size_t)l * CW * DA;
    float a = P.conv_b[l * DA + c];
    for (int j = 0; j < CW; ++j) { const int tt = t - (CW - 1) + j; if (tt >= 0) a += cw[j * DA + c] * bf2f(AG[(size_t)(row - (CW - 1) + j) * 1024 + c]); }
    float s = wave_sum(a); if (lane == 0) red[w] = s; __syncthreads();
    float mu = 0.f; for (int i = 0; i < 8; ++i) mu += red[i]; mu *= (1.f / DA);
    const float d = a - mu; s = wave_sum(d * d); if (lane == 0) red[8 + w] = s; __syncthreads();
    float var = 0.f; for (int i = 0; i < 8; ++i) var += red[8 + i]; var *= (1.f / DA);
    const float y = d * rsqrtf(var + EPS) * P.cn_g[l * DA + c] + P.cn_b[l * DA + c];
    const float az = bf2f(B0[(size_t)row * 1024 + c]);
    B0[(size_t)row * 1024 + c] = f2bf(siluf(y) * az);
}

__global__ void __launch_bounds__(256) nv_gmlp(Ptrs P, int l) {
    extern __shared__ float vn[];
    const int ch = blockIdx.x, g = blockIdx.y, tid = threadIdx.x; const size_t row0 = (size_t)ch * CHK;
    const bf16_t* V = (const bf16_t*)(P.ws + WS_B3); bf16_t* B0 = (bf16_t*)(P.ws + WS_B0); const bf16_t* BZ = (const bf16_t*)(P.ws + WS_B4);
    const float* vss = (const float*)(P.ws + WS_VSS);
    const bf16_t* WSB = (const bf16_t*)(P.ws + WS_WSB) + ((size_t)l * NG + g) * CHK * CHK;
    for (int e = tid; e < 128 * 128; e += 256) { const int s = e >> 7, c = e & 127; const float* q = vss + (row0 + s) * 8;
        const float ss = ((q[0] + q[1]) + (q[2] + q[3])) + ((q[4] + q[5]) + (q[6] + q[7])); const float rv = rsqrtf(ss * (1.f / DB) + EPS);
        vn[s * 129 + c] = bfr(bf2f(V[(row0 + s) * 1024 + 512 + 128 * g + c]) * rv * P.gn_g[l * DB + 128 * g + c]); }
    __syncthreads();
    for (int e = tid; e < 128 * 128; e += 256) { const int t = e >> 7, c = e & 127; float acc = 0.f;
        for (int s = 0; s <= t; ++s) acc += bf2f(WSB[t * 128 + s]) * vn[s * 129 + c];
        acc += P.b_s[((size_t)l * NG + g) * CHK + t];
        const size_t o = (row0 + t) * 1024 + 512 + 128 * g + c;
        B0[o] = f2bf(bf2f(B0[o]) * acc * bf2f(BZ[(row0 + t) * 512 + 128 * g + c])); }
}

__global__ void __launch_bounds__(256) nv_attn(Ptrs P) {
    extern __shared__ float sc[];
    const int lane = threadIdx.x & 63, w = threadIdx.x >> 6; const int item = blockIdx.x * 4 + w, row = item >> 3, h = item & 7, b = row / SEQ, t = row % SEQ;
    float* s = sc + w * SEQ;
    bf16_t* B1 = (bf16_t*)(P.ws + WS_B1); const bf16_t* B2 = (const bf16_t*)(P.ws + WS_B2);
    const float* cs = (const float*)(P.ws + WS_CS) + (size_t)(b * NH + h) * SEQ;
    float q[64];
#pragma unroll
    for (int d = 0; d < 64; ++d) q[d] = bf2f(B1[(size_t)row * 1024 + 64 * h + d]);
    const float cq = cs[t]; float mx = -INFINITY;
    for (int k = lane; k <= t; k += 64) { const bf16_t* kr = B1 + ((size_t)b * SEQ + k) * 1024 + 512 + 64 * h; float dot = 0.f;
#pragma unroll
        for (int d8 = 0; d8 < 8; ++d8) { const bf16x8 kv = *(const bf16x8*)(kr + 8 * d8);
#pragma unroll
            for (int e = 0; e < 8; ++e) dot += q[8 * d8 + e] * bf2f((bf16_t)kv[e]); }
        const float v = dot + (cq - cs[k]); s[k] = v; mx = fmaxf(mx, v); }
#pragma unroll
    for (int o = 1; o < 64; o <<= 1) mx = fmaxf(mx, __shfl_xor(mx, o));
    float lsum = 0.f;
    for (int k = lane; k <= t; k += 64) { const float p = exp2f(s[k] - mx); lsum += p; s[k] = bfr(p); }
    lsum = wave_sum(lsum);
    __builtin_amdgcn_s_waitcnt(0); __builtin_amdgcn_wave_barrier();
    float o = 0.f; const bf16_t* vb = B2 + (size_t)b * SEQ * 1024 + 64 * h + lane;
    for (int k = 0; k <= t; ++k) o += s[k] * bf2f(vb[(size_t)k * 1024]);
    const float cz = bf2f(B2[(size_t)row * 1024 + 512 + 64 * h + lane]);
    B1[(size_t)row * 1024 + 64 * h + lane] = f2bf(o / lsum * cz);
}

__global__ void __launch_bounds__(256) nv_merge(Ptrs P, int l) {
    extern __shared__ float T[];
    const int pn = blockIdx.x, row0 = blockIdx.y * 64, tid = threadIdx.x, w = tid >> 6, ln = tid & 63, fr = ln & 15, fq = ln >> 4;
    const unsigned char* wl = P.ws + WS_W + (size_t)l * W_LAYER;
    const bf16_t* H = (const bf16_t*)(P.ws + WS_H); const bf16_t* WG = (const bf16_t*)(wl + WO_WG); const bf16_t* WAB = (const bf16_t*)(wl + WO_WAB); const bf16_t* WC = (const bf16_t*)(wl + WO_WC);
    const bf16_t* B0 = (const bf16_t*)(P.ws + WS_B0); const bf16_t* B1 = (const bf16_t*)(P.ws + WS_B1);
    float* G = T; float* MGs = T + 64 * 256;
    f32x4 acc[4][4];
    for (int br = 0; br < 3; ++br) {
        nv_gemm_acc(H + (size_t)row0 * D, D, WG + ((size_t)br * 1024 + 256 * pn) * D, D, D, acc);
#pragma unroll
        for (int m = 0; m < 4; ++m)
#pragma unroll
            for (int n = 0; n < 4; ++n)
#pragma unroll
                for (int r = 0; r < 4; ++r) { const int c = 64 * w + 16 * n + fr; G[((m * 4 + n) * 4 + r) * 256 + tid] = bfr(sigm(acc[m][n][r] + P.b_gate[(size_t)l * 3072 + br * 1024 + 256 * pn + c])); }
        const bf16_t* A = br == 0 ? B0 : (br == 1 ? B0 + 512 : B1); const bf16_t* Bt = br == 0 ? WAB : (br == 1 ? WAB + 512 : WC);
        nv_gemm_acc(A + (size_t)row0 * 1024, 1024, Bt + (size_t)256 * pn * 1024, 1024, 512, acc);
#pragma unroll
        for (int m = 0; m < 4; ++m)
#pragma unroll
            for (int n = 0; n < 4; ++n)
#pragma unroll
                for (int r = 0; r < 4; ++r) { const int s = ((m * 4 + n) * 4 + r) * 256 + tid; const float v = G[s] * acc[m][n][r]; MGs[s] = bfr(br == 0 ? v : MGs[s] + v); }
    }
    bf16_t* MG = (bf16_t*)(P.ws + WS_MG);
#pragma unroll
    for (int m = 0; m < 4; ++m)
#pragma unroll
        for (int n = 0; n < 4; ++n)
#pragma unroll
            for (int r = 0; r < 4; ++r) MG[(size_t)(row0 + 16 * m + 4 * fq + r) * 1024 + 256 * pn + 64 * w + 16 * n + fr] = f2bf(MGs[((m * 4 + n) * 4 + r) * 256 + tid]);
}

__global__ void __launch_bounds__(256) nv_out(Ptrs P, int l, const float* xin, float* xout) {
    const int pn = blockIdx.x, row0 = blockIdx.y * 64, tid = threadIdx.x, w = tid >> 6, ln = tid & 63, fr = ln & 15, fq = ln >> 4;
    const bf16_t* MG = (const bf16_t*)(P.ws + WS_MG); const bf16_t* WO = (const bf16_t*)(P.ws + WS_W + (size_t)l * W_LAYER + WO_WO);
    f32x4 acc[4][4];
    nv_gemm_acc(MG + (size_t)row0 * 1024, 1024, WO + (size_t)256 * pn * 1024, 1024, 1024, acc);
#pragma unroll
    for (int m = 0; m < 4; ++m)
#pragma unroll
        for (int n = 0; n < 4; ++n)
#pragma unroll
            for (int r = 0; r < 4; ++r) { const size_t o = (size_t)(row0 + 16 * m + 4 * fq + r) * D + 256 * pn + 64 * w + 16 * n + fr; xout[o] = xin[o] + acc[m][n][r]; }
}


#define LAS __attribute__((address_space(3)))
#define GAS __attribute__((address_space(1)))
typedef GAS unsigned gu32;
#define RLX_AGENT __ATOMIC_RELAXED, __HIP_MEMORY_SCOPE_AGENT
#define LDS_WAIT() asm volatile("s_waitcnt lgkmcnt(0)" ::: "memory")
#define VM_WAIT() asm volatile("s_waitcnt vmcnt(0)" ::: "memory")
constexpr int NWAVES = 8;
constexpr int RING_OFF = 0, RING_BYTES = 131072;
constexpr int LDSCTL_OFF = RING_BYTES, MISC_OFF = LDSCTL_OFF + 320;
constexpr int LDS_BYTES = 147456;
constexpr int CW_TMO = 0, CW_CODE = 1, CW_BAR = 4096;
constexpr float SKIP_L2 = 160.f;
constexpr int NPH = 10;

__device__ __forceinline__ unsigned cvt_pk_bf16(float lo, float hi) { unsigned r; asm volatile("v_cvt_pk_bf16_f32 %0, %1, %2" : "=v"(r) : "v"(lo), "v"(hi)); return r; }
__device__ __forceinline__ float fsigm(float x) { return __builtin_amdgcn_rcpf(1.f + __builtin_amdgcn_exp2f(-LOG2E * x)); }
__device__ __forceinline__ u32x4 pack8(const f32x4& a, const f32x4& b) { u32x4 w; w.x = cvt_pk_bf16(a[0], a[1]); w.y = cvt_pk_bf16(a[2], a[3]); w.z = cvt_pk_bf16(b[0], b[1]); w.w = cvt_pk_bf16(b[2], b[3]); return w; }
__device__ __forceinline__ void unpack8(const u32x4& w, f32x4& a, f32x4& b) {
    a[0] = __uint_as_float(w.x << 16); a[1] = __uint_as_float(w.x & 0xffff0000u); a[2] = __uint_as_float(w.y << 16); a[3] = __uint_as_float(w.y & 0xffff0000u);
    b[0] = __uint_as_float(w.z << 16); b[1] = __uint_as_float(w.z & 0xffff0000u); b[2] = __uint_as_float(w.w << 16); b[3] = __uint_as_float(w.w & 0xffff0000u); }

namespace pg8 {
constexpr int BM = 256, BK = 64, HALF = 128, HTB = HALF * BK * 2, STAGE_BYTES = 8 * HTB, NXCD = 8, WGM = 8, PITCH = 1024;
__host__ __device__ __forceinline__ int lds_byte(int r, int c) { const int st = (r >> 4) * 2 + (c >> 5), rr = r & 15, cc = c & 31, ob = rr * 64 + cc * 2; return st * 1024 + (ob ^ (((ob >> 9) & 1) << 5)); }
__host__ __device__ __forceinline__ void stage_rc(int b, int& R, int& C) { const int st = b / 1024, sb = b % 1024, swz = sb ^ (((sb >> 9) & 1) << 5); R = (st >> 1) * 16 + swz / 64; C = (st & 1) * 32 + (swz % 64) / 2; }
__host__ __device__ __forceinline__ int perm32(int rho) { const int n = rho >> 4, i = rho & 15; return 8 * (i >> 2) + 4 * n + (i & 3); }

struct Unit { const char* A; const char* B; int nt, pm, pn, tag; };

struct TileOrder {
    int nM, nN, nwg, G, c;
    __device__ __forceinline__ void init(int Mr, int N, int G_, int c_) { nM = Mr / BM; nN = N / BM; nwg = nM * nN; G = G_; c = c_; }
    __device__ __forceinline__ bool tile(int i, int& pm, int& pn) const {
        const long L = (long)i * G + c; if (L >= nwg) return false;
        int wgid = (int)L; { const int q = nwg / NXCD, r = nwg % NXCD, xcd = wgid % NXCD, off = wgid / NXCD; wgid = (xcd < r ? xcd * (q + 1) : r * (q + 1) + (xcd - r) * q) + off; }
        const int nig = WGM * nN, gid = wgid / nig, fm = gid * WGM, gsz = (nM - fm) < WGM ? (nM - fm) : WGM;
        pm = fm + ((wgid % nig) % gsz); pn = (wgid % nig) / gsz; return true;
    }
};

template <class Epi, class Sched>
__device__ __forceinline__ void gemm_phase(LAS unsigned char* lds, const Sched& S, const Epi& E) {
    int tid = threadIdx.x; asm volatile("" : "+v"(tid));
    const int wid = __builtin_amdgcn_readfirstlane(tid >> 6), lane = tid & 63, wr = wid >> 2, wc = wid & 3, fr = lane & 15, fq = lane >> 4;
    unsigned voffA[2], voffB[2];
#pragma unroll
    for (int i = 0; i < 2; ++i) { int R, C; stage_rc(tid * 16 + i * 8192, R, C); const int Rb = (R & ~31) + perm32(R & 31);
        voffA[i] = (unsigned)(R * PITCH + C) * 2u; voffB[i] = (unsigned)(Rb * PITCH + C) * 2u; }
    const size_t kstep = (size_t)(BK * 2);
    const size_t hstep = (size_t)HALF * PITCH * 2;
    const unsigned ldsw = (unsigned)wid * 1024u;
    const int aoff = lds_byte(wr * 64 + fr, fq * 8), boff = lds_byte(wc * 32 + fr, fq * 8);
#define PG8_SA(b, h) (((b) * 2 + (h)) * HTB)
#define PG8_SB(b, h) ((4 + (b) * 2 + (h)) * HTB)
#define PG8_STAGE(bufoff, gbase, voff) do { _Pragma("unroll") for (int _i = 0; _i < 2; ++_i) \
        __builtin_amdgcn_global_load_lds((const unsigned*)((const char*)(gbase) + (voff)[_i]), (LAS unsigned*)(lds + (bufoff) + ldsw + _i * 8192), 16, 0, 0); } while (0)
#define PG8_LDA(dst, b, h) do { _Pragma("unroll") for (int m = 0; m < 4; ++m) _Pragma("unroll") for (int k = 0; k < 2; ++k) dst[m][k] = *(const LAS bf16x8*)(lds + PG8_SA(b, h) + aoff + m * 2048 + k * 1024); } while (0)
#define PG8_LDB(dst, b, h) do { _Pragma("unroll") for (int n = 0; n < 2; ++n) _Pragma("unroll") for (int k = 0; k < 2; ++k) dst[n][k] = *(const LAS bf16x8*)(lds + PG8_SB(b, h) + boff + n * 2048 + k * 1024); } while (0)
#define PG8_MMA(ai, bj, At, Bt) do { __builtin_amdgcn_s_setprio(1); _Pragma("unroll") for (int m = 0; m < 4; ++m) _Pragma("unroll") for (int n = 0; n < 2; ++n) _Pragma("unroll") for (int k = 0; k < 2; ++k) \
        acc[ai][bj][m][n] = __builtin_amdgcn_mfma_f32_16x16x32_bf16(Bt[n][k], At[m][k], acc[ai][bj][m][n], 0, 0, 0); __builtin_amdgcn_s_setprio(0); } while (0)
#define PG8_WAIT_V(n) asm volatile("s_waitcnt vmcnt(" #n ")" ::: "memory")
#define PG8_WAIT_L(n) asm volatile("s_waitcnt lgkmcnt(" #n ")" ::: "memory")
#define PG8_BAR __builtin_amdgcn_s_barrier()
#define PG8_SCHED __builtin_amdgcn_sched_barrier(0)
    Unit cur, nxt; int ui = 0;
    if (!S.next(0, cur)) return;
    f32x4 acc[2][2][4][2];
#pragma unroll
    for (int a = 0; a < 2; ++a)
#pragma unroll
        for (int b = 0; b < 2; ++b)
#pragma unroll
            for (int m = 0; m < 4; ++m)
#pragma unroll
                for (int n = 0; n < 2; ++n) acc[a][b][m][n] = (f32x4){0.f, 0.f, 0.f, 0.f};
    bf16x8 At[4][2], B0[2][2], B1[2][2];
    const char* cA = cur.A; const char* cB = cur.B;
    PG8_STAGE(PG8_SB(0, 0), cB, voffB); PG8_STAGE(PG8_SB(0, 1), cB + hstep, voffB); PG8_STAGE(PG8_SA(0, 0), cA, voffA); PG8_STAGE(PG8_SA(0, 1), cA + hstep, voffA);
    if (wr == 1) PG8_BAR;
    PG8_WAIT_V(2); PG8_BAR;
    PG8_STAGE(PG8_SB(1, 0), cB + kstep, voffB); PG8_STAGE(PG8_SA(1, 0), cA + kstep, voffA); PG8_STAGE(PG8_SB(1, 1), cB + hstep + kstep, voffB);
    PG8_WAIT_V(6); PG8_BAR;
    for (;;) {
        const bool has_next = S.next(ui + 1, nxt);
        const char* nA = has_next ? nxt.A : cA; const char* nB = has_next ? nxt.B : cB;
        const int nt = cur.nt;
        for (int t = 0; t < nt; t += 2) {
            const bool last = (t == nt - 2);
            const char* a1 = cA + (size_t)(t + 1) * kstep;
            const char* a2 = last ? nA : cA + (size_t)(t + 2) * kstep; const char* b2 = last ? nB : cB + (size_t)(t + 2) * kstep;
            const char* a3 = a2 + kstep; const char* b3 = b2 + kstep;
            PG8_LDB(B0, 0, 0); PG8_LDB(B1, 0, 1); PG8_SCHED; PG8_LDA(At, 0, 0); PG8_STAGE(PG8_SA(1, 1), a1 + hstep, voffA);
            PG8_WAIT_V(8); PG8_WAIT_L(0); PG8_BAR; PG8_MMA(0, 0, At, B0); PG8_MMA(0, 1, At, B1); PG8_BAR; PG8_SCHED;
            PG8_LDA(At, 0, 1); PG8_STAGE(PG8_SB(0, 0), b2, voffB); PG8_STAGE(PG8_SB(0, 1), b2 + hstep, voffB); PG8_STAGE(PG8_SA(0, 0), a2, voffA);
            PG8_WAIT_V(8); PG8_WAIT_L(0); PG8_BAR; PG8_MMA(1, 0, At, B0); PG8_MMA(1, 1, At, B1); PG8_BAR; PG8_SCHED;
            PG8_LDB(B0, 1, 0); PG8_LDB(B1, 1, 1); PG8_SCHED; PG8_LDA(At, 1, 0); PG8_STAGE(PG8_SA(0, 1), a2 + hstep, voffA);
            PG8_WAIT_V(8); PG8_WAIT_L(0); PG8_BAR; PG8_MMA(0, 0, At, B0); PG8_MMA(0, 1, At, B1); PG8_BAR; PG8_SCHED;
            PG8_LDA(At, 1, 1); PG8_STAGE(PG8_SB(1, 0), b3, voffB); PG8_STAGE(PG8_SB(1, 1), b3 + hstep, voffB); PG8_STAGE(PG8_SA(1, 0), a3, voffA);
            PG8_WAIT_V(8); PG8_WAIT_L(0); PG8_BAR; PG8_MMA(1, 0, At, B0); PG8_MMA(1, 1, At, B1); PG8_BAR; PG8_SCHED;
        }
        if (wr == 0) PG8_BAR;
        E(acc, cur, wr, wc, fr, fq);
        if (!has_next) break;
#pragma unroll
        for (int a = 0; a < 2; ++a)
#pragma unroll
            for (int b = 0; b < 2; ++b)
#pragma unroll
                for (int m = 0; m < 4; ++m)
#pragma unroll
                    for (int n = 0; n < 2; ++n) acc[a][b][m][n] = (f32x4){0.f, 0.f, 0.f, 0.f};
        cur = nxt; cA = nA; cB = nB; ++ui;
        if (wr == 1) PG8_BAR;
    }
    PG8_WAIT_V(0);
    PG8_BAR;
#undef PG8_SA
#undef PG8_SB
#undef PG8_STAGE
#undef PG8_LDA
#undef PG8_LDB
#undef PG8_MMA
#undef PG8_WAIT_V
#undef PG8_WAIT_L
#undef PG8_BAR
#undef PG8_SCHED
}

struct EpiG1 {
    bf16_t *B0, *B1, *B2, *B3, *B4; float* vss; const float *gq, *gk;
    __device__ __forceinline__ void operator()(const f32x4 (&acc)[2][2][4][2], const Unit& u, int wr, int wc, int fr, int fq) const {
        const int j = u.pn; const size_t rowb = (size_t)u.pm * BM + wr * 64 + fr; const int cl = 32 * wc + 8 * fq;
        if (j < 4) {
#pragma unroll
            for (int ai = 0; ai < 2; ++ai)
#pragma unroll
                for (int m = 0; m < 4; ++m) { f32x4 o0, o1;
#pragma unroll
                    for (int e = 0; e < 4; ++e) { o0[e] = acc[ai][0][m][0][e] * fsigm(acc[ai][1][m][0][e]); o1[e] = acc[ai][0][m][1][e] * fsigm(acc[ai][1][m][1][e]); }
                    *(u32x4*)(B3 + (rowb + ai * HALF + m * 16) * 1024 + 128 * j + cl) = pack8(o0, o1); }
        } else if (j < 12 || j >= 16) {
            bf16_t* dst; int pitch, coff; bool act;
            if (j < 6) { dst = B0; pitch = 1024; coff = 256 * (j - 4); act = true; }
            else if (j < 8) { dst = B0; pitch = 1024; coff = 512 + 256 * (j - 6); act = false; }
            else if (j < 10) { dst = B3; pitch = 1024; coff = 512 + 256 * (j - 8); act = false; }
            else if (j < 12) { dst = B4; pitch = 512; coff = 256 * (j - 10); act = true; }
            else if (j < 18) { dst = B2; pitch = 1024; coff = 256 * (j - 16); act = false; }
            else { dst = B2; pitch = 1024; coff = 512 + 256 * (j - 18); act = true; }
            const bool stat = (j == 8 || j == 9);
#pragma unroll
            for (int ai = 0; ai < 2; ++ai)
#pragma unroll
                for (int m = 0; m < 4; ++m) { const size_t row = rowb + ai * HALF + m * 16; float s = 0.f;
#pragma unroll
                    for (int bj = 0; bj < 2; ++bj) { f32x4 v0 = acc[ai][bj][m][0], v1 = acc[ai][bj][m][1];
                        if (act) {
#pragma unroll
                            for (int e = 0; e < 4; ++e) { v0[e] = v0[e] * fsigm(v0[e]); v1[e] = v1[e] * fsigm(v1[e]); } }
                        s += (v0[0] * v0[0] + v0[1] * v0[1]) + (v0[2] * v0[2] + v0[3] * v0[3]) + (v1[0] * v1[0] + v1[1] * v1[1]) + (v1[2] * v1[2] + v1[3] * v1[3]);
                        *(u32x4*)(dst + row * pitch + coff + 128 * bj + cl) = pack8(v0, v1); }
                    if (stat) { s += __shfl_xor(s, 16); s += __shfl_xor(s, 32); if (fq == 0) vss[row * 8 + (j - 8) * 4 + wc] = s; } }
        } else {
            const bool isk = j >= 14; const int jj = (j - 12) & 1; const float* g = isk ? gk : gq; const float sc = isk ? 1.f : C2;
            f32x4 gv[2][2];
#pragma unroll
            for (int bj = 0; bj < 2; ++bj) { gv[bj][0] = *(const f32x4*)(g + 32 * bj + 8 * fq) * sc; gv[bj][1] = *(const f32x4*)(g + 32 * bj + 8 * fq + 4) * sc; }
            bf16_t* dst = B1 + (isk ? 512 : 0) + 64 * (4 * jj + wc) + 8 * fq;
#pragma unroll
            for (int ai = 0; ai < 2; ++ai)
#pragma unroll
                for (int m = 0; m < 4; ++m) { const size_t row = rowb + ai * HALF + m * 16; float s = 0.f;
#pragma unroll
                    for (int bj = 0; bj < 2; ++bj) { const f32x4 v0 = acc[ai][bj][m][0], v1 = acc[ai][bj][m][1];
                        s += (v0[0] * v0[0] + v0[1] * v0[1]) + (v0[2] * v0[2] + v0[3] * v0[3]) + (v1[0] * v1[0] + v1[1] * v1[1]) + (v1[2] * v1[2] + v1[3] * v1[3]); }
                    s += __shfl_xor(s, 16); s += __shfl_xor(s, 32);
                    const float r = __builtin_amdgcn_rsqf(s * (1.f / 64.f) + EPS);
#pragma unroll
                    for (int bj = 0; bj < 2; ++bj) *(u32x4*)(dst + row * 1024 + 32 * bj) = pack8(acc[ai][bj][m][0] * r * gv[bj][0], acc[ai][bj][m][1] * r * gv[bj][1]); }
        }
    }
};
struct EpiMerge {
    unsigned char* gt; bf16_t* MG; const float* bgate;
    __device__ __forceinline__ void operator()(const f32x4 (&acc)[2][2][4][2], const Unit& u, int wr, int wc, int fr, int fq) const {
        const int tag = u.tag, br = tag >> 1; const size_t rowb = (size_t)u.pm * BM + wr * 64 + fr; const int col0 = u.pn * BM + 32 * wc + 8 * fq;
        u32x4* slots_ = (u32x4*)gt + ((wr * 4 + wc) * 64 + fq * 16 + fr); asm volatile("" : "+v"(slots_)); __attribute__((address_space(1))) u32x4* slots = (__attribute__((address_space(1))) u32x4*)slots_;
        if ((tag & 1) == 0) {
            f32x4 bv[2][2];
#pragma unroll
            for (int bj = 0; bj < 2; ++bj) { bv[bj][0] = *(const f32x4*)(bgate + br * 1024 + col0 + 128 * bj); bv[bj][1] = *(const f32x4*)(bgate + br * 1024 + col0 + 128 * bj + 4); }
#pragma unroll
            for (int ai = 0; ai < 2; ++ai)
#pragma unroll
                for (int m = 0; m < 4; ++m)
#pragma unroll
                    for (int bj = 0; bj < 2; ++bj) { f32x4 v0 = acc[ai][bj][m][0] + bv[bj][0], v1 = acc[ai][bj][m][1] + bv[bj][1];
#pragma unroll
                        for (int e = 0; e < 4; ++e) { v0[e] = fsigm(v0[e]); v1[e] = fsigm(v1[e]); }
                        slots[(size_t)(((ai * 4 + m) * 2 + bj) * 512)] = pack8(v0, v1); }
        } else {
#pragma unroll
            for (int ai = 0; ai < 2; ++ai)
#pragma unroll
                for (int m = 0; m < 4; ++m) {
#pragma unroll
                    for (int bj = 0; bj < 2; ++bj) { const u32x4 gw = slots[(size_t)(((ai * 4 + m) * 2 + bj) * 512)]; f32x4 g0, g1; unpack8(gw, g0, g1);
                        f32x4 v0 = g0 * acc[ai][bj][m][0], v1 = g1 * acc[ai][bj][m][1];
                        u32x4* p = (u32x4*)(MG + (rowb + ai * HALF + m * 16) * 1024 + col0 + 128 * bj);
                        if (br > 0) { const u32x4 ow = *p; f32x4 p0, p1; unpack8(ow, p0, p1); v0 += p0; v1 += p1; }
                        *p = pack8(v0, v1); }
                    if (m & 1) asm volatile("" ::: "memory"); }
        }
    }
};
struct EpiOut {
    const float* base; float* out;
    __device__ __forceinline__ void operator()(const f32x4 (&acc)[2][2][4][2], const Unit& u, int wr, int wc, int fr, int fq) const {
        const size_t rowb = (size_t)u.pm * BM + wr * 64 + fr; const int col0 = u.pn * BM + 32 * wc + 8 * fq;
#pragma unroll
        for (int ai = 0; ai < 2; ++ai)
#pragma unroll
            for (int m = 0; m < 4; ++m) {
#pragma unroll
                for (int bj = 0; bj < 2; ++bj) { const size_t o = (rowb + ai * HALF + m * 16) * D + col0 + 128 * bj;
                    const f32x4 b0 = *(const f32x4*)(base + o), b1 = *(const f32x4*)(base + o + 4);
                    *(f32x4*)(out + o) = b0 + acc[ai][bj][m][0]; *(f32x4*)(out + o + 4) = b1 + acc[ai][bj][m][1]; }
                if (m & 1) asm volatile("" ::: "memory"); }
    }
};
struct SchedG1 { TileOrder T; const char* A; const char* B;
    __device__ __forceinline__ bool next(int i, Unit& u) const { int pm, pn; if (!T.tile(i, pm, pn)) return false; u.pm = pm; u.pn = pn; u.tag = 0; u.nt = 16; u.A = A + (size_t)pm * (BM * PITCH * 2); u.B = B + (size_t)pn * (BM * PITCH * 2); return true; } };
struct SchedMerge { int pm, pn; bool ok; const char *ws, *wl;
    __device__ __forceinline__ bool next(int i, Unit& u) const { if (!ok || i >= 6) return false; const int br = i >> 1; u.pm = pm; u.pn = pn; u.tag = i;
        const size_t ro = (size_t)pm * (BM * PITCH * 2), co = (size_t)pn * (BM * PITCH * 2);
        if ((i & 1) == 0) { u.nt = 16; u.A = ws + WS_H + ro; u.B = wl + WO_WG + (size_t)br * (1024 * PITCH * 2) + co; }
        else { u.nt = 8; const size_t ao = br == 0 ? WS_B0 : (br == 1 ? WS_B0 + 1024 : WS_B1), bo = br == 0 ? WO_WAB : (br == 1 ? WO_WAB + 1024 : WO_WC); u.A = ws + ao + ro; u.B = wl + bo + co; }
        return true; } };
}

#define XB_TMO      128
#define XB_XCNT(j)  (256  + 64 * (j))
#define XB_XSUB(j)  (1280 + 64 * (j))
#define XB_XGEN(j)  (2304 + 64 * (j))
#define XB_TOP      3328
#define XB_TOPGEN   3392
#define XCD_BAR_WORDS 3456
#define XB_SPIN_CAP (1u << 18)
__device__ __forceinline__ unsigned xb_ld(unsigned* p)              { return __hip_atomic_load(p, __ATOMIC_RELAXED, __HIP_MEMORY_SCOPE_AGENT); }
__device__ __forceinline__ unsigned xb_add(unsigned* p, unsigned v) { return __hip_atomic_fetch_add(p, v, __ATOMIC_RELAXED, __HIP_MEMORY_SCOPE_AGENT); }
__device__ __forceinline__ unsigned xb_xcc_id() { return (unsigned)__builtin_amdgcn_s_getreg((3 << 11) | 20) & 0xFu; }
#define XB_SPIN(cond, bar) do { unsigned _sp = 0; while (cond) { __builtin_amdgcn_s_sleep(1); \
    if ((++_sp & 255u) == 0u) { if (xb_ld(&(bar)[XB_TMO])) break; if (_sp > XB_SPIN_CAP) { atomicAdd(&(bar)[XB_TMO], 1u); break; } } } } while (0)
struct XcdBarrier { unsigned* bar; unsigned x; volatile LAS unsigned* st; };
__device__ __forceinline__ XcdBarrier xcd_barrier_post(unsigned* bar, volatile LAS unsigned* st) {
    XcdBarrier b; b.bar = bar; b.x = xb_xcc_id(); b.st = st;
    if (threadIdx.x == 0) (void)xb_add(&bar[XB_XCNT(b.x)], 1u);
    return b;
}
__device__ __forceinline__ void xcd_barrier_complete(unsigned* bar, unsigned x, unsigned& nloc, unsigned& nx) {
    const unsigned G = gridDim.x * gridDim.y * gridDim.z;
    unsigned sum, cnt, mine, sp = 0u;
    for (;;) {
        sum = 0u; cnt = 0u; mine = 0u;
#pragma unroll
        for (unsigned j = 0; j < 16; ++j) { const unsigned c = xb_ld(&bar[XB_XCNT(j)]); sum += c; cnt += (c > 0u) ? 1u : 0u; mine = (j == x) ? c : mine; }
        if (sum == G) break;
        __builtin_amdgcn_s_sleep(1);
        if ((++sp & 255u) == 0u) { if (xb_ld(&bar[XB_TMO])) break; if (sp > XB_SPIN_CAP) { atomicAdd(&bar[XB_TMO], 1u); break; } }
    }
    nloc = mine > 0u ? mine : 1u; nx = cnt > 0u ? cnt : 1u;
}
__device__ __forceinline__ void xcd_barrier(const XcdBarrier& b) {
    asm volatile("s_waitcnt vmcnt(0)" ::: "memory");
    __syncthreads();
    if (threadIdx.x == 0) {
        unsigned* bar = b.bar;
        __builtin_amdgcn_s_waitcnt(0);
        unsigned nloc = b.st[0], nx = b.st[1];
        if (nloc == 0u) { xcd_barrier_complete(bar, b.x, nloc, nx); b.st[0] = nloc; b.st[1] = nx; }
        const unsigned old = xb_add(&bar[XB_XSUB(b.x)], 1u);
        const unsigned gen = old / nloc;
        if (old + 1u == (gen + 1u) * nloc) {
            __builtin_amdgcn_fence(__ATOMIC_RELEASE, "agent");
            asm volatile("s_waitcnt vmcnt(0)" ::: "memory");
            const unsigned og = xb_add(&bar[XB_TOP], 1u);
            const unsigned tg = og / nx;
            if (og + 1u == (tg + 1u) * nx) xb_add(&bar[XB_TOPGEN], 1u);
            else XB_SPIN(xb_ld(&bar[XB_TOPGEN]) == tg, bar);
            __builtin_amdgcn_fence(__ATOMIC_ACQUIRE, "agent");
            xb_add(&bar[XB_XGEN(b.x)], 1u);
            asm volatile("s_waitcnt vmcnt(0)" ::: "memory");
        } else {
            XB_SPIN(xb_ld(&bar[XB_XGEN(b.x)]) == gen, bar);
            __builtin_amdgcn_fence(__ATOMIC_ACQUIRE, "agent");
            asm volatile("s_waitcnt vmcnt(0)" ::: "memory");
        }
    }
    __syncthreads();
}

struct Args { const float* in[18]; float* out; unsigned char* ws; int ph_lo, ph_hi, li, pad; };
struct Frame { LAS unsigned char* lds; int tid, lane, wave, vcu, G; Ptrs P; };

__device__ __forceinline__ unsigned pk2(float lo, float hi) { return (unsigned)f2bf(lo) | ((unsigned)f2bf(hi) << 16); }
__device__ __forceinline__ void p0_transpose_item(const float* W, int ldw, int src_col, int k0, bf16_t* WT, size_t dst_row, int dst_col, LAS float* scr, int lane) {
#pragma unroll 8
    for (int i = 0; i < 32; ++i) { const int kk = 2 * i + (lane >> 5); scr[kk * 33 + (lane & 31)] = W[(size_t)(k0 + kk) * ldw + src_col + (lane & 31)]; }
    LDS_WAIT(); asm volatile("" ::: "memory");
    const int c = lane & 7;
#pragma unroll
    for (int j = 0; j < 4; ++j) { const int n = (lane >> 3) + 8 * j; const LAS float* s = scr + (8 * c) * 33 + n;
        u32x4 o; o.x = pk2(s[0 * 33], s[1 * 33]); o.y = pk2(s[2 * 33], s[3 * 33]); o.z = pk2(s[4 * 33], s[5 * 33]); o.w = pk2(s[6 * 33], s[7 * 33]);
        *(GAS u32x4*)(WT + (dst_row + n) * 1024 + dst_col + k0 + 8 * c) = o; }
    LDS_WAIT(); asm volatile("" ::: "memory");
}
__device__ __forceinline__ void p0_weights(Frame& F) {
    LAS float* scr = (LAS float*)(F.lds + RING_OFF + F.wave * 16384);
    const int gw = F.vcu * NWAVES + F.wave, NGW = F.G * NWAVES;
    constexpr int I_W1 = 16 * (N1 / 32), I_WG = 16 * 96, I_Y = 8 * 32, I_WO = 16 * 32, I_L = I_W1 + I_WG + 3 * I_Y + I_WO;
    for (int it = gw; it < NL * I_L; it += NGW) {
        const int l = it / I_L; int r = it % I_L;
        unsigned char* wl = F.P.ws + WS_W + (size_t)l * W_LAYER; const float* win = F.P.w_in + (size_t)l * D * NIN;
        if (r < I_W1) { const int kb = r / (N1 / 32), nb = r % (N1 / 32); p0_transpose_item(win, NIN, g1_col(32 * nb), 64 * kb, (bf16_t*)(wl + WO_W1), 32 * nb, 0, scr, F.lane); continue; } r -= I_W1;
        if (r < I_WG) { const int kb = r / 96, nb = r % 96; p0_transpose_item(win, NIN, 32 * nb, 64 * kb, (bf16_t*)(wl + WO_WG), 32 * nb, 0, scr, F.lane); continue; } r -= I_WG;
        if (r < I_Y) { const int kb = r / 32, nb = r % 32; p0_transpose_item(F.P.w_a + (size_t)l * DA * D, D, 32 * nb, 64 * kb, (bf16_t*)(wl + WO_WAB), 32 * nb, 0, scr, F.lane); continue; } r -= I_Y;
        if (r < I_Y) { const int kb = r / 32, nb = r % 32; p0_transpose_item(F.P.w_b + (size_t)l * DB * D, D, 32 * nb, 64 * kb, (bf16_t*)(wl + WO_WAB), 32 * nb, 512, scr, F.lane); continue; } r -= I_Y;
        if (r < I_Y) { const int kb = r / 32, nb = r % 32; p0_transpose_item(F.P.w_c + (size_t)l * DC * D, D, 32 * nb, 64 * kb, (bf16_t*)(wl + WO_WC), 32 * nb, 0, scr, F.lane); continue; } r -= I_Y;
        { const int kb = r / 32, nb = r % 32; p0_transpose_item(F.P.w_out + (size_t)l * D * D, D, 32 * nb, 64 * kb, (bf16_t*)(wl + WO_WO), 32 * nb, 0, scr, F.lane); }
    }
    bf16_t* WSB = (bf16_t*)(F.P.ws + WS_WSB);
    for (int i = (int)blockIdx.x * 512 + F.tid; i < NL * NG * CHK * CHK; i += F.G * 512) { const int s = i & 127, t = (i >> 7) & 127; WSB[i] = s <= t ? f2bf(F.P.w_s[i]) : (bf16_t)0; }
}
__device__ __forceinline__ void p0_ln(Frame& F, int l, const float* xin) {
    LAS float* wf = (LAS float*)(F.lds + RING_OFF);
    const float* g = F.P.norm_g + (size_t)l * D; const float* win = F.P.w_in + (size_t)l * D * NIN;
    __syncthreads();
    for (int i = F.tid; i < D * 8; i += 512) { const int k = i >> 3, e = i & 7; wf[i] = g[k] * win[(size_t)k * NIN + OC_F + e]; }
    __syncthreads();
    const int gw = F.vcu * NWAVES + F.wave, NGW = F.G * NWAVES;
    bf16_t* H = (bf16_t*)(F.P.ws + WS_H); float* LOGF = (float*)(F.P.ws + WS_LOGF);
    f32x4 gv[4];
#pragma unroll
    for (int j = 0; j < 4; ++j) gv[j] = ((const f32x4*)g)[64 * j + F.lane];
    for (int m = gw; m < M; m += NGW) {
        const GAS f32x4* xr = (const GAS f32x4*)(xin + (size_t)m * D) + F.lane;
        f32x4 v[4]; float ss = 0.f;
#pragma unroll
        for (int j = 0; j < 4; ++j) { v[j] = xr[64 * j]; ss += (v[j].x * v[j].x + v[j].y * v[j].y) + (v[j].z * v[j].z + v[j].w * v[j].w); }
        ss = wave_sum(ss);
        const float r = rsqrtf(ss * (1.f / D) + EPS);
        float f[8] = {0.f, 0.f, 0.f, 0.f, 0.f, 0.f, 0.f, 0.f};
        GAS unsigned long long* o8 = (GAS unsigned long long*)(H + (size_t)m * D) + F.lane;
#pragma unroll
        for (int j = 0; j < 4; ++j) {
            const f32x4 hv = v[j] * r * gv[j];
            o8[64 * j] = (unsigned long long)pk2(hv.x, hv.y) | ((unsigned long long)pk2(hv.z, hv.w) << 32);
#pragma unroll
            for (int i = 0; i < 4; ++i) { const LAS f32x4* w4 = (const LAS f32x4*)(wf + (256 * j + 4 * F.lane + i) * 8); const f32x4 wa = w4[0], wb = w4[1]; const float xv = v[j][i];
                f[0] += xv * wa.x; f[1] += xv * wa.y; f[2] += xv * wa.z; f[3] += xv * wa.w; f[4] += xv * wb.x; f[5] += xv * wb.y; f[6] += xv * wb.z; f[7] += xv * wb.w; }
        }
#pragma unroll
        for (int e = 0; e < 8; ++e) f[e] = wave_sum(f[e]);
        if (F.lane < 8) { float z = 0.f;
#pragma unroll
            for (int e = 0; e < 8; ++e) if (F.lane == e) z = f[e];
            z = z * r + F.P.b_f[l * NH + F.lane];
            LOGF[(size_t)m * 8 + F.lane] = fminf(z, 0.f) - log1pf(expf(-fabsf(z))); }
    }
    __syncthreads();
}
__device__ __forceinline__ void p1_scan(Frame& F, int bh) {
    LAS float* sh = (LAS float*)(F.lds + RING_OFF);
    const int b = bh / NH, h = bh % NH, t0 = F.tid * 8;
    const float* lf = (const float*)(F.P.ws + WS_LOGF) + ((size_t)b * SEQ + t0) * 8 + h;
    float c[8]; float run = 0.f;
#pragma unroll
    for (int i = 0; i < 8; ++i) { run += lf[i * 8]; c[i] = run; }
    float inc = run;
#pragma unroll
    for (int o = 1; o < 64; o <<= 1) { const float n = __shfl_up(inc, o); if (F.lane >= o) inc += n; }
    if (F.lane == 63) sh[F.wave] = inc;
    __syncthreads();
    float base = inc - run;
    for (int w = 0; w < F.wave; ++w) base += sh[w];
    float* cs = (float*)(F.P.ws + WS_CS) + (size_t)bh * SEQ + t0;
    *(f32x4*)cs = (f32x4){(base + c[0]) * LOG2E, (base + c[1]) * LOG2E, (base + c[2]) * LOG2E, (base + c[3]) * LOG2E};
    *(f32x4*)(cs + 4) = (f32x4){(base + c[4]) * LOG2E, (base + c[5]) * LOG2E, (base + c[6]) * LOG2E, (base + c[7]) * LOG2E};
    __syncthreads();
    LAS float* c2s = sh + 16;
#pragma unroll
    for (int i = 0; i < 8; ++i) c2s[t0 + i] = (base + c[i]) * LOG2E;
    __syncthreads();
    if (F.tid < SEQ / 256) { const int qb = F.tid, nt = 4 * qb + 4; const float cq = c2s[256 * qb]; int lo = 0, hi = nt - 4;
        while (lo < hi) { const int mid = (lo + hi) >> 1; if (cq - c2s[64 * mid + 63] >= -SKIP_L2) hi = mid; else lo = mid + 1; }
        ((int*)(F.P.ws + WS_TS))[bh * 16 + qb] = lo & ~1; }
    __syncthreads();
}


#include <hip/hip_bf16.h>
namespace attn_body {
using bf16=__hip_bfloat16;
using s16x4=__attribute__((ext_vector_type(4)))short;
using f32x16=__attribute__((ext_vector_type(16)))float;
constexpr int NHEAD=NH,D=64,DM=1024;
constexpr int NW=8,QBLK=32,QB=QBLK*NW,KVBLK=64,NQB=SEQ/QB;
__device__ __forceinline__ int crow(int r,int hi){return (r&3)+8*(r>>2)+4*hi;}
#define SBAR() __builtin_amdgcn_sched_barrier(0)
__device__ __forceinline__ void cmask(f32x16&p0,f32x16&p1,int jb,int qrel,int hi){
  const float NEG=-INFINITY; int kb=64*jb+4*hi;
  #pragma unroll
  for(int r=0;r<16;++r){int kv=kb+(r&3)+8*(r>>2); if(kv>qrel)p0[r]=NEG; if(kv+32>qrel)p1[r]=NEG;}
}
constexpr int NSLOT=3, SLOTB=8192;
constexpr int LDS_K=0, LDS_V=NSLOT*SLOTB, LDS_WS=2*NSLOT*SLOTB, LDS_OST=LDS_WS+NW*64*4, LDS_C2=LDS_OST+NW*4096, LDS_BYTES=LDS_C2+SEQ*4+512;
__device__ __forceinline__ void glds16(const void*gsrc,unsigned lds_dst){unsigned keep;
  asm volatile("s_mov_b32 %0, m0\n\ts_mov_b32 m0, %2\n\ts_nop 0\n\tglobal_load_lds_dwordx4 %1, off\n\ts_mov_b32 m0, %0":"=&s"(keep):"v"(gsrc),"s"(lds_dst):"memory");}
__device__ __forceinline__ float max3f(float a,float b,float c){float r;asm("v_max3_f32 %0, %1, %2, %3":"=v"(r):"v"(a),"v"(b),"v"(c));return r;}
__device__ __forceinline__ float max2f(float a,float b){float r;asm("v_max_f32_e32 %0, %1, %2":"=v"(r):"v"(a),"v"(b));return r;}
__device__ __forceinline__ float fadd_s(float a,float b){float r;asm("v_add_f32_e32 %0, %1, %2":"=v"(r):"v"(a),"v"(b));return r;}
__device__ __forceinline__ float fsub_s(float a,float b){float r;asm("v_sub_f32_e32 %0, %1, %2":"=v"(r):"v"(a),"v"(b));return r;}
typedef float f32x2_t __attribute__((ext_vector_type(2))); typedef __bf16 bf16x2_t __attribute__((ext_vector_type(2)));
__device__ __forceinline__ unsigned cvtpk_s(float lo,float hi){f32x2_t v={lo,hi};bf16x2_t b=__builtin_convertvector(v,bf16x2_t);return __builtin_bit_cast(unsigned,b);}
#define WAIT_BAR(N) asm volatile("s_waitcnt vmcnt(" #N ") lgkmcnt(0)\n\ts_barrier":::"memory")
__device__ __forceinline__ void split3(float x,unsigned&h,unsigned&m,unsigned&l){
  const unsigned u=__float_as_uint(x)&0xffff0000u; const float r1=x-__uint_as_float(u);
  const unsigned u1=__float_as_uint(r1)&0xffff0000u; const float r2=r1-__uint_as_float(u1);
  h=u>>16; m=u1>>16; l=__float_as_uint(r2)>>16; }
__device__ __forceinline__ bf16x8 make_qx(float base,int hi){ unsigned h,m,l; split3(base,h,m,l); u32x4 w; w.x=h|(m<<16); w.y=l|0x3f800000u; w.z=0x3f803f80u; w.w=0u; if(hi){w.x=0u;w.y=0u;w.z=0u;} return __builtin_bit_cast(bf16x8,w); }
__device__ __forceinline__ bf16x8 make_kx(float ck,int hi){ unsigned h,m,l; split3(-ck,h,m,l); u32x4 w; w.x=0x3f803f80u; w.y=0x3f80u|(h<<16); w.z=m|(l<<16); w.w=0u; if(hi){w.x=0u;w.y=0u;w.z=0u;} return __builtin_bit_cast(bf16x8,w); }

__device__ __forceinline__ void qkt(f32x16&p0,f32x16&p1,const char*Kslot,const bf16x8*qr,bf16x8 qx,bf16x8 kx0,bf16x8 kx1,int r32,int hi){
  const char*kb=Kslot+hi*1024+r32*16; const f32x16 z=f32x16{};
  p0=__builtin_amdgcn_mfma_f32_32x32x16_bf16(kx0,qx,z,0,0,0);p1=__builtin_amdgcn_mfma_f32_32x32x16_bf16(kx1,qx,z,0,0,0);
  #pragma unroll
  for(int d0=0;d0<4;++d0){
    const bf16x8 b0=*reinterpret_cast<const bf16x8*>(kb+d0*2048);
    const bf16x8 b1=*reinterpret_cast<const bf16x8*>(kb+d0*2048+512);
    p0=__builtin_amdgcn_mfma_f32_32x32x16_bf16(b0,qr[d0],p0,0,0,0);p1=__builtin_amdgcn_mfma_f32_32x32x16_bf16(b1,qr[d0],p1,0,0,0);}
}
typedef __attribute__((address_space(3))) const char* lds_cptr;
typedef short v4i16_t __attribute__((ext_vector_type(4)));
__device__ __forceinline__ void kload8(bf16x8*kf,lds_cptr kp){
  kf[0]=*(const __attribute__((address_space(3))) bf16x8*)(kp);      kf[1]=*(const __attribute__((address_space(3))) bf16x8*)(kp+512);
  kf[2]=*(const __attribute__((address_space(3))) bf16x8*)(kp+2048); kf[3]=*(const __attribute__((address_space(3))) bf16x8*)(kp+2560);
  kf[4]=*(const __attribute__((address_space(3))) bf16x8*)(kp+4096); kf[5]=*(const __attribute__((address_space(3))) bf16x8*)(kp+4608);
  kf[6]=*(const __attribute__((address_space(3))) bf16x8*)(kp+6144); kf[7]=*(const __attribute__((address_space(3))) bf16x8*)(kp+6656);
}
__device__ __forceinline__ void kload2(bf16x8*kf,lds_cptr kp,int j){ kf[2*j]=*(const __attribute__((address_space(3))) bf16x8*)(kp+j*2048); kf[2*j+1]=*(const __attribute__((address_space(3))) bf16x8*)(kp+j*2048+512); }
__device__ __forceinline__ s16x4 vtr(lds_cptr p){ return __builtin_bit_cast(s16x4,__builtin_amdgcn_ds_read_tr16_b64_v4i16((__attribute__((address_space(3))) v4i16_t*)p)); }
__device__ __forceinline__ float rowmax(const f32x16&p0,const f32x16&p1){
  float a=max3f(p0[0],p0[1],p1[0]),b=max3f(p0[2],p0[3],p1[1]);a=max3f(a,p1[2],p1[3]);
  #pragma unroll
  for(int r=4;r<16;r+=4){a=max3f(a,p0[r],p0[r+1]);b=max3f(b,p0[r+2],p0[r+3]);a=max3f(a,p1[r],p1[r+1]);b=max3f(b,p1[r+2],p1[r+3]);}
  const float m=max2f(a,b);
  auto rr=__builtin_amdgcn_permlane32_swap(__float_as_uint(m),__float_as_uint(m),false,false);
  return max2f(__uint_as_float(rr[0]),__uint_as_float(rr[1]));
}
__device__ __forceinline__ void pv(f32x16*o,int vb,bf16x8 pa0,bf16x8 pa1,bf16x8 pa2,bf16x8 pa3){
  #pragma unroll
  for(int d0=0;d0<2;++d0){s16x4 lo[4],hi[4];
    #pragma unroll
    for(int ks=0;ks<4;++ks){
      asm volatile("ds_read_b64_tr_b16 %0,%1 offset:%c2":"=&v"(lo[ks]):"v"(vb),"i"(d0*4096+ks*1024):"memory");
      asm volatile("ds_read_b64_tr_b16 %0,%1 offset:%c2":"=&v"(hi[ks]):"v"(vb),"i"(d0*4096+ks*1024+512):"memory");}
    asm volatile("s_waitcnt lgkmcnt(0)":::"memory");SBAR();
    #define PK(k) (bf16x8){lo[k][0],lo[k][1],lo[k][2],lo[k][3],hi[k][0],hi[k][1],hi[k][2],hi[k][3]}
    o[d0]=__builtin_amdgcn_mfma_f32_32x32x16_bf16(pa0,PK(0),o[d0],0,0,0);
    o[d0]=__builtin_amdgcn_mfma_f32_32x32x16_bf16(pa1,PK(1),o[d0],0,0,0);
    o[d0]=__builtin_amdgcn_mfma_f32_32x32x16_bf16(pa2,PK(2),o[d0],0,0,0);
    o[d0]=__builtin_amdgcn_mfma_f32_32x32x16_bf16(pa3,PK(3),o[d0],0,0,0);
    #undef PK
  }
}
#define ATTN_STORE16(p,v) (*(u32x4*)(p)=(v))
template<int THRL> __device__ __forceinline__ void attn_unit(int b,int h,int qb,const bf16*Q,const bf16*__restrict__ K,const bf16*__restrict__ V,const bf16*__restrict__ CZ,bf16*O,const float*__restrict__ c2g,int ts,float ub,char*shm){
  int tid=threadIdx.x; asm volatile("":"+v"(tid));
  const int lane=tid&63,r32=lane&31,hi=lane>>5; const int wid=__builtin_amdgcn_readfirstlane(tid>>6);
  const long rowbase=(long)b*SEQ; const int q0=qb*QB;
  const bf16*Qw=Q+(rowbase+q0+wid*QBLK)*DM+h*D;
  const bf16*Kh=K+(rowbase+(long)ts*KVBLK)*DM+h*D,*Vh=V+(rowbase+(long)ts*KVBLK)*DM+h*D;
  const unsigned lds0=(unsigned)(uintptr_t)shm;
  float*wsf=(float*)(shm+LDS_WS)+wid*64;
  float*c2l=(float*)(shm+LDS_C2);
  { const int kb0=ts*KVBLK; for(int i=tid*4;i<q0+QB-kb0;i+=NW*64*4)*(f32x4*)(c2l+i)=*(const f32x4*)(c2g+kb0+i); }
  const bf16*ksrc=Kh+(long)lane*DM+wid*8;
  const bf16*vsrc=Vh+(long)(16*(wid&3)+(lane>>2))*DM+(wid>>2)*32+(lane&3)*8;
  const unsigned kdst=lds0+LDS_K+wid*1024, vdst=lds0+LDS_V+wid*1024;
  #define DMA_K(t,slot) glds16(ksrc+(long)(t)*KVBLK*DM,(unsigned)__builtin_amdgcn_readfirstlane(kdst+(slot)))
  #define DMA_V(t,slot) glds16(vsrc+(long)(t)*KVBLK*DM,(unsigned)__builtin_amdgcn_readfirstlane(vdst+(slot)))
  const int vb0=(int)(lds0+LDS_V)+((lane>>4)&1)*32+(lane&3)*8+(4*hi+((lane&15)>>2))*64;
  const char*Kbase=shm+LDS_K; bf16x8 kf[8];
  const lds_cptr shm3=(lds_cptr)shm; const lds_cptr kp0=shm3+LDS_K+hi*1024+r32*16; const lds_cptr vp0=shm3+LDS_V+((lane>>4)&1)*32+(lane&3)*8+(4*hi+((lane&15)>>2))*64;
  const int NT=(q0+QB)/KVBLK-ts;
  DMA_K(0,0);DMA_V(0,0);DMA_K(1,SLOTB);
  bf16x8 qr[4];
  #pragma unroll
  for(int d0=0;d0<4;++d0)qr[d0]=*reinterpret_cast<const bf16x8*>(&Qw[(long)r32*DM+d0*16+hi*8]);
    float mhat=ub,l_reg=0.f;f32x16 o[2];o[0]=f32x16{};o[1]=f32x16{};
  const int qrel=wid*QBLK+r32;
  #define CMASK(P0,P1,t) do{int jb_=(t)-(NT-4); if(jb_>=0)cmask(P0,P1,jb_,qrel,hi);}while(0)
  bool resc=false;
  bf16x8 qx; float cq2;
  #define START(P0,P1) do{ resc=false; \
    _Pragma("unroll") for(int r=0;r<16;++r)P0[r]=__builtin_amdgcn_exp2f(P0[r]); }while(0)
  #define RESC() do{ if(resc){ asm volatile("s_waitcnt lgkmcnt(0)":::"memory"); \
      _Pragma("unroll") for(int d_=0;d_<2;++d_) _Pragma("unroll") for(int r=0;r<16;++r)o[d_][r]*=wsf[crow(r,hi)]; } }while(0)
  f32x16 pA0,pA1,pB0,pB1;
  int sl_prev=0,sl_cur=0,sl_next=SLOTB;
  #define ROT() do{sl_prev=sl_cur;sl_cur=sl_next;sl_next=(sl_next==(NSLOT-1)*SLOTB)?0:sl_next+SLOTB;}while(0)
  DMA_K(2,2*SLOTB);
  WAIT_BAR(3);
  cq2=c2l[q0+qrel-ts*KVBLK]; qx=make_qx(cq2-mhat,hi);
  float ck0=c2l[r32],ck1=c2l[32+r32];
  { const bf16x8 kx0=make_kx(ck0,hi),kx1=make_kx(ck1,hi);
    qkt(pA0,pA1,Kbase,qr,qx,kx0,kx1,r32,hi); }
  asm volatile("s_nop 15\n\ts_nop 7":"+v"(pA0),"+v"(pA1));CMASK(pA0,pA1,0);
  ck0=c2l[64+r32];ck1=c2l[96+r32];
  START(pA0,pA1);
  _Pragma("unroll") for(int r=0;r<16;++r)pA1[r]=__builtin_amdgcn_exp2f(pA1[r]);
  WAIT_BAR(0);
  DMA_K(3,0);DMA_V(1,SLOTB);
  ROT();
  kload8(kf,kp0+sl_cur);
  WAIT_BAR(2);
  s16x4 vlo[8],vhi[8]; u32x4 pw0,pw1,pw2,pw3;
  #define PKW(P,B) cvtpk_s(P[B],P[B+1])
  #define PAF(k) __builtin_bit_cast(bf16x8,pw##k)
  #define VFR(i) (bf16x8){vlo[i][0],vlo[i][1],vlo[i][2],vlo[i][3],vhi[i][0],vhi[i][1],vhi[i][2],vhi[i][3]}
  #define PIN(x) asm volatile("":"+v"(x))
  #define MX3(a,b,c) __builtin_fmaxf(__builtin_fmaxf((a),(b)),(c))
  #define GAPA(MF,A0,A1,A2,A3,W0,W1,PW) do{ MF; sacc+=A0; sacc+=A1; sacc+=A2; sacc+=A3; PIN(sacc); W0; W1; PIN(PW); SBAR(); }while(0)
  #define EX(v) __builtin_amdgcn_exp2f(v)
  #define GAPB(MF,X,B) do{ MF; X[B]=EX(X[B]); X[B+1]=EX(X[B+1]); X[B+2]=EX(X[B+2]); X[B+3]=EX(X[B+3]); PIN(X); SBAR(); }while(0)
  #define VRD(i) do{ vlo[i]=vtr(vp_+(((i)>>2)*4096+((i)&3)*1024)); vhi[i]=vtr(vp_+(((i)>>2)*4096+((i)&3)*1024+512)); }while(0)
  #define KRD(G,j) do{ if(G){ kload2(kf,kp0+sl_next,j); SBAR(); } }while(0)
  #define STEP(C0,C1,P0,P1,t,GK,GV,GL) do{ SBAR(); \
    const lds_cptr vp_=vp0+sl_prev; \
    { const bf16x8 kx0_=make_kx(ck0,hi),kx1_=make_kx(ck1,hi); const f32x16 z_=f32x16{}; \
      C0=__builtin_amdgcn_mfma_f32_32x32x16_bf16(kx0_,qx,z_,0,0,0); C1=__builtin_amdgcn_mfma_f32_32x32x16_bf16(kx1_,qx,z_,0,0,0); } SBAR(); \
    VRD(0); SBAR(); float sacc=(P0[0]+P0[1]); \
    GAPA(C0=__builtin_amdgcn_mfma_f32_32x32x16_bf16(kf[0],qr[0],C0,0,0,0), P0[2],P0[3],P0[4],P0[5],     pw0[0]=PKW(P0,0), pw0[1]=PKW(P0,2), pw0); \
    VRD(4); SBAR(); GAPA(C1=__builtin_amdgcn_mfma_f32_32x32x16_bf16(kf[1],qr[0],C1,0,0,0), P0[6],P0[7],P0[8],P0[9],     pw0[2]=PKW(P0,4), pw0[3]=PKW(P0,6), pw0); \
    VRD(1); SBAR(); GAPA(C0=__builtin_amdgcn_mfma_f32_32x32x16_bf16(kf[2],qr[1],C0,0,0,0),   P0[10],P0[11],P0[12],P0[13], pw1[0]=PKW(P0,8), pw1[1]=PKW(P0,10), pw1); \
    VRD(5); SBAR(); GAPA(C1=__builtin_amdgcn_mfma_f32_32x32x16_bf16(kf[3],qr[1],C1,0,0,0),   P0[14],P0[15],P1[0],P1[1],   pw1[2]=PKW(P0,12),pw1[3]=PKW(P0,14), pw1); \
    VRD(2); SBAR(); GAPA(C0=__builtin_amdgcn_mfma_f32_32x32x16_bf16(kf[4],qr[2],C0,0,0,0),   P1[2],P1[3],P1[4],P1[5],     pw2[0]=PKW(P1,0), pw2[1]=PKW(P1,2), pw2); \
    VRD(6); SBAR(); GAPA(C1=__builtin_amdgcn_mfma_f32_32x32x16_bf16(kf[5],qr[2],C1,0,0,0),   P1[6],P1[7],P1[8],P1[9],     pw2[2]=PKW(P1,4), pw2[3]=PKW(P1,6), pw2); \
    VRD(3); SBAR(); GAPA(C0=__builtin_amdgcn_mfma_f32_32x32x16_bf16(kf[6],qr[3],C0,0,0,0),   P1[10],P1[11],P1[12],P1[13], pw3[0]=PKW(P1,8), pw3[1]=PKW(P1,10), pw3); \
    VRD(7); SBAR(); GAPA(C1=__builtin_amdgcn_mfma_f32_32x32x16_bf16(kf[7],qr[3],C1,0,0,0),   P1[14],P1[15],0.f,0.f,       pw3[2]=PKW(P1,12),pw3[3]=PKW(P1,14), pw3); \
    l_reg+=sacc; \
    if(GK){DMA_K((t)+3,sl_cur);} if(GV){DMA_V((t)+1,sl_next);} \
    if(GL){ ck0=c2l[64*((t)+1)+r32]; ck1=c2l[64*((t)+1)+32+r32]; } \
    CMASK(C0,C1,t); \
    { float a=MX3(C0[0],C0[1],C1[0]),b=MX3(C0[2],C0[3],C1[1]); a=MX3(a,C1[2],C1[3]); \
      _Pragma("unroll") for(int r=4;r<16;r+=4){a=MX3(a,C0[r],C0[r+1]);b=MX3(b,C0[r+2],C0[r+3]);a=MX3(a,C1[r],C1[r+1]);b=MX3(b,C1[r+2],C1[r+3]);} \
      float rm=__builtin_fmaxf(a,b); { auto rr=__builtin_amdgcn_permlane32_swap(__float_as_uint(rm),__float_as_uint(rm),false,false); rm=__builtin_fmaxf(__uint_as_float(rr[0]),__uint_as_float(rr[1])); } \
      resc=false; \
      if(__builtin_expect(__any(rm>(float)THRL),0)){ const float dl=__builtin_fmaxf(rm,0.f); mhat+=dl; \
        _Pragma("unroll") for(int r=0;r<16;++r){C0[r]-=dl;C1[r]-=dl;} \
        qx=make_qx(cq2-mhat,hi); asm volatile("":"+v"(qx)); \
        const float f=__builtin_amdgcn_exp2f(-dl); l_reg*=f; if(hi==0)wsf[r32]=f; resc=true; } } \
    SBAR(); \
    GAPB(o[0]=__builtin_amdgcn_mfma_f32_32x32x16_bf16(PAF(0),VFR(0),o[0],0,0,0), C0,0); \
    GAPB(o[1]=__builtin_amdgcn_mfma_f32_32x32x16_bf16(PAF(0),VFR(4),o[1],0,0,0), C0,4); \
    KRD(GL,0); GAPB(o[0]=__builtin_amdgcn_mfma_f32_32x32x16_bf16(PAF(1),VFR(1),o[0],0,0,0), C0,8); \
    KRD(GL,1); GAPB(o[1]=__builtin_amdgcn_mfma_f32_32x32x16_bf16(PAF(1),VFR(5),o[1],0,0,0), C0,12); \
    KRD(GL,2); GAPB(o[0]=__builtin_amdgcn_mfma_f32_32x32x16_bf16(PAF(2),VFR(2),o[0],0,0,0), C1,0); \
    KRD(GL,3); GAPB(o[1]=__builtin_amdgcn_mfma_f32_32x32x16_bf16(PAF(2),VFR(6),o[1],0,0,0), C1,4); \
    GAPB(o[0]=__builtin_amdgcn_mfma_f32_32x32x16_bf16(PAF(3),VFR(3),o[0],0,0,0), C1,8); \
    GAPB(o[1]=__builtin_amdgcn_mfma_f32_32x32x16_bf16(PAF(3),VFR(7),o[1],0,0,0), C1,12); \
    }while(0)
  int t=1;
  #undef CMASK
  #define CMASK(P0,P1,t) do{}while(0)
  for(;t+5<NT;t+=2){
    STEP(pB0,pB1,pA0,pA1,t,true,true,true);     WAIT_BAR(2); RESC(); ROT();
    STEP(pA0,pA1,pB0,pB1,t+1,true,true,true);   WAIT_BAR(2); RESC(); ROT();
  }
  #undef CMASK
  #define CMASK(P0,P1,t) do{int jb_=(t)-(NT-4); if(jb_>=0)cmask(P0,P1,jb_,qrel,hi);}while(0)
  #define ENDW(tt) do{ if((tt)+3<NT){WAIT_BAR(2);} else if((tt)+2<NT){WAIT_BAR(1);} else {WAIT_BAR(0);} }while(0)
  for(;t+1<NT;t+=2){
    STEP(pB0,pB1,pA0,pA1,t,(t+3<NT),(t+1<NT),(t+1<NT));       ENDW(t);   RESC(); ROT();
    STEP(pA0,pA1,pB0,pB1,t+1,(t+4<NT),(t+2<NT),(t+2<NT));     ENDW(t+1); RESC(); ROT();
  }
  STEP(pB0,pB1,pA0,pA1,NT-1,false,false,false); RESC();
  { float sacc=pB0[0]+pB0[1]; _Pragma("unroll") for(int r=2;r<16;++r)sacc+=pB0[r]; _Pragma("unroll") for(int r=0;r<16;++r)sacc+=pB1[r]; l_reg+=sacc;
    pw0=(u32x4){PKW(pB0,0),PKW(pB0,2),PKW(pB0,4),PKW(pB0,6)};pw1=(u32x4){PKW(pB0,8),PKW(pB0,10),PKW(pB0,12),PKW(pB0,14)};pw2=(u32x4){PKW(pB1,0),PKW(pB1,2),PKW(pB1,4),PKW(pB1,6)};pw3=(u32x4){PKW(pB1,8),PKW(pB1,10),PKW(pB1,12),PKW(pB1,14)};
    SBAR(); pv(o,vb0+sl_cur,PAF(0),PAF(1),PAF(2),PAF(3)); }
  #undef PKW
  #undef PAF
  #undef VFR
  #undef PIN
  #undef MX3
  #undef GAPA
  #undef GAPB
  #undef EX
  #undef VRD
  #undef KRD
  #undef STEP
  #undef ENDW
  {auto rr=__builtin_amdgcn_permlane32_swap(__float_as_uint(l_reg),__float_as_uint(l_reg),false,false);l_reg=__uint_as_float(rr[0])+__uint_as_float(rr[1]);}
  if(hi==0)wsf[32+r32]=l_reg;asm volatile("s_waitcnt lgkmcnt(0)":::"memory");
  bf16*Ow=O+(rowbase+q0+wid*QBLK)*DM+h*D;
  const unsigned short*Cw=(const unsigned short*)(CZ+(rowbase+q0+wid*QBLK)*DM+h*D);
  { bf16*stg=(bf16*)(shm+LDS_OST)+wid*2048;
    #pragma unroll
    for(int r=0;r<16;++r){const int orow=crow(r,hi); const float rl=__builtin_amdgcn_rcpf(wsf[32+orow]);
      #pragma unroll
      for(int d0=0;d0<2;++d0){ const float cz=__uint_as_float((unsigned)Cw[(long)orow*DM+d0*32+r32]<<16); stg[orow*64+d0*32+r32]=__float2bfloat16(o[d0][r]*rl*cz);} }
    asm volatile("s_waitcnt lgkmcnt(0)":::"memory");
    #pragma unroll
    for(int i=0;i<4;++i){const int row=i*8+(lane>>3),ch=lane&7; const u32x4 v=*(const u32x4*)(stg+row*64+ch*8); ATTN_STORE16(Ow+(long)row*DM+ch*8,v);} }
  asm volatile("s_waitcnt lgkmcnt(0)\n\ts_barrier":::"memory");
  #undef DMA_K
  #undef DMA_V
  #undef CMASK
  #undef START
  #undef RESC
  #undef ROT
}
#undef SBAR
#undef WAIT_BAR
}

typedef float f32x2 __attribute__((ext_vector_type(2)));
__device__ __forceinline__ void p2_conv(Frame& F, int l, int unit, bf16_t* outb) {
    const int tid = F.tid, cp = tid & 255, th = tid >> 8, lane = F.lane, wq = F.wave & 3;
    const size_t row0 = (size_t)unit * 64; const int tseq0 = (int)(row0 % SEQ);
    const bf16_t* AG = (const bf16_t*)(F.P.ws + WS_B3); bf16_t* B0 = (bf16_t*)(F.P.ws + WS_B0);
    const float* cw = F.P.conv_w + (size_t)l * CW * DA + 2 * cp;
    f32x2 w[CW];
#pragma unroll
    for (int j = 0; j < CW; ++j) w[j] = *(const f32x2*)(cw + j * DA);
    const f32x2 cb = *(const f32x2*)(F.P.conv_b + l * DA + 2 * cp), gg = *(const f32x2*)(F.P.cn_g + l * DA + 2 * cp), be = *(const f32x2*)(F.P.cn_b + l * DA + 2 * cp);
    LAS float* red = (LAS float*)(F.lds + RING_OFF);
    for (int sb = 0; sb < 4; ++sb) {
        const int tl0 = th * 32 + sb * 8;
        f32x2 in[38];
#pragma unroll
        for (int i = 0; i < 38; ++i) { const int tr = tl0 - (CW - 1) + i; const bool valid = tseq0 + tr >= 0;
            const unsigned wv = valid ? *(const unsigned*)(AG + (size_t)((long)row0 + (valid ? tr : 0)) * 1024 + 2 * cp) : 0u;
            in[i] = (f32x2){__uint_as_float(wv << 16), __uint_as_float(wv & 0xffff0000u)}; }
        f32x2 out[8];
#pragma unroll
        for (int o = 0; o < 8; ++o) out[o] = cb;
#pragma unroll
        for (int j = 0; j < CW; ++j)
#pragma unroll
            for (int o = 0; o < 8; ++o) out[o] += w[j] * in[o + j];
        LAS float* rp = red + (sb & 1) * 256 + th * 128;
#pragma unroll
        for (int o = 0; o < 8; ++o) { float s1 = out[o].x + out[o].y, s2 = out[o].x * out[o].x + out[o].y * out[o].y; s1 = wave_sum(s1); s2 = wave_sum(s2);
            if (lane == 0) { rp[(o * 4 + wq) * 2] = s1; rp[(o * 4 + wq) * 2 + 1] = s2; } }
        __syncthreads();
#pragma unroll
        for (int o = 0; o < 8; ++o) { const LAS f32x4* q = (const LAS f32x4*)(rp + o * 8); const f32x4 a = q[0], b = q[1];
            const float mu = ((a.x + a.z) + (b.x + b.z)) * (1.f / DA), ex2 = ((a.y + a.w) + (b.y + b.w)) * (1.f / DA); const float rstd = rsqrtf(fmaxf(ex2 - mu * mu, 0.f) + EPS);
            f32x2 y = (out[o] - mu) * rstd * gg + be; y.x = y.x * fsigm(y.x); y.y = y.y * fsigm(y.y);
            const size_t ao = (row0 + tl0 + o) * 1024 + 2 * cp; const unsigned az = *(const unsigned*)(B0 + ao);
            *(unsigned*)(outb + ao) = cvt_pk_bf16(y.x * __uint_as_float(az << 16), y.y * __uint_as_float(az & 0xffff0000u)); }
    }
    __syncthreads();
}
__device__ __forceinline__ void p2_gmlp(Frame& F, int l, int unit, bf16_t* outb) {
    constexpr int VTP = 136;
    const int tid = F.tid, lane = F.lane, w = F.wave, fr = lane & 15, fq = lane >> 4, ch = unit >> 2, g = unit & 3; const size_t row0 = (size_t)ch * CHK;
    LAS bf16_t* vt = (LAS bf16_t*)(F.lds + RING_OFF);
    const bf16_t* V = (const bf16_t*)(F.P.ws + WS_B3) + 512 + 128 * g; const bf16_t* U = (const bf16_t*)(F.P.ws + WS_B0) + 512 + 128 * g; const bf16_t* BZ = (const bf16_t*)(F.P.ws + WS_B4) + 128 * g;
    const float* vss = (const float*)(F.P.ws + WS_VSS); const float* gn = F.P.gn_g + l * DB + 128 * g;
    for (int it = tid; it < 2048; it += 512) { const int s = it & 127, c8 = (it >> 7) * 8;
        const u32x4 raw = *(const u32x4*)(V + (row0 + s) * 1024 + c8); const f32x4 qa = *(const f32x4*)(vss + (row0 + s) * 8), qb = *(const f32x4*)(vss + (row0 + s) * 8 + 4);
        const float ss = ((qa.x + qa.y) + (qa.z + qa.w)) + ((qb.x + qb.y) + (qb.z + qb.w)); const float rv = rsqrtf(ss * (1.f / DB) + EPS);
        f32x4 v0, v1; unpack8(raw, v0, v1); const f32x4 g0 = *(const f32x4*)(gn + c8), g1 = *(const f32x4*)(gn + c8 + 4);
        v0 = v0 * rv * g0; v1 = v1 * rv * g1;
#pragma unroll
        for (int e = 0; e < 4; ++e) { vt[(c8 + e) * VTP + s] = f2bf(v0[e]); vt[(c8 + 4 + e) * VTP + s] = f2bf(v1[e]); } }
    __syncthreads();
    f32x4 acc[8];
#pragma unroll
    for (int n = 0; n < 8; ++n) acc[n] = (f32x4){0.f, 0.f, 0.f, 0.f};
    const bf16_t* Wg = (const bf16_t*)(F.P.ws + WS_WSB) + ((size_t)(l * NG + g) * CHK + 16 * w + fr) * CHK + 8 * fq;
#pragma unroll
    for (int ks = 0; ks < 4; ++ks) {
        const bf16x8 wf = *(const bf16x8*)(Wg + 32 * ks);
#pragma unroll
        for (int n = 0; n < 8; ++n) { const bf16x8 vf = *(const LAS bf16x8*)(vt + (16 * n + fr) * VTP + 32 * ks + 8 * fq); acc[n] = __builtin_amdgcn_mfma_f32_16x16x32_bf16(vf, wf, acc[n], 0, 0, 0); }
    }
    const size_t t = row0 + 16 * w + fr; const float bs = F.P.b_s[(size_t)(l * NG + g) * CHK + 16 * w + fr];
#pragma unroll
    for (int n = 0; n < 8; ++n) { const int c = 16 * n + 4 * fq;
        const unsigned long long* up = (const unsigned long long*)(U + t * 1024 + c); const unsigned long long uu = *up, zz = *(const unsigned long long*)(BZ + t * 512 + c);
        const unsigned u0 = (unsigned)uu, u1 = (unsigned)(uu >> 32), z0 = (unsigned)zz, z1 = (unsigned)(zz >> 32);
        const float o0 = __uint_as_float(u0 << 16) * (acc[n][0] + bs) * __uint_as_float(z0 << 16), o1 = __uint_as_float(u0 & 0xffff0000u) * (acc[n][1] + bs) * __uint_as_float(z0 & 0xffff0000u);
        const float o2 = __uint_as_float(u1 << 16) * (acc[n][2] + bs) * __uint_as_float(z1 << 16), o3 = __uint_as_float(u1 & 0xffff0000u) * (acc[n][3] + bs) * __uint_as_float(z1 & 0xffff0000u);
        *(unsigned long long*)(outb + 512 + 128 * g + t * 1024 + c) = (unsigned long long)cvt_pk_bf16(o0, o1) | ((unsigned long long)cvt_pk_bf16(o2, o3) << 32); }
    __syncthreads();
}

__global__ void __launch_bounds__(NWAVES * 64, 2) mk_fwd(Args args) {
    extern __shared__ __attribute__((aligned(16))) unsigned char lds[];
    Frame F;
    F.lds = (LAS unsigned char*)lds;
    volatile LAS unsigned* MISC = (volatile LAS unsigned*)(F.lds + MISC_OFF);
    F.tid = threadIdx.x; F.lane = F.tid & 63; F.wave = __builtin_amdgcn_readfirstlane(F.tid >> 6);
    F.G = gridDim.x; { const int bx = blockIdx.x; F.vcu = (F.G % 8 == 0) ? (bx % 8) * (F.G / 8) + bx / 8 : bx; }
    F.P.x = args.in[0]; F.P.norm_g = args.in[1]; F.P.w_in = args.in[2]; F.P.b_gate = args.in[3]; F.P.conv_w = args.in[4]; F.P.conv_b = args.in[5]; F.P.cn_g = args.in[6]; F.P.cn_b = args.in[7]; F.P.w_a = args.in[8];
    F.P.gn_g = args.in[9]; F.P.w_s = args.in[10]; F.P.b_s = args.in[11]; F.P.w_b = args.in[12]; F.P.qn_g = args.in[13]; F.P.kn_g = args.in[14]; F.P.b_f = args.in[15]; F.P.w_c = args.in[16]; F.P.w_out = args.in[17];
    F.P.out = args.out; F.P.ws = args.ws;
    gu32* ctl = (gu32*)(args.ws + WS_CTL);
    for (int u = F.tid; u < (LDS_BYTES - LDSCTL_OFF) / 4; u += NWAVES * 64) ((LAS unsigned*)(F.lds + LDSCTL_OFF))[u] = 0u;
    __syncthreads();
    XcdBarrier bar = xcd_barrier_post((unsigned*)(ctl + CW_BAR) + args.li * XCD_BAR_WORDS, MISC + 8);

    bool dup_done = false;
    for (int ph = args.ph_lo; ph < args.ph_hi;) {
        const int l = ph / 5, p = ph % 5;
        const bool dummy = (PROBE_DUP >= 0) && p == PROBE_DUP && !dup_done;
        asm volatile("" : "+v"(F.tid)); F.lane = F.tid & 63;
        unsigned char* ws = F.P.ws; unsigned char* wl = ws + WS_W + (size_t)l * W_LAYER;
        const float* xin = l == 0 ? F.P.x : F.P.out;
        if (p == 0) {
            if (l == 0) p0_weights(F);
            p0_ln(F, l, xin);
        } else if (p == 1) {
            if (blockIdx.x < NB * NH) p1_scan(F, (int)blockIdx.x);
            pg8::SchedG1 S; S.T.init(M, N1, F.G, (int)blockIdx.x); S.A = (const char*)(ws + WS_H); S.B = (const char*)(wl + WO_W1);
            pg8::EpiG1 E{(bf16_t*)(ws + WS_B0), (bf16_t*)(ws + WS_B1), (bf16_t*)(ws + WS_B2), (bf16_t*)(ws + WS_B3), (bf16_t*)(ws + WS_B4), (float*)(ws + WS_VSS), F.P.qn_g + l * HD, F.P.kn_g + l * HD};
            pg8::gemm_phase<pg8::EpiG1, pg8::SchedG1>(F.lds + RING_OFF, S, E);
        } else if (p == 2) {
            p2_conv(F, l, (int)blockIdx.x, dummy ? (bf16_t*)(ws + WS_DUMMY) : (bf16_t*)(ws + WS_B0));
            { bf16_t* ob = dummy ? (bf16_t*)(ws + WS_DUMMY) : (bf16_t*)(ws + WS_B0); p2_gmlp(F, l, 2 * (int)blockIdx.x, ob); p2_gmlp(F, l, 2 * (int)blockIdx.x + 1, ob); }
            { const int bh = F.vcu >> 3, sq = F.vcu & 7; const attn_body::bf16* b1 = (const attn_body::bf16*)(ws + WS_B1); const attn_body::bf16* b2 = (const attn_body::bf16*)(ws + WS_B2);
              const float* c2g = (const float*)(ws + WS_CS) + (size_t)bh * SEQ; const int* tsg = (const int*)(ws + WS_TS) + bh * 16;
              float gqm = fabsf(F.P.qn_g[l * HD + F.lane]), gkm = fabsf(F.P.kn_g[l * HD + F.lane]);
#pragma unroll
              for (int o_ = 1; o_ < 64; o_ <<= 1) { gqm = fmaxf(gqm, __shfl_xor(gqm, o_)); gkm = fmaxf(gkm, __shfl_xor(gkm, o_)); }
              const float ub = 64.f * C2 * gqm * gkm * 1.01f;
              for (int i = 0; i < 2; ++i) { const int qb = i == 0 ? 15 - sq : sq; const int ts = __builtin_amdgcn_readfirstlane(tsg[qb]); attn_body::attn_unit<8>(bh / NH, bh % NH, qb, b1, b1 + 512, b2, b2 + 512, dummy ? (attn_body::bf16*)(ws + WS_DUMMY) : (attn_body::bf16*)(ws + WS_B1), c2g, ts, ub, (char*)lds + RING_OFF); } }
        } else if (p == 3) {
            pg8::TileOrder T; T.init(M, D, F.G, (int)blockIdx.x);
            pg8::SchedMerge S; { int pm_ = 0, pn_ = 0; S.ok = T.tile(0, pm_, pn_); S.pm = pm_; S.pn = pn_; }
            S.ws = (const char*)ws; S.wl = (const char*)wl;
            pg8::EpiMerge E{ws + WS_GT + (size_t)blockIdx.x * 131072, (bf16_t*)(ws + WS_MG), F.P.b_gate + (size_t)l * 3072};
            pg8::gemm_phase<pg8::EpiMerge, pg8::SchedMerge>(F.lds + RING_OFF, S, E);
        } else {
            pg8::SchedG1 S; S.T.init(M, D, F.G, (int)blockIdx.x); S.A = (const char*)(ws + WS_MG); S.B = (const char*)(wl + WO_WO);
            pg8::EpiOut E{xin, dummy ? (float*)(ws + WS_H) : F.P.out};
            pg8::gemm_phase<pg8::EpiOut, pg8::SchedG1>(F.lds + RING_OFF, S, E);
        }
        if (dummy) { dup_done = true; continue; }
        dup_done = false; ++ph;
        if (ph < args.ph_hi) xcd_barrier(bar);
    }
}

#ifndef MK_MODE
#define MK_MODE 2
#endif
extern "C" void kernel_launch(void* const* d_in, const int* in_sizes, int n_in, void* d_out, int out_size, void* d_ws, size_t ws_size, hipStream_t stream) {
    static int ok = 0;
    if (ok == 0) {
        if (n_in != 18 || in_sizes[0] != M * D || out_size != M * D || ws_size < WS_END) { fprintf(stderr, "kernel_launch: unexpected shapes (n_in %d in0 %d out %d ws %zu)\n", n_in, n_in > 0 ? in_sizes[0] : -1, out_size, ws_size); ok = -1; return; }
        const int tl = 64 * TLD * 4;
        (void)hipFuncSetAttribute((const void*)nv_gemm1, hipFuncAttributeMaxDynamicSharedMemorySize, tl);
        (void)hipFuncSetAttribute((const void*)nv_merge, hipFuncAttributeMaxDynamicSharedMemorySize, 2 * 64 * 256 * 4);
        (void)hipFuncSetAttribute((const void*)nv_gmlp, hipFuncAttributeMaxDynamicSharedMemorySize, 128 * 129 * 4);
        (void)hipFuncSetAttribute((const void*)nv_attn, hipFuncAttributeMaxDynamicSharedMemorySize, 4 * SEQ * 4);
        if (hipFuncSetAttribute((const void*)mk_fwd, hipFuncAttributeMaxDynamicSharedMemorySize, LDS_BYTES) != hipSuccess) { fprintf(stderr, "kernel_launch: hipFuncSetAttribute(mk_fwd) failed\n"); ok = -1; return; }
        int dev = 0, cus = 0; (void)hipGetDevice(&dev); (void)hipDeviceGetAttribute(&cus, hipDeviceAttributeMultiprocessorCount, dev);
        if (cus != 256) fprintf(stderr, "kernel_launch: note: %d CUs (built for 256)\n", cus);
        (void)hipGetLastError();
        ok = 1;
    }
    if (ok < 0) return;
    Ptrs P{};
    const float** pp = (const float**)&P;
    for (int i = 0; i < 18; ++i) pp[i] = (const float*)d_in[i];
    P.out = (float*)d_out; P.ws = (unsigned char*)d_ws;
    const int tl = 64 * TLD * 4;
#if MK_MODE == 0
    nv_prep<<<2048, 256, 0, stream>>>(P);
    for (int l = 0; l < NL; ++l) {
        const float* xin = l == 0 ? P.x : P.out;
        nv_ln<<<M / 4, 256, 0, stream>>>(P, l, xin);
        nv_scan<<<NB * NH, 256, 0, stream>>>(P);
        nv_gemm1<<<dim3(20, 256), 256, tl, stream>>>(P, l);
        nv_conv<<<M, 512, 0, stream>>>(P, l);
        nv_gmlp<<<dim3(128, 4), 256, 128 * 129 * 4, stream>>>(P, l);
        nv_attn<<<M * NH / 4, 256, 4 * SEQ * 4, stream>>>(P);
        nv_merge<<<dim3(4, 256), 256, 2 * 64 * 256 * 4, stream>>>(P, l);
        nv_out<<<dim3(4, 256), 256, 0, stream>>>(P, l, xin, P.out);
    }
#else
    (void)tl;
    if (hipMemsetAsync((char*)d_ws + WS_CTL, 0, CTL_ZERO_BYTES, stream) != hipSuccess) { fprintf(stderr, "kernel_launch: memset failed\n"); return; }
    Args a{};
    for (int i = 0; i < 18; ++i) a.in[i] = (const float*)d_in[i];
    a.out = (float*)d_out; a.ws = (unsigned char*)d_ws;
    auto mk = [&](int lo, int hi, int li) { a.ph_lo = lo; a.ph_hi = hi; a.li = li; hipLaunchKernelGGL(mk_fwd, dim3(256), dim3(NWAVES * 64), LDS_BYTES, stream, a);
        const hipError_t le = hipPeekAtLastError(); if (le != hipSuccess) fprintf(stderr, "kernel_launch: mk launch [%d,%d) failed: %s\n", lo, hi, hipGetErrorName(le)); };
#if MK_MODE == 1
    auto mixers = [&](int l) { nv_conv<<<M, 512, 0, stream>>>(P, l); nv_gmlp<<<dim3(128, 4), 256, 128 * 129 * 4, stream>>>(P, l); nv_attn<<<M * NH / 4, 256, 4 * SEQ * 4, stream>>>(P); };
    mk(0, 2, 0); mixers(0); mk(3, 7, 1); mixers(1); mk(8, 10, 2);
#else
    mk(0, NPH, 0);
#endif
#endif
}
```

```cpp
#include <hip/hip_runtime.h>
#include <cstdio>
#include <cstdint>
#include <cmath>

constexpr int NL = 2, NB = 4, SEQ = 4096, M = NB * SEQ, D = 1024;
constexpr int DA = 512, DB = 512, NH = 8, HD = 64, DC = 512, CW = 31, CHK = 128, NG = 4, GD = 128, NIN = 8200;
constexpr float EPS = 1e-6f;
constexpr float LOG2E = 1.4426950408889634f;
constexpr float C2 = 0.125f * LOG2E;
constexpr int N1 = 5120;
constexpr int OC_GATE = 0, OC_AIN = 3072, OC_AZ = 4096, OC_U = 4608, OC_V = 5120, OC_BZ = 5632, OC_Q = 6144, OC_K = 6656, OC_VA = 7168, OC_CZ = 7680, OC_F = 8192;

constexpr size_t MiB = 1u << 20;
constexpr size_t WS_CTL = 0, CTL_ZERO_BYTES = 1 * MiB;
constexpr size_t WS_VSS = 1 * MiB;
constexpr size_t WS_LOGF = WS_VSS + 512 * 1024;
constexpr size_t WS_CS = 2 * MiB;
constexpr size_t WS_WSB = WS_CS + 512 * 1024;
constexpr size_t WS_TS = 3 * MiB;
constexpr size_t WS_W = 4 * MiB, W_LAYER = 22 * MiB;
constexpr size_t WO_W1 = 0, WO_WG = 10 * MiB, WO_WAB = 16 * MiB, WO_WC = 18 * MiB, WO_WO = 20 * MiB;
constexpr size_t WS_H = 48 * MiB;
constexpr size_t WS_B0 = 80 * MiB;
constexpr size_t WS_B1 = 112 * MiB;
constexpr size_t WS_B2 = 144 * MiB;
constexpr size_t WS_B3 = 176 * MiB;
constexpr size_t WS_B4 = 208 * MiB;
constexpr size_t WS_GT = WS_B2, WS_MG = WS_B3;
constexpr size_t WS_DUMMY = 224 * MiB;
constexpr size_t WS_END = 256 * MiB;
#ifndef PROBE_SUB
#define PROBE_SUB 7
#endif
#ifndef PROBE_DUP
#define PROBE_DUP -1
#endif

typedef unsigned short bf16_t;
typedef short bf16x8 __attribute__((ext_vector_type(8)));
typedef float f32x4 __attribute__((ext_vector_type(4)));
typedef unsigned u32x4 __attribute__((ext_vector_type(4)));

__host__ __device__ __forceinline__ float bf2f(bf16_t v) { union { unsigned u; float f; } c; c.u = (unsigned)v << 16; return c.f; }
__host__ __device__ __forceinline__ bf16_t f2bf(float f) { union { unsigned u; float f; } c; c.f = f; unsigned u = c.u; return (bf16_t)((u + 0x7fffu + ((u >> 16) & 1u)) >> 16); }
__device__ __forceinline__ float bfr(float f) { return bf2f(f2bf(f)); }
__device__ __forceinline__ float sigm(float x) { return 1.f / (1.f + __expf(-x)); }
__device__ __forceinline__ float siluf(float x) { return x * sigm(x); }

__host__ __device__ __forceinline__ int g1_col(int n) {
    const int j = n >> 8, lc = n & 255;
    if (j < 4) return lc < 128 ? OC_AIN + 128 * j + lc : OC_AIN + 512 + 128 * j + (lc - 128);
    if (j < 6) return OC_AZ + 256 * (j - 4) + lc;
    if (j < 8) return OC_U + 256 * (j - 6) + lc;
    if (j < 10) return OC_V + 256 * (j - 8) + lc;
    if (j < 12) return OC_BZ + 256 * (j - 10) + lc;
    if (j < 16) { const int isk = j >= 14, jj = (j - 12) & 1, head = 4 * jj + ((lc >> 5) & 3), d = 32 * (lc >> 7) + (lc & 31); return (isk ? OC_K : OC_Q) + 64 * head + d; }
    if (j < 18) return OC_VA + 256 * (j - 16) + lc;
    return OC_CZ + 256 * (j - 18) + lc;
}

struct Ptrs {
    const float *x, *norm_g, *w_in, *b_gate, *conv_w, *conv_b, *cn_g, *cn_b, *w_a, *gn_g, *w_s, *b_s, *w_b, *qn_g, *kn_g, *b_f, *w_c, *w_out;
    float* out; unsigned char* ws;
};

__global__ void nv_prep(Ptrs P) {
    const size_t gid = (size_t)blockIdx.x * blockDim.x + threadIdx.x, gsz = (size_t)gridDim.x * blockDim.x;
    for (int l = 0; l < NL; ++l) {
        unsigned char* wl = P.ws + WS_W + (size_t)l * W_LAYER;
        bf16_t* W1 = (bf16_t*)(wl + WO_W1); bf16_t* WG = (bf16_t*)(wl + WO_WG); bf16_t* WAB = (bf16_t*)(wl + WO_WAB); bf16_t* WC = (bf16_t*)(wl + WO_WC); bf16_t* WO = (bf16_t*)(wl + WO_WO);
        const float* win = P.w_in + (size_t)l * D * NIN;
        for (size_t i = gid; i < (size_t)N1 * D; i += gsz) { const int n = (int)(i >> 10), k = (int)(i & 1023); W1[i] = f2bf(win[(size_t)k * NIN + g1_col(n)]); }
        for (size_t i = gid; i < (size_t)3072 * D; i += gsz) { const int n = (int)(i >> 10), k = (int)(i & 1023); WG[i] = f2bf(win[(size_t)k * NIN + n]); }
        for (size_t i = gid; i < (size_t)1024 * 1024; i += gsz) { const int n = (int)(i >> 10), k = (int)(i & 1023);
            WAB[i] = f2bf(k < 512 ? P.w_a[((size_t)l * DA + k) * D + n] : P.w_b[((size_t)l * DB + (k - 512)) * D + n]);
            WC[i] = k < 512 ? f2bf(P.w_c[((size_t)l * DC + k) * D + n]) : (bf16_t)0;
            WO[i] = f2bf(P.w_out[((size_t)l * D + k) * D + n]); }
        bf16_t* WSB = (bf16_t*)(P.ws + WS_WSB) + (size_t)l * NG * CHK * CHK;
        for (size_t i = gid; i < (size_t)NG * CHK * CHK; i += gsz) { const int s = (int)(i & 127), t = (int)((i >> 7) & 127); WSB[i] = s <= t ? f2bf(P.w_s[(size_t)l * NG * CHK * CHK + i]) : (bf16_t)0; }
    }
}

__device__ __forceinline__ float wave_sum(float v) {
#pragma unroll
    for (int o = 1; o < 64; o <<= 1) v += __shfl_xor(v, o);
    return v;
}

__global__ void nv_ln(Ptrs P, int l, const float* xin) {
    const int lane = threadIdx.x & 63, row = blockIdx.x * 4 + (threadIdx.x >> 6);
    const float* xr = xin + (size_t)row * D; const float* g = P.norm_g + (size_t)l * D; const float* win = P.w_in + (size_t)l * D * NIN;
    float v[16]; float ss = 0.f;
#pragma unroll
    for (int j = 0; j < 16; ++j) { v[j] = xr[lane + 64 * j]; ss += v[j] * v[j]; }
    ss = wave_sum(ss);
    const float r = rsqrtf(ss * (1.f / D) + EPS);
    bf16_t* h = (bf16_t*)(P.ws + WS_H) + (size_t)row * D;
    float f[8] = {0, 0, 0, 0, 0, 0, 0, 0};
#pragma unroll
    for (int j = 0; j < 16; ++j) { const int k = lane + 64 * j; const float hv = v[j] * r * g[k]; h[k] = f2bf(hv);
#pragma unroll
        for (int e = 0; e < 8; ++e) f[e] += hv * win[(size_t)k * NIN + OC_F + e]; }
#pragma unroll
    for (int e = 0; e < 8; ++e) f[e] = wave_sum(f[e]);
    if (lane < 8) { float z = 0.f;
#pragma unroll
        for (int e = 0; e < 8; ++e) if (lane == e) z = f[e];
        z += P.b_f[l * NH + lane];
        const float lf = fminf(z, 0.f) - log1pf(expf(-fabsf(z)));
        ((float*)(P.ws + WS_LOGF))[(size_t)row * 8 + lane] = lf; }
}

__global__ void nv_scan(Ptrs P) {
    __shared__ float buf[SEQ];
    const int bh = blockIdx.x, b = bh / NH, h = bh % NH;
    const float* lf = (const float*)(P.ws + WS_LOGF);
    for (int t = threadIdx.x; t < SEQ; t += blockDim.x) buf[t] = lf[((size_t)b * SEQ + t) * 8 + h];
    __syncthreads();
    if (threadIdx.x == 0) { float c = 0.f; for (int t = 0; t < SEQ; ++t) { c += buf[t]; buf[t] = c * LOG2E; } }
    __syncthreads();
    float* cs = (float*)(P.ws + WS_CS) + (size_t)bh * SEQ;
    for (int t = threadIdx.x; t < SEQ; t += blockDim.x) cs[t] = buf[t];
}

constexpr int TLD = 257;
__device__ __forceinline__ void nv_gemm_acc(const bf16_t* A, int lda, const bf16_t* Bt, int ldb, int K, f32x4 (&acc)[4][4]) {
    const int tid = threadIdx.x, w = tid >> 6, l = tid & 63, fr = l & 15, fq = l >> 4;
#pragma unroll
    for (int m = 0; m < 4; ++m)
#pragma unroll
        for (int n = 0; n < 4; ++n) acc[m][n] = (f32x4){0.f, 0.f, 0.f, 0.f};
    for (int k0 = 0; k0 < K; k0 += 32) {
        bf16x8 a[4], b[4];
#pragma unroll
        for (int m = 0; m < 4; ++m) a[m] = *(const bf16x8*)(A + (size_t)(16 * m + fr) * lda + k0 + 8 * fq);
#pragma unroll
        for (int n = 0; n < 4; ++n) b[n] = *(const bf16x8*)(Bt + (size_t)(64 * w + 16 * n + fr) * ldb + k0 + 8 * fq);
#pragma unroll
        for (int m = 0; m < 4; ++m)
#pragma unroll
            for (int n = 0; n < 4; ++n) acc[m][n] = __builtin_amdgcn_mfma_f32_16x16x32_bf16(a[m], b[n], acc[m][n], 0, 0, 0);
    }
}
__device__ __forceinline__ void nv_gemm_tile(const bf16_t* A, int lda, const bf16_t* Bt, int ldb, int K, float* T) {
    const int tid = threadIdx.x, w = tid >> 6, l = tid & 63, fr = l & 15, fq = l >> 4;
    f32x4 acc[4][4];
    nv_gemm_acc(A, lda, Bt, ldb, K, acc);
#pragma unroll
    for (int m = 0; m < 4; ++m)
#pragma unroll
        for (int n = 0; n < 4; ++n)
#pragma unroll
            for (int r = 0; r < 4; ++r) T[(16 * m + 4 * fq + r) * TLD + 64 * w + 16 * n + fr] = acc[m][n][r];
}

__global__ void __launch_bounds__(256) nv_gemm1(Ptrs P, int l) {
    extern __shared__ float T[];
    __shared__ float R[64 * 4];
    const int j = blockIdx.x, row0 = blockIdx.y * 64, tid = threadIdx.x;
    const bf16_t* H = (const bf16_t*)(P.ws + WS_H);
    const bf16_t* W1 = (const bf16_t*)(P.ws + WS_W + (size_t)l * W_LAYER + WO_W1);
    nv_gemm_tile(H + (size_t)row0 * D, D, W1 + (size_t)j * 256 * D, D, D, T);
    __syncthreads();
    bf16_t* B0 = (bf16_t*)(P.ws + WS_B0); bf16_t* B1 = (bf16_t*)(P.ws + WS_B1); bf16_t* B2 = (bf16_t*)(P.ws + WS_B2); bf16_t* B3 = (bf16_t*)(P.ws + WS_B3); bf16_t* B4 = (bf16_t*)(P.ws + WS_B4);
    if (j < 4) {
        for (int e = tid; e < 64 * 128; e += 256) { const int r = e >> 7, c = e & 127; B3[(size_t)(row0 + r) * 1024 + 128 * j + c] = f2bf(T[r * TLD + c] * sigm(T[r * TLD + c + 128])); }
    } else if (j < 12 || j >= 16) {
        bf16_t* dst; int pitch, coff; bool act;
        if (j < 6) { dst = B0; pitch = 1024; coff = 256 * (j - 4); act = true; }
        else if (j < 8) { dst = B0; pitch = 1024; coff = 512 + 256 * (j - 6); act = false; }
        else if (j < 10) { dst = B3; pitch = 1024; coff = 512 + 256 * (j - 8); act = false; }
        else if (j < 12) { dst = B4; pitch = 512; coff = 256 * (j - 10); act = true; }
        else if (j < 18) { dst = B2; pitch = 1024; coff = 256 * (j - 16); act = false; }
        else { dst = B2; pitch = 1024; coff = 512 + 256 * (j - 18); act = true; }
        for (int e = tid; e < 64 * 256; e += 256) { const int r = e >> 8, c = e & 255; const float v = T[r * TLD + c]; dst[(size_t)(row0 + r) * pitch + coff + c] = f2bf(act ? siluf(v) : v); }
        if (j == 8 || j == 9) { const int r = tid >> 2, wc = tid & 3; float s = 0.f;
            for (int bj = 0; bj < 2; ++bj) for (int i = 0; i < 32; ++i) { const float v = T[r * TLD + 128 * bj + 32 * wc + i]; s += v * v; }
            ((float*)(P.ws + WS_VSS))[(size_t)(row0 + r) * 8 + (j - 8) * 4 + wc] = s; }
    } else {
        const bool isk = j >= 14; const int jj = (j - 12) & 1;
        { const int r = tid >> 2, hh = tid & 3; float s = 0.f;
          for (int d = 0; d < 64; ++d) { const float v = T[r * TLD + 128 * (d >> 5) + 32 * hh + (d & 31)]; s += v * v; }
          R[r * 4 + hh] = rsqrtf(s * (1.f / 64.f) + EPS); }
        __syncthreads();
        const float* gq = (isk ? P.kn_g : P.qn_g) + (size_t)l * HD;
        for (int e = tid; e < 64 * 256; e += 256) { const int r = e >> 8, c = e & 255, hh = (c >> 5) & 3, d = 32 * (c >> 7) + (c & 31);
            float v = T[r * TLD + c] * R[r * 4 + hh] * gq[d]; if (!isk) v *= C2;
            B1[(size_t)(row0 + r) * 1024 + (isk ? 512 : 0) + 64 * (4 * jj + hh) + d] = f2bf(v); }
    }
}

__global__ void __launch_bounds__(512) nv_conv(Ptrs P, int l) {
    __shared__ float red[16];
    const int row = blockIdx.x, t = row % SEQ, c = threadIdx.x, lane = c & 63, w = c >> 6;
    const bf16_t* AG = (const bf16_t*)(P.ws + WS_B3); bf16_t* B0 = (bf16_t*)(P.ws + WS_B0);
    const float* cw = P.conv_w + (size_t)l * CW * DA;
    float a = P.conv_b[l * DA + c];
    for (int j = 0; j < CW; ++j) { const int tt = t - (CW - 1) + j; if (tt >= 0) a += cw[j * DA + c] * bf2f(AG[(size_t)(row - (CW - 1) + j) * 1024 + c]); }
    float s = wave_sum(a); if (lane == 0) red[w] = s; __syncthreads();
    float mu = 0.f; for (int i = 0; i < 8; ++i) mu += red[i]; mu *= (1.f / DA);
    const float d = a - mu; s = wave_sum(d * d); if (lane == 0) red[8 + w] = s; __syncthreads();
    float var = 0.f; for (int i = 0; i < 8; ++i) var += red[8 + i]; var *= (1.f / DA);
    const float y = d * rsqrtf(var + EPS) * P.cn_g[l * DA + c] + P.cn_b[l * DA + c];
    const float az = bf2f(B0[(size_t)row * 1024 + c]);
    B0[(size_t)row * 1024 + c] = f2bf(siluf(y) * az);
}

__global__ void __launch_bounds__(256) nv_gmlp(Ptrs P, int l) {
    extern __shared__ float vn[];
    const int ch = blockIdx.x, g = blockIdx.y, tid = threadIdx.x; const size_t row0 = (size_t)ch * CHK;
    const bf16_t* V = (const bf16_t*)(P.ws + WS_B3); bf16_t* B0 = (bf16_t*)(P.ws + WS_B0); const bf16_t* BZ = (const bf16_t*)(P.ws + WS_B4);
    const float* vss = (const float*)(P.ws + WS_VSS);
    const bf16_t* WSB = (const bf16_t*)(P.ws + WS_WSB) + ((size_t)l * NG + g) * CHK * CHK;
    for (int e = tid; e < 128 * 128; e += 256) { const int s = e >> 7, c = e & 127; const float* q = vss + (row0 + s) * 8;
        const float ss = ((q[0] + q[1]) + (q[2] + q[3])) + ((q[4] + q[5]) + (q[6] + q[7])); const float rv = rsqrtf(ss * (1.f / DB) + EPS);
        vn[s * 129 + c] = bfr(bf2f(V[(row0 + s) * 1024 + 512 + 128 * g + c]) * rv * P.gn_g[l * DB + 128 * g + c]); }
    __syncthreads();
    for (int e = tid; e < 128 * 128; e += 256) { const int t = e >> 7, c = e & 127; float acc = 0.f;
        for (int s = 0; s <= t; ++s) acc += bf2f(WSB[t * 128 + s]) * vn[s * 129 + c];
        acc += P.b_s[((size_t)l * NG + g) * CHK + t];
        const size_t o = (row0 + t) * 1024 + 512 + 128 * g + c;
        B0[o] = f2bf(bf2f(B0[o]) * acc * bf2f(BZ[(row0 + t) * 512 + 128 * g + c])); }
}

__global__ void __launch_bounds__(256) nv_attn(Ptrs P) {
    extern __shared__ float sc[];
    const int lane = threadIdx.x & 63, w = threadIdx.x >> 6; const int item = blockIdx.x * 4 + w, row = item >> 3, h = item & 7, b = row / SEQ, t = row % SEQ;
    float* s = sc + w * SEQ;
    bf16_t* B1 = (bf16_t*)(P.ws + WS_B1); const bf16_t* B2 = (const bf16_t*)(P.ws + WS_B2);
    const float* cs = (const float*)(P.ws + WS_CS) + (size_t)(b * NH + h) * SEQ;
    float q[64];
#pragma unroll
    for (int d = 0; d < 64; ++d) q[d] = bf2f(B1[(size_t)row * 1024 + 64 * h + d]);
    const float cq = cs[t]; float mx = -INFINITY;
    for (int k = lane; k <= t; k += 64) { const bf16_t* kr = B1 + ((size_t)b * SEQ + k) * 1024 + 512 + 64 * h; float dot = 0.f;
#pragma unroll
        for (int d8 = 0; d8 < 8; ++d8) { const bf16x8 kv = *(const bf16x8*)(kr + 8 * d8);
#pragma unroll
            for (int e = 0; e < 8; ++e) dot += q[8 * d8 + e] * bf2f((bf16_t)kv[e]); }
        const float v = dot + (cq - cs[k]); s[k] = v; mx = fmaxf(mx, v); }
#pragma unroll
    for (int o = 1; o < 64; o <<= 1) mx = fmaxf(mx, __shfl_xor(mx, o));
    float lsum = 0.f;
    for (int k = lane; k <= t; k += 64) { const float p = exp2f(s[k] - mx); lsum += p; s[k] = bfr(p); }
    lsum = wave_sum(lsum);
    __builtin_amdgcn_s_waitcnt(0); __builtin_amdgcn_wave_barrier();
    float o = 0.f; const bf16_t* vb = B2 + (size_t)b * SEQ * 1024 + 64 * h + lane;
    for (int k = 0; k <= t; ++k) o += s[k] * bf2f(vb[(size_t)k * 1024]);
    const float cz = bf2f(B2[(size_t)row * 1024 + 512 + 64 * h + lane]);
    B1[(size_t)row * 1024 + 64 * h + lane] = f2bf(o / lsum * cz);
}

__global__ void __launch_bounds__(256) nv_merge(Ptrs P, int l) {
    extern __shared__ float T[];
    const int pn = blockIdx.x, row0 = blockIdx.y * 64, tid = threadIdx.x, w = tid >> 6, ln = tid & 63, fr = ln & 15, fq = ln >> 4;
    const unsigned char* wl = P.ws + WS_W + (size_t)l * W_LAYER;
    const bf16_t* H = (const bf16_t*)(P.ws + WS_H); const bf16_t* WG = (const bf16_t*)(wl + WO_WG); const bf16_t* WAB = (const bf16_t*)(wl + WO_WAB); const bf16_t* WC = (const bf16_t*)(wl + WO_WC);
    const bf16_t* B0 = (const bf16_t*)(P.ws + WS_B0); const bf16_t* B1 = (const bf16_t*)(P.ws + WS_B1);
    float* G = T; float* MGs = T + 64 * 256;
    f32x4 acc[4][4];
    for (int br = 0; br < 3; ++br) {
        nv_gemm_acc(H + (size_t)row0 * D, D, WG + ((size_t)br * 1024 + 256 * pn) * D, D, D, acc);
#pragma unroll
        for (int m = 0; m < 4; ++m)
#pragma unroll
            for (int n = 0; n < 4; ++n)
#pragma unroll
                for (int r = 0; r < 4; ++r) { const int c = 64 * w + 16 * n + fr; G[((m * 4 + n) * 4 + r) * 256 + tid] = bfr(sigm(acc[m][n][r] + P.b_gate[(size_t)l * 3072 + br * 1024 + 256 * pn + c])); }
        const bf16_t* A = br == 0 ? B0 : (br == 1 ? B0 + 512 : B1); const bf16_t* Bt = br == 0 ? WAB : (br == 1 ? WAB + 512 : WC);
        nv_gemm_acc(A + (size_t)row0 * 1024, 1024, Bt + (size_t)256 * pn * 1024, 1024, 512, acc);
#pragma unroll
        for (int m = 0; m < 4; ++m)
#pragma unroll
            for (int n = 0; n < 4; ++n)
#pragma unroll
                for (int r = 0; r < 4; ++r) { const int s = ((m * 4 + n) * 4 + r) * 256 + tid; const float v = G[s] * acc[m][n][r]; MGs[s] = bfr(br == 0 ? v : MGs[s] + v); }
    }
    bf16_t* MG = (bf16_t*)(P.ws + WS_MG);
#pragma unroll
    for (int m = 0; m < 4; ++m)
#pragma unroll
        for (int n = 0; n < 4; ++n)
#pragma unroll
            for (int r = 0; r < 4; ++r) MG[(size_t)(row0 + 16 * m + 4 * fq + r) * 1024 + 256 * pn + 64 * w + 16 * n + fr] = f2bf(MGs[((m * 4 + n) * 4 + r) * 256 + tid]);
}

__global__ void __launch_bounds__(256) nv_out(Ptrs P, int l, const float* xin, float* xout) {
    const int pn = blockIdx.x, row0 = blockIdx.y * 64, tid = threadIdx.x, w = tid >> 6, ln = tid & 63, fr = ln & 15, fq = ln >> 4;
    const bf16_t* MG = (const bf16_t*)(P.ws + WS_MG); const bf16_t* WO = (const bf16_t*)(P.ws + WS_W + (size_t)l * W_LAYER + WO_WO);
    f32x4 acc[4][4];
    nv_gemm_acc(MG + (size_t)row0 * 1024, 1024, WO + (size_t)256 * pn * 1024, 1024, 1024, acc);
#pragma unroll
    for (int m = 0; m < 4; ++m)
#pragma unroll
        for (int n = 0; n < 4; ++n)
#pragma unroll
            for (int r = 0; r < 4; ++r) { const size_t o = (size_t)(row0 + 16 * m + 4 * fq + r) * D + 256 * pn + 64 * w + 16 * n + fr; xout[o] = xin[o] + acc[m][n][r]; }
}


#define LAS __attribute__((address_space(3)))
#define GAS __attribute__((address_space(1)))
typedef GAS unsigned gu32;
#define RLX_AGENT __ATOMIC_RELAXED, __HIP_MEMORY_SCOPE_AGENT
#define LDS_WAIT() asm volatile("s_waitcnt lgkmcnt(0)" ::: "memory")
#define VM_WAIT() asm volatile("s_waitcnt vmcnt(0)" ::: "memory")
constexpr int NWAVES = 8;
constexpr int RING_OFF = 0, RING_BYTES = 131072;
constexpr int LDSCTL_OFF = RING_BYTES, MISC_OFF = LDSCTL_OFF + 320;
constexpr int LDS_BYTES = 147456;
constexpr int CW_TMO = 0, CW_CODE = 1, CW_BAR = 4096;
constexpr float SKIP_L2 = 160.f;
constexpr int NPH = 10;

__device__ __forceinline__ unsigned cvt_pk_bf16(float lo, float hi) { unsigned r; asm volatile("v_cvt_pk_bf16_f32 %0, %1, %2" : "=v"(r) : "v"(lo), "v"(hi)); return r; }
__device__ __forceinline__ float fsigm(float x) { return __builtin_amdgcn_rcpf(1.f + __builtin_amdgcn_exp2f(-LOG2E * x)); }
__device__ __forceinline__ u32x4 pack8(const f32x4& a, const f32x4& b) { u32x4 w; w.x = cvt_pk_bf16(a[0], a[1]); w.y = cvt_pk_bf16(a[2], a[3]); w.z = cvt_pk_bf16(b[0], b[1]); w.w = cvt_pk_bf16(b[2], b[3]); return w; }
__device__ __forceinline__ void unpack8(const u32x4& w, f32x4& a, f32x4& b) {
    a[0] = __uint_as_float(w.x << 16); a[1] = __uint_as_float(w.x & 0xffff0000u); a[2] = __uint_as_float(w.y << 16); a[3] = __uint_as_float(w.y & 0xffff0000u);
    b[0] = __uint_as_float(w.z << 16); b[1] = __uint_as_float(w.z & 0xffff0000u); b[2] = __uint_as_float(w.w << 16); b[3] = __uint_as_float(w.w & 0xffff0000u); }

namespace pg8 {
constexpr int BM = 256, BK = 64, HALF = 128, HTB = HALF * BK * 2, STAGE_BYTES = 8 * HTB, NXCD = 8, WGM = 8, PITCH = 1024;
__host__ __device__ __forceinline__ int lds_byte(int r, int c) { const int st = (r >> 4) * 2 + (c >> 5), rr = r & 15, cc = c & 31, ob = rr * 64 + cc * 2; return st * 1024 + (ob ^ (((ob >> 9) & 1) << 5)); }
__host__ __device__ __forceinline__ void stage_rc(int b, int& R, int& C) { const int st = b / 1024, sb = b % 1024, swz = sb ^ (((sb >> 9) & 1) << 5); R = (st >> 1) * 16 + swz / 64; C = (st & 1) * 32 + (swz % 64) / 2; }
__host__ __device__ __forceinline__ int perm32(int rho) { const int n = rho >> 4, i = rho & 15; return 8 * (i >> 2) + 4 * n + (i & 3); }

struct Unit { const char* A; const char* B; int nt, pm, pn, tag; };

struct TileOrder {
    int nM, nN, nwg, G, c;
    __device__ __forceinline__ void init(int Mr, int N, int G_, int c_) { nM = Mr / BM; nN = N / BM; nwg = nM * nN; G = G_; c = c_; }
    __device__ __forceinline__ bool tile(int i, int& pm, int& pn) const {
        const long L = (long)i * G + c; if (L >= nwg) return false;
        int wgid = (int)L; { const int q = nwg / NXCD, r = nwg % NXCD, xcd = wgid % NXCD, off = wgid / NXCD; wgid = (xcd < r ? xcd * (q + 1) : r * (q + 1) + (xcd - r) * q) + off; }
        const int nig = WGM * nN, gid = wgid / nig, fm = gid * WGM, gsz = (nM - fm) < WGM ? (nM - fm) : WGM;
        pm = fm + ((wgid % nig) % gsz); pn = (wgid % nig) / gsz; return true;
    }
};

template <class Epi, class Sched>
__device__ __forceinline__ void gemm_phase(LAS unsigned char* lds, const Sched& S, const Epi& E) {
    int tid = threadIdx.x; asm volatile("" : "+v"(tid));
    const int wid = __builtin_amdgcn_readfirstlane(tid >> 6), lane = tid & 63, wr = wid >> 2, wc = wid & 3, fr = lane & 15, fq = lane >> 4;
    unsigned voffA[2], voffB[2];
#pragma unroll
    for (int i = 0; i < 2; ++i) { int R, C; stage_rc(tid * 16 + i * 8192, R, C); const int Rb = (R & ~31) + perm32(R & 31);
        voffA[i] = (unsigned)(R * PITCH + C) * 2u; voffB[i] = (unsigned)(Rb * PITCH + C) * 2u; }
    const size_t kstep = (size_t)(BK * 2);
    const size_t hstep = (size_t)HALF * PITCH * 2;
    const unsigned ldsw = (unsigned)wid * 1024u;
    const int aoff = lds_byte(wr * 64 + fr, fq * 8), boff = lds_byte(wc * 32 + fr, fq * 8);
#define PG8_SA(b, h) (((b) * 2 + (h)) * HTB)
#define PG8_SB(b, h) ((4 + (b) * 2 + (h)) * HTB)
#define PG8_STAGE(bufoff, gbase, voff) do { _Pragma("unroll") for (int _i = 0; _i < 2; ++_i) \
        __builtin_amdgcn_global_load_lds((const unsigned*)((const char*)(gbase) + (voff)[_i]), (LAS unsigned*)(lds + (bufoff) + ldsw + _i * 8192), 16, 0, 0); } while (0)
#define PG8_LDA(dst, b, h) do { _Pragma("unroll") for (int m = 0; m < 4; ++m) _Pragma("unroll") for (int k = 0; k < 2; ++k) dst[m][k] = *(const LAS bf16x8*)(lds + PG8_SA(b, h) + aoff + m * 2048 + k * 1024); } while (0)
#define PG8_LDB(dst, b, h) do { _Pragma("unroll") for (int n = 0; n < 2; ++n) _Pragma("unroll") for (int k = 0; k < 2; ++k) dst[n][k] = *(const LAS bf16x8*)(lds + PG8_SB(b, h) + boff + n * 2048 + k * 1024); } while (0)
#define PG8_MMA(ai, bj, At, Bt) do { __builtin_amdgcn_s_setprio(1); _Pragma("unroll") for (int m = 0; m < 4; ++m) _Pragma("unroll") for (int n = 0; n < 2; ++n) _Pragma("unroll") for (int k = 0; k < 2; ++k) \
        acc[ai][bj][m][n] = __builtin_amdgcn_mfma_f32_16x16x32_bf16(Bt[n][k], At[m][k], acc[ai][bj][m][n], 0, 0, 0); __builtin_amdgcn_s_setprio(0); } while (0)
#define PG8_WAIT_V(n) asm volatile("s_waitcnt vmcnt(" #n ")" ::: "memory")
#define PG8_WAIT_L(n) asm volatile("s_waitcnt lgkmcnt(" #n ")" ::: "memory")
#define PG8_BAR __builtin_amdgcn_s_barrier()
#define PG8_SCHED __builtin_amdgcn_sched_barrier(0)
    Unit cur, nxt; int ui = 0;
    if (!S.next(0, cur)) return;
    f32x4 acc[2][2][4][2];
#pragma unroll
    for (int a = 0; a < 2; ++a)
#pragma unroll
        for (int b = 0; b < 2; ++b)
#pragma unroll
            for (int m = 0; m < 4; ++m)
#pragma unroll
                for (int n = 0; n < 2; ++n) acc[a][b][m][n] = (f32x4){0.f, 0.f, 0.f, 0.f};
    bf16x8 At[4][2], B0[2][2], B1[2][2];
    const char* cA = cur.A; const char* cB = cur.B;
    PG8_STAGE(PG8_SB(0, 0), cB, voffB); PG8_STAGE(PG8_SB(0, 1), cB + hstep, voffB); PG8_STAGE(PG8_SA(0, 0), cA, voffA); PG8_STAGE(PG8_SA(0, 1), cA + hstep, voffA);
    if (wr == 1) PG8_BAR;
    PG8_WAIT_V(2); PG8_BAR;
    PG8_STAGE(PG8_SB(1, 0), cB + kstep, voffB); PG8_STAGE(PG8_SA(1, 0), cA + kstep, voffA); PG8_STAGE(PG8_SB(1, 1), cB + hstep + kstep, voffB);
    PG8_WAIT_V(6); PG8_BAR;
    for (;;) {
        const bool has_next = S.next(ui + 1, nxt);
        const char* nA = has_next ? nxt.A : cA; const char* nB = has_next ? nxt.B : cB;
        const int nt = cur.nt;
        for (int t = 0; t < nt; t += 2) {
            const bool last = (t == nt - 2);
            const char* a1 = cA + (size_t)(t + 1) * kstep;
            const char* a2 = last ? nA : cA + (size_t)(t + 2) * kstep; const char* b2 = last ? nB : cB + (size_t)(t + 2) * kstep;
            const char* a3 = a2 + kstep; const char* b3 = b2 + kstep;
            PG8_LDB(B0, 0, 0); PG8_LDB(B1, 0, 1); PG8_SCHED; PG8_LDA(At, 0, 0); PG8_STAGE(PG8_SA(1, 1), a1 + hstep, voffA);
            PG8_WAIT_V(8); PG8_WAIT_L(0); PG8_BAR; PG8_MMA(0, 0, At, B0); PG8_MMA(0, 1, At, B1); PG8_BAR; PG8_SCHED;
            PG8_LDA(At, 0, 1); PG8_STAGE(PG8_SB(0, 0), b2, voffB); PG8_STAGE(PG8_SB(0, 1), b2 + hstep, voffB); PG8_STAGE(PG8_SA(0, 0), a2, voffA);
            PG8_WAIT_V(8); PG8_WAIT_L(0); PG8_BAR; PG8_MMA(1, 0, At, B0); PG8_MMA(1, 1, At, B1); PG8_BAR; PG8_SCHED;
            PG8_LDB(B0, 1, 0); PG8_LDB(B1, 1, 1); PG8_SCHED; PG8_LDA(At, 1, 0); PG8_STAGE(PG8_SA(0, 1), a2 + hstep, voffA);
            PG8_WAIT_V(8); PG8_WAIT_L(0); PG8_BAR; PG8_MMA(0, 0, At, B0); PG8_MMA(0, 1, At, B1); PG8_BAR; PG8_SCHED;
            PG8_LDA(At, 1, 1); PG8_STAGE(PG8_SB(1, 0), b3, voffB); PG8_STAGE(PG8_SB(1, 1), b3 + hstep, voffB); PG8_STAGE(PG8_SA(1, 0), a3, voffA);
            PG8_WAIT_V(8); PG8_WAIT_L(0); PG8_BAR; PG8_MMA(1, 0, At, B0); PG8_MMA(1, 1, At, B1); PG8_BAR; PG8_SCHED;
        }
        if (wr == 0) PG8_BAR;
        E(acc, cur, wr, wc, fr, fq);
        if (!has_next) break;
#pragma unroll
        for (int a = 0; a < 2; ++a)
#pragma unroll
            for (int b = 0; b < 2; ++b)
#pragma unroll
                for (int m = 0; m < 4; ++m)
#pragma unroll
                    for (int n = 0; n < 2; ++n) acc[a][b][m][n] = (f32x4){0.f, 0.f, 0.f, 0.f};
        cur = nxt; cA = nA; cB = nB; ++ui;
        if (wr == 1) PG8_BAR;
    }
    PG8_WAIT_V(0);
    PG8_BAR;
#undef PG8_SA
#undef PG8_SB
#undef PG8_STAGE
#undef PG8_LDA
#undef PG8_LDB
#undef PG8_MMA
#undef PG8_WAIT_V
#undef PG8_WAIT_L
#undef PG8_BAR
#undef PG8_SCHED
}

struct EpiG1 {
    bf16_t *B0, *B1, *B2, *B3, *B4; float* vss; const float *gq, *gk;
    __device__ __forceinline__ void operator()(const f32x4 (&acc)[2][2][4][2], const Unit& u, int wr, int wc, int fr, int fq) const {
        const int j = u.pn; const size_t rowb = (size_t)u.pm * BM + wr * 64 + fr; const int cl = 32 * wc + 8 * fq;
        if (j < 4) {
#pragma unroll
            for (int ai = 0; ai < 2; ++ai)
#pragma unroll
                for (int m = 0; m < 4; ++m) { f32x4 o0, o1;
#pragma unroll
                    for (int e = 0; e < 4; ++e) { o0[e] = acc[ai][0][m][0][e] * fsigm(acc[ai][1][m][0][e]); o1[e] = acc[ai][0][m][1][e] * fsigm(acc[ai][1][m][1][e]); }
                    *(u32x4*)(B3 + (rowb + ai * HALF + m * 16) * 1024 + 128 * j + cl) = pack8(o0, o1); }
        } else if (j < 12 || j >= 16) {
            bf16_t* dst; int pitch, coff; bool act;
            if (j < 6) { dst = B0; pitch = 1024; coff = 256 * (j - 4); act = true; }
            else if (j < 8) { dst = B0; pitch = 1024; coff = 512 + 256 * (j - 6); act = false; }
            else if (j < 10) { dst = B3; pitch = 1024; coff = 512 + 256 * (j - 8); act = false; }
            else if (j < 12) { dst = B4; pitch = 512; coff = 256 * (j - 10); act = true; }
            else if (j < 18) { dst = B2; pitch = 1024; coff = 256 * (j - 16); act = false; }
            else { dst = B2; pitch = 1024; coff = 512 + 256 * (j - 18); act = true; }
            const bool stat = (j == 8 || j == 9);
#pragma unroll
            for (int ai = 0; ai < 2; ++ai)
#pragma unroll
                for (int m = 0; m < 4; ++m) { const size_t row = rowb + ai * HALF + m * 16; float s = 0.f;
#pragma unroll
                    for (int bj = 0; bj < 2; ++bj) { f32x4 v0 = acc[ai][bj][m][0], v1 = acc[ai][bj][m][1];
                        if (act) {
#pragma unroll
                            for (int e = 0; e < 4; ++e) { v0[e] = v0[e] * fsigm(v0[e]); v1[e] = v1[e] * fsigm(v1[e]); } }
                        s += (v0[0] * v0[0] + v0[1] * v0[1]) + (v0[2] * v0[2] + v0[3] * v0[3]) + (v1[0] * v1[0] + v1[1] * v1[1]) + (v1[2] * v1[2] + v1[3] * v1[3]);
                        *(u32x4*)(dst + row * pitch + coff + 128 * bj + cl) = pack8(v0, v1); }
                    if (stat) { s += __shfl_xor(s, 16); s += __shfl_xor(s, 32); if (fq == 0) vss[row * 8 + (j - 8) * 4 + wc] = s; } }
        } else {
            const bool isk = j >= 14; const int jj = (j - 12) & 1; const float* g = isk ? gk : gq; const float sc = isk ? 1.f : C2;
            f32x4 gv[2][2];
#pragma unroll
            for (int bj = 0; bj < 2; ++bj) { gv[bj][0] = *(const f32x4*)(g + 32 * bj + 8 * fq) * sc; gv[bj][1] = *(const f32x4*)(g + 32 * bj + 8 * fq + 4) * sc; }
            bf16_t* dst = B1 + (isk ? 512 : 0) + 64 * (4 * jj + wc) + 8 * fq;
#pragma unroll
            for (int ai = 0; ai < 2; ++ai)
#pragma unroll
                for (int m = 0; m < 4; ++m) { const size_t row = rowb + ai * HALF + m * 16; float s = 0.f;
#pragma unroll
                    for (int bj = 0; bj < 2; ++bj) { const f32x4 v0 = acc[ai][bj][m][0], v1 = acc[ai][bj][m][1];
                        s += (v0[0] * v0[0] + v0[1] * v0[1]) + (v0[2] * v0[2] + v0[3] * v0[3]) + (v1[0] * v1[0] + v1[1] * v1[1]) + (v1[2] * v1[2] + v1[3] * v1[3]); }
                    s += __shfl_xor(s, 16); s += __shfl_xor(s, 32);
                    const float r = __builtin_amdgcn_rsqf(s * (1.f / 64.f) + EPS);
#pragma unroll
                    for (int bj = 0; bj < 2; ++bj) *(u32x4*)(dst + row * 1024 + 32 * bj) = pack8(acc[ai][bj][m][0] * r * gv[bj][0], acc[ai][bj][m][1] * r * gv[bj][1]); }
        }
    }
};
struct EpiMerge {
    unsigned char* gt; bf16_t* MG; const float* bgate;
    __device__ __forceinline__ void operator()(const f32x4 (&acc)[2][2][4][2], const Unit& u, int wr, int wc, int fr, int fq) const {
        const int tag = u.tag, br = tag >> 1; const size_t rowb = (size_t)u.pm * BM + wr * 64 + fr; const int col0 = u.pn * BM + 32 * wc + 8 * fq;
        u32x4* slots_ = (u32x4*)gt + ((wr * 4 + wc) * 64 + fq * 16 + fr); asm volatile("" : "+v"(slots_)); __attribute__((address_space(1))) u32x4* slots = (__attribute__((address_space(1))) u32x4*)slots_;
        if ((tag & 1) == 0) {
            f32x4 bv[2][2];
#pragma unroll
            for (int bj = 0; bj < 2; ++bj) { bv[bj][0] = *(const f32x4*)(bgate + br * 1024 + col0 + 128 * bj); bv[bj][1] = *(const f32x4*)(bgate + br * 1024 + col0 + 128 * bj + 4); }
#pragma unroll
            for (int ai = 0; ai < 2; ++ai)
#pragma unroll
                for (int m = 0; m < 4; ++m)
#pragma unroll
                    for (int bj = 0; bj < 2; ++bj) { f32x4 v0 = acc[ai][bj][m][0] + bv[bj][0], v1 = acc[ai][bj][m][1] + bv[bj][1];
#pragma unroll
                        for (int e = 0; e < 4; ++e) { v0[e] = fsigm(v0[e]); v1[e] = fsigm(v1[e]); }
                        slots[(size_t)(((ai * 4 + m) * 2 + bj) * 512)] = pack8(v0, v1); }
        } else {
#pragma unroll
            for (int ai = 0; ai < 2; ++ai)
#pragma unroll
                for (int m = 0; m < 4; ++m) {
#pragma unroll
                    for (int bj = 0; bj < 2; ++bj) { const u32x4 gw = slots[(size_t)(((ai * 4 + m) * 2 + bj) * 512)]; f32x4 g0, g1; unpack8(gw, g0, g1);
                        f32x4 v0 = g0 * acc[ai][bj][m][0], v1 = g1 * acc[ai][bj][m][1];
                        u32x4* p = (u32x4*)(MG + (rowb + ai * HALF + m * 16) * 1024 + col0 + 128 * bj);
                        if (br > 0) { const u32x4 ow = *p; f32x4 p0, p1; unpack8(ow, p0, p1); v0 += p0; v1 += p1; }
                        *p = pack8(v0, v1); }
                    if (m & 1) asm volatile("" ::: "memory"); }
        }
    }
};
struct EpiOut {
    const float* base; float* out;
    __device__ __forceinline__ void operator()(const f32x4 (&acc)[2][2][4][2], const Unit& u, int wr, int wc, int fr, int fq) const {
        const size_t rowb = (size_t)u.pm * BM + wr * 64 + fr; const int col0 = u.pn * BM + 32 * wc + 8 * fq;
#pragma unroll
        for (int ai = 0; ai < 2; ++ai)
#pragma unroll
            for (int m = 0; m < 4; ++m) {
#pragma unroll
                for (int bj = 0; bj < 2; ++bj) { const size_t o = (rowb + ai * HALF + m * 16) * D + col0 + 128 * bj;
                    const f32x4 b0 = *(const f32x4*)(base + o), b1 = *(const f32x4*)(base + o + 4);
                    *(f32x4*)(out + o) = b0 + acc[ai][bj][m][0]; *(f32x4*)(out + o + 4) = b1 + acc[ai][bj][m][1]; }
                if (m & 1) asm volatile("" ::: "memory"); }
    }
};
struct SchedG1 { TileOrder T; const char* A; const char* B;
    __device__ __forceinline__ bool next(int i, Unit& u) const { int pm, pn; if (!T.tile(i, pm, pn)) return false; u.pm = pm; u.pn = pn; u.tag = 0; u.nt = 16; u.A = A + (size_t)pm * (BM * PITCH * 2); u.B = B + (size_t)pn * (BM * PITCH * 2); return true; } };
struct SchedMerge { int pm, pn; bool ok; const char *ws, *wl;
    __device__ __forceinline__ bool next(int i, Unit& u) const { if (!ok || i >= 6) return false; const int br = i >> 1; u.pm = pm; u.pn = pn; u.tag = i;
        const size_t ro = (size_t)pm * (BM * PITCH * 2), co = (size_t)pn * (BM * PITCH * 2);
        if ((i & 1) == 0) { u.nt = 16; u.A = ws + WS_H + ro; u.B = wl + WO_WG + (size_t)br * (1024 * PITCH * 2) + co; }
        else { u.nt = 8; const size_t ao = br == 0 ? WS_B0 : (br == 1 ? WS_B0 + 1024 : WS_B1), bo = br == 0 ? WO_WAB : (br == 1 ? WO_WAB + 1024 : WO_WC); u.A = ws + ao + ro; u.B = wl + bo + co; }
        return true; } };
}

#define XB_TMO      128
#define XB_XCNT(j)  (256  + 64 * (j))
#define XB_XSUB(j)  (1280 + 64 * (j))
#define XB_XGEN(j)  (2304 + 64 * (j))
#define XB_TOP      3328
#define XB_TOPGEN   3392
#define XCD_BAR_WORDS 3456
#define XB_SPIN_CAP (1u << 18)
__device__ __forceinline__ unsigned xb_ld(unsigned* p)              { return __hip_atomic_load(p, __ATOMIC_RELAXED, __HIP_MEMORY_SCOPE_AGENT); }
__device__ __forceinline__ unsigned xb_add(unsigned* p, unsigned v) { return __hip_atomic_fetch_add(p, v, __ATOMIC_RELAXED, __HIP_MEMORY_SCOPE_AGENT); }
__device__ __forceinline__ unsigned xb_xcc_id() { return (unsigned)__builtin_amdgcn_s_getreg((3 << 11) | 20) & 0xFu; }
#define XB_SPIN(cond, bar) do { unsigned _sp = 0; while (cond) { __builtin_amdgcn_s_sleep(1); \
    if ((++_sp & 255u) == 0u) { if (xb_ld(&(bar)[XB_TMO])) break; if (_sp > XB_SPIN_CAP) { atomicAdd(&(bar)[XB_TMO], 1u); break; } } } } while (0)
struct XcdBarrier { unsigned* bar; unsigned x; volatile LAS unsigned* st; };
__device__ __forceinline__ XcdBarrier xcd_barrier_post(unsigned* bar, volatile LAS unsigned* st) {
    XcdBarrier b; b.bar = bar; b.x = xb_xcc_id(); b.st = st;
    if (threadIdx.x == 0) (void)xb_add(&bar[XB_XCNT(b.x)], 1u);
    return b;
}
__device__ __forceinline__ void xcd_barrier_complete(unsigned* bar, unsigned x, unsigned& nloc, unsigned& nx) {
    const unsigned G = gridDim.x * gridDim.y * gridDim.z;
    unsigned sum, cnt, mine, sp = 0u;
    for (;;) {
        sum = 0u; cnt = 0u; mine = 0u;
#pragma unroll
        for (unsigned j = 0; j < 16; ++j) { const unsigned c = xb_ld(&bar[XB_XCNT(j)]); sum += c; cnt += (c > 0u) ? 1u : 0u; mine = (j == x) ? c : mine; }
        if (sum == G) break;
        __builtin_amdgcn_s_sleep(1);
        if ((++sp & 255u) == 0u) { if (xb_ld(&bar[XB_TMO])) break; if (sp > XB_SPIN_CAP) { atomicAdd(&bar[XB_TMO], 1u); break; } }
    }
    nloc = mine > 0u ? mine : 1u; nx = cnt > 0u ? cnt : 1u;
}
__device__ __forceinline__ void xcd_barrier(const XcdBarrier& b) {
    asm volatile("s_waitcnt vmcnt(0)" ::: "memory");
    __syncthreads();
    if (threadIdx.x == 0) {
        unsigned* bar = b.bar;
        __builtin_amdgcn_s_waitcnt(0);
        unsigned nloc = b.st[0], nx = b.st[1];
        if (nloc == 0u) { xcd_barrier_complete(bar, b.x, nloc, nx); b.st[0] = nloc; b.st[1] = nx; }
        const unsigned old = xb_add(&bar[XB_XSUB(b.x)], 1u);
        const unsigned gen = old / nloc;
        if (old + 1u == (gen + 1u) * nloc) {
            __builtin_amdgcn_fence(__ATOMIC_RELEASE, "agent");
            asm volatile("s_waitcnt vmcnt(0)" ::: "memory");
            const unsigned og = xb_add(&bar[XB_TOP], 1u);
            const unsigned tg = og / nx;
            if (og + 1u == (tg + 1u) * nx) xb_add(&bar[XB_TOPGEN], 1u);
            else XB_SPIN(xb_ld(&bar[XB_TOPGEN]) == tg, bar);
            __builtin_amdgcn_fence(__ATOMIC_ACQUIRE, "agent");
            xb_add(&bar[XB_XGEN(b.x)], 1u);
            asm volatile("s_waitcnt vmcnt(0)" ::: "memory");
        } else {
            XB_SPIN(xb_ld(&bar[XB_XGEN(b.x)]) == gen, bar);
            __builtin_amdgcn_fence(__ATOMIC_ACQUIRE, "agent");
            asm volatile("s_waitcnt vmcnt(0)" ::: "memory");
        }
    }
    __syncthreads();
}

struct Args { const float* in[18]; float* out; unsigned char* ws; int ph_lo, ph_hi, li, pad; };
struct Frame { LAS unsigned char* lds; int tid, lane, wave, vcu, G; Ptrs P; };

__device__ __forceinline__ unsigned pk2(float lo, float hi) { return (unsigned)f2bf(lo) | ((unsigned)f2bf(hi) << 16); }
__device__ __forceinline__ void p0_transpose_item(const float* W, int ldw, int src_col, int k0, bf16_t* WT, size_t dst_row, int dst_col, LAS float* scr, int lane) {
#pragma unroll 8
    for (int i = 0; i < 32; ++i) { const int kk = 2 * i + (lane >> 5); scr[kk * 33 + (lane & 31)] = W[(size_t)(k0 + kk) * ldw + src_col + (lane & 31)]; }
    LDS_WAIT(); asm volatile("" ::: "memory");
    const int c = lane & 7;
#pragma unroll
    for (int j = 0; j < 4; ++j) { const int n = (lane >> 3) + 8 * j; const LAS float* s = scr + (8 * c) * 33 + n;
        u32x4 o; o.x = pk2(s[0 * 33], s[1 * 33]); o.y = pk2(s[2 * 33], s[3 * 33]); o.z = pk2(s[4 * 33], s[5 * 33]); o.w = pk2(s[6 * 33], s[7 * 33]);
        *(GAS u32x4*)(WT + (dst_row + n) * 1024 + dst_col + k0 + 8 * c) = o; }
    LDS_WAIT(); asm volatile("" ::: "memory");
}
__device__ __forceinline__ void p0_weights(Frame& F) {
    LAS float* scr = (LAS float*)(F.lds + RING_OFF + F.wave * 16384);
    const int gw = F.vcu * NWAVES + F.wave, NGW = F.G * NWAVES;
    constexpr int I_W1 = 16 * (N1 / 32), I_WG = 16 * 96, I_Y = 8 * 32, I_WO = 16 * 32, I_L = I_W1 + I_WG + 3 * I_Y + I_WO;
    for (int it = gw; it < NL * I_L; it += NGW) {
        const int l = it / I_L; int r = it % I_L;
        unsigned char* wl = F.P.ws + WS_W + (size_t)l * W_LAYER; const float* win = F.P.w_in + (size_t)l * D * NIN;
        if (r < I_W1) { const int kb = r / (N1 / 32), nb = r % (N1 / 32); p0_transpose_item(win, NIN, g1_col(32 * nb), 64 * kb, (bf16_t*)(wl + WO_W1), 32 * nb, 0, scr, F.lane); continue; } r -= I_W1;
        if (r < I_WG) { const int kb = r / 96, nb = r % 96; p0_transpose_item(win, NIN, 32 * nb, 64 * kb, (bf16_t*)(wl + WO_WG), 32 * nb, 0, scr, F.lane); continue; } r -= I_WG;
        if (r < I_Y) { const int kb = r / 32, nb = r % 32; p0_transpose_item(F.P.w_a + (size_t)l * DA * D, D, 32 * nb, 64 * kb, (bf16_t*)(wl + WO_WAB), 32 * nb, 0, scr, F.lane); continue; } r -= I_Y;
        if (r < I_Y) { const int kb = r / 32, nb = r % 32; p0_transpose_item(F.P.w_b + (size_t)l * DB * D, D, 32 * nb, 64 * kb, (bf16_t*)(wl + WO_WAB), 32 * nb, 512, scr, F.lane); continue; } r -= I_Y;
        if (r < I_Y) { const int kb = r / 32, nb = r % 32; p0_transpose_item(F.P.w_c + (size_t)l * DC * D, D, 32 * nb, 64 * kb, (bf16_t*)(wl + WO_WC), 32 * nb, 0, scr, F.lane); continue; } r -= I_Y;
        { const int kb = r / 32, nb = r % 32; p0_transpose_item(F.P.w_out + (size_t)l * D * D, D, 32 * nb, 64 * kb, (bf16_t*)(wl + WO_WO), 32 * nb, 0, scr, F.lane); }
    }
    bf16_t* WSB = (bf16_t*)(F.P.ws + WS_WSB);
    for (int i = (int)blockIdx.x * 512 + F.tid; i < NL * NG * CHK * CHK; i += F.G * 512) { const int s = i & 127, t = (i >> 7) & 127; WSB[i] = s <= t ? f2bf(F.P.w_s[i]) : (bf16_t)0; }
}
__device__ __forceinline__ void p0_ln(Frame& F, int l, const float* xin) {
    LAS float* wf = (LAS float*)(F.lds + RING_OFF);
    const float* g = F.P.norm_g + (size_t)l * D; const float* win = F.P.w_in + (size_t)l * D * NIN;
    __syncthreads();
    for (int i = F.tid; i < D * 8; i += 512) { const int k = i >> 3, e = i & 7; wf[i] = g[k] * win[(size_t)k * NIN + OC_F + e]; }
    __syncthreads();
    const int gw = F.vcu * NWAVES + F.wave, NGW = F.G * NWAVES;
    bf16_t* H = (bf16_t*)(F.P.ws + WS_H); float* LOGF = (float*)(F.P.ws + WS_LOGF);
    f32x4 gv[4];
#pragma unroll
    for (int j = 0; j < 4; ++j) gv[j] = ((const f32x4*)g)[64 * j + F.lane];
    for (int m = gw; m < M; m += NGW) {
        const GAS f32x4* xr = (const GAS f32x4*)(xin + (size_t)m * D) + F.lane;
        f32x4 v[4]; float ss = 0.f;
#pragma unroll
        for (int j = 0; j < 4; ++j) { v[j] = xr[64 * j]; ss += (v[j].x * v[j].x + v[j].y * v[j].y) + (v[j].z * v[j].z + v[j].w * v[j].w); }
        ss = wave_sum(ss);
        const float r = rsqrtf(ss * (1.f / D) + EPS);
        float f[8] = {0.f, 0.f, 0.f, 0.f, 0.f, 0.f, 0.f, 0.f};
        GAS unsigned long long* o8 = (GAS unsigned long long*)(H + (size_t)m * D) + F.lane;
#pragma unroll
        for (int j = 0; j < 4; ++j) {
            const f32x4 hv = v[j] * r * gv[j];
            o8[64 * j] = (unsigned long long)pk2(hv.x, hv.y) | ((unsigned long long)pk2(hv.z, hv.w) << 32);
#pragma unroll
            for (int i = 0; i < 4; ++i) { const LAS f32x4* w4 = (const LAS f32x4*)(wf + (256 * j + 4 * F.lane + i) * 8); const f32x4 wa = w4[0], wb = w4[1]; const float xv = v[j][i];
                f[0] += xv * wa.x; f[1] += xv * wa.y; f[2] += xv * wa.z; f[3] += xv * wa.w; f[4] += xv * wb.x; f[5] += xv * wb.y; f[6] += xv * wb.z; f[7] += xv * wb.w; }
        }
#pragma unroll
        for (int e = 0; e < 8; ++e) f[e] = wave_sum(f[e]);
        if (F.lane < 8) { float z = 0.f;
#pragma unroll
            for (int e = 0; e < 8; ++e) if (F.lane == e) z = f[e];
            z = z * r + F.P.b_f[l * NH + F.lane];
            LOGF[(size_t)m * 8 + F.lane] = fminf(z, 0.f) - log1pf(expf(-fabsf(z))); }
    }
    __syncthreads();
}
__device__ __forceinline__ void p1_scan(Frame& F, int bh) {
    LAS float* sh = (LAS float*)(F.lds + RING_OFF);
    const int b = bh / NH, h = bh % NH, t0 = F.tid * 8;
    const float* lf = (const float*)(F.P.ws + WS_LOGF) + ((size_t)b * SEQ + t0) * 8 + h;
    float c[8]; float run = 0.f;
#pragma unroll
    for (int i = 0; i < 8; ++i) { run += lf[i * 8]; c[i] = run; }
    float inc = run;
#pragma unroll
    for (int o = 1; o < 64; o <<= 1) { const float n = __shfl_up(inc, o); if (F.lane >= o) inc += n; }
    if (F.lane == 63) sh[F.wave] = inc;
    __syncthreads();
    float base = inc - run;
    for (int w = 0; w < F.wave; ++w) base += sh[w];
    float* cs = (float*)(F.P.ws + WS_CS) + (size_t)bh * SEQ + t0;
    *(f32x4*)cs = (f32x4){(base + c[0]) * LOG2E, (base + c[1]) * LOG2E, (base + c[2]) * LOG2E, (base + c[3]) * LOG2E};
    *(f32x4*)(cs + 4) = (f32x4){(base + c[4]) * LOG2E, (base + c[5]) * LOG2E, (base + c[6]) * LOG2E, (base + c[7]) * LOG2E};
    __syncthreads();
    LAS float* c2s = sh + 16;
#pragma unroll
    for (int i = 0; i < 8; ++i) c2s[t0 + i] = (base + c[i]) * LOG2E;
    __syncthreads();
    if (F.tid < SEQ / 256) { const int qb = F.tid, nt = 4 * qb + 4; const float cq = c2s[256 * qb]; int lo = 0, hi = nt - 4;
        while (lo < hi) { const int mid = (lo + hi) >> 1; if (cq - c2s[64 * mid + 63] >= -SKIP_L2) hi = mid; else lo = mid + 1; }
        ((int*)(F.P.ws + WS_TS))[bh * 16 + qb] = lo & ~1; }
    __syncthreads();
}


#include <hip/hip_bf16.h>
namespace attn_body {
using bf16=__hip_bfloat16;
using s16x4=__attribute__((ext_vector_type(4)))short;
using f32x16=__attribute__((ext_vector_type(16)))float;
constexpr int NHEAD=NH,D=64,DM=1024;
constexpr int NW=8,QBLK=32,QB=QBLK*NW,KVBLK=64,NQB=SEQ/QB;
__device__ __forceinline__ int crow(int r,int hi){return (r&3)+8*(r>>2)+4*hi;}
#define SBAR() __builtin_amdgcn_sched_barrier(0)
__device__ __forceinline__ void cmask(f32x16&p0,f32x16&p1,int jb,int qrel,int hi){
  const float NEG=-INFINITY; int kb=64*jb+4*hi;
  #pragma unroll
  for(int r=0;r<16;++r){int kv=kb+(r&3)+8*(r>>2); if(kv>qrel)p0[r]=NEG; if(kv+32>qrel)p1[r]=NEG;}
}
constexpr int NSLOT=3, SLOTB=8192;
constexpr int LDS_K=0, LDS_V=NSLOT*SLOTB, LDS_WS=2*NSLOT*SLOTB, LDS_OST=LDS_WS+NW*64*4, LDS_C2=LDS_OST+NW*4096, LDS_BYTES=LDS_C2+SEQ*4+512;
__device__ __forceinline__ void glds16(const void*gsrc,unsigned lds_dst){unsigned keep;
  asm volatile("s_mov_b32 %0, m0\n\ts_mov_b32 m0, %2\n\ts_nop 0\n\tglobal_load_lds_dwordx4 %1, off\n\ts_mov_b32 m0, %0":"=&s"(keep):"v"(gsrc),"s"(lds_dst):"memory");}
__device__ __forceinline__ float max3f(float a,float b,float c){float r;asm("v_max3_f32 %0, %1, %2, %3":"=v"(r):"v"(a),"v"(b),"v"(c));return r;}
__device__ __forceinline__ float max2f(float a,float b){float r;asm("v_max_f32_e32 %0, %1, %2":"=v"(r):"v"(a),"v"(b));return r;}
__device__ __forceinline__ float fadd_s(float a,float b){float r;asm("v_add_f32_e32 %0, %1, %2":"=v"(r):"v"(a),"v"(b));return r;}
__device__ __forceinline__ float fsub_s(float a,float b){float r;asm("v_sub_f32_e32 %0, %1, %2":"=v"(r):"v"(a),"v"(b));return r;}
typedef float f32x2_t __attribute__((ext_vector_type(2))); typedef __bf16 bf16x2_t __attribute__((ext_vector_type(2)));
__device__ __forceinline__ unsigned cvtpk_s(float lo,float hi){f32x2_t v={lo,hi};bf16x2_t b=__builtin_convertvector(v,bf16x2_t);return __builtin_bit_cast(unsigned,b);}
#define WAIT_BAR(N) asm volatile("s_waitcnt vmcnt(" #N ") lgkmcnt(0)\n\ts_barrier":::"memory")
__device__ __forceinline__ void split3(float x,unsigned&h,unsigned&m,unsigned&l){
  const unsigned u=__float_as_uint(x)&0xffff0000u; const float r1=x-__uint_as_float(u);
  const unsigned u1=__float_as_uint(r1)&0xffff0000u; const float r2=r1-__uint_as_float(u1);
  h=u>>16; m=u1>>16; l=__float_as_uint(r2)>>16; }
__device__ __forceinline__ bf16x8 make_qx(float base,int hi){ unsigned h,m,l; split3(base,h,m,l); u32x4 w; w.x=h|(m<<16); w.y=l|0x3f800000u; w.z=0x3f803f80u; w.w=0u; if(hi){w.x=0u;w.y=0u;w.z=0u;} return __builtin_bit_cast(bf16x8,w); }
__device__ __forceinline__ bf16x8 make_kx(float ck,int hi){ unsigned h,m,l; split3(-ck,h,m,l); u32x4 w; w.x=0x3f803f80u; w.y=0x3f80u|(h<<16); w.z=m|(l<<16); w.w=0u; if(hi){w.x=0u;w.y=0u;w.z=0u;} return __builtin_bit_cast(bf16x8,w); }

__device__ __forceinline__ void qkt(f32x16&p0,f32x16&p1,const char*Kslot,const bf16x8*qr,bf16x8 qx,bf16x8 kx0,bf16x8 kx1,int r32,int hi){
  const char*kb=Kslot+hi*1024+r32*16; const f32x16 z=f32x16{};
  p0=__builtin_amdgcn_mfma_f32_32x32x16_bf16(kx0,qx,z,0,0,0);p1=__builtin_amdgcn_mfma_f32_32x32x16_bf16(kx1,qx,z,0,0,0);
  #pragma unroll
  for(int d0=0;d0<4;++d0){
    const bf16x8 b0=*reinterpret_cast<const bf16x8*>(kb+d0*2048);
    const bf16x8 b1=*reinterpret_cast<const bf16x8*>(kb+d0*2048+512);
    p0=__builtin_amdgcn_mfma_f32_32x32x16_bf16(b0,qr[d0],p0,0,0,0);p1=__builtin_amdgcn_mfma_f32_32x32x16_bf16(b1,qr[d0],p1,0,0,0);}
}
typedef __attribute__((address_space(3))) const char* lds_cptr;
typedef short v4i16_t __attribute__((ext_vector_type(4)));
__device__ __forceinline__ void kload8(bf16x8*kf,lds_cptr kp){
  kf[0]=*(const __attribute__((address_space(3))) bf16x8*)(kp);      kf[1]=*(const __attribute__((address_space(3))) bf16x8*)(kp+512);
  kf[2]=*(const __attribute__((address_space(3))) bf16x8*)(kp+2048); kf[3]=*(const __attribute__((address_space(3))) bf16x8*)(kp+2560);
  kf[4]=*(const __attribute__((address_space(3))) bf16x8*)(kp+4096); kf[5]=*(const __attribute__((address_space(3))) bf16x8*)(kp+4608);
  kf[6]=*(const __attribute__((address_space(3))) bf16x8*)(kp+6144); kf[7]=*(const __attribute__((address_space(3))) bf16x8*)(kp+6656);
}
__device__ __forceinline__ void kload2(bf16x8*kf,lds_cptr kp,int j){ kf[2*j]=*(const __attribute__((address_space(3))) bf16x8*)(kp+j*2048); kf[2*j+1]=*(const __attribute__((address_space(3))) bf16x8*)(kp+j*2048+512); }
__device__ __forceinline__ s16x4 vtr(lds_cptr p){ return __builtin_bit_cast(s16x4,__builtin_amdgcn_ds_read_tr16_b64_v4i16((__attribute__((address_space(3))) v4i16_t*)p)); }
__device__ __forceinline__ float rowmax(const f32x16&p0,const f32x16&p1){
  float a=max3f(p0[0],p0[1],p1[0]),b=max3f(p0[2],p0[3],p1[1]);a=max3f(a,p1[2],p1[3]);
  #pragma unroll
  for(int r=4;r<16;r+=4){a=max3f(a,p0[r],p0[r+1]);b=max3f(b,p0[r+2],p0[r+3]);a=max3f(a,p1[r],p1[r+1]);b=max3f(b,p1[r+2],p1[r+3]);}
  const float m=max2f(a,b);
  auto rr=__builtin_amdgcn_permlane32_swap(__float_as_uint(m),__float_as_uint(m),false,false);
  return max2f(__uint_as_float(rr[0]),__uint_as_float(rr[1]));
}
__device__ __forceinline__ void pv(f32x16*o,int vb,bf16x8 pa0,bf16x8 pa1,bf16x8 pa2,bf16x8 pa3){
  #pragma unroll
  for(int d0=0;d0<2;++d0){s16x4 lo[4],hi[4];
    #pragma unroll
    for(int ks=0;ks<4;++ks){
      asm volatile("ds_read_b64_tr_b16 %0,%1 offset:%c2":"=&v"(lo[ks]):"v"(vb),"i"(d0*4096+ks*1024):"memory");
      asm volatile("ds_read_b64_tr_b16 %0,%1 offset:%c2":"=&v"(hi[ks]):"v"(vb),"i"(d0*4096+ks*1024+512):"memory");}
    asm volatile("s_waitcnt lgkmcnt(0)":::"memory");SBAR();
    #define PK(k) (bf16x8){lo[k][0],lo[k][1],lo[k][2],lo[k][3],hi[k][0],hi[k][1],hi[k][2],hi[k][3]}
    o[d0]=__builtin_amdgcn_mfma_f32_32x32x16_bf16(pa0,PK(0),o[d0],0,0,0);
    o[d0]=__builtin_amdgcn_mfma_f32_32x32x16_bf16(pa1,PK(1),o[d0],0,0,0);
    o[d0]=__builtin_amdgcn_mfma_f32_32x32x16_bf16(pa2,PK(2),o[d0],0,0,0);
    o[d0]=__builtin_amdgcn_mfma_f32_32x32x16_bf16(pa3,PK(3),o[d0],0,0,0);
    #undef PK
  }
}
#define ATTN_STORE16(p,v) (*(u32x4*)(p)=(v))
template<int THRL> __device__ __forceinline__ void attn_unit(int b,int h,int qb,const bf16*Q,const bf16*__restrict__ K,const bf16*__restrict__ V,const bf16*__restrict__ CZ,bf16*O,const float*__restrict__ c2g,int ts,float ub,char*shm){
  int tid=threadIdx.x; asm volatile("":"+v"(tid));
  const int lane=tid&63,r32=lane&31,hi=lane>>5; const int wid=__builtin_amdgcn_readfirstlane(tid>>6);
  const long rowbase=(long)b*SEQ; const int q0=qb*QB;
  const bf16*Qw=Q+(rowbase+q0+wid*QBLK)*DM+h*D;
  const bf16*Kh=K+(rowbase+(long)ts*KVBLK)*DM+h*D,*Vh=V+(rowbase+(long)ts*KVBLK)*DM+h*D;
  const unsigned lds0=(unsigned)(uintptr_t)shm;
  float*wsf=(float*)(shm+LDS_WS)+wid*64;
  float*c2l=(float*)(shm+LDS_C2);
  { const int kb0=ts*KVBLK; for(int i=tid*4;i<q0+QB-kb0;i+=NW*64*4)*(f32x4*)(c2l+i)=*(const f32x4*)(c2g+kb0+i); }
  const bf16*ksrc=Kh+(long)lane*DM+wid*8;
  const bf16*vsrc=Vh+(long)(16*(wid&3)+(lane>>2))*DM+(wid>>2)*32+(lane&3)*8;
  const unsigned kdst=lds0+LDS_K+wid*1024, vdst=lds0+LDS_V+wid*1024;
  #define DMA_K(t,slot) glds16(ksrc+(long)(t)*KVBLK*DM,(unsigned)__builtin_amdgcn_readfirstlane(kdst+(slot)))
  #define DMA_V(t,slot) glds16(vsrc+(long)(t)*KVBLK*DM,(unsigned)__builtin_amdgcn_readfirstlane(vdst+(slot)))
  const int vb0=(int)(lds0+LDS_V)+((lane>>4)&1)*32+(lane&3)*8+(4*hi+((lane&15)>>2))*64;
  const char*Kbase=shm+LDS_K; bf16x8 kf[8];
  const lds_cptr shm3=(lds_cptr)shm; const lds_cptr kp0=shm3+LDS_K+hi*1024+r32*16; const lds_cptr vp0=shm3+LDS_V+((lane>>4)&1)*32+(lane&3)*8+(4*hi+((lane&15)>>2))*64;
  const int NT=(q0+QB)/KVBLK-ts;
  DMA_K(0,0);DMA_V(0,0);DMA_K(1,SLOTB);
  bf16x8 qr[4];
  #pragma unroll
  for(int d0=0;d0<4;++d0)qr[d0]=*reinterpret_cast<const bf16x8*>(&Qw[(long)r32*DM+d0*16+hi*8]);
    float mhat=ub,l_reg=0.f;f32x16 o[2];o[0]=f32x16{};o[1]=f32x16{};
  const int qrel=wid*QBLK+r32;
  #define CMASK(P0,P1,t) do{int jb_=(t)-(NT-4); if(jb_>=0)cmask(P0,P1,jb_,qrel,hi);}while(0)
  bool resc=false;
  bf16x8 qx; float cq2;
  #define START(P0,P1) do{ resc=false; \
    _Pragma("unroll") for(int r=0;r<16;++r)P0[r]=__builtin_amdgcn_exp2f(P0[r]); }while(0)
  #define RESC() do{ if(resc){ asm volatile("s_waitcnt lgkmcnt(0)":::"memory"); \
      _Pragma("unroll") for(int d_=0;d_<2;++d_) _Pragma("unroll") for(int r=0;r<16;++r)o[d_][r]*=wsf[crow(r,hi)]; } }while(0)
  f32x16 pA0,pA1,pB0,pB1;
  int sl_prev=0,sl_cur=0,sl_next=SLOTB;
  #define ROT() do{sl_prev=sl_cur;sl_cur=sl_next;sl_next=(sl_next==(NSLOT-1)*SLOTB)?0:sl_next+SLOTB;}while(0)
  DMA_K(2,2*SLOTB);
  WAIT_BAR(3);
  cq2=c2l[q0+qrel-ts*KVBLK]; qx=make_qx(cq2-mhat,hi);
  float ck0=c2l[r32],ck1=c2l[32+r32];
  { const bf16x8 kx0=make_kx(ck0,hi),kx1=make_kx(ck1,hi);
    qkt(pA0,pA1,Kbase,qr,qx,kx0,kx1,r32,hi); }
  asm volatile("s_nop 15\n\ts_nop 7":"+v"(pA0),"+v"(pA1));CMASK(pA0,pA1,0);
  ck0=c2l[64+r32];ck1=c2l[96+r32];
  START(pA0,pA1);
  _Pragma("unroll") for(int r=0;r<16;++r)pA1[r]=__builtin_amdgcn_exp2f(pA1[r]);
  WAIT_BAR(0);
  DMA_K(3,0);DMA_V(1,SLOTB);
  ROT();
  kload8(kf,kp0+sl_cur);
  WAIT_BAR(2);
  s16x4 vlo[8],vhi[8]; u32x4 pw0,pw1,pw2,pw3;
  #define PKW(P,B) cvtpk_s(P[B],P[B+1])
  #define PAF(k) __builtin_bit_cast(bf16x8,pw##k)
  #define VFR(i) (bf16x8){vlo[i][0],vlo[i][1],vlo[i][2],vlo[i][3],vhi[i][0],vhi[i][1],vhi[i][2],vhi[i][3]}
  #define PIN(x) asm volatile("":"+v"(x))
  #define MX3(a,b,c) __builtin_fmaxf(__builtin_fmaxf((a),(b)),(c))
  #define GAPA(MF,A0,A1,A2,A3,W0,W1,PW) do{ MF; sacc+=A0; sacc+=A1; sacc+=A2; sacc+=A3; PIN(sacc); W0; W1; PIN(PW); SBAR(); }while(0)
  #define EX(v) __builtin_amdgcn_exp2f(v)
  #define GAPB(MF,X,B) do{ MF; X[B]=EX(X[B]); X[B+1]=EX(X[B+1]); X[B+2]=EX(X[B+2]); X[B+3]=EX(X[B+3]); PIN(X); SBAR(); }while(0)
  #define VRD(i) do{ vlo[i]=vtr(vp_+(((i)>>2)*4096+((i)&3)*1024)); vhi[i]=vtr(vp_+(((i)>>2)*4096+((i)&3)*1024+512)); }while(0)
  #define KRD(G,j) do{ if(G){ kload2(kf,kp0+sl_next,j); SBAR(); } }while(0)
  #define STEP(C0,C1,P0,P1,t,GK,GV,GL) do{ SBAR(); \
    const lds_cptr vp_=vp0+sl_prev; \
    { const bf16x8 kx0_=make_kx(ck0,hi),kx1_=make_kx(ck1,hi); const f32x16 z_=f32x16{}; \
      C0=__builtin_amdgcn_mfma_f32_32x32x16_bf16(kx0_,qx,z_,0,0,0); C1=__builtin_amdgcn_mfma_f32_32x32x16_bf16(kx1_,qx,z_,0,0,0); } SBAR(); \
    VRD(0); SBAR(); float sacc=(P0[0]+P0[1]); \
    GAPA(C0=__builtin_amdgcn_mfma_f32_32x32x16_bf16(kf[0],qr[0],C0,0,0,0), P0[2],P0[3],P0[4],P0[5],     pw0[0]=PKW(P0,0), pw0[1]=PKW(P0,2), pw0); \
    VRD(4); SBAR(); GAPA(C1=__builtin_amdgcn_mfma_f32_32x32x16_bf16(kf[1],qr[0],C1,0,0,0), P0[6],P0[7],P0[8],P0[9],     pw0[2]=PKW(P0,4), pw0[3]=PKW(P0,6), pw0); \
    VRD(1); SBAR(); GAPA(C0=__builtin_amdgcn_mfma_f32_32x32x16_bf16(kf[2],qr[1],C0,0,0,0),   P0[10],P0[11],P0[12],P0[13], pw1[0]=PKW(P0,8), pw1[1]=PKW(P0,10), pw1); \
    VRD(5); SBAR(); GAPA(C1=__builtin_amdgcn_mfma_f32_32x32x16_bf16(kf[3],qr[1],C1,0,0,0),   P0[14],P0[15],P1[0],P1[1],   pw1[2]=PKW(P0,12),pw1[3]=PKW(P0,14), pw1); \
    VRD(2); SBAR(); GAPA(C0=__builtin_amdgcn_mfma_f32_32x32x16_bf16(kf[4],qr[2],C0,0,0,0),   P1[2],P1[3],P1[4],P1[5],     pw2[0]=PKW(P1,0), pw2[1]=PKW(P1,2), pw2); \
    VRD(6); SBAR(); GAPA(C1=__builtin_amdgcn_mfma_f32_32x32x16_bf16(kf[5],qr[2],C1,0,0,0),   P1[6],P1[7],P1[8],P1[9],     pw2[2]=PKW(P1,4), pw2[3]=PKW(P1,6), pw2); \
    VRD(3); SBAR(); GAPA(C0=__builtin_amdgcn_mfma_f32_32x32x16_bf16(kf[6],qr[3],C0,0,0,0),   P1[10],P1[11],P1[12],P1[13], pw3[0]=PKW(P1,8), pw3[1]=PKW(P1,10), pw3); \
    VRD(7); SBAR(); GAPA(C1=__builtin_amdgcn_mfma_f32_32x32x16_bf16(kf[7],qr[3],C1,0,0,0),   P1[14],P1[15],0.f,0.f,       pw3[2]=PKW(P1,12),pw3[3]=PKW(P1,14), pw3); \
    l_reg+=sacc; \
    if(GK){DMA_K((t)+3,sl_cur);} if(GV){DMA_V((t)+1,sl_next);} \
    if(GL){ ck0=c2l[64*((t)+1)+r32]; ck1=c2l[64*((t)+1)+32+r32]; } \
    CMASK(C0,C1,t); \
    { float a=MX3(C0[0],C0[1],C1[0]),b=MX3(C0[2],C0[3],C1[1]); a=MX3(a,C1[2],C1[3]); \
      _Pragma("unroll") for(int r=4;r<16;r+=4){a=MX3(a,C0[r],C0[r+1]);b=MX3(b,C0[r+2],C0[r+3]);a=MX3(a,C1[r],C1[r+1]);b=MX3(b,C1[r+2],C1[r+3]);} \
      float rm=__builtin_fmaxf(a,b); { auto rr=__builtin_amdgcn_permlane32_swap(__float_as_uint(rm),__float_as_uint(rm),false,false); rm=__builtin_fmaxf(__uint_as_float(rr[0]),__uint_as_float(rr[1])); } \
      resc=false; \
      if(__builtin_expect(__any(rm>(float)THRL),0)){ const float dl=__builtin_fmaxf(rm,0.f); mhat+=dl; \
        _Pragma("unroll") for(int r=0;r<16;++r){C0[r]-=dl;C1[r]-=dl;} \
        qx=make_qx(cq2-mhat,hi); asm volatile("":"+v"(qx)); \
        const float f=__builtin_amdgcn_exp2f(-dl); l_reg*=f; if(hi==0)wsf[r32]=f; resc=true; } } \
    SBAR(); \
    GAPB(o[0]=__builtin_amdgcn_mfma_f32_32x32x16_bf16(PAF(0),VFR(0),o[0],0,0,0), C0,0); \
    GAPB(o[1]=__builtin_amdgcn_mfma_f32_32x32x16_bf16(PAF(0),VFR(4),o[1],0,0,0), C0,4); \
    KRD(GL,0); GAPB(o[0]=__builtin_amdgcn_mfma_f32_32x32x16_bf16(PAF(1),VFR(1),o[0],0,0,0), C0,8); \
    KRD(GL,1); GAPB(o[1]=__builtin_amdgcn_mfma_f32_32x32x16_bf16(PAF(1),VFR(5),o[1],0,0,0), C0,12); \
    KRD(GL,2); GAPB(o[0]=__builtin_amdgcn_mfma_f32_32x32x16_bf16(PAF(2),VFR(2),o[0],0,0,0), C1,0); \
    KRD(GL,3); GAPB(o[1]=__builtin_amdgcn_mfma_f32_32x32x16_bf16(PAF(2),VFR(6),o[1],0,0,0), C1,4); \
    GAPB(o[0]=__builtin_amdgcn_mfma_f32_32x32x16_bf16(PAF(3),VFR(3),o[0],0,0,0), C1,8); \
    GAPB(o[1]=__builtin_amdgcn_mfma_f32_32x32x16_bf16(PAF(3),VFR(7),o[1],0,0,0), C1,12); \
    }while(0)
  int t=1;
  #undef CMASK
  #define CMASK(P0,P1,t) do{}while(0)
  for(;t+5<NT;t+=2){
    STEP(pB0,pB1,pA0,pA1,t,true,true,true);     WAIT_BAR(2); RESC(); ROT();
    STEP(pA0,pA1,pB0,pB1,t+1,true,true,true);   WAIT_BAR(2); RESC(); ROT();
  }
  #undef CMASK
  #define CMASK(P0,P1,t) do{int jb_=(t)-(NT-4); if(jb_>=0)cmask(P0,P1,jb_,qrel,hi);}while(0)
  #define ENDW(tt) do{ if((tt)+3<NT){WAIT_BAR(2);} else if((tt)+2<NT){WAIT_BAR(1);} else {WAIT_BAR(0);} }while(0)
  for(;t+1<NT;t+=2){
    STEP(pB0,pB1,pA0,pA1,t,(t+3<NT),(t+1<NT),(t+1<NT));       ENDW(t);   RESC(); ROT();
    STEP(pA0,pA1,pB0,pB1,t+1,(t+4<NT),(t+2<NT),(t+2<NT));     ENDW(t+1); RESC(); ROT();
  }
  STEP(pB0,pB1,pA0,pA1,NT-1,false,false,false); RESC();
  { float sacc=pB0[0]+pB0[1]; _Pragma("unroll") for(int r=2;r<16;++r)sacc+=pB0[r]; _Pragma("unroll") for(int r=0;r<16;++r)sacc+=pB1[r]; l_reg+=sacc;
    pw0=(u32x4){PKW(pB0,0),PKW(pB0,2),PKW(pB0,4),PKW(pB0,6)};pw1=(u32x4){PKW(pB0,8),PKW(pB0,10),PKW(pB0,12),PKW(pB0,14)};pw2=(u32x4){PKW(pB1,0),PKW(pB1,2),PKW(pB1,4),PKW(pB1,6)};pw3=(u32x4){PKW(pB1,8),PKW(pB1,10),PKW(pB1,12),PKW(pB1,14)};
    SBAR(); pv(o,vb0+sl_cur,PAF(0),PAF(1),PAF(2),PAF(3)); }
  #undef PKW
  #undef PAF
  #undef VFR
  #undef PIN
  #undef MX3
  #undef GAPA
  #undef GAPB
  #undef EX
  #undef VRD
  #undef KRD
  #undef STEP
  #undef ENDW
  {auto rr=__builtin_amdgcn_permlane32_swap(__float_as_uint(l_reg),__float_as_uint(l_reg),false,false);l_reg=__uint_as_float(rr[0])+__uint_as_float(rr[1]);}
  if(hi==0)wsf[32+r32]=l_reg;asm volatile("s_waitcnt lgkmcnt(0)":::"memory");
  bf16*Ow=O+(rowbase+q0+wid*QBLK)*DM+h*D;
  const unsigned short*Cw=(const unsigned short*)(CZ+(rowbase+q0+wid*QBLK)*DM+h*D);
  { bf16*stg=(bf16*)(shm+LDS_OST)+wid*2048;
    #pragma unroll
    for(int r=0;r<16;++r){const int orow=crow(r,hi); const float rl=__builtin_amdgcn_rcpf(wsf[32+orow]);
      #pragma unroll
      for(int d0=0;d0<2;++d0){ const float cz=__uint_as_float((unsigned)Cw[(long)orow*DM+d0*32+r32]<<16); stg[orow*64+d0*32+r32]=__float2bfloat16(o[d0][r]*rl*cz);} }
    asm volatile("s_waitcnt lgkmcnt(0)":::"memory");
    #pragma unroll
    for(int i=0;i<4;++i){const int row=i*8+(lane>>3),ch=lane&7; const u32x4 v=*(const u32x4*)(stg+row*64+ch*8); ATTN_STORE16(Ow+(long)row*DM+ch*8,v);} }
  asm volatile("s_waitcnt lgkmcnt(0)\n\ts_barrier":::"memory");
  #undef DMA_K
  #undef DMA_V
  #undef CMASK
  #undef START
  #undef RESC
  #undef ROT
}
#undef SBAR
#undef WAIT_BAR
}

typedef float f32x2 __attribute__((ext_vector_type(2)));
__device__ __forceinline__ void p2_conv(Frame& F, int l, int unit, bf16_t* outb) {
    const int tid = F.tid, lane = F.lane, w = F.wave;
    const size_t row0 = (size_t)unit * 64; const int tseq0 = (int)(row0 % SEQ);
    const bf16_t* AG = (const bf16_t*)(F.P.ws + WS_B3); const bf16_t* B0 = (const bf16_t*)(F.P.ws + WS_B0);
    LAS unsigned char* tile = F.lds + RING_OFF;
    for (int c = tid; c < 94 * 64; c += 512) { const int r = c >> 6, ch = c & 63, tr = r - (CW - 1); const bool valid = tseq0 + tr >= 0;
        u32x4 v = (u32x4){0u, 0u, 0u, 0u}; if (valid) v = *(const u32x4*)(AG + (size_t)((long)row0 + tr) * 1024 + ch * 8);
        *(LAS u32x4*)(tile + r * 1024 + ch * 16) = v; }
    __syncthreads();
    f32x2 out[4][8]; float s1[8], s2[8];
#pragma unroll
    for (int o = 0; o < 8; ++o) { s1[o] = 0.f; s2[o] = 0.f; }
#pragma unroll
    for (int i = 0; i < 4; ++i) {
        __builtin_amdgcn_sched_barrier(0);
        int p = lane + 64 * i; asm volatile("" : "+v"(p));
        const float* cw = F.P.conv_w + (size_t)l * CW * DA + 2 * p;
        f32x2 wv[CW];
#pragma unroll
        for (int j = 0; j < CW; ++j) wv[j] = *(const f32x2*)(cw + j * DA);
        const f32x2 cb = *(const f32x2*)(F.P.conv_b + l * DA + 2 * p);
        const LAS unsigned* tp = (const LAS unsigned*)(tile + (8 * w) * 1024 + 4 * p);
        f32x2 win[16];
#pragma unroll
        for (int k = 0; k < 16; ++k) { const unsigned u = tp[k * 256]; win[k] = (f32x2){__uint_as_float(u << 16), __uint_as_float(u & 0xffff0000u)}; }
#pragma unroll
        for (int o = 0; o < 8; ++o) out[i][o] = cb;
        __builtin_amdgcn_sched_barrier(0);
#pragma unroll
        for (int j = 0; j < CW; ++j) {
#pragma unroll
            for (int o = 0; o < 8; ++o) out[i][o] += wv[j] * win[(j + o) & 15];
            asm volatile("" : "+v"(out[i][0]), "+v"(out[i][1]), "+v"(out[i][2]), "+v"(out[i][3]), "+v"(out[i][4]), "+v"(out[i][5]), "+v"(out[i][6]), "+v"(out[i][7]));
            if (j + 16 < 38) { const LAS unsigned* tq = tp + (j + 16) * 256; asm volatile("" : "+v"(tq)); const unsigned u = *tq; win[j & 15] = (f32x2){__uint_as_float(u << 16), __uint_as_float(u & 0xffff0000u)}; }
            __builtin_amdgcn_sched_barrier(0);
        }
#pragma unroll
        for (int o = 0; o < 8; ++o) { s1[o] += out[i][o].x + out[i][o].y; s2[o] += out[i][o].x * out[i][o].x + out[i][o].y * out[i][o].y; }
    }
    unsigned az[4][8];
#pragma unroll
    for (int i = 0; i < 4; ++i)
#pragma unroll
        for (int o = 0; o < 8; ++o) az[i][o] = *(const unsigned*)(B0 + (row0 + 8 * w + o) * 1024 + 2 * (lane + 64 * i));
#pragma unroll
    for (int o = 0; o < 8; ++o) { s1[o] = wave_sum(s1[o]); s2[o] = wave_sum(s2[o]); }
#pragma unroll
    for (int i = 0; i < 4; ++i) {
        const int p = lane + 64 * i;
        const f32x2 gg = *(const f32x2*)(F.P.cn_g + l * DA + 2 * p), be = *(const f32x2*)(F.P.cn_b + l * DA + 2 * p);
#pragma unroll
        for (int o = 0; o < 8; ++o) { const float mu = s1[o] * (1.f / DA), ex2 = s2[o] * (1.f / DA); const float rstd = rsqrtf(fmaxf(ex2 - mu * mu, 0.f) + EPS);
            f32x2 y = (out[i][o] - mu) * rstd * gg + be; y.x = y.x * fsigm(y.x); y.y = y.y * fsigm(y.y);
            *(unsigned*)(outb + (row0 + 8 * w + o) * 1024 + 2 * p) = cvt_pk_bf16(y.x * __uint_as_float(az[i][o] << 16), y.y * __uint_as_float(az[i][o] & 0xffff0000u)); }
    }
    __syncthreads();
}
__device__ __forceinline__ void p2_gmlp(Frame& F, int l, int unit, bf16_t* outb) {
    constexpr int VTP = 136;
    const int tid = F.tid, lane = F.lane, w = F.wave, fr = lane & 15, fq = lane >> 4, ch = unit >> 1, gp = unit & 1, c0 = 256 * gp; const size_t row0 = (size_t)ch * CHK;
    LAS bf16_t* vt = (LAS bf16_t*)(F.lds + RING_OFF);
    const bf16_t* V = (const bf16_t*)(F.P.ws + WS_B3) + 512 + c0; const bf16_t* U = (const bf16_t*)(F.P.ws + WS_B0) + 512 + c0; const bf16_t* BZ = (const bf16_t*)(F.P.ws + WS_B4) + c0;
    const float* vss = (const float*)(F.P.ws + WS_VSS); const float* gn = F.P.gn_g + l * DB + c0;
    const size_t t = row0 + 16 * w + fr;
    unsigned long long uu[16], zz[16];
#pragma unroll
    for (int n = 0; n < 16; ++n) { uu[n] = *(const unsigned long long*)(U + t * 1024 + 16 * n + 4 * fq); zz[n] = *(const unsigned long long*)(BZ + t * 512 + 16 * n + 4 * fq); }
    bf16x8 wf[2][4];
#pragma unroll
    for (int g2 = 0; g2 < 2; ++g2)
#pragma unroll
        for (int ks = 0; ks < 4; ++ks) wf[g2][ks] = *(const bf16x8*)((const bf16_t*)(F.P.ws + WS_WSB) + ((size_t)(l * NG + 2 * gp + g2) * CHK + 16 * w + fr) * CHK + 32 * ks + 8 * fq);
    const float bs0 = F.P.b_s[(size_t)(l * NG + 2 * gp) * CHK + 16 * w + fr], bs1 = F.P.b_s[(size_t)(l * NG + 2 * gp + 1) * CHK + 16 * w + fr];
    { const int sidx = tid & 127; const f32x4 qa = *(const f32x4*)(vss + (row0 + sidx) * 8), qb = *(const f32x4*)(vss + (row0 + sidx) * 8 + 4);
      const float ss = ((qa.x + qa.y) + (qa.z + qa.w)) + ((qb.x + qb.y) + (qb.z + qb.w)); const float rv = rsqrtf(ss * (1.f / DB) + EPS);
      u32x4 raw[8];
#pragma unroll
      for (int k = 0; k < 8; ++k) raw[k] = *(const u32x4*)(V + (row0 + sidx) * 1024 + ((tid >> 7) + 4 * k) * 8);
#pragma unroll
      for (int k = 0; k < 8; ++k) { const int c8 = ((tid >> 7) + 4 * k) * 8; f32x4 v0, v1; unpack8(raw[k], v0, v1); const f32x4 g0 = *(const f32x4*)(gn + c8), g1 = *(const f32x4*)(gn + c8 + 4);
          v0 = v0 * rv * g0; v1 = v1 * rv * g1;
#pragma unroll
          for (int e = 0; e < 4; ++e) { vt[(c8 + e) * VTP + sidx] = f2bf(v0[e]); vt[(c8 + 4 + e) * VTP + sidx] = f2bf(v1[e]); } } }
    __syncthreads();
    f32x4 acc[16];
#pragma unroll
    for (int n = 0; n < 16; ++n) acc[n] = (f32x4){0.f, 0.f, 0.f, 0.f};
#pragma unroll
    for (int ks = 0; ks < 4; ++ks) {
        if (32 * ks <= 16 * w + 15) {
#pragma unroll
            for (int n = 0; n < 16; ++n) { const bf16x8 vf = *(const LAS bf16x8*)(vt + (16 * n + fr) * VTP + 32 * ks + 8 * fq); acc[n] = __builtin_amdgcn_mfma_f32_16x16x32_bf16(vf, wf[n >> 3][ks], acc[n], 0, 0, 0); }
        }
    }
#pragma unroll
    for (int n = 0; n < 16; ++n) { const float bs = n < 8 ? bs0 : bs1;
        const unsigned u0 = (unsigned)uu[n], u1 = (unsigned)(uu[n] >> 32), z0 = (unsigned)zz[n], z1 = (unsigned)(zz[n] >> 32);
        const float o0 = __uint_as_float(u0 << 16) * (acc[n][0] + bs) * __uint_as_float(z0 << 16), o1 = __uint_as_float(u0 & 0xffff0000u) * (acc[n][1] + bs) * __uint_as_float(z0 & 0xffff0000u);
        const float o2 = __uint_as_float(u1 << 16) * (acc[n][2] + bs) * __uint_as_float(z1 << 16), o3 = __uint_as_float(u1 & 0xffff0000u) * (acc[n][3] + bs) * __uint_as_float(z1 & 0xffff0000u);
        *(unsigned long long*)(outb + 512 + c0 + t * 1024 + 16 * n + 4 * fq) = (unsigned long long)cvt_pk_bf16(o0, o1) | ((unsigned long long)cvt_pk_bf16(o2, o3) << 32); }
    __syncthreads();
}

__global__ void __launch_bounds__(NWAVES * 64, 2) mk_fwd(Args args) {
    extern __shared__ __attribute__((aligned(16))) unsigned char lds[];
    Frame F;
    F.lds = (LAS unsigned char*)lds;
    volatile LAS unsigned* MISC = (volatile LAS unsigned*)(F.lds + MISC_OFF);
    F.tid = threadIdx.x; F.lane = F.tid & 63; F.wave = __builtin_amdgcn_readfirstlane(F.tid >> 6);
    F.G = gridDim.x; { const int bx = blockIdx.x; F.vcu = (F.G % 8 == 0) ? (bx % 8) * (F.G / 8) + bx / 8 : bx; }
    F.P.x = args.in[0]; F.P.norm_g = args.in[1]; F.P.w_in = args.in[2]; F.P.b_gate = args.in[3]; F.P.conv_w = args.in[4]; F.P.conv_b = args.in[5]; F.P.cn_g = args.in[6]; F.P.cn_b = args.in[7]; F.P.w_a = args.in[8];
    F.P.gn_g = args.in[9]; F.P.w_s = args.in[10]; F.P.b_s = args.in[11]; F.P.w_b = args.in[12]; F.P.qn_g = args.in[13]; F.P.kn_g = args.in[14]; F.P.b_f = args.in[15]; F.P.w_c = args.in[16]; F.P.w_out = args.in[17];
    F.P.out = args.out; F.P.ws = args.ws;
    gu32* ctl = (gu32*)(args.ws + WS_CTL);
    for (int u = F.tid; u < (LDS_BYTES - LDSCTL_OFF) / 4; u += NWAVES * 64) ((LAS unsigned*)(F.lds + LDSCTL_OFF))[u] = 0u;
    __syncthreads();
    XcdBarrier bar = xcd_barrier_post((unsigned*)(ctl + CW_BAR) + args.li * XCD_BAR_WORDS, MISC + 8);

    bool dup_done = false;
    for (int ph = args.ph_lo; ph < args.ph_hi;) {
        const int l = ph / 5, p = ph % 5;
        const bool dummy = (PROBE_DUP >= 0) && p == PROBE_DUP && !dup_done;
        asm volatile("" : "+v"(F.tid)); F.lane = F.tid & 63;
        int bid = (int)blockIdx.x; asm volatile("" : "+s"(bid));
        unsigned char* ws = F.P.ws; unsigned char* wl = ws + WS_W + (size_t)l * W_LAYER;
        const float* xin = l == 0 ? F.P.x : F.P.out;
        if (p == 0) {
            if (l == 0) p0_weights(F);
            p0_ln(F, l, xin);
        } else if (p == 1) {
            if (bid < NB * NH) p1_scan(F, bid);
            pg8::SchedG1 S; S.T.init(M, N1, F.G, bid); S.A = (const char*)(ws + WS_H); S.B = (const char*)(wl + WO_W1);
            pg8::EpiG1 E{(bf16_t*)(ws + WS_B0), (bf16_t*)(ws + WS_B1), (bf16_t*)(ws + WS_B2), (bf16_t*)(ws + WS_B3), (bf16_t*)(ws + WS_B4), (float*)(ws + WS_VSS), F.P.qn_g + l * HD, F.P.kn_g + l * HD};
            pg8::gemm_phase<pg8::EpiG1, pg8::SchedG1>(F.lds + RING_OFF, S, E);
        } else if (p == 2) {
            if (!dummy || (PROBE_SUB & 1)) p2_conv(F, l, bid, dummy ? (bf16_t*)(ws + WS_DUMMY) : (bf16_t*)(ws + WS_B0));
            if (!dummy || (PROBE_SUB & 2)) { bf16_t* ob = dummy ? (bf16_t*)(ws + WS_DUMMY) : (bf16_t*)(ws + WS_B0); p2_gmlp(F, l, bid, ob); }
            if (!dummy || (PROBE_SUB & 4)) { const int bh = F.vcu >> 3, sq = F.vcu & 7; const attn_body::bf16* b1 = (const attn_body::bf16*)(ws + WS_B1); const attn_body::bf16* b2 = (const attn_body::bf16*)(ws + WS_B2);
              const float* c2g = (const float*)(ws + WS_CS) + (size_t)bh * SEQ; const int* tsg = (const int*)(ws + WS_TS) + bh * 16;
              float gqm = fabsf(F.P.qn_g[l * HD + F.lane]), gkm = fabsf(F.P.kn_g[l * HD + F.lane]);
#pragma unroll
              for (int o_ = 1; o_ < 64; o_ <<= 1) { gqm = fmaxf(gqm, __shfl_xor(gqm, o_)); gkm = fmaxf(gkm, __shfl_xor(gkm, o_)); }
              const float ub = 64.f * C2 * gqm * gkm * 1.01f;
              for (int i = 0; i < 2; ++i) { const int qb = i == 0 ? 15 - sq : sq; const int ts = __builtin_amdgcn_readfirstlane(tsg[qb]); attn_body::attn_unit<8>(bh / NH, bh % NH, qb, b1, b1 + 512, b2, b2 + 512, dummy ? (attn_body::bf16*)(ws + WS_DUMMY) : (attn_body::bf16*)(ws + WS_B1), c2g, ts, ub, (char*)lds + RING_OFF); } }
        } else if (p == 3) {
            pg8::TileOrder T; T.init(M, D, F.G, bid);
            pg8::SchedMerge S; { int pm_ = 0, pn_ = 0; S.ok = T.tile(0, pm_, pn_); S.pm = pm_; S.pn = pn_; }
            S.ws = (const char*)ws; S.wl = (const char*)wl;
            pg8::EpiMerge E{ws + WS_GT + (size_t)bid * 131072, (bf16_t*)(ws + WS_MG), F.P.b_gate + (size_t)l * 3072};
            pg8::gemm_phase<pg8::EpiMerge, pg8::SchedMerge>(F.lds + RING_OFF, S, E);
        } else {
            pg8::SchedG1 S; S.T.init(M, D, F.G, bid); S.A = (const char*)(ws + WS_MG); S.B = (const char*)(wl + WO_WO);
            pg8::EpiOut E{xin, dummy ? (float*)(ws + WS_H) : F.P.out};
            pg8::gemm_phase<pg8::EpiOut, pg8::SchedG1>(F.lds + RING_OFF, S, E);
        }
        if (dummy) { dup_done = true; continue; }
        dup_done = false; ++ph;
        if (ph < args.ph_hi) xcd_barrier(bar);
    }
}

#ifndef MK_MODE
#define MK_MODE 2
#endif
extern "C" void kernel_launch(void* const* d_in, const int* in_sizes, int n_in, void* d_out, int out_size, void* d_ws, size_t ws_size, hipStream_t stream) {
    static int ok = 0;
    if (ok == 0) {
        if (n_in != 18 || in_sizes[0] != M * D || out_size != M * D || ws_size < WS_END) { fprintf(stderr, "kernel_launch: unexpected shapes (n_in %d in0 %d out %d ws %zu)\n", n_in, n_in > 0 ? in_sizes[0] : -1, out_size, ws_size); ok = -1; return; }
        const int tl = 64 * TLD * 4;
        (void)hipFuncSetAttribute((const void*)nv_gemm1, hipFuncAttributeMaxDynamicSharedMemorySize, tl);
        (void)hipFuncSetAttribute((const void*)nv_merge, hipFuncAttributeMaxDynamicSharedMemorySize, 2 * 64 * 256 * 4);
        (void)hipFuncSetAttribute((const void*)nv_gmlp, hipFuncAttributeMaxDynamicSharedMemorySize, 128 * 129 * 4);
        (void)hipFuncSetAttribute((const void*)nv_attn, hipFuncAttributeMaxDynamicSharedMemorySize, 4 * SEQ * 4);
        if (hipFuncSetAttribute((const void*)mk_fwd, hipFuncAttributeMaxDynamicSharedMemorySize, LDS_BYTES) != hipSuccess) { fprintf(stderr, "kernel_launch: hipFuncSetAttribute(mk_fwd) failed\n"); ok = -1; return; }
        int dev = 0, cus = 0; (void)hipGetDevice(&dev); (void)hipDeviceGetAttribute(&cus, hipDeviceAttributeMultiprocessorCount, dev);
        if (cus != 256) fprintf(stderr, "kernel_launch: note: %d CUs (built for 256)\n", cus);
        (void)hipGetLastError();
        ok = 1;
    }
    if (ok < 0) return;
    Ptrs P{};
    const float** pp = (const float**)&P;
    for (int i = 0; i < 18; ++i) pp[i] = (const float*)d_in[i];
    P.out = (float*)d_out; P.ws = (unsigned char*)d_ws;
    const int tl = 64 * TLD * 4;
#if MK_MODE == 0
    nv_prep<<<2048, 256, 0, stream>>>(P);
    for (int l = 0; l < NL; ++l) {
        const float* xin = l == 0 ? P.x : P.out;
        nv_ln<<<M / 4, 256, 0, stream>>>(P, l, xin);
        nv_scan<<<NB * NH, 256, 0, stream>>>(P);
        nv_gemm1<<<dim3(20, 256), 256, tl, stream>>>(P, l);
        nv_conv<<<M, 512, 0, stream>>>(P, l);
        nv_gmlp<<<dim3(128, 4), 256, 128 * 129 * 4, stream>>>(P, l);
        nv_attn<<<M * NH / 4, 256, 4 * SEQ * 4, stream>>>(P);
        nv_merge<<<dim3(4, 256), 256, 2 * 64 * 256 * 4, stream>>>(P, l);
        nv_out<<<dim3(4, 256), 256, 0, stream>>>(P, l, xin, P.out);
    }
#else
    (void)tl;
    if (hipMemsetAsync((char*)d_ws + WS_CTL, 0, CTL_ZERO_BYTES, stream) != hipSuccess) { fprintf(stderr, "kernel_launch: memset failed\n"); return; }
    Args a{};
    for (int i = 0; i < 18; ++i) a.in[i] = (const float*)d_in[i];
    a.out = (float*)d_out; a.ws = (unsigned char*)d_ws;
    auto mk = [&](int lo, int hi, int li) { a.ph_lo = lo; a.ph_hi = hi; a.li = li; hipLaunchKernelGGL(mk_fwd, dim3(256), dim3(NWAVES * 64), LDS_BYTES, stream, a);
        const hipError_t le = hipPeekAtLastError(); if (le != hipSuccess) fprintf(stderr, "kernel_launch: mk launch [%d,%d) failed: %s\n", lo, hi, hipGetErrorName(le)); };
#if MK_MODE == 1
    auto mixers = [&](int l) { nv_conv<<<M, 512, 0, stream>>>(P, l); nv_gmlp<<<dim3(128, 4), 256, 128 * 129 * 4, stream>>>(P, l); nv_attn<<<M * NH / 4, 256, 4 * SEQ * 4, stream>>>(P); };
    mk(0, 2, 0); mixers(0); mk(3, 7, 1); mixers(1); mk(8, 10, 2);
#else
    mk(0, NPH, 0);
#endif
#endif
}
```

```cpp
#include <hip/hip_runtime.h>
#include <cstdio>
#include <cstdint>
#include <cmath>

constexpr int NL = 2, NB = 4, SEQ = 4096, M = NB * SEQ, D = 1024;
constexpr int DA = 512, DB = 512, NH = 8, HD = 64, DC = 512, CW = 31, CHK = 128, NG = 4, GD = 128, NIN = 8200;
constexpr float EPS = 1e-6f;
constexpr float LOG2E = 1.4426950408889634f;
constexpr float C2 = 0.125f * LOG2E;
constexpr int N1 = 5120;
constexpr int OC_GATE = 0, OC_AIN = 3072, OC_AZ = 4096, OC_U = 4608, OC_V = 5120, OC_BZ = 5632, OC_Q = 6144, OC_K = 6656, OC_VA = 7168, OC_CZ = 7680, OC_F = 8192;

constexpr size_t MiB = 1u << 20;
constexpr size_t WS_CTL = 0, CTL_ZERO_BYTES = 1 * MiB;
constexpr size_t WS_VSS = 1 * MiB;
constexpr size_t WS_LOGF = WS_VSS + 512 * 1024;
constexpr size_t WS_CS = 2 * MiB;
constexpr size_t WS_WSB = WS_CS + 512 * 1024;
constexpr size_t WS_TS = 3 * MiB;
constexpr size_t WS_W = 4 * MiB, W_LAYER = 22 * MiB;
constexpr size_t WO_W1 = 0, WO_WG = 10 * MiB, WO_WAB = 16 * MiB, WO_WC = 18 * MiB, WO_WO = 20 * MiB;
constexpr size_t WS_H = 48 * MiB;
constexpr size_t WS_B0 = 80 * MiB;
constexpr size_t WS_B1 = 112 * MiB;
constexpr size_t WS_B2 = 144 * MiB;
constexpr size_t WS_B3 = 176 * MiB;
constexpr size_t WS_B4 = 208 * MiB;
constexpr size_t WS_GT = WS_B2, WS_MG = WS_B3;
constexpr size_t WS_DUMMY = 224 * MiB;
constexpr size_t WS_END = 256 * MiB;
#ifndef PROBE_SUB
#define PROBE_SUB 7
#endif
#ifndef PROBE_DUP
#define PROBE_DUP -1
#endif

typedef unsigned short bf16_t;
typedef short bf16x8 __attribute__((ext_vector_type(8)));
typedef float f32x4 __attribute__((ext_vector_type(4)));
typedef unsigned u32x4 __attribute__((ext_vector_type(4)));

__host__ __device__ __forceinline__ float bf2f(bf16_t v) { union { unsigned u; float f; } c; c.u = (unsigned)v << 16; return c.f; }
__host__ __device__ __forceinline__ bf16_t f2bf(float f) { union { unsigned u; float f; } c; c.f = f; unsigned u = c.u; return (bf16_t)((u + 0x7fffu + ((u >> 16) & 1u)) >> 16); }
__device__ __forceinline__ float bfr(float f) { return bf2f(f2bf(f)); }
__device__ __forceinline__ float sigm(float x) { return 1.f / (1.f + __expf(-x)); }
__device__ __forceinline__ float siluf(float x) { return x * sigm(x); }

__host__ __device__ __forceinline__ int g1_col(int n) {
    const int j = n >> 8, lc = n & 255;
    if (j < 4) return lc < 128 ? OC_AIN + 128 * j + lc : OC_AIN + 512 + 128 * j + (lc - 128);
    if (j < 6) return OC_AZ + 256 * (j - 4) + lc;
    if (j < 8) return OC_U + 256 * (j - 6) + lc;
    if (j < 10) return OC_V + 256 * (j - 8) + lc;
    if (j < 12) return OC_BZ + 256 * (j - 10) + lc;
    if (j < 16) { const int isk = j >= 14, jj = (j - 12) & 1, head = 4 * jj + ((lc >> 5) & 3), d = 32 * (lc >> 7) + (lc & 31); return (isk ? OC_K : OC_Q) + 64 * head + d; }
    if (j < 18) return OC_VA + 256 * (j - 16) + lc;
    return OC_CZ + 256 * (j - 18) + lc;
}

struct Ptrs {
    const float *x, *norm_g, *w_in, *b_gate, *conv_w, *conv_b, *cn_g, *cn_b, *w_a, *gn_g, *w_s, *b_s, *w_b, *qn_g, *kn_g, *b_f, *w_c, *w_out;
    float* out; unsigned char* ws;
};

__global__ void nv_prep(Ptrs P) {
    const size_t gid = (size_t)blockIdx.x * blockDim.x + threadIdx.x, gsz = (size_t)gridDim.x * blockDim.x;
    for (int l = 0; l < NL; ++l) {
        unsigned char* wl = P.ws + WS_W + (size_t)l * W_LAYER;
        bf16_t* W1 = (bf16_t*)(wl + WO_W1); bf16_t* WG = (bf16_t*)(wl + WO_WG); bf16_t* WAB = (bf16_t*)(wl + WO_WAB); bf16_t* WC = (bf16_t*)(wl + WO_WC); bf16_t* WO = (bf16_t*)(wl + WO_WO);
        const float* win = P.w_in + (size_t)l * D * NIN;
        for (size_t i = gid; i < (size_t)N1 * D; i += gsz) { const int n = (int)(i >> 10), k = (int)(i & 1023); W1[i] = f2bf(win[(size_t)k * NIN + g1_col(n)]); }
        for (size_t i = gid; i < (size_t)3072 * D; i += gsz) { const int n = (int)(i >> 10), k = (int)(i & 1023); WG[i] = f2bf(win[(size_t)k * NIN + n]); }
        for (size_t i = gid; i < (size_t)1024 * 1024; i += gsz) { const int n = (int)(i >> 10), k = (int)(i & 1023);
            WAB[i] = f2bf(k < 512 ? P.w_a[((size_t)l * DA + k) * D + n] : P.w_b[((size_t)l * DB + (k - 512)) * D + n]);
            WC[i] = k < 512 ? f2bf(P.w_c[((size_t)l * DC + k) * D + n]) : (bf16_t)0;
            WO[i] = f2bf(P.w_out[((size_t)l * D + k) * D + n]); }
        bf16_t* WSB = (bf16_t*)(P.ws + WS_WSB) + (size_t)l * NG * CHK * CHK;
        for (size_t i = gid; i < (size_t)NG * CHK * CHK; i += gsz) { const int s = (int)(i & 127), t = (int)((i >> 7) & 127); WSB[i] = s <= t ? f2bf(P.w_s[(size_t)l * NG * CHK * CHK + i]) : (bf16_t)0; }
    }
}

__device__ __forceinline__ float wave_sum(float v) {
#pragma unroll
    for (int o = 1; o < 64; o <<= 1) v += __shfl_xor(v, o);
    return v;
}

__global__ void nv_ln(Ptrs P, int l, const float* xin) {
    const int lane = threadIdx.x & 63, row = blockIdx.x * 4 + (threadIdx.x >> 6);
    const float* xr = xin + (size_t)row * D; const float* g = P.norm_g + (size_t)l * D; const float* win = P.w_in + (size_t)l * D * NIN;
    float v[16]; float ss = 0.f;
#pragma unroll
    for (int j = 0; j < 16; ++j) { v[j] = xr[lane + 64 * j]; ss += v[j] * v[j]; }
    ss = wave_sum(ss);
    const float r = rsqrtf(ss * (1.f / D) + EPS);
    bf16_t* h = (bf16_t*)(P.ws + WS_H) + (size_t)row * D;
    float f[8] = {0, 0, 0, 0, 0, 0, 0, 0};
#pragma unroll
    for (int j = 0; j < 16; ++j) { const int k = lane + 64 * j; const float hv = v[j] * r * g[k]; h[k] = f2bf(hv);
#pragma unroll
        for (int e = 0; e < 8; ++e) f[e] += hv * win[(size_t)k * NIN + OC_F + e]; }
#pragma unroll
    for (int e = 0; e < 8; ++e) f[e] = wave_sum(f[e]);
    if (lane < 8) { float z = 0.f;
#pragma unroll
        for (int e = 0; e < 8; ++e) if (lane == e) z = f[e];
        z += P.b_f[l * NH + lane];
        const float lf = fminf(z, 0.f) - log1pf(expf(-fabsf(z)));
        ((float*)(P.ws + WS_LOGF))[(size_t)row * 8 + lane] = lf; }
}

__global__ void nv_scan(Ptrs P) {
    __shared__ float buf[SEQ];
    const int bh = blockIdx.x, b = bh / NH, h = bh % NH;
    const float* lf = (const float*)(P.ws + WS_LOGF);
    for (int t = threadIdx.x; t < SEQ; t += blockDim.x) buf[t] = lf[((size_t)b * SEQ + t) * 8 + h];
    __syncthreads();
    if (threadIdx.x == 0) { float c = 0.f; for (int t = 0; t < SEQ; ++t) { c += buf[t]; buf[t] = c * LOG2E; } }
    __syncthreads();
    float* cs = (float*)(P.ws + WS_CS) + (size_t)bh * SEQ;
    for (int t = threadIdx.x; t < SEQ; t += blockDim.x) cs[t] = buf[t];
}

constexpr int TLD = 257;
__device__ __forceinline__ void nv_gemm_acc(const bf16_t* A, int lda, const bf16_t* Bt, int ldb, int K, f32x4 (&acc)[4][4]) {
    const int tid = threadIdx.x, w = tid >> 6, l = tid & 63, fr = l & 15, fq = l >> 4;
#pragma unroll
    for (int m = 0; m < 4; ++m)
#pragma unroll
        for (int n = 0; n < 4; ++n) acc[m][n] = (f32x4){0.f, 0.f, 0.f, 0.f};
    for (int k0 = 0; k0 < K; k0 += 32) {
        bf16x8 a[4], b[4];
#pragma unroll
        for (int m = 0; m < 4; ++m) a[m] = *(const bf16x8*)(A + (size_t)(16 * m + fr) * lda + k0 + 8 * fq);
#pragma unroll
        for (int n = 0; n < 4; ++n) b[n] = *(const bf16x8*)(Bt + (size_t)(64 * w + 16 * n + fr) * ldb + k0 + 8 * fq);
#pragma unroll
        for (int m = 0; m < 4; ++m)
#pragma unroll
            for (int n = 0; n < 4; ++n) acc[m][n] = __builtin_amdgcn_mfma_f32_16x16x32_bf16(a[m], b[n], acc[m][n], 0, 0, 0);
    }
}
__device__ __forceinline__ void nv_gemm_tile(const bf16_t* A, int lda, const bf16_t* Bt, int ldb, int K, float* T) {
    const int tid = threadIdx.x, w = tid >> 6, l = tid & 63, fr = l & 15, fq = l >> 4;
    f32x4 acc[4][4];
    nv_gemm_acc(A, lda, Bt, ldb, K, acc);
#pragma unroll
    for (int m = 0; m < 4; ++m)
#pragma unroll
        for (int n = 0; n < 4; ++n)
#pragma unroll
            for (int r = 0; r < 4; ++r) T[(16 * m + 4 * fq + r) * TLD + 64 * w + 16 * n + fr] = acc[m][n][r];
}

__global__ void __launch_bounds__(256) nv_gemm1(Ptrs P, int l) {
    extern __shared__ float T[];
    __shared__ float R[64 * 4];
    const int j = blockIdx.x, row0 = blockIdx.y * 64, tid = threadIdx.x;
    const bf16_t* H = (const bf16_t*)(P.ws + WS_H);
    const bf16_t* W1 = (const bf16_t*)(P.ws + WS_W + (size_t)l * W_LAYER + WO_W1);
    nv_gemm_tile(H + (size_t)row0 * D, D, W1 + (size_t)j * 256 * D, D, D, T);
    __syncthreads();
    bf16_t* B0 = (bf16_t*)(P.ws + WS_B0); bf16_t* B1 = (bf16_t*)(P.ws + WS_B1); bf16_t* B2 = (bf16_t*)(P.ws + WS_B2); bf16_t* B3 = (bf16_t*)(P.ws + WS_B3); bf16_t* B4 = (bf16_t*)(P.ws + WS_B4);
    if (j < 4) {
        for (int e = tid; e < 64 * 128; e += 256) { const int r = e >> 7, c = e & 127; B3[(size_t)(row0 + r) * 1024 + 128 * j + c] = f2bf(T[r * TLD + c] * sigm(T[r * TLD + c + 128])); }
    } else if (j < 12 || j >= 16) {
        bf16_t* dst; int pitch, coff; bool act;
        if (j < 6) { dst = B0; pitch = 1024; coff = 256 * (j - 4); act = true; }
        else if (j < 8) { dst = B0; pitch = 1024; coff = 512 + 256 * (j - 6); act = false; }
        else if (j < 10) { dst = B3; pitch = 1024; coff = 512 + 256 * (j - 8); act = false; }
        else if (j < 12) { dst = B4; pitch = 512; coff = 256 * (j - 10); act = true; }
        else if (j < 18) { dst = B2; pitch = 1024; coff = 256 * (j - 16); act = false; }
        else { dst = B2; pitch = 1024; coff = 512 + 256 * (j - 18); act = true; }
        for (int e = tid; e < 64 * 256; e += 256) { const int r = e >> 8, c = e & 255; const float v = T[r * TLD + c]; dst[(size_t)(row0 + r) * pitch + coff + c] = f2bf(act ? siluf(v) : v); }
        if (j == 8 || j == 9) { const int r = tid >> 2, wc = tid & 3; float s = 0.f;
            for (int bj = 0; bj < 2; ++bj) for (int i = 0; i < 32; ++i) { const float v = T[r * TLD + 128 * bj + 32 * wc + i]; s += v * v; }
            ((float*)(P.ws + WS_VSS))[(size_t)(row0 + r) * 8 + (j - 8) * 4 + wc] = s; }
    } else {
        const bool isk = j >= 14; const int jj = (j - 12) & 1;
        { const int r = tid >> 2, hh = tid & 3; float s = 0.f;
          for (int d = 0; d < 64; ++d) { const float v = T[r * TLD + 128 * (d >> 5) + 32 * hh + (d & 31)]; s += v * v; }
          R[r * 4 + hh] = rsqrtf(s * (1.f / 64.f) + EPS); }
        __syncthreads();
        const float* gq = (isk ? P.kn_g : P.qn_g) + (size_t)l * HD;
        for (int e = tid; e < 64 * 256; e += 256) { const int r = e >> 8, c = e & 255, hh = (c >> 5) & 3, d = 32 * (c >> 7) + (c & 31);
            float v = T[r * TLD + c] * R[r * 4 + hh] * gq[d]; if (!isk) v *= C2;
            B1[(size_t)(row0 + r) * 1024 + (isk ? 512 : 0) + 64 * (4 * jj + hh) + d] = f2bf(v); }
    }
}

__global__ void __launch_bounds__(512) nv_conv(Ptrs P, int l) {
    __shared__ float red[16];
    const int row = blockIdx.x, t = row % SEQ, c = threadIdx.x, lane = c & 63, w = c >> 6;
    const bf16_t* AG = (const bf16_t*)(P.ws + WS_B3); bf16_t* B0 = (bf16_t*)(P.ws + WS_B0);
    const float* cw = P.conv_w + (size_t)l * CW * DA;
    float a = P.conv_b[l * DA + c];
    for (int j = 0; j < CW; ++j) { const int tt = t - (CW - 1) + j; if (tt >= 0) a += cw[j * DA + c] * bf2f(AG[(size_t)(row - (CW - 1) + j) * 1024 + c]); }
    float s = wave_sum(a); if (lane == 0) red[w] = s; __syncthreads();
    float mu = 0.f; for (int i = 0; i < 8; ++i) mu += red[i]; mu *= (1.f / DA);
    const float d = a - mu; s = wave_sum(d * d); if (lane == 0) red[8 + w] = s; __syncthreads();
    float var = 0.f; for (int i = 0; i < 8; ++i) var += red[8 + i]; var *= (1.f / DA);
    const float y = d * rsqrtf(var + EPS) * P.cn_g[l * DA + c] + P.cn_b[l * DA + c];
    const float az = bf2f(B0[(size_t)row * 1024 + c]);
    B0[(size_t)row * 1024 + c] = f2bf(siluf(y) * az);
}

__global__ void __launch_bounds__(256) nv_gmlp(Ptrs P, int l) {
    extern __shared__ float vn[];
    const int ch = blockIdx.x, g = blockIdx.y, tid = threadIdx.x; const size_t row0 = (size_t)ch * CHK;
    const bf16_t* V = (const bf16_t*)(P.ws + WS_B3); bf16_t* B0 = (bf16_t*)(P.ws + WS_B0); const bf16_t* BZ = (const bf16_t*)(P.ws + WS_B4);
    const float* vss = (const float*)(P.ws + WS_VSS);
    const bf16_t* WSB = (const bf16_t*)(P.ws + WS_WSB) + ((size_t)l * NG + g) * CHK * CHK;
    for (int e = tid; e < 128 * 128; e += 256) { const int s = e >> 7, c = e & 127; const float* q = vss + (row0 + s) * 8;
        const float ss = ((q[0] + q[1]) + (q[2] + q[3])) + ((q[4] + q[5]) + (q[6] + q[7])); const float rv = rsqrtf(ss * (1.f / DB) + EPS);
        vn[s * 129 + c] = bfr(bf2f(V[(row0 + s) * 1024 + 512 + 128 * g + c]) * rv * P.gn_g[l * DB + 128 * g + c]); }
    __syncthreads();
    for (int e = tid; e < 128 * 128; e += 256) { const int t = e >> 7, c = e & 127; float acc = 0.f;
        for (int s = 0; s <= t; ++s) acc += bf2f(WSB[t * 128 + s]) * vn[s * 129 + c];
        acc += P.b_s[((size_t)l * NG + g) * CHK + t];
        const size_t o = (row0 + t) * 1024 + 512 + 128 * g + c;
        B0[o] = f2bf(bf2f(B0[o]) * acc * bf2f(BZ[(row0 + t) * 512 + 128 * g + c])); }
}

__global__ void __launch_bounds__(256) nv_attn(Ptrs P) {
    extern __shared__ float sc[];
    const int lane = threadIdx.x & 63, w = threadIdx.x >> 6; const int item = blockIdx.x * 4 + w, row = item >> 3, h = item & 7, b = row / SEQ, t = row % SEQ;
    float* s = sc + w * SEQ;
    bf16_t* B1 = (bf16_t*)(P.ws + WS_B1); const bf16_t* B2 = (const bf16_t*)(P.ws + WS_B2);
    const float* cs = (const float*)(P.ws + WS_CS) + (size_t)(b * NH + h) * SEQ;
    float q[64];
#pragma unroll
    for (int d = 0; d < 64; ++d) q[d] = bf2f(B1[(size_t)row * 1024 + 64 * h + d]);
    const float cq = cs[t]; float mx = -INFINITY;
    for (int k = lane; k <= t; k += 64) { const bf16_t* kr = B1 + ((size_t)b * SEQ + k) * 1024 + 512 + 64 * h; float dot = 0.f;
#pragma unroll
        for (int d8 = 0; d8 < 8; ++d8) { const bf16x8 kv = *(const bf16x8*)(kr + 8 * d8);
#pragma unroll
            for (int e = 0; e < 8; ++e) dot += q[8 * d8 + e] * bf2f((bf16_t)kv[e]); }
        const float v = dot + (cq - cs[k]); s[k] = v; mx = fmaxf(mx, v); }
#pragma unroll
    for (int o = 1; o < 64; o <<= 1) mx = fmaxf(mx, __shfl_xor(mx, o));
    float lsum = 0.f;
    for (int k = lane; k <= t; k += 64) { const float p = exp2f(s[k] - mx); lsum += p; s[k] = bfr(p); }
    lsum = wave_sum(lsum);
    __builtin_amdgcn_s_waitcnt(0); __builtin_amdgcn_wave_barrier();
    float o = 0.f; const bf16_t* vb = B2 + (size_t)b * SEQ * 1024 + 64 * h + lane;
    for (int k = 0; k <= t; ++k) o += s[k] * bf2f(vb[(size_t)k * 1024]);
    const float cz = bf2f(B2[(size_t)row * 1024 + 512 + 64 * h + lane]);
    B1[(size_t)row * 1024 + 64 * h + lane] = f2bf(o / lsum * cz);
}

__global__ void __launch_bounds__(256) nv_merge(Ptrs P, int l) {
    extern __shared__ float T[];
    const int pn = blockIdx.x, row0 = blockIdx.y * 64, tid = threadIdx.x, w = tid >> 6, ln = tid & 63, fr = ln & 15, fq = ln >> 4;
    const unsigned char* wl = P.ws + WS_W + (size_t)l * W_LAYER;
    const bf16_t* H = (const bf16_t*)(P.ws + WS_H); const bf16_t* WG = (const bf16_t*)(wl + WO_WG); const bf16_t* WAB = (const bf16_t*)(wl + WO_WAB); const bf16_t* WC = (const bf16_t*)(wl + WO_WC);
    const bf16_t* B0 = (const bf16_t*)(P.ws + WS_B0); const bf16_t* B1 = (const bf16_t*)(P.ws + WS_B1);
    float* G = T; float* MGs = T + 64 * 256;
    f32x4 acc[4][4];
    for (int br = 0; br < 3; ++br) {
        nv_gemm_acc(H + (size_t)row0 * D, D, WG + ((size_t)br * 1024 + 256 * pn) * D, D, D, acc);
#pragma unroll
        for (int m = 0; m < 4; ++m)
#pragma unroll
            for (int n = 0; n < 4; ++n)
#pragma unroll
                for (int r = 0; r < 4; ++r) { const int c = 64 * w + 16 * n + fr; G[((m * 4 + n) * 4 + r) * 256 + tid] = bfr(sigm(acc[m][n][r] + P.b_gate[(size_t)l * 3072 + br * 1024 + 256 * pn + c])); }
        const bf16_t* A = br == 0 ? B0 : (br == 1 ? B0 + 512 : B1); const bf16_t* Bt = br == 0 ? WAB : (br == 1 ? WAB + 512 : WC);
        nv_gemm_acc(A + (size_t)row0 * 1024, 1024, Bt + (size_t)256 * pn * 1024, 1024, 512, acc);
#pragma unroll
        for (int m = 0; m < 4; ++m)
#pragma unroll
            for (int n = 0; n < 4; ++n)
#pragma unroll
                for (int r = 0; r < 4; ++r) { const int s = ((m * 4 + n) * 4 + r) * 256 + tid; const float v = G[s] * acc[m][n][r]; MGs[s] = bfr(br == 0 ? v : MGs[s] + v); }
    }
    bf16_t* MG = (bf16_t*)(P.ws + WS_MG);
#pragma unroll
    for (int m = 0; m < 4; ++m)
#pragma unroll
        for (int n = 0; n < 4; ++n)
#pragma unroll
            for (int r = 0; r < 4; ++r) MG[(size_t)(row0 + 16 * m + 4 * fq + r) * 1024 + 256 * pn + 64 * w + 16 * n + fr] = f2bf(MGs[((m * 4 + n) * 4 + r) * 256 + tid]);
}

__global__ void __launch_bounds__(256) nv_out(Ptrs P, int l, const float* xin, float* xout) {
    const int pn = blockIdx.x, row0 = blockIdx.y * 64, tid = threadIdx.x, w = tid >> 6, ln = tid & 63, fr = ln & 15, fq = ln >> 4;
    const bf16_t* MG = (const bf16_t*)(P.ws + WS_MG); const bf16_t* WO = (const bf16_t*)(P.ws + WS_W + (size_t)l * W_LAYER + WO_WO);
    f32x4 acc[4][4];
    nv_gemm_acc(MG + (size_t)row0 * 1024, 1024, WO + (size_t)256 * pn * 1024, 1024, 1024, acc);
#pragma unroll
    for (int m = 0; m < 4; ++m)
#pragma unroll
        for (int n = 0; n < 4; ++n)
#pragma unroll
            for (int r = 0; r < 4; ++r) { const size_t o = (size_t)(row0 + 16 * m + 4 * fq + r) * D + 256 * pn + 64 * w + 16 * n + fr; xout[o] = xin[o] + acc[m][n][r]; }
}


#define LAS __attribute__((address_space(3)))
#define GAS __attribute__((address_space(1)))
typedef GAS unsigned gu32;
#define RLX_AGENT __ATOMIC_RELAXED, __HIP_MEMORY_SCOPE_AGENT
#define LDS_WAIT() asm volatile("s_waitcnt lgkmcnt(0)" ::: "memory")
#define VM_WAIT() asm volatile("s_waitcnt vmcnt(0)" ::: "memory")
constexpr int NWAVES = 8;
constexpr int RING_OFF = 0, RING_BYTES = 131072;
constexpr int LDSCTL_OFF = RING_BYTES, MISC_OFF = LDSCTL_OFF + 320;
constexpr int LDS_BYTES = 147456;
constexpr int CW_TMO = 0, CW_CODE = 1, CW_BAR = 4096;
constexpr float SKIP_L2 = 160.f;
constexpr int NPH = 10;

__device__ __forceinline__ unsigned cvt_pk_bf16(float lo, float hi) { unsigned r; asm volatile("v_cvt_pk_bf16_f32 %0, %1, %2" : "=v"(r) : "v"(lo), "v"(hi)); return r; }
__device__ __forceinline__ float fsigm(float x) { return __builtin_amdgcn_rcpf(1.f + __builtin_amdgcn_exp2f(-LOG2E * x)); }
__device__ __forceinline__ u32x4 pack8(const f32x4& a, const f32x4& b) { u32x4 w; w.x = cvt_pk_bf16(a[0], a[1]); w.y = cvt_pk_bf16(a[2], a[3]); w.z = cvt_pk_bf16(b[0], b[1]); w.w = cvt_pk_bf16(b[2], b[3]); return w; }
__device__ __forceinline__ void unpack8(const u32x4& w, f32x4& a, f32x4& b) {
    a[0] = __uint_as_float(w.x << 16); a[1] = __uint_as_float(w.x & 0xffff0000u); a[2] = __uint_as_float(w.y << 16); a[3] = __uint_as_float(w.y & 0xffff0000u);
    b[0] = __uint_as_float(w.z << 16); b[1] = __uint_as_float(w.z & 0xffff0000u); b[2] = __uint_as_float(w.w << 16); b[3] = __uint_as_float(w.w & 0xffff0000u); }

namespace pg8 {
constexpr int BM = 256, BK = 64, HALF = 128, HTB = HALF * BK * 2, STAGE_BYTES = 8 * HTB, NXCD = 8, WGM = 8, PITCH = 1024;
__host__ __device__ __forceinline__ int lds_byte(int r, int c) { const int st = (r >> 4) * 2 + (c >> 5), rr = r & 15, cc = c & 31, ob = rr * 64 + cc * 2; return st * 1024 + (ob ^ (((ob >> 9) & 1) << 5)); }
__host__ __device__ __forceinline__ void stage_rc(int b, int& R, int& C) { const int st = b / 1024, sb = b % 1024, swz = sb ^ (((sb >> 9) & 1) << 5); R = (st >> 1) * 16 + swz / 64; C = (st & 1) * 32 + (swz % 64) / 2; }
__host__ __device__ __forceinline__ int perm32(int rho) { const int n = rho >> 4, i = rho & 15; return 8 * (i >> 2) + 4 * n + (i & 3); }

struct Unit { const char* A; const char* B; int nt, pm, pn, tag; };

struct TileOrder {
    int nM, nN, nwg, G, c;
    __device__ __forceinline__ void init(int Mr, int N, int G_, int c_) { nM = Mr / BM; nN = N / BM; nwg = nM * nN; G = G_; c = c_; }
    __device__ __forceinline__ bool tile(int i, int& pm, int& pn) const {
        const long L = (long)i * G + c; if (L >= nwg) return false;
        int wgid = (int)L; { const int q = nwg / NXCD, r = nwg % NXCD, xcd = wgid % NXCD, off = wgid / NXCD; wgid = (xcd < r ? xcd * (q + 1) : r * (q + 1) + (xcd - r) * q) + off; }
        const int nig = WGM * nN, gid = wgid / nig, fm = gid * WGM, gsz = (nM - fm) < WGM ? (nM - fm) : WGM;
        pm = fm + ((wgid % nig) % gsz); pn = (wgid % nig) / gsz; return true;
    }
};

template <class Epi, class Sched>
__device__ __forceinline__ void gemm_phase(LAS unsigned char* lds, const Sched& S, const Epi& E) {
    int tid = threadIdx.x; asm volatile("" : "+v"(tid));
    const int wid = __builtin_amdgcn_readfirstlane(tid >> 6), lane = tid & 63, wr = wid >> 2, wc = wid & 3, fr = lane & 15, fq = lane >> 4;
    unsigned voffA[2], voffB[2];
#pragma unroll
    for (int i = 0; i < 2; ++i) { int R, C; stage_rc(tid * 16 + i * 8192, R, C); const int Rb = (R & ~31) + perm32(R & 31);
        voffA[i] = (unsigned)(R * PITCH + C) * 2u; voffB[i] = (unsigned)(Rb * PITCH + C) * 2u; }
    const size_t kstep = (size_t)(BK * 2);
    const size_t hstep = (size_t)HALF * PITCH * 2;
    const unsigned ldsw = (unsigned)wid * 1024u;
    const int aoff = lds_byte(wr * 64 + fr, fq * 8), boff = lds_byte(wc * 32 + fr, fq * 8);
#define PG8_SA(b, h) (((b) * 2 + (h)) * HTB)
#define PG8_SB(b, h) ((4 + (b) * 2 + (h)) * HTB)
#define PG8_STAGE(bufoff, gbase, voff) do { _Pragma("unroll") for (int _i = 0; _i < 2; ++_i) \
        __builtin_amdgcn_global_load_lds((const unsigned*)((const char*)(gbase) + (voff)[_i]), (LAS unsigned*)(lds + (bufoff) + ldsw + _i * 8192), 16, 0, 0); } while (0)
#define PG8_LDA(dst, b, h) do { _Pragma("unroll") for (int m = 0; m < 4; ++m) _Pragma("unroll") for (int k = 0; k < 2; ++k) dst[m][k] = *(const LAS bf16x8*)(lds + PG8_SA(b, h) + aoff + m * 2048 + k * 1024); } while (0)
#define PG8_LDB(dst, b, h) do { _Pragma("unroll") for (int n = 0; n < 2; ++n) _Pragma("unroll") for (int k = 0; k < 2; ++k) dst[n][k] = *(const LAS bf16x8*)(lds + PG8_SB(b, h) + boff + n * 2048 + k * 1024); } while (0)
#define PG8_MMA(ai, bj, At, Bt) do { __builtin_amdgcn_s_setprio(1); _Pragma("unroll") for (int m = 0; m < 4; ++m) _Pragma("unroll") for (int n = 0; n < 2; ++n) _Pragma("unroll") for (int k = 0; k < 2; ++k) \
        acc[ai][bj][m][n] = __builtin_amdgcn_mfma_f32_16x16x32_bf16(Bt[n][k], At[m][k], acc[ai][bj][m][n], 0, 0, 0); __builtin_amdgcn_s_setprio(0); } while (0)
#define PG8_WAIT_V(n) asm volatile("s_waitcnt vmcnt(" #n ")" ::: "memory")
#define PG8_WAIT_L(n) asm volatile("s_waitcnt lgkmcnt(" #n ")" ::: "memory")
#define PG8_BAR __builtin_amdgcn_s_barrier()
#define PG8_SCHED __builtin_amdgcn_sched_barrier(0)
    Unit cur, nxt; int ui = 0;
    if (!S.next(0, cur)) return;
    f32x4 acc[2][2][4][2];
#pragma unroll
    for (int a = 0; a < 2; ++a)
#pragma unroll
        for (int b = 0; b < 2; ++b)
#pragma unroll
            for (int m = 0; m < 4; ++m)
#pragma unroll
                for (int n = 0; n < 2; ++n) acc[a][b][m][n] = (f32x4){0.f, 0.f, 0.f, 0.f};
    bf16x8 At[4][2], B0[2][2], B1[2][2];
    const char* cA = cur.A; const char* cB = cur.B;
    PG8_STAGE(PG8_SB(0, 0), cB, voffB); PG8_STAGE(PG8_SB(0, 1), cB + hstep, voffB); PG8_STAGE(PG8_SA(0, 0), cA, voffA); PG8_STAGE(PG8_SA(0, 1), cA + hstep, voffA);
    if (wr == 1) PG8_BAR;
    PG8_WAIT_V(2); PG8_BAR;
    PG8_STAGE(PG8_SB(1, 0), cB + kstep, voffB); PG8_STAGE(PG8_SA(1, 0), cA + kstep, voffA); PG8_STAGE(PG8_SB(1, 1), cB + hstep + kstep, voffB);
    PG8_WAIT_V(6); PG8_BAR;
    for (;;) {
        const bool has_next = S.next(ui + 1, nxt);
        const char* nA = has_next ? nxt.A : cA; const char* nB = has_next ? nxt.B : cB;
        const int nt = cur.nt;
        for (int t = 0; t < nt; t += 2) {
            const bool last = (t == nt - 2);
            const char* a1 = cA + (size_t)(t + 1) * kstep;
            const char* a2 = last ? nA : cA + (size_t)(t + 2) * kstep; const char* b2 = last ? nB : cB + (size_t)(t + 2) * kstep;
            const char* a3 = a2 + kstep; const char* b3 = b2 + kstep;
            PG8_LDB(B0, 0, 0); PG8_LDB(B1, 0, 1); PG8_SCHED; PG8_LDA(At, 0, 0); PG8_STAGE(PG8_SA(1, 1), a1 + hstep, voffA);
            PG8_WAIT_V(8); PG8_WAIT_L(0); PG8_BAR; PG8_MMA(0, 0, At, B0); PG8_MMA(0, 1, At, B1); PG8_BAR; PG8_SCHED;
            PG8_LDA(At, 0, 1); PG8_STAGE(PG8_SB(0, 0), b2, voffB); PG8_STAGE(PG8_SB(0, 1), b2 + hstep, voffB); PG8_STAGE(PG8_SA(0, 0), a2, voffA);
            PG8_WAIT_V(8); PG8_WAIT_L(0); PG8_BAR; PG8_MMA(1, 0, At, B0); PG8_MMA(1, 1, At, B1); PG8_BAR; PG8_SCHED;
            PG8_LDB(B0, 1, 0); PG8_LDB(B1, 1, 1); PG8_SCHED; PG8_LDA(At, 1, 0); PG8_STAGE(PG8_SA(0, 1), a2 + hstep, voffA);
            PG8_WAIT_V(8); PG8_WAIT_L(0); PG8_BAR; PG8_MMA(0, 0, At, B0); PG8_MMA(0, 1, At, B1); PG8_BAR; PG8_SCHED;
            PG8_LDA(At, 1, 1); PG8_STAGE(PG8_SB(1, 0), b3, voffB); PG8_STAGE(PG8_SB(1, 1), b3 + hstep, voffB); PG8_STAGE(PG8_SA(1, 0), a3, voffA);
            PG8_WAIT_V(8); PG8_WAIT_L(0); PG8_BAR; PG8_MMA(1, 0, At, B0); PG8_MMA(1, 1, At, B1); PG8_BAR; PG8_SCHED;
        }
        if (wr == 0) PG8_BAR;
        E(acc, cur, wr, wc, fr, fq);
        if (!has_next) break;
#pragma unroll
        for (int a = 0; a < 2; ++a)
#pragma unroll
            for (int b = 0; b < 2; ++b)
#pragma unroll
                for (int m = 0; m < 4; ++m)
#pragma unroll
                    for (int n = 0; n < 2; ++n) acc[a][b][m][n] = (f32x4){0.f, 0.f, 0.f, 0.f};
        cur = nxt; cA = nA; cB = nB; ++ui;
        if (wr == 1) PG8_BAR;
    }
    PG8_WAIT_V(0);
    PG8_BAR;
#undef PG8_SA
#undef PG8_SB
#undef PG8_STAGE
#undef PG8_LDA
#undef PG8_LDB
#undef PG8_MMA
#undef PG8_WAIT_V
#undef PG8_WAIT_L
#undef PG8_BAR
#undef PG8_SCHED
}

struct EpiG1 {
    bf16_t *B0, *B1, *B2, *B3, *B4; float* vss; const float *gq, *gk;
    __device__ __forceinline__ void operator()(const f32x4 (&acc)[2][2][4][2], const Unit& u, int wr, int wc, int fr, int fq) const {
        const int j = u.pn; const size_t rowb = (size_t)u.pm * BM + wr * 64 + fr; const int cl = 32 * wc + 8 * fq;
        if (j < 4) {
#pragma unroll
            for (int ai = 0; ai < 2; ++ai)
#pragma unroll
                for (int m = 0; m < 4; ++m) { f32x4 o0, o1;
#pragma unroll
                    for (int e = 0; e < 4; ++e) { o0[e] = acc[ai][0][m][0][e] * fsigm(acc[ai][1][m][0][e]); o1[e] = acc[ai][0][m][1][e] * fsigm(acc[ai][1][m][1][e]); }
                    *(u32x4*)(B3 + (rowb + ai * HALF + m * 16) * 1024 + 128 * j + cl) = pack8(o0, o1); }
        } else if (j < 12 || j >= 16) {
            bf16_t* dst; int pitch, coff; bool act;
            if (j < 6) { dst = B0; pitch = 1024; coff = 256 * (j - 4); act = true; }
            else if (j < 8) { dst = B0; pitch = 1024; coff = 512 + 256 * (j - 6); act = false; }
            else if (j < 10) { dst = B3; pitch = 1024; coff = 512 + 256 * (j - 8); act = false; }
            else if (j < 12) { dst = B4; pitch = 512; coff = 256 * (j - 10); act = true; }
            else if (j < 18) { dst = B2; pitch = 1024; coff = 256 * (j - 16); act = false; }
            else { dst = B2; pitch = 1024; coff = 512 + 256 * (j - 18); act = true; }
            const bool stat = (j == 8 || j == 9);
#pragma unroll
            for (int ai = 0; ai < 2; ++ai)
#pragma unroll
                for (int m = 0; m < 4; ++m) { const size_t row = rowb + ai * HALF + m * 16; float s = 0.f;
#pragma unroll
                    for (int bj = 0; bj < 2; ++bj) { f32x4 v0 = acc[ai][bj][m][0], v1 = acc[ai][bj][m][1];
                        if (act) {
#pragma unroll
                            for (int e = 0; e < 4; ++e) { v0[e] = v0[e] * fsigm(v0[e]); v1[e] = v1[e] * fsigm(v1[e]); } }
                        s += (v0[0] * v0[0] + v0[1] * v0[1]) + (v0[2] * v0[2] + v0[3] * v0[3]) + (v1[0] * v1[0] + v1[1] * v1[1]) + (v1[2] * v1[2] + v1[3] * v1[3]);
                        *(u32x4*)(dst + row * pitch + coff + 128 * bj + cl) = pack8(v0, v1); }
                    if (stat) { s += __shfl_xor(s, 16); s += __shfl_xor(s, 32); if (fq == 0) vss[row * 8 + (j - 8) * 4 + wc] = s; } }
        } else {
            const bool isk = j >= 14; const int jj = (j - 12) & 1; const float* g = isk ? gk : gq; const float sc = isk ? 1.f : C2;
            f32x4 gv[2][2];
#pragma unroll
            for (int bj = 0; bj < 2; ++bj) { gv[bj][0] = *(const f32x4*)(g + 32 * bj + 8 * fq) * sc; gv[bj][1] = *(const f32x4*)(g + 32 * bj + 8 * fq + 4) * sc; }
            bf16_t* dst = B1 + (isk ? 512 : 0) + 64 * (4 * jj + wc) + 8 * fq;
#pragma unroll
            for (int ai = 0; ai < 2; ++ai)
#pragma unroll
                for (int m = 0; m < 4; ++m) { const size_t row = rowb + ai * HALF + m * 16; float s = 0.f;
#pragma unroll
                    for (int bj = 0; bj < 2; ++bj) { const f32x4 v0 = acc[ai][bj][m][0], v1 = acc[ai][bj][m][1];
                        s += (v0[0] * v0[0] + v0[1] * v0[1]) + (v0[2] * v0[2] + v0[3] * v0[3]) + (v1[0] * v1[0] + v1[1] * v1[1]) + (v1[2] * v1[2] + v1[3] * v1[3]); }
                    s += __shfl_xor(s, 16); s += __shfl_xor(s, 32);
                    const float r = __builtin_amdgcn_rsqf(s * (1.f / 64.f) + EPS);
#pragma unroll
                    for (int bj = 0; bj < 2; ++bj) *(u32x4*)(dst + row * 1024 + 32 * bj) = pack8(acc[ai][bj][m][0] * r * gv[bj][0], acc[ai][bj][m][1] * r * gv[bj][1]); }
        }
    }
};
struct EpiMerge {
    unsigned char* gt; bf16_t* MG; const float* bgate;
    __device__ __forceinline__ void operator()(const f32x4 (&acc)[2][2][4][2], const Unit& u, int wr, int wc, int fr, int fq) const {
        const int tag = u.tag, br = tag >> 1; const size_t rowb = (size_t)u.pm * BM + wr * 64 + fr; const int col0 = u.pn * BM + 32 * wc + 8 * fq;
        u32x4* slots_ = (u32x4*)gt + ((wr * 4 + wc) * 64 + fq * 16 + fr); asm volatile("" : "+v"(slots_)); __attribute__((address_space(1))) u32x4* slots = (__attribute__((address_space(1))) u32x4*)slots_;
        if ((tag & 1) == 0) {
            f32x4 bv[2][2];
#pragma unroll
            for (int bj = 0; bj < 2; ++bj) { bv[bj][0] = *(const f32x4*)(bgate + br * 1024 + col0 + 128 * bj); bv[bj][1] = *(const f32x4*)(bgate + br * 1024 + col0 + 128 * bj + 4); }
#pragma unroll
            for (int ai = 0; ai < 2; ++ai)
#pragma unroll
                for (int m = 0; m < 4; ++m)
#pragma unroll
                    for (int bj = 0; bj < 2; ++bj) { f32x4 v0 = acc[ai][bj][m][0] + bv[bj][0], v1 = acc[ai][bj][m][1] + bv[bj][1];
#pragma unroll
                        for (int e = 0; e < 4; ++e) { v0[e] = fsigm(v0[e]); v1[e] = fsigm(v1[e]); }
                        slots[(size_t)(((ai * 4 + m) * 2 + bj) * 512)] = pack8(v0, v1); }
        } else {
#pragma unroll
            for (int ai = 0; ai < 2; ++ai)
#pragma unroll
                for (int m = 0; m < 4; ++m) {
#pragma unroll
                    for (int bj = 0; bj < 2; ++bj) { const u32x4 gw = slots[(size_t)(((ai * 4 + m) * 2 + bj) * 512)]; f32x4 g0, g1; unpack8(gw, g0, g1);
                        f32x4 v0 = g0 * acc[ai][bj][m][0], v1 = g1 * acc[ai][bj][m][1];
                        u32x4* p = (u32x4*)(MG + (rowb + ai * HALF + m * 16) * 1024 + col0 + 128 * bj);
                        if (br > 0) { const u32x4 ow = *p; f32x4 p0, p1; unpack8(ow, p0, p1); v0 += p0; v1 += p1; }
                        *p = pack8(v0, v1); }
                    if (m & 1) asm volatile("" ::: "memory"); }
        }
    }
};
struct EpiOut {
    const float* base; float* out;
    __device__ __forceinline__ void operator()(const f32x4 (&acc)[2][2][4][2], const Unit& u, int wr, int wc, int fr, int fq) const {
        const size_t rowb = (size_t)u.pm * BM + wr * 64 + fr; const int col0 = u.pn * BM + 32 * wc + 8 * fq;
#pragma unroll
        for (int ai = 0; ai < 2; ++ai)
#pragma unroll
            for (int m = 0; m < 4; ++m) {
#pragma unroll
                for (int bj = 0; bj < 2; ++bj) { const size_t o = (rowb + ai * HALF + m * 16) * D + col0 + 128 * bj;
                    const f32x4 b0 = *(const f32x4*)(base + o), b1 = *(const f32x4*)(base + o + 4);
                    *(f32x4*)(out + o) = b0 + acc[ai][bj][m][0]; *(f32x4*)(out + o + 4) = b1 + acc[ai][bj][m][1]; }
                if (m & 1) asm volatile("" ::: "memory"); }
    }
};
struct SchedG1 { TileOrder T; const char* A; const char* B;
    __device__ __forceinline__ bool next(int i, Unit& u) const { int pm, pn; if (!T.tile(i, pm, pn)) return false; u.pm = pm; u.pn = pn; u.tag = 0; u.nt = 16; u.A = A + (size_t)pm * (BM * PITCH * 2); u.B = B + (size_t)pn * (BM * PITCH * 2); return true; } };
struct SchedMerge { int pm, pn; bool ok; const char *ws, *wl;
    __device__ __forceinline__ bool next(int i, Unit& u) const { if (!ok || i >= 6) return false; const int br = i >> 1; u.pm = pm; u.pn = pn; u.tag = i;
        const size_t ro = (size_t)pm * (BM * PITCH * 2), co = (size_t)pn * (BM * PITCH * 2);
        if ((i & 1) == 0) { u.nt = 16; u.A = ws + WS_H + ro; u.B = wl + WO_WG + (size_t)br * (1024 * PITCH * 2) + co; }
        else { u.nt = 8; const size_t ao = br == 0 ? WS_B0 : (br == 1 ? WS_B0 + 1024 : WS_B1), bo = br == 0 ? WO_WAB : (br == 1 ? WO_WAB + 1024 : WO_WC); u.A = ws + ao + ro; u.B = wl + bo + co; }
        return true; } };
}

#define XB_TMO      128
#define XB_XCNT(j)  (256  + 64 * (j))
#define XB_XSUB(j)  (1280 + 64 * (j))
#define XB_XGEN(j)  (2304 + 64 * (j))
#define XB_TOP      3328
#define XB_TOPGEN   3392
#define XCD_BAR_WORDS 3456
#define XB_SPIN_CAP (1u << 18)
__device__ __forceinline__ unsigned xb_ld(unsigned* p)              { return __hip_atomic_load(p, __ATOMIC_RELAXED, __HIP_MEMORY_SCOPE_AGENT); }
__device__ __forceinline__ unsigned xb_add(unsigned* p, unsigned v) { return __hip_atomic_fetch_add(p, v, __ATOMIC_RELAXED, __HIP_MEMORY_SCOPE_AGENT); }
__device__ __forceinline__ unsigned xb_xcc_id() { return (unsigned)__builtin_amdgcn_s_getreg((3 << 11) | 20) & 0xFu; }
#define XB_SPIN(cond, bar) do { unsigned _sp = 0; while (cond) { __builtin_amdgcn_s_sleep(1); \
    if ((++_sp & 255u) == 0u) { if (xb_ld(&(bar)[XB_TMO])) break; if (_sp > XB_SPIN_CAP) { atomicAdd(&(bar)[XB_TMO], 1u); break; } } } } while (0)
struct XcdBarrier { unsigned* bar; unsigned x; volatile LAS unsigned* st; };
__device__ __forceinline__ XcdBarrier xcd_barrier_post(unsigned* bar, volatile LAS unsigned* st) {
    XcdBarrier b; b.bar = bar; b.x = xb_xcc_id(); b.st = st;
    if (threadIdx.x == 0) (void)xb_add(&bar[XB_XCNT(b.x)], 1u);
    return b;
}
__device__ __forceinline__ void xcd_barrier_complete(unsigned* bar, unsigned x, unsigned& nloc, unsigned& nx) {
    const unsigned G = gridDim.x * gridDim.y * gridDim.z;
    unsigned sum, cnt, mine, sp = 0u;
    for (;;) {
        sum = 0u; cnt = 0u; mine = 0u;
#pragma unroll
        for (unsigned j = 0; j < 16; ++j) { const unsigned c = xb_ld(&bar[XB_XCNT(j)]); sum += c; cnt += (c > 0u) ? 1u : 0u; mine = (j == x) ? c : mine; }
        if (sum == G) break;
        __builtin_amdgcn_s_sleep(1);
        if ((++sp & 255u) == 0u) { if (xb_ld(&bar[XB_TMO])) break; if (sp > XB_SPIN_CAP) { atomicAdd(&bar[XB_TMO], 1u); break; } }
    }
    nloc = mine > 0u ? mine : 1u; nx = cnt > 0u ? cnt : 1u;
}
__device__ __forceinline__ void xcd_barrier(const XcdBarrier& b) {
    asm volatile("s_waitcnt vmcnt(0)" ::: "memory");
    __syncthreads();
    if (threadIdx.x == 0) {
        unsigned* bar = b.bar;
        __builtin_amdgcn_s_waitcnt(0);
        unsigned nloc = b.st[0], nx = b.st[1];
        if (nloc == 0u) { xcd_barrier_complete(bar, b.x, nloc, nx); b.st[0] = nloc; b.st[1] = nx; }
        const unsigned old = xb_add(&bar[XB_XSUB(b.x)], 1u);
        const unsigned gen = old / nloc;
        if (old + 1u == (gen + 1u) * nloc) {
            __builtin_amdgcn_fence(__ATOMIC_RELEASE, "agent");
            asm volatile("s_waitcnt vmcnt(0)" ::: "memory");
            const unsigned og = xb_add(&bar[XB_TOP], 1u);
            const unsigned tg = og / nx;
            if (og + 1u == (tg + 1u) * nx) xb_add(&bar[XB_TOPGEN], 1u);
            else XB_SPIN(xb_ld(&bar[XB_TOPGEN]) == tg, bar);
            __builtin_amdgcn_fence(__ATOMIC_ACQUIRE, "agent");
            xb_add(&bar[XB_XGEN(b.x)], 1u);
            asm volatile("s_waitcnt vmcnt(0)" ::: "memory");
        } else {
            XB_SPIN(xb_ld(&bar[XB_XGEN(b.x)]) == gen, bar);
            __builtin_amdgcn_fence(__ATOMIC_ACQUIRE, "agent");
            asm volatile("s_waitcnt vmcnt(0)" ::: "memory");
        }
    }
    __syncthreads();
}

struct Args { const float* in[18]; float* out; unsigned char* ws; int ph_lo, ph_hi, li, pad; };
struct Frame { LAS unsigned char* lds; int tid, lane, wave, vcu, G; Ptrs P; };

__device__ __forceinline__ unsigned pk2(float lo, float hi) { return (unsigned)f2bf(lo) | ((unsigned)f2bf(hi) << 16); }
__device__ __forceinline__ void p0_transpose_item(const float* W, int ldw, int src_col, int k0, bf16_t* WT, size_t dst_row, int dst_col, LAS float* scr, int lane) {
#pragma unroll 8
    for (int i = 0; i < 32; ++i) { const int kk = 2 * i + (lane >> 5); scr[kk * 33 + (lane & 31)] = W[(size_t)(k0 + kk) * ldw + src_col + (lane & 31)]; }
    LDS_WAIT(); asm volatile("" ::: "memory");
    const int c = lane & 7;
#pragma unroll
    for (int j = 0; j < 4; ++j) { const int n = (lane >> 3) + 8 * j; const LAS float* s = scr + (8 * c) * 33 + n;
        u32x4 o; o.x = pk2(s[0 * 33], s[1 * 33]); o.y = pk2(s[2 * 33], s[3 * 33]); o.z = pk2(s[4 * 33], s[5 * 33]); o.w = pk2(s[6 * 33], s[7 * 33]);
        *(GAS u32x4*)(WT + (dst_row + n) * 1024 + dst_col + k0 + 8 * c) = o; }
    LDS_WAIT(); asm volatile("" ::: "memory");
}
__device__ __forceinline__ void p0_weights(Frame& F) {
    LAS float* scr = (LAS float*)(F.lds + RING_OFF + F.wave * 16384);
    const int gw = F.vcu * NWAVES + F.wave, NGW = F.G * NWAVES;
    constexpr int I_W1 = 16 * (N1 / 32), I_WG = 16 * 96, I_Y = 8 * 32, I_WO = 16 * 32, I_L = I_W1 + I_WG + 3 * I_Y + I_WO;
    for (int it = gw; it < NL * I_L; it += NGW) {
        const int l = it / I_L; int r = it % I_L;
        unsigned char* wl = F.P.ws + WS_W + (size_t)l * W_LAYER; const float* win = F.P.w_in + (size_t)l * D * NIN;
        if (r < I_W1) { const int kb = r / (N1 / 32), nb = r % (N1 / 32); p0_transpose_item(win, NIN, g1_col(32 * nb), 64 * kb, (bf16_t*)(wl + WO_W1), 32 * nb, 0, scr, F.lane); continue; } r -= I_W1;
        if (r < I_WG) { const int kb = r / 96, nb = r % 96; p0_transpose_item(win, NIN, 32 * nb, 64 * kb, (bf16_t*)(wl + WO_WG), 32 * nb, 0, scr, F.lane); continue; } r -= I_WG;
        if (r < I_Y) { const int kb = r / 32, nb = r % 32; p0_transpose_item(F.P.w_a + (size_t)l * DA * D, D, 32 * nb, 64 * kb, (bf16_t*)(wl + WO_WAB), 32 * nb, 0, scr, F.lane); continue; } r -= I_Y;
        if (r < I_Y) { const int kb = r / 32, nb = r % 32; p0_transpose_item(F.P.w_b + (size_t)l * DB * D, D, 32 * nb, 64 * kb, (bf16_t*)(wl + WO_WAB), 32 * nb, 512, scr, F.lane); continue; } r -= I_Y;
        if (r < I_Y) { const int kb = r / 32, nb = r % 32; p0_transpose_item(F.P.w_c + (size_t)l * DC * D, D, 32 * nb, 64 * kb, (bf16_t*)(wl + WO_WC), 32 * nb, 0, scr, F.lane); continue; } r -= I_Y;
        { const int kb = r / 32, nb = r % 32; p0_transpose_item(F.P.w_out + (size_t)l * D * D, D, 32 * nb, 64 * kb, (bf16_t*)(wl + WO_WO), 32 * nb, 0, scr, F.lane); }
    }
    bf16_t* WSB = (bf16_t*)(F.P.ws + WS_WSB);
    for (int i = (int)blockIdx.x * 512 + F.tid; i < NL * NG * CHK * CHK; i += F.G * 512) { const int s = i & 127, t = (i >> 7) & 127; WSB[i] = s <= t ? f2bf(F.P.w_s[i]) : (bf16_t)0; }
}
__device__ __forceinline__ void p0_ln(Frame& F, int l, const float* xin) {
    LAS float* wf = (LAS float*)(F.lds + RING_OFF);
    const float* g = F.P.norm_g + (size_t)l * D; const float* win = F.P.w_in + (size_t)l * D * NIN;
    __syncthreads();
    for (int i = F.tid; i < D * 8; i += 512) { const int k = i >> 3, e = i & 7; wf[i] = g[k] * win[(size_t)k * NIN + OC_F + e]; }
    __syncthreads();
    const int gw = F.vcu * NWAVES + F.wave, NGW = F.G * NWAVES;
    bf16_t* H = (bf16_t*)(F.P.ws + WS_H); float* LOGF = (float*)(F.P.ws + WS_LOGF);
    f32x4 gv[4];
#pragma unroll
    for (int j = 0; j < 4; ++j) gv[j] = ((const f32x4*)g)[64 * j + F.lane];
    for (int m = gw; m < M; m += NGW) {
        const GAS f32x4* xr = (const GAS f32x4*)(xin + (size_t)m * D) + F.lane;
        f32x4 v[4]; float ss = 0.f;
#pragma unroll
        for (int j = 0; j < 4; ++j) { v[j] = xr[64 * j]; ss += (v[j].x * v[j].x + v[j].y * v[j].y) + (v[j].z * v[j].z + v[j].w * v[j].w); }
        ss = wave_sum(ss);
        const float r = rsqrtf(ss * (1.f / D) + EPS);
        float f[8] = {0.f, 0.f, 0.f, 0.f, 0.f, 0.f, 0.f, 0.f};
        GAS unsigned long long* o8 = (GAS unsigned long long*)(H + (size_t)m * D) + F.lane;
#pragma unroll
        for (int j = 0; j < 4; ++j) {
            const f32x4 hv = v[j] * r * gv[j];
            o8[64 * j] = (unsigned long long)pk2(hv.x, hv.y) | ((unsigned long long)pk2(hv.z, hv.w) << 32);
#pragma unroll
            for (int i = 0; i < 4; ++i) { const LAS f32x4* w4 = (const LAS f32x4*)(wf + (256 * j + 4 * F.lane + i) * 8); const f32x4 wa = w4[0], wb = w4[1]; const float xv = v[j][i];
                f[0] += xv * wa.x; f[1] += xv * wa.y; f[2] += xv * wa.z; f[3] += xv * wa.w; f[4] += xv * wb.x; f[5] += xv * wb.y; f[6] += xv * wb.z; f[7] += xv * wb.w; }
        }
#pragma unroll
        for (int e = 0; e < 8; ++e) f[e] = wave_sum(f[e]);
        if (F.lane < 8) { float z = 0.f;
#pragma unroll
            for (int e = 0; e < 8; ++e) if (F.lane == e) z = f[e];
            z = z * r + F.P.b_f[l * NH + F.lane];
            LOGF[(size_t)m * 8 + F.lane] = fminf(z, 0.f) - log1pf(expf(-fabsf(z))); }
    }
    __syncthreads();
}
__device__ __forceinline__ void p1_scan(Frame& F, int bh) {
    LAS float* sh = (LAS float*)(F.lds + RING_OFF);
    const int b = bh / NH, h = bh % NH, t0 = F.tid * 8;
    const float* lf = (const float*)(F.P.ws + WS_LOGF) + ((size_t)b * SEQ + t0) * 8 + h;
    float c[8]; float run = 0.f;
#pragma unroll
    for (int i = 0; i < 8; ++i) { run += lf[i * 8]; c[i] = run; }
    float inc = run;
#pragma unroll
    for (int o = 1; o < 64; o <<= 1) { const float n = __shfl_up(inc, o); if (F.lane >= o) inc += n; }
    if (F.lane == 63) sh[F.wave] = inc;
    __syncthreads();
    float base = inc - run;
    for (int w = 0; w < F.wave; ++w) base += sh[w];
    float* cs = (float*)(F.P.ws + WS_CS) + (size_t)bh * SEQ + t0;
    *(f32x4*)cs = (f32x4){(base + c[0]) * LOG2E, (base + c[1]) * LOG2E, (base + c[2]) * LOG2E, (base + c[3]) * LOG2E};
    *(f32x4*)(cs + 4) = (f32x4){(base + c[4]) * LOG2E, (base + c[5]) * LOG2E, (base + c[6]) * LOG2E, (base + c[7]) * LOG2E};
    __syncthreads();
    LAS float* c2s = sh + 16;
#pragma unroll
    for (int i = 0; i < 8; ++i) c2s[t0 + i] = (base + c[i]) * LOG2E;
    __syncthreads();
    if (F.tid < SEQ / 256) { const int qb = F.tid, nt = 4 * qb + 4; const float cq = c2s[256 * qb]; int lo = 0, hi = nt - 4;
        while (lo < hi) { const int mid = (lo + hi) >> 1; if (cq - c2s[64 * mid + 63] >= -SKIP_L2) hi = mid; else lo = mid + 1; }
        ((int*)(F.P.ws + WS_TS))[bh * 16 + qb] = lo & ~1; }
    __syncthreads();
}


#include <hip/hip_bf16.h>
namespace attn_body {
using bf16=__hip_bfloat16;
using s16x4=__attribute__((ext_vector_type(4)))short;
using f32x16=__attribute__((ext_vector_type(16)))float;
constexpr int NHEAD=NH,D=64,DM=1024;
constexpr int NW=8,QBLK=32,QB=QBLK*NW,KVBLK=64,NQB=SEQ/QB;
__device__ __forceinline__ int crow(int r,int hi){return (r&3)+8*(r>>2)+4*hi;}
#define SBAR() __builtin_amdgcn_sched_barrier(0)
__device__ __forceinline__ void cmask(f32x16&p0,f32x16&p1,int jb,int qrel,int hi){
  const float NEG=-INFINITY; int kb=64*jb+4*hi;
  #pragma unroll
  for(int r=0;r<16;++r){int kv=kb+(r&3)+8*(r>>2); if(kv>qrel)p0[r]=NEG; if(kv+32>qrel)p1[r]=NEG;}
}
constexpr int NSLOT=3, SLOTB=8192;
constexpr int LDS_K=0, LDS_V=NSLOT*SLOTB, LDS_WS=2*NSLOT*SLOTB, LDS_OST=LDS_WS+NW*64*4, LDS_C2=LDS_OST+NW*4096, LDS_BYTES=LDS_C2+SEQ*4+512;
__device__ __forceinline__ void glds16(const void*gsrc,unsigned lds_dst){unsigned keep;
  asm volatile("s_mov_b32 %0, m0\n\ts_mov_b32 m0, %2\n\ts_nop 0\n\tglobal_load_lds_dwordx4 %1, off\n\ts_mov_b32 m0, %0":"=&s"(keep):"v"(gsrc),"s"(lds_dst):"memory");}
__device__ __forceinline__ float max3f(float a,float b,float c){float r;asm("v_max3_f32 %0, %1, %2, %3":"=v"(r):"v"(a),"v"(b),"v"(c));return r;}
__device__ __forceinline__ float max2f(float a,float b){float r;asm("v_max_f32_e32 %0, %1, %2":"=v"(r):"v"(a),"v"(b));return r;}
__device__ __forceinline__ float fadd_s(float a,float b){float r;asm("v_add_f32_e32 %0, %1, %2":"=v"(r):"v"(a),"v"(b));return r;}
__device__ __forceinline__ float fsub_s(float a,float b){float r;asm("v_sub_f32_e32 %0, %1, %2":"=v"(r):"v"(a),"v"(b));return r;}
typedef float f32x2_t __attribute__((ext_vector_type(2))); typedef __bf16 bf16x2_t __attribute__((ext_vector_type(2)));
__device__ __forceinline__ unsigned cvtpk_s(float lo,float hi){f32x2_t v={lo,hi};bf16x2_t b=__builtin_convertvector(v,bf16x2_t);return __builtin_bit_cast(unsigned,b);}
#define WAIT_BAR(N) asm volatile("s_waitcnt vmcnt(" #N ") lgkmcnt(0)\n\ts_barrier":::"memory")
__device__ __forceinline__ void split3(float x,unsigned&h,unsigned&m,unsigned&l){
  const unsigned u=__float_as_uint(x)&0xffff0000u; const float r1=x-__uint_as_float(u);
  const unsigned u1=__float_as_uint(r1)&0xffff0000u; const float r2=r1-__uint_as_float(u1);
  h=u>>16; m=u1>>16; l=__float_as_uint(r2)>>16; }
__device__ __forceinline__ bf16x8 make_qx(float base,int hi){ unsigned h,m,l; split3(base,h,m,l); u32x4 w; w.x=h|(m<<16); w.y=l|0x3f800000u; w.z=0x3f803f80u; w.w=0u; if(hi){w.x=0u;w.y=0u;w.z=0u;} return __builtin_bit_cast(bf16x8,w); }
__device__ __forceinline__ bf16x8 make_kx(float ck,int hi){ unsigned h,m,l; split3(-ck,h,m,l); u32x4 w; w.x=0x3f803f80u; w.y=0x3f80u|(h<<16); w.z=m|(l<<16); w.w=0u; if(hi){w.x=0u;w.y=0u;w.z=0u;} return __builtin_bit_cast(bf16x8,w); }

__device__ __forceinline__ void qkt(f32x16&p0,f32x16&p1,const char*Kslot,const bf16x8*qr,bf16x8 qx,bf16x8 kx0,bf16x8 kx1,int r32,int hi){
  const char*kb=Kslot+hi*1024+r32*16; const f32x16 z=f32x16{};
  p0=__builtin_amdgcn_mfma_f32_32x32x16_bf16(kx0,qx,z,0,0,0);p1=__builtin_amdgcn_mfma_f32_32x32x16_bf16(kx1,qx,z,0,0,0);
  #pragma unroll
  for(int d0=0;d0<4;++d0){
    const bf16x8 b0=*reinterpret_cast<const bf16x8*>(kb+d0*2048);
    const bf16x8 b1=*reinterpret_cast<const bf16x8*>(kb+d0*2048+512);
    p0=__builtin_amdgcn_mfma_f32_32x32x16_bf16(b0,qr[d0],p0,0,0,0);p1=__builtin_amdgcn_mfma_f32_32x32x16_bf16(b1,qr[d0],p1,0,0,0);}
}
typedef __attribute__((address_space(3))) const char* lds_cptr;
typedef short v4i16_t __attribute__((ext_vector_type(4)));
__device__ __forceinline__ void kload8(bf16x8*kf,lds_cptr kp){
  kf[0]=*(const __attribute__((address_space(3))) bf16x8*)(kp);      kf[1]=*(const __attribute__((address_space(3))) bf16x8*)(kp+512);
  kf[2]=*(const __attribute__((address_space(3))) bf16x8*)(kp+2048); kf[3]=*(const __attribute__((address_space(3))) bf16x8*)(kp+2560);
  kf[4]=*(const __attribute__((address_space(3))) bf16x8*)(kp+4096); kf[5]=*(const __attribute__((address_space(3))) bf16x8*)(kp+4608);
  kf[6]=*(const __attribute__((address_space(3))) bf16x8*)(kp+6144); kf[7]=*(const __attribute__((address_space(3))) bf16x8*)(kp+6656);
}
__device__ __forceinline__ void kload2(bf16x8*kf,lds_cptr kp,int j){ kf[2*j]=*(const __attribute__((address_space(3))) bf16x8*)(kp+j*2048); kf[2*j+1]=*(const __attribute__((address_space(3))) bf16x8*)(kp+j*2048+512); }
__device__ __forceinline__ s16x4 vtr(lds_cptr p){ return __builtin_bit_cast(s16x4,__builtin_amdgcn_ds_read_tr16_b64_v4i16((__attribute__((address_space(3))) v4i16_t*)p)); }
__device__ __forceinline__ float rowmax(const f32x16&p0,const f32x16&p1){
  float a=max3f(p0[0],p0[1],p1[0]),b=max3f(p0[2],p0[3],p1[1]);a=max3f(a,p1[2],p1[3]);
  #pragma unroll
  for(int r=4;r<16;r+=4){a=max3f(a,p0[r],p0[r+1]);b=max3f(b,p0[r+2],p0[r+3]);a=max3f(a,p1[r],p1[r+1]);b=max3f(b,p1[r+2],p1[r+3]);}
  const float m=max2f(a,b);
  auto rr=__builtin_amdgcn_permlane32_swap(__float_as_uint(m),__float_as_uint(m),false,false);
  return max2f(__uint_as_float(rr[0]),__uint_as_float(rr[1]));
}
__device__ __forceinline__ void pv(f32x16*o,int vb,bf16x8 pa0,bf16x8 pa1,bf16x8 pa2,bf16x8 pa3){
  #pragma unroll
  for(int d0=0;d0<2;++d0){s16x4 lo[4],hi[4];
    #pragma unroll
    for(int ks=0;ks<4;++ks){
      asm volatile("ds_read_b64_tr_b16 %0,%1 offset:%c2":"=&v"(lo[ks]):"v"(vb),"i"(d0*4096+ks*1024):"memory");
      asm volatile("ds_read_b64_tr_b16 %0,%1 offset:%c2":"=&v"(hi[ks]):"v"(vb),"i"(d0*4096+ks*1024+512):"memory");}
    asm volatile("s_waitcnt lgkmcnt(0)":::"memory");SBAR();
    #define PK(k) (bf16x8){lo[k][0],lo[k][1],lo[k][2],lo[k][3],hi[k][0],hi[k][1],hi[k][2],hi[k][3]}
    o[d0]=__builtin_amdgcn_mfma_f32_32x32x16_bf16(pa0,PK(0),o[d0],0,0,0);
    o[d0]=__builtin_amdgcn_mfma_f32_32x32x16_bf16(pa1,PK(1),o[d0],0,0,0);
    o[d0]=__builtin_amdgcn_mfma_f32_32x32x16_bf16(pa2,PK(2),o[d0],0,0,0);
    o[d0]=__builtin_amdgcn_mfma_f32_32x32x16_bf16(pa3,PK(3),o[d0],0,0,0);
    #undef PK
  }
}
#define ATTN_STORE16(p,v) (*(u32x4*)(p)=(v))
template<int THRL> __device__ __forceinline__ void attn_unit(int b,int h,int qb,const bf16*Q,const bf16*__restrict__ K,const bf16*__restrict__ V,const bf16*__restrict__ CZ,bf16*O,const float*__restrict__ c2g,int ts,float ub,char*shm){
  int tid=threadIdx.x; asm volatile("":"+v"(tid));
  const int lane=tid&63,r32=lane&31,hi=lane>>5; const int wid=__builtin_amdgcn_readfirstlane(tid>>6);
  const long rowbase=(long)b*SEQ; const int q0=qb*QB;
  const bf16*Qw=Q+(rowbase+q0+wid*QBLK)*DM+h*D;
  const bf16*Kh=K+(rowbase+(long)ts*KVBLK)*DM+h*D,*Vh=V+(rowbase+(long)ts*KVBLK)*DM+h*D;
  const unsigned lds0=(unsigned)(uintptr_t)shm;
  float*wsf=(float*)(shm+LDS_WS)+wid*64;
  float*c2l=(float*)(shm+LDS_C2);
  const bf16*ksrc=Kh+(long)lane*DM+wid*8;
  const bf16*vsrc=Vh+(long)(16*(wid&3)+(lane>>2))*DM+(wid>>2)*32+(lane&3)*8;
  const unsigned kdst=lds0+LDS_K+wid*1024, vdst=lds0+LDS_V+wid*1024;
  #define DMA_K(t,slot) glds16(ksrc+(long)(t)*KVBLK*DM,(unsigned)__builtin_amdgcn_readfirstlane(kdst+(slot)))
  #define DMA_V(t,slot) glds16(vsrc+(long)(t)*KVBLK*DM,(unsigned)__builtin_amdgcn_readfirstlane(vdst+(slot)))
  const int vb0=(int)(lds0+LDS_V)+((lane>>4)&1)*32+(lane&3)*8+(4*hi+((lane&15)>>2))*64;
  const char*Kbase=shm+LDS_K; bf16x8 kf[8];
  const lds_cptr shm3=(lds_cptr)shm; const lds_cptr kp0=shm3+LDS_K+hi*1024+r32*16; const lds_cptr vp0=shm3+LDS_V+((lane>>4)&1)*32+(lane&3)*8+(4*hi+((lane&15)>>2))*64;
  const int NT=(q0+QB)/KVBLK-ts;
  DMA_K(0,0);DMA_V(0,0);DMA_K(1,SLOTB);
  { const int kb0=ts*KVBLK; for(int i=tid*4;i<q0+QB-kb0;i+=NW*64*4)*(f32x4*)(c2l+i)=*(const f32x4*)(c2g+kb0+i); }
  bf16x8 qr[4];
  #pragma unroll
  for(int d0=0;d0<4;++d0)qr[d0]=*reinterpret_cast<const bf16x8*>(&Qw[(long)r32*DM+d0*16+hi*8]);
    float mhat=ub,l_reg=0.f;f32x16 o[2];o[0]=f32x16{};o[1]=f32x16{};
  const int qrel=wid*QBLK+r32;
  #define CMASK(P0,P1,t) do{int jb_=(t)-(NT-4); if(jb_>=0)cmask(P0,P1,jb_,qrel,hi);}while(0)
  bool resc=false;
  bf16x8 qx; float cq2;
  #define START(P0,P1) do{ resc=false; \
    _Pragma("unroll") for(int r=0;r<16;++r)P0[r]=__builtin_amdgcn_exp2f(P0[r]); }while(0)
  #define RESC() do{}while(0)
  f32x16 pA0,pA1,pB0,pB1;
  int sl_prev=0,sl_cur=0,sl_next=SLOTB;
  #define ROT() do{sl_prev=sl_cur;sl_cur=sl_next;sl_next=(sl_next==(NSLOT-1)*SLOTB)?0:sl_next+SLOTB;}while(0)
  DMA_K(2,2*SLOTB);
  WAIT_BAR(3);
  cq2=c2l[q0+qrel-ts*KVBLK]; qx=make_qx(cq2-mhat,hi);
  float ck0=c2l[r32],ck1=c2l[32+r32];
  { const bf16x8 kx0=make_kx(ck0,hi),kx1=make_kx(ck1,hi);
    qkt(pA0,pA1,Kbase,qr,qx,kx0,kx1,r32,hi); }
  asm volatile("s_nop 15\n\ts_nop 7":"+v"(pA0),"+v"(pA1));CMASK(pA0,pA1,0);
  ck0=c2l[64+r32];ck1=c2l[96+r32];
  START(pA0,pA1);
  _Pragma("unroll") for(int r=0;r<16;++r)pA1[r]=__builtin_amdgcn_exp2f(pA1[r]);
  WAIT_BAR(0);
  DMA_K(3,0);DMA_V(1,SLOTB);
  ROT();
  kload8(kf,kp0+sl_cur);
  WAIT_BAR(2);
  s16x4 vlo[8],vhi[8]; u32x4 pw0,pw1,pw2,pw3;
  #define PKW(P,B) cvtpk_s(P[B],P[B+1])
  #define PAF(k) __builtin_bit_cast(bf16x8,pw##k)
  #define VFR(i) (bf16x8){vlo[i][0],vlo[i][1],vlo[i][2],vlo[i][3],vhi[i][0],vhi[i][1],vhi[i][2],vhi[i][3]}
  #define PIN(x) asm volatile("":"+v"(x))
  #define MX3(a,b,c) __builtin_fmaxf(__builtin_fmaxf((a),(b)),(c))
  #define GAPA(MF,A0,A1,A2,A3,W0,W1,PW) do{ MF; sacc+=A0; sacc+=A1; sacc+=A2; sacc+=A3; PIN(sacc); W0; W1; PIN(PW); SBAR(); }while(0)
  #define EX(v) __builtin_amdgcn_exp2f(v)
  #define GAPB(MF,X,B) do{ MF; X[B]=EX(X[B]); X[B+1]=EX(X[B+1]); X[B+2]=EX(X[B+2]); X[B+3]=EX(X[B+3]); PIN(X); SBAR(); }while(0)
  #define VRD(i) do{ vlo[i]=vtr(vp_+(((i)>>2)*4096+((i)&3)*1024)); vhi[i]=vtr(vp_+(((i)>>2)*4096+((i)&3)*1024+512)); }while(0)
  #define KRD(G,j) do{ if(G){ kload2(kf,kp0+sl_next,j); SBAR(); } }while(0)
  #define STEP(C0,C1,P0,P1,t,GK,GV,GL) do{ SBAR(); \
    const lds_cptr vp_=vp0+sl_prev; \
    { const bf16x8 kx0_=make_kx(ck0,hi),kx1_=make_kx(ck1,hi); const f32x16 z_=f32x16{}; \
      C0=__builtin_amdgcn_mfma_f32_32x32x16_bf16(kx0_,qx,z_,0,0,0); C1=__builtin_amdgcn_mfma_f32_32x32x16_bf16(kx1_,qx,z_,0,0,0); } SBAR(); \
    VRD(0); SBAR(); float sacc=(P0[0]+P0[1]); \
    GAPA(C0=__builtin_amdgcn_mfma_f32_32x32x16_bf16(kf[0],qr[0],C0,0,0,0), P0[2],P0[3],P0[4],P0[5],     pw0[0]=PKW(P0,0), pw0[1]=PKW(P0,2), pw0); \
    VRD(4); SBAR(); GAPA(C1=__builtin_amdgcn_mfma_f32_32x32x16_bf16(kf[1],qr[0],C1,0,0,0), P0[6],P0[7],P0[8],P0[9],     pw0[2]=PKW(P0,4), pw0[3]=PKW(P0,6), pw0); \
    VRD(1); SBAR(); GAPA(C0=__builtin_amdgcn_mfma_f32_32x32x16_bf16(kf[2],qr[1],C0,0,0,0),   P0[10],P0[11],P0[12],P0[13], pw1[0]=PKW(P0,8), pw1[1]=PKW(P0,10), pw1); \
    VRD(5); SBAR(); GAPA(C1=__builtin_amdgcn_mfma_f32_32x32x16_bf16(kf[3],qr[1],C1,0,0,0),   P0[14],P0[15],P1[0],P1[1],   pw1[2]=PKW(P0,12),pw1[3]=PKW(P0,14), pw1); \
    VRD(2); SBAR(); GAPA(C0=__builtin_amdgcn_mfma_f32_32x32x16_bf16(kf[4],qr[2],C0,0,0,0),   P1[2],P1[3],P1[4],P1[5],     pw2[0]=PKW(P1,0), pw2[1]=PKW(P1,2), pw2); \
    VRD(6); SBAR(); GAPA(C1=__builtin_amdgcn_mfma_f32_32x32x16_bf16(kf[5],qr[2],C1,0,0,0),   P1[6],P1[7],P1[8],P1[9],     pw2[2]=PKW(P1,4), pw2[3]=PKW(P1,6), pw2); \
    VRD(3); SBAR(); GAPA(C0=__builtin_amdgcn_mfma_f32_32x32x16_bf16(kf[6],qr[3],C0,0,0,0),   P1[10],P1[11],P1[12],P1[13], pw3[0]=PKW(P1,8), pw3[1]=PKW(P1,10), pw3); \
    VRD(7); SBAR(); GAPA(C1=__builtin_amdgcn_mfma_f32_32x32x16_bf16(kf[7],qr[3],C1,0,0,0),   P1[14],P1[15],0.f,0.f,       pw3[2]=PKW(P1,12),pw3[3]=PKW(P1,14), pw3); \
    l_reg+=sacc; \
    if(GK){DMA_K((t)+3,sl_cur);} if(GV){DMA_V((t)+1,sl_next);} \
    if(GL){ ck0=c2l[64*((t)+1)+r32]; ck1=c2l[64*((t)+1)+32+r32]; } \
    CMASK(C0,C1,t); \
    SBAR(); \
    GAPB(o[0]=__builtin_amdgcn_mfma_f32_32x32x16_bf16(PAF(0),VFR(0),o[0],0,0,0), C0,0); \
    GAPB(o[1]=__builtin_amdgcn_mfma_f32_32x32x16_bf16(PAF(0),VFR(4),o[1],0,0,0), C0,4); \
    KRD(GL,0); GAPB(o[0]=__builtin_amdgcn_mfma_f32_32x32x16_bf16(PAF(1),VFR(1),o[0],0,0,0), C0,8); \
    KRD(GL,1); GAPB(o[1]=__builtin_amdgcn_mfma_f32_32x32x16_bf16(PAF(1),VFR(5),o[1],0,0,0), C0,12); \
    KRD(GL,2); GAPB(o[0]=__builtin_amdgcn_mfma_f32_32x32x16_bf16(PAF(2),VFR(2),o[0],0,0,0), C1,0); \
    KRD(GL,3); GAPB(o[1]=__builtin_amdgcn_mfma_f32_32x32x16_bf16(PAF(2),VFR(6),o[1],0,0,0), C1,4); \
    GAPB(o[0]=__builtin_amdgcn_mfma_f32_32x32x16_bf16(PAF(3),VFR(3),o[0],0,0,0), C1,8); \
    GAPB(o[1]=__builtin_amdgcn_mfma_f32_32x32x16_bf16(PAF(3),VFR(7),o[1],0,0,0), C1,12); \
    }while(0)
  int t=1;
  #undef CMASK
  #define CMASK(P0,P1,t) do{}while(0)
  for(;t+5<NT;t+=2){
    STEP(pB0,pB1,pA0,pA1,t,true,true,true);     WAIT_BAR(2); RESC(); ROT();
    STEP(pA0,pA1,pB0,pB1,t+1,true,true,true);   WAIT_BAR(2); RESC(); ROT();
  }
  #undef CMASK
  #define CMASK(P0,P1,t) do{int jb_=(t)-(NT-4); if(jb_>=0)cmask(P0,P1,jb_,qrel,hi);}while(0)
  #define ENDW(tt) do{ if((tt)+3<NT){WAIT_BAR(2);} else if((tt)+2<NT){WAIT_BAR(1);} else {WAIT_BAR(0);} }while(0)
  for(;t+1<NT;t+=2){
    STEP(pB0,pB1,pA0,pA1,t,(t+3<NT),(t+1<NT),(t+1<NT));       ENDW(t);   RESC(); ROT();
    STEP(pA0,pA1,pB0,pB1,t+1,(t+4<NT),(t+2<NT),(t+2<NT));     ENDW(t+1); RESC(); ROT();
  }
  STEP(pB0,pB1,pA0,pA1,NT-1,false,false,false); RESC();
  { float sacc=pB0[0]+pB0[1]; _Pragma("unroll") for(int r=2;r<16;++r)sacc+=pB0[r]; _Pragma("unroll") for(int r=0;r<16;++r)sacc+=pB1[r]; l_reg+=sacc;
    pw0=(u32x4){PKW(pB0,0),PKW(pB0,2),PKW(pB0,4),PKW(pB0,6)};pw1=(u32x4){PKW(pB0,8),PKW(pB0,10),PKW(pB0,12),PKW(pB0,14)};pw2=(u32x4){PKW(pB1,0),PKW(pB1,2),PKW(pB1,4),PKW(pB1,6)};pw3=(u32x4){PKW(pB1,8),PKW(pB1,10),PKW(pB1,12),PKW(pB1,14)};
    SBAR(); pv(o,vb0+sl_cur,PAF(0),PAF(1),PAF(2),PAF(3)); }
  #undef PKW
  #undef PAF
  #undef VFR
  #undef PIN
  #undef MX3
  #undef GAPA
  #undef GAPB
  #undef EX
  #undef VRD
  #undef KRD
  #undef STEP
  #undef ENDW
  {auto rr=__builtin_amdgcn_permlane32_swap(__float_as_uint(l_reg),__float_as_uint(l_reg),false,false);l_reg=__uint_as_float(rr[0])+__uint_as_float(rr[1]);}
  if(hi==0)wsf[32+r32]=l_reg;asm volatile("s_waitcnt lgkmcnt(0)":::"memory");
  bf16*Ow=O+(rowbase+q0+wid*QBLK)*DM+h*D;
  const unsigned short*Cw=(const unsigned short*)(CZ+(rowbase+q0+wid*QBLK)*DM+h*D);
  { bf16*stg=(bf16*)(shm+LDS_OST)+wid*2048;
    #pragma unroll
    for(int r=0;r<16;++r){const int orow=crow(r,hi); const float rl=__builtin_amdgcn_rcpf(wsf[32+orow]);
      #pragma unroll
      for(int d0=0;d0<2;++d0){ const float cz=__uint_as_float((unsigned)Cw[(long)orow*DM+d0*32+r32]<<16); stg[orow*64+d0*32+r32]=__float2bfloat16(o[d0][r]*rl*cz);} }
    asm volatile("s_waitcnt lgkmcnt(0)":::"memory");
    #pragma unroll
    for(int i=0;i<4;++i){const int row=i*8+(lane>>3),ch=lane&7; const u32x4 v=*(const u32x4*)(stg+row*64+ch*8); ATTN_STORE16(Ow+(long)row*DM+ch*8,v);} }
  asm volatile("s_waitcnt lgkmcnt(0)\n\ts_barrier":::"memory");
  #undef DMA_K
  #undef DMA_V
  #undef CMASK
  #undef START
  #undef RESC
  #undef ROT
}
#undef SBAR
#undef WAIT_BAR
}

typedef float f32x2 __attribute__((ext_vector_type(2)));
__device__ __forceinline__ void p2_conv(Frame& F, int l, int unit, bf16_t* outb) {
    const int tid = F.tid, lane = F.lane, w = F.wave;
    const size_t row0 = (size_t)unit * 64; const int tseq0 = (int)(row0 % SEQ);
    const bf16_t* AG = (const bf16_t*)(F.P.ws + WS_B3); const bf16_t* B0 = (const bf16_t*)(F.P.ws + WS_B0);
    LAS unsigned char* tile = F.lds + RING_OFF;
    for (int c = tid; c < 94 * 64; c += 512) { const int r = c >> 6, ch = c & 63, tr = r - (CW - 1); const bool valid = tseq0 + tr >= 0;
        u32x4 v = (u32x4){0u, 0u, 0u, 0u}; if (valid) v = *(const u32x4*)(AG + (size_t)((long)row0 + tr) * 1024 + ch * 8);
        *(LAS u32x4*)(tile + r * 1024 + ch * 16) = v; }
    __syncthreads();
    f32x2 out[4][8]; float s1[8], s2[8];
#pragma unroll
    for (int o = 0; o < 8; ++o) { s1[o] = 0.f; s2[o] = 0.f; }
#pragma unroll
    for (int i = 0; i < 4; ++i) {
        __builtin_amdgcn_sched_barrier(0);
        int p = lane + 64 * i; asm volatile("" : "+v"(p));
        const float* cw = F.P.conv_w + (size_t)l * CW * DA + 2 * p;
        f32x2 wv[CW];
#pragma unroll
        for (int j = 0; j < CW; ++j) wv[j] = *(const f32x2*)(cw + j * DA);
        const f32x2 cb = *(const f32x2*)(F.P.conv_b + l * DA + 2 * p);
        const LAS unsigned* tp = (const LAS unsigned*)(tile + (8 * w) * 1024 + 4 * p);
        f32x2 win[16];
#pragma unroll
        for (int k = 0; k < 16; ++k) { const unsigned u = tp[k * 256]; win[k] = (f32x2){__uint_as_float(u << 16), __uint_as_float(u & 0xffff0000u)}; }
#pragma unroll
        for (int o = 0; o < 8; ++o) out[i][o] = cb;
        __builtin_amdgcn_sched_barrier(0);
#pragma unroll
        for (int j = 0; j < CW; ++j) {
#pragma unroll
            for (int o = 0; o < 8; ++o) out[i][o] += wv[j] * win[(j + o) & 15];
            asm volatile("" : "+v"(out[i][0]), "+v"(out[i][1]), "+v"(out[i][2]), "+v"(out[i][3]), "+v"(out[i][4]), "+v"(out[i][5]), "+v"(out[i][6]), "+v"(out[i][7]));
            if (j + 16 < 38) { const LAS unsigned* tq = tp + (j + 16) * 256; asm volatile("" : "+v"(tq)); const unsigned u = *tq; win[j & 15] = (f32x2){__uint_as_float(u << 16), __uint_as_float(u & 0xffff0000u)}; }
            __builtin_amdgcn_sched_barrier(0);
        }
#pragma unroll
        for (int o = 0; o < 8; ++o) { s1[o] += out[i][o].x + out[i][o].y; s2[o] += out[i][o].x * out[i][o].x + out[i][o].y * out[i][o].y; }
    }
    unsigned az[4][8];
#pragma unroll
    for (int i = 0; i < 4; ++i)
#pragma unroll
        for (int o = 0; o < 8; ++o) az[i][o] = *(const unsigned*)(B0 + (row0 + 8 * w + o) * 1024 + 2 * (lane + 64 * i));
#pragma unroll
    for (int o = 0; o < 8; ++o) { s1[o] = wave_sum(s1[o]); s2[o] = wave_sum(s2[o]); }
#pragma unroll
    for (int i = 0; i < 4; ++i) {
        const int p = lane + 64 * i;
        const f32x2 gg = *(const f32x2*)(F.P.cn_g + l * DA + 2 * p), be = *(const f32x2*)(F.P.cn_b + l * DA + 2 * p);
#pragma unroll
        for (int o = 0; o < 8; ++o) { const float mu = s1[o] * (1.f / DA), ex2 = s2[o] * (1.f / DA); const float rstd = rsqrtf(fmaxf(ex2 - mu * mu, 0.f) + EPS);
            f32x2 y = (out[i][o] - mu) * rstd * gg + be; y.x = y.x * fsigm(y.x); y.y = y.y * fsigm(y.y);
            *(unsigned*)(outb + (row0 + 8 * w + o) * 1024 + 2 * p) = cvt_pk_bf16(y.x * __uint_as_float(az[i][o] << 16), y.y * __uint_as_float(az[i][o] & 0xffff0000u)); }
    }
    __syncthreads();
}
__device__ __forceinline__ void p2_gmlp(Frame& F, int l, int unit, bf16_t* outb) {
    constexpr int VTP = 136;
    const int tid = F.tid, lane = F.lane, w = F.wave, fr = lane & 15, fq = lane >> 4, ch = unit >> 1, gp = unit & 1, c0 = 256 * gp; const size_t row0 = (size_t)ch * CHK;
    LAS bf16_t* vt = (LAS bf16_t*)(F.lds + RING_OFF);
    const bf16_t* V = (const bf16_t*)(F.P.ws + WS_B3) + 512 + c0; const bf16_t* U = (const bf16_t*)(F.P.ws + WS_B0) + 512 + c0; const bf16_t* BZ = (const bf16_t*)(F.P.ws + WS_B4) + c0;
    const float* vss = (const float*)(F.P.ws + WS_VSS); const float* gn = F.P.gn_g + l * DB + c0;
    const size_t t = row0 + 16 * w + fr;
    unsigned long long uu[16], zz[16];
#pragma unroll
    for (int n = 0; n < 16; ++n) { uu[n] = *(const unsigned long long*)(U + t * 1024 + 16 * n + 4 * fq); zz[n] = *(const unsigned long long*)(BZ + t * 512 + 16 * n + 4 * fq); }
    bf16x8 wf[2][4];
#pragma unroll
    for (int g2 = 0; g2 < 2; ++g2)
#pragma unroll
        for (int ks = 0; ks < 4; ++ks) wf[g2][ks] = *(const bf16x8*)((const bf16_t*)(F.P.ws + WS_WSB) + ((size_t)(l * NG + 2 * gp + g2) * CHK + 16 * w + fr) * CHK + 32 * ks + 8 * fq);
    const float bs0 = F.P.b_s[(size_t)(l * NG + 2 * gp) * CHK + 16 * w + fr], bs1 = F.P.b_s[(size_t)(l * NG + 2 * gp + 1) * CHK + 16 * w + fr];
    { const int sidx = tid & 127; const f32x4 qa = *(const f32x4*)(vss + (row0 + sidx) * 8), qb = *(const f32x4*)(vss + (row0 + sidx) * 8 + 4);
      const float ss = ((qa.x + qa.y) + (qa.z + qa.w)) + ((qb.x + qb.y) + (qb.z + qb.w)); const float rv = rsqrtf(ss * (1.f / DB) + EPS);
      u32x4 raw[8];
#pragma unroll
      for (int k = 0; k < 8; ++k) raw[k] = *(const u32x4*)(V + (row0 + sidx) * 1024 + ((tid >> 7) + 4 * k) * 8);
#pragma unroll
      for (int k = 0; k < 8; ++k) { const int c8 = ((tid >> 7) + 4 * k) * 8; f32x4 v0, v1; unpack8(raw[k], v0, v1); const f32x4 g0 = *(const f32x4*)(gn + c8), g1 = *(const f32x4*)(gn + c8 + 4);
          v0 = v0 * rv * g0; v1 = v1 * rv * g1;
#pragma unroll
          for (int e = 0; e < 4; ++e) { vt[(c8 + e) * VTP + sidx] = f2bf(v0[e]); vt[(c8 + 4 + e) * VTP + sidx] = f2bf(v1[e]); } } }
    __syncthreads();
    f32x4 acc[16];
#pragma unroll
    for (int n = 0; n < 16; ++n) acc[n] = (f32x4){0.f, 0.f, 0.f, 0.f};
#pragma unroll
    for (int ks = 0; ks < 4; ++ks) {
        if (32 * ks <= 16 * w + 15) {
#pragma unroll
            for (int n = 0; n < 16; ++n) { const bf16x8 vf = *(const LAS bf16x8*)(vt + (16 * n + fr) * VTP + 32 * ks + 8 * fq); acc[n] = __builtin_amdgcn_mfma_f32_16x16x32_bf16(vf, wf[n >> 3][ks], acc[n], 0, 0, 0); }
        }
    }
#pragma unroll
    for (int n = 0; n < 16; ++n) { const float bs = n < 8 ? bs0 : bs1;
        const unsigned u0 = (unsigned)uu[n], u1 = (unsigned)(uu[n] >> 32), z0 = (unsigned)zz[n], z1 = (unsigned)(zz[n] >> 32);
        const float o0 = __uint_as_float(u0 << 16) * (acc[n][0] + bs) * __uint_as_float(z0 << 16), o1 = __uint_as_float(u0 & 0xffff0000u) * (acc[n][1] + bs) * __uint_as_float(z0 & 0xffff0000u);
        const float o2 = __uint_as_float(u1 << 16) * (acc[n][2] + bs) * __uint_as_float(z1 << 16), o3 = __uint_as_float(u1 & 0xffff0000u) * (acc[n][3] + bs) * __uint_as_float(z1 & 0xffff0000u);
        *(unsigned long long*)(outb + 512 + c0 + t * 1024 + 16 * n + 4 * fq) = (unsigned long long)cvt_pk_bf16(o0, o1) | ((unsigned long long)cvt_pk_bf16(o2, o3) << 32); }
    __syncthreads();
}

__global__ void __launch_bounds__(NWAVES * 64, 2) mk_fwd(Args args) {
    extern __shared__ __attribute__((aligned(16))) unsigned char lds[];
    Frame F;
    F.lds = (LAS unsigned char*)lds;
    volatile LAS unsigned* MISC = (volatile LAS unsigned*)(F.lds + MISC_OFF);
    F.tid = threadIdx.x; F.lane = F.tid & 63; F.wave = __builtin_amdgcn_readfirstlane(F.tid >> 6);
    F.G = gridDim.x; { const int bx = blockIdx.x; F.vcu = (F.G % 8 == 0) ? (bx % 8) * (F.G / 8) + bx / 8 : bx; }
    F.P.x = args.in[0]; F.P.norm_g = args.in[1]; F.P.w_in = args.in[2]; F.P.b_gate = args.in[3]; F.P.conv_w = args.in[4]; F.P.conv_b = args.in[5]; F.P.cn_g = args.in[6]; F.P.cn_b = args.in[7]; F.P.w_a = args.in[8];
    F.P.gn_g = args.in[9]; F.P.w_s = args.in[10]; F.P.b_s = args.in[11]; F.P.w_b = args.in[12]; F.P.qn_g = args.in[13]; F.P.kn_g = args.in[14]; F.P.b_f = args.in[15]; F.P.w_c = args.in[16]; F.P.w_out = args.in[17];
    F.P.out = args.out; F.P.ws = args.ws;
    gu32* ctl = (gu32*)(args.ws + WS_CTL);
    for (int u = F.tid; u < (LDS_BYTES - LDSCTL_OFF) / 4; u += NWAVES * 64) ((LAS unsigned*)(F.lds + LDSCTL_OFF))[u] = 0u;
    __syncthreads();
    XcdBarrier bar = xcd_barrier_post((unsigned*)(ctl + CW_BAR) + args.li * XCD_BAR_WORDS, MISC + 8);

    bool dup_done = false;
    for (int ph = args.ph_lo; ph < args.ph_hi;) {
        const int l = ph / 5, p = ph % 5;
        const bool dummy = (PROBE_DUP >= 0) && p == PROBE_DUP && !dup_done;
        asm volatile("" : "+v"(F.tid)); F.lane = F.tid & 63;
        int bid = (int)blockIdx.x; asm volatile("" : "+s"(bid));
        unsigned char* ws = F.P.ws; unsigned char* wl = ws + WS_W + (size_t)l * W_LAYER;
        const float* xin = l == 0 ? F.P.x : F.P.out;
        if (p == 0) {
            if (l == 0) p0_weights(F);
            p0_ln(F, l, xin);
        } else if (p == 1) {
            if (bid < NB * NH) p1_scan(F, bid);
            pg8::SchedG1 S; S.T.init(M, N1, F.G, bid); S.A = (const char*)(ws + WS_H); S.B = (const char*)(wl + WO_W1);
            pg8::EpiG1 E{(bf16_t*)(ws + WS_B0), (bf16_t*)(ws + WS_B1), (bf16_t*)(ws + WS_B2), (bf16_t*)(ws + WS_B3), (bf16_t*)(ws + WS_B4), (float*)(ws + WS_VSS), F.P.qn_g + l * HD, F.P.kn_g + l * HD};
            pg8::gemm_phase<pg8::EpiG1, pg8::SchedG1>(F.lds + RING_OFF, S, E);
        } else if (p == 2) {
            if (!dummy || (PROBE_SUB & 1)) p2_conv(F, l, bid, dummy ? (bf16_t*)(ws + WS_DUMMY) : (bf16_t*)(ws + WS_B0));
            if (!dummy || (PROBE_SUB & 2)) { bf16_t* ob = dummy ? (bf16_t*)(ws + WS_DUMMY) : (bf16_t*)(ws + WS_B0); p2_gmlp(F, l, bid, ob); }
            if (!dummy || (PROBE_SUB & 4)) { const int bh = F.vcu >> 3, sq = F.vcu & 7; const attn_body::bf16* b1 = (const attn_body::bf16*)(ws + WS_B1); const attn_body::bf16* b2 = (const attn_body::bf16*)(ws + WS_B2);
              const float* c2g = (const float*)(ws + WS_CS) + (size_t)bh * SEQ; const int* tsg = (const int*)(ws + WS_TS) + bh * 16;
              float gqm = fabsf(F.P.qn_g[l * HD + F.lane]), gkm = fabsf(F.P.kn_g[l * HD + F.lane]);
#pragma unroll
              for (int o_ = 1; o_ < 64; o_ <<= 1) { gqm = fmaxf(gqm, __shfl_xor(gqm, o_)); gkm = fmaxf(gkm, __shfl_xor(gkm, o_)); }
              const float ub = 64.f * C2 * gqm * gkm * 1.01f;
              for (int i = 0; i < 2; ++i) { const int qb = i == 0 ? 15 - sq : sq; const int ts = __builtin_amdgcn_readfirstlane(tsg[qb]); attn_body::attn_unit<8>(bh / NH, bh % NH, qb, b1, b1 + 512, b2, b2 + 512, dummy ? (attn_body::bf16*)(ws + WS_DUMMY) : (attn_body::bf16*)(ws + WS_B1), c2g, ts, ub, (char*)lds + RING_OFF); } }
        } else if (p == 3) {
            pg8::TileOrder T; T.init(M, D, F.G, bid);
            pg8::SchedMerge S; { int pm_ = 0, pn_ = 0; S.ok = T.tile(0, pm_, pn_); S.pm = pm_; S.pn = pn_; }
            S.ws = (const char*)ws; S.wl = (const char*)wl;
            pg8::EpiMerge E{ws + WS_GT + (size_t)bid * 131072, (bf16_t*)(ws + WS_MG), F.P.b_gate + (size_t)l * 3072};
            pg8::gemm_phase<pg8::EpiMerge, pg8::SchedMerge>(F.lds + RING_OFF, S, E);
        } else {
            pg8::SchedG1 S; S.T.init(M, D, F.G, bid); S.A = (const char*)(ws + WS_MG); S.B = (const char*)(wl + WO_WO);
            pg8::EpiOut E{xin, dummy ? (float*)(ws + WS_H) : F.P.out};
            pg8::gemm_phase<pg8::EpiOut, pg8::SchedG1>(F.lds + RING_OFF, S, E);
        }
        if (dummy) { dup_done = true; continue; }
        dup_done = false; ++ph;
        if (ph < args.ph_hi) xcd_barrier(bar);
    }
}

#ifndef MK_MODE
#define MK_MODE 2
#endif
extern "C" void kernel_launch(void* const* d_in, const int* in_sizes, int n_in, void* d_out, int out_size, void* d_ws, size_t ws_size, hipStream_t stream) {
    static int ok = 0;
    if (ok == 0) {
        if (n_in != 18 || in_sizes[0] != M * D || out_size != M * D || ws_size < WS_END) { fprintf(stderr, "kernel_launch: unexpected shapes (n_in %d in0 %d out %d ws %zu)\n", n_in, n_in > 0 ? in_sizes[0] : -1, out_size, ws_size); ok = -1; return; }
        const int tl = 64 * TLD * 4;
        (void)hipFuncSetAttribute((const void*)nv_gemm1, hipFuncAttributeMaxDynamicSharedMemorySize, tl);
        (void)hipFuncSetAttribute((const void*)nv_merge, hipFuncAttributeMaxDynamicSharedMemorySize, 2 * 64 * 256 * 4);
        (void)hipFuncSetAttribute((const void*)nv_gmlp, hipFuncAttributeMaxDynamicSharedMemorySize, 128 * 129 * 4);
        (void)hipFuncSetAttribute((const void*)nv_attn, hipFuncAttributeMaxDynamicSharedMemorySize, 4 * SEQ * 4);
        if (hipFuncSetAttribute((const void*)mk_fwd, hipFuncAttributeMaxDynamicSharedMemorySize, LDS_BYTES) != hipSuccess) { fprintf(stderr, "kernel_launch: hipFuncSetAttribute(mk_fwd) failed\n"); ok = -1; return; }
        int dev = 0, cus = 0; (void)hipGetDevice(&dev); (void)hipDeviceGetAttribute(&cus, hipDeviceAttributeMultiprocessorCount, dev);
        if (cus != 256) fprintf(stderr, "kernel_launch: note: %d CUs (built for 256)\n", cus);
        (void)hipGetLastError();
        ok = 1;
    }
    if (ok < 0) return;
    Ptrs P{};
    const float** pp = (const float**)&P;
    for (int i = 0; i < 18; ++i) pp[i] = (const float*)d_in[i];
    P.out = (float*)d_out; P.ws = (unsigned char*)d_ws;
    const int tl = 64 * TLD * 4;
#if MK_MODE == 0
    nv_prep<<<2048, 256, 0, stream>>>(P);
    for (int l = 0; l < NL; ++l) {
        const float* xin = l == 0 ? P.x : P.out;
        nv_ln<<<M / 4, 256, 0, stream>>>(P, l, xin);
        nv_scan<<<NB * NH, 256, 0, stream>>>(P);
        nv_gemm1<<<dim3(20, 256), 256, tl, stream>>>(P, l);
        nv_conv<<<M, 512, 0, stream>>>(P, l);
        nv_gmlp<<<dim3(128, 4), 256, 128 * 129 * 4, stream>>>(P, l);
        nv_attn<<<M * NH / 4, 256, 4 * SEQ * 4, stream>>>(P);
        nv_merge<<<dim3(4, 256), 256, 2 * 64 * 256 * 4, stream>>>(P, l);
        nv_out<<<dim3(4, 256), 256, 0, stream>>>(P, l, xin, P.out);
    }
#else
    (void)tl;
    if (hipMemsetAsync((char*)d_ws + WS_CTL, 0, CTL_ZERO_BYTES, stream) != hipSuccess) { fprintf(stderr, "kernel_launch: memset failed\n"); return; }
    Args a{};
    for (int i = 0; i < 18; ++i) a.in[i] = (const float*)d_in[i];
    a.out = (float*)d_out; a.ws = (unsigned char*)d_ws;
    auto mk = [&](int lo, int hi, int li) { a.ph_lo = lo; a.ph_hi = hi; a.li = li; hipLaunchKernelGGL(mk_fwd, dim3(256), dim3(NWAVES * 64), LDS_BYTES, stream, a);
        const hipError_t le = hipPeekAtLastError(); if (le != hipSuccess) fprintf(stderr, "kernel_launch: mk launch [%d,%d) failed: %s\n", lo, hi, hipGetErrorName(le)); };
#if MK_MODE == 1
    auto mixers = [&](int l) { nv_conv<<<M, 512, 0, stream>>>(P, l); nv_gmlp<<<dim3(128, 4), 256, 128 * 129 * 4, stream>>>(P, l); nv_attn<<<M * NH / 4, 256, 4 * SEQ * 4, stream>>>(P); };
    mk(0, 2, 0); mixers(0); mk(3, 7, 1); mixers(1); mk(8, 10, 2);
#else
    mk(0, NPH, 0);
#endif
#endif
}
```

```cpp
#include <hip/hip_runtime.h>
#include <cstdio>
#include <cstdint>
#include <cmath>

constexpr int NL = 2, NB = 4, SEQ = 4096, M = NB * SEQ, D = 1024;
constexpr int DA = 512, DB = 512, NH = 8, HD = 64, DC = 512, CW = 31, CHK = 128, NG = 4, GD = 128, NIN = 8200;
constexpr float EPS = 1e-6f;
constexpr float LOG2E = 1.4426950408889634f;
constexpr float C2 = 0.125f * LOG2E;
constexpr int N1 = 5120;
constexpr int OC_GATE = 0, OC_AIN = 3072, OC_AZ = 4096, OC_U = 4608, OC_V = 5120, OC_BZ = 5632, OC_Q = 6144, OC_K = 6656, OC_VA = 7168, OC_CZ = 7680, OC_F = 8192;

constexpr size_t MiB = 1u << 20;
constexpr size_t WS_CTL = 0, CTL_ZERO_BYTES = 1 * MiB;
constexpr size_t WS_VSS = 1 * MiB;
constexpr size_t WS_LOGF = WS_VSS + 512 * 1024;
constexpr size_t WS_CS = 2 * MiB;
constexpr size_t WS_WSB = WS_CS + 512 * 1024;
constexpr size_t WS_TS = 3 * MiB;
constexpr size_t WS_W = 4 * MiB, W_LAYER = 22 * MiB;
constexpr size_t WO_W1 = 0, WO_WG = 10 * MiB, WO_WAB = 16 * MiB, WO_WC = 18 * MiB, WO_WO = 20 * MiB;
constexpr size_t WS_H = 48 * MiB;
constexpr size_t WS_B0 = 80 * MiB;
constexpr size_t WS_B1 = 112 * MiB;
constexpr size_t WS_B2 = 144 * MiB;
constexpr size_t WS_B3 = 176 * MiB;
constexpr size_t WS_B4 = 208 * MiB;
constexpr size_t WS_GT = WS_B2, WS_MG = WS_B3;
constexpr size_t WS_FP = 240 * MiB;
constexpr size_t WS_SSP = 242 * MiB;
constexpr size_t WS_DUMMY = 224 * MiB;
constexpr size_t WS_END = 256 * MiB;
#ifndef PROBE_CONV
#define PROBE_CONV 0
#endif
#ifndef PROBE_SUB
#define PROBE_SUB 7
#endif
#ifndef PROBE_DUP
#define PROBE_DUP -1
#endif

typedef unsigned short bf16_t;
typedef short bf16x8 __attribute__((ext_vector_type(8)));
typedef float f32x4 __attribute__((ext_vector_type(4)));
typedef unsigned u32x4 __attribute__((ext_vector_type(4)));

__host__ __device__ __forceinline__ float bf2f(bf16_t v) { union { unsigned u; float f; } c; c.u = (unsigned)v << 16; return c.f; }
__host__ __device__ __forceinline__ bf16_t f2bf(float f) { union { unsigned u; float f; } c; c.f = f; unsigned u = c.u; return (bf16_t)((u + 0x7fffu + ((u >> 16) & 1u)) >> 16); }
__device__ __forceinline__ float bfr(float f) { return bf2f(f2bf(f)); }
__device__ __forceinline__ float sigm(float x) { return 1.f / (1.f + __expf(-x)); }
__device__ __forceinline__ float siluf(float x) { return x * sigm(x); }

__host__ __device__ __forceinline__ int g1_col(int n) {
    const int j = n >> 8, lc = n & 255;
    if (j < 4) return lc < 128 ? OC_AIN + 128 * j + lc : OC_AIN + 512 + 128 * j + (lc - 128);
    if (j < 6) return OC_AZ + 256 * (j - 4) + lc;
    if (j < 8) return OC_U + 256 * (j - 6) + lc;
    if (j < 10) return OC_V + 256 * (j - 8) + lc;
    if (j < 12) return OC_BZ + 256 * (j - 10) + lc;
    if (j < 16) { const int isk = j >= 14, jj = (j - 12) & 1, head = 4 * jj + ((lc >> 5) & 3), d = 32 * (lc >> 7) + (lc & 31); return (isk ? OC_K : OC_Q) + 64 * head + d; }
    if (j < 18) return OC_VA + 256 * (j - 16) + lc;
    return OC_CZ + 256 * (j - 18) + lc;
}

struct Ptrs {
    const float *x, *norm_g, *w_in, *b_gate, *conv_w, *conv_b, *cn_g, *cn_b, *w_a, *gn_g, *w_s, *b_s, *w_b, *qn_g, *kn_g, *b_f, *w_c, *w_out;
    float* out; unsigned char* ws;
};

__global__ void nv_prep(Ptrs P) {
    const size_t gid = (size_t)blockIdx.x * blockDim.x + threadIdx.x, gsz = (size_t)gridDim.x * blockDim.x;
    for (int l = 0; l < NL; ++l) {
        unsigned char* wl = P.ws + WS_W + (size_t)l * W_LAYER;
        bf16_t* W1 = (bf16_t*)(wl + WO_W1); bf16_t* WG = (bf16_t*)(wl + WO_WG); bf16_t* WAB = (bf16_t*)(wl + WO_WAB); bf16_t* WC = (bf16_t*)(wl + WO_WC); bf16_t* WO = (bf16_t*)(wl + WO_WO);
        const float* win = P.w_in + (size_t)l * D * NIN;
        for (size_t i = gid; i < (size_t)N1 * D; i += gsz) { const int n = (int)(i >> 10), k = (int)(i & 1023); W1[i] = f2bf(win[(size_t)k * NIN + g1_col(n)]); }
        for (size_t i = gid; i < (size_t)3072 * D; i += gsz) { const int n = (int)(i >> 10), k = (int)(i & 1023); WG[i] = f2bf(win[(size_t)k * NIN + n]); }
        for (size_t i = gid; i < (size_t)1024 * 1024; i += gsz) { const int n = (int)(i >> 10), k = (int)(i & 1023);
            WAB[i] = f2bf(k < 512 ? P.w_a[((size_t)l * DA + k) * D + n] : P.w_b[((size_t)l * DB + (k - 512)) * D + n]);
            WC[i] = k < 512 ? f2bf(P.w_c[((size_t)l * DC + k) * D + n]) : (bf16_t)0;
            WO[i] = f2bf(P.w_out[((size_t)l * D + k) * D + n]); }
        bf16_t* WSB = (bf16_t*)(P.ws + WS_WSB) + (size_t)l * NG * CHK * CHK;
        for (size_t i = gid; i < (size_t)NG * CHK * CHK; i += gsz) { const int s = (int)(i & 127), t = (int)((i >> 7) & 127); WSB[i] = s <= t ? f2bf(P.w_s[(size_t)l * NG * CHK * CHK + i]) : (bf16_t)0; }
    }
}

__device__ __forceinline__ float wave_sum(float v) {
#pragma unroll
    for (int o = 1; o < 64; o <<= 1) v += __shfl_xor(v, o);
    return v;
}

__global__ void nv_ln(Ptrs P, int l, const float* xin) {
    const int lane = threadIdx.x & 63, row = blockIdx.x * 4 + (threadIdx.x >> 6);
    const float* xr = xin + (size_t)row * D; const float* g = P.norm_g + (size_t)l * D; const float* win = P.w_in + (size_t)l * D * NIN;
    float v[16]; float ss = 0.f;
#pragma unroll
    for (int j = 0; j < 16; ++j) { v[j] = xr[lane + 64 * j]; ss += v[j] * v[j]; }
    ss = wave_sum(ss);
    const float r = rsqrtf(ss * (1.f / D) + EPS);
    bf16_t* h = (bf16_t*)(P.ws + WS_H) + (size_t)row * D;
    float f[8] = {0, 0, 0, 0, 0, 0, 0, 0};
#pragma unroll
    for (int j = 0; j < 16; ++j) { const int k = lane + 64 * j; const float hv = v[j] * r * g[k]; h[k] = f2bf(hv);
#pragma unroll
        for (int e = 0; e < 8; ++e) f[e] += hv * win[(size_t)k * NIN + OC_F + e]; }
#pragma unroll
    for (int e = 0; e < 8; ++e) f[e] = wave_sum(f[e]);
    if (lane < 8) { float z = 0.f;
#pragma unroll
        for (int e = 0; e < 8; ++e) if (lane == e) z = f[e];
        z += P.b_f[l * NH + lane];
        const float lf = fminf(z, 0.f) - log1pf(expf(-fabsf(z)));
        ((float*)(P.ws + WS_LOGF))[(size_t)row * 8 + lane] = lf; }
}

__global__ void nv_scan(Ptrs P) {
    __shared__ float buf[SEQ];
    const int bh = blockIdx.x, b = bh / NH, h = bh % NH;
    const float* lf = (const float*)(P.ws + WS_LOGF);
    for (int t = threadIdx.x; t < SEQ; t += blockDim.x) buf[t] = lf[((size_t)b * SEQ + t) * 8 + h];
    __syncthreads();
    if (threadIdx.x == 0) { float c = 0.f; for (int t = 0; t < SEQ; ++t) { c += buf[t]; buf[t] = c * LOG2E; } }
    __syncthreads();
    float* cs = (float*)(P.ws + WS_CS) + (size_t)bh * SEQ;
    for (int t = threadIdx.x; t < SEQ; t += blockDim.x) cs[t] = buf[t];
}

constexpr int TLD = 257;
__device__ __forceinline__ void nv_gemm_acc(const bf16_t* A, int lda, const bf16_t* Bt, int ldb, int K, f32x4 (&acc)[4][4]) {
    const int tid = threadIdx.x, w = tid >> 6, l = tid & 63, fr = l & 15, fq = l >> 4;
#pragma unroll
    for (int m = 0; m < 4; ++m)
#pragma unroll
        for (int n = 0; n < 4; ++n) acc[m][n] = (f32x4){0.f, 0.f, 0.f, 0.f};
    for (int k0 = 0; k0 < K; k0 += 32) {
        bf16x8 a[4], b[4];
#pragma unroll
        for (int m = 0; m < 4; ++m) a[m] = *(const bf16x8*)(A + (size_t)(16 * m + fr) * lda + k0 + 8 * fq);
#pragma unroll
        for (int n = 0; n < 4; ++n) b[n] = *(const bf16x8*)(Bt + (size_t)(64 * w + 16 * n + fr) * ldb + k0 + 8 * fq);
#pragma unroll
        for (int m = 0; m < 4; ++m)
#pragma unroll
            for (int n = 0; n < 4; ++n) acc[m][n] = __builtin_amdgcn_mfma_f32_16x16x32_bf16(a[m], b[n], acc[m][n], 0, 0, 0);
    }
}
__device__ __forceinline__ void nv_gemm_tile(const bf16_t* A, int lda, const bf16_t* Bt, int ldb, int K, float* T) {
    const int tid = threadIdx.x, w = tid >> 6, l = tid & 63, fr = l & 15, fq = l >> 4;
    f32x4 acc[4][4];
    nv_gemm_acc(A, lda, Bt, ldb, K, acc);
#pragma unroll
    for (int m = 0; m < 4; ++m)
#pragma unroll
        for (int n = 0; n < 4; ++n)
#pragma unroll
            for (int r = 0; r < 4; ++r) T[(16 * m + 4 * fq + r) * TLD + 64 * w + 16 * n + fr] = acc[m][n][r];
}

__global__ void __launch_bounds__(256) nv_gemm1(Ptrs P, int l) {
    extern __shared__ float T[];
    __shared__ float R[64 * 4];
    const int j = blockIdx.x, row0 = blockIdx.y * 64, tid = threadIdx.x;
    const bf16_t* H = (const bf16_t*)(P.ws + WS_H);
    const bf16_t* W1 = (const bf16_t*)(P.ws + WS_W + (size_t)l * W_LAYER + WO_W1);
    nv_gemm_tile(H + (size_t)row0 * D, D, W1 + (size_t)j * 256 * D, D, D, T);
    __syncthreads();
    bf16_t* B0 = (bf16_t*)(P.ws + WS_B0); bf16_t* B1 = (bf16_t*)(P.ws + WS_B1); bf16_t* B2 = (bf16_t*)(P.ws + WS_B2); bf16_t* B3 = (bf16_t*)(P.ws + WS_B3); bf16_t* B4 = (bf16_t*)(P.ws + WS_B4);
    if (j < 4) {
        for (int e = tid; e < 64 * 128; e += 256) { const int r = e >> 7, c = e & 127; B3[(size_t)(row0 + r) * 1024 + 128 * j + c] = f2bf(T[r * TLD + c] * sigm(T[r * TLD + c + 128])); }
    } else if (j < 12 || j >= 16) {
        bf16_t* dst; int pitch, coff; bool act;
        if (j < 6) { dst = B0; pitch = 1024; coff = 256 * (j - 4); act = true; }
        else if (j < 8) { dst = B0; pitch = 1024; coff = 512 + 256 * (j - 6); act = false; }
        else if (j < 10) { dst = B3; pitch = 1024; coff = 512 + 256 * (j - 8); act = false; }
        else if (j < 12) { dst = B4; pitch = 512; coff = 256 * (j - 10); act = true; }
        else if (j < 18) { dst = B2; pitch = 1024; coff = 256 * (j - 16); act = false; }
        else { dst = B2; pitch = 1024; coff = 512 + 256 * (j - 18); act = true; }
        for (int e = tid; e < 64 * 256; e += 256) { const int r = e >> 8, c = e & 255; const float v = T[r * TLD + c]; dst[(size_t)(row0 + r) * pitch + coff + c] = f2bf(act ? siluf(v) : v); }
        if (j == 8 || j == 9) { const int r = tid >> 2, wc = tid & 3; float s = 0.f;
            for (int bj = 0; bj < 2; ++bj) for (int i = 0; i < 32; ++i) { const float v = T[r * TLD + 128 * bj + 32 * wc + i]; s += v * v; }
            ((float*)(P.ws + WS_VSS))[(size_t)(row0 + r) * 8 + (j - 8) * 4 + wc] = s; }
    } else {
        const bool isk = j >= 14; const int jj = (j - 12) & 1;
        { const int r = tid >> 2, hh = tid & 3; float s = 0.f;
          for (int d = 0; d < 64; ++d) { const float v = T[r * TLD + 128 * (d >> 5) + 32 * hh + (d & 31)]; s += v * v; }
          R[r * 4 + hh] = rsqrtf(s * (1.f / 64.f) + EPS); }
        __syncthreads();
        const float* gq = (isk ? P.kn_g : P.qn_g) + (size_t)l * HD;
        for (int e = tid; e < 64 * 256; e += 256) { const int r = e >> 8, c = e & 255, hh = (c >> 5) & 3, d = 32 * (c >> 7) + (c & 31);
            float v = T[r * TLD + c] * R[r * 4 + hh] * gq[d]; if (!isk) v *= C2;
            B1[(size_t)(row0 + r) * 1024 + (isk ? 512 : 0) + 64 * (4 * jj + hh) + d] = f2bf(v); }
    }
}

__global__ void __launch_bounds__(512) nv_conv(Ptrs P, int l) {
    __shared__ float red[16];
    const int row = blockIdx.x, t = row % SEQ, c = threadIdx.x, lane = c & 63, w = c >> 6;
    const bf16_t* AG = (const bf16_t*)(P.ws + WS_B3); bf16_t* B0 = (bf16_t*)(P.ws + WS_B0);
    const float* cw = P.conv_w + (size_t)l * CW * DA;
    float a = P.conv_b[l * DA + c];
    for (int j = 0; j < CW; ++j) { const int tt = t - (CW - 1) + j; if (tt >= 0) a += cw[j * DA + c] * bf2f(AG[(size_t)(row - (CW - 1) + j) * 1024 + c]); }
    float s = wave_sum(a); if (lane == 0) red[w] = s; __syncthreads();
    float mu = 0.f; for (int i = 0; i < 8; ++i) mu += red[i]; mu *= (1.f / DA);
    const float d = a - mu; s = wave_sum(d * d); if (lane == 0) red[8 + w] = s; __syncthreads();
    float var = 0.f; for (int i = 0; i < 8; ++i) var += red[8 + i]; var *= (1.f / DA);
    const float y = d * rsqrtf(var + EPS) * P.cn_g[l * DA + c] + P.cn_b[l * DA + c];
    const float az = bf2f(B0[(size_t)row * 1024 + c]);
    B0[(size_t)row * 1024 + c] = f2bf(siluf(y) * az);
}

__global__ void __launch_bounds__(256) nv_gmlp(Ptrs P, int l) {
    extern __shared__ float vn[];
    const int ch = blockIdx.x, g = blockIdx.y, tid = threadIdx.x; const size_t row0 = (size_t)ch * CHK;
    const bf16_t* V = (const bf16_t*)(P.ws + WS_B3); bf16_t* B0 = (bf16_t*)(P.ws + WS_B0); const bf16_t* BZ = (const bf16_t*)(P.ws + WS_B4);
    const float* vss = (const float*)(P.ws + WS_VSS);
    const bf16_t* WSB = (const bf16_t*)(P.ws + WS_WSB) + ((size_t)l * NG + g) * CHK * CHK;
    for (int e = tid; e < 128 * 128; e += 256) { const int s = e >> 7, c = e & 127; const float* q = vss + (row0 + s) * 8;
        const float ss = ((q[0] + q[1]) + (q[2] + q[3])) + ((q[4] + q[5]) + (q[6] + q[7])); const float rv = rsqrtf(ss * (1.f / DB) + EPS);
        vn[s * 129 + c] = bfr(bf2f(V[(row0 + s) * 1024 + 512 + 128 * g + c]) * rv * P.gn_g[l * DB + 128 * g + c]); }
    __syncthreads();
    for (int e = tid; e < 128 * 128; e += 256) { const int t = e >> 7, c = e & 127; float acc = 0.f;
        for (int s = 0; s <= t; ++s) acc += bf2f(WSB[t * 128 + s]) * vn[s * 129 + c];
        acc += P.b_s[((size_t)l * NG + g) * CHK + t];
        const size_t o = (row0 + t) * 1024 + 512 + 128 * g + c;
        B0[o] = f2bf(bf2f(B0[o]) * acc * bf2f(BZ[(row0 + t) * 512 + 128 * g + c])); }
}

__global__ void __launch_bounds__(256) nv_attn(Ptrs P) {
    extern __shared__ float sc[];
    const int lane = threadIdx.x & 63, w = threadIdx.x >> 6; const int item = blockIdx.x * 4 + w, row = item >> 3, h = item & 7, b = row / SEQ, t = row % SEQ;
    float* s = sc + w * SEQ;
    bf16_t* B1 = (bf16_t*)(P.ws + WS_B1); const bf16_t* B2 = (const bf16_t*)(P.ws + WS_B2);
    const float* cs = (const float*)(P.ws + WS_CS) + (size_t)(b * NH + h) * SEQ;
    float q[64];
#pragma unroll
    for (int d = 0; d < 64; ++d) q[d] = bf2f(B1[(size_t)row * 1024 + 64 * h + d]);
    const float cq = cs[t]; float mx = -INFINITY;
    for (int k = lane; k <= t; k += 64) { const bf16_t* kr = B1 + ((size_t)b * SEQ + k) * 1024 + 512 + 64 * h; float dot = 0.f;
#pragma unroll
        for (int d8 = 0; d8 < 8; ++d8) { const bf16x8 kv = *(const bf16x8*)(kr + 8 * d8);
#pragma unroll
            for (int e = 0; e < 8; ++e) dot += q[8 * d8 + e] * bf2f((bf16_t)kv[e]); }
        const float v = dot + (cq - cs[k]); s[k] = v; mx = fmaxf(mx, v); }
#pragma unroll
    for (int o = 1; o < 64; o <<= 1) mx = fmaxf(mx, __shfl_xor(mx, o));
    float lsum = 0.f;
    for (int k = lane; k <= t; k += 64) { const float p = exp2f(s[k] - mx); lsum += p; s[k] = bfr(p); }
    lsum = wave_sum(lsum);
    __builtin_amdgcn_s_waitcnt(0); __builtin_amdgcn_wave_barrier();
    float o = 0.f; const bf16_t* vb = B2 + (size_t)b * SEQ * 1024 + 64 * h + lane;
    for (int k = 0; k <= t; ++k) o += s[k] * bf2f(vb[(size_t)k * 1024]);
    const float cz = bf2f(B2[(size_t)row * 1024 + 512 + 64 * h + lane]);
    B1[(size_t)row * 1024 + 64 * h + lane] = f2bf(o / lsum * cz);
}

__global__ void __launch_bounds__(256) nv_merge(Ptrs P, int l) {
    extern __shared__ float T[];
    const int pn = blockIdx.x, row0 = blockIdx.y * 64, tid = threadIdx.x, w = tid >> 6, ln = tid & 63, fr = ln & 15, fq = ln >> 4;
    const unsigned char* wl = P.ws + WS_W + (size_t)l * W_LAYER;
    const bf16_t* H = (const bf16_t*)(P.ws + WS_H); const bf16_t* WG = (const bf16_t*)(wl + WO_WG); const bf16_t* WAB = (const bf16_t*)(wl + WO_WAB); const bf16_t* WC = (const bf16_t*)(wl + WO_WC);
    const bf16_t* B0 = (const bf16_t*)(P.ws + WS_B0); const bf16_t* B1 = (const bf16_t*)(P.ws + WS_B1);
    float* G = T; float* MGs = T + 64 * 256;
    f32x4 acc[4][4];
    for (int br = 0; br < 3; ++br) {
        nv_gemm_acc(H + (size_t)row0 * D, D, WG + ((size_t)br * 1024 + 256 * pn) * D, D, D, acc);
#pragma unroll
        for (int m = 0; m < 4; ++m)
#pragma unroll
            for (int n = 0; n < 4; ++n)
#pragma unroll
                for (int r = 0; r < 4; ++r) { const int c = 64 * w + 16 * n + fr; G[((m * 4 + n) * 4 + r) * 256 + tid] = bfr(sigm(acc[m][n][r] + P.b_gate[(size_t)l * 3072 + br * 1024 + 256 * pn + c])); }
        const bf16_t* A = br == 0 ? B0 : (br == 1 ? B0 + 512 : B1); const bf16_t* Bt = br == 0 ? WAB : (br == 1 ? WAB + 512 : WC);
        nv_gemm_acc(A + (size_t)row0 * 1024, 1024, Bt + (size_t)256 * pn * 1024, 1024, 512, acc);
#pragma unroll
        for (int m = 0; m < 4; ++m)
#pragma unroll
            for (int n = 0; n < 4; ++n)
#pragma unroll
                for (int r = 0; r < 4; ++r) { const int s = ((m * 4 + n) * 4 + r) * 256 + tid; const float v = G[s] * acc[m][n][r]; MGs[s] = bfr(br == 0 ? v : MGs[s] + v); }
    }
    bf16_t* MG = (bf16_t*)(P.ws + WS_MG);
#pragma unroll
    for (int m = 0; m < 4; ++m)
#pragma unroll
        for (int n = 0; n < 4; ++n)
#pragma unroll
            for (int r = 0; r < 4; ++r) MG[(size_t)(row0 + 16 * m + 4 * fq + r) * 1024 + 256 * pn + 64 * w + 16 * n + fr] = f2bf(MGs[((m * 4 + n) * 4 + r) * 256 + tid]);
}

__global__ void __launch_bounds__(256) nv_out(Ptrs P, int l, const float* xin, float* xout) {
    const int pn = blockIdx.x, row0 = blockIdx.y * 64, tid = threadIdx.x, w = tid >> 6, ln = tid & 63, fr = ln & 15, fq = ln >> 4;
    const bf16_t* MG = (const bf16_t*)(P.ws + WS_MG); const bf16_t* WO = (const bf16_t*)(P.ws + WS_W + (size_t)l * W_LAYER + WO_WO);
    f32x4 acc[4][4];
    nv_gemm_acc(MG + (size_t)row0 * 1024, 1024, WO + (size_t)256 * pn * 1024, 1024, 1024, acc);
#pragma unroll
    for (int m = 0; m < 4; ++m)
#pragma unroll
        for (int n = 0; n < 4; ++n)
#pragma unroll
            for (int r = 0; r < 4; ++r) { const size_t o = (size_t)(row0 + 16 * m + 4 * fq + r) * D + 256 * pn + 64 * w + 16 * n + fr; xout[o] = xin[o] + acc[m][n][r]; }
}


#define LAS __attribute__((address_space(3)))
#define GAS __attribute__((address_space(1)))
__device__ __forceinline__ float wsum(float v) {
    v += __builtin_bit_cast(float, __builtin_amdgcn_update_dpp(0, __builtin_bit_cast(int, v), 0xB1, 0xF, 0xF, true));
    v += __builtin_bit_cast(float, __builtin_amdgcn_update_dpp(0, __builtin_bit_cast(int, v), 0x4E, 0xF, 0xF, true));
    v += __builtin_bit_cast(float, __builtin_amdgcn_update_dpp(0, __builtin_bit_cast(int, v), 0x141, 0xF, 0xF, true));
    v += __builtin_bit_cast(float, __builtin_amdgcn_update_dpp(0, __builtin_bit_cast(int, v), 0x140, 0xF, 0xF, true));
    const int iv = __builtin_bit_cast(int, v);
    return (__builtin_bit_cast(float, __builtin_amdgcn_readlane(iv, 0)) + __builtin_bit_cast(float, __builtin_amdgcn_readlane(iv, 16))) + (__builtin_bit_cast(float, __builtin_amdgcn_readlane(iv, 32)) + __builtin_bit_cast(float, __builtin_amdgcn_readlane(iv, 48)));
}
typedef GAS unsigned gu32;
#define RLX_AGENT __ATOMIC_RELAXED, __HIP_MEMORY_SCOPE_AGENT
#define LDS_WAIT() asm volatile("s_waitcnt lgkmcnt(0)" ::: "memory")
#define VM_WAIT() asm volatile("s_waitcnt vmcnt(0)" ::: "memory")
constexpr int NWAVES = 8;
constexpr int RING_OFF = 0, RING_BYTES = 131072;
constexpr int LDS_BYTES = 163840;
constexpr int LDSCTL_OFF = LDS_BYTES - 512, MISC_OFF = LDSCTL_OFF + 320;
constexpr int RT_OFF = LDSCTL_OFF - 1024;
constexpr int CW_TMO = 0, CW_CODE = 1, CW_BAR = 4096;
constexpr float SKIP_L2 = 160.f;
constexpr int NPH = 10;

__device__ __forceinline__ unsigned cvt_pk_bf16(float lo, float hi) { unsigned r; asm volatile("v_cvt_pk_bf16_f32 %0, %1, %2" : "=v"(r) : "v"(lo), "v"(hi)); return r; }
__device__ __forceinline__ float fsigm(float x) { return __builtin_amdgcn_rcpf(1.f + __builtin_amdgcn_exp2f(-LOG2E * x)); }
__device__ __forceinline__ u32x4 pack8(const f32x4& a, const f32x4& b) { u32x4 w; w.x = cvt_pk_bf16(a[0], a[1]); w.y = cvt_pk_bf16(a[2], a[3]); w.z = cvt_pk_bf16(b[0], b[1]); w.w = cvt_pk_bf16(b[2], b[3]); return w; }
__device__ __forceinline__ void unpack8(const u32x4& w, f32x4& a, f32x4& b) {
    a[0] = __uint_as_float(w.x << 16); a[1] = __uint_as_float(w.x & 0xffff0000u); a[2] = __uint_as_float(w.y << 16); a[3] = __uint_as_float(w.y & 0xffff0000u);
    b[0] = __uint_as_float(w.z << 16); b[1] = __uint_as_float(w.z & 0xffff0000u); b[2] = __uint_as_float(w.w << 16); b[3] = __uint_as_float(w.w & 0xffff0000u); }

namespace pg8 {
constexpr int BM = 256, BK = 64, HALF = 128, HTB = HALF * BK * 2, STAGE_BYTES = 8 * HTB, NXCD = 8, WGM = 8, PITCH = 1024;
__host__ __device__ __forceinline__ int lds_byte(int r, int c) { const int st = (r >> 4) * 2 + (c >> 5), rr = r & 15, cc = c & 31, ob = rr * 64 + cc * 2; return st * 1024 + (ob ^ (((ob >> 9) & 1) << 5)); }
__host__ __device__ __forceinline__ void stage_rc(int b, int& R, int& C) { const int st = b / 1024, sb = b % 1024, swz = sb ^ (((sb >> 9) & 1) << 5); R = (st >> 1) * 16 + swz / 64; C = (st & 1) * 32 + (swz % 64) / 2; }
__host__ __device__ __forceinline__ int perm32(int rho) { const int n = rho >> 4, i = rho & 15; return 8 * (i >> 2) + 4 * n + (i & 3); }

struct Unit { const char* A; const char* B; int nt, pm, pn, tag; };

struct TileOrder {
    int nM, nN, nwg, G, c;
    __device__ __forceinline__ void init(int Mr, int N, int G_, int c_) { nM = Mr / BM; nN = N / BM; nwg = nM * nN; G = G_; c = c_; }
    __device__ __forceinline__ bool tile(int i, int& pm, int& pn) const {
        const long L = (long)i * G + c; if (L >= nwg) return false;
        int wgid = (int)L; { const int q = nwg / NXCD, r = nwg % NXCD, xcd = wgid % NXCD, off = wgid / NXCD; wgid = (xcd < r ? xcd * (q + 1) : r * (q + 1) + (xcd - r) * q) + off; }
        const int nig = WGM * nN, gid = wgid / nig, fm = gid * WGM, gsz = (nM - fm) < WGM ? (nM - fm) : WGM;
        pm = fm + ((wgid % nig) % gsz); pn = (wgid % nig) / gsz; return true;
    }
};

template <class Epi, class Sched>
__device__ __forceinline__ void gemm_phase(LAS unsigned char* lds, const Sched& S, const Epi& E) {
    int tid = threadIdx.x; asm volatile("" : "+v"(tid));
    const int wid = __builtin_amdgcn_readfirstlane(tid >> 6), lane = tid & 63, wr = wid >> 2, wc = wid & 3, fr = lane & 15, fq = lane >> 4;
    unsigned voffA[2], voffB[2];
#pragma unroll
    for (int i = 0; i < 2; ++i) { int R, C; stage_rc(tid * 16 + i * 8192, R, C); const int Rb = (R & ~31) + perm32(R & 31);
        voffA[i] = (unsigned)(R * PITCH + C) * 2u; voffB[i] = (unsigned)(Rb * PITCH + C) * 2u; }
    const size_t kstep = (size_t)(BK * 2);
    const size_t hstep = (size_t)HALF * PITCH * 2;
    const unsigned ldsw = (unsigned)wid * 1024u;
    const int aoff = lds_byte(wr * 64 + fr, fq * 8), boff = lds_byte(wc * 32 + fr, fq * 8);
#define PG8_SA(b, h) (((b) * 2 + (h)) * HTB)
#define PG8_SB(b, h) ((4 + (b) * 2 + (h)) * HTB)
#define PG8_STAGE(bufoff, gbase, voff) do { _Pragma("unroll") for (int _i = 0; _i < 2; ++_i) \
        __builtin_amdgcn_global_load_lds((const unsigned*)((const char*)(gbase) + (voff)[_i]), (LAS unsigned*)(lds + (bufoff) + ldsw + _i * 8192), 16, 0, 0); } while (0)
#define PG8_LDA(dst, b, h) do { _Pragma("unroll") for (int m = 0; m < 4; ++m) _Pragma("unroll") for (int k = 0; k < 2; ++k) dst[m][k] = *(const LAS bf16x8*)(lds + PG8_SA(b, h) + aoff + m * 2048 + k * 1024); } while (0)
#define PG8_LDB(dst, b, h) do { _Pragma("unroll") for (int n = 0; n < 2; ++n) _Pragma("unroll") for (int k = 0; k < 2; ++k) dst[n][k] = *(const LAS bf16x8*)(lds + PG8_SB(b, h) + boff + n * 2048 + k * 1024); } while (0)
#define PG8_MMA(ai, bj, At, Bt) do { __builtin_amdgcn_s_setprio(1); _Pragma("unroll") for (int m = 0; m < 4; ++m) _Pragma("unroll") for (int n = 0; n < 2; ++n) _Pragma("unroll") for (int k = 0; k < 2; ++k) \
        acc[ai][bj][m][n] = __builtin_amdgcn_mfma_f32_16x16x32_bf16(Bt[n][k], At[m][k], acc[ai][bj][m][n], 0, 0, 0); __builtin_amdgcn_s_setprio(0); } while (0)
#define PG8_WAIT_V(n) asm volatile("s_waitcnt vmcnt(" #n ")" ::: "memory")
#define PG8_WAIT_L(n) asm volatile("s_waitcnt lgkmcnt(" #n ")" ::: "memory")
#define PG8_BAR __builtin_amdgcn_s_barrier()
#define PG8_SCHED __builtin_amdgcn_sched_barrier(0)
    Unit cur, nxt; int ui = 0;
    if (!S.next(0, cur)) return;
    f32x4 acc[2][2][4][2];
#pragma unroll
    for (int a = 0; a < 2; ++a)
#pragma unroll
        for (int b = 0; b < 2; ++b)
#pragma unroll
            for (int m = 0; m < 4; ++m)
#pragma unroll
                for (int n = 0; n < 2; ++n) acc[a][b][m][n] = (f32x4){0.f, 0.f, 0.f, 0.f};
    bf16x8 At[4][2], B0[2][2], B1[2][2];
    const char* cA = cur.A; const char* cB = cur.B;
    PG8_STAGE(PG8_SB(0, 0), cB, voffB); PG8_STAGE(PG8_SB(0, 1), cB + hstep, voffB); PG8_STAGE(PG8_SA(0, 0), cA, voffA); PG8_STAGE(PG8_SA(0, 1), cA + hstep, voffA);
    if (wr == 1) PG8_BAR;
    PG8_WAIT_V(2); PG8_BAR;
    PG8_STAGE(PG8_SB(1, 0), cB + kstep, voffB); PG8_STAGE(PG8_SA(1, 0), cA + kstep, voffA); PG8_STAGE(PG8_SB(1, 1), cB + hstep + kstep, voffB);
    PG8_WAIT_V(6); PG8_BAR;
    for (;;) {
        const bool has_next = S.next(ui + 1, nxt);
        const char* nA = has_next ? nxt.A : cA; const char* nB = has_next ? nxt.B : cB;
        const int nt = cur.nt;
        for (int t = 0; t < nt; t += 2) {
            const bool last = (t == nt - 2);
            const char* a1 = cA + (size_t)(t + 1) * kstep;
            const char* a2 = last ? nA : cA + (size_t)(t + 2) * kstep; const char* b2 = last ? nB : cB + (size_t)(t + 2) * kstep;
            const char* a3 = a2 + kstep; const char* b3 = b2 + kstep;
            PG8_LDB(B0, 0, 0); PG8_LDB(B1, 0, 1); PG8_SCHED; PG8_LDA(At, 0, 0); PG8_STAGE(PG8_SA(1, 1), a1 + hstep, voffA);
            PG8_WAIT_V(8); PG8_WAIT_L(0); PG8_BAR; PG8_MMA(0, 0, At, B0); PG8_MMA(0, 1, At, B1); PG8_BAR; PG8_SCHED;
            PG8_LDA(At, 0, 1); PG8_STAGE(PG8_SB(0, 0), b2, voffB); PG8_STAGE(PG8_SB(0, 1), b2 + hstep, voffB); PG8_STAGE(PG8_SA(0, 0), a2, voffA);
            PG8_WAIT_V(8); PG8_WAIT_L(0); PG8_BAR; PG8_MMA(1, 0, At, B0); PG8_MMA(1, 1, At, B1); PG8_BAR; PG8_SCHED;
            PG8_LDB(B0, 1, 0); PG8_LDB(B1, 1, 1); PG8_SCHED; PG8_LDA(At, 1, 0); PG8_STAGE(PG8_SA(0, 1), a2 + hstep, voffA);
            PG8_WAIT_V(8); PG8_WAIT_L(0); PG8_BAR; PG8_MMA(0, 0, At, B0); PG8_MMA(0, 1, At, B1); PG8_BAR; PG8_SCHED;
            PG8_LDA(At, 1, 1); PG8_STAGE(PG8_SB(1, 0), b3, voffB); PG8_STAGE(PG8_SB(1, 1), b3 + hstep, voffB); PG8_STAGE(PG8_SA(1, 0), a3, voffA);
            PG8_WAIT_V(8); PG8_WAIT_L(0); PG8_BAR; PG8_MMA(1, 0, At, B0); PG8_MMA(1, 1, At, B1); PG8_BAR; PG8_SCHED;
        }
        if (wr == 0) PG8_BAR;
        E(acc, cur, wr, wc, fr, fq);
        if (!has_next) break;
#pragma unroll
        for (int a = 0; a < 2; ++a)
#pragma unroll
            for (int b = 0; b < 2; ++b)
#pragma unroll
                for (int m = 0; m < 4; ++m)
#pragma unroll
                    for (int n = 0; n < 2; ++n) acc[a][b][m][n] = (f32x4){0.f, 0.f, 0.f, 0.f};
        cur = nxt; cA = nA; cB = nB; ++ui;
        if (wr == 1) PG8_BAR;
    }
    PG8_WAIT_V(0);
    PG8_BAR;
    E.after(acc, cur, lds, wr, wc, fr, fq);
#undef PG8_SA
#undef PG8_SB
#undef PG8_STAGE
#undef PG8_LDA
#undef PG8_LDB
#undef PG8_MMA
#undef PG8_WAIT_V
#undef PG8_WAIT_L
#undef PG8_BAR
#undef PG8_SCHED
}

struct EpiG1 {
    bf16_t *B0, *B1, *B2, *B3, *B4; float* vss; const float *gq, *gk; const LAS float* R;
    __device__ __forceinline__ void after(f32x4 (&)[2][2][4][2], const Unit&, LAS unsigned char*, int, int, int, int) const {}
    __device__ __forceinline__ void operator()(f32x4 (&acc)[2][2][4][2], const Unit& u, int wr, int wc, int fr, int fq) const {
        const int j = u.pn; const size_t rowb = (size_t)u.pm * BM + wr * 64 + fr; const int cl = 32 * wc + 8 * fq;
#pragma unroll
        for (int ai = 0; ai < 2; ++ai)
#pragma unroll
            for (int m = 0; m < 4; ++m) { const float rs = R[ai * HALF + wr * 64 + m * 16 + fr];
#pragma unroll
                for (int bj = 0; bj < 2; ++bj) { acc[ai][bj][m][0] *= rs; acc[ai][bj][m][1] *= rs; } }
        if (j < 4) {
#pragma unroll
            for (int ai = 0; ai < 2; ++ai)
#pragma unroll
                for (int m = 0; m < 4; ++m) { f32x4 o0, o1;
#pragma unroll
                    for (int e = 0; e < 4; ++e) { o0[e] = acc[ai][0][m][0][e] * fsigm(acc[ai][1][m][0][e]); o1[e] = acc[ai][0][m][1][e] * fsigm(acc[ai][1][m][1][e]); }
                    *(u32x4*)(B3 + (rowb + ai * HALF + m * 16) * 1024 + 128 * j + cl) = pack8(o0, o1); }
        } else if (j < 12 || j >= 16) {
            bf16_t* dst; int pitch, coff; bool act;
            if (j < 6) { dst = B0; pitch = 1024; coff = 256 * (j - 4); act = true; }
            else if (j < 8) { dst = B0; pitch = 1024; coff = 512 + 256 * (j - 6); act = false; }
            else if (j < 10) { dst = B3; pitch = 1024; coff = 512 + 256 * (j - 8); act = false; }
            else if (j < 12) { dst = B4; pitch = 512; coff = 256 * (j - 10); act = true; }
            else if (j < 18) { dst = B2; pitch = 1024; coff = 256 * (j - 16); act = false; }
            else { dst = B2; pitch = 1024; coff = 512 + 256 * (j - 18); act = true; }
            const bool stat = (j == 8 || j == 9);
#pragma unroll
            for (int ai = 0; ai < 2; ++ai)
#pragma unroll
                for (int m = 0; m < 4; ++m) { const size_t row = rowb + ai * HALF + m * 16; float s = 0.f;
#pragma unroll
                    for (int bj = 0; bj < 2; ++bj) { f32x4 v0 = acc[ai][bj][m][0], v1 = acc[ai][bj][m][1];
                        if (act) {
#pragma unroll
                            for (int e = 0; e < 4; ++e) { v0[e] = v0[e] * fsigm(v0[e]); v1[e] = v1[e] * fsigm(v1[e]); } }
                        s += (v0[0] * v0[0] + v0[1] * v0[1]) + (v0[2] * v0[2] + v0[3] * v0[3]) + (v1[0] * v1[0] + v1[1] * v1[1]) + (v1[2] * v1[2] + v1[3] * v1[3]);
                        *(u32x4*)(dst + row * pitch + coff + 128 * bj + cl) = pack8(v0, v1); }
                    if (stat) { s += __shfl_xor(s, 16); s += __shfl_xor(s, 32); if (fq == 0) vss[row * 8 + (j - 8) * 4 + wc] = s; } }
        } else {
            const bool isk = j >= 14; const int jj = (j - 12) & 1; const float* g = isk ? gk : gq; const float sc = isk ? 1.f : C2;
            f32x4 gv[2][2];
#pragma unroll
            for (int bj = 0; bj < 2; ++bj) { gv[bj][0] = *(const f32x4*)(g + 32 * bj + 8 * fq) * sc; gv[bj][1] = *(const f32x4*)(g + 32 * bj + 8 * fq + 4) * sc; }
            bf16_t* dst = B1 + (isk ? 512 : 0) + 64 * (4 * jj + wc) + 8 * fq;
#pragma unroll
            for (int ai = 0; ai < 2; ++ai)
#pragma unroll
                for (int m = 0; m < 4; ++m) { const size_t row = rowb + ai * HALF + m * 16; float s = 0.f;
#pragma unroll
                    for (int bj = 0; bj < 2; ++bj) { const f32x4 v0 = acc[ai][bj][m][0], v1 = acc[ai][bj][m][1];
                        s += (v0[0] * v0[0] + v0[1] * v0[1]) + (v0[2] * v0[2] + v0[3] * v0[3]) + (v1[0] * v1[0] + v1[1] * v1[1]) + (v1[2] * v1[2] + v1[3] * v1[3]); }
                    s += __shfl_xor(s, 16); s += __shfl_xor(s, 32);
                    const float r = __builtin_amdgcn_rsqf(s * (1.f / 64.f) + EPS);
#pragma unroll
                    for (int bj = 0; bj < 2; ++bj) *(u32x4*)(dst + row * 1024 + 32 * bj) = pack8(acc[ai][bj][m][0] * r * gv[bj][0], acc[ai][bj][m][1] * r * gv[bj][1]); }
        }
    }
};
struct EpiMerge {
    unsigned char* gt; bf16_t* MG; const float* bgate; const LAS float* R;
    __device__ __forceinline__ void after(f32x4 (&)[2][2][4][2], const Unit&, LAS unsigned char*, int, int, int, int) const {}
    __device__ __forceinline__ void operator()(f32x4 (&acc)[2][2][4][2], const Unit& u, int wr, int wc, int fr, int fq) const {
        const int tag = u.tag, br = tag >> 1; const size_t rowb = (size_t)u.pm * BM + wr * 64 + fr; const int col0 = u.pn * BM + 32 * wc + 8 * fq;
        u32x4* slots_ = (u32x4*)gt + ((wr * 4 + wc) * 64 + fq * 16 + fr); asm volatile("" : "+v"(slots_)); __attribute__((address_space(1))) u32x4* slots = (__attribute__((address_space(1))) u32x4*)slots_;
        if ((tag & 1) == 0) {
            f32x4 bv[2][2];
#pragma unroll
            for (int bj = 0; bj < 2; ++bj) { bv[bj][0] = *(const f32x4*)(bgate + br * 1024 + col0 + 128 * bj); bv[bj][1] = *(const f32x4*)(bgate + br * 1024 + col0 + 128 * bj + 4); }
#pragma unroll
            for (int ai = 0; ai < 2; ++ai)
#pragma unroll
                for (int m = 0; m < 4; ++m)
#pragma unroll
                    for (int bj = 0; bj < 2; ++bj) { const float rs = R[ai * HALF + wr * 64 + m * 16 + fr]; f32x4 v0 = acc[ai][bj][m][0] * rs + bv[bj][0], v1 = acc[ai][bj][m][1] * rs + bv[bj][1];
#pragma unroll
                        for (int e = 0; e < 4; ++e) { v0[e] = fsigm(v0[e]); v1[e] = fsigm(v1[e]); }
                        slots[(size_t)(((ai * 4 + m) * 2 + bj) * 512)] = pack8(v0, v1); }
        } else {
#pragma unroll
            for (int ai = 0; ai < 2; ++ai)
#pragma unroll
                for (int m = 0; m < 4; ++m) {
#pragma unroll
                    for (int bj = 0; bj < 2; ++bj) { const u32x4 gw = slots[(size_t)(((ai * 4 + m) * 2 + bj) * 512)]; f32x4 g0, g1; unpack8(gw, g0, g1);
                        f32x4 v0 = g0 * acc[ai][bj][m][0], v1 = g1 * acc[ai][bj][m][1];
                        u32x4* p = (u32x4*)(MG + (rowb + ai * HALF + m * 16) * 1024 + col0 + 128 * bj);
                        if (br > 0) { const u32x4 ow = *p; f32x4 p0, p1; unpack8(ow, p0, p1); v0 += p0; v1 += p1; }
                        *p = pack8(v0, v1); }
                    if (m & 1) asm volatile("" ::: "memory"); }
        }
    }
};
struct EpiOut {
    const float* base; float* out;
    __device__ __forceinline__ void after(f32x4 (&)[2][2][4][2], const Unit&, LAS unsigned char*, int, int, int, int) const {}
    __device__ __forceinline__ void operator()(f32x4 (&acc)[2][2][4][2], const Unit& u, int wr, int wc, int fr, int fq) const {
        const size_t rowb = (size_t)u.pm * BM + wr * 64 + fr; const int col0 = u.pn * BM + 32 * wc + 8 * fq;
#pragma unroll
        for (int ai = 0; ai < 2; ++ai)
#pragma unroll
            for (int m = 0; m < 4; ++m) {
#pragma unroll
                for (int bj = 0; bj < 2; ++bj) { const size_t o = (rowb + ai * HALF + m * 16) * D + col0 + 128 * bj;
                    const f32x4 b0 = *(const f32x4*)(base + o), b1 = *(const f32x4*)(base + o + 4);
                    *(f32x4*)(out + o) = b0 + acc[ai][bj][m][0]; *(f32x4*)(out + o + 4) = b1 + acc[ai][bj][m][1]; }
                if (m & 1) asm volatile("" ::: "memory"); }
    }
};
struct EpiOutLN {
    const float* base; float* out; bf16_t* XG; const float* gnext; const float* wfnext; float* SSP; float* FP;
    __device__ __forceinline__ void operator()(f32x4 (&)[2][2][4][2], const Unit&, int, int, int, int) const {}
    __device__ __forceinline__ void after(f32x4 (&acc)[2][2][4][2], const Unit& u, LAS unsigned char* lds, int wr, int wc, int fr, int fq) const {
        const int tid = ((wr * 4 + wc) * 64) + fq * 16 + fr;
        const size_t rowb = (size_t)u.pm * BM + wr * 64 + fr; const int cl = 32 * wc + 8 * fq, col0 = u.pn * BM + cl;
        LAS float* FL = (LAS float*)lds;
        LAS float* WL = (LAS float*)(lds + 512 * 72 * 4);
        for (int i = tid; i < 256 * 8; i += 512) { const int c = i >> 3, e = i & 7; WL[i] = gnext[u.pn * BM + c] * wfnext[(size_t)(u.pn * BM + c) * NIN + e]; }
        f32x4 gv[2][2];
#pragma unroll
        for (int bj = 0; bj < 2; ++bj) { gv[bj][0] = *(const f32x4*)(gnext + col0 + 128 * bj); gv[bj][1] = *(const f32x4*)(gnext + col0 + 128 * bj + 4); }
#pragma unroll
        for (int ai = 0; ai < 2; ++ai)
#pragma unroll
            for (int m = 0; m < 4; ++m) { float ss = 0.f;
#pragma unroll
                for (int bj = 0; bj < 2; ++bj) { const size_t o = (rowb + ai * HALF + m * 16) * D + col0 + 128 * bj;
                    const f32x4 x0 = *(const f32x4*)(base + o) + acc[ai][bj][m][0], x1 = *(const f32x4*)(base + o + 4) + acc[ai][bj][m][1];
                    *(f32x4*)(out + o) = x0; *(f32x4*)(out + o + 4) = x1;
                    ss += (x0[0] * x0[0] + x0[1] * x0[1]) + (x0[2] * x0[2] + x0[3] * x0[3]) + (x1[0] * x1[0] + x1[1] * x1[1]) + (x1[2] * x1[2] + x1[3] * x1[3]);
                    const f32x4 h0 = x0 * gv[bj][0], h1 = x1 * gv[bj][1];
                    *(u32x4*)(XG + o) = pack8(h0, h1);
                    acc[ai][bj][m][0] = x0; acc[ai][bj][m][1] = x1; }
                FL[tid * 72 + 64 + ai * 4 + m] = ss;
                if (m & 1) asm volatile("" ::: "memory"); }
        asm volatile("s_waitcnt lgkmcnt(0)" ::: "memory"); __builtin_amdgcn_s_barrier(); asm volatile("" ::: "memory");
#pragma unroll
        for (int hh = 0; hh < 2; ++hh) {
            f32x4 f[8];
#pragma unroll
            for (int rg = 0; rg < 8; ++rg) f[rg] = (f32x4){0.f, 0.f, 0.f, 0.f};
#pragma unroll
            for (int bj = 0; bj < 2; ++bj)
#pragma unroll
                for (int n = 0; n < 2; ++n)
#pragma unroll
                    for (int i = 0; i < 4; ++i) { const f32x4 wv = *(const LAS f32x4*)(WL + (128 * bj + cl + 4 * n + i) * 8 + 4 * hh);
#pragma unroll
                        for (int ai = 0; ai < 2; ++ai)
#pragma unroll
                            for (int m = 0; m < 4; ++m) f[ai * 4 + m] += acc[ai][bj][m][n][i] * wv; }
#pragma unroll
            for (int rg = 0; rg < 8; ++rg) *(LAS f32x4*)(FL + tid * 72 + rg * 8 + 4 * hh) = f[rg];
            asm volatile("" ::: "memory");
        }
        asm volatile("s_waitcnt lgkmcnt(0)" ::: "memory"); __builtin_amdgcn_s_barrier(); asm volatile("" ::: "memory");
        { const int row = tid & 255, hb = (tid >> 8) * 4, ai_ = row >> 7, wr_ = (row >> 6) & 1, m_ = (row >> 4) & 3, fr_ = row & 15, rg = ai_ * 4 + m_;
          f32x4 sum = (f32x4){0.f, 0.f, 0.f, 0.f}; float ssum = 0.f;
#pragma unroll
          for (int wc_ = 0; wc_ < 4; ++wc_)
#pragma unroll
              for (int fq_ = 0; fq_ < 4; ++fq_) { const LAS float* src = FL + (((wr_ * 4 + wc_) * 64) + fq_ * 16 + fr_) * 72; sum += *(const LAS f32x4*)(src + rg * 8 + hb); ssum += src[64 + rg]; }
          const size_t grow = (size_t)u.pm * BM + row;
          *(f32x4*)(FP + (grow * 4 + u.pn) * 8 + hb) = sum;
          if (hb == 0) SSP[grow * 4 + u.pn] = ssum; }
    }
};
struct SchedG1 { TileOrder T; const char* A; const char* B;
    __device__ __forceinline__ bool next(int i, Unit& u) const { int pm, pn; if (!T.tile(i, pm, pn)) return false; u.pm = pm; u.pn = pn; u.tag = 0; u.nt = 16; u.A = A + (size_t)pm * (BM * PITCH * 2); u.B = B + (size_t)pn * (BM * PITCH * 2); return true; } };
struct SchedMerge { int pm, pn; bool ok; const char *ws, *wl;
    __device__ __forceinline__ bool next(int i, Unit& u) const { if (!ok || i >= 6) return false; const int br = i >> 1; u.pm = pm; u.pn = pn; u.tag = i;
        const size_t ro = (size_t)pm * (BM * PITCH * 2), co = (size_t)pn * (BM * PITCH * 2);
        if ((i & 1) == 0) { u.nt = 16; u.A = ws + WS_H + ro; u.B = wl + WO_WG + (size_t)br * (1024 * PITCH * 2) + co; }
        else { u.nt = 8; const size_t ao = br == 0 ? WS_B0 : (br == 1 ? WS_B0 + 1024 : WS_B1), bo = br == 0 ? WO_WAB : (br == 1 ? WO_WAB + 1024 : WO_WC); u.A = ws + ao + ro; u.B = wl + bo + co; }
        return true; } };
}

#define XB_TMO      128
#define XB_XCNT(j)  (256  + 64 * (j))
#define XB_XSUB(j)  (1280 + 64 * (j))
#define XB_XGEN(j)  (2304 + 64 * (j))
#define XB_TOP      3328
#define XB_TOPGEN   3392
#define XCD_BAR_WORDS 3456
#define XB_SPIN_CAP (1u << 18)
__device__ __forceinline__ unsigned xb_ld(unsigned* p)              { return __hip_atomic_load(p, __ATOMIC_RELAXED, __HIP_MEMORY_SCOPE_AGENT); }
__device__ __forceinline__ unsigned xb_add(unsigned* p, unsigned v) { return __hip_atomic_fetch_add(p, v, __ATOMIC_RELAXED, __HIP_MEMORY_SCOPE_AGENT); }
__device__ __forceinline__ unsigned xb_xcc_id() { return (unsigned)__builtin_amdgcn_s_getreg((3 << 11) | 20) & 0xFu; }
#define XB_SPIN(cond, bar) do { unsigned _sp = 0; while (cond) { __builtin_amdgcn_s_sleep(1); \
    if ((++_sp & 255u) == 0u) { if (xb_ld(&(bar)[XB_TMO])) break; if (_sp > XB_SPIN_CAP) { atomicAdd(&(bar)[XB_TMO], 1u); break; } } } } while (0)
struct XcdBarrier { unsigned* bar; unsigned x; volatile LAS unsigned* st; };
__device__ __forceinline__ XcdBarrier xcd_barrier_post(unsigned* bar, volatile LAS unsigned* st) {
    XcdBarrier b; b.bar = bar; b.x = xb_xcc_id(); b.st = st;
    if (threadIdx.x == 0) (void)xb_add(&bar[XB_XCNT(b.x)], 1u);
    return b;
}
__device__ __forceinline__ void xcd_barrier_complete(unsigned* bar, unsigned x, unsigned& nloc, unsigned& nx) {
    const unsigned G = gridDim.x * gridDim.y * gridDim.z;
    unsigned sum, cnt, mine, sp = 0u;
    for (;;) {
        sum = 0u; cnt = 0u; mine = 0u;
#pragma unroll
        for (unsigned j = 0; j < 16; ++j) { const unsigned c = xb_ld(&bar[XB_XCNT(j)]); sum += c; cnt += (c > 0u) ? 1u : 0u; mine = (j == x) ? c : mine; }
        if (sum == G) break;
        __builtin_amdgcn_s_sleep(1);
        if ((++sp & 255u) == 0u) { if (xb_ld(&bar[XB_TMO])) break; if (sp > XB_SPIN_CAP) { atomicAdd(&bar[XB_TMO], 1u); break; } }
    }
    nloc = mine > 0u ? mine : 1u; nx = cnt > 0u ? cnt : 1u;
}
__device__ __forceinline__ void xcd_barrier(const XcdBarrier& b) {
    asm volatile("s_waitcnt vmcnt(0)" ::: "memory");
    __syncthreads();
    if (threadIdx.x == 0) {
        unsigned* bar = b.bar;
        __builtin_amdgcn_s_waitcnt(0);
        unsigned nloc = b.st[0], nx = b.st[1];
        if (nloc == 0u) { xcd_barrier_complete(bar, b.x, nloc, nx); b.st[0] = nloc; b.st[1] = nx; }
        const unsigned old = xb_add(&bar[XB_XSUB(b.x)], 1u);
        const unsigned gen = old / nloc;
        if (old + 1u == (gen + 1u) * nloc) {
            __builtin_amdgcn_fence(__ATOMIC_RELEASE, "agent");
            asm volatile("s_waitcnt vmcnt(0)" ::: "memory");
            const unsigned og = xb_add(&bar[XB_TOP], 1u);
            const unsigned tg = og / nx;
            if (og + 1u == (tg + 1u) * nx) xb_add(&bar[XB_TOPGEN], 1u);
            else XB_SPIN(xb_ld(&bar[XB_TOPGEN]) == tg, bar);
            __builtin_amdgcn_fence(__ATOMIC_ACQUIRE, "agent");
            xb_add(&bar[XB_XGEN(b.x)], 1u);
            asm volatile("s_waitcnt vmcnt(0)" ::: "memory");
        } else {
            XB_SPIN(xb_ld(&bar[XB_XGEN(b.x)]) == gen, bar);
            __builtin_amdgcn_fence(__ATOMIC_ACQUIRE, "agent");
            asm volatile("s_waitcnt vmcnt(0)" ::: "memory");
        }
    }
    __syncthreads();
}

struct Args { const float* in[18]; float* out; unsigned char* ws; int ph_lo, ph_hi, li, pad; };
struct Frame { LAS unsigned char* lds; int tid, lane, wave, vcu, G; Ptrs P; };

__device__ __forceinline__ unsigned pk2(float lo, float hi) { return (unsigned)f2bf(lo) | ((unsigned)f2bf(hi) << 16); }
__device__ __forceinline__ void p0_transpose_item(const float* W, int ldw, int src_col, int k0, bf16_t* WT, size_t dst_row, int dst_col, LAS float* scr, int lane) {
#pragma unroll 8
    for (int i = 0; i < 32; ++i) { const int kk = 2 * i + (lane >> 5); scr[kk * 33 + (lane & 31)] = W[(size_t)(k0 + kk) * ldw + src_col + (lane & 31)]; }
    LDS_WAIT(); asm volatile("" ::: "memory");
    const int c = lane & 7;
#pragma unroll
    for (int j = 0; j < 4; ++j) { const int n = (lane >> 3) + 8 * j; const LAS float* s = scr + (8 * c) * 33 + n;
        u32x4 o; o.x = pk2(s[0 * 33], s[1 * 33]); o.y = pk2(s[2 * 33], s[3 * 33]); o.z = pk2(s[4 * 33], s[5 * 33]); o.w = pk2(s[6 * 33], s[7 * 33]);
        *(GAS u32x4*)(WT + (dst_row + n) * 1024 + dst_col + k0 + 8 * c) = o; }
    LDS_WAIT(); asm volatile("" ::: "memory");
}
__device__ __forceinline__ void p0_weights(Frame& F) {
    LAS float* scr = (LAS float*)(F.lds + RING_OFF + F.wave * 16384);
    const int gw = F.vcu * NWAVES + F.wave, NGW = F.G * NWAVES;
    constexpr int I_W1 = 16 * (N1 / 32), I_WG = 16 * 96, I_Y = 8 * 32, I_WO = 16 * 32, I_L = I_W1 + I_WG + 3 * I_Y + I_WO;
    for (int it = gw; it < NL * I_L; it += NGW) {
        const int l = it / I_L; int r = it % I_L;
        unsigned char* wl = F.P.ws + WS_W + (size_t)l * W_LAYER; const float* win = F.P.w_in + (size_t)l * D * NIN;
        if (r < I_W1) { const int kb = r / (N1 / 32), nb = r % (N1 / 32); p0_transpose_item(win, NIN, g1_col(32 * nb), 64 * kb, (bf16_t*)(wl + WO_W1), 32 * nb, 0, scr, F.lane); continue; } r -= I_W1;
        if (r < I_WG) { const int kb = r / 96, nb = r % 96; p0_transpose_item(win, NIN, 32 * nb, 64 * kb, (bf16_t*)(wl + WO_WG), 32 * nb, 0, scr, F.lane); continue; } r -= I_WG;
        if (r < I_Y) { const int kb = r / 32, nb = r % 32; p0_transpose_item(F.P.w_a + (size_t)l * DA * D, D, 32 * nb, 64 * kb, (bf16_t*)(wl + WO_WAB), 32 * nb, 0, scr, F.lane); continue; } r -= I_Y;
        if (r < I_Y) { const int kb = r / 32, nb = r % 32; p0_transpose_item(F.P.w_b + (size_t)l * DB * D, D, 32 * nb, 64 * kb, (bf16_t*)(wl + WO_WAB), 32 * nb, 512, scr, F.lane); continue; } r -= I_Y;
        if (r < I_Y) { const int kb = r / 32, nb = r % 32; p0_transpose_item(F.P.w_c + (size_t)l * DC * D, D, 32 * nb, 64 * kb, (bf16_t*)(wl + WO_WC), 32 * nb, 0, scr, F.lane); continue; } r -= I_Y;
        { const int kb = r / 32, nb = r % 32; p0_transpose_item(F.P.w_out + (size_t)l * D * D, D, 32 * nb, 64 * kb, (bf16_t*)(wl + WO_WO), 32 * nb, 0, scr, F.lane); }
    }
    bf16_t* WSB = (bf16_t*)(F.P.ws + WS_WSB);
    for (int i = (int)blockIdx.x * 512 + F.tid; i < NL * NG * CHK * CHK; i += F.G * 512) { const int s = i & 127, t = (i >> 7) & 127; WSB[i] = s <= t ? f2bf(F.P.w_s[i]) : (bf16_t)0; }
}
__device__ __forceinline__ void p0_ln(Frame& F, int l, const float* xin) {
    LAS float* wf = (LAS float*)(F.lds + RING_OFF);
    const float* g = F.P.norm_g + (size_t)l * D; const float* win = F.P.w_in + (size_t)l * D * NIN;
    __syncthreads();
    for (int i = F.tid; i < D * 8; i += 512) { const int k = i >> 3, e = i & 7; wf[i] = g[k] * win[(size_t)k * NIN + OC_F + e]; }
    __syncthreads();
    const int gw = F.vcu * NWAVES + F.wave, NGW = F.G * NWAVES;
    bf16_t* H = (bf16_t*)(F.P.ws + WS_H); float* LOGF = (float*)(F.P.ws + WS_LOGF);
    f32x4 gv[4];
#pragma unroll
    for (int j = 0; j < 4; ++j) gv[j] = ((const f32x4*)g)[64 * j + F.lane];
    static_assert(M == 8 * 256 * NWAVES, "p0_ln: 8 rows per wave on a 256-workgroup grid");
    float zrow[8];
#pragma unroll
    for (int k = 0; k < 8; ++k) zrow[k] = 0.f;
    f32x4 v[8][4];
#pragma unroll
    for (int bt = 0; bt < 4; ++bt) {
        asm volatile("" ::: "memory");
        if ((bt & 1) == 0) {
#pragma unroll
            for (int k = 2 * bt; k < 2 * bt + 4; ++k) { const GAS f32x4* xr = (const GAS f32x4*)(xin + (size_t)(gw + k * NGW) * D) + F.lane;
#pragma unroll
                for (int j = 0; j < 4; ++j) v[k][j] = xr[64 * j]; }
            asm volatile("" ::: "memory"); }
        float r[2]; float f[2][8];
#pragma unroll
        for (int q = 0; q < 2; ++q) { float ss = 0.f;
#pragma unroll
            for (int j = 0; j < 4; ++j) { const f32x4 x = v[2 * bt + q][j]; ss += (x.x * x.x + x.y * x.y) + (x.z * x.z + x.w * x.w); }
            r[q] = rsqrtf(wsum(ss) * (1.f / D) + EPS);
#pragma unroll
            for (int e = 0; e < 8; ++e) f[q][e] = 0.f; }
#pragma unroll
        for (int j = 0; j < 4; ++j) {
#pragma unroll
            for (int q = 0; q < 2; ++q) { const f32x4 hv = v[2 * bt + q][j] * r[q] * gv[j];
                GAS unsigned long long* o8 = (GAS unsigned long long*)(H + (size_t)(gw + (2 * bt + q) * NGW) * D) + F.lane;
                o8[64 * j] = (unsigned long long)pk2(hv.x, hv.y) | ((unsigned long long)pk2(hv.z, hv.w) << 32); }
#pragma unroll
            for (int i = 0; i < 4; ++i) { const LAS f32x4* w4 = (const LAS f32x4*)(wf + (256 * j + 4 * F.lane + i) * 8); const f32x4 wa = w4[0], wb = w4[1];
#pragma unroll
                for (int q = 0; q < 2; ++q) { const float xv = v[2 * bt + q][j][i];
                    f[q][0] += xv * wa.x; f[q][1] += xv * wa.y; f[q][2] += xv * wa.z; f[q][3] += xv * wa.w; f[q][4] += xv * wb.x; f[q][5] += xv * wb.y; f[q][6] += xv * wb.z; f[q][7] += xv * wb.w; } }
        }
#pragma unroll
        for (int q = 0; q < 2; ++q) {
#pragma unroll
            for (int e = 0; e < 8; ++e) f[q][e] = wsum(f[q][e]);
            if (F.lane < 8) { float z = 0.f;
#pragma unroll
                for (int e = 0; e < 8; ++e) if (F.lane == e) z = f[q][e];
                zrow[2 * bt + q] = z * r[q]; } }
    }
    if (F.lane < 8) { const float bfv = F.P.b_f[l * NH + F.lane];
#pragma unroll
        for (int k = 0; k < 8; ++k) { const float z = zrow[k] + bfv; LOGF[(size_t)(gw + k * NGW) * 8 + F.lane] = fminf(z, 0.f) - log1pf(expf(-fabsf(z))); } }
    __syncthreads();
}
__device__ __forceinline__ void p1_scan(Frame& F, int bh, int l) {
    LAS float* sh = (LAS float*)(F.lds + RING_OFF);
    const int b = bh / NH, h = bh % NH, t0 = F.tid * 8;
    float c[8]; float run = 0.f;
    if (l == 0) { const float* lf = (const float*)(F.P.ws + WS_LOGF) + ((size_t)b * SEQ + t0) * 8 + h;
#pragma unroll
        for (int i = 0; i < 8; ++i) { run += lf[i * 8]; c[i] = run; }
    } else {
        const float* fp = (const float*)(F.P.ws + WS_FP) + ((size_t)b * SEQ + t0) * 32 + h; const float* sp = (const float*)(F.P.ws + WS_SSP) + ((size_t)b * SEQ + t0) * 4; const float bfv = F.P.b_f[l * NH + h];
        float z[8];
#pragma unroll
        for (int i = 0; i < 8; ++i) { const f32x4 q = *(const f32x4*)(sp + i * 4); const float r = rsqrtf(((q.x + q.y) + (q.z + q.w)) * (1.f / D) + EPS);
            z[i] = r * ((fp[i * 32] + fp[i * 32 + 8]) + (fp[i * 32 + 16] + fp[i * 32 + 24])) + bfv; }
#pragma unroll
        for (int i = 0; i < 8; ++i) { run += fminf(z[i], 0.f) - log1pf(expf(-fabsf(z[i]))); c[i] = run; }
    }
    float inc = run;
#pragma unroll
    for (int o = 1; o < 64; o <<= 1) { const float n = __shfl_up(inc, o); if (F.lane >= o) inc += n; }
    if (F.lane == 63) sh[F.wave] = inc;
    __syncthreads();
    float base = inc - run;
    for (int w = 0; w < F.wave; ++w) base += sh[w];
    float* cs = (float*)(F.P.ws + WS_CS) + (size_t)bh * SEQ + t0;
    *(f32x4*)cs = (f32x4){(base + c[0]) * LOG2E, (base + c[1]) * LOG2E, (base + c[2]) * LOG2E, (base + c[3]) * LOG2E};
    *(f32x4*)(cs + 4) = (f32x4){(base + c[4]) * LOG2E, (base + c[5]) * LOG2E, (base + c[6]) * LOG2E, (base + c[7]) * LOG2E};
    __syncthreads();
    LAS float* c2s = sh + 16;
#pragma unroll
    for (int i = 0; i < 8; ++i) c2s[t0 + i] = (base + c[i]) * LOG2E;
    __syncthreads();
    if (F.tid < SEQ / 256) { const int qb = F.tid, nt = 4 * qb + 4; const float cq = c2s[256 * qb]; int lo = 0, hi = nt - 4;
        while (lo < hi) { const int mid = (lo + hi) >> 1; if (cq - c2s[64 * mid + 63] >= -SKIP_L2) hi = mid; else lo = mid + 1; }
        ((int*)(F.P.ws + WS_TS))[bh * 16 + qb] = lo & ~1; }
    __syncthreads();
}


#include <hip/hip_bf16.h>
namespace attn_body {
using bf16=__hip_bfloat16;
using s16x4=__attribute__((ext_vector_type(4)))short;
using f32x16=__attribute__((ext_vector_type(16)))float;
constexpr int NHEAD=NH,D=64,DM=1024;
constexpr int NW=8,QBLK=32,QB=QBLK*NW,KVBLK=64,NQB=SEQ/QB;
__device__ __forceinline__ int crow(int r,int hi){return (r&3)+8*(r>>2)+4*hi;}
#define SBAR() __builtin_amdgcn_sched_barrier(0)
__device__ __forceinline__ void cmask(f32x16&p0,f32x16&p1,int jb,int qrel,int hi){
  const float NEG=-INFINITY; int kb=64*jb+4*hi;
  #pragma unroll
  for(int r=0;r<16;++r){int kv=kb+(r&3)+8*(r>>2); if(kv>qrel)p0[r]=NEG; if(kv+32>qrel)p1[r]=NEG;}
}
constexpr int NSLOT=3, SLOTB=8192;
constexpr int LDS_K=0, LDS_V=NSLOT*SLOTB, LDS_WS=2*NSLOT*SLOTB, LDS_OST=LDS_WS+NW*64*4, LDS_C2=LDS_OST+NW*4096, LDS_BYTES=LDS_C2+SEQ*4+512;
__device__ __forceinline__ void glds16(const void*gsrc,unsigned lds_dst){unsigned keep;
  asm volatile("s_mov_b32 %0, m0\n\ts_mov_b32 m0, %2\n\ts_nop 0\n\tglobal_load_lds_dwordx4 %1, off\n\ts_mov_b32 m0, %0":"=&s"(keep):"v"(gsrc),"s"(lds_dst):"memory");}
__device__ __forceinline__ float max3f(float a,float b,float c){float r;asm("v_max3_f32 %0, %1, %2, %3":"=v"(r):"v"(a),"v"(b),"v"(c));return r;}
__device__ __forceinline__ float max2f(float a,float b){float r;asm("v_max_f32_e32 %0, %1, %2":"=v"(r):"v"(a),"v"(b));return r;}
__device__ __forceinline__ float fadd_s(float a,float b){float r;asm("v_add_f32_e32 %0, %1, %2":"=v"(r):"v"(a),"v"(b));return r;}
__device__ __forceinline__ float fsub_s(float a,float b){float r;asm("v_sub_f32_e32 %0, %1, %2":"=v"(r):"v"(a),"v"(b));return r;}
typedef float f32x2_t __attribute__((ext_vector_type(2))); typedef __bf16 bf16x2_t __attribute__((ext_vector_type(2)));
__device__ __forceinline__ unsigned cvtpk_s(float lo,float hi){f32x2_t v={lo,hi};bf16x2_t b=__builtin_convertvector(v,bf16x2_t);return __builtin_bit_cast(unsigned,b);}
#define WAIT_BAR(N) asm volatile("s_waitcnt vmcnt(" #N ") lgkmcnt(0)\n\ts_barrier":::"memory")
__device__ __forceinline__ void split3(float x,unsigned&h,unsigned&m,unsigned&l){
  const unsigned u=__float_as_uint(x)&0xffff0000u; const float r1=x-__uint_as_float(u);
  const unsigned u1=__float_as_uint(r1)&0xffff0000u; const float r2=r1-__uint_as_float(u1);
  h=u>>16; m=u1>>16; l=__float_as_uint(r2)>>16; }
__device__ __forceinline__ bf16x8 make_qx(float base,int hi){ unsigned h,m,l; split3(base,h,m,l); u32x4 w; w.x=h|(m<<16); w.y=l|0x3f800000u; w.z=0x3f803f80u; w.w=0u; if(hi){w.x=0u;w.y=0u;w.z=0u;} return __builtin_bit_cast(bf16x8,w); }
__device__ __forceinline__ bf16x8 make_kx(float ck,int hi){ unsigned h,m,l; split3(-ck,h,m,l); u32x4 w; w.x=0x3f803f80u; w.y=0x3f80u|(h<<16); w.z=m|(l<<16); w.w=0u; if(hi){w.x=0u;w.y=0u;w.z=0u;} return __builtin_bit_cast(bf16x8,w); }

__device__ __forceinline__ void qkt(f32x16&p0,f32x16&p1,const char*Kslot,const bf16x8*qr,bf16x8 qx,bf16x8 kx0,bf16x8 kx1,int r32,int hi){
  const char*kb=Kslot+hi*1024+r32*16; const f32x16 z=f32x16{};
  p0=__builtin_amdgcn_mfma_f32_32x32x16_bf16(kx0,qx,z,0,0,0);p1=__builtin_amdgcn_mfma_f32_32x32x16_bf16(kx1,qx,z,0,0,0);
  #pragma unroll
  for(int d0=0;d0<4;++d0){
    const bf16x8 b0=*reinterpret_cast<const bf16x8*>(kb+d0*2048);
    const bf16x8 b1=*reinterpret_cast<const bf16x8*>(kb+d0*2048+512);
    p0=__builtin_amdgcn_mfma_f32_32x32x16_bf16(b0,qr[d0],p0,0,0,0);p1=__builtin_amdgcn_mfma_f32_32x32x16_bf16(b1,qr[d0],p1,0,0,0);}
}
typedef __attribute__((address_space(3))) const char* lds_cptr;
typedef short v4i16_t __attribute__((ext_vector_type(4)));
__device__ __forceinline__ void kload8(bf16x8*kf,lds_cptr kp){
  kf[0]=*(const __attribute__((address_space(3))) bf16x8*)(kp);      kf[1]=*(const __attribute__((address_space(3))) bf16x8*)(kp+512);
  kf[2]=*(const __attribute__((address_space(3))) bf16x8*)(kp+2048); kf[3]=*(const __attribute__((address_space(3))) bf16x8*)(kp+2560);
  kf[4]=*(const __attribute__((address_space(3))) bf16x8*)(kp+4096); kf[5]=*(const __attribute__((address_space(3))) bf16x8*)(kp+4608);
  kf[6]=*(const __attribute__((address_space(3))) bf16x8*)(kp+6144); kf[7]=*(const __attribute__((address_space(3))) bf16x8*)(kp+6656);
}
__device__ __forceinline__ void kload2(bf16x8*kf,lds_cptr kp,int j){ kf[2*j]=*(const __attribute__((address_space(3))) bf16x8*)(kp+j*2048); kf[2*j+1]=*(const __attribute__((address_space(3))) bf16x8*)(kp+j*2048+512); }
__device__ __forceinline__ s16x4 vtr(lds_cptr p){ return __builtin_bit_cast(s16x4,__builtin_amdgcn_ds_read_tr16_b64_v4i16((__attribute__((address_space(3))) v4i16_t*)p)); }
__device__ __forceinline__ float rowmax(const f32x16&p0,const f32x16&p1){
  float a=max3f(p0[0],p0[1],p1[0]),b=max3f(p0[2],p0[3],p1[1]);a=max3f(a,p1[2],p1[3]);
  #pragma unroll
  for(int r=4;r<16;r+=4){a=max3f(a,p0[r],p0[r+1]);b=max3f(b,p0[r+2],p0[r+3]);a=max3f(a,p1[r],p1[r+1]);b=max3f(b,p1[r+2],p1[r+3]);}
  const float m=max2f(a,b);
  auto rr=__builtin_amdgcn_permlane32_swap(__float_as_uint(m),__float_as_uint(m),false,false);
  return max2f(__uint_as_float(rr[0]),__uint_as_float(rr[1]));
}
__device__ __forceinline__ void pv(f32x16*o,int vb,bf16x8 pa0,bf16x8 pa1,bf16x8 pa2,bf16x8 pa3){
  #pragma unroll
  for(int d0=0;d0<2;++d0){s16x4 lo[4],hi[4];
    #pragma unroll
    for(int ks=0;ks<4;++ks){
      asm volatile("ds_read_b64_tr_b16 %0,%1 offset:%c2":"=&v"(lo[ks]):"v"(vb),"i"(d0*4096+ks*1024):"memory");
      asm volatile("ds_read_b64_tr_b16 %0,%1 offset:%c2":"=&v"(hi[ks]):"v"(vb),"i"(d0*4096+ks*1024+512):"memory");}
    asm volatile("s_waitcnt lgkmcnt(0)":::"memory");SBAR();
    #define PK(k) (bf16x8){lo[k][0],lo[k][1],lo[k][2],lo[k][3],hi[k][0],hi[k][1],hi[k][2],hi[k][3]}
    o[d0]=__builtin_amdgcn_mfma_f32_32x32x16_bf16(pa0,PK(0),o[d0],0,0,0);
    o[d0]=__builtin_amdgcn_mfma_f32_32x32x16_bf16(pa1,PK(1),o[d0],0,0,0);
    o[d0]=__builtin_amdgcn_mfma_f32_32x32x16_bf16(pa2,PK(2),o[d0],0,0,0);
    o[d0]=__builtin_amdgcn_mfma_f32_32x32x16_bf16(pa3,PK(3),o[d0],0,0,0);
    #undef PK
  }
}
#define ATTN_STORE16(p,v) (*(u32x4*)(p)=(v))
template<int THRL> __device__ __forceinline__ void attn_unit(int b,int h,int qb,const bf16*Q,const bf16*__restrict__ K,const bf16*__restrict__ V,const bf16*__restrict__ CZ,bf16*O,const float*__restrict__ c2g,int ts,float ub,char*shm){
  int tid=threadIdx.x; asm volatile("":"+v"(tid));
  const int lane=tid&63,r32=lane&31,hi=lane>>5; const int wid=__builtin_amdgcn_readfirstlane(tid>>6);
  const long rowbase=(long)b*SEQ; const int q0=qb*QB;
  const bf16*Qw=Q+(rowbase+q0+wid*QBLK)*DM+h*D;
  const bf16*Kh=K+(rowbase+(long)ts*KVBLK)*DM+h*D,*Vh=V+(rowbase+(long)ts*KVBLK)*DM+h*D;
  const unsigned lds0=(unsigned)(uintptr_t)shm;
  float*wsf=(float*)(shm+LDS_WS)+wid*64;
  float*c2l=(float*)(shm+LDS_C2);
  const bf16*ksrc=Kh+(long)lane*DM+wid*8;
  const bf16*vsrc=Vh+(long)(16*(wid&3)+(lane>>2))*DM+(wid>>2)*32+(lane&3)*8;
  const unsigned kdst=lds0+LDS_K+wid*1024, vdst=lds0+LDS_V+wid*1024;
  #define DMA_K(t,slot) glds16(ksrc+(long)(t)*KVBLK*DM,(unsigned)__builtin_amdgcn_readfirstlane(kdst+(slot)))
  #define DMA_V(t,slot) glds16(vsrc+(long)(t)*KVBLK*DM,(unsigned)__builtin_amdgcn_readfirstlane(vdst+(slot)))
  const int vb0=(int)(lds0+LDS_V)+((lane>>4)&1)*32+(lane&3)*8+(4*hi+((lane&15)>>2))*64;
  const char*Kbase=shm+LDS_K; bf16x8 kf[8];
  const lds_cptr shm3=(lds_cptr)shm; const lds_cptr kp0=shm3+LDS_K+hi*1024+r32*16; const lds_cptr vp0=shm3+LDS_V+((lane>>4)&1)*32+(lane&3)*8+(4*hi+((lane&15)>>2))*64;
  const int NT=(q0+QB)/KVBLK-ts;
  DMA_K(0,0);DMA_V(0,0);DMA_K(1,SLOTB);
  { const int kb0=ts*KVBLK; for(int i=tid*4;i<q0+QB-kb0;i+=NW*64*4)*(f32x4*)(c2l+i)=*(const f32x4*)(c2g+kb0+i); }
  bf16x8 qr[4];
  #pragma unroll
  for(int d0=0;d0<4;++d0)qr[d0]=*reinterpret_cast<const bf16x8*>(&Qw[(long)r32*DM+d0*16+hi*8]);
    float mhat=ub,l_reg=0.f;f32x16 o[2];o[0]=f32x16{};o[1]=f32x16{};
  const int qrel=wid*QBLK+r32;
  #define CMASK(P0,P1,t) do{int jb_=(t)-(NT-4); if(jb_>=0)cmask(P0,P1,jb_,qrel,hi);}while(0)
  bool resc=false;
  bf16x8 qx; float cq2;
  #define START(P0,P1) do{ resc=false; \
    _Pragma("unroll") for(int r=0;r<16;++r)P0[r]=__builtin_amdgcn_exp2f(P0[r]); }while(0)
  #define RESC() do{}while(0)
  f32x16 pA0,pA1,pB0,pB1;
  int sl_prev=0,sl_cur=0,sl_next=SLOTB;
  #define ROT() do{sl_prev=sl_cur;sl_cur=sl_next;sl_next=(sl_next==(NSLOT-1)*SLOTB)?0:sl_next+SLOTB;}while(0)
  DMA_K(2,2*SLOTB);
  WAIT_BAR(3);
  cq2=c2l[q0+qrel-ts*KVBLK]; qx=make_qx(cq2-mhat,hi);
  float ck0=c2l[r32],ck1=c2l[32+r32];
  { const bf16x8 kx0=make_kx(ck0,hi),kx1=make_kx(ck1,hi);
    qkt(pA0,pA1,Kbase,qr,qx,kx0,kx1,r32,hi); }
  asm volatile("s_nop 15\n\ts_nop 7":"+v"(pA0),"+v"(pA1));CMASK(pA0,pA1,0);
  ck0=c2l[64+r32];ck1=c2l[96+r32];
  START(pA0,pA1);
  _Pragma("unroll") for(int r=0;r<16;++r)pA1[r]=__builtin_amdgcn_exp2f(pA1[r]);
  WAIT_BAR(0);
  DMA_K(3,0);DMA_V(1,SLOTB);
  ROT();
  kload8(kf,kp0+sl_cur);
  WAIT_BAR(2);
  s16x4 vlo[8],vhi[8]; u32x4 pw0,pw1,pw2,pw3;
  #define PKW(P,B) cvtpk_s(P[B],P[B+1])
  #define PAF(k) __builtin_bit_cast(bf16x8,pw##k)
  #define VFR(i) (bf16x8){vlo[i][0],vlo[i][1],vlo[i][2],vlo[i][3],vhi[i][0],vhi[i][1],vhi[i][2],vhi[i][3]}
  #define PIN(x) asm volatile("":"+v"(x))
  #define MX3(a,b,c) __builtin_fmaxf(__builtin_fmaxf((a),(b)),(c))
  #define GAPA(MF,A0,A1,A2,A3,W0,W1,PW) do{ MF; sacc+=A0; sacc+=A1; sacc+=A2; sacc+=A3; PIN(sacc); W0; W1; PIN(PW); SBAR(); }while(0)
  #define EX(v) __builtin_amdgcn_exp2f(v)
  #define GAPB(MF,X,B) do{ MF; X[B]=EX(X[B]); X[B+1]=EX(X[B+1]); X[B+2]=EX(X[B+2]); X[B+3]=EX(X[B+3]); PIN(X); SBAR(); }while(0)
  #define VRD(i) do{ vlo[i]=vtr(vp_+(((i)>>2)*4096+((i)&3)*1024)); vhi[i]=vtr(vp_+(((i)>>2)*4096+((i)&3)*1024+512)); }while(0)
  #define KRD(G,j) do{ if(G){ kload2(kf,kp0+sl_next,j); SBAR(); } }while(0)
  #define STEP(C0,C1,P0,P1,t,GK,GV,GL) do{ SBAR(); \
    const lds_cptr vp_=vp0+sl_prev; \
    { const bf16x8 kx0_=make_kx(ck0,hi),kx1_=make_kx(ck1,hi); const f32x16 z_=f32x16{}; \
      C0=__builtin_amdgcn_mfma_f32_32x32x16_bf16(kx0_,qx,z_,0,0,0); C1=__builtin_amdgcn_mfma_f32_32x32x16_bf16(kx1_,qx,z_,0,0,0); } SBAR(); \
    VRD(0); SBAR(); float sacc=(P0[0]+P0[1]); \
    GAPA(C0=__builtin_amdgcn_mfma_f32_32x32x16_bf16(kf[0],qr[0],C0,0,0,0), P0[2],P0[3],P0[4],P0[5],     pw0[0]=PKW(P0,0), pw0[1]=PKW(P0,2), pw0); \
    VRD(4); SBAR(); GAPA(C1=__builtin_amdgcn_mfma_f32_32x32x16_bf16(kf[1],qr[0],C1,0,0,0), P0[6],P0[7],P0[8],P0[9],     pw0[2]=PKW(P0,4), pw0[3]=PKW(P0,6), pw0); \
    VRD(1); SBAR(); GAPA(C0=__builtin_amdgcn_mfma_f32_32x32x16_bf16(kf[2],qr[1],C0,0,0,0),   P0[10],P0[11],P0[12],P0[13], pw1[0]=PKW(P0,8), pw1[1]=PKW(P0,10), pw1); \
    VRD(5); SBAR(); GAPA(C1=__builtin_amdgcn_mfma_f32_32x32x16_bf16(kf[3],qr[1],C1,0,0,0),   P0[14],P0[15],P1[0],P1[1],   pw1[2]=PKW(P0,12),pw1[3]=PKW(P0,14), pw1); \
    VRD(2); SBAR(); GAPA(C0=__builtin_amdgcn_mfma_f32_32x32x16_bf16(kf[4],qr[2],C0,0,0,0),   P1[2],P1[3],P1[4],P1[5],     pw2[0]=PKW(P1,0), pw2[1]=PKW(P1,2), pw2); \
    VRD(6); SBAR(); GAPA(C1=__builtin_amdgcn_mfma_f32_32x32x16_bf16(kf[5],qr[2],C1,0,0,0),   P1[6],P1[7],P1[8],P1[9],     pw2[2]=PKW(P1,4), pw2[3]=PKW(P1,6), pw2); \
    VRD(3); SBAR(); GAPA(C0=__builtin_amdgcn_mfma_f32_32x32x16_bf16(kf[6],qr[3],C0,0,0,0),   P1[10],P1[11],P1[12],P1[13], pw3[0]=PKW(P1,8), pw3[1]=PKW(P1,10), pw3); \
    VRD(7); SBAR(); GAPA(C1=__builtin_amdgcn_mfma_f32_32x32x16_bf16(kf[7],qr[3],C1,0,0,0),   P1[14],P1[15],0.f,0.f,       pw3[2]=PKW(P1,12),pw3[3]=PKW(P1,14), pw3); \
    l_reg+=sacc; \
    if(GK){DMA_K((t)+3,sl_cur);} if(GV){DMA_V((t)+1,sl_next);} \
    if(GL){ ck0=c2l[64*((t)+1)+r32]; ck1=c2l[64*((t)+1)+32+r32]; } \
    CMASK(C0,C1,t); \
    SBAR(); \
    GAPB(o[0]=__builtin_amdgcn_mfma_f32_32x32x16_bf16(PAF(0),VFR(0),o[0],0,0,0), C0,0); \
    GAPB(o[1]=__builtin_amdgcn_mfma_f32_32x32x16_bf16(PAF(0),VFR(4),o[1],0,0,0), C0,4); \
    KRD(GL,0); GAPB(o[0]=__builtin_amdgcn_mfma_f32_32x32x16_bf16(PAF(1),VFR(1),o[0],0,0,0), C0,8); \
    KRD(GL,1); GAPB(o[1]=__builtin_amdgcn_mfma_f32_32x32x16_bf16(PAF(1),VFR(5),o[1],0,0,0), C0,12); \
    KRD(GL,2); GAPB(o[0]=__builtin_amdgcn_mfma_f32_32x32x16_bf16(PAF(2),VFR(2),o[0],0,0,0), C1,0); \
    KRD(GL,3); GAPB(o[1]=__builtin_amdgcn_mfma_f32_32x32x16_bf16(PAF(2),VFR(6),o[1],0,0,0), C1,4); \
    GAPB(o[0]=__builtin_amdgcn_mfma_f32_32x32x16_bf16(PAF(3),VFR(3),o[0],0,0,0), C1,8); \
    GAPB(o[1]=__builtin_amdgcn_mfma_f32_32x32x16_bf16(PAF(3),VFR(7),o[1],0,0,0), C1,12); \
    }while(0)
  int t=1;
  #undef CMASK
  #define CMASK(P0,P1,t) do{}while(0)
  for(;t+5<NT;t+=2){
    STEP(pB0,pB1,pA0,pA1,t,true,true,true);     WAIT_BAR(2); RESC(); ROT();
    STEP(pA0,pA1,pB0,pB1,t+1,true,true,true);   WAIT_BAR(2); RESC(); ROT();
  }
  #undef CMASK
  #define CMASK(P0,P1,t) do{int jb_=(t)-(NT-4); if(jb_>=0)cmask(P0,P1,jb_,qrel,hi);}while(0)
  #define ENDW(tt) do{ if((tt)+3<NT){WAIT_BAR(2);} else if((tt)+2<NT){WAIT_BAR(1);} else {WAIT_BAR(0);} }while(0)
  for(;t+1<NT;t+=2){
    STEP(pB0,pB1,pA0,pA1,t,(t+3<NT),(t+1<NT),(t+1<NT));       ENDW(t);   RESC(); ROT();
    STEP(pA0,pA1,pB0,pB1,t+1,(t+4<NT),(t+2<NT),(t+2<NT));     ENDW(t+1); RESC(); ROT();
  }
  STEP(pB0,pB1,pA0,pA1,NT-1,false,false,false); RESC();
  { float sacc=pB0[0]+pB0[1]; _Pragma("unroll") for(int r=2;r<16;++r)sacc+=pB0[r]; _Pragma("unroll") for(int r=0;r<16;++r)sacc+=pB1[r]; l_reg+=sacc;
    pw0=(u32x4){PKW(pB0,0),PKW(pB0,2),PKW(pB0,4),PKW(pB0,6)};pw1=(u32x4){PKW(pB0,8),PKW(pB0,10),PKW(pB0,12),PKW(pB0,14)};pw2=(u32x4){PKW(pB1,0),PKW(pB1,2),PKW(pB1,4),PKW(pB1,6)};pw3=(u32x4){PKW(pB1,8),PKW(pB1,10),PKW(pB1,12),PKW(pB1,14)};
    SBAR(); pv(o,vb0+sl_cur,PAF(0),PAF(1),PAF(2),PAF(3)); }
  #undef PKW
  #undef PAF
  #undef VFR
  #undef PIN
  #undef MX3
  #undef GAPA
  #undef GAPB
  #undef EX
  #undef VRD
  #undef KRD
  #undef STEP
  #undef ENDW
  {auto rr=__builtin_amdgcn_permlane32_swap(__float_as_uint(l_reg),__float_as_uint(l_reg),false,false);l_reg=__uint_as_float(rr[0])+__uint_as_float(rr[1]);}
  if(hi==0)wsf[32+r32]=l_reg;asm volatile("s_waitcnt lgkmcnt(0)":::"memory");
  bf16*Ow=O+(rowbase+q0+wid*QBLK)*DM+h*D;
  const unsigned short*Cw=(const unsigned short*)(CZ+(rowbase+q0+wid*QBLK)*DM+h*D);
  { bf16*stg=(bf16*)(shm+LDS_OST)+wid*2048;
    #pragma unroll
    for(int r=0;r<16;++r){const int orow=crow(r,hi); const float rl=__builtin_amdgcn_rcpf(wsf[32+orow]);
      #pragma unroll
      for(int d0=0;d0<2;++d0){ const float cz=__uint_as_float((unsigned)Cw[(long)orow*DM+d0*32+r32]<<16); stg[orow*64+d0*32+r32]=__float2bfloat16(o[d0][r]*rl*cz);} }
    asm volatile("s_waitcnt lgkmcnt(0)":::"memory");
    #pragma unroll
    for(int i=0;i<4;++i){const int row=i*8+(lane>>3),ch=lane&7; const u32x4 v=*(const u32x4*)(stg+row*64+ch*8); ATTN_STORE16(Ow+(long)row*DM+ch*8,v);} }
  asm volatile("s_waitcnt lgkmcnt(0)\n\ts_barrier":::"memory");
  #undef DMA_K
  #undef DMA_V
  #undef CMASK
  #undef START
  #undef RESC
  #undef ROT
}
#undef SBAR
#undef WAIT_BAR
}

typedef float f32x2 __attribute__((ext_vector_type(2)));
__device__ __forceinline__ void p2_conv(Frame& F, int l, int unit, bf16_t* outb, const bool pv_ = false) {
    const int tid = F.tid, lane = F.lane, w = F.wave;
    const size_t row0 = (size_t)unit * 64; const int tseq0 = (int)(row0 % SEQ);
    const bf16_t* AG = (const bf16_t*)(F.P.ws + WS_B3); const bf16_t* B0 = (const bf16_t*)(F.P.ws + WS_B0);
    LAS unsigned char* tile = F.lds + RING_OFF;
    for (int c = tid; c < 94 * 64; c += 512) { const int r = c >> 6, ch = c & 63, tr = r - (CW - 1); const bool valid = tseq0 + tr >= 0;
        u32x4 v = (u32x4){0u, 0u, 0u, 0u}; if (valid) v = *(const u32x4*)(AG + (size_t)((long)row0 + tr) * 1024 + ch * 8);
        *(LAS u32x4*)(tile + r * 1024 + ch * 16) = v; }
    LAS float* wl = (LAS float*)(tile + 94 * 1024);
    { const float* cwg = F.P.conv_w + (size_t)l * CW * DA; for (int c = tid; c < CW * DA / 4; c += 512) *(LAS f32x4*)(wl + 4 * c) = *(const f32x4*)(cwg + 4 * c); }
    __syncthreads();
    if (PROBE_CONV == 2 && pv_) { __syncthreads(); return; }
    f32x2 out[4][8]; float s1[8], s2[8];
#pragma unroll
    for (int o = 0; o < 8; ++o) { s1[o] = 0.f; s2[o] = 0.f; }
#pragma unroll
    for (int i = 0; i < 4; ++i) {
        __builtin_amdgcn_sched_barrier(0);
        int p = lane + 64 * i; asm volatile("" : "+v"(p));
        const LAS float* cw = wl + 2 * p;
        f32x2 wv[CW];
#pragma unroll
        for (int j = 0; j < CW; ++j) wv[j] = *(const LAS f32x2*)(cw + j * DA);
        const f32x2 cb = *(const f32x2*)(F.P.conv_b + l * DA + 2 * p);
        const LAS unsigned* tp = (const LAS unsigned*)(tile + (8 * w) * 1024 + 4 * p);
        f32x2 win[16];
#pragma unroll
        for (int k = 0; k < 16; ++k) { const unsigned u = tp[k * 256]; win[k] = (f32x2){__uint_as_float(u << 16), __uint_as_float(u & 0xffff0000u)}; }
#pragma unroll
        for (int o = 0; o < 8; ++o) out[i][o] = cb;
        __builtin_amdgcn_sched_barrier(0);
#pragma unroll
        for (int j = 0; j < CW; ++j) {
            if (!(PROBE_CONV == 1 && pv_))
#pragma unroll
            for (int o = 0; o < 8; ++o) out[i][o] += wv[j] * win[(j + o) & 15];
            asm volatile("" : "+v"(out[i][0]), "+v"(out[i][1]), "+v"(out[i][2]), "+v"(out[i][3]), "+v"(out[i][4]), "+v"(out[i][5]), "+v"(out[i][6]), "+v"(out[i][7]));
            if (j + 16 < 38) { const LAS unsigned* tq = tp; asm volatile("" : "+v"(tq)); const unsigned u = tq[(j + 16) * 256]; win[j & 15] = (f32x2){__uint_as_float(u << 16), __uint_as_float(u & 0xffff0000u)}; }
            __builtin_amdgcn_sched_barrier(0);
        }
#pragma unroll
        for (int o = 0; o < 8; ++o) { s1[o] += out[i][o].x + out[i][o].y; s2[o] += out[i][o].x * out[i][o].x + out[i][o].y * out[i][o].y; }
    }
    unsigned az[4][8];
#pragma unroll
    for (int i = 0; i < 4; ++i)
#pragma unroll
        for (int o = 0; o < 8; ++o) az[i][o] = *(const unsigned*)(B0 + (row0 + 8 * w + o) * 1024 + 2 * (lane + 64 * i));
#pragma unroll
    for (int o = 0; o < 8; ++o) { s1[o] = wsum(s1[o]); s2[o] = wsum(s2[o]); }
#pragma unroll
    for (int i = 0; i < 4; ++i) {
        const int p = lane + 64 * i;
        const f32x2 gg = *(const f32x2*)(F.P.cn_g + l * DA + 2 * p), be = *(const f32x2*)(F.P.cn_b + l * DA + 2 * p);
#pragma unroll
        for (int o = 0; o < 8; ++o) { const float mu = s1[o] * (1.f / DA), ex2 = s2[o] * (1.f / DA); const float rstd = rsqrtf(fmaxf(ex2 - mu * mu, 0.f) + EPS);
            f32x2 y = (out[i][o] - mu) * rstd * gg + be; y.x = y.x * fsigm(y.x); y.y = y.y * fsigm(y.y);
            *(unsigned*)(outb + (row0 + 8 * w + o) * 1024 + 2 * p) = cvt_pk_bf16(y.x * __uint_as_float(az[i][o] << 16), y.y * __uint_as_float(az[i][o] & 0xffff0000u)); }
    }
    __syncthreads();
}
__device__ __forceinline__ void p2_gmlp(Frame& F, int l, int unit, bf16_t* outb) {
    constexpr int VTP = 136;
    const int tid = F.tid, lane = F.lane, w = F.wave, fr = lane & 15, fq = lane >> 4, ch = unit >> 1, gp = unit & 1, c0 = 256 * gp; const size_t row0 = (size_t)ch * CHK;
    LAS bf16_t* vt = (LAS bf16_t*)(F.lds + RING_OFF);
    const bf16_t* V = (const bf16_t*)(F.P.ws + WS_B3) + 512 + c0; const bf16_t* U = (const bf16_t*)(F.P.ws + WS_B0) + 512 + c0; const bf16_t* BZ = (const bf16_t*)(F.P.ws + WS_B4) + c0;
    const float* vss = (const float*)(F.P.ws + WS_VSS); const float* gn = F.P.gn_g + l * DB + c0;
    const size_t t = row0 + 16 * w + fr;
    unsigned long long uu[16], zz[16];
#pragma unroll
    for (int n = 0; n < 16; ++n) { uu[n] = *(const unsigned long long*)(U + t * 1024 + 16 * n + 4 * fq); zz[n] = *(const unsigned long long*)(BZ + t * 512 + 16 * n + 4 * fq); }
    bf16x8 wf[2][4];
#pragma unroll
    for (int g2 = 0; g2 < 2; ++g2)
#pragma unroll
        for (int ks = 0; ks < 4; ++ks) wf[g2][ks] = *(const bf16x8*)((const bf16_t*)(F.P.ws + WS_WSB) + ((size_t)(l * NG + 2 * gp + g2) * CHK + 16 * w + fr) * CHK + 32 * ks + 8 * fq);
    const float bs0 = F.P.b_s[(size_t)(l * NG + 2 * gp) * CHK + 16 * w + fr], bs1 = F.P.b_s[(size_t)(l * NG + 2 * gp + 1) * CHK + 16 * w + fr];
    { const int sidx = tid & 127; const f32x4 qa = *(const f32x4*)(vss + (row0 + sidx) * 8), qb = *(const f32x4*)(vss + (row0 + sidx) * 8 + 4);
      const float ss = ((qa.x + qa.y) + (qa.z + qa.w)) + ((qb.x + qb.y) + (qb.z + qb.w)); const float rv = rsqrtf(ss * (1.f / DB) + EPS);
      u32x4 raw[8];
#pragma unroll
      for (int k = 0; k < 8; ++k) raw[k] = *(const u32x4*)(V + (row0 + sidx) * 1024 + ((tid >> 7) + 4 * k) * 8);
#pragma unroll
      for (int k = 0; k < 8; ++k) { const int c8 = ((tid >> 7) + 4 * k) * 8; f32x4 v0, v1; unpack8(raw[k], v0, v1); const f32x4 g0 = *(const f32x4*)(gn + c8), g1 = *(const f32x4*)(gn + c8 + 4);
          v0 = v0 * rv * g0; v1 = v1 * rv * g1;
#pragma unroll
          for (int e = 0; e < 4; ++e) { vt[(c8 + e) * VTP + sidx] = f2bf(v0[e]); vt[(c8 + 4 + e) * VTP + sidx] = f2bf(v1[e]); } } }
    __syncthreads();
    f32x4 acc[16];
#pragma unroll
    for (int n = 0; n < 16; ++n) acc[n] = (f32x4){0.f, 0.f, 0.f, 0.f};
#pragma unroll
    for (int ks = 0; ks < 4; ++ks) {
        if (32 * ks <= 16 * w + 15) {
#pragma unroll
            for (int n = 0; n < 16; ++n) { const bf16x8 vf = *(const LAS bf16x8*)(vt + (16 * n + fr) * VTP + 32 * ks + 8 * fq); acc[n] = __builtin_amdgcn_mfma_f32_16x16x32_bf16(vf, wf[n >> 3][ks], acc[n], 0, 0, 0); }
        }
    }
#pragma unroll
    for (int n = 0; n < 16; ++n) { const float bs = n < 8 ? bs0 : bs1;
        const unsigned u0 = (unsigned)uu[n], u1 = (unsigned)(uu[n] >> 32), z0 = (unsigned)zz[n], z1 = (unsigned)(zz[n] >> 32);
        const float o0 = __uint_as_float(u0 << 16) * (acc[n][0] + bs) * __uint_as_float(z0 << 16), o1 = __uint_as_float(u0 & 0xffff0000u) * (acc[n][1] + bs) * __uint_as_float(z0 & 0xffff0000u);
        const float o2 = __uint_as_float(u1 << 16) * (acc[n][2] + bs) * __uint_as_float(z1 << 16), o3 = __uint_as_float(u1 & 0xffff0000u) * (acc[n][3] + bs) * __uint_as_float(z1 & 0xffff0000u);
        *(unsigned long long*)(outb + 512 + c0 + t * 1024 + 16 * n + 4 * fq) = (unsigned long long)cvt_pk_bf16(o0, o1) | ((unsigned long long)cvt_pk_bf16(o2, o3) << 32); }
    __syncthreads();
}

__global__ void __launch_bounds__(NWAVES * 64, 2) mk_fwd(Args args) {
    extern __shared__ __attribute__((aligned(16))) unsigned char lds[];
    Frame F;
    F.lds = (LAS unsigned char*)lds;
    volatile LAS unsigned* MISC = (volatile LAS unsigned*)(F.lds + MISC_OFF);
    F.tid = threadIdx.x; F.lane = F.tid & 63; F.wave = __builtin_amdgcn_readfirstlane(F.tid >> 6);
    F.G = gridDim.x; { const int bx = blockIdx.x; F.vcu = (F.G % 8 == 0) ? (bx % 8) * (F.G / 8) + bx / 8 : bx; }
    F.P.x = args.in[0]; F.P.norm_g = args.in[1]; F.P.w_in = args.in[2]; F.P.b_gate = args.in[3]; F.P.conv_w = args.in[4]; F.P.conv_b = args.in[5]; F.P.cn_g = args.in[6]; F.P.cn_b = args.in[7]; F.P.w_a = args.in[8];
    F.P.gn_g = args.in[9]; F.P.w_s = args.in[10]; F.P.b_s = args.in[11]; F.P.w_b = args.in[12]; F.P.qn_g = args.in[13]; F.P.kn_g = args.in[14]; F.P.b_f = args.in[15]; F.P.w_c = args.in[16]; F.P.w_out = args.in[17];
    F.P.out = args.out; F.P.ws = args.ws;
    gu32* ctl = (gu32*)(args.ws + WS_CTL);
    for (int u = F.tid; u < (LDS_BYTES - LDSCTL_OFF) / 4; u += NWAVES * 64) ((LAS unsigned*)(F.lds + LDSCTL_OFF))[u] = 0u;
    __syncthreads();
    XcdBarrier bar = xcd_barrier_post((unsigned*)(ctl + CW_BAR) + args.li * XCD_BAR_WORDS, MISC + 8);

    bool dup_done = false;
    for (int ph = args.ph_lo; ph < args.ph_hi;) {
        const int l = ph / 5, p = ph % 5;
        const bool dummy = (PROBE_DUP >= 0) && p == PROBE_DUP && !dup_done;
        asm volatile("" : "+v"(F.tid)); F.lane = F.tid & 63;
        int bid = (int)blockIdx.x; asm volatile("" : "+s"(bid));
        unsigned char* ws = F.P.ws; unsigned char* wl = ws + WS_W + (size_t)l * W_LAYER;
        const float* xin = l == 0 ? F.P.x : F.P.out;
        if (p == 0) {
            if (l > 0) { ++ph; continue; }
            if (l == 0 && (!dummy || (PROBE_SUB & 1))) p0_weights(F);
            if (!dummy || (PROBE_SUB & 2)) p0_ln(F, l, xin);
        } else if (p == 1) {
            if (bid < NB * NH) p1_scan(F, bid, l);
            { pg8::TileOrder T0; T0.init(M, N1, F.G, bid); int pm_ = 0, pn_ = 0; (void)T0.tile(0, pm_, pn_);
              LAS float* Rt = (LAS float*)(F.lds + RT_OFF);
              if (F.tid < 256) { float r = 1.f; if (l > 0) { const f32x4 q = *(const f32x4*)((const float*)(ws + WS_SSP) + ((size_t)pm_ * 256 + F.tid) * 4); r = rsqrtf(((q.x + q.y) + (q.z + q.w)) * (1.f / D) + EPS); } Rt[F.tid] = r; }
              __syncthreads(); }
            pg8::SchedG1 S; S.T.init(M, N1, F.G, bid); S.A = (const char*)(ws + WS_H); S.B = (const char*)(wl + WO_W1);
            pg8::EpiG1 E{(bf16_t*)(ws + WS_B0), (bf16_t*)(ws + WS_B1), (bf16_t*)(ws + WS_B2), (bf16_t*)(ws + WS_B3), (bf16_t*)(ws + WS_B4), (float*)(ws + WS_VSS), F.P.qn_g + l * HD, F.P.kn_g + l * HD, (const LAS float*)(F.lds + RT_OFF)};
            pg8::gemm_phase<pg8::EpiG1, pg8::SchedG1>(F.lds + RING_OFF, S, E);
        } else if (p == 2) {
            if (!dummy || (PROBE_SUB & 1)) p2_conv(F, l, bid, dummy ? (bf16_t*)(ws + WS_DUMMY) : (bf16_t*)(ws + WS_B0), dummy);
            if (!dummy || (PROBE_SUB & 2)) { bf16_t* ob = dummy ? (bf16_t*)(ws + WS_DUMMY) : (bf16_t*)(ws + WS_B0); p2_gmlp(F, l, bid, ob); }
            if (!dummy || (PROBE_SUB & 4)) { const int bh = F.vcu >> 3, sq = F.vcu & 7; const attn_body::bf16* b1 = (const attn_body::bf16*)(ws + WS_B1); const attn_body::bf16* b2 = (const attn_body::bf16*)(ws + WS_B2);
              const float* c2g = (const float*)(ws + WS_CS) + (size_t)bh * SEQ; const int* tsg = (const int*)(ws + WS_TS) + bh * 16;
              float gqm = fabsf(F.P.qn_g[l * HD + F.lane]), gkm = fabsf(F.P.kn_g[l * HD + F.lane]);
#pragma unroll
              for (int o_ = 1; o_ < 64; o_ <<= 1) { gqm = fmaxf(gqm, __shfl_xor(gqm, o_)); gkm = fmaxf(gkm, __shfl_xor(gkm, o_)); }
              const float ub = 64.f * C2 * gqm * gkm * 1.01f;
              for (int i = 0; i < 2; ++i) { const int qb = i == 0 ? 15 - sq : sq; const int ts = __builtin_amdgcn_readfirstlane(tsg[qb]); attn_body::attn_unit<8>(bh / NH, bh % NH, qb, b1, b1 + 512, b2, b2 + 512, dummy ? (attn_body::bf16*)(ws + WS_DUMMY) : (attn_body::bf16*)(ws + WS_B1), c2g, ts, ub, (char*)lds + RING_OFF); } }
        } else if (p == 3) {
            pg8::TileOrder T; T.init(M, D, F.G, bid);
            pg8::SchedMerge S; { int pm_ = 0, pn_ = 0; S.ok = T.tile(0, pm_, pn_); S.pm = pm_; S.pn = pn_; }
            S.ws = (const char*)ws; S.wl = (const char*)wl;
            pg8::EpiMerge E{ws + WS_GT + (size_t)bid * 131072, (bf16_t*)(ws + WS_MG), F.P.b_gate + (size_t)l * 3072, (const LAS float*)(F.lds + RT_OFF)};
            pg8::gemm_phase<pg8::EpiMerge, pg8::SchedMerge>(F.lds + RING_OFF, S, E);
        } else {
            pg8::SchedG1 S; S.T.init(M, D, F.G, bid); S.A = (const char*)(ws + WS_MG); S.B = (const char*)(wl + WO_WO);
            if (l + 1 < NL) {
                pg8::EpiOutLN E{xin, dummy ? (float*)(ws + WS_B0) : F.P.out, (bf16_t*)(ws + WS_H), F.P.norm_g + (size_t)(l + 1) * D, F.P.w_in + (size_t)(l + 1) * D * NIN + OC_F, (float*)(ws + WS_SSP), (float*)(ws + WS_FP)};
                pg8::gemm_phase<pg8::EpiOutLN, pg8::SchedG1>(F.lds + RING_OFF, S, E);
            } else {
                pg8::EpiOut E{xin, dummy ? (float*)(ws + WS_B0) : F.P.out};
                pg8::gemm_phase<pg8::EpiOut, pg8::SchedG1>(F.lds + RING_OFF, S, E);
            }
        }
        if (dummy) { dup_done = true; continue; }
        dup_done = false; ++ph;
        if (ph < args.ph_hi) xcd_barrier(bar);
    }
}

#ifndef MK_MODE
#define MK_MODE 2
#endif
extern "C" void kernel_launch(void* const* d_in, const int* in_sizes, int n_in, void* d_out, int out_size, void* d_ws, size_t ws_size, hipStream_t stream) {
    static int ok = 0;
    if (ok == 0) {
        if (n_in != 18 || in_sizes[0] != M * D || out_size != M * D || ws_size < WS_END) { fprintf(stderr, "kernel_launch: unexpected shapes (n_in %d in0 %d out %d ws %zu)\n", n_in, n_in > 0 ? in_sizes[0] : -1, out_size, ws_size); ok = -1; return; }
        const int tl = 64 * TLD * 4;
        (void)hipFuncSetAttribute((const void*)nv_gemm1, hipFuncAttributeMaxDynamicSharedMemorySize, tl);
        (void)hipFuncSetAttribute((const void*)nv_merge, hipFuncAttributeMaxDynamicSharedMemorySize, 2 * 64 * 256 * 4);
        (void)hipFuncSetAttribute((const void*)nv_gmlp, hipFuncAttributeMaxDynamicSharedMemorySize, 128 * 129 * 4);
        (void)hipFuncSetAttribute((const void*)nv_attn, hipFuncAttributeMaxDynamicSharedMemorySize, 4 * SEQ * 4);
        if (hipFuncSetAttribute((const void*)mk_fwd, hipFuncAttributeMaxDynamicSharedMemorySize, LDS_BYTES) != hipSuccess) { fprintf(stderr, "kernel_launch: hipFuncSetAttribute(mk_fwd) failed\n"); ok = -1; return; }
        int dev = 0, cus = 0; (void)hipGetDevice(&dev); (void)hipDeviceGetAttribute(&cus, hipDeviceAttributeMultiprocessorCount, dev);
        if (cus != 256) fprintf(stderr, "kernel_launch: note: %d CUs (built for 256)\n", cus);
        (void)hipGetLastError();
        ok = 1;
    }
    if (ok < 0) return;
    Ptrs P{};
    const float** pp = (const float**)&P;
    for (int i = 0; i < 18; ++i) pp[i] = (const float*)d_in[i];
    P.out = (float*)d_out; P.ws = (unsigned char*)d_ws;
    const int tl = 64 * TLD * 4;
#if MK_MODE == 0
    nv_prep<<<2048, 256, 0, stream>>>(P);
    for (int l = 0; l < NL; ++l) {
        const float* xin = l == 0 ? P.x : P.out;
        nv_ln<<<M / 4, 256, 0, stream>>>(P, l, xin);
        nv_scan<<<NB * NH, 256, 0, stream>>>(P);
        nv_gemm1<<<dim3(20, 256), 256, tl, stream>>>(P, l);
        nv_conv<<<M, 512, 0, stream>>>(P, l);
        nv_gmlp<<<dim3(128, 4), 256, 128 * 129 * 4, stream>>>(P, l);
        nv_attn<<<M * NH / 4, 256, 4 * SEQ * 4, stream>>>(P);
        nv_merge<<<dim3(4, 256), 256, 2 * 64 * 256 * 4, stream>>>(P, l);
        nv_out<<<dim3(4, 256), 256, 0, stream>>>(P, l, xin, P.out);
    }
#else
    (void)tl;
    if (hipMemsetAsync((char*)d_ws + WS_CTL, 0, CTL_ZERO_BYTES, stream) != hipSuccess) { fprintf(stderr, "kernel_launch: memset failed\n"); return; }
    Args a{};
    for (int i = 0; i < 18; ++i) a.in[i] = (const float*)d_in[i];
    a.out = (float*)d_out; a.ws = (unsigned char*)d_ws;
    auto mk = [&](int lo, int hi, int li) { a.ph_lo = lo; a.ph_hi = hi; a.li = li; hipLaunchKernelGGL(mk_fwd, dim3(256), dim3(NWAVES * 64), LDS_BYTES, stream, a);
        const hipError_t le = hipPeekAtLastError(); if (le != hipSuccess) fprintf(stderr, "kernel_launch: mk launch [%d,%d) failed: %s\n", lo, hi, hipGetErrorName(le)); };
#if MK_MODE == 1
    auto mixers = [&](int l) { nv_conv<<<M, 512, 0, stream>>>(P, l); nv_gmlp<<<dim3(128, 4), 256, 128 * 129 * 4, stream>>>(P, l); nv_attn<<<M * NH / 4, 256, 4 * SEQ * 4, stream>>>(P); };
    mk(0, 2, 0); mixers(0); mk(3, 7, 1); mixers(1); mk(8, 10, 2);
#else
    mk(0, NPH, 0);
#endif
#endif
}
```

```cpp
#include <hip/hip_runtime.h>
#include <cstdio>
#include <cstdint>
#include <cmath>

constexpr int NL = 2, NB = 4, SEQ = 4096, M = NB * SEQ, D = 1024;
constexpr int DA = 512, DB = 512, NH = 8, HD = 64, DC = 512, CW = 31, CHK = 128, NG = 4, GD = 128, NIN = 8200;
constexpr float EPS = 1e-6f;
constexpr float LOG2E = 1.4426950408889634f;
constexpr float C2 = 0.125f * LOG2E;
constexpr int N1 = 5120;
constexpr int OC_GATE = 0, OC_AIN = 3072, OC_AZ = 4096, OC_U = 4608, OC_V = 5120, OC_BZ = 5632, OC_Q = 6144, OC_K = 6656, OC_VA = 7168, OC_CZ = 7680, OC_F = 8192;

constexpr size_t MiB = 1u << 20;
constexpr size_t WS_CTL = 0, CTL_ZERO_BYTES = 1 * MiB;
constexpr size_t WS_VSS = 1 * MiB;
constexpr size_t WS_LOGF = WS_VSS + 512 * 1024;
constexpr size_t WS_CS = 2 * MiB;
constexpr size_t WS_WSB = WS_CS + 512 * 1024;
constexpr size_t WS_TS = 3 * MiB;
constexpr size_t WS_W = 4 * MiB, W_LAYER = 22 * MiB;
constexpr size_t WO_W1 = 0, WO_WG = 10 * MiB, WO_WAB = 16 * MiB, WO_WC = 18 * MiB, WO_WO = 20 * MiB;
constexpr size_t WS_H = 48 * MiB;
constexpr size_t WS_B0 = 80 * MiB;
constexpr size_t WS_B1 = 112 * MiB;
constexpr size_t WS_B2 = 144 * MiB;
constexpr size_t WS_B3 = 176 * MiB;
constexpr size_t WS_B4 = 208 * MiB;
constexpr size_t WS_GT = WS_B2, WS_MG = WS_B3;
constexpr size_t WS_FP = 240 * MiB;
constexpr size_t WS_SSP = 242 * MiB;
constexpr size_t WS_DUMMY = 224 * MiB;
constexpr size_t WS_END = 256 * MiB;
#ifndef PROBE_CONV
#define PROBE_CONV 0
#endif
#ifndef PROBE_SUB
#define PROBE_SUB 7
#endif
#ifndef PROBE_DUP
#define PROBE_DUP -1
#endif

typedef unsigned short bf16_t;
typedef short bf16x8 __attribute__((ext_vector_type(8)));
typedef float f32x4 __attribute__((ext_vector_type(4)));
typedef unsigned u32x4 __attribute__((ext_vector_type(4)));

__host__ __device__ __forceinline__ float bf2f(bf16_t v) { union { unsigned u; float f; } c; c.u = (unsigned)v << 16; return c.f; }
__host__ __device__ __forceinline__ bf16_t f2bf(float f) { union { unsigned u; float f; } c; c.f = f; unsigned u = c.u; return (bf16_t)((u + 0x7fffu + ((u >> 16) & 1u)) >> 16); }
__device__ __forceinline__ float bfr(float f) { return bf2f(f2bf(f)); }
__device__ __forceinline__ float sigm(float x) { return 1.f / (1.f + __expf(-x)); }
__device__ __forceinline__ float siluf(float x) { return x * sigm(x); }

__host__ __device__ __forceinline__ int g1_col(int n) {
    const int j = n >> 8, lc = n & 255;
    if (j < 4) return lc < 128 ? OC_AIN + 128 * j + lc : OC_AIN + 512 + 128 * j + (lc - 128);
    if (j < 6) return OC_AZ + 256 * (j - 4) + lc;
    if (j < 8) return OC_U + 256 * (j - 6) + lc;
    if (j < 10) return OC_V + 256 * (j - 8) + lc;
    if (j < 12) return OC_BZ + 256 * (j - 10) + lc;
    if (j < 16) { const int isk = j >= 14, jj = (j - 12) & 1, head = 4 * jj + ((lc >> 5) & 3), d = 32 * (lc >> 7) + (lc & 31); return (isk ? OC_K : OC_Q) + 64 * head + d; }
    if (j < 18) return OC_VA + 256 * (j - 16) + lc;
    return OC_CZ + 256 * (j - 18) + lc;
}

struct Ptrs {
    const float *x, *norm_g, *w_in, *b_gate, *conv_w, *conv_b, *cn_g, *cn_b, *w_a, *gn_g, *w_s, *b_s, *w_b, *qn_g, *kn_g, *b_f, *w_c, *w_out;
    float* out; unsigned char* ws;
};

__global__ void nv_prep(Ptrs P) {
    const size_t gid = (size_t)blockIdx.x * blockDim.x + threadIdx.x, gsz = (size_t)gridDim.x * blockDim.x;
    for (int l = 0; l < NL; ++l) {
        unsigned char* wl = P.ws + WS_W + (size_t)l * W_LAYER;
        bf16_t* W1 = (bf16_t*)(wl + WO_W1); bf16_t* WG = (bf16_t*)(wl + WO_WG); bf16_t* WAB = (bf16_t*)(wl + WO_WAB); bf16_t* WC = (bf16_t*)(wl + WO_WC); bf16_t* WO = (bf16_t*)(wl + WO_WO);
        const float* win = P.w_in + (size_t)l * D * NIN;
        for (size_t i = gid; i < (size_t)N1 * D; i += gsz) { const int n = (int)(i >> 10), k = (int)(i & 1023); W1[i] = f2bf(win[(size_t)k * NIN + g1_col(n)]); }
        for (size_t i = gid; i < (size_t)3072 * D; i += gsz) { const int n = (int)(i >> 10), k = (int)(i & 1023); WG[i] = f2bf(win[(size_t)k * NIN + n]); }
        for (size_t i = gid; i < (size_t)1024 * 1024; i += gsz) { const int n = (int)(i >> 10), k = (int)(i & 1023);
            WAB[i] = f2bf(k < 512 ? P.w_a[((size_t)l * DA + k) * D + n] : P.w_b[((size_t)l * DB + (k - 512)) * D + n]);
            WC[i] = k < 512 ? f2bf(P.w_c[((size_t)l * DC + k) * D + n]) : (bf16_t)0;
            WO[i] = f2bf(P.w_out[((size_t)l * D + k) * D + n]); }
        bf16_t* WSB = (bf16_t*)(P.ws + WS_WSB) + (size_t)l * NG * CHK * CHK;
        for (size_t i = gid; i < (size_t)NG * CHK * CHK; i += gsz) { const int s = (int)(i & 127), t = (int)((i >> 7) & 127); WSB[i] = s <= t ? f2bf(P.w_s[(size_t)l * NG * CHK * CHK + i]) : (bf16_t)0; }
    }
}

__device__ __forceinline__ float wave_sum(float v) {
#pragma unroll
    for (int o = 1; o < 64; o <<= 1) v += __shfl_xor(v, o);
    return v;
}

__global__ void nv_ln(Ptrs P, int l, const float* xin) {
    const int lane = threadIdx.x & 63, row = blockIdx.x * 4 + (threadIdx.x >> 6);
    const float* xr = xin + (size_t)row * D; const float* g = P.norm_g + (size_t)l * D; const float* win = P.w_in + (size_t)l * D * NIN;
    float v[16]; float ss = 0.f;
#pragma unroll
    for (int j = 0; j < 16; ++j) { v[j] = xr[lane + 64 * j]; ss += v[j] * v[j]; }
    ss = wave_sum(ss);
    const float r = rsqrtf(ss * (1.f / D) + EPS);
    bf16_t* h = (bf16_t*)(P.ws + WS_H) + (size_t)row * D;
    float f[8] = {0, 0, 0, 0, 0, 0, 0, 0};
#pragma unroll
    for (int j = 0; j < 16; ++j) { const int k = lane + 64 * j; const float hv = v[j] * r * g[k]; h[k] = f2bf(hv);
#pragma unroll
        for (int e = 0; e < 8; ++e) f[e] += hv * win[(size_t)k * NIN + OC_F + e]; }
#pragma unroll
    for (int e = 0; e < 8; ++e) f[e] = wave_sum(f[e]);
    if (lane < 8) { float z = 0.f;
#pragma unroll
        for (int e = 0; e < 8; ++e) if (lane == e) z = f[e];
        z += P.b_f[l * NH + lane];
        const float lf = fminf(z, 0.f) - log1pf(expf(-fabsf(z)));
        ((float*)(P.ws + WS_LOGF))[(size_t)row * 8 + lane] = lf; }
}

__global__ void nv_scan(Ptrs P) {
    __shared__ float buf[SEQ];
    const int bh = blockIdx.x, b = bh / NH, h = bh % NH;
    const float* lf = (const float*)(P.ws + WS_LOGF);
    for (int t = threadIdx.x; t < SEQ; t += blockDim.x) buf[t] = lf[((size_t)b * SEQ + t) * 8 + h];
    __syncthreads();
    if (threadIdx.x == 0) { float c = 0.f; for (int t = 0; t < SEQ; ++t) { c += buf[t]; buf[t] = c * LOG2E; } }
    __syncthreads();
    float* cs = (float*)(P.ws + WS_CS) + (size_t)bh * SEQ;
    for (int t = threadIdx.x; t < SEQ; t += blockDim.x) cs[t] = buf[t];
}

constexpr int TLD = 257;
__device__ __forceinline__ void nv_gemm_acc(const bf16_t* A, int lda, const bf16_t* Bt, int ldb, int K, f32x4 (&acc)[4][4]) {
    const int tid = threadIdx.x, w = tid >> 6, l = tid & 63, fr = l & 15, fq = l >> 4;
#pragma unroll
    for (int m = 0; m < 4; ++m)
#pragma unroll
        for (int n = 0; n < 4; ++n) acc[m][n] = (f32x4){0.f, 0.f, 0.f, 0.f};
    for (int k0 = 0; k0 < K; k0 += 32) {
        bf16x8 a[4], b[4];
#pragma unroll
        for (int m = 0; m < 4; ++m) a[m] = *(const bf16x8*)(A + (size_t)(16 * m + fr) * lda + k0 + 8 * fq);
#pragma unroll
        for (int n = 0; n < 4; ++n) b[n] = *(const bf16x8*)(Bt + (size_t)(64 * w + 16 * n + fr) * ldb + k0 + 8 * fq);
#pragma unroll
        for (int m = 0; m < 4; ++m)
#pragma unroll
            for (int n = 0; n < 4; ++n) acc[m][n] = __builtin_amdgcn_mfma_f32_16x16x32_bf16(a[m], b[n], acc[m][n], 0, 0, 0);
    }
}
__device__ __forceinline__ void nv_gemm_tile(const bf16_t* A, int lda, const bf16_t* Bt, int ldb, int K, float* T) {
    const int tid = threadIdx.x, w = tid >> 6, l = tid & 63, fr = l & 15, fq = l >> 4;
    f32x4 acc[4][4];
    nv_gemm_acc(A, lda, Bt, ldb, K, acc);
#pragma unroll
    for (int m = 0; m < 4; ++m)
#pragma unroll
        for (int n = 0; n < 4; ++n)
#pragma unroll
            for (int r = 0; r < 4; ++r) T[(16 * m + 4 * fq + r) * TLD + 64 * w + 16 * n + fr] = acc[m][n][r];
}

__global__ void __launch_bounds__(256) nv_gemm1(Ptrs P, int l) {
    extern __shared__ float T[];
    __shared__ float R[64 * 4];
    const int j = blockIdx.x, row0 = blockIdx.y * 64, tid = threadIdx.x;
    const bf16_t* H = (const bf16_t*)(P.ws + WS_H);
    const bf16_t* W1 = (const bf16_t*)(P.ws + WS_W + (size_t)l * W_LAYER + WO_W1);
    nv_gemm_tile(H + (size_t)row0 * D, D, W1 + (size_t)j * 256 * D, D, D, T);
    __syncthreads();
    bf16_t* B0 = (bf16_t*)(P.ws + WS_B0); bf16_t* B1 = (bf16_t*)(P.ws + WS_B1); bf16_t* B2 = (bf16_t*)(P.ws + WS_B2); bf16_t* B3 = (bf16_t*)(P.ws + WS_B3); bf16_t* B4 = (bf16_t*)(P.ws + WS_B4);
    if (j < 4) {
        for (int e = tid; e < 64 * 128; e += 256) { const int r = e >> 7, c = e & 127; B3[(size_t)(row0 + r) * 1024 + 128 * j + c] = f2bf(T[r * TLD + c] * sigm(T[r * TLD + c + 128])); }
    } else if (j < 12 || j >= 16) {
        bf16_t* dst; int pitch, coff; bool act;
        if (j < 6) { dst = B0; pitch = 1024; coff = 256 * (j - 4); act = true; }
        else if (j < 8) { dst = B0; pitch = 1024; coff = 512 + 256 * (j - 6); act = false; }
        else if (j < 10) { dst = B3; pitch = 1024; coff = 512 + 256 * (j - 8); act = false; }
        else if (j < 12) { dst = B4; pitch = 512; coff = 256 * (j - 10); act = true; }
        else if (j < 18) { dst = B2; pitch = 1024; coff = 256 * (j - 16); act = false; }
        else { dst = B2; pitch = 1024; coff = 512 + 256 * (j - 18); act = true; }
        for (int e = tid; e < 64 * 256; e += 256) { const int r = e >> 8, c = e & 255; const float v = T[r * TLD + c]; dst[(size_t)(row0 + r) * pitch + coff + c] = f2bf(act ? siluf(v) : v); }
        if (j == 8 || j == 9) { const int r = tid >> 2, wc = tid & 3; float s = 0.f;
            for (int bj = 0; bj < 2; ++bj) for (int i = 0; i < 32; ++i) { const float v = T[r * TLD + 128 * bj + 32 * wc + i]; s += v * v; }
            ((float*)(P.ws + WS_VSS))[(size_t)(row0 + r) * 8 + (j - 8) * 4 + wc] = s; }
    } else {
        const bool isk = j >= 14; const int jj = (j - 12) & 1;
        { const int r = tid >> 2, hh = tid & 3; float s = 0.f;
          for (int d = 0; d < 64; ++d) { const float v = T[r * TLD + 128 * (d >> 5) + 32 * hh + (d & 31)]; s += v * v; }
          R[r * 4 + hh] = rsqrtf(s * (1.f / 64.f) + EPS); }
        __syncthreads();
        const float* gq = (isk ? P.kn_g : P.qn_g) + (size_t)l * HD;
        for (int e = tid; e < 64 * 256; e += 256) { const int r = e >> 8, c = e & 255, hh = (c >> 5) & 3, d = 32 * (c >> 7) + (c & 31);
            float v = T[r * TLD + c] * R[r * 4 + hh] * gq[d]; if (!isk) v *= C2;
            B1[(size_t)(row0 + r) * 1024 + (isk ? 512 : 0) + 64 * (4 * jj + hh) + d] = f2bf(v); }
    }
}

__global__ void __launch_bounds__(512) nv_conv(Ptrs P, int l) {
    __shared__ float red[16];
    const int row = blockIdx.x, t = row % SEQ, c = threadIdx.x, lane = c & 63, w = c >> 6;
    const bf16_t* AG = (const bf16_t*)(P.ws + WS_B3); bf16_t* B0 = (bf16_t*)(P.ws + WS_B0);
    const float* cw = P.conv_w + (size_t)l * CW * DA;
    float a = P.conv_b[l * DA + c];
    for (int j = 0; j < CW; ++j) { const int tt = t - (CW - 1) + j; if (tt >= 0) a += cw[j * DA + c] * bf2f(AG[(size_t)(row - (CW - 1) + j) * 1024 + c]); }
    float s = wave_sum(a); if (lane == 0) red[w] = s; __syncthreads();
    float mu = 0.f; for (int i = 0; i < 8; ++i) mu += red[i]; mu *= (1.f / DA);
    const float d = a - mu; s = wave_sum(d * d); if (lane == 0) red[8 + w] = s; __syncthreads();
    float var = 0.f; for (int i = 0; i < 8; ++i) var += red[8 + i]; var *= (1.f / DA);
    const float y = d * rsqrtf(var + EPS) * P.cn_g[l * DA + c] + P.cn_b[l * DA + c];
    const float az = bf2f(B0[(size_t)row * 1024 + c]);
    B0[(size_t)row * 1024 + c] = f2bf(siluf(y) * az);
}

__global__ void __launch_bounds__(256) nv_gmlp(Ptrs P, int l) {
    extern __shared__ float vn[];
    const int ch = blockIdx.x, g = blockIdx.y, tid = threadIdx.x; const size_t row0 = (size_t)ch * CHK;
    const bf16_t* V = (const bf16_t*)(P.ws + WS_B3); bf16_t* B0 = (bf16_t*)(P.ws + WS_B0); const bf16_t* BZ = (const bf16_t*)(P.ws + WS_B4);
    const float* vss = (const float*)(P.ws + WS_VSS);
    const bf16_t* WSB = (const bf16_t*)(P.ws + WS_WSB) + ((size_t)l * NG + g) * CHK * CHK;
    for (int e = tid; e < 128 * 128; e += 256) { const int s = e >> 7, c = e & 127; const float* q = vss + (row0 + s) * 8;
        const float ss = ((q[0] + q[1]) + (q[2] + q[3])) + ((q[4] + q[5]) + (q[6] + q[7])); const float rv = rsqrtf(ss * (1.f / DB) + EPS);
        vn[s * 129 + c] = bfr(bf2f(V[(row0 + s) * 1024 + 512 + 128 * g + c]) * rv * P.gn_g[l * DB + 128 * g + c]); }
    __syncthreads();
    for (int e = tid; e < 128 * 128; e += 256) { const int t = e >> 7, c = e & 127; float acc = 0.f;
        for (int s = 0; s <= t; ++s) acc += bf2f(WSB[t * 128 + s]) * vn[s * 129 + c];
        acc += P.b_s[((size_t)l * NG + g) * CHK + t];
        const size_t o = (row0 + t) * 1024 + 512 + 128 * g + c;
        B0[o] = f2bf(bf2f(B0[o]) * acc * bf2f(BZ[(row0 + t) * 512 + 128 * g + c])); }
}

__global__ void __launch_bounds__(256) nv_attn(Ptrs P) {
    extern __shared__ float sc[];
    const int lane = threadIdx.x & 63, w = threadIdx.x >> 6; const int item = blockIdx.x * 4 + w, row = item >> 3, h = item & 7, b = row / SEQ, t = row % SEQ;
    float* s = sc + w * SEQ;
    bf16_t* B1 = (bf16_t*)(P.ws + WS_B1); const bf16_t* B2 = (const bf16_t*)(P.ws + WS_B2);
    const float* cs = (const float*)(P.ws + WS_CS) + (size_t)(b * NH + h) * SEQ;
    float q[64];
#pragma unroll
    for (int d = 0; d < 64; ++d) q[d] = bf2f(B1[(size_t)row * 1024 + 64 * h + d]);
    const float cq = cs[t]; float mx = -INFINITY;
    for (int k = lane; k <= t; k += 64) { const bf16_t* kr = B1 + ((size_t)b * SEQ + k) * 1024 + 512 + 64 * h; float dot = 0.f;
#pragma unroll
        for (int d8 = 0; d8 < 8; ++d8) { const bf16x8 kv = *(const bf16x8*)(kr + 8 * d8);
#pragma unroll
            for (int e = 0; e < 8; ++e) dot += q[8 * d8 + e] * bf2f((bf16_t)kv[e]); }
        const float v = dot + (cq - cs[k]); s[k] = v; mx = fmaxf(mx, v); }
#pragma unroll
    for (int o = 1; o < 64; o <<= 1) mx = fmaxf(mx, __shfl_xor(mx, o));
    float lsum = 0.f;
    for (int k = lane; k <= t; k += 64) { const float p = exp2f(s[k] - mx); lsum += p; s[k] = bfr(p); }
    lsum = wave_sum(lsum);
    __builtin_amdgcn_s_waitcnt(0); __builtin_amdgcn_wave_barrier();
    float o = 0.f; const bf16_t* vb = B2 + (size_t)b * SEQ * 1024 + 64 * h + lane;
    for (int k = 0; k <= t; ++k) o += s[k] * bf2f(vb[(size_t)k * 1024]);
    const float cz = bf2f(B2[(size_t)row * 1024 + 512 + 64 * h + lane]);
    B1[(size_t)row * 1024 + 64 * h + lane] = f2bf(o / lsum * cz);
}

__global__ void __launch_bounds__(256) nv_merge(Ptrs P, int l) {
    extern __shared__ float T[];
    const int pn = blockIdx.x, row0 = blockIdx.y * 64, tid = threadIdx.x, w = tid >> 6, ln = tid & 63, fr = ln & 15, fq = ln >> 4;
    const unsigned char* wl = P.ws + WS_W + (size_t)l * W_LAYER;
    const bf16_t* H = (const bf16_t*)(P.ws + WS_H); const bf16_t* WG = (const bf16_t*)(wl + WO_WG); const bf16_t* WAB = (const bf16_t*)(wl + WO_WAB); const bf16_t* WC = (const bf16_t*)(wl + WO_WC);
    const bf16_t* B0 = (const bf16_t*)(P.ws + WS_B0); const bf16_t* B1 = (const bf16_t*)(P.ws + WS_B1);
    float* G = T; float* MGs = T + 64 * 256;
    f32x4 acc[4][4];
    for (int br = 0; br < 3; ++br) {
        nv_gemm_acc(H + (size_t)row0 * D, D, WG + ((size_t)br * 1024 + 256 * pn) * D, D, D, acc);
#pragma unroll
        for (int m = 0; m < 4; ++m)
#pragma unroll
            for (int n = 0; n < 4; ++n)
#pragma unroll
                for (int r = 0; r < 4; ++r) { const int c = 64 * w + 16 * n + fr; G[((m * 4 + n) * 4 + r) * 256 + tid] = bfr(sigm(acc[m][n][r] + P.b_gate[(size_t)l * 3072 + br * 1024 + 256 * pn + c])); }
        const bf16_t* A = br == 0 ? B0 : (br == 1 ? B0 + 512 : B1); const bf16_t* Bt = br == 0 ? WAB : (br == 1 ? WAB + 512 : WC);
        nv_gemm_acc(A + (size_t)row0 * 1024, 1024, Bt + (size_t)256 * pn * 1024, 1024, 512, acc);
#pragma unroll
        for (int m = 0; m < 4; ++m)
#pragma unroll
            for (int n = 0; n < 4; ++n)
#pragma unroll
                for (int r = 0; r < 4; ++r) { const int s = ((m * 4 + n) * 4 + r) * 256 + tid; const float v = G[s] * acc[m][n][r]; MGs[s] = bfr(br == 0 ? v : MGs[s] + v); }
    }
    bf16_t* MG = (bf16_t*)(P.ws + WS_MG);
#pragma unroll
    for (int m = 0; m < 4; ++m)
#pragma unroll
        for (int n = 0; n < 4; ++n)
#pragma unroll
            for (int r = 0; r < 4; ++r) MG[(size_t)(row0 + 16 * m + 4 * fq + r) * 1024 + 256 * pn + 64 * w + 16 * n + fr] = f2bf(MGs[((m * 4 + n) * 4 + r) * 256 + tid]);
}

__global__ void __launch_bounds__(256) nv_out(Ptrs P, int l, const float* xin, float* xout) {
    const int pn = blockIdx.x, row0 = blockIdx.y * 64, tid = threadIdx.x, w = tid >> 6, ln = tid & 63, fr = ln & 15, fq = ln >> 4;
    const bf16_t* MG = (const bf16_t*)(P.ws + WS_MG); const bf16_t* WO = (const bf16_t*)(P.ws + WS_W + (size_t)l * W_LAYER + WO_WO);
    f32x4 acc[4][4];
    nv_gemm_acc(MG + (size_t)row0 * 1024, 1024, WO + (size_t)256 * pn * 1024, 1024, 1024, acc);
#pragma unroll
    for (int m = 0; m < 4; ++m)
#pragma unroll
        for (int n = 0; n < 4; ++n)
#pragma unroll
            for (int r = 0; r < 4; ++r) { const size_t o = (size_t)(row0 + 16 * m + 4 * fq + r) * D + 256 * pn + 64 * w + 16 * n + fr; xout[o] = xin[o] + acc[m][n][r]; }
}


#define LAS __attribute__((address_space(3)))
#define GAS __attribute__((address_space(1)))
__device__ __forceinline__ float wsum(float v) {
    v += __builtin_bit_cast(float, __builtin_amdgcn_update_dpp(0, __builtin_bit_cast(int, v), 0xB1, 0xF, 0xF, true));
    v += __builtin_bit_cast(float, __builtin_amdgcn_update_dpp(0, __builtin_bit_cast(int, v), 0x4E, 0xF, 0xF, true));
    v += __builtin_bit_cast(float, __builtin_amdgcn_update_dpp(0, __builtin_bit_cast(int, v), 0x141, 0xF, 0xF, true));
    v += __builtin_bit_cast(float, __builtin_amdgcn_update_dpp(0, __builtin_bit_cast(int, v), 0x140, 0xF, 0xF, true));
    const int iv = __builtin_bit_cast(int, v);
    return (__builtin_bit_cast(float, __builtin_amdgcn_readlane(iv, 0)) + __builtin_bit_cast(float, __builtin_amdgcn_readlane(iv, 16))) + (__builtin_bit_cast(float, __builtin_amdgcn_readlane(iv, 32)) + __builtin_bit_cast(float, __builtin_amdgcn_readlane(iv, 48)));
}
typedef GAS unsigned gu32;
#define RLX_AGENT __ATOMIC_RELAXED, __HIP_MEMORY_SCOPE_AGENT
#define LDS_WAIT() asm volatile("s_waitcnt lgkmcnt(0)" ::: "memory")
#define VM_WAIT() asm volatile("s_waitcnt vmcnt(0)" ::: "memory")
constexpr int NWAVES = 8;
constexpr int RING_OFF = 0, RING_BYTES = 131072;
constexpr int LDS_BYTES = 163840;
constexpr int LDSCTL_OFF = LDS_BYTES - 512, MISC_OFF = LDSCTL_OFF + 320;
constexpr int RT_OFF = LDSCTL_OFF - 1024;
constexpr int CW_TMO = 0, CW_CODE = 1, CW_BAR = 4096;
constexpr float SKIP_L2 = 160.f;
constexpr int NPH = 10;

__device__ __forceinline__ unsigned cvt_pk_bf16(float lo, float hi) { unsigned r; asm volatile("v_cvt_pk_bf16_f32 %0, %1, %2" : "=v"(r) : "v"(lo), "v"(hi)); return r; }
__device__ __forceinline__ float fsigm(float x) { return __builtin_amdgcn_rcpf(1.f + __builtin_amdgcn_exp2f(-LOG2E * x)); }
__device__ __forceinline__ u32x4 pack8(const f32x4& a, const f32x4& b) { u32x4 w; w.x = cvt_pk_bf16(a[0], a[1]); w.y = cvt_pk_bf16(a[2], a[3]); w.z = cvt_pk_bf16(b[0], b[1]); w.w = cvt_pk_bf16(b[2], b[3]); return w; }
__device__ __forceinline__ void unpack8(const u32x4& w, f32x4& a, f32x4& b) {
    a[0] = __uint_as_float(w.x << 16); a[1] = __uint_as_float(w.x & 0xffff0000u); a[2] = __uint_as_float(w.y << 16); a[3] = __uint_as_float(w.y & 0xffff0000u);
    b[0] = __uint_as_float(w.z << 16); b[1] = __uint_as_float(w.z & 0xffff0000u); b[2] = __uint_as_float(w.w << 16); b[3] = __uint_as_float(w.w & 0xffff0000u); }

namespace pg8 {
constexpr int BM = 256, BK = 64, HALF = 128, HTB = HALF * BK * 2, STAGE_BYTES = 8 * HTB, NXCD = 8, WGM = 8, PITCH = 1024;
__host__ __device__ __forceinline__ int lds_byte(int r, int c) { const int st = (r >> 4) * 2 + (c >> 5), rr = r & 15, cc = c & 31, ob = rr * 64 + cc * 2; return st * 1024 + (ob ^ (((ob >> 9) & 1) << 5)); }
__host__ __device__ __forceinline__ void stage_rc(int b, int& R, int& C) { const int st = b / 1024, sb = b % 1024, swz = sb ^ (((sb >> 9) & 1) << 5); R = (st >> 1) * 16 + swz / 64; C = (st & 1) * 32 + (swz % 64) / 2; }
__host__ __device__ __forceinline__ int perm32(int rho) { const int n = rho >> 4, i = rho & 15; return 8 * (i >> 2) + 4 * n + (i & 3); }

struct Unit { const char* A; const char* B; int nt, pm, pn, tag; };

struct TileOrder {
    int nM, nN, nwg, G, c;
    __device__ __forceinline__ void init(int Mr, int N, int G_, int c_) { nM = Mr / BM; nN = N / BM; nwg = nM * nN; G = G_; c = c_; }
    __device__ __forceinline__ bool tile(int i, int& pm, int& pn) const {
        const long L = (long)i * G + c; if (L >= nwg) return false;
        int wgid = (int)L; { const int q = nwg / NXCD, r = nwg % NXCD, xcd = wgid % NXCD, off = wgid / NXCD; wgid = (xcd < r ? xcd * (q + 1) : r * (q + 1) + (xcd - r) * q) + off; }
        const int nig = WGM * nN, gid = wgid / nig, fm = gid * WGM, gsz = (nM - fm) < WGM ? (nM - fm) : WGM;
        pm = fm + ((wgid % nig) % gsz); pn = (wgid % nig) / gsz; return true;
    }
};

template <class Epi, class Sched>
__device__ __forceinline__ void gemm_phase(LAS unsigned char* lds, const Sched& S, const Epi& E) {
    int tid = threadIdx.x; asm volatile("" : "+v"(tid));
    const int wid = __builtin_amdgcn_readfirstlane(tid >> 6), lane = tid & 63, wr = wid >> 2, wc = wid & 3, fr = lane & 15, fq = lane >> 4;
    unsigned voffA[2], voffB[2];
#pragma unroll
    for (int i = 0; i < 2; ++i) { int R, C; stage_rc(tid * 16 + i * 8192, R, C); const int Rb = (R & ~31) + perm32(R & 31);
        voffA[i] = (unsigned)(R * PITCH + C) * 2u; voffB[i] = (unsigned)(Rb * PITCH + C) * 2u; }
    const size_t kstep = (size_t)(BK * 2);
    const size_t hstep = (size_t)HALF * PITCH * 2;
    const unsigned ldsw = (unsigned)wid * 1024u;
    const int aoff = lds_byte(wr * 64 + fr, fq * 8), boff = lds_byte(wc * 32 + fr, fq * 8);
#define PG8_SA(b, h) (((b) * 2 + (h)) * HTB)
#define PG8_SB(b, h) ((4 + (b) * 2 + (h)) * HTB)
#define PG8_STAGE(bufoff, gbase, voff) do { _Pragma("unroll") for (int _i = 0; _i < 2; ++_i) \
        __builtin_amdgcn_global_load_lds((const unsigned*)((const char*)(gbase) + (voff)[_i]), (LAS unsigned*)(lds + (bufoff) + ldsw + _i * 8192), 16, 0, 0); } while (0)
#define PG8_LDA(dst, b, h) do { _Pragma("unroll") for (int m = 0; m < 4; ++m) _Pragma("unroll") for (int k = 0; k < 2; ++k) dst[m][k] = *(const LAS bf16x8*)(lds + PG8_SA(b, h) + aoff + m * 2048 + k * 1024); } while (0)
#define PG8_LDB(dst, b, h) do { _Pragma("unroll") for (int n = 0; n < 2; ++n) _Pragma("unroll") for (int k = 0; k < 2; ++k) dst[n][k] = *(const LAS bf16x8*)(lds + PG8_SB(b, h) + boff + n * 2048 + k * 1024); } while (0)
#define PG8_MMA(ai, bj, At, Bt) do { __builtin_amdgcn_s_setprio(1); _Pragma("unroll") for (int m = 0; m < 4; ++m) _Pragma("unroll") for (int n = 0; n < 2; ++n) _Pragma("unroll") for (int k = 0; k < 2; ++k) \
        acc[ai][bj][m][n] = __builtin_amdgcn_mfma_f32_16x16x32_bf16(Bt[n][k], At[m][k], acc[ai][bj][m][n], 0, 0, 0); __builtin_amdgcn_s_setprio(0); } while (0)
#define PG8_WAIT_V(n) asm volatile("s_waitcnt vmcnt(" #n ")" ::: "memory")
#define PG8_WAIT_L(n) asm volatile("s_waitcnt lgkmcnt(" #n ")" ::: "memory")
#define PG8_BAR __builtin_amdgcn_s_barrier()
#define PG8_SCHED __builtin_amdgcn_sched_barrier(0)
    Unit cur, nxt; int ui = 0;
    if (!S.next(0, cur)) return;
    f32x4 acc[2][2][4][2];
#pragma unroll
    for (int a = 0; a < 2; ++a)
#pragma unroll
        for (int b = 0; b < 2; ++b)
#pragma unroll
            for (int m = 0; m < 4; ++m)
#pragma unroll
                for (int n = 0; n < 2; ++n) acc[a][b][m][n] = (f32x4){0.f, 0.f, 0.f, 0.f};
    bf16x8 At[4][2], B0[2][2], B1[2][2];
    const char* cA = cur.A; const char* cB = cur.B;
    PG8_STAGE(PG8_SB(0, 0), cB, voffB); PG8_STAGE(PG8_SB(0, 1), cB + hstep, voffB); PG8_STAGE(PG8_SA(0, 0), cA, voffA); PG8_STAGE(PG8_SA(0, 1), cA + hstep, voffA);
    if (wr == 1) PG8_BAR;
    PG8_WAIT_V(2); PG8_BAR;
    PG8_STAGE(PG8_SB(1, 0), cB + kstep, voffB); PG8_STAGE(PG8_SA(1, 0), cA + kstep, voffA); PG8_STAGE(PG8_SB(1, 1), cB + hstep + kstep, voffB);
    PG8_WAIT_V(6); PG8_BAR;
    for (;;) {
        const bool has_next = S.next(ui + 1, nxt);
        const char* nA = has_next ? nxt.A : cA; const char* nB = has_next ? nxt.B : cB;
        const int nt = cur.nt;
        for (int t = 0; t < nt; t += 2) {
            const bool last = (t == nt - 2);
            const char* a1 = cA + (size_t)(t + 1) * kstep;
            const char* a2 = last ? nA : cA + (size_t)(t + 2) * kstep; const char* b2 = last ? nB : cB + (size_t)(t + 2) * kstep;
            const char* a3 = a2 + kstep; const char* b3 = b2 + kstep;
            PG8_LDB(B0, 0, 0); PG8_LDB(B1, 0, 1); PG8_SCHED; PG8_LDA(At, 0, 0); PG8_STAGE(PG8_SA(1, 1), a1 + hstep, voffA);
            PG8_WAIT_V(8); PG8_WAIT_L(0); PG8_BAR; PG8_MMA(0, 0, At, B0); PG8_MMA(0, 1, At, B1); PG8_BAR; PG8_SCHED;
            PG8_LDA(At, 0, 1); PG8_STAGE(PG8_SB(0, 0), b2, voffB); PG8_STAGE(PG8_SB(0, 1), b2 + hstep, voffB); PG8_STAGE(PG8_SA(0, 0), a2, voffA);
            PG8_WAIT_V(8); PG8_WAIT_L(0); PG8_BAR; PG8_MMA(1, 0, At, B0); PG8_MMA(1, 1, At, B1); PG8_BAR; PG8_SCHED;
            PG8_LDB(B0, 1, 0); PG8_LDB(B1, 1, 1); PG8_SCHED; PG8_LDA(At, 1, 0); PG8_STAGE(PG8_SA(0, 1), a2 + hstep, voffA);
            PG8_WAIT_V(8); PG8_WAIT_L(0); PG8_BAR; PG8_MMA(0, 0, At, B0); PG8_MMA(0, 1, At, B1); PG8_BAR; PG8_SCHED;
            PG8_LDA(At, 1, 1); PG8_STAGE(PG8_SB(1, 0), b3, voffB); PG8_STAGE(PG8_SB(1, 1), b3 + hstep, voffB); PG8_STAGE(PG8_SA(1, 0), a3, voffA);
            PG8_WAIT_V(8); PG8_WAIT_L(0); PG8_BAR; PG8_MMA(1, 0, At, B0); PG8_MMA(1, 1, At, B1); PG8_BAR; PG8_SCHED;
        }
        if (wr == 0) PG8_BAR;
        E(acc, cur, wr, wc, fr, fq);
        if (!has_next) break;
#pragma unroll
        for (int a = 0; a < 2; ++a)
#pragma unroll
            for (int b = 0; b < 2; ++b)
#pragma unroll
                for (int m = 0; m < 4; ++m)
#pragma unroll
                    for (int n = 0; n < 2; ++n) acc[a][b][m][n] = (f32x4){0.f, 0.f, 0.f, 0.f};
        cur = nxt; cA = nA; cB = nB; ++ui;
        if (wr == 1) PG8_BAR;
    }
    PG8_WAIT_V(0);
    PG8_BAR;
    E.after(acc, cur, lds, wr, wc, fr, fq);
#undef PG8_SA
#undef PG8_SB
#undef PG8_STAGE
#undef PG8_LDA
#undef PG8_LDB
#undef PG8_MMA
#undef PG8_WAIT_V
#undef PG8_WAIT_L
#undef PG8_BAR
#undef PG8_SCHED
}

struct EpiG1 {
    bf16_t *B0, *B1, *B2, *B3, *B4; float* vss; const float *gq, *gk; const LAS float* R;
    __device__ __forceinline__ void after(f32x4 (&)[2][2][4][2], const Unit&, LAS unsigned char*, int, int, int, int) const {}
    __device__ __forceinline__ void operator()(f32x4 (&acc)[2][2][4][2], const Unit& u, int wr, int wc, int fr, int fq) const {
        const int j = u.pn; const size_t rowb = (size_t)u.pm * BM + wr * 64 + fr; const int cl = 32 * wc + 8 * fq;
#pragma unroll
        for (int ai = 0; ai < 2; ++ai)
#pragma unroll
            for (int m = 0; m < 4; ++m) { const float rs = R[ai * HALF + wr * 64 + m * 16 + fr];
#pragma unroll
                for (int bj = 0; bj < 2; ++bj) { acc[ai][bj][m][0] *= rs; acc[ai][bj][m][1] *= rs; } }
        if (j < 4) {
#pragma unroll
            for (int ai = 0; ai < 2; ++ai)
#pragma unroll
                for (int m = 0; m < 4; ++m) { f32x4 o0, o1;
#pragma unroll
                    for (int e = 0; e < 4; ++e) { o0[e] = acc[ai][0][m][0][e] * fsigm(acc[ai][1][m][0][e]); o1[e] = acc[ai][0][m][1][e] * fsigm(acc[ai][1][m][1][e]); }
                    *(u32x4*)(B3 + (rowb + ai * HALF + m * 16) * 1024 + 128 * j + cl) = pack8(o0, o1); }
        } else if (j < 12 || j >= 16) {
            bf16_t* dst; int pitch, coff; bool act;
            if (j < 6) { dst = B0; pitch = 1024; coff = 256 * (j - 4); act = true; }
            else if (j < 8) { dst = B0; pitch = 1024; coff = 512 + 256 * (j - 6); act = false; }
            else if (j < 10) { dst = B3; pitch = 1024; coff = 512 + 256 * (j - 8); act = false; }
            else if (j < 12) { dst = B4; pitch = 512; coff = 256 * (j - 10); act = true; }
            else if (j < 18) { dst = B2; pitch = 1024; coff = 256 * (j - 16); act = false; }
            else { dst = B2; pitch = 1024; coff = 512 + 256 * (j - 18); act = true; }
            const bool stat = (j == 8 || j == 9);
#pragma unroll
            for (int ai = 0; ai < 2; ++ai)
#pragma unroll
                for (int m = 0; m < 4; ++m) { const size_t row = rowb + ai * HALF + m * 16; float s = 0.f;
#pragma unroll
                    for (int bj = 0; bj < 2; ++bj) { f32x4 v0 = acc[ai][bj][m][0], v1 = acc[ai][bj][m][1];
                        if (act) {
#pragma unroll
                            for (int e = 0; e < 4; ++e) { v0[e] = v0[e] * fsigm(v0[e]); v1[e] = v1[e] * fsigm(v1[e]); } }
                        s += (v0[0] * v0[0] + v0[1] * v0[1]) + (v0[2] * v0[2] + v0[3] * v0[3]) + (v1[0] * v1[0] + v1[1] * v1[1]) + (v1[2] * v1[2] + v1[3] * v1[3]);
                        *(u32x4*)(dst + row * pitch + coff + 128 * bj + cl) = pack8(v0, v1); }
                    if (stat) { s += __shfl_xor(s, 16); s += __shfl_xor(s, 32); if (fq == 0) vss[row * 8 + (j - 8) * 4 + wc] = s; } }
        } else {
            const bool isk = j >= 14; const int jj = (j - 12) & 1; const float* g = isk ? gk : gq; const float sc = isk ? 1.f : C2;
            f32x4 gv[2][2];
#pragma unroll
            for (int bj = 0; bj < 2; ++bj) { gv[bj][0] = *(const f32x4*)(g + 32 * bj + 8 * fq) * sc; gv[bj][1] = *(const f32x4*)(g + 32 * bj + 8 * fq + 4) * sc; }
            bf16_t* dst = B1 + (isk ? 512 : 0) + 64 * (4 * jj + wc) + 8 * fq;
#pragma unroll
            for (int ai = 0; ai < 2; ++ai)
#pragma unroll
                for (int m = 0; m < 4; ++m) { const size_t row = rowb + ai * HALF + m * 16; float s = 0.f;
#pragma unroll
                    for (int bj = 0; bj < 2; ++bj) { const f32x4 v0 = acc[ai][bj][m][0], v1 = acc[ai][bj][m][1];
                        s += (v0[0] * v0[0] + v0[1] * v0[1]) + (v0[2] * v0[2] + v0[3] * v0[3]) + (v1[0] * v1[0] + v1[1] * v1[1]) + (v1[2] * v1[2] + v1[3] * v1[3]); }
                    s += __shfl_xor(s, 16); s += __shfl_xor(s, 32);
                    const float r = __builtin_amdgcn_rsqf(s * (1.f / 64.f) + EPS);
#pragma unroll
                    for (int bj = 0; bj < 2; ++bj) *(u32x4*)(dst + row * 1024 + 32 * bj) = pack8(acc[ai][bj][m][0] * r * gv[bj][0], acc[ai][bj][m][1] * r * gv[bj][1]); }
        }
    }
};
struct EpiMerge {
    unsigned char* gt; bf16_t* MG; const float* bgate; const LAS float* R;
    __device__ __forceinline__ void after(f32x4 (&)[2][2][4][2], const Unit&, LAS unsigned char*, int, int, int, int) const {}
    __device__ __forceinline__ void operator()(f32x4 (&acc)[2][2][4][2], const Unit& u, int wr, int wc, int fr, int fq) const {
        const int tag = u.tag, br = tag >> 1; const size_t rowb = (size_t)u.pm * BM + wr * 64 + fr; const int col0 = u.pn * BM + 32 * wc + 8 * fq;
        u32x4* slots_ = (u32x4*)gt + ((wr * 4 + wc) * 64 + fq * 16 + fr); asm volatile("" : "+v"(slots_)); __attribute__((address_space(1))) u32x4* slots = (__attribute__((address_space(1))) u32x4*)slots_;
        if ((tag & 1) == 0) {
            f32x4 bv[2][2];
#pragma unroll
            for (int bj = 0; bj < 2; ++bj) { bv[bj][0] = *(const f32x4*)(bgate + br * 1024 + col0 + 128 * bj); bv[bj][1] = *(const f32x4*)(bgate + br * 1024 + col0 + 128 * bj + 4); }
#pragma unroll
            for (int ai = 0; ai < 2; ++ai)
#pragma unroll
                for (int m = 0; m < 4; ++m)
#pragma unroll
                    for (int bj = 0; bj < 2; ++bj) { const float rs = R[ai * HALF + wr * 64 + m * 16 + fr]; f32x4 v0 = acc[ai][bj][m][0] * rs + bv[bj][0], v1 = acc[ai][bj][m][1] * rs + bv[bj][1];
#pragma unroll
                        for (int e = 0; e < 4; ++e) { v0[e] = fsigm(v0[e]); v1[e] = fsigm(v1[e]); }
                        slots[(size_t)(((ai * 4 + m) * 2 + bj) * 512)] = pack8(v0, v1); }
        } else {
#pragma unroll
            for (int ai = 0; ai < 2; ++ai)
#pragma unroll
                for (int m = 0; m < 4; ++m) {
#pragma unroll
                    for (int bj = 0; bj < 2; ++bj) { const u32x4 gw = slots[(size_t)(((ai * 4 + m) * 2 + bj) * 512)]; f32x4 g0, g1; unpack8(gw, g0, g1);
                        f32x4 v0 = g0 * acc[ai][bj][m][0], v1 = g1 * acc[ai][bj][m][1];
                        u32x4* p = (u32x4*)(MG + (rowb + ai * HALF + m * 16) * 1024 + col0 + 128 * bj);
                        if (br > 0) { const u32x4 ow = *p; f32x4 p0, p1; unpack8(ow, p0, p1); v0 += p0; v1 += p1; }
                        *p = pack8(v0, v1); }
                    if (m & 1) asm volatile("" ::: "memory"); }
        }
    }
};
struct EpiOut {
    const float* base; float* out;
    __device__ __forceinline__ void after(f32x4 (&)[2][2][4][2], const Unit&, LAS unsigned char*, int, int, int, int) const {}
    __device__ __forceinline__ void operator()(f32x4 (&acc)[2][2][4][2], const Unit& u, int wr, int wc, int fr, int fq) const {
        const size_t rowb = (size_t)u.pm * BM + wr * 64 + fr; const int col0 = u.pn * BM + 32 * wc + 8 * fq;
#pragma unroll
        for (int ai = 0; ai < 2; ++ai)
#pragma unroll
            for (int m = 0; m < 4; ++m) {
#pragma unroll
                for (int bj = 0; bj < 2; ++bj) { const size_t o = (rowb + ai * HALF + m * 16) * D + col0 + 128 * bj;
                    const f32x4 b0 = *(const f32x4*)(base + o), b1 = *(const f32x4*)(base + o + 4);
                    *(f32x4*)(out + o) = b0 + acc[ai][bj][m][0]; *(f32x4*)(out + o + 4) = b1 + acc[ai][bj][m][1]; }
                if (m & 1) asm volatile("" ::: "memory"); }
    }
};
struct EpiOutLN {
    const float* base; float* out; bf16_t* XG; const float* gnext; const float* wfnext; float* SSP; float* FP;
    __device__ __forceinline__ void operator()(f32x4 (&)[2][2][4][2], const Unit&, int, int, int, int) const {}
    __device__ __forceinline__ void after(f32x4 (&acc)[2][2][4][2], const Unit& u, LAS unsigned char* lds, int wr, int wc, int fr, int fq) const {
        const int tid = ((wr * 4 + wc) * 64) + fq * 16 + fr;
        const size_t rowb = (size_t)u.pm * BM + wr * 64 + fr; const int cl = 32 * wc + 8 * fq, col0 = u.pn * BM + cl;
        LAS float* FL = (LAS float*)lds;
        LAS float* WL = (LAS float*)(lds + 512 * 72 * 4);
        for (int i = tid; i < 256 * 8; i += 512) { const int c = i >> 3, e = i & 7; WL[i] = gnext[u.pn * BM + c] * wfnext[(size_t)(u.pn * BM + c) * NIN + e]; }
        f32x4 gv[2][2];
#pragma unroll
        for (int bj = 0; bj < 2; ++bj) { gv[bj][0] = *(const f32x4*)(gnext + col0 + 128 * bj); gv[bj][1] = *(const f32x4*)(gnext + col0 + 128 * bj + 4); }
#pragma unroll
        for (int ai = 0; ai < 2; ++ai)
#pragma unroll
            for (int m = 0; m < 4; ++m) { float ss = 0.f;
#pragma unroll
                for (int bj = 0; bj < 2; ++bj) { const size_t o = (rowb + ai * HALF + m * 16) * D + col0 + 128 * bj;
                    const f32x4 x0 = *(const f32x4*)(base + o) + acc[ai][bj][m][0], x1 = *(const f32x4*)(base + o + 4) + acc[ai][bj][m][1];
                    *(f32x4*)(out + o) = x0; *(f32x4*)(out + o + 4) = x1;
                    ss += (x0[0] * x0[0] + x0[1] * x0[1]) + (x0[2] * x0[2] + x0[3] * x0[3]) + (x1[0] * x1[0] + x1[1] * x1[1]) + (x1[2] * x1[2] + x1[3] * x1[3]);
                    const f32x4 h0 = x0 * gv[bj][0], h1 = x1 * gv[bj][1];
                    *(u32x4*)(XG + o) = pack8(h0, h1);
                    acc[ai][bj][m][0] = x0; acc[ai][bj][m][1] = x1; }
                FL[tid * 72 + 64 + ai * 4 + m] = ss;
                if (m & 1) asm volatile("" ::: "memory"); }
        asm volatile("s_waitcnt lgkmcnt(0)" ::: "memory"); __builtin_amdgcn_s_barrier(); asm volatile("" ::: "memory");
#pragma unroll
        for (int hh = 0; hh < 2; ++hh) {
            f32x4 f[8];
#pragma unroll
            for (int rg = 0; rg < 8; ++rg) f[rg] = (f32x4){0.f, 0.f, 0.f, 0.f};
#pragma unroll
            for (int bj = 0; bj < 2; ++bj)
#pragma unroll
                for (int n = 0; n < 2; ++n)
#pragma unroll
                    for (int i = 0; i < 4; ++i) { const f32x4 wv = *(const LAS f32x4*)(WL + (128 * bj + cl + 4 * n + i) * 8 + 4 * hh);
#pragma unroll
                        for (int ai = 0; ai < 2; ++ai)
#pragma unroll
                            for (int m = 0; m < 4; ++m) f[ai * 4 + m] += acc[ai][bj][m][n][i] * wv; }
#pragma unroll
            for (int rg = 0; rg < 8; ++rg) *(LAS f32x4*)(FL + tid * 72 + rg * 8 + 4 * hh) = f[rg];
            asm volatile("" ::: "memory");
        }
        asm volatile("s_waitcnt lgkmcnt(0)" ::: "memory"); __builtin_amdgcn_s_barrier(); asm volatile("" ::: "memory");
        { const int row = tid & 255, hb = (tid >> 8) * 4, ai_ = row >> 7, wr_ = (row >> 6) & 1, m_ = (row >> 4) & 3, fr_ = row & 15, rg = ai_ * 4 + m_;
          f32x4 sum = (f32x4){0.f, 0.f, 0.f, 0.f}; float ssum = 0.f;
#pragma unroll
          for (int wc_ = 0; wc_ < 4; ++wc_)
#pragma unroll
              for (int fq_ = 0; fq_ < 4; ++fq_) { const LAS float* src = FL + (((wr_ * 4 + wc_) * 64) + fq_ * 16 + fr_) * 72; sum += *(const LAS f32x4*)(src + rg * 8 + hb); ssum += src[64 + rg]; }
          const size_t grow = (size_t)u.pm * BM + row;
          *(f32x4*)(FP + (grow * 4 + u.pn) * 8 + hb) = sum;
          if (hb == 0) SSP[grow * 4 + u.pn] = ssum; }
    }
};
struct SchedG1 { TileOrder T; const char* A; const char* B;
    __device__ __forceinline__ bool next(int i, Unit& u) const { int pm, pn; if (!T.tile(i, pm, pn)) return false; u.pm = pm; u.pn = pn; u.tag = 0; u.nt = 16; u.A = A + (size_t)pm * (BM * PITCH * 2); u.B = B + (size_t)pn * (BM * PITCH * 2); return true; } };
struct SchedMerge { int pm, pn; bool ok; const char *ws, *wl;
    __device__ __forceinline__ bool next(int i, Unit& u) const { if (!ok || i >= 6) return false; const int br = i >> 1; u.pm = pm; u.pn = pn; u.tag = i;
        const size_t ro = (size_t)pm * (BM * PITCH * 2), co = (size_t)pn * (BM * PITCH * 2);
        if ((i & 1) == 0) { u.nt = 16; u.A = ws + WS_H + ro; u.B = wl + WO_WG + (size_t)br * (1024 * PITCH * 2) + co; }
        else { u.nt = 8; const size_t ao = br == 0 ? WS_B0 : (br == 1 ? WS_B0 + 1024 : WS_B1), bo = br == 0 ? WO_WAB : (br == 1 ? WO_WAB + 1024 : WO_WC); u.A = ws + ao + ro; u.B = wl + bo + co; }
        return true; } };
}

#define XB_TMO      128
#define XB_XCNT(j)  (256  + 64 * (j))
#define XB_XSUB(j)  (1280 + 64 * (j))
#define XB_XGEN(j)  (2304 + 64 * (j))
#define XB_TOP      3328
#define XB_TOPGEN   3392
#define XCD_BAR_WORDS 3456
#define XB_SPIN_CAP (1u << 18)
__device__ __forceinline__ unsigned xb_ld(unsigned* p)              { return __hip_atomic_load(p, __ATOMIC_RELAXED, __HIP_MEMORY_SCOPE_AGENT); }
__device__ __forceinline__ unsigned xb_add(unsigned* p, unsigned v) { return __hip_atomic_fetch_add(p, v, __ATOMIC_RELAXED, __HIP_MEMORY_SCOPE_AGENT); }
__device__ __forceinline__ unsigned xb_xcc_id() { return (unsigned)__builtin_amdgcn_s_getreg((3 << 11) | 20) & 0xFu; }
#define XB_SPIN(cond, bar) do { unsigned _sp = 0; while (cond) { __builtin_amdgcn_s_sleep(1); \
    if ((++_sp & 255u) == 0u) { if (xb_ld(&(bar)[XB_TMO])) break; if (_sp > XB_SPIN_CAP) { atomicAdd(&(bar)[XB_TMO], 1u); break; } } } } while (0)
struct XcdBarrier { unsigned* bar; unsigned x; volatile LAS unsigned* st; };
__device__ __forceinline__ XcdBarrier xcd_barrier_post(unsigned* bar, volatile LAS unsigned* st) {
    XcdBarrier b; b.bar = bar; b.x = xb_xcc_id(); b.st = st;
    if (threadIdx.x == 0) (void)xb_add(&bar[XB_XCNT(b.x)], 1u);
    return b;
}
__device__ __forceinline__ void xcd_barrier_complete(unsigned* bar, unsigned x, unsigned& nloc, unsigned& nx) {
    const unsigned G = gridDim.x * gridDim.y * gridDim.z;
    unsigned sum, cnt, mine, sp = 0u;
    for (;;) {
        sum = 0u; cnt = 0u; mine = 0u;
#pragma unroll
        for (unsigned j = 0; j < 16; ++j) { const unsigned c = xb_ld(&bar[XB_XCNT(j)]); sum += c; cnt += (c > 0u) ? 1u : 0u; mine = (j == x) ? c : mine; }
        if (sum == G) break;
        __builtin_amdgcn_s_sleep(1);
        if ((++sp & 255u) == 0u) { if (xb_ld(&bar[XB_TMO])) break; if (sp > XB_SPIN_CAP) { atomicAdd(&bar[XB_TMO], 1u); break; } }
    }
    nloc = mine > 0u ? mine : 1u; nx = cnt > 0u ? cnt : 1u;
}
__device__ __forceinline__ void xcd_barrier(const XcdBarrier& b) {
    asm volatile("s_waitcnt vmcnt(0)" ::: "memory");
    __syncthreads();
    if (threadIdx.x == 0) {
        unsigned* bar = b.bar;
        __builtin_amdgcn_s_waitcnt(0);
        unsigned nloc = b.st[0], nx = b.st[1];
        if (nloc == 0u) { xcd_barrier_complete(bar, b.x, nloc, nx); b.st[0] = nloc; b.st[1] = nx; }
        const unsigned old = xb_add(&bar[XB_XSUB(b.x)], 1u);
        const unsigned gen = old / nloc;
        if (old + 1u == (gen + 1u) * nloc) {
            __builtin_amdgcn_fence(__ATOMIC_RELEASE, "agent");
            asm volatile("s_waitcnt vmcnt(0)" ::: "memory");
            const unsigned og = xb_add(&bar[XB_TOP], 1u);
            const unsigned tg = og / nx;
            if (og + 1u == (tg + 1u) * nx) xb_add(&bar[XB_TOPGEN], 1u);
            else XB_SPIN(xb_ld(&bar[XB_TOPGEN]) == tg, bar);
            __builtin_amdgcn_fence(__ATOMIC_ACQUIRE, "agent");
            xb_add(&bar[XB_XGEN(b.x)], 1u);
            asm volatile("s_waitcnt vmcnt(0)" ::: "memory");
        } else {
            XB_SPIN(xb_ld(&bar[XB_XGEN(b.x)]) == gen, bar);
            __builtin_amdgcn_fence(__ATOMIC_ACQUIRE, "agent");
            asm volatile("s_waitcnt vmcnt(0)" ::: "memory");
        }
    }
    __syncthreads();
}

struct Args { const float* in[18]; float* out; unsigned char* ws; int ph_lo, ph_hi, li, pad; };
struct Frame { LAS unsigned char* lds; int tid, lane, wave, vcu, G; Ptrs P; };

__device__ __forceinline__ unsigned pk2(float lo, float hi) { return (unsigned)f2bf(lo) | ((unsigned)f2bf(hi) << 16); }
__device__ __forceinline__ void p0_transpose_item(const float* W, int ldw, int src_col, int k0, bf16_t* WT, size_t dst_row, int dst_col, LAS float* scr, int lane) {
#pragma unroll 8
    for (int i = 0; i < 32; ++i) { const int kk = 2 * i + (lane >> 5); scr[kk * 33 + (lane & 31)] = W[(size_t)(k0 + kk) * ldw + src_col + (lane & 31)]; }
    LDS_WAIT(); asm volatile("" ::: "memory");
    const int c = lane & 7;
#pragma unroll
    for (int j = 0; j < 4; ++j) { const int n = (lane >> 3) + 8 * j; const LAS float* s = scr + (8 * c) * 33 + n;
        u32x4 o; o.x = pk2(s[0 * 33], s[1 * 33]); o.y = pk2(s[2 * 33], s[3 * 33]); o.z = pk2(s[4 * 33], s[5 * 33]); o.w = pk2(s[6 * 33], s[7 * 33]);
        *(GAS u32x4*)(WT + (dst_row + n) * 1024 + dst_col + k0 + 8 * c) = o; }
    LDS_WAIT(); asm volatile("" ::: "memory");
}
__device__ __forceinline__ void p0_weights(Frame& F) {
    LAS float* scr = (LAS float*)(F.lds + RING_OFF + F.wave * 16384);
    const int gw = F.vcu * NWAVES + F.wave, NGW = F.G * NWAVES;
    constexpr int I_W1 = 16 * (N1 / 32), I_WG = 16 * 96, I_Y = 8 * 32, I_WO = 16 * 32, I_L = I_W1 + I_WG + 3 * I_Y + I_WO;
    for (int it = gw; it < NL * I_L; it += NGW) {
        const int l = it / I_L; int r = it % I_L;
        unsigned char* wl = F.P.ws + WS_W + (size_t)l * W_LAYER; const float* win = F.P.w_in + (size_t)l * D * NIN;
        if (r < I_W1) { const int kb = r / (N1 / 32), nb = r % (N1 / 32); p0_transpose_item(win, NIN, g1_col(32 * nb), 64 * kb, (bf16_t*)(wl + WO_W1), 32 * nb, 0, scr, F.lane); continue; } r -= I_W1;
        if (r < I_WG) { const int kb = r / 96, nb = r % 96; p0_transpose_item(win, NIN, 32 * nb, 64 * kb, (bf16_t*)(wl + WO_WG), 32 * nb, 0, scr, F.lane); continue; } r -= I_WG;
        if (r < I_Y) { const int kb = r / 32, nb = r % 32; p0_transpose_item(F.P.w_a + (size_t)l * DA * D, D, 32 * nb, 64 * kb, (bf16_t*)(wl + WO_WAB), 32 * nb, 0, scr, F.lane); continue; } r -= I_Y;
        if (r < I_Y) { const int kb = r / 32, nb = r % 32; p0_transpose_item(F.P.w_b + (size_t)l * DB * D, D, 32 * nb, 64 * kb, (bf16_t*)(wl + WO_WAB), 32 * nb, 512, scr, F.lane); continue; } r -= I_Y;
        if (r < I_Y) { const int kb = r / 32, nb = r % 32; p0_transpose_item(F.P.w_c + (size_t)l * DC * D, D, 32 * nb, 64 * kb, (bf16_t*)(wl + WO_WC), 32 * nb, 0, scr, F.lane); continue; } r -= I_Y;
        { const int kb = r / 32, nb = r % 32; p0_transpose_item(F.P.w_out + (size_t)l * D * D, D, 32 * nb, 64 * kb, (bf16_t*)(wl + WO_WO), 32 * nb, 0, scr, F.lane); }
    }
    bf16_t* WSB = (bf16_t*)(F.P.ws + WS_WSB);
    for (int i = (int)blockIdx.x * 512 + F.tid; i < NL * NG * CHK * CHK; i += F.G * 512) { const int s = i & 127, t = (i >> 7) & 127; WSB[i] = s <= t ? f2bf(F.P.w_s[i]) : (bf16_t)0; }
}
__device__ __forceinline__ void p0_ln(Frame& F, int l, const float* xin) {
    LAS float* wf = (LAS float*)(F.lds + RING_OFF);
    const float* g = F.P.norm_g + (size_t)l * D; const float* win = F.P.w_in + (size_t)l * D * NIN;
    __syncthreads();
    for (int i = F.tid; i < D * 8; i += 512) { const int k = i >> 3, e = i & 7; wf[i] = g[k] * win[(size_t)k * NIN + OC_F + e]; }
    __syncthreads();
    const int gw = F.vcu * NWAVES + F.wave, NGW = F.G * NWAVES;
    bf16_t* H = (bf16_t*)(F.P.ws + WS_H); float* LOGF = (float*)(F.P.ws + WS_LOGF);
    f32x4 gv[4];
#pragma unroll
    for (int j = 0; j < 4; ++j) gv[j] = ((const f32x4*)g)[64 * j + F.lane];
    static_assert(M == 8 * 256 * NWAVES, "p0_ln: 8 rows per wave on a 256-workgroup grid");
    float zrow[8];
#pragma unroll
    for (int k = 0; k < 8; ++k) zrow[k] = 0.f;
    f32x4 v[8][4];
#pragma unroll
    for (int bt = 0; bt < 4; ++bt) {
        asm volatile("" ::: "memory");
        if ((bt & 1) == 0) {
#pragma unroll
            for (int k = 2 * bt; k < 2 * bt + 4; ++k) { const GAS f32x4* xr = (const GAS f32x4*)(xin + (size_t)(gw + k * NGW) * D) + F.lane;
#pragma unroll
                for (int j = 0; j < 4; ++j) v[k][j] = xr[64 * j]; }
            asm volatile("" ::: "memory"); }
        float r[2]; float f[2][8];
#pragma unroll
        for (int q = 0; q < 2; ++q) { float ss = 0.f;
#pragma unroll
            for (int j = 0; j < 4; ++j) { const f32x4 x = v[2 * bt + q][j]; ss += (x.x * x.x + x.y * x.y) + (x.z * x.z + x.w * x.w); }
            r[q] = rsqrtf(wsum(ss) * (1.f / D) + EPS);
#pragma unroll
            for (int e = 0; e < 8; ++e) f[q][e] = 0.f; }
#pragma unroll
        for (int j = 0; j < 4; ++j) {
#pragma unroll
            for (int q = 0; q < 2; ++q) { const f32x4 hv = v[2 * bt + q][j] * r[q] * gv[j];
                GAS unsigned long long* o8 = (GAS unsigned long long*)(H + (size_t)(gw + (2 * bt + q) * NGW) * D) + F.lane;
                o8[64 * j] = (unsigned long long)pk2(hv.x, hv.y) | ((unsigned long long)pk2(hv.z, hv.w) << 32); }
#pragma unroll
            for (int i = 0; i < 4; ++i) { const LAS f32x4* w4 = (const LAS f32x4*)(wf + (256 * j + 4 * F.lane + i) * 8); const f32x4 wa = w4[0], wb = w4[1];
#pragma unroll
                for (int q = 0; q < 2; ++q) { const float xv = v[2 * bt + q][j][i];
                    f[q][0] += xv * wa.x; f[q][1] += xv * wa.y; f[q][2] += xv * wa.z; f[q][3] += xv * wa.w; f[q][4] += xv * wb.x; f[q][5] += xv * wb.y; f[q][6] += xv * wb.z; f[q][7] += xv * wb.w; } }
        }
#pragma unroll
        for (int q = 0; q < 2; ++q) {
#pragma unroll
            for (int e = 0; e < 8; ++e) f[q][e] = wsum(f[q][e]);
            if (F.lane < 8) { float z = 0.f;
#pragma unroll
                for (int e = 0; e < 8; ++e) if (F.lane == e) z = f[q][e];
                zrow[2 * bt + q] = z * r[q]; } }
    }
    if (F.lane < 8) { const float bfv = F.P.b_f[l * NH + F.lane];
#pragma unroll
        for (int k = 0; k < 8; ++k) { const float z = zrow[k] + bfv; LOGF[(size_t)(gw + k * NGW) * 8 + F.lane] = fminf(z, 0.f) - log1pf(expf(-fabsf(z))); } }
    __syncthreads();
}
__device__ __forceinline__ void p1_scan(Frame& F, int bh, int l) {
    LAS float* sh = (LAS float*)(F.lds + RING_OFF);
    const int b = bh / NH, h = bh % NH, t0 = F.tid * 8;
    float c[8]; float run = 0.f;
    if (l == 0) { const float* lf = (const float*)(F.P.ws + WS_LOGF) + ((size_t)b * SEQ + t0) * 8 + h;
#pragma unroll
        for (int i = 0; i < 8; ++i) { run += lf[i * 8]; c[i] = run; }
    } else {
        const float* fp = (const float*)(F.P.ws + WS_FP) + ((size_t)b * SEQ + t0) * 32 + h; const float* sp = (const float*)(F.P.ws + WS_SSP) + ((size_t)b * SEQ + t0) * 4; const float bfv = F.P.b_f[l * NH + h];
        float z[8];
#pragma unroll
        for (int i = 0; i < 8; ++i) { const f32x4 q = *(const f32x4*)(sp + i * 4); const float r = rsqrtf(((q.x + q.y) + (q.z + q.w)) * (1.f / D) + EPS);
            z[i] = r * ((fp[i * 32] + fp[i * 32 + 8]) + (fp[i * 32 + 16] + fp[i * 32 + 24])) + bfv; }
#pragma unroll
        for (int i = 0; i < 8; ++i) { run += fminf(z[i], 0.f) - log1pf(expf(-fabsf(z[i]))); c[i] = run; }
    }
    float inc = run;
#pragma unroll
    for (int o = 1; o < 64; o <<= 1) { const float n = __shfl_up(inc, o); if (F.lane >= o) inc += n; }
    if (F.lane == 63) sh[F.wave] = inc;
    __syncthreads();
    float base = inc - run;
    for (int w = 0; w < F.wave; ++w) base += sh[w];
    float* cs = (float*)(F.P.ws + WS_CS) + (size_t)bh * SEQ + t0;
    *(f32x4*)cs = (f32x4){(base + c[0]) * LOG2E, (base + c[1]) * LOG2E, (base + c[2]) * LOG2E, (base + c[3]) * LOG2E};
    *(f32x4*)(cs + 4) = (f32x4){(base + c[4]) * LOG2E, (base + c[5]) * LOG2E, (base + c[6]) * LOG2E, (base + c[7]) * LOG2E};
    __syncthreads();
    LAS float* c2s = sh + 16;
#pragma unroll
    for (int i = 0; i < 8; ++i) c2s[t0 + i] = (base + c[i]) * LOG2E;
    __syncthreads();
    if (F.tid < SEQ / 256) { const int qb = F.tid, nt = 4 * qb + 4; const float cq = c2s[256 * qb]; int lo = 0, hi = nt - 4;
        while (lo < hi) { const int mid = (lo + hi) >> 1; if (cq - c2s[64 * mid + 63] >= -SKIP_L2) hi = mid; else lo = mid + 1; }
        ((int*)(F.P.ws + WS_TS))[bh * 16 + qb] = lo & ~1; }
    __syncthreads();
}


#include <hip/hip_bf16.h>
namespace attn_body {
using bf16=__hip_bfloat16;
using s16x4=__attribute__((ext_vector_type(4)))short;
using f32x16=__attribute__((ext_vector_type(16)))float;
constexpr int NHEAD=NH,D=64,DM=1024;
constexpr int NW=8,QBLK=32,QB=QBLK*NW,KVBLK=64,NQB=SEQ/QB;
__device__ __forceinline__ int crow(int r,int hi){return (r&3)+8*(r>>2)+4*hi;}
#define SBAR() __builtin_amdgcn_sched_barrier(0)
__device__ __forceinline__ void cmask(f32x16&p0,f32x16&p1,int jb,int qrel,int hi){
  const float NEG=-INFINITY; int kb=64*jb+4*hi;
  #pragma unroll
  for(int r=0;r<16;++r){int kv=kb+(r&3)+8*(r>>2); if(kv>qrel)p0[r]=NEG; if(kv+32>qrel)p1[r]=NEG;}
}
constexpr int NSLOT=3, SLOTB=8192;
constexpr int LDS_K=0, LDS_V=NSLOT*SLOTB, LDS_WS=2*NSLOT*SLOTB, LDS_OST=LDS_WS+NW*64*4, LDS_C2=LDS_OST+NW*4096, LDS_BYTES=LDS_C2+SEQ*4+512;
__device__ __forceinline__ void glds16(const void*gsrc,unsigned lds_dst){unsigned keep;
  asm volatile("s_mov_b32 %0, m0\n\ts_mov_b32 m0, %2\n\ts_nop 0\n\tglobal_load_lds_dwordx4 %1, off\n\ts_mov_b32 m0, %0":"=&s"(keep):"v"(gsrc),"s"(lds_dst):"memory");}
__device__ __forceinline__ float max3f(float a,float b,float c){float r;asm("v_max3_f32 %0, %1, %2, %3":"=v"(r):"v"(a),"v"(b),"v"(c));return r;}
__device__ __forceinline__ float max2f(float a,float b){float r;asm("v_max_f32_e32 %0, %1, %2":"=v"(r):"v"(a),"v"(b));return r;}
__device__ __forceinline__ float fadd_s(float a,float b){float r;asm("v_add_f32_e32 %0, %1, %2":"=v"(r):"v"(a),"v"(b));return r;}
__device__ __forceinline__ float fsub_s(float a,float b){float r;asm("v_sub_f32_e32 %0, %1, %2":"=v"(r):"v"(a),"v"(b));return r;}
typedef float f32x2_t __attribute__((ext_vector_type(2))); typedef __bf16 bf16x2_t __attribute__((ext_vector_type(2)));
__device__ __forceinline__ unsigned cvtpk_s(float lo,float hi){f32x2_t v={lo,hi};bf16x2_t b=__builtin_convertvector(v,bf16x2_t);return __builtin_bit_cast(unsigned,b);}
#define WAIT_BAR(N) asm volatile("s_waitcnt vmcnt(" #N ") lgkmcnt(0)\n\ts_barrier":::"memory")
__device__ __forceinline__ void split3(float x,unsigned&h,unsigned&m,unsigned&l){
  const unsigned u=__float_as_uint(x)&0xffff0000u; const float r1=x-__uint_as_float(u);
  const unsigned u1=__float_as_uint(r1)&0xffff0000u; const float r2=r1-__uint_as_float(u1);
  h=u>>16; m=u1>>16; l=__float_as_uint(r2)>>16; }
__device__ __forceinline__ bf16x8 make_qx(float base,int hi){ unsigned h,m,l; split3(base,h,m,l); u32x4 w; w.x=h|(m<<16); w.y=l|0x3f800000u; w.z=0x3f803f80u; w.w=0u; if(hi){w.x=0u;w.y=0u;w.z=0u;} return __builtin_bit_cast(bf16x8,w); }
__device__ __forceinline__ bf16x8 make_kx(float ck,int hi){ unsigned h,m,l; split3(-ck,h,m,l); u32x4 w; w.x=0x3f803f80u; w.y=0x3f80u|(h<<16); w.z=m|(l<<16); w.w=0u; if(hi){w.x=0u;w.y=0u;w.z=0u;} return __builtin_bit_cast(bf16x8,w); }

__device__ __forceinline__ void qkt(f32x16&p0,f32x16&p1,const char*Kslot,const bf16x8*qr,bf16x8 qx,bf16x8 kx0,bf16x8 kx1,int r32,int hi){
  const char*kb=Kslot+hi*1024+r32*16; const f32x16 z=f32x16{};
  p0=__builtin_amdgcn_mfma_f32_32x32x16_bf16(kx0,qx,z,0,0,0);p1=__builtin_amdgcn_mfma_f32_32x32x16_bf16(kx1,qx,z,0,0,0);
  #pragma unroll
  for(int d0=0;d0<4;++d0){
    const bf16x8 b0=*reinterpret_cast<const bf16x8*>(kb+d0*2048);
    const bf16x8 b1=*reinterpret_cast<const bf16x8*>(kb+d0*2048+512);
    p0=__builtin_amdgcn_mfma_f32_32x32x16_bf16(b0,qr[d0],p0,0,0,0);p1=__builtin_amdgcn_mfma_f32_32x32x16_bf16(b1,qr[d0],p1,0,0,0);}
}
typedef __attribute__((address_space(3))) const char* lds_cptr;
typedef short v4i16_t __attribute__((ext_vector_type(4)));
__device__ __forceinline__ void kload8(bf16x8*kf,lds_cptr kp){
  kf[0]=*(const __attribute__((address_space(3))) bf16x8*)(kp);      kf[1]=*(const __attribute__((address_space(3))) bf16x8*)(kp+512);
  kf[2]=*(const __attribute__((address_space(3))) bf16x8*)(kp+2048); kf[3]=*(const __attribute__((address_space(3))) bf16x8*)(kp+2560);
  kf[4]=*(const __attribute__((address_space(3))) bf16x8*)(kp+4096); kf[5]=*(const __attribute__((address_space(3))) bf16x8*)(kp+4608);
  kf[6]=*(const __attribute__((address_space(3))) bf16x8*)(kp+6144); kf[7]=*(const __attribute__((address_space(3))) bf16x8*)(kp+6656);
}
__device__ __forceinline__ void kload2(bf16x8*kf,lds_cptr kp,int j){ kf[2*j]=*(const __attribute__((address_space(3))) bf16x8*)(kp+j*2048); kf[2*j+1]=*(const __attribute__((address_space(3))) bf16x8*)(kp+j*2048+512); }
__device__ __forceinline__ s16x4 vtr(lds_cptr p){ return __builtin_bit_cast(s16x4,__builtin_amdgcn_ds_read_tr16_b64_v4i16((__attribute__((address_space(3))) v4i16_t*)p)); }
__device__ __forceinline__ float rowmax(const f32x16&p0,const f32x16&p1){
  float a=max3f(p0[0],p0[1],p1[0]),b=max3f(p0[2],p0[3],p1[1]);a=max3f(a,p1[2],p1[3]);
  #pragma unroll
  for(int r=4;r<16;r+=4){a=max3f(a,p0[r],p0[r+1]);b=max3f(b,p0[r+2],p0[r+3]);a=max3f(a,p1[r],p1[r+1]);b=max3f(b,p1[r+2],p1[r+3]);}
  const float m=max2f(a,b);
  auto rr=__builtin_amdgcn_permlane32_swap(__float_as_uint(m),__float_as_uint(m),false,false);
  return max2f(__uint_as_float(rr[0]),__uint_as_float(rr[1]));
}
__device__ __forceinline__ void pv(f32x16*o,int vb,bf16x8 pa0,bf16x8 pa1,bf16x8 pa2,bf16x8 pa3){
  #pragma unroll
  for(int d0=0;d0<2;++d0){s16x4 lo[4],hi[4];
    #pragma unroll
    for(int ks=0;ks<4;++ks){
      asm volatile("ds_read_b64_tr_b16 %0,%1 offset:%c2":"=&v"(lo[ks]):"v"(vb),"i"(d0*4096+ks*1024):"memory");
      asm volatile("ds_read_b64_tr_b16 %0,%1 offset:%c2":"=&v"(hi[ks]):"v"(vb),"i"(d0*4096+ks*1024+512):"memory");}
    asm volatile("s_waitcnt lgkmcnt(0)":::"memory");SBAR();
    #define PK(k) (bf16x8){lo[k][0],lo[k][1],lo[k][2],lo[k][3],hi[k][0],hi[k][1],hi[k][2],hi[k][3]}
    o[d0]=__builtin_amdgcn_mfma_f32_32x32x16_bf16(pa0,PK(0),o[d0],0,0,0);
    o[d0]=__builtin_amdgcn_mfma_f32_32x32x16_bf16(pa1,PK(1),o[d0],0,0,0);
    o[d0]=__builtin_amdgcn_mfma_f32_32x32x16_bf16(pa2,PK(2),o[d0],0,0,0);
    o[d0]=__builtin_amdgcn_mfma_f32_32x32x16_bf16(pa3,PK(3),o[d0],0,0,0);
    #undef PK
  }
}
#define ATTN_STORE16(p,v) (*(u32x4*)(p)=(v))
template<int THRL> __device__ __forceinline__ void attn_unit(int b,int h,int qb,const bf16*Q,const bf16*__restrict__ K,const bf16*__restrict__ V,const bf16*__restrict__ CZ,bf16*O,const float*__restrict__ c2g,int ts,float ub,char*shm){
  int tid=threadIdx.x; asm volatile("":"+v"(tid));
  const int lane=tid&63,r32=lane&31,hi=lane>>5; const int wid=__builtin_amdgcn_readfirstlane(tid>>6);
  const long rowbase=(long)b*SEQ; const int q0=qb*QB;
  const bf16*Qw=Q+(rowbase+q0+wid*QBLK)*DM+h*D;
  const bf16*Kh=K+(rowbase+(long)ts*KVBLK)*DM+h*D,*Vh=V+(rowbase+(long)ts*KVBLK)*DM+h*D;
  const unsigned lds0=(unsigned)(uintptr_t)shm;
  float*wsf=(float*)(shm+LDS_WS)+wid*64;
  float*c2l=(float*)(shm+LDS_C2);
  const bf16*ksrc=Kh+(long)lane*DM+wid*8;
  const bf16*vsrc=Vh+(long)(16*(wid&3)+(lane>>2))*DM+(wid>>2)*32+(lane&3)*8;
  const unsigned kdst=lds0+LDS_K+wid*1024, vdst=lds0+LDS_V+wid*1024;
  #define DMA_K(t,slot) glds16(ksrc+(long)(t)*KVBLK*DM,(unsigned)__builtin_amdgcn_readfirstlane(kdst+(slot)))
  #define DMA_V(t,slot) glds16(vsrc+(long)(t)*KVBLK*DM,(unsigned)__builtin_amdgcn_readfirstlane(vdst+(slot)))
  const int vb0=(int)(lds0+LDS_V)+((lane>>4)&1)*32+(lane&3)*8+(4*hi+((lane&15)>>2))*64;
  const char*Kbase=shm+LDS_K; bf16x8 kf[8];
  const lds_cptr shm3=(lds_cptr)shm; const lds_cptr kp0=shm3+LDS_K+hi*1024+r32*16; const lds_cptr vp0=shm3+LDS_V+((lane>>4)&1)*32+(lane&3)*8+(4*hi+((lane&15)>>2))*64;
  const int NT=(q0+QB)/KVBLK-ts;
  DMA_K(0,0);DMA_V(0,0);DMA_K(1,SLOTB);
  { const int kb0=ts*KVBLK; for(int i=tid*4;i<q0+QB-kb0;i+=NW*64*4)*(f32x4*)(c2l+i)=*(const f32x4*)(c2g+kb0+i); }
  bf16x8 qr[4];
  #pragma unroll
  for(int d0=0;d0<4;++d0)qr[d0]=*reinterpret_cast<const bf16x8*>(&Qw[(long)r32*DM+d0*16+hi*8]);
    float mhat=ub,l_reg=0.f;f32x16 o[2];o[0]=f32x16{};o[1]=f32x16{};
  const int qrel=wid*QBLK+r32;
  #define CMASK(P0,P1,t) do{int jb_=(t)-(NT-4); if(jb_>=0)cmask(P0,P1,jb_,qrel,hi);}while(0)
  bool resc=false;
  bf16x8 qx; float cq2;
  #define START(P0,P1) do{ resc=false; \
    _Pragma("unroll") for(int r=0;r<16;++r)P0[r]=__builtin_amdgcn_exp2f(P0[r]); }while(0)
  #define RESC() do{}while(0)
  f32x16 pA0,pA1,pB0,pB1;
  int sl_prev=0,sl_cur=0,sl_next=SLOTB;
  #define ROT() do{sl_prev=sl_cur;sl_cur=sl_next;sl_next=(sl_next==(NSLOT-1)*SLOTB)?0:sl_next+SLOTB;}while(0)
  DMA_K(2,2*SLOTB);
  WAIT_BAR(3);
  cq2=c2l[q0+qrel-ts*KVBLK]; qx=make_qx(cq2-mhat,hi);
  float ck0=c2l[r32],ck1=c2l[32+r32];
  { const bf16x8 kx0=make_kx(ck0,hi),kx1=make_kx(ck1,hi);
    qkt(pA0,pA1,Kbase,qr,qx,kx0,kx1,r32,hi); }
  asm volatile("s_nop 15\n\ts_nop 7":"+v"(pA0),"+v"(pA1));CMASK(pA0,pA1,0);
  ck0=c2l[64+r32];ck1=c2l[96+r32];
  START(pA0,pA1);
  _Pragma("unroll") for(int r=0;r<16;++r)pA1[r]=__builtin_amdgcn_exp2f(pA1[r]);
  WAIT_BAR(0);
  DMA_K(3,0);DMA_V(1,SLOTB);
  ROT();
  kload8(kf,kp0+sl_cur);
  WAIT_BAR(2);
  s16x4 vlo[8],vhi[8]; u32x4 pw0,pw1,pw2,pw3;
  #define PKW(P,B) cvtpk_s(P[B],P[B+1])
  #define PAF(k) __builtin_bit_cast(bf16x8,pw##k)
  #define VFR(i) (bf16x8){vlo[i][0],vlo[i][1],vlo[i][2],vlo[i][3],vhi[i][0],vhi[i][1],vhi[i][2],vhi[i][3]}
  #define PIN(x) asm volatile("":"+v"(x))
  #define MX3(a,b,c) __builtin_fmaxf(__builtin_fmaxf((a),(b)),(c))
  #define GAPA(MF,A0,A1,A2,A3,W0,W1,PW) do{ MF; sacc+=A0; sacc+=A1; sacc+=A2; sacc+=A3; PIN(sacc); W0; W1; PIN(PW); SBAR(); }while(0)
  #define EX(v) __builtin_amdgcn_exp2f(v)
  #define GAPB(MF,X,B) do{ MF; X[B]=EX(X[B]); X[B+1]=EX(X[B+1]); X[B+2]=EX(X[B+2]); X[B+3]=EX(X[B+3]); PIN(X); SBAR(); }while(0)
  #define VRD(i) do{ vlo[i]=vtr(vp_+(((i)>>2)*4096+((i)&3)*1024)); vhi[i]=vtr(vp_+(((i)>>2)*4096+((i)&3)*1024+512)); }while(0)
  #define KRD(G,j) do{ if(G){ kload2(kf,kp0+sl_next,j); SBAR(); } }while(0)
  #define STEP(C0,C1,P0,P1,t,GK,GV,GL) do{ SBAR(); \
    const lds_cptr vp_=vp0+sl_prev; \
    { const bf16x8 kx0_=make_kx(ck0,hi),kx1_=make_kx(ck1,hi); const f32x16 z_=f32x16{}; \
      C0=__builtin_amdgcn_mfma_f32_32x32x16_bf16(kx0_,qx,z_,0,0,0); C1=__builtin_amdgcn_mfma_f32_32x32x16_bf16(kx1_,qx,z_,0,0,0); } SBAR(); \
    VRD(0); SBAR(); float sacc=(P0[0]+P0[1]); \
    GAPA(C0=__builtin_amdgcn_mfma_f32_32x32x16_bf16(kf[0],qr[0],C0,0,0,0), P0[2],P0[3],P0[4],P0[5],     pw0[0]=PKW(P0,0), pw0[1]=PKW(P0,2), pw0); \
    VRD(4); SBAR(); GAPA(C1=__builtin_amdgcn_mfma_f32_32x32x16_bf16(kf[1],qr[0],C1,0,0,0), P0[6],P0[7],P0[8],P0[9],     pw0[2]=PKW(P0,4), pw0[3]=PKW(P0,6), pw0); \
    VRD(1); SBAR(); GAPA(C0=__builtin_amdgcn_mfma_f32_32x32x16_bf16(kf[2],qr[1],C0,0,0,0),   P0[10],P0[11],P0[12],P0[13], pw1[0]=PKW(P0,8), pw1[1]=PKW(P0,10), pw1); \
    VRD(5); SBAR(); GAPA(C1=__builtin_amdgcn_mfma_f32_32x32x16_bf16(kf[3],qr[1],C1,0,0,0),   P0[14],P0[15],P1[0],P1[1],   pw1[2]=PKW(P0,12),pw1[3]=PKW(P0,14), pw1); \
    VRD(2); SBAR(); GAPA(C0=__builtin_amdgcn_mfma_f32_32x32x16_bf16(kf[4],qr[2],C0,0,0,0),   P1[2],P1[3],P1[4],P1[5],     pw2[0]=PKW(P1,0), pw2[1]=PKW(P1,2), pw2); \
    VRD(6); SBAR(); GAPA(C1=__builtin_amdgcn_mfma_f32_32x32x16_bf16(kf[5],qr[2],C1,0,0,0),   P1[6],P1[7],P1[8],P1[9],     pw2[2]=PKW(P1,4), pw2[3]=PKW(P1,6), pw2); \
    VRD(3); SBAR(); GAPA(C0=__builtin_amdgcn_mfma_f32_32x32x16_bf16(kf[6],qr[3],C0,0,0,0),   P1[10],P1[11],P1[12],P1[13], pw3[0]=PKW(P1,8), pw3[1]=PKW(P1,10), pw3); \
    VRD(7); SBAR(); GAPA(C1=__builtin_amdgcn_mfma_f32_32x32x16_bf16(kf[7],qr[3],C1,0,0,0),   P1[14],P1[15],0.f,0.f,       pw3[2]=PKW(P1,12),pw3[3]=PKW(P1,14), pw3); \
    l_reg+=sacc; \
    if(GK){DMA_K((t)+3,sl_cur);} if(GV){DMA_V((t)+1,sl_next);} \
    if(GL){ ck0=c2l[64*((t)+1)+r32]; ck1=c2l[64*((t)+1)+32+r32]; } \
    CMASK(C0,C1,t); \
    SBAR(); \
    GAPB(o[0]=__builtin_amdgcn_mfma_f32_32x32x16_bf16(PAF(0),VFR(0),o[0],0,0,0), C0,0); \
    GAPB(o[1]=__builtin_amdgcn_mfma_f32_32x32x16_bf16(PAF(0),VFR(4),o[1],0,0,0), C0,4); \
    KRD(GL,0); GAPB(o[0]=__builtin_amdgcn_mfma_f32_32x32x16_bf16(PAF(1),VFR(1),o[0],0,0,0), C0,8); \
    KRD(GL,1); GAPB(o[1]=__builtin_amdgcn_mfma_f32_32x32x16_bf16(PAF(1),VFR(5),o[1],0,0,0), C0,12); \
    KRD(GL,2); GAPB(o[0]=__builtin_amdgcn_mfma_f32_32x32x16_bf16(PAF(2),VFR(2),o[0],0,0,0), C1,0); \
    KRD(GL,3); GAPB(o[1]=__builtin_amdgcn_mfma_f32_32x32x16_bf16(PAF(2),VFR(6),o[1],0,0,0), C1,4); \
    GAPB(o[0]=__builtin_amdgcn_mfma_f32_32x32x16_bf16(PAF(3),VFR(3),o[0],0,0,0), C1,8); \
    GAPB(o[1]=__builtin_amdgcn_mfma_f32_32x32x16_bf16(PAF(3),VFR(7),o[1],0,0,0), C1,12); \
    }while(0)
  int t=1;
  #undef CMASK
  #define CMASK(P0,P1,t) do{}while(0)
  for(;t+5<NT;t+=2){
    STEP(pB0,pB1,pA0,pA1,t,true,true,true);     WAIT_BAR(2); RESC(); ROT();
    STEP(pA0,pA1,pB0,pB1,t+1,true,true,true);   WAIT_BAR(2); RESC(); ROT();
  }
  #undef CMASK
  #define CMASK(P0,P1,t) do{int jb_=(t)-(NT-4); if(jb_>=0)cmask(P0,P1,jb_,qrel,hi);}while(0)
  #define ENDW(tt) do{ if((tt)+3<NT){WAIT_BAR(2);} else if((tt)+2<NT){WAIT_BAR(1);} else {WAIT_BAR(0);} }while(0)
  for(;t+1<NT;t+=2){
    STEP(pB0,pB1,pA0,pA1,t,(t+3<NT),(t+1<NT),(t+1<NT));       ENDW(t);   RESC(); ROT();
    STEP(pA0,pA1,pB0,pB1,t+1,(t+4<NT),(t+2<NT),(t+2<NT));     ENDW(t+1); RESC(); ROT();
  }
  STEP(pB0,pB1,pA0,pA1,NT-1,false,false,false); RESC();
  { float sacc=pB0[0]+pB0[1]; _Pragma("unroll") for(int r=2;r<16;++r)sacc+=pB0[r]; _Pragma("unroll") for(int r=0;r<16;++r)sacc+=pB1[r]; l_reg+=sacc;
    pw0=(u32x4){PKW(pB0,0),PKW(pB0,2),PKW(pB0,4),PKW(pB0,6)};pw1=(u32x4){PKW(pB0,8),PKW(pB0,10),PKW(pB0,12),PKW(pB0,14)};pw2=(u32x4){PKW(pB1,0),PKW(pB1,2),PKW(pB1,4),PKW(pB1,6)};pw3=(u32x4){PKW(pB1,8),PKW(pB1,10),PKW(pB1,12),PKW(pB1,14)};
    SBAR(); pv(o,vb0+sl_cur,PAF(0),PAF(1),PAF(2),PAF(3)); }
  #undef PKW
  #undef PAF
  #undef VFR
  #undef PIN
  #undef MX3
  #undef GAPA
  #undef GAPB
  #undef EX
  #undef VRD
  #undef KRD
  #undef STEP
  #undef ENDW
  {auto rr=__builtin_amdgcn_permlane32_swap(__float_as_uint(l_reg),__float_as_uint(l_reg),false,false);l_reg=__uint_as_float(rr[0])+__uint_as_float(rr[1]);}
  if(hi==0)wsf[32+r32]=l_reg;asm volatile("s_waitcnt lgkmcnt(0)":::"memory");
  bf16*Ow=O+(rowbase+q0+wid*QBLK)*DM+h*D;
  const unsigned short*Cw=(const unsigned short*)(CZ+(rowbase+q0+wid*QBLK)*DM+h*D);
  { bf16*stg=(bf16*)(shm+LDS_OST)+wid*2048;
    #pragma unroll
    for(int r=0;r<16;++r){const int orow=crow(r,hi); const float rl=__builtin_amdgcn_rcpf(wsf[32+orow]);
      #pragma unroll
      for(int d0=0;d0<2;++d0){ const float cz=__uint_as_float((unsigned)Cw[(long)orow*DM+d0*32+r32]<<16); stg[orow*64+d0*32+r32]=__float2bfloat16(o[d0][r]*rl*cz);} }
    asm volatile("s_waitcnt lgkmcnt(0)":::"memory");
    #pragma unroll
    for(int i=0;i<4;++i){const int row=i*8+(lane>>3),ch=lane&7; const u32x4 v=*(const u32x4*)(stg+row*64+ch*8); ATTN_STORE16(Ow+(long)row*DM+ch*8,v);} }
  asm volatile("s_waitcnt lgkmcnt(0)\n\ts_barrier":::"memory");
  #undef DMA_K
  #undef DMA_V
  #undef CMASK
  #undef START
  #undef RESC
  #undef ROT
}
#undef SBAR
#undef WAIT_BAR
}

typedef float f32x2 __attribute__((ext_vector_type(2)));
__device__ __forceinline__ void p2_conv(Frame& F, int l, int unit, bf16_t* outb, const bool pv_ = false) {
    const int tid = F.tid, lane = F.lane, w = F.wave;
    const size_t row0 = (size_t)unit * 64; const int tseq0 = (int)(row0 % SEQ);
    const bf16_t* AG = (const bf16_t*)(F.P.ws + WS_B3); const bf16_t* B0 = (const bf16_t*)(F.P.ws + WS_B0);
    LAS unsigned char* tile = F.lds + RING_OFF;
    for (int c = tid; c < 94 * 64; c += 512) { const int r = c >> 6, ch = c & 63, tr = r - (CW - 1); const bool valid = tseq0 + tr >= 0;
        u32x4 v = (u32x4){0u, 0u, 0u, 0u}; if (valid) v = *(const u32x4*)(AG + (size_t)((long)row0 + tr) * 1024 + ch * 8);
        *(LAS u32x4*)(tile + r * 1024 + ch * 16) = v; }
    LAS float* wl = (LAS float*)(tile + 94 * 1024);
    { const float* cwg = F.P.conv_w + (size_t)l * CW * DA; for (int c = tid; c < CW * DA / 4; c += 512) *(LAS f32x4*)(wl + 4 * c) = *(const f32x4*)(cwg + 4 * c); }
    __syncthreads();
    if (PROBE_CONV == 2 && pv_) { __syncthreads(); return; }
    f32x2 out[4][8]; float s1[8], s2[8];
#pragma unroll
    for (int o = 0; o < 8; ++o) { s1[o] = 0.f; s2[o] = 0.f; }
#pragma unroll
    for (int i = 0; i < 4; ++i) {
        __builtin_amdgcn_sched_barrier(0);
        int p = lane + 64 * i; asm volatile("" : "+v"(p));
        const LAS float* cw = wl + 2 * p;
        f32x2 wv[CW];
#pragma unroll
        for (int j = 0; j < CW; ++j) wv[j] = *(const LAS f32x2*)(cw + j * DA);
        const f32x2 cb = *(const f32x2*)(F.P.conv_b + l * DA + 2 * p);
        const LAS unsigned* tp = (const LAS unsigned*)(tile + (8 * w) * 1024 + 4 * p);
        f32x2 win[16];
#pragma unroll
        for (int k = 0; k < 16; ++k) { const unsigned u = tp[k * 256]; win[k] = (f32x2){__uint_as_float(u << 16), __uint_as_float(u & 0xffff0000u)}; }
#pragma unroll
        for (int o = 0; o < 8; ++o) out[i][o] = cb;
        __builtin_amdgcn_sched_barrier(0);
#pragma unroll
        for (int j = 0; j < CW; ++j) {
            if (!(PROBE_CONV == 1 && pv_))
#pragma unroll
            for (int o = 0; o < 8; ++o) out[i][o] += wv[j] * win[(j + o) & 15];
            asm volatile("" : "+v"(out[i][0]), "+v"(out[i][1]), "+v"(out[i][2]), "+v"(out[i][3]), "+v"(out[i][4]), "+v"(out[i][5]), "+v"(out[i][6]), "+v"(out[i][7]));
            if (j + 16 < 38) { const LAS unsigned* tq = tp; asm volatile("" : "+v"(tq)); const unsigned u = tq[(j + 16) * 256]; win[j & 15] = (f32x2){__uint_as_float(u << 16), __uint_as_float(u & 0xffff0000u)}; }
            __builtin_amdgcn_sched_barrier(0);
        }
#pragma unroll
        for (int o = 0; o < 8; ++o) { s1[o] += out[i][o].x + out[i][o].y; s2[o] += out[i][o].x * out[i][o].x + out[i][o].y * out[i][o].y; }
    }
    unsigned az[4][8];
#pragma unroll
    for (int i = 0; i < 4; ++i)
#pragma unroll
        for (int o = 0; o < 8; ++o) az[i][o] = *(const unsigned*)(B0 + (row0 + 8 * w + o) * 1024 + 2 * (lane + 64 * i));
#pragma unroll
    for (int o = 0; o < 8; ++o) { s1[o] = wsum(s1[o]); s2[o] = wsum(s2[o]); }
#pragma unroll
    for (int i = 0; i < 4; ++i) {
        const int p = lane + 64 * i;
        const f32x2 gg = *(const f32x2*)(F.P.cn_g + l * DA + 2 * p), be = *(const f32x2*)(F.P.cn_b + l * DA + 2 * p);
#pragma unroll
        for (int o = 0; o < 8; ++o) { const float mu = s1[o] * (1.f / DA), ex2 = s2[o] * (1.f / DA); const float rstd = rsqrtf(fmaxf(ex2 - mu * mu, 0.f) + EPS);
            f32x2 y = (out[i][o] - mu) * rstd * gg + be; y.x = y.x * fsigm(y.x); y.y = y.y * fsigm(y.y);
            *(unsigned*)(outb + (row0 + 8 * w + o) * 1024 + 2 * p) = cvt_pk_bf16(y.x * __uint_as_float(az[i][o] << 16), y.y * __uint_as_float(az[i][o] & 0xffff0000u)); }
    }
    __syncthreads();
}
__device__ __forceinline__ void p2_gmlp(Frame& F, int l, int unit, bf16_t* outb) {
    constexpr int VTP = 136;
    const int tid = F.tid, lane = F.lane, w = F.wave, fr = lane & 15, fq = lane >> 4, ch = unit >> 1, gp = unit & 1, c0 = 256 * gp; const size_t row0 = (size_t)ch * CHK;
    LAS bf16_t* vt = (LAS bf16_t*)(F.lds + RING_OFF);
    const bf16_t* V = (const bf16_t*)(F.P.ws + WS_B3) + 512 + c0; const bf16_t* U = (const bf16_t*)(F.P.ws + WS_B0) + 512 + c0; const bf16_t* BZ = (const bf16_t*)(F.P.ws + WS_B4) + c0;
    const float* vss = (const float*)(F.P.ws + WS_VSS); const float* gn = F.P.gn_g + l * DB + c0;
    const size_t t = row0 + 16 * w + fr;
    unsigned long long uu[16], zz[16];
#pragma unroll
    for (int n = 0; n < 16; ++n) { uu[n] = *(const unsigned long long*)(U + t * 1024 + 16 * n + 4 * fq); zz[n] = *(const unsigned long long*)(BZ + t * 512 + 16 * n + 4 * fq); }
    bf16x8 wf[2][4];
#pragma unroll
    for (int g2 = 0; g2 < 2; ++g2)
#pragma unroll
        for (int ks = 0; ks < 4; ++ks) wf[g2][ks] = *(const bf16x8*)((const bf16_t*)(F.P.ws + WS_WSB) + ((size_t)(l * NG + 2 * gp + g2) * CHK + 16 * w + fr) * CHK + 32 * ks + 8 * fq);
    const float bs0 = F.P.b_s[(size_t)(l * NG + 2 * gp) * CHK + 16 * w + fr], bs1 = F.P.b_s[(size_t)(l * NG + 2 * gp + 1) * CHK + 16 * w + fr];
    { const int sidx = tid & 127; const f32x4 qa = *(const f32x4*)(vss + (row0 + sidx) * 8), qb = *(const f32x4*)(vss + (row0 + sidx) * 8 + 4);
      const float ss = ((qa.x + qa.y) + (qa.z + qa.w)) + ((qb.x + qb.y) + (qb.z + qb.w)); const float rv = rsqrtf(ss * (1.f / DB) + EPS);
      u32x4 raw[8];
#pragma unroll
      for (int k = 0; k < 8; ++k) raw[k] = *(const u32x4*)(V + (row0 + sidx) * 1024 + ((tid >> 7) + 4 * k) * 8);
#pragma unroll
      for (int k = 0; k < 8; ++k) { const int c8 = ((tid >> 7) + 4 * k) * 8; f32x4 v0, v1; unpack8(raw[k], v0, v1); const f32x4 g0 = *(const f32x4*)(gn + c8), g1 = *(const f32x4*)(gn + c8 + 4);
          v0 = v0 * rv * g0; v1 = v1 * rv * g1;
#pragma unroll
          for (int e = 0; e < 4; ++e) { vt[(c8 + e) * VTP + sidx] = f2bf(v0[e]); vt[(c8 + 4 + e) * VTP + sidx] = f2bf(v1[e]); } } }
    __syncthreads();
    f32x4 acc[16];
#pragma unroll
    for (int n = 0; n < 16; ++n) acc[n] = (f32x4){0.f, 0.f, 0.f, 0.f};
#pragma unroll
    for (int ks = 0; ks < 4; ++ks) {
        if (32 * ks <= 16 * w + 15) {
#pragma unroll
            for (int n = 0; n < 16; ++n) { const bf16x8 vf = *(const LAS bf16x8*)(vt + (16 * n + fr) * VTP + 32 * ks + 8 * fq); acc[n] = __builtin_amdgcn_mfma_f32_16x16x32_bf16(vf, wf[n >> 3][ks], acc[n], 0, 0, 0); }
        }
    }
#pragma unroll
    for (int n = 0; n < 16; ++n) { const float bs = n < 8 ? bs0 : bs1;
        const unsigned u0 = (unsigned)uu[n], u1 = (unsigned)(uu[n] >> 32), z0 = (unsigned)zz[n], z1 = (unsigned)(zz[n] >> 32);
        const float o0 = __uint_as_float(u0 << 16) * (acc[n][0] + bs) * __uint_as_float(z0 << 16), o1 = __uint_as_float(u0 & 0xffff0000u) * (acc[n][1] + bs) * __uint_as_float(z0 & 0xffff0000u);
        const float o2 = __uint_as_float(u1 << 16) * (acc[n][2] + bs) * __uint_as_float(z1 << 16), o3 = __uint_as_float(u1 & 0xffff0000u) * (acc[n][3] + bs) * __uint_as_float(z1 & 0xffff0000u);
        *(unsigned long long*)(outb + 512 + c0 + t * 1024 + 16 * n + 4 * fq) = (unsigned long long)cvt_pk_bf16(o0, o1) | ((unsigned long long)cvt_pk_bf16(o2, o3) << 32); }
    __syncthreads();
}

__global__ void __launch_bounds__(NWAVES * 64, 2) mk_fwd(Args args) {
    extern __shared__ __attribute__((aligned(16))) unsigned char lds[];
    Frame F;
    F.lds = (LAS unsigned char*)lds;
    volatile LAS unsigned* MISC = (volatile LAS unsigned*)(F.lds + MISC_OFF);
    F.tid = threadIdx.x; F.lane = F.tid & 63; F.wave = __builtin_amdgcn_readfirstlane(F.tid >> 6);
    F.G = gridDim.x; { const int bx = blockIdx.x; F.vcu = (F.G % 8 == 0) ? (bx % 8) * (F.G / 8) + bx / 8 : bx; }
    F.P.x = args.in[0]; F.P.norm_g = args.in[1]; F.P.w_in = args.in[2]; F.P.b_gate = args.in[3]; F.P.conv_w = args.in[4]; F.P.conv_b = args.in[5]; F.P.cn_g = args.in[6]; F.P.cn_b = args.in[7]; F.P.w_a = args.in[8];
    F.P.gn_g = args.in[9]; F.P.w_s = args.in[10]; F.P.b_s = args.in[11]; F.P.w_b = args.in[12]; F.P.qn_g = args.in[13]; F.P.kn_g = args.in[14]; F.P.b_f = args.in[15]; F.P.w_c = args.in[16]; F.P.w_out = args.in[17];
    F.P.out = args.out; F.P.ws = args.ws;
    gu32* ctl = (gu32*)(args.ws + WS_CTL);
    for (int u = F.tid; u < (LDS_BYTES - LDSCTL_OFF) / 4; u += NWAVES * 64) ((LAS unsigned*)(F.lds + LDSCTL_OFF))[u] = 0u;
    __syncthreads();
    XcdBarrier bar = xcd_barrier_post((unsigned*)(ctl + CW_BAR) + args.li * XCD_BAR_WORDS, MISC + 8);

    bool dup_done = false;
    for (int ph = args.ph_lo; ph < args.ph_hi;) {
        const int l = ph / 5, p = ph % 5;
        const bool dummy = (PROBE_DUP >= 0) && p == PROBE_DUP && !dup_done;
        asm volatile("" : "+v"(F.tid)); F.lane = F.tid & 63;
        int bid = (int)blockIdx.x; asm volatile("" : "+s"(bid));
        unsigned char* ws = F.P.ws; unsigned char* wl = ws + WS_W + (size_t)l * W_LAYER;
        const float* xin = l == 0 ? F.P.x : F.P.out;
        if (p == 0) {
            if (l > 0) { ++ph; continue; }
            if (l == 0 && (!dummy || (PROBE_SUB & 1))) p0_weights(F);
            if (!dummy || (PROBE_SUB & 2)) p0_ln(F, l, xin);
        } else if (p == 1) {
            if (bid < NB * NH) p1_scan(F, bid, l);
            { pg8::TileOrder T0; T0.init(M, N1, F.G, bid); int pm_ = 0, pn_ = 0; (void)T0.tile(0, pm_, pn_);
              LAS float* Rt = (LAS float*)(F.lds + RT_OFF);
              if (F.tid < 256) { float r = 1.f; if (l > 0) { const f32x4 q = *(const f32x4*)((const float*)(ws + WS_SSP) + ((size_t)pm_ * 256 + F.tid) * 4); r = rsqrtf(((q.x + q.y) + (q.z + q.w)) * (1.f / D) + EPS); } Rt[F.tid] = r; }
              __syncthreads(); }
            pg8::SchedG1 S; S.T.init(M, N1, F.G, bid); S.A = (const char*)(ws + WS_H); S.B = (const char*)(wl + WO_W1);
            pg8::EpiG1 E{(bf16_t*)(ws + WS_B0), (bf16_t*)(ws + WS_B1), (bf16_t*)(ws + WS_B2), (bf16_t*)(ws + WS_B3), (bf16_t*)(ws + WS_B4), (float*)(ws + WS_VSS), F.P.qn_g + l * HD, F.P.kn_g + l * HD, (const LAS float*)(F.lds + RT_OFF)};
            pg8::gemm_phase<pg8::EpiG1, pg8::SchedG1>(F.lds + RING_OFF, S, E);
        } else if (p == 2) {
            for (int part = 0; part < 2; ++part) {
              asm volatile("" : "+v"(F.tid)); F.lane = F.tid & 63; asm volatile("" : "+s"(bid));
              if ((part == 0) == ((F.vcu & 1) == 0)) {
            if (!dummy || (PROBE_SUB & 1)) p2_conv(F, l, bid, dummy ? (bf16_t*)(ws + WS_DUMMY) : (bf16_t*)(ws + WS_B0), dummy);
            if (!dummy || (PROBE_SUB & 2)) { bf16_t* ob = dummy ? (bf16_t*)(ws + WS_DUMMY) : (bf16_t*)(ws + WS_B0); p2_gmlp(F, l, bid, ob); }
              } else {
            if (!dummy || (PROBE_SUB & 4)) { const int bh = F.vcu >> 3, sq = F.vcu & 7; const attn_body::bf16* b1 = (const attn_body::bf16*)(ws + WS_B1); const attn_body::bf16* b2 = (const attn_body::bf16*)(ws + WS_B2);
              const float* c2g = (const float*)(ws + WS_CS) + (size_t)bh * SEQ; const int* tsg = (const int*)(ws + WS_TS) + bh * 16;
              float gqm = fabsf(F.P.qn_g[l * HD + F.lane]), gkm = fabsf(F.P.kn_g[l * HD + F.lane]);
#pragma unroll
              for (int o_ = 1; o_ < 64; o_ <<= 1) { gqm = fmaxf(gqm, __shfl_xor(gqm, o_)); gkm = fmaxf(gkm, __shfl_xor(gkm, o_)); }
              const float ub = 64.f * C2 * gqm * gkm * 1.01f;
              for (int i = 0; i < 2; ++i) { const int qb = i == 0 ? 15 - sq : sq; const int ts = __builtin_amdgcn_readfirstlane(tsg[qb]); attn_body::attn_unit<8>(bh / NH, bh % NH, qb, b1, b1 + 512, b2, b2 + 512, dummy ? (attn_body::bf16*)(ws + WS_DUMMY) : (attn_body::bf16*)(ws + WS_B1), c2g, ts, ub, (char*)lds + RING_OFF); } }
              }
            }
        } else if (p == 3) {
            pg8::TileOrder T; T.init(M, D, F.G, bid);
            pg8::SchedMerge S; { int pm_ = 0, pn_ = 0; S.ok = T.tile(0, pm_, pn_); S.pm = pm_; S.pn = pn_; }
            S.ws = (const char*)ws; S.wl = (const char*)wl;
            pg8::EpiMerge E{ws + WS_GT + (size_t)bid * 131072, (bf16_t*)(ws + WS_MG), F.P.b_gate + (size_t)l * 3072, (const LAS float*)(F.lds + RT_OFF)};
            pg8::gemm_phase<pg8::EpiMerge, pg8::SchedMerge>(F.lds + RING_OFF, S, E);
        } else {
            pg8::SchedG1 S; S.T.init(M, D, F.G, bid); S.A = (const char*)(ws + WS_MG); S.B = (const char*)(wl + WO_WO);
            if (l + 1 < NL) {
                pg8::EpiOutLN E{xin, dummy ? (float*)(ws + WS_B0) : F.P.out, (bf16_t*)(ws + WS_H), F.P.norm_g + (size_t)(l + 1) * D, F.P.w_in + (size_t)(l + 1) * D * NIN + OC_F, (float*)(ws + WS_SSP), (float*)(ws + WS_FP)};
                pg8::gemm_phase<pg8::EpiOutLN, pg8::SchedG1>(F.lds + RING_OFF, S, E);
            } else {
                pg8::EpiOut E{xin, dummy ? (float*)(ws + WS_B0) : F.P.out};
                pg8::gemm_phase<pg8::EpiOut, pg8::SchedG1>(F.lds + RING_OFF, S, E);
            }
        }
        if (dummy) { dup_done = true; continue; }
        dup_done = false; ++ph;
        if (ph < args.ph_hi) xcd_barrier(bar);
    }
}

#ifndef MK_MODE
#define MK_MODE 2
#endif
extern "C" void kernel_launch(void* const* d_in, const int* in_sizes, int n_in, void* d_out, int out_size, void* d_ws, size_t ws_size, hipStream_t stream) {
    static int ok = 0;
    if (ok == 0) {
        if (n_in != 18 || in_sizes[0] != M * D || out_size != M * D || ws_size < WS_END) { fprintf(stderr, "kernel_launch: unexpected shapes (n_in %d in0 %d out %d ws %zu)\n", n_in, n_in > 0 ? in_sizes[0] : -1, out_size, ws_size); ok = -1; return; }
        const int tl = 64 * TLD * 4;
        (void)hipFuncSetAttribute((const void*)nv_gemm1, hipFuncAttributeMaxDynamicSharedMemorySize, tl);
        (void)hipFuncSetAttribute((const void*)nv_merge, hipFuncAttributeMaxDynamicSharedMemorySize, 2 * 64 * 256 * 4);
        (void)hipFuncSetAttribute((const void*)nv_gmlp, hipFuncAttributeMaxDynamicSharedMemorySize, 128 * 129 * 4);
        (void)hipFuncSetAttribute((const void*)nv_attn, hipFuncAttributeMaxDynamicSharedMemorySize, 4 * SEQ * 4);
        if (hipFuncSetAttribute((const void*)mk_fwd, hipFuncAttributeMaxDynamicSharedMemorySize, LDS_BYTES) != hipSuccess) { fprintf(stderr, "kernel_launch: hipFuncSetAttribute(mk_fwd) failed\n"); ok = -1; return; }
        int dev = 0, cus = 0; (void)hipGetDevice(&dev); (void)hipDeviceGetAttribute(&cus, hipDeviceAttributeMultiprocessorCount, dev);
        if (cus != 256) fprintf(stderr, "kernel_launch: note: %d CUs (built for 256)\n", cus);
        (void)hipGetLastError();
        ok = 1;
    }
    if (ok < 0) return;
    Ptrs P{};
    const float** pp = (const float**)&P;
    for (int i = 0; i < 18; ++i) pp[i] = (const float*)d_in[i];
    P.out = (float*)d_out; P.ws = (unsigned char*)d_ws;
    const int tl = 64 * TLD * 4;
#if MK_MODE == 0
    nv_prep<<<2048, 256, 0, stream>>>(P);
    for (int l = 0; l < NL; ++l) {
        const float* xin = l == 0 ? P.x : P.out;
        nv_ln<<<M / 4, 256, 0, stream>>>(P, l, xin);
        nv_scan<<<NB * NH, 256, 0, stream>>>(P);
        nv_gemm1<<<dim3(20, 256), 256, tl, stream>>>(P, l);
        nv_conv<<<M, 512, 0, stream>>>(P, l);
        nv_gmlp<<<dim3(128, 4), 256, 128 * 129 * 4, stream>>>(P, l);
        nv_attn<<<M * NH / 4, 256, 4 * SEQ * 4, stream>>>(P);
        nv_merge<<<dim3(4, 256), 256, 2 * 64 * 256 * 4, stream>>>(P, l);
        nv_out<<<dim3(4, 256), 256, 0, stream>>>(P, l, xin, P.out);
    }
#else
    (void)tl;
    if (hipMemsetAsync((char*)d_ws + WS_CTL, 0, CTL_ZERO_BYTES, stream) != hipSuccess) { fprintf(stderr, "kernel_launch: memset failed\n"); return; }
    Args a{};
    for (int i = 0; i < 18; ++i) a.in[i] = (const float*)d_in[i];
    a.out = (float*)d_out; a.ws = (unsigned char*)d_ws;
    auto mk = [&](int lo, int hi, int li) { a.ph_lo = lo; a.ph_hi = hi; a.li = li; hipLaunchKernelGGL(mk_fwd, dim3(256), dim3(NWAVES * 64), LDS_BYTES, stream, a);
        const hipError_t le = hipPeekAtLastError(); if (le != hipSuccess) fprintf(stderr, "kernel_launch: mk launch [%d,%d) failed: %s\n", lo, hi, hipGetErrorName(le)); };
#if MK_MODE == 1
    auto mixers = [&](int l) { nv_conv<<<M, 512, 0, stream>>>(P, l); nv_gmlp<<<dim3(128, 4), 256, 128 * 129 * 4, stream>>>(P, l); nv_attn<<<M * NH / 4, 256, 4 * SEQ * 4, stream>>>(P); };
    mk(0, 2, 0); mixers(0); mk(3, 7, 1); mixers(1); mk(8, 10, 2);
#else
    mk(0, NPH, 0);
#endif
#endif
}
```

```cpp
#include <hip/hip_runtime.h>
#include <cstdio>
#include <cstdint>
#include <cmath>

constexpr int NL = 2, NB = 4, SEQ = 4096, M = NB * SEQ, D = 1024;
constexpr int DA = 512, DB = 512, NH = 8, HD = 64, DC = 512, CW = 31, CHK = 128, NG = 4, GD = 128, NIN = 8200;
constexpr float EPS = 1e-6f;
constexpr float LOG2E = 1.4426950408889634f;
constexpr float C2 = 0.125f * LOG2E;
constexpr int N1 = 5120;
constexpr int OC_GATE = 0, OC_AIN = 3072, OC_AZ = 4096, OC_U = 4608, OC_V = 5120, OC_BZ = 5632, OC_Q = 6144, OC_K = 6656, OC_VA = 7168, OC_CZ = 7680, OC_F = 8192;

constexpr size_t MiB = 1u << 20;
constexpr size_t WS_CTL = 0, CTL_ZERO_BYTES = 1 * MiB;
constexpr size_t WS_VSS = 1 * MiB;
constexpr size_t WS_LOGF = WS_VSS + 512 * 1024;
constexpr size_t WS_CS = 2 * MiB;
constexpr size_t WS_WSB = WS_CS + 512 * 1024;
constexpr size_t WS_TS = 3 * MiB;
constexpr size_t WS_W = 4 * MiB, W_LAYER = 22 * MiB;
constexpr size_t WO_W1 = 0, WO_WG = 10 * MiB, WO_WAB = 16 * MiB, WO_WC = 18 * MiB, WO_WO = 20 * MiB;
constexpr size_t WS_H = 48 * MiB;
constexpr size_t WS_B0 = 80 * MiB;
constexpr size_t WS_B1 = 112 * MiB;
constexpr size_t WS_B2 = 144 * MiB;
constexpr size_t WS_B3 = 176 * MiB;
constexpr size_t WS_B4 = 208 * MiB;
constexpr size_t WS_GT = WS_B2, WS_MG = WS_B3;
constexpr size_t WS_FP = 240 * MiB;
constexpr size_t WS_SSP = 242 * MiB;
constexpr size_t WS_DUMMY = 224 * MiB;
constexpr size_t WS_END = 256 * MiB;
#ifndef PROBE_CONV
#define PROBE_CONV 0
#endif
#ifndef PROBE_SUB
#define PROBE_SUB 7
#endif
#ifndef PROBE_DUP
#define PROBE_DUP -1
#endif

typedef unsigned short bf16_t;
typedef short bf16x8 __attribute__((ext_vector_type(8)));
typedef float f32x4 __attribute__((ext_vector_type(4)));
typedef unsigned u32x4 __attribute__((ext_vector_type(4)));

__host__ __device__ __forceinline__ float bf2f(bf16_t v) { union { unsigned u; float f; } c; c.u = (unsigned)v << 16; return c.f; }
__host__ __device__ __forceinline__ bf16_t f2bf(float f) { union { unsigned u; float f; } c; c.f = f; unsigned u = c.u; return (bf16_t)((u + 0x7fffu + ((u >> 16) & 1u)) >> 16); }
__device__ __forceinline__ float bfr(float f) { return bf2f(f2bf(f)); }
__device__ __forceinline__ float sigm(float x) { return 1.f / (1.f + __expf(-x)); }
__device__ __forceinline__ float siluf(float x) { return x * sigm(x); }

__host__ __device__ __forceinline__ int g1_col(int n) {
    const int j = n >> 8, lc = n & 255;
    if (j < 4) return lc < 128 ? OC_AIN + 128 * j + lc : OC_AIN + 512 + 128 * j + (lc - 128);
    if (j < 6) return OC_AZ + 256 * (j - 4) + lc;
    if (j < 8) return OC_U + 256 * (j - 6) + lc;
    if (j < 10) return OC_V + 256 * (j - 8) + lc;
    if (j < 12) return OC_BZ + 256 * (j - 10) + lc;
    if (j < 16) { const int isk = j >= 14, jj = (j - 12) & 1, head = 4 * jj + ((lc >> 5) & 3), d = 32 * (lc >> 7) + (lc & 31); return (isk ? OC_K : OC_Q) + 64 * head + d; }
    if (j < 18) return OC_VA + 256 * (j - 16) + lc;
    return OC_CZ + 256 * (j - 18) + lc;
}

struct Ptrs {
    const float *x, *norm_g, *w_in, *b_gate, *conv_w, *conv_b, *cn_g, *cn_b, *w_a, *gn_g, *w_s, *b_s, *w_b, *qn_g, *kn_g, *b_f, *w_c, *w_out;
    float* out; unsigned char* ws;
};

__global__ void nv_prep(Ptrs P) {
    const size_t gid = (size_t)blockIdx.x * blockDim.x + threadIdx.x, gsz = (size_t)gridDim.x * blockDim.x;
    for (int l = 0; l < NL; ++l) {
        unsigned char* wl = P.ws + WS_W + (size_t)l * W_LAYER;
        bf16_t* W1 = (bf16_t*)(wl + WO_W1); bf16_t* WG = (bf16_t*)(wl + WO_WG); bf16_t* WAB = (bf16_t*)(wl + WO_WAB); bf16_t* WC = (bf16_t*)(wl + WO_WC); bf16_t* WO = (bf16_t*)(wl + WO_WO);
        const float* win = P.w_in + (size_t)l * D * NIN;
        for (size_t i = gid; i < (size_t)N1 * D; i += gsz) { const int n = (int)(i >> 10), k = (int)(i & 1023); W1[i] = f2bf(win[(size_t)k * NIN + g1_col(n)]); }
        for (size_t i = gid; i < (size_t)3072 * D; i += gsz) { const int n = (int)(i >> 10), k = (int)(i & 1023); WG[i] = f2bf(win[(size_t)k * NIN + n]); }
        for (size_t i = gid; i < (size_t)1024 * 1024; i += gsz) { const int n = (int)(i >> 10), k = (int)(i & 1023);
            WAB[i] = f2bf(k < 512 ? P.w_a[((size_t)l * DA + k) * D + n] : P.w_b[((size_t)l * DB + (k - 512)) * D + n]);
            WC[i] = k < 512 ? f2bf(P.w_c[((size_t)l * DC + k) * D + n]) : (bf16_t)0;
            WO[i] = f2bf(P.w_out[((size_t)l * D + k) * D + n]); }
        bf16_t* WSB = (bf16_t*)(P.ws + WS_WSB) + (size_t)l * NG * CHK * CHK;
        for (size_t i = gid; i < (size_t)NG * CHK * CHK; i += gsz) { const int s = (int)(i & 127), t = (int)((i >> 7) & 127); WSB[i] = s <= t ? f2bf(P.w_s[(size_t)l * NG * CHK * CHK + i]) : (bf16_t)0; }
    }
}

__device__ __forceinline__ float wave_sum(float v) {
#pragma unroll
    for (int o = 1; o < 64; o <<= 1) v += __shfl_xor(v, o);
    return v;
}

__global__ void nv_ln(Ptrs P, int l, const float* xin) {
    const int lane = threadIdx.x & 63, row = blockIdx.x * 4 + (threadIdx.x >> 6);
    const float* xr = xin + (size_t)row * D; const float* g = P.norm_g + (size_t)l * D; const float* win = P.w_in + (size_t)l * D * NIN;
    float v[16]; float ss = 0.f;
#pragma unroll
    for (int j = 0; j < 16; ++j) { v[j] = xr[lane + 64 * j]; ss += v[j] * v[j]; }
    ss = wave_sum(ss);
    const float r = rsqrtf(ss * (1.f / D) + EPS);
    bf16_t* h = (bf16_t*)(P.ws + WS_H) + (size_t)row * D;
    float f[8] = {0, 0, 0, 0, 0, 0, 0, 0};
#pragma unroll
    for (int j = 0; j < 16; ++j) { const int k = lane + 64 * j; const float hv = v[j] * r * g[k]; h[k] = f2bf(hv);
#pragma unroll
        for (int e = 0; e < 8; ++e) f[e] += hv * win[(size_t)k * NIN + OC_F + e]; }
#pragma unroll
    for (int e = 0; e < 8; ++e) f[e] = wave_sum(f[e]);
    if (lane < 8) { float z = 0.f;
#pragma unroll
        for (int e = 0; e < 8; ++e) if (lane == e) z = f[e];
        z += P.b_f[l * NH + lane];
        const float lf = fminf(z, 0.f) - log1pf(expf(-fabsf(z)));
        ((float*)(P.ws + WS_LOGF))[(size_t)row * 8 + lane] = lf; }
}

__global__ void nv_scan(Ptrs P) {
    __shared__ float buf[SEQ];
    const int bh = blockIdx.x, b = bh / NH, h = bh % NH;
    const float* lf = (const float*)(P.ws + WS_LOGF);
    for (int t = threadIdx.x; t < SEQ; t += blockDim.x) buf[t] = lf[((size_t)b * SEQ + t) * 8 + h];
    __syncthreads();
    if (threadIdx.x == 0) { float c = 0.f; for (int t = 0; t < SEQ; ++t) { c += buf[t]; buf[t] = c * LOG2E; } }
    __syncthreads();
    float* cs = (float*)(P.ws + WS_CS) + (size_t)bh * SEQ;
    for (int t = threadIdx.x; t < SEQ; t += blockDim.x) cs[t] = buf[t];
}

constexpr int TLD = 257;
__device__ __forceinline__ void nv_gemm_acc(const bf16_t* A, int lda, const bf16_t* Bt, int ldb, int K, f32x4 (&acc)[4][4]) {
    const int tid = threadIdx.x, w = tid >> 6, l = tid & 63, fr = l & 15, fq = l >> 4;
#pragma unroll
    for (int m = 0; m < 4; ++m)
#pragma unroll
        for (int n = 0; n < 4; ++n) acc[m][n] = (f32x4){0.f, 0.f, 0.f, 0.f};
    for (int k0 = 0; k0 < K; k0 += 32) {
        bf16x8 a[4], b[4];
#pragma unroll
        for (int m = 0; m < 4; ++m) a[m] = *(const bf16x8*)(A + (size_t)(16 * m + fr) * lda + k0 + 8 * fq);
#pragma unroll
        for (int n = 0; n < 4; ++n) b[n] = *(const bf16x8*)(Bt + (size_t)(64 * w + 16 * n + fr) * ldb + k0 + 8 * fq);
#pragma unroll
        for (int m = 0; m < 4; ++m)
#pragma unroll
            for (int n = 0; n < 4; ++n) acc[m][n] = __builtin_amdgcn_mfma_f32_16x16x32_bf16(a[m], b[n], acc[m][n], 0, 0, 0);
    }
}
__device__ __forceinline__ void nv_gemm_tile(const bf16_t* A, int lda, const bf16_t* Bt, int ldb, int K, float* T) {
    const int tid = threadIdx.x, w = tid >> 6, l = tid & 63, fr = l & 15, fq = l >> 4;
    f32x4 acc[4][4];
    nv_gemm_acc(A, lda, Bt, ldb, K, acc);
#pragma unroll
    for (int m = 0; m < 4; ++m)
#pragma unroll
        for (int n = 0; n < 4; ++n)
#pragma unroll
            for (int r = 0; r < 4; ++r) T[(16 * m + 4 * fq + r) * TLD + 64 * w + 16 * n + fr] = acc[m][n][r];
}

__global__ void __launch_bounds__(256) nv_gemm1(Ptrs P, int l) {
    extern __shared__ float T[];
    __shared__ float R[64 * 4];
    const int j = blockIdx.x, row0 = blockIdx.y * 64, tid = threadIdx.x;
    const bf16_t* H = (const bf16_t*)(P.ws + WS_H);
    const bf16_t* W1 = (const bf16_t*)(P.ws + WS_W + (size_t)l * W_LAYER + WO_W1);
    nv_gemm_tile(H + (size_t)row0 * D, D, W1 + (size_t)j * 256 * D, D, D, T);
    __syncthreads();
    bf16_t* B0 = (bf16_t*)(P.ws + WS_B0); bf16_t* B1 = (bf16_t*)(P.ws + WS_B1); bf16_t* B2 = (bf16_t*)(P.ws + WS_B2); bf16_t* B3 = (bf16_t*)(P.ws + WS_B3); bf16_t* B4 = (bf16_t*)(P.ws + WS_B4);
    if (j < 4) {
        for (int e = tid; e < 64 * 128; e += 256) { const int r = e >> 7, c = e & 127; B3[(size_t)(row0 + r) * 1024 + 128 * j + c] = f2bf(T[r * TLD + c] * sigm(T[r * TLD + c + 128])); }
    } else if (j < 12 || j >= 16) {
        bf16_t* dst; int pitch, coff; bool act;
        if (j < 6) { dst = B0; pitch = 1024; coff = 256 * (j - 4); act = true; }
        else if (j < 8) { dst = B0; pitch = 1024; coff = 512 + 256 * (j - 6); act = false; }
        else if (j < 10) { dst = B3; pitch = 1024; coff = 512 + 256 * (j - 8); act = false; }
        else if (j < 12) { dst = B4; pitch = 512; coff = 256 * (j - 10); act = true; }
        else if (j < 18) { dst = B2; pitch = 1024; coff = 256 * (j - 16); act = false; }
        else { dst = B2; pitch = 1024; coff = 512 + 256 * (j - 18); act = true; }
        for (int e = tid; e < 64 * 256; e += 256) { const int r = e >> 8, c = e & 255; const float v = T[r * TLD + c]; dst[(size_t)(row0 + r) * pitch + coff + c] = f2bf(act ? siluf(v) : v); }
        if (j == 8 || j == 9) { const int r = tid >> 2, wc = tid & 3; float s = 0.f;
            for (int bj = 0; bj < 2; ++bj) for (int i = 0; i < 32; ++i) { const float v = T[r * TLD + 128 * bj + 32 * wc + i]; s += v * v; }
            ((float*)(P.ws + WS_VSS))[(size_t)(row0 + r) * 8 + (j - 8) * 4 + wc] = s; }
    } else {
        const bool isk = j >= 14; const int jj = (j - 12) & 1;
        { const int r = tid >> 2, hh = tid & 3; float s = 0.f;
          for (int d = 0; d < 64; ++d) { const float v = T[r * TLD + 128 * (d >> 5) + 32 * hh + (d & 31)]; s += v * v; }
          R[r * 4 + hh] = rsqrtf(s * (1.f / 64.f) + EPS); }
        __syncthreads();
        const float* gq = (isk ? P.kn_g : P.qn_g) + (size_t)l * HD;
        for (int e = tid; e < 64 * 256; e += 256) { const int r = e >> 8, c = e & 255, hh = (c >> 5) & 3, d = 32 * (c >> 7) + (c & 31);
            float v = T[r * TLD + c] * R[r * 4 + hh] * gq[d]; if (!isk) v *= C2;
            B1[(size_t)(row0 + r) * 1024 + (isk ? 512 : 0) + 64 * (4 * jj + hh) + d] = f2bf(v); }
    }
}

__global__ void __launch_bounds__(512) nv_conv(Ptrs P, int l) {
    __shared__ float red[16];
    const int row = blockIdx.x, t = row % SEQ, c = threadIdx.x, lane = c & 63, w = c >> 6;
    const bf16_t* AG = (const bf16_t*)(P.ws + WS_B3); bf16_t* B0 = (bf16_t*)(P.ws + WS_B0);
    const float* cw = P.conv_w + (size_t)l * CW * DA;
    float a = P.conv_b[l * DA + c];
    for (int j = 0; j < CW; ++j) { const int tt = t - (CW - 1) + j; if (tt >= 0) a += cw[j * DA + c] * bf2f(AG[(size_t)(row - (CW - 1) + j) * 1024 + c]); }
    float s = wave_sum(a); if (lane == 0) red[w] = s; __syncthreads();
    float mu = 0.f; for (int i = 0; i < 8; ++i) mu += red[i]; mu *= (1.f / DA);
    const float d = a - mu; s = wave_sum(d * d); if (lane == 0) red[8 + w] = s; __syncthreads();
    float var = 0.f; for (int i = 0; i < 8; ++i) var += red[8 + i]; var *= (1.f / DA);
    const float y = d * rsqrtf(var + EPS) * P.cn_g[l * DA + c] + P.cn_b[l * DA + c];
    const float az = bf2f(B0[(size_t)row * 1024 + c]);
    B0[(size_t)row * 1024 + c] = f2bf(siluf(y) * az);
}

__global__ void __launch_bounds__(256) nv_gmlp(Ptrs P, int l) {
    extern __shared__ float vn[];
    const int ch = blockIdx.x, g = blockIdx.y, tid = threadIdx.x; const size_t row0 = (size_t)ch * CHK;
    const bf16_t* V = (const bf16_t*)(P.ws + WS_B3); bf16_t* B0 = (bf16_t*)(P.ws + WS_B0); const bf16_t* BZ = (const bf16_t*)(P.ws + WS_B4);
    const float* vss = (const float*)(P.ws + WS_VSS);
    const bf16_t* WSB = (const bf16_t*)(P.ws + WS_WSB) + ((size_t)l * NG + g) * CHK * CHK;
    for (int e = tid; e < 128 * 128; e += 256) { const int s = e >> 7, c = e & 127; const float* q = vss + (row0 + s) * 8;
        const float ss = ((q[0] + q[1]) + (q[2] + q[3])) + ((q[4] + q[5]) + (q[6] + q[7])); const float rv = rsqrtf(ss * (1.f / DB) + EPS);
        vn[s * 129 + c] = bfr(bf2f(V[(row0 + s) * 1024 + 512 + 128 * g + c]) * rv * P.gn_g[l * DB + 128 * g + c]); }
    __syncthreads();
    for (int e = tid; e < 128 * 128; e += 256) { const int t = e >> 7, c = e & 127; float acc = 0.f;
        for (int s = 0; s <= t; ++s) acc += bf2f(WSB[t * 128 + s]) * vn[s * 129 + c];
        acc += P.b_s[((size_t)l * NG + g) * CHK + t];
        const size_t o = (row0 + t) * 1024 + 512 + 128 * g + c;
        B0[o] = f2bf(bf2f(B0[o]) * acc * bf2f(BZ[(row0 + t) * 512 + 128 * g + c])); }
}

__global__ void __launch_bounds__(256) nv_attn(Ptrs P) {
    extern __shared__ float sc[];
    const int lane = threadIdx.x & 63, w = threadIdx.x >> 6; const int item = blockIdx.x * 4 + w, row = item >> 3, h = item & 7, b = row / SEQ, t = row % SEQ;
    float* s = sc + w * SEQ;
    bf16_t* B1 = (bf16_t*)(P.ws + WS_B1); const bf16_t* B2 = (const bf16_t*)(P.ws + WS_B2);
    const float* cs = (const float*)(P.ws + WS_CS) + (size_t)(b * NH + h) * SEQ;
    float q[64];
#pragma unroll
    for (int d = 0; d < 64; ++d) q[d] = bf2f(B1[(size_t)row * 1024 + 64 * h + d]);
    const float cq = cs[t]; float mx = -INFINITY;
    for (int k = lane; k <= t; k += 64) { const bf16_t* kr = B1 + ((size_t)b * SEQ + k) * 1024 + 512 + 64 * h; float dot = 0.f;
#pragma unroll
        for (int d8 = 0; d8 < 8; ++d8) { const bf16x8 kv = *(const bf16x8*)(kr + 8 * d8);
#pragma unroll
            for (int e = 0; e < 8; ++e) dot += q[8 * d8 + e] * bf2f((bf16_t)kv[e]); }
        const float v = dot + (cq - cs[k]); s[k] = v; mx = fmaxf(mx, v); }
#pragma unroll
    for (int o = 1; o < 64; o <<= 1) mx = fmaxf(mx, __shfl_xor(mx, o));
    float lsum = 0.f;
    for (int k = lane; k <= t; k += 64) { const float p = exp2f(s[k] - mx); lsum += p; s[k] = bfr(p); }
    lsum = wave_sum(lsum);
    __builtin_amdgcn_s_waitcnt(0); __builtin_amdgcn_wave_barrier();
    float o = 0.f; const bf16_t* vb = B2 + (size_t)b * SEQ * 1024 + 64 * h + lane;
    for (int k = 0; k <= t; ++k) o += s[k] * bf2f(vb[(size_t)k * 1024]);
    const float cz = bf2f(B2[(size_t)row * 1024 + 512 + 64 * h + lane]);
    B1[(size_t)row * 1024 + 64 * h + lane] = f2bf(o / lsum * cz);
}

__global__ void __launch_bounds__(256) nv_merge(Ptrs P, int l) {
    extern __shared__ float T[];
    const int pn = blockIdx.x, row0 = blockIdx.y * 64, tid = threadIdx.x, w = tid >> 6, ln = tid & 63, fr = ln & 15, fq = ln >> 4;
    const unsigned char* wl = P.ws + WS_W + (size_t)l * W_LAYER;
    const bf16_t* H = (const bf16_t*)(P.ws + WS_H); const bf16_t* WG = (const bf16_t*)(wl + WO_WG); const bf16_t* WAB = (const bf16_t*)(wl + WO_WAB); const bf16_t* WC = (const bf16_t*)(wl + WO_WC);
    const bf16_t* B0 = (const bf16_t*)(P.ws + WS_B0); const bf16_t* B1 = (const bf16_t*)(P.ws + WS_B1);
    float* G = T; float* MGs = T + 64 * 256;
    f32x4 acc[4][4];
    for (int br = 0; br < 3; ++br) {
        nv_gemm_acc(H + (size_t)row0 * D, D, WG + ((size_t)br * 1024 + 256 * pn) * D, D, D, acc);
#pragma unroll
        for (int m = 0; m < 4; ++m)
#pragma unroll
            for (int n = 0; n < 4; ++n)
#pragma unroll
                for (int r = 0; r < 4; ++r) { const int c = 64 * w + 16 * n + fr; G[((m * 4 + n) * 4 + r) * 256 + tid] = bfr(sigm(acc[m][n][r] + P.b_gate[(size_t)l * 3072 + br * 1024 + 256 * pn + c])); }
        const bf16_t* A = br == 0 ? B0 : (br == 1 ? B0 + 512 : B1); const bf16_t* Bt = br == 0 ? WAB : (br == 1 ? WAB + 512 : WC);
        nv_gemm_acc(A + (size_t)row0 * 1024, 1024, Bt + (size_t)256 * pn * 1024, 1024, 512, acc);
#pragma unroll
        for (int m = 0; m < 4; ++m)
#pragma unroll
            for (int n = 0; n < 4; ++n)
#pragma unroll
                for (int r = 0; r < 4; ++r) { const int s = ((m * 4 + n) * 4 + r) * 256 + tid; const float v = G[s] * acc[m][n][r]; MGs[s] = bfr(br == 0 ? v : MGs[s] + v); }
    }
    bf16_t* MG = (bf16_t*)(P.ws + WS_MG);
#pragma unroll
    for (int m = 0; m < 4; ++m)
#pragma unroll
        for (int n = 0; n < 4; ++n)
#pragma unroll
            for (int r = 0; r < 4; ++r) MG[(size_t)(row0 + 16 * m + 4 * fq + r) * 1024 + 256 * pn + 64 * w + 16 * n + fr] = f2bf(MGs[((m * 4 + n) * 4 + r) * 256 + tid]);
}

__global__ void __launch_bounds__(256) nv_out(Ptrs P, int l, const float* xin, float* xout) {
    const int pn = blockIdx.x, row0 = blockIdx.y * 64, tid = threadIdx.x, w = tid >> 6, ln = tid & 63, fr = ln & 15, fq = ln >> 4;
    const bf16_t* MG = (const bf16_t*)(P.ws + WS_MG); const bf16_t* WO = (const bf16_t*)(P.ws + WS_W + (size_t)l * W_LAYER + WO_WO);
    f32x4 acc[4][4];
    nv_gemm_acc(MG + (size_t)row0 * 1024, 1024, WO + (size_t)256 * pn * 1024, 1024, 1024, acc);
#pragma unroll
    for (int m = 0; m < 4; ++m)
#pragma unroll
        for (int n = 0; n < 4; ++n)
#pragma unroll
            for (int r = 0; r < 4; ++r) { const size_t o = (size_t)(row0 + 16 * m + 4 * fq + r) * D + 256 * pn + 64 * w + 16 * n + fr; xout[o] = xin[o] + acc[m][n][r]; }
}


#define LAS __attribute__((address_space(3)))
#define GAS __attribute__((address_space(1)))
__device__ __forceinline__ float wsum(float v) {
    v += __builtin_bit_cast(float, __builtin_amdgcn_update_dpp(0, __builtin_bit_cast(int, v), 0xB1, 0xF, 0xF, true));
    v += __builtin_bit_cast(float, __builtin_amdgcn_update_dpp(0, __builtin_bit_cast(int, v), 0x4E, 0xF, 0xF, true));
    v += __builtin_bit_cast(float, __builtin_amdgcn_update_dpp(0, __builtin_bit_cast(int, v), 0x141, 0xF, 0xF, true));
    v += __builtin_bit_cast(float, __builtin_amdgcn_update_dpp(0, __builtin_bit_cast(int, v), 0x140, 0xF, 0xF, true));
    const int iv = __builtin_bit_cast(int, v);
    return (__builtin_bit_cast(float, __builtin_amdgcn_readlane(iv, 0)) + __builtin_bit_cast(float, __builtin_amdgcn_readlane(iv, 16))) + (__builtin_bit_cast(float, __builtin_amdgcn_readlane(iv, 32)) + __builtin_bit_cast(float, __builtin_amdgcn_readlane(iv, 48)));
}
typedef GAS unsigned gu32;
#define RLX_AGENT __ATOMIC_RELAXED, __HIP_MEMORY_SCOPE_AGENT
#define LDS_WAIT() asm volatile("s_waitcnt lgkmcnt(0)" ::: "memory")
#define VM_WAIT() asm volatile("s_waitcnt vmcnt(0)" ::: "memory")
constexpr int NWAVES = 8;
constexpr int RING_OFF = 0, RING_BYTES = 131072;
constexpr int LDS_BYTES = 163840;
constexpr int LDSCTL_OFF = LDS_BYTES - 512, MISC_OFF = LDSCTL_OFF + 320;
constexpr int RT_OFF = LDSCTL_OFF - 1024;
constexpr int CW_TMO = 0, CW_CODE = 1, CW_BAR = 4096;
constexpr float SKIP_L2 = 160.f;
constexpr int NPH = 10;

__device__ __forceinline__ unsigned cvt_pk_bf16(float lo, float hi) { unsigned r; asm volatile("v_cvt_pk_bf16_f32 %0, %1, %2" : "=v"(r) : "v"(lo), "v"(hi)); return r; }
__device__ __forceinline__ float fsigm(float x) { return __builtin_amdgcn_rcpf(1.f + __builtin_amdgcn_exp2f(-LOG2E * x)); }
__device__ __forceinline__ u32x4 pack8(const f32x4& a, const f32x4& b) { u32x4 w; w.x = cvt_pk_bf16(a[0], a[1]); w.y = cvt_pk_bf16(a[2], a[3]); w.z = cvt_pk_bf16(b[0], b[1]); w.w = cvt_pk_bf16(b[2], b[3]); return w; }
__device__ __forceinline__ void unpack8(const u32x4& w, f32x4& a, f32x4& b) {
    a[0] = __uint_as_float(w.x << 16); a[1] = __uint_as_float(w.x & 0xffff0000u); a[2] = __uint_as_float(w.y << 16); a[3] = __uint_as_float(w.y & 0xffff0000u);
    b[0] = __uint_as_float(w.z << 16); b[1] = __uint_as_float(w.z & 0xffff0000u); b[2] = __uint_as_float(w.w << 16); b[3] = __uint_as_float(w.w & 0xffff0000u); }

namespace pg8 {
constexpr int BM = 256, BK = 64, HALF = 128, HTB = HALF * BK * 2, STAGE_BYTES = 8 * HTB, NXCD = 8, WGM = 8, PITCH = 1024;
__host__ __device__ __forceinline__ int lds_byte(int r, int c) { const int st = (r >> 4) * 2 + (c >> 5), rr = r & 15, cc = c & 31, ob = rr * 64 + cc * 2; return st * 1024 + (ob ^ (((ob >> 9) & 1) << 5)); }
__host__ __device__ __forceinline__ void stage_rc(int b, int& R, int& C) { const int st = b / 1024, sb = b % 1024, swz = sb ^ (((sb >> 9) & 1) << 5); R = (st >> 1) * 16 + swz / 64; C = (st & 1) * 32 + (swz % 64) / 2; }
__host__ __device__ __forceinline__ int perm32(int rho) { const int n = rho >> 4, i = rho & 15; return 8 * (i >> 2) + 4 * n + (i & 3); }

struct Unit { const char* A; const char* B; int nt, pm, pn, tag; };

struct TileOrder {
    int nM, nN, nwg, G, c;
    __device__ __forceinline__ void init(int Mr, int N, int G_, int c_) { nM = Mr / BM; nN = N / BM; nwg = nM * nN; G = G_; c = c_; }
    __device__ __forceinline__ bool tile(int i, int& pm, int& pn) const {
        const long L = (long)i * G + c; if (L >= nwg) return false;
        int wgid = (int)L; { const int q = nwg / NXCD, r = nwg % NXCD, xcd = wgid % NXCD, off = wgid / NXCD; wgid = (xcd < r ? xcd * (q + 1) : r * (q + 1) + (xcd - r) * q) + off; }
        const int nig = WGM * nN, gid = wgid / nig, fm = gid * WGM, gsz = (nM - fm) < WGM ? (nM - fm) : WGM;
        pm = fm + ((wgid % nig) % gsz); pn = (wgid % nig) / gsz; return true;
    }
};

template <class Epi, class Sched>
__device__ __forceinline__ void gemm_phase(LAS unsigned char* lds, const Sched& S, const Epi& E) {
    int tid = threadIdx.x; asm volatile("" : "+v"(tid));
    const int wid = __builtin_amdgcn_readfirstlane(tid >> 6), lane = tid & 63, wr = wid >> 2, wc = wid & 3, fr = lane & 15, fq = lane >> 4;
    unsigned voffA[2], voffB[2];
#pragma unroll
    for (int i = 0; i < 2; ++i) { int R, C; stage_rc(tid * 16 + i * 8192, R, C); const int Rb = (R & ~31) + perm32(R & 31);
        voffA[i] = (unsigned)(R * PITCH + C) * 2u; voffB[i] = (unsigned)(Rb * PITCH + C) * 2u; }
    const size_t kstep = (size_t)(BK * 2);
    const size_t hstep = (size_t)HALF * PITCH * 2;
    const unsigned ldsw = (unsigned)wid * 1024u;
    const int aoff = lds_byte(wr * 64 + fr, fq * 8), boff = lds_byte(wc * 32 + fr, fq * 8);
#define PG8_SA(b, h) (((b) * 2 + (h)) * HTB)
#define PG8_SB(b, h) ((4 + (b) * 2 + (h)) * HTB)
#define PG8_STAGE(bufoff, gbase, voff) do { _Pragma("unroll") for (int _i = 0; _i < 2; ++_i) \
        __builtin_amdgcn_global_load_lds((const unsigned*)((const char*)(gbase) + (voff)[_i]), (LAS unsigned*)(lds + (bufoff) + ldsw + _i * 8192), 16, 0, 0); } while (0)
#define PG8_LDA(dst, b, h) do { _Pragma("unroll") for (int m = 0; m < 4; ++m) _Pragma("unroll") for (int k = 0; k < 2; ++k) dst[m][k] = *(const LAS bf16x8*)(lds + PG8_SA(b, h) + aoff + m * 2048 + k * 1024); } while (0)
#define PG8_LDB(dst, b, h) do { _Pragma("unroll") for (int n = 0; n < 2; ++n) _Pragma("unroll") for (int k = 0; k < 2; ++k) dst[n][k] = *(const LAS bf16x8*)(lds + PG8_SB(b, h) + boff + n * 2048 + k * 1024); } while (0)
#define PG8_MMA(ai, bj, At, Bt) do { __builtin_amdgcn_s_setprio(1); _Pragma("unroll") for (int m = 0; m < 4; ++m) _Pragma("unroll") for (int n = 0; n < 2; ++n) _Pragma("unroll") for (int k = 0; k < 2; ++k) \
        acc[ai][bj][m][n] = __builtin_amdgcn_mfma_f32_16x16x32_bf16(Bt[n][k], At[m][k], acc[ai][bj][m][n], 0, 0, 0); __builtin_amdgcn_s_setprio(0); } while (0)
#define PG8_WAIT_V(n) asm volatile("s_waitcnt vmcnt(" #n ")" ::: "memory")
#define PG8_WAIT_L(n) asm volatile("s_waitcnt lgkmcnt(" #n ")" ::: "memory")
#define PG8_BAR __builtin_amdgcn_s_barrier()
#define PG8_SCHED __builtin_amdgcn_sched_barrier(0)
    Unit cur, nxt; int ui = 0;
    if (!S.next(0, cur)) return;
    f32x4 acc[2][2][4][2];
#pragma unroll
    for (int a = 0; a < 2; ++a)
#pragma unroll
        for (int b = 0; b < 2; ++b)
#pragma unroll
            for (int m = 0; m < 4; ++m)
#pragma unroll
                for (int n = 0; n < 2; ++n) acc[a][b][m][n] = (f32x4){0.f, 0.f, 0.f, 0.f};
    bf16x8 At[4][2], B0[2][2], B1[2][2];
    const char* cA = cur.A; const char* cB = cur.B;
    PG8_STAGE(PG8_SB(0, 0), cB, voffB); PG8_STAGE(PG8_SB(0, 1), cB + hstep, voffB); PG8_STAGE(PG8_SA(0, 0), cA, voffA); PG8_STAGE(PG8_SA(0, 1), cA + hstep, voffA);
    if (wr == 1) PG8_BAR;
    PG8_WAIT_V(2); PG8_BAR;
    PG8_STAGE(PG8_SB(1, 0), cB + kstep, voffB); PG8_STAGE(PG8_SA(1, 0), cA + kstep, voffA); PG8_STAGE(PG8_SB(1, 1), cB + hstep + kstep, voffB);
    PG8_WAIT_V(6); PG8_BAR;
    for (;;) {
        const bool has_next = S.next(ui + 1, nxt);
        const char* nA = has_next ? nxt.A : cA; const char* nB = has_next ? nxt.B : cB;
        const int nt = cur.nt;
        for (int t = 0; t < nt; t += 2) {
            const bool last = (t == nt - 2);
            const char* a1 = cA + (size_t)(t + 1) * kstep;
            const char* a2 = last ? nA : cA + (size_t)(t + 2) * kstep; const char* b2 = last ? nB : cB + (size_t)(t + 2) * kstep;
            const char* a3 = a2 + kstep; const char* b3 = b2 + kstep;
            PG8_LDB(B0, 0, 0); PG8_LDB(B1, 0, 1); PG8_SCHED; PG8_LDA(At, 0, 0); PG8_STAGE(PG8_SA(1, 1), a1 + hstep, voffA);
            PG8_WAIT_V(8); PG8_WAIT_L(0); PG8_BAR; PG8_MMA(0, 0, At, B0); PG8_MMA(0, 1, At, B1); PG8_BAR; PG8_SCHED;
            PG8_LDA(At, 0, 1); PG8_STAGE(PG8_SB(0, 0), b2, voffB); PG8_STAGE(PG8_SB(0, 1), b2 + hstep, voffB); PG8_STAGE(PG8_SA(0, 0), a2, voffA);
            PG8_WAIT_V(8); PG8_WAIT_L(0); PG8_BAR; PG8_MMA(1, 0, At, B0); PG8_MMA(1, 1, At, B1); PG8_BAR; PG8_SCHED;
            PG8_LDB(B0, 1, 0); PG8_LDB(B1, 1, 1); PG8_SCHED; PG8_LDA(At, 1, 0); PG8_STAGE(PG8_SA(0, 1), a2 + hstep, voffA);
            PG8_WAIT_V(8); PG8_WAIT_L(0); PG8_BAR; PG8_MMA(0, 0, At, B0); PG8_MMA(0, 1, At, B1); PG8_BAR; PG8_SCHED;
            PG8_LDA(At, 1, 1); PG8_STAGE(PG8_SB(1, 0), b3, voffB); PG8_STAGE(PG8_SB(1, 1), b3 + hstep, voffB); PG8_STAGE(PG8_SA(1, 0), a3, voffA);
            PG8_WAIT_V(8); PG8_WAIT_L(0); PG8_BAR; PG8_MMA(1, 0, At, B0); PG8_MMA(1, 1, At, B1); PG8_BAR; PG8_SCHED;
        }
        if (wr == 0) PG8_BAR;
        E(acc, cur, wr, wc, fr, fq);
        if (!has_next) break;
#pragma unroll
        for (int a = 0; a < 2; ++a)
#pragma unroll
            for (int b = 0; b < 2; ++b)
#pragma unroll
                for (int m = 0; m < 4; ++m)
#pragma unroll
                    for (int n = 0; n < 2; ++n) acc[a][b][m][n] = (f32x4){0.f, 0.f, 0.f, 0.f};
        cur = nxt; cA = nA; cB = nB; ++ui;
        if (wr == 1) PG8_BAR;
    }
    PG8_WAIT_V(0);
    PG8_BAR;
    E.after(acc, cur, lds, wr, wc, fr, fq);
#undef PG8_SA
#undef PG8_SB
#undef PG8_STAGE
#undef PG8_LDA
#undef PG8_LDB
#undef PG8_MMA
#undef PG8_WAIT_V
#undef PG8_WAIT_L
#undef PG8_BAR
#undef PG8_SCHED
}

struct EpiG1 {
    bf16_t *B0, *B1, *B2, *B3, *B4; float* vss; const float *gq, *gk; const LAS float* R;
    __device__ __forceinline__ void after(f32x4 (&)[2][2][4][2], const Unit&, LAS unsigned char*, int, int, int, int) const {}
    __device__ __forceinline__ void operator()(f32x4 (&acc)[2][2][4][2], const Unit& u, int wr, int wc, int fr, int fq) const {
        const int j = u.pn; const size_t rowb = (size_t)u.pm * BM + wr * 64 + fr; const int cl = 32 * wc + 8 * fq;
#pragma unroll
        for (int ai = 0; ai < 2; ++ai)
#pragma unroll
            for (int m = 0; m < 4; ++m) { const float rs = R[ai * HALF + wr * 64 + m * 16 + fr];
#pragma unroll
                for (int bj = 0; bj < 2; ++bj) { acc[ai][bj][m][0] *= rs; acc[ai][bj][m][1] *= rs; } }
        if (j < 4) {
#pragma unroll
            for (int ai = 0; ai < 2; ++ai)
#pragma unroll
                for (int m = 0; m < 4; ++m) { f32x4 o0, o1;
#pragma unroll
                    for (int e = 0; e < 4; ++e) { o0[e] = acc[ai][0][m][0][e] * fsigm(acc[ai][1][m][0][e]); o1[e] = acc[ai][0][m][1][e] * fsigm(acc[ai][1][m][1][e]); }
                    *(u32x4*)(B3 + (rowb + ai * HALF + m * 16) * 1024 + 128 * j + cl) = pack8(o0, o1); }
        } else if (j < 12 || j >= 16) {
            bf16_t* dst; int pitch, coff; bool act;
            if (j < 6) { dst = B0; pitch = 1024; coff = 256 * (j - 4); act = true; }
            else if (j < 8) { dst = B0; pitch = 1024; coff = 512 + 256 * (j - 6); act = false; }
            else if (j < 10) { dst = B3; pitch = 1024; coff = 512 + 256 * (j - 8); act = false; }
            else if (j < 12) { dst = B4; pitch = 512; coff = 256 * (j - 10); act = true; }
            else if (j < 18) { dst = B2; pitch = 1024; coff = 256 * (j - 16); act = false; }
            else { dst = B2; pitch = 1024; coff = 512 + 256 * (j - 18); act = true; }
            const bool stat = (j == 8 || j == 9);
#pragma unroll
            for (int ai = 0; ai < 2; ++ai)
#pragma unroll
                for (int m = 0; m < 4; ++m) { const size_t row = rowb + ai * HALF + m * 16; float s = 0.f;
#pragma unroll
                    for (int bj = 0; bj < 2; ++bj) { f32x4 v0 = acc[ai][bj][m][0], v1 = acc[ai][bj][m][1];
                        if (act) {
#pragma unroll
                            for (int e = 0; e < 4; ++e) { v0[e] = v0[e] * fsigm(v0[e]); v1[e] = v1[e] * fsigm(v1[e]); } }
                        s += (v0[0] * v0[0] + v0[1] * v0[1]) + (v0[2] * v0[2] + v0[3] * v0[3]) + (v1[0] * v1[0] + v1[1] * v1[1]) + (v1[2] * v1[2] + v1[3] * v1[3]);
                        *(u32x4*)(dst + row * pitch + coff + 128 * bj + cl) = pack8(v0, v1); }
                    if (stat) { s += __shfl_xor(s, 16); s += __shfl_xor(s, 32); if (fq == 0) vss[row * 8 + (j - 8) * 4 + wc] = s; } }
        } else {
            const bool isk = j >= 14; const int jj = (j - 12) & 1; const float* g = isk ? gk : gq; const float sc = isk ? 1.f : C2;
            f32x4 gv[2][2];
#pragma unroll
            for (int bj = 0; bj < 2; ++bj) { gv[bj][0] = *(const f32x4*)(g + 32 * bj + 8 * fq) * sc; gv[bj][1] = *(const f32x4*)(g + 32 * bj + 8 * fq + 4) * sc; }
            bf16_t* dst = B1 + (isk ? 512 : 0) + 64 * (4 * jj + wc) + 8 * fq;
#pragma unroll
            for (int ai = 0; ai < 2; ++ai)
#pragma unroll
                for (int m = 0; m < 4; ++m) { const size_t row = rowb + ai * HALF + m * 16; float s = 0.f;
#pragma unroll
                    for (int bj = 0; bj < 2; ++bj) { const f32x4 v0 = acc[ai][bj][m][0], v1 = acc[ai][bj][m][1];
                        s += (v0[0] * v0[0] + v0[1] * v0[1]) + (v0[2] * v0[2] + v0[3] * v0[3]) + (v1[0] * v1[0] + v1[1] * v1[1]) + (v1[2] * v1[2] + v1[3] * v1[3]); }
                    s += __shfl_xor(s, 16); s += __shfl_xor(s, 32);
                    const float r = __builtin_amdgcn_rsqf(s * (1.f / 64.f) + EPS);
#pragma unroll
                    for (int bj = 0; bj < 2; ++bj) *(u32x4*)(dst + row * 1024 + 32 * bj) = pack8(acc[ai][bj][m][0] * r * gv[bj][0], acc[ai][bj][m][1] * r * gv[bj][1]); }
        }
    }
};
struct EpiMerge {
    unsigned char* gt; bf16_t* MG; const float* bgate; const LAS float* R; int cls; size_t gt2off;
    __device__ __forceinline__ void after(f32x4 (&)[2][2][4][2], const Unit&, LAS unsigned char*, int, int, int, int) const {}
    __device__ __forceinline__ void operator()(f32x4 (&acc)[2][2][4][2], const Unit& u, int wr, int wc, int fr, int fq) const {
        const int tag = u.tag, br = tag >> 1; const size_t rowb = (size_t)u.pm * BM + wr * 64 + fr; const int col0 = u.pn * BM + 32 * wc + 8 * fq;
        u32x4* slots_ = (u32x4*)(gt + ((cls && br == 1) ? gt2off : (size_t)0)) + ((wr * 4 + wc) * 64 + fq * 16 + fr); asm volatile("" : "+v"(slots_)); __attribute__((address_space(1))) u32x4* slots = (__attribute__((address_space(1))) u32x4*)slots_;
        if ((tag & 1) == 0) {
            f32x4 bv[2][2];
#pragma unroll
            for (int bj = 0; bj < 2; ++bj) { bv[bj][0] = *(const f32x4*)(bgate + br * 1024 + col0 + 128 * bj); bv[bj][1] = *(const f32x4*)(bgate + br * 1024 + col0 + 128 * bj + 4); }
#pragma unroll
            for (int ai = 0; ai < 2; ++ai)
#pragma unroll
                for (int m = 0; m < 4; ++m)
#pragma unroll
                    for (int bj = 0; bj < 2; ++bj) { const float rs = R[ai * HALF + wr * 64 + m * 16 + fr]; f32x4 v0 = acc[ai][bj][m][0] * rs + bv[bj][0], v1 = acc[ai][bj][m][1] * rs + bv[bj][1];
#pragma unroll
                        for (int e = 0; e < 4; ++e) { v0[e] = fsigm(v0[e]); v1[e] = fsigm(v1[e]); }
                        slots[(size_t)(((ai * 4 + m) * 2 + bj) * 512)] = pack8(v0, v1); }
        } else {
#pragma unroll
            for (int ai = 0; ai < 2; ++ai)
#pragma unroll
                for (int m = 0; m < 4; ++m) {
#pragma unroll
                    for (int bj = 0; bj < 2; ++bj) { const u32x4 gw = slots[(size_t)(((ai * 4 + m) * 2 + bj) * 512)]; f32x4 g0, g1; unpack8(gw, g0, g1);
                        f32x4 v0 = g0 * acc[ai][bj][m][0], v1 = g1 * acc[ai][bj][m][1];
                        u32x4* p = (u32x4*)(MG + (rowb + ai * HALF + m * 16) * 1024 + col0 + 128 * bj);
                        if (br > 0) { const u32x4 ow = *p; f32x4 p0, p1; unpack8(ow, p0, p1); v0 += p0; v1 += p1; }
                        *p = pack8(v0, v1); }
                    if (m & 1) asm volatile("" ::: "memory"); }
        }
    }
};
struct EpiOut {
    const float* base; float* out;
    __device__ __forceinline__ void after(f32x4 (&)[2][2][4][2], const Unit&, LAS unsigned char*, int, int, int, int) const {}
    __device__ __forceinline__ void operator()(f32x4 (&acc)[2][2][4][2], const Unit& u, int wr, int wc, int fr, int fq) const {
        const size_t rowb = (size_t)u.pm * BM + wr * 64 + fr; const int col0 = u.pn * BM + 32 * wc + 8 * fq;
#pragma unroll
        for (int ai = 0; ai < 2; ++ai)
#pragma unroll
            for (int m = 0; m < 4; ++m) {
#pragma unroll
                for (int bj = 0; bj < 2; ++bj) { const size_t o = (rowb + ai * HALF + m * 16) * D + col0 + 128 * bj;
                    const f32x4 b0 = *(const f32x4*)(base + o), b1 = *(const f32x4*)(base + o + 4);
                    *(f32x4*)(out + o) = b0 + acc[ai][bj][m][0]; *(f32x4*)(out + o + 4) = b1 + acc[ai][bj][m][1]; }
                if (m & 1) asm volatile("" ::: "memory"); }
    }
};
struct EpiOutLN {
    const float* base; float* out; bf16_t* XG; const float* gnext; const float* wfnext; float* SSP; float* FP;
    __device__ __forceinline__ void operator()(f32x4 (&)[2][2][4][2], const Unit&, int, int, int, int) const {}
    __device__ __forceinline__ void after(f32x4 (&acc)[2][2][4][2], const Unit& u, LAS unsigned char* lds, int wr, int wc, int fr, int fq) const {
        const int tid = ((wr * 4 + wc) * 64) + fq * 16 + fr;
        const size_t rowb = (size_t)u.pm * BM + wr * 64 + fr; const int cl = 32 * wc + 8 * fq, col0 = u.pn * BM + cl;
        LAS float* FL = (LAS float*)lds;
        LAS float* WL = (LAS float*)(lds + 512 * 72 * 4);
        for (int i = tid; i < 256 * 8; i += 512) { const int c = i >> 3, e = i & 7; WL[i] = gnext[u.pn * BM + c] * wfnext[(size_t)(u.pn * BM + c) * NIN + e]; }
        f32x4 gv[2][2];
#pragma unroll
        for (int bj = 0; bj < 2; ++bj) { gv[bj][0] = *(const f32x4*)(gnext + col0 + 128 * bj); gv[bj][1] = *(const f32x4*)(gnext + col0 + 128 * bj + 4); }
#pragma unroll
        for (int ai = 0; ai < 2; ++ai)
#pragma unroll
            for (int m = 0; m < 4; ++m) { float ss = 0.f;
#pragma unroll
                for (int bj = 0; bj < 2; ++bj) { const size_t o = (rowb + ai * HALF + m * 16) * D + col0 + 128 * bj;
                    const f32x4 x0 = *(const f32x4*)(base + o) + acc[ai][bj][m][0], x1 = *(const f32x4*)(base + o + 4) + acc[ai][bj][m][1];
                    *(f32x4*)(out + o) = x0; *(f32x4*)(out + o + 4) = x1;
                    ss += (x0[0] * x0[0] + x0[1] * x0[1]) + (x0[2] * x0[2] + x0[3] * x0[3]) + (x1[0] * x1[0] + x1[1] * x1[1]) + (x1[2] * x1[2] + x1[3] * x1[3]);
                    const f32x4 h0 = x0 * gv[bj][0], h1 = x1 * gv[bj][1];
                    *(u32x4*)(XG + o) = pack8(h0, h1);
                    acc[ai][bj][m][0] = x0; acc[ai][bj][m][1] = x1; }
                FL[tid * 72 + 64 + ai * 4 + m] = ss;
                if (m & 1) asm volatile("" ::: "memory"); }
        asm volatile("s_waitcnt lgkmcnt(0)" ::: "memory"); __builtin_amdgcn_s_barrier(); asm volatile("" ::: "memory");
#pragma unroll
        for (int hh = 0; hh < 2; ++hh) {
            f32x4 f[8];
#pragma unroll
            for (int rg = 0; rg < 8; ++rg) f[rg] = (f32x4){0.f, 0.f, 0.f, 0.f};
#pragma unroll
            for (int bj = 0; bj < 2; ++bj)
#pragma unroll
                for (int n = 0; n < 2; ++n)
#pragma unroll
                    for (int i = 0; i < 4; ++i) { const f32x4 wv = *(const LAS f32x4*)(WL + (128 * bj + cl + 4 * n + i) * 8 + 4 * hh);
#pragma unroll
                        for (int ai = 0; ai < 2; ++ai)
#pragma unroll
                            for (int m = 0; m < 4; ++m) f[ai * 4 + m] += acc[ai][bj][m][n][i] * wv; }
#pragma unroll
            for (int rg = 0; rg < 8; ++rg) *(LAS f32x4*)(FL + tid * 72 + rg * 8 + 4 * hh) = f[rg];
            asm volatile("" ::: "memory");
        }
        asm volatile("s_waitcnt lgkmcnt(0)" ::: "memory"); __builtin_amdgcn_s_barrier(); asm volatile("" ::: "memory");
        { const int row = tid & 255, hb = (tid >> 8) * 4, ai_ = row >> 7, wr_ = (row >> 6) & 1, m_ = (row >> 4) & 3, fr_ = row & 15, rg = ai_ * 4 + m_;
          f32x4 sum = (f32x4){0.f, 0.f, 0.f, 0.f}; float ssum = 0.f;
#pragma unroll
          for (int wc_ = 0; wc_ < 4; ++wc_)
#pragma unroll
              for (int fq_ = 0; fq_ < 4; ++fq_) { const LAS float* src = FL + (((wr_ * 4 + wc_) * 64) + fq_ * 16 + fr_) * 72; sum += *(const LAS f32x4*)(src + rg * 8 + hb); ssum += src[64 + rg]; }
          const size_t grow = (size_t)u.pm * BM + row;
          *(f32x4*)(FP + (grow * 4 + u.pn) * 8 + hb) = sum;
          if (hb == 0) SSP[grow * 4 + u.pn] = ssum; }
    }
};
struct SchedG1 { TileOrder T; const char* A; const char* B;
    __device__ __forceinline__ bool next(int i, Unit& u) const { int pm, pn; if (!T.tile(i, pm, pn)) return false; u.pm = pm; u.pn = pn; u.tag = 0; u.nt = 16; u.A = A + (size_t)pm * (BM * PITCH * 2); u.B = B + (size_t)pn * (BM * PITCH * 2); return true; } };
struct SchedMerge { int pm, pn; bool ok; int cls; const char *ws, *wl;
    __device__ __forceinline__ bool next(int i, Unit& u) const { if (!ok || i >= 6) return false;
        const int tag = cls == 0 ? i : (i == 0 ? 0 : i == 1 ? 2 : i == 2 ? 1 : i == 3 ? 4 : i == 4 ? 3 : 5);
        const int br = tag >> 1; u.pm = pm; u.pn = pn; u.tag = tag;
        const size_t ro = (size_t)pm * (BM * PITCH * 2), co = (size_t)pn * (BM * PITCH * 2);
        if ((tag & 1) == 0) { u.nt = 16; u.A = ws + WS_H + ro; u.B = wl + WO_WG + (size_t)br * (1024 * PITCH * 2) + co; }
        else { u.nt = 8; const size_t ao = br == 0 ? WS_B0 : (br == 1 ? WS_B0 + 1024 : WS_B1), bo = br == 0 ? WO_WAB : (br == 1 ? WO_WAB + 1024 : WO_WC); u.A = ws + ao + ro; u.B = wl + bo + co; }
        return true; } };
}

#define XB_TMO      128
#define XB_XCNT(j)  (256  + 64 * (j))
#define XB_XSUB(j)  (1280 + 64 * (j))
#define XB_XGEN(j)  (2304 + 64 * (j))
#define XB_TOP      3328
#define XB_TOPGEN   3392
#define XCD_BAR_WORDS 3456
#define XB_SPIN_CAP (1u << 18)
__device__ __forceinline__ unsigned xb_ld(unsigned* p)              { return __hip_atomic_load(p, __ATOMIC_RELAXED, __HIP_MEMORY_SCOPE_AGENT); }
__device__ __forceinline__ unsigned xb_add(unsigned* p, unsigned v) { return __hip_atomic_fetch_add(p, v, __ATOMIC_RELAXED, __HIP_MEMORY_SCOPE_AGENT); }
__device__ __forceinline__ unsigned xb_xcc_id() { return (unsigned)__builtin_amdgcn_s_getreg((3 << 11) | 20) & 0xFu; }
#define XB_SPIN(cond, bar) do { unsigned _sp = 0; while (cond) { __builtin_amdgcn_s_sleep(1); \
    if ((++_sp & 255u) == 0u) { if (xb_ld(&(bar)[XB_TMO])) break; if (_sp > XB_SPIN_CAP) { atomicAdd(&(bar)[XB_TMO], 1u); break; } } } } while (0)
struct XcdBarrier { unsigned* bar; unsigned x; volatile LAS unsigned* st; };
__device__ __forceinline__ XcdBarrier xcd_barrier_post(unsigned* bar, volatile LAS unsigned* st) {
    XcdBarrier b; b.bar = bar; b.x = xb_xcc_id(); b.st = st;
    if (threadIdx.x == 0) (void)xb_add(&bar[XB_XCNT(b.x)], 1u);
    return b;
}
__device__ __forceinline__ void xcd_barrier_complete(unsigned* bar, unsigned x, unsigned& nloc, unsigned& nx) {
    const unsigned G = gridDim.x * gridDim.y * gridDim.z;
    unsigned sum, cnt, mine, sp = 0u;
    for (;;) {
        sum = 0u; cnt = 0u; mine = 0u;
#pragma unroll
        for (unsigned j = 0; j < 16; ++j) { const unsigned c = xb_ld(&bar[XB_XCNT(j)]); sum += c; cnt += (c > 0u) ? 1u : 0u; mine = (j == x) ? c : mine; }
        if (sum == G) break;
        __builtin_amdgcn_s_sleep(1);
        if ((++sp & 255u) == 0u) { if (xb_ld(&bar[XB_TMO])) break; if (sp > XB_SPIN_CAP) { atomicAdd(&bar[XB_TMO], 1u); break; } }
    }
    nloc = mine > 0u ? mine : 1u; nx = cnt > 0u ? cnt : 1u;
}
__device__ __forceinline__ void xcd_barrier(const XcdBarrier& b) {
    asm volatile("s_waitcnt vmcnt(0)" ::: "memory");
    __syncthreads();
    if (threadIdx.x == 0) {
        unsigned* bar = b.bar;
        __builtin_amdgcn_s_waitcnt(0);
        unsigned nloc = b.st[0], nx = b.st[1];
        if (nloc == 0u) { xcd_barrier_complete(bar, b.x, nloc, nx); b.st[0] = nloc; b.st[1] = nx; }
        const unsigned old = xb_add(&bar[XB_XSUB(b.x)], 1u);
        const unsigned gen = old / nloc;
        if (old + 1u == (gen + 1u) * nloc) {
            __builtin_amdgcn_fence(__ATOMIC_RELEASE, "agent");
            asm volatile("s_waitcnt vmcnt(0)" ::: "memory");
            const unsigned og = xb_add(&bar[XB_TOP], 1u);
            const unsigned tg = og / nx;
            if (og + 1u == (tg + 1u) * nx) xb_add(&bar[XB_TOPGEN], 1u);
            else XB_SPIN(xb_ld(&bar[XB_TOPGEN]) == tg, bar);
            __builtin_amdgcn_fence(__ATOMIC_ACQUIRE, "agent");
            xb_add(&bar[XB_XGEN(b.x)], 1u);
            asm volatile("s_waitcnt vmcnt(0)" ::: "memory");
        } else {
            XB_SPIN(xb_ld(&bar[XB_XGEN(b.x)]) == gen, bar);
            __builtin_amdgcn_fence(__ATOMIC_ACQUIRE, "agent");
            asm volatile("s_waitcnt vmcnt(0)" ::: "memory");
        }
    }
    __syncthreads();
}

struct Args { const float* in[18]; float* out; unsigned char* ws; int ph_lo, ph_hi, li, pad; };
struct Frame { LAS unsigned char* lds; int tid, lane, wave, vcu, G; Ptrs P; };

__device__ __forceinline__ unsigned pk2(float lo, float hi) { return (unsigned)f2bf(lo) | ((unsigned)f2bf(hi) << 16); }
__device__ __forceinline__ void p0_transpose_item(const float* W, int ldw, int src_col, int k0, bf16_t* WT, size_t dst_row, int dst_col, LAS float* scr, int lane) {
#pragma unroll 8
    for (int i = 0; i < 32; ++i) { const int kk = 2 * i + (lane >> 5); scr[kk * 33 + (lane & 31)] = W[(size_t)(k0 + kk) * ldw + src_col + (lane & 31)]; }
    LDS_WAIT(); asm volatile("" ::: "memory");
    const int c = lane & 7;
#pragma unroll
    for (int j = 0; j < 4; ++j) { const int n = (lane >> 3) + 8 * j; const LAS float* s = scr + (8 * c) * 33 + n;
        u32x4 o; o.x = pk2(s[0 * 33], s[1 * 33]); o.y = pk2(s[2 * 33], s[3 * 33]); o.z = pk2(s[4 * 33], s[5 * 33]); o.w = pk2(s[6 * 33], s[7 * 33]);
        *(GAS u32x4*)(WT + (dst_row + n) * 1024 + dst_col + k0 + 8 * c) = o; }
    LDS_WAIT(); asm volatile("" ::: "memory");
}
__device__ __forceinline__ void p0_weights(Frame& F) {
    LAS float* scr = (LAS float*)(F.lds + RING_OFF + F.wave * 16384);
    const int gw = F.vcu * NWAVES + F.wave, NGW = F.G * NWAVES;
    constexpr int I_W1 = 16 * (N1 / 32), I_WG = 16 * 96, I_Y = 8 * 32, I_WO = 16 * 32, I_L = I_W1 + I_WG + 3 * I_Y + I_WO;
    for (int it = gw; it < NL * I_L; it += NGW) {
        const int l = it / I_L; int r = it % I_L;
        unsigned char* wl = F.P.ws + WS_W + (size_t)l * W_LAYER; const float* win = F.P.w_in + (size_t)l * D * NIN;
        if (r < I_W1) { const int kb = r / (N1 / 32), nb = r % (N1 / 32); p0_transpose_item(win, NIN, g1_col(32 * nb), 64 * kb, (bf16_t*)(wl + WO_W1), 32 * nb, 0, scr, F.lane); continue; } r -= I_W1;
        if (r < I_WG) { const int kb = r / 96, nb = r % 96; p0_transpose_item(win, NIN, 32 * nb, 64 * kb, (bf16_t*)(wl + WO_WG), 32 * nb, 0, scr, F.lane); continue; } r -= I_WG;
        if (r < I_Y) { const int kb = r / 32, nb = r % 32; p0_transpose_item(F.P.w_a + (size_t)l * DA * D, D, 32 * nb, 64 * kb, (bf16_t*)(wl + WO_WAB), 32 * nb, 0, scr, F.lane); continue; } r -= I_Y;
        if (r < I_Y) { const int kb = r / 32, nb = r % 32; p0_transpose_item(F.P.w_b + (size_t)l * DB * D, D, 32 * nb, 64 * kb, (bf16_t*)(wl + WO_WAB), 32 * nb, 512, scr, F.lane); continue; } r -= I_Y;
        if (r < I_Y) { const int kb = r / 32, nb = r % 32; p0_transpose_item(F.P.w_c + (size_t)l * DC * D, D, 32 * nb, 64 * kb, (bf16_t*)(wl + WO_WC), 32 * nb, 0, scr, F.lane); continue; } r -= I_Y;
        { const int kb = r / 32, nb = r % 32; p0_transpose_item(F.P.w_out + (size_t)l * D * D, D, 32 * nb, 64 * kb, (bf16_t*)(wl + WO_WO), 32 * nb, 0, scr, F.lane); }
    }
    bf16_t* WSB = (bf16_t*)(F.P.ws + WS_WSB);
    for (int i = (int)blockIdx.x * 512 + F.tid; i < NL * NG * CHK * CHK; i += F.G * 512) { const int s = i & 127, t = (i >> 7) & 127; WSB[i] = s <= t ? f2bf(F.P.w_s[i]) : (bf16_t)0; }
}
__device__ __forceinline__ void p0_ln(Frame& F, int l, const float* xin) {
    LAS float* wf = (LAS float*)(F.lds + RING_OFF);
    const float* g = F.P.norm_g + (size_t)l * D; const float* win = F.P.w_in + (size_t)l * D * NIN;
    __syncthreads();
    for (int i = F.tid; i < D * 8; i += 512) { const int k = i >> 3, e = i & 7; wf[i] = g[k] * win[(size_t)k * NIN + OC_F + e]; }
    __syncthreads();
    const int gw = F.vcu * NWAVES + F.wave, NGW = F.G * NWAVES;
    bf16_t* H = (bf16_t*)(F.P.ws + WS_H); float* LOGF = (float*)(F.P.ws + WS_LOGF);
    f32x4 gv[4];
#pragma unroll
    for (int j = 0; j < 4; ++j) gv[j] = ((const f32x4*)g)[64 * j + F.lane];
    static_assert(M == 8 * 256 * NWAVES, "p0_ln: 8 rows per wave on a 256-workgroup grid");
    float zrow[8];
#pragma unroll
    for (int k = 0; k < 8; ++k) zrow[k] = 0.f;
    f32x4 v[8][4];
#pragma unroll
    for (int bt = 0; bt < 4; ++bt) {
        asm volatile("" ::: "memory");
        if ((bt & 1) == 0) {
#pragma unroll
            for (int k = 2 * bt; k < 2 * bt + 4; ++k) { const GAS f32x4* xr = (const GAS f32x4*)(xin + (size_t)(gw + k * NGW) * D) + F.lane;
#pragma unroll
                for (int j = 0; j < 4; ++j) v[k][j] = xr[64 * j]; }
            asm volatile("" ::: "memory"); }
        float r[2]; float f[2][8];
#pragma unroll
        for (int q = 0; q < 2; ++q) { float ss = 0.f;
#pragma unroll
            for (int j = 0; j < 4; ++j) { const f32x4 x = v[2 * bt + q][j]; ss += (x.x * x.x + x.y * x.y) + (x.z * x.z + x.w * x.w); }
            r[q] = rsqrtf(wsum(ss) * (1.f / D) + EPS);
#pragma unroll
            for (int e = 0; e < 8; ++e) f[q][e] = 0.f; }
#pragma unroll
        for (int j = 0; j < 4; ++j) {
#pragma unroll
            for (int q = 0; q < 2; ++q) { const f32x4 hv = v[2 * bt + q][j] * r[q] * gv[j];
                GAS unsigned long long* o8 = (GAS unsigned long long*)(H + (size_t)(gw + (2 * bt + q) * NGW) * D) + F.lane;
                o8[64 * j] = (unsigned long long)pk2(hv.x, hv.y) | ((unsigned long long)pk2(hv.z, hv.w) << 32); }
#pragma unroll
            for (int i = 0; i < 4; ++i) { const LAS f32x4* w4 = (const LAS f32x4*)(wf + (256 * j + 4 * F.lane + i) * 8); const f32x4 wa = w4[0], wb = w4[1];
#pragma unroll
                for (int q = 0; q < 2; ++q) { const float xv = v[2 * bt + q][j][i];
                    f[q][0] += xv * wa.x; f[q][1] += xv * wa.y; f[q][2] += xv * wa.z; f[q][3] += xv * wa.w; f[q][4] += xv * wb.x; f[q][5] += xv * wb.y; f[q][6] += xv * wb.z; f[q][7] += xv * wb.w; } }
        }
#pragma unroll
        for (int q = 0; q < 2; ++q) {
#pragma unroll
            for (int e = 0; e < 8; ++e) f[q][e] = wsum(f[q][e]);
            if (F.lane < 8) { float z = 0.f;
#pragma unroll
                for (int e = 0; e < 8; ++e) if (F.lane == e) z = f[q][e];
                zrow[2 * bt + q] = z * r[q]; } }
    }
    if (F.lane < 8) { const float bfv = F.P.b_f[l * NH + F.lane];
#pragma unroll
        for (int k = 0; k < 8; ++k) { const float z = zrow[k] + bfv; LOGF[(size_t)(gw + k * NGW) * 8 + F.lane] = fminf(z, 0.f) - log1pf(expf(-fabsf(z))); } }
    __syncthreads();
}
__device__ __forceinline__ void p1_scan(Frame& F, int bh, int l) {
    LAS float* sh = (LAS float*)(F.lds + RING_OFF);
    const int b = bh / NH, h = bh % NH, t0 = F.tid * 8;
    float c[8]; float run = 0.f;
    if (l == 0) { const float* lf = (const float*)(F.P.ws + WS_LOGF) + ((size_t)b * SEQ + t0) * 8 + h;
#pragma unroll
        for (int i = 0; i < 8; ++i) { run += lf[i * 8]; c[i] = run; }
    } else {
        const float* fp = (const float*)(F.P.ws + WS_FP) + ((size_t)b * SEQ + t0) * 32 + h; const float* sp = (const float*)(F.P.ws + WS_SSP) + ((size_t)b * SEQ + t0) * 4; const float bfv = F.P.b_f[l * NH + h];
        float z[8];
#pragma unroll
        for (int i = 0; i < 8; ++i) { const f32x4 q = *(const f32x4*)(sp + i * 4); const float r = rsqrtf(((q.x + q.y) + (q.z + q.w)) * (1.f / D) + EPS);
            z[i] = r * ((fp[i * 32] + fp[i * 32 + 8]) + (fp[i * 32 + 16] + fp[i * 32 + 24])) + bfv; }
#pragma unroll
        for (int i = 0; i < 8; ++i) { run += fminf(z[i], 0.f) - log1pf(expf(-fabsf(z[i]))); c[i] = run; }
    }
    float inc = run;
#pragma unroll
    for (int o = 1; o < 64; o <<= 1) { const float n = __shfl_up(inc, o); if (F.lane >= o) inc += n; }
    if (F.lane == 63) sh[F.wave] = inc;
    __syncthreads();
    float base = inc - run;
    for (int w = 0; w < F.wave; ++w) base += sh[w];
    float* cs = (float*)(F.P.ws + WS_CS) + (size_t)bh * SEQ + t0;
    *(f32x4*)cs = (f32x4){(base + c[0]) * LOG2E, (base + c[1]) * LOG2E, (base + c[2]) * LOG2E, (base + c[3]) * LOG2E};
    *(f32x4*)(cs + 4) = (f32x4){(base + c[4]) * LOG2E, (base + c[5]) * LOG2E, (base + c[6]) * LOG2E, (base + c[7]) * LOG2E};
    __syncthreads();
    LAS float* c2s = sh + 16;
#pragma unroll
    for (int i = 0; i < 8; ++i) c2s[t0 + i] = (base + c[i]) * LOG2E;
    __syncthreads();
    if (F.tid < SEQ / 256) { const int qb = F.tid, nt = 4 * qb + 4; const float cq = c2s[256 * qb]; int lo = 0, hi = nt - 4;
        while (lo < hi) { const int mid = (lo + hi) >> 1; if (cq - c2s[64 * mid + 63] >= -SKIP_L2) hi = mid; else lo = mid + 1; }
        ((int*)(F.P.ws + WS_TS))[bh * 16 + qb] = lo & ~1; }
    __syncthreads();
}


#include <hip/hip_bf16.h>
namespace attn_body {
using bf16=__hip_bfloat16;
using s16x4=__attribute__((ext_vector_type(4)))short;
using f32x16=__attribute__((ext_vector_type(16)))float;
constexpr int NHEAD=NH,D=64,DM=1024;
constexpr int NW=8,QBLK=32,QB=QBLK*NW,KVBLK=64,NQB=SEQ/QB;
__device__ __forceinline__ int crow(int r,int hi){return (r&3)+8*(r>>2)+4*hi;}
#define SBAR() __builtin_amdgcn_sched_barrier(0)
__device__ __forceinline__ void cmask(f32x16&p0,f32x16&p1,int jb,int qrel,int hi){
  const float NEG=-INFINITY; int kb=64*jb+4*hi;
  #pragma unroll
  for(int r=0;r<16;++r){int kv=kb+(r&3)+8*(r>>2); if(kv>qrel)p0[r]=NEG; if(kv+32>qrel)p1[r]=NEG;}
}
constexpr int NSLOT=3, SLOTB=8192;
constexpr int LDS_K=0, LDS_V=NSLOT*SLOTB, LDS_WS=2*NSLOT*SLOTB, LDS_OST=LDS_WS+NW*64*4, LDS_C2=LDS_OST+NW*4096, LDS_BYTES=LDS_C2+SEQ*4+512;
__device__ __forceinline__ void glds16(const void*gsrc,unsigned lds_dst){unsigned keep;
  asm volatile("s_mov_b32 %0, m0\n\ts_mov_b32 m0, %2\n\ts_nop 0\n\tglobal_load_lds_dwordx4 %1, off\n\ts_mov_b32 m0, %0":"=&s"(keep):"v"(gsrc),"s"(lds_dst):"memory");}
__device__ __forceinline__ float max3f(float a,float b,float c){float r;asm("v_max3_f32 %0, %1, %2, %3":"=v"(r):"v"(a),"v"(b),"v"(c));return r;}
__device__ __forceinline__ float max2f(float a,float b){float r;asm("v_max_f32_e32 %0, %1, %2":"=v"(r):"v"(a),"v"(b));return r;}
__device__ __forceinline__ float fadd_s(float a,float b){float r;asm("v_add_f32_e32 %0, %1, %2":"=v"(r):"v"(a),"v"(b));return r;}
__device__ __forceinline__ float fsub_s(float a,float b){float r;asm("v_sub_f32_e32 %0, %1, %2":"=v"(r):"v"(a),"v"(b));return r;}
typedef float f32x2_t __attribute__((ext_vector_type(2))); typedef __bf16 bf16x2_t __attribute__((ext_vector_type(2)));
__device__ __forceinline__ unsigned cvtpk_s(float lo,float hi){f32x2_t v={lo,hi};bf16x2_t b=__builtin_convertvector(v,bf16x2_t);return __builtin_bit_cast(unsigned,b);}
#define WAIT_BAR(N) asm volatile("s_waitcnt vmcnt(" #N ") lgkmcnt(0)\n\ts_barrier":::"memory")
__device__ __forceinline__ void split3(float x,unsigned&h,unsigned&m,unsigned&l){
  const unsigned u=__float_as_uint(x)&0xffff0000u; const float r1=x-__uint_as_float(u);
  const unsigned u1=__float_as_uint(r1)&0xffff0000u; const float r2=r1-__uint_as_float(u1);
  h=u>>16; m=u1>>16; l=__float_as_uint(r2)>>16; }
__device__ __forceinline__ bf16x8 make_qx(float base,int hi){ unsigned h,m,l; split3(base,h,m,l); u32x4 w; w.x=h|(m<<16); w.y=l|0x3f800000u; w.z=0x3f803f80u; w.w=0u; if(hi){w.x=0u;w.y=0u;w.z=0u;} return __builtin_bit_cast(bf16x8,w); }
__device__ __forceinline__ bf16x8 make_kx(float ck,int hi){ unsigned h,m,l; split3(-ck,h,m,l); u32x4 w; w.x=0x3f803f80u; w.y=0x3f80u|(h<<16); w.z=m|(l<<16); w.w=0u; if(hi){w.x=0u;w.y=0u;w.z=0u;} return __builtin_bit_cast(bf16x8,w); }

__device__ __forceinline__ void qkt(f32x16&p0,f32x16&p1,const char*Kslot,const bf16x8*qr,bf16x8 qx,bf16x8 kx0,bf16x8 kx1,int r32,int hi){
  const char*kb=Kslot+hi*1024+r32*16; const f32x16 z=f32x16{};
  p0=__builtin_amdgcn_mfma_f32_32x32x16_bf16(kx0,qx,z,0,0,0);p1=__builtin_amdgcn_mfma_f32_32x32x16_bf16(kx1,qx,z,0,0,0);
  #pragma unroll
  for(int d0=0;d0<4;++d0){
    const bf16x8 b0=*reinterpret_cast<const bf16x8*>(kb+d0*2048);
    const bf16x8 b1=*reinterpret_cast<const bf16x8*>(kb+d0*2048+512);
    p0=__builtin_amdgcn_mfma_f32_32x32x16_bf16(b0,qr[d0],p0,0,0,0);p1=__builtin_amdgcn_mfma_f32_32x32x16_bf16(b1,qr[d0],p1,0,0,0);}
}
typedef __attribute__((address_space(3))) const char* lds_cptr;
typedef short v4i16_t __attribute__((ext_vector_type(4)));
__device__ __forceinline__ void kload8(bf16x8*kf,lds_cptr kp){
  kf[0]=*(const __attribute__((address_space(3))) bf16x8*)(kp);      kf[1]=*(const __attribute__((address_space(3))) bf16x8*)(kp+512);
  kf[2]=*(const __attribute__((address_space(3))) bf16x8*)(kp+2048); kf[3]=*(const __attribute__((address_space(3))) bf16x8*)(kp+2560);
  kf[4]=*(const __attribute__((address_space(3))) bf16x8*)(kp+4096); kf[5]=*(const __attribute__((address_space(3))) bf16x8*)(kp+4608);
  kf[6]=*(const __attribute__((address_space(3))) bf16x8*)(kp+6144); kf[7]=*(const __attribute__((address_space(3))) bf16x8*)(kp+6656);
}
__device__ __forceinline__ void kload2(bf16x8*kf,lds_cptr kp,int j){ kf[2*j]=*(const __attribute__((address_space(3))) bf16x8*)(kp+j*2048); kf[2*j+1]=*(const __attribute__((address_space(3))) bf16x8*)(kp+j*2048+512); }
__device__ __forceinline__ s16x4 vtr(lds_cptr p){ return __builtin_bit_cast(s16x4,__builtin_amdgcn_ds_read_tr16_b64_v4i16((__attribute__((address_space(3))) v4i16_t*)p)); }
__device__ __forceinline__ float rowmax(const f32x16&p0,const f32x16&p1){
  float a=max3f(p0[0],p0[1],p1[0]),b=max3f(p0[2],p0[3],p1[1]);a=max3f(a,p1[2],p1[3]);
  #pragma unroll
  for(int r=4;r<16;r+=4){a=max3f(a,p0[r],p0[r+1]);b=max3f(b,p0[r+2],p0[r+3]);a=max3f(a,p1[r],p1[r+1]);b=max3f(b,p1[r+2],p1[r+3]);}
  const float m=max2f(a,b);
  auto rr=__builtin_amdgcn_permlane32_swap(__float_as_uint(m),__float_as_uint(m),false,false);
  return max2f(__uint_as_float(rr[0]),__uint_as_float(rr[1]));
}
__device__ __forceinline__ void pv(f32x16*o,int vb,bf16x8 pa0,bf16x8 pa1,bf16x8 pa2,bf16x8 pa3){
  #pragma unroll
  for(int d0=0;d0<2;++d0){s16x4 lo[4],hi[4];
    #pragma unroll
    for(int ks=0;ks<4;++ks){
      asm volatile("ds_read_b64_tr_b16 %0,%1 offset:%c2":"=&v"(lo[ks]):"v"(vb),"i"(d0*4096+ks*1024):"memory");
      asm volatile("ds_read_b64_tr_b16 %0,%1 offset:%c2":"=&v"(hi[ks]):"v"(vb),"i"(d0*4096+ks*1024+512):"memory");}
    asm volatile("s_waitcnt lgkmcnt(0)":::"memory");SBAR();
    #define PK(k) (bf16x8){lo[k][0],lo[k][1],lo[k][2],lo[k][3],hi[k][0],hi[k][1],hi[k][2],hi[k][3]}
    o[d0]=__builtin_amdgcn_mfma_f32_32x32x16_bf16(pa0,PK(0),o[d0],0,0,0);
    o[d0]=__builtin_amdgcn_mfma_f32_32x32x16_bf16(pa1,PK(1),o[d0],0,0,0);
    o[d0]=__builtin_amdgcn_mfma_f32_32x32x16_bf16(pa2,PK(2),o[d0],0,0,0);
    o[d0]=__builtin_amdgcn_mfma_f32_32x32x16_bf16(pa3,PK(3),o[d0],0,0,0);
    #undef PK
  }
}
#define ATTN_STORE16(p,v) (*(u32x4*)(p)=(v))
template<int THRL> __device__ __forceinline__ void attn_unit(int b,int h,int qb,const bf16*Q,const bf16*__restrict__ K,const bf16*__restrict__ V,const bf16*__restrict__ CZ,bf16*O,const float*__restrict__ c2g,int ts,float ub,char*shm){
  int tid=threadIdx.x; asm volatile("":"+v"(tid));
  const int lane=tid&63,r32=lane&31,hi=lane>>5; const int wid=__builtin_amdgcn_readfirstlane(tid>>6);
  const long rowbase=(long)b*SEQ; const int q0=qb*QB;
  const bf16*Qw=Q+(rowbase+q0+wid*QBLK)*DM+h*D;
  const bf16*Kh=K+(rowbase+(long)ts*KVBLK)*DM+h*D,*Vh=V+(rowbase+(long)ts*KVBLK)*DM+h*D;
  const unsigned lds0=(unsigned)(uintptr_t)shm;
  float*wsf=(float*)(shm+LDS_WS)+wid*64;
  float*c2l=(float*)(shm+LDS_C2);
  const bf16*ksrc=Kh+(long)lane*DM+wid*8;
  const bf16*vsrc=Vh+(long)(16*(wid&3)+(lane>>2))*DM+(wid>>2)*32+(lane&3)*8;
  const unsigned kdst=lds0+LDS_K+wid*1024, vdst=lds0+LDS_V+wid*1024;
  #define DMA_K(t,slot) glds16(ksrc+(long)(t)*KVBLK*DM,(unsigned)__builtin_amdgcn_readfirstlane(kdst+(slot)))
  #define DMA_V(t,slot) glds16(vsrc+(long)(t)*KVBLK*DM,(unsigned)__builtin_amdgcn_readfirstlane(vdst+(slot)))
  const int vb0=(int)(lds0+LDS_V)+((lane>>4)&1)*32+(lane&3)*8+(4*hi+((lane&15)>>2))*64;
  const char*Kbase=shm+LDS_K; bf16x8 kf[8];
  const lds_cptr shm3=(lds_cptr)shm; const lds_cptr kp0=shm3+LDS_K+hi*1024+r32*16; const lds_cptr vp0=shm3+LDS_V+((lane>>4)&1)*32+(lane&3)*8+(4*hi+((lane&15)>>2))*64;
  const int NT=(q0+QB)/KVBLK-ts;
  DMA_K(0,0);DMA_V(0,0);DMA_K(1,SLOTB);
  { const int kb0=ts*KVBLK; for(int i=tid*4;i<q0+QB-kb0;i+=NW*64*4)*(f32x4*)(c2l+i)=*(const f32x4*)(c2g+kb0+i); }
  bf16x8 qr[4];
  #pragma unroll
  for(int d0=0;d0<4;++d0)qr[d0]=*reinterpret_cast<const bf16x8*>(&Qw[(long)r32*DM+d0*16+hi*8]);
    float mhat=ub,l_reg=0.f;f32x16 o[2];o[0]=f32x16{};o[1]=f32x16{};
  const int qrel=wid*QBLK+r32;
  #define CMASK(P0,P1,t) do{int jb_=(t)-(NT-4); if(jb_>=0)cmask(P0,P1,jb_,qrel,hi);}while(0)
  bool resc=false;
  bf16x8 qx; float cq2;
  #define START(P0,P1) do{ resc=false; \
    _Pragma("unroll") for(int r=0;r<16;++r)P0[r]=__builtin_amdgcn_exp2f(P0[r]); }while(0)
  #define RESC() do{}while(0)
  f32x16 pA0,pA1,pB0,pB1;
  int sl_prev=0,sl_cur=0,sl_next=SLOTB;
  #define ROT() do{sl_prev=sl_cur;sl_cur=sl_next;sl_next=(sl_next==(NSLOT-1)*SLOTB)?0:sl_next+SLOTB;}while(0)
  DMA_K(2,2*SLOTB);
  WAIT_BAR(3);
  cq2=c2l[q0+qrel-ts*KVBLK]; qx=make_qx(cq2-mhat,hi);
  float ck0=c2l[r32],ck1=c2l[32+r32];
  { const bf16x8 kx0=make_kx(ck0,hi),kx1=make_kx(ck1,hi);
    qkt(pA0,pA1,Kbase,qr,qx,kx0,kx1,r32,hi); }
  asm volatile("s_nop 15\n\ts_nop 7":"+v"(pA0),"+v"(pA1));CMASK(pA0,pA1,0);
  ck0=c2l[64+r32];ck1=c2l[96+r32];
  START(pA0,pA1);
  _Pragma("unroll") for(int r=0;r<16;++r)pA1[r]=__builtin_amdgcn_exp2f(pA1[r]);
  WAIT_BAR(0);
  DMA_K(3,0);DMA_V(1,SLOTB);
  ROT();
  kload8(kf,kp0+sl_cur);
  WAIT_BAR(2);
  s16x4 vlo[8],vhi[8]; u32x4 pw0,pw1,pw2,pw3;
  #define PKW(P,B) cvtpk_s(P[B],P[B+1])
  #define PAF(k) __builtin_bit_cast(bf16x8,pw##k)
  #define VFR(i) (bf16x8){vlo[i][0],vlo[i][1],vlo[i][2],vlo[i][3],vhi[i][0],vhi[i][1],vhi[i][2],vhi[i][3]}
  #define PIN(x) asm volatile("":"+v"(x))
  #define MX3(a,b,c) __builtin_fmaxf(__builtin_fmaxf((a),(b)),(c))
  #define GAPA(MF,A0,A1,A2,A3,W0,W1,PW) do{ MF; sacc+=A0; sacc+=A1; sacc+=A2; sacc+=A3; PIN(sacc); W0; W1; PIN(PW); SBAR(); }while(0)
  #define EX(v) __builtin_amdgcn_exp2f(v)
  #define GAPB(MF,X,B) do{ MF; X[B]=EX(X[B]); X[B+1]=EX(X[B+1]); X[B+2]=EX(X[B+2]); X[B+3]=EX(X[B+3]); PIN(X); SBAR(); }while(0)
  #define VRD(i) do{ vlo[i]=vtr(vp_+(((i)>>2)*4096+((i)&3)*1024)); vhi[i]=vtr(vp_+(((i)>>2)*4096+((i)&3)*1024+512)); }while(0)
  #define KRD(G,j) do{ if(G){ kload2(kf,kp0+sl_next,j); SBAR(); } }while(0)
  #define STEP(C0,C1,P0,P1,t,GK,GV,GL) do{ SBAR(); \
    const lds_cptr vp_=vp0+sl_prev; \
    { const bf16x8 kx0_=make_kx(ck0,hi),kx1_=make_kx(ck1,hi); const f32x16 z_=f32x16{}; \
      C0=__builtin_amdgcn_mfma_f32_32x32x16_bf16(kx0_,qx,z_,0,0,0); C1=__builtin_amdgcn_mfma_f32_32x32x16_bf16(kx1_,qx,z_,0,0,0); } SBAR(); \
    VRD(0); SBAR(); float sacc=(P0[0]+P0[1]); \
    GAPA(C0=__builtin_amdgcn_mfma_f32_32x32x16_bf16(kf[0],qr[0],C0,0,0,0), P0[2],P0[3],P0[4],P0[5],     pw0[0]=PKW(P0,0), pw0[1]=PKW(P0,2), pw0); \
    VRD(4); SBAR(); GAPA(C1=__builtin_amdgcn_mfma_f32_32x32x16_bf16(kf[1],qr[0],C1,0,0,0), P0[6],P0[7],P0[8],P0[9],     pw0[2]=PKW(P0,4), pw0[3]=PKW(P0,6), pw0); \
    VRD(1); SBAR(); GAPA(C0=__builtin_amdgcn_mfma_f32_32x32x16_bf16(kf[2],qr[1],C0,0,0,0),   P0[10],P0[11],P0[12],P0[13], pw1[0]=PKW(P0,8), pw1[1]=PKW(P0,10), pw1); \
    VRD(5); SBAR(); GAPA(C1=__builtin_amdgcn_mfma_f32_32x32x16_bf16(kf[3],qr[1],C1,0,0,0),   P0[14],P0[15],P1[0],P1[1],   pw1[2]=PKW(P0,12),pw1[3]=PKW(P0,14), pw1); \
    VRD(2); SBAR(); GAPA(C0=__builtin_amdgcn_mfma_f32_32x32x16_bf16(kf[4],qr[2],C0,0,0,0),   P1[2],P1[3],P1[4],P1[5],     pw2[0]=PKW(P1,0), pw2[1]=PKW(P1,2), pw2); \
    VRD(6); SBAR(); GAPA(C1=__builtin_amdgcn_mfma_f32_32x32x16_bf16(kf[5],qr[2],C1,0,0,0),   P1[6],P1[7],P1[8],P1[9],     pw2[2]=PKW(P1,4), pw2[3]=PKW(P1,6), pw2); \
    VRD(3); SBAR(); GAPA(C0=__builtin_amdgcn_mfma_f32_32x32x16_bf16(kf[6],qr[3],C0,0,0,0),   P1[10],P1[11],P1[12],P1[13], pw3[0]=PKW(P1,8), pw3[1]=PKW(P1,10), pw3); \
    VRD(7); SBAR(); GAPA(C1=__builtin_amdgcn_mfma_f32_32x32x16_bf16(kf[7],qr[3],C1,0,0,0),   P1[14],P1[15],0.f,0.f,       pw3[2]=PKW(P1,12),pw3[3]=PKW(P1,14), pw3); \
    l_reg+=sacc; \
    if(GK){DMA_K((t)+3,sl_cur);} if(GV){DMA_V((t)+1,sl_next);} \
    if(GL){ ck0=c2l[64*((t)+1)+r32]; ck1=c2l[64*((t)+1)+32+r32]; } \
    CMASK(C0,C1,t); \
    SBAR(); \
    GAPB(o[0]=__builtin_amdgcn_mfma_f32_32x32x16_bf16(PAF(0),VFR(0),o[0],0,0,0), C0,0); \
    GAPB(o[1]=__builtin_amdgcn_mfma_f32_32x32x16_bf16(PAF(0),VFR(4),o[1],0,0,0), C0,4); \
    KRD(GL,0); GAPB(o[0]=__builtin_amdgcn_mfma_f32_32x32x16_bf16(PAF(1),VFR(1),o[0],0,0,0), C0,8); \
    KRD(GL,1); GAPB(o[1]=__builtin_amdgcn_mfma_f32_32x32x16_bf16(PAF(1),VFR(5),o[1],0,0,0), C0,12); \
    KRD(GL,2); GAPB(o[0]=__builtin_amdgcn_mfma_f32_32x32x16_bf16(PAF(2),VFR(2),o[0],0,0,0), C1,0); \
    KRD(GL,3); GAPB(o[1]=__builtin_amdgcn_mfma_f32_32x32x16_bf16(PAF(2),VFR(6),o[1],0,0,0), C1,4); \
    GAPB(o[0]=__builtin_amdgcn_mfma_f32_32x32x16_bf16(PAF(3),VFR(3),o[0],0,0,0), C1,8); \
    GAPB(o[1]=__builtin_amdgcn_mfma_f32_32x32x16_bf16(PAF(3),VFR(7),o[1],0,0,0), C1,12); \
    }while(0)
  int t=1;
  #undef CMASK
  #define CMASK(P0,P1,t) do{}while(0)
  for(;t+5<NT;t+=2){
    STEP(pB0,pB1,pA0,pA1,t,true,true,true);     WAIT_BAR(2); RESC(); ROT();
    STEP(pA0,pA1,pB0,pB1,t+1,true,true,true);   WAIT_BAR(2); RESC(); ROT();
  }
  #undef CMASK
  #define CMASK(P0,P1,t) do{int jb_=(t)-(NT-4); if(jb_>=0)cmask(P0,P1,jb_,qrel,hi);}while(0)
  #define ENDW(tt) do{ if((tt)+3<NT){WAIT_BAR(2);} else if((tt)+2<NT){WAIT_BAR(1);} else {WAIT_BAR(0);} }while(0)
  for(;t+1<NT;t+=2){
    STEP(pB0,pB1,pA0,pA1,t,(t+3<NT),(t+1<NT),(t+1<NT));       ENDW(t);   RESC(); ROT();
    STEP(pA0,pA1,pB0,pB1,t+1,(t+4<NT),(t+2<NT),(t+2<NT));     ENDW(t+1); RESC(); ROT();
  }
  STEP(pB0,pB1,pA0,pA1,NT-1,false,false,false); RESC();
  { float sacc=pB0[0]+pB0[1]; _Pragma("unroll") for(int r=2;r<16;++r)sacc+=pB0[r]; _Pragma("unroll") for(int r=0;r<16;++r)sacc+=pB1[r]; l_reg+=sacc;
    pw0=(u32x4){PKW(pB0,0),PKW(pB0,2),PKW(pB0,4),PKW(pB0,6)};pw1=(u32x4){PKW(pB0,8),PKW(pB0,10),PKW(pB0,12),PKW(pB0,14)};pw2=(u32x4){PKW(pB1,0),PKW(pB1,2),PKW(pB1,4),PKW(pB1,6)};pw3=(u32x4){PKW(pB1,8),PKW(pB1,10),PKW(pB1,12),PKW(pB1,14)};
    SBAR(); pv(o,vb0+sl_cur,PAF(0),PAF(1),PAF(2),PAF(3)); }
  #undef PKW
  #undef PAF
  #undef VFR
  #undef PIN
  #undef MX3
  #undef GAPA
  #undef GAPB
  #undef EX
  #undef VRD
  #undef KRD
  #undef STEP
  #undef ENDW
  {auto rr=__builtin_amdgcn_permlane32_swap(__float_as_uint(l_reg),__float_as_uint(l_reg),false,false);l_reg=__uint_as_float(rr[0])+__uint_as_float(rr[1]);}
  if(hi==0)wsf[32+r32]=l_reg;asm volatile("s_waitcnt lgkmcnt(0)":::"memory");
  bf16*Ow=O+(rowbase+q0+wid*QBLK)*DM+h*D;
  const unsigned short*Cw=(const unsigned short*)(CZ+(rowbase+q0+wid*QBLK)*DM+h*D);
  { bf16*stg=(bf16*)(shm+LDS_OST)+wid*2048;
    #pragma unroll
    for(int r=0;r<16;++r){const int orow=crow(r,hi); const float rl=__builtin_amdgcn_rcpf(wsf[32+orow]);
      #pragma unroll
      for(int d0=0;d0<2;++d0){ const float cz=__uint_as_float((unsigned)Cw[(long)orow*DM+d0*32+r32]<<16); stg[orow*64+d0*32+r32]=__float2bfloat16(o[d0][r]*rl*cz);} }
    asm volatile("s_waitcnt lgkmcnt(0)":::"memory");
    #pragma unroll
    for(int i=0;i<4;++i){const int row=i*8+(lane>>3),ch=lane&7; const u32x4 v=*(const u32x4*)(stg+row*64+ch*8); ATTN_STORE16(Ow+(long)row*DM+ch*8,v);} }
  asm volatile("s_waitcnt lgkmcnt(0)\n\ts_barrier":::"memory");
  #undef DMA_K
  #undef DMA_V
  #undef CMASK
  #undef START
  #undef RESC
  #undef ROT
}
#undef SBAR
#undef WAIT_BAR
}

typedef float f32x2 __attribute__((ext_vector_type(2)));
__device__ __forceinline__ void p2_conv(Frame& F, int l, int unit, bf16_t* outb, const bool pv_ = false) {
    const int tid = F.tid, lane = F.lane, w = F.wave;
    const size_t row0 = (size_t)unit * 64; const int tseq0 = (int)(row0 % SEQ);
    const bf16_t* AG = (const bf16_t*)(F.P.ws + WS_B3); const bf16_t* B0 = (const bf16_t*)(F.P.ws + WS_B0);
    LAS unsigned char* tile = F.lds + RING_OFF;
    for (int c = tid; c < 94 * 64; c += 512) { const int r = c >> 6, ch = c & 63, tr = r - (CW - 1); const bool valid = tseq0 + tr >= 0;
        u32x4 v = (u32x4){0u, 0u, 0u, 0u}; if (valid) v = *(const u32x4*)(AG + (size_t)((long)row0 + tr) * 1024 + ch * 8);
        *(LAS u32x4*)(tile + r * 1024 + ch * 16) = v; }
    LAS float* wl = (LAS float*)(tile + 94 * 1024);
    { const float* cwg = F.P.conv_w + (size_t)l * CW * DA; for (int c = tid; c < CW * DA / 4; c += 512) *(LAS f32x4*)(wl + 4 * c) = *(const f32x4*)(cwg + 4 * c); }
    __syncthreads();
    if (PROBE_CONV == 2 && pv_) { __syncthreads(); return; }
    f32x2 out[4][8]; float s1[8], s2[8];
#pragma unroll
    for (int o = 0; o < 8; ++o) { s1[o] = 0.f; s2[o] = 0.f; }
#pragma unroll
    for (int i = 0; i < 4; ++i) {
        __builtin_amdgcn_sched_barrier(0);
        int p = lane + 64 * i; asm volatile("" : "+v"(p));
        const LAS float* cw = wl + 2 * p;
        f32x2 wv[CW];
#pragma unroll
        for (int j = 0; j < CW; ++j) wv[j] = *(const LAS f32x2*)(cw + j * DA);
        const f32x2 cb = *(const f32x2*)(F.P.conv_b + l * DA + 2 * p);
        const LAS unsigned* tp = (const LAS unsigned*)(tile + (8 * w) * 1024 + 4 * p);
        f32x2 win[16];
#pragma unroll
        for (int k = 0; k < 16; ++k) { const unsigned u = tp[k * 256]; win[k] = (f32x2){__uint_as_float(u << 16), __uint_as_float(u & 0xffff0000u)}; }
#pragma unroll
        for (int o = 0; o < 8; ++o) out[i][o] = cb;
        __builtin_amdgcn_sched_barrier(0);
#pragma unroll
        for (int j = 0; j < CW; ++j) {
            if (!(PROBE_CONV == 1 && pv_))
#pragma unroll
            for (int o = 0; o < 8; ++o) out[i][o] += wv[j] * win[(j + o) & 15];
            asm volatile("" : "+v"(out[i][0]), "+v"(out[i][1]), "+v"(out[i][2]), "+v"(out[i][3]), "+v"(out[i][4]), "+v"(out[i][5]), "+v"(out[i][6]), "+v"(out[i][7]));
            if (j + 16 < 38) { const LAS unsigned* tq = tp; asm volatile("" : "+v"(tq)); const unsigned u = tq[(j + 16) * 256]; win[j & 15] = (f32x2){__uint_as_float(u << 16), __uint_as_float(u & 0xffff0000u)}; }
            __builtin_amdgcn_sched_barrier(0);
        }
#pragma unroll
        for (int o = 0; o < 8; ++o) { s1[o] += out[i][o].x + out[i][o].y; s2[o] += out[i][o].x * out[i][o].x + out[i][o].y * out[i][o].y; }
    }
    unsigned az[4][8];
#pragma unroll
    for (int i = 0; i < 4; ++i)
#pragma unroll
        for (int o = 0; o < 8; ++o) az[i][o] = *(const unsigned*)(B0 + (row0 + 8 * w + o) * 1024 + 2 * (lane + 64 * i));
#pragma unroll
    for (int o = 0; o < 8; ++o) { s1[o] = wsum(s1[o]); s2[o] = wsum(s2[o]); }
#pragma unroll
    for (int i = 0; i < 4; ++i) {
        const int p = lane + 64 * i;
        const f32x2 gg = *(const f32x2*)(F.P.cn_g + l * DA + 2 * p), be = *(const f32x2*)(F.P.cn_b + l * DA + 2 * p);
#pragma unroll
        for (int o = 0; o < 8; ++o) { const float mu = s1[o] * (1.f / DA), ex2 = s2[o] * (1.f / DA); const float rstd = rsqrtf(fmaxf(ex2 - mu * mu, 0.f) + EPS);
            f32x2 y = (out[i][o] - mu) * rstd * gg + be; y.x = y.x * fsigm(y.x); y.y = y.y * fsigm(y.y);
            *(unsigned*)(outb + (row0 + 8 * w + o) * 1024 + 2 * p) = cvt_pk_bf16(y.x * __uint_as_float(az[i][o] << 16), y.y * __uint_as_float(az[i][o] & 0xffff0000u)); }
    }
    __syncthreads();
}
__device__ __forceinline__ void p2_gmlp(Frame& F, int l, int unit, bf16_t* outb) {
    constexpr int VTP = 136;
    const int tid = F.tid, lane = F.lane, w = F.wave, fr = lane & 15, fq = lane >> 4, ch = unit >> 1, gp = unit & 1, c0 = 256 * gp; const size_t row0 = (size_t)ch * CHK;
    LAS bf16_t* vt = (LAS bf16_t*)(F.lds + RING_OFF);
    const bf16_t* V = (const bf16_t*)(F.P.ws + WS_B3) + 512 + c0; const bf16_t* U = (const bf16_t*)(F.P.ws + WS_B0) + 512 + c0; const bf16_t* BZ = (const bf16_t*)(F.P.ws + WS_B4) + c0;
    const float* vss = (const float*)(F.P.ws + WS_VSS); const float* gn = F.P.gn_g + l * DB + c0;
    const size_t t = row0 + 16 * w + fr;
    unsigned long long uu[16], zz[16];
#pragma unroll
    for (int n = 0; n < 16; ++n) { uu[n] = *(const unsigned long long*)(U + t * 1024 + 16 * n + 4 * fq); zz[n] = *(const unsigned long long*)(BZ + t * 512 + 16 * n + 4 * fq); }
    bf16x8 wf[2][4];
#pragma unroll
    for (int g2 = 0; g2 < 2; ++g2)
#pragma unroll
        for (int ks = 0; ks < 4; ++ks) wf[g2][ks] = *(const bf16x8*)((const bf16_t*)(F.P.ws + WS_WSB) + ((size_t)(l * NG + 2 * gp + g2) * CHK + 16 * w + fr) * CHK + 32 * ks + 8 * fq);
    const float bs0 = F.P.b_s[(size_t)(l * NG + 2 * gp) * CHK + 16 * w + fr], bs1 = F.P.b_s[(size_t)(l * NG + 2 * gp + 1) * CHK + 16 * w + fr];
    { const int sidx = tid & 127; const f32x4 qa = *(const f32x4*)(vss + (row0 + sidx) * 8), qb = *(const f32x4*)(vss + (row0 + sidx) * 8 + 4);
      const float ss = ((qa.x + qa.y) + (qa.z + qa.w)) + ((qb.x + qb.y) + (qb.z + qb.w)); const float rv = rsqrtf(ss * (1.f / DB) + EPS);
      u32x4 raw[8];
#pragma unroll
      for (int k = 0; k < 8; ++k) raw[k] = *(const u32x4*)(V + (row0 + sidx) * 1024 + ((tid >> 7) + 4 * k) * 8);
#pragma unroll
      for (int k = 0; k < 8; ++k) { const int c8 = ((tid >> 7) + 4 * k) * 8; f32x4 v0, v1; unpack8(raw[k], v0, v1); const f32x4 g0 = *(const f32x4*)(gn + c8), g1 = *(const f32x4*)(gn + c8 + 4);
          v0 = v0 * rv * g0; v1 = v1 * rv * g1;
#pragma unroll
          for (int e = 0; e < 4; ++e) { vt[(c8 + e) * VTP + sidx] = f2bf(v0[e]); vt[(c8 + 4 + e) * VTP + sidx] = f2bf(v1[e]); } } }
    __syncthreads();
    f32x4 acc[16];
#pragma unroll
    for (int n = 0; n < 16; ++n) acc[n] = (f32x4){0.f, 0.f, 0.f, 0.f};
#pragma unroll
    for (int ks = 0; ks < 4; ++ks) {
        if (32 * ks <= 16 * w + 15) {
#pragma unroll
            for (int n = 0; n < 16; ++n) { const bf16x8 vf = *(const LAS bf16x8*)(vt + (16 * n + fr) * VTP + 32 * ks + 8 * fq); acc[n] = __builtin_amdgcn_mfma_f32_16x16x32_bf16(vf, wf[n >> 3][ks], acc[n], 0, 0, 0); }
        }
    }
#pragma unroll
    for (int n = 0; n < 16; ++n) { const float bs = n < 8 ? bs0 : bs1;
        const unsigned u0 = (unsigned)uu[n], u1 = (unsigned)(uu[n] >> 32), z0 = (unsigned)zz[n], z1 = (unsigned)(zz[n] >> 32);
        const float o0 = __uint_as_float(u0 << 16) * (acc[n][0] + bs) * __uint_as_float(z0 << 16), o1 = __uint_as_float(u0 & 0xffff0000u) * (acc[n][1] + bs) * __uint_as_float(z0 & 0xffff0000u);
        const float o2 = __uint_as_float(u1 << 16) * (acc[n][2] + bs) * __uint_as_float(z1 << 16), o3 = __uint_as_float(u1 & 0xffff0000u) * (acc[n][3] + bs) * __uint_as_float(z1 & 0xffff0000u);
        *(unsigned long long*)(outb + 512 + c0 + t * 1024 + 16 * n + 4 * fq) = (unsigned long long)cvt_pk_bf16(o0, o1) | ((unsigned long long)cvt_pk_bf16(o2, o3) << 32); }
    __syncthreads();
}

__global__ void __launch_bounds__(NWAVES * 64, 2) mk_fwd(Args args) {
    extern __shared__ __attribute__((aligned(16))) unsigned char lds[];
    Frame F;
    F.lds = (LAS unsigned char*)lds;
    volatile LAS unsigned* MISC = (volatile LAS unsigned*)(F.lds + MISC_OFF);
    F.tid = threadIdx.x; F.lane = F.tid & 63; F.wave = __builtin_amdgcn_readfirstlane(F.tid >> 6);
    F.G = gridDim.x; { const int bx = blockIdx.x; F.vcu = (F.G % 8 == 0) ? (bx % 8) * (F.G / 8) + bx / 8 : bx; }
    F.P.x = args.in[0]; F.P.norm_g = args.in[1]; F.P.w_in = args.in[2]; F.P.b_gate = args.in[3]; F.P.conv_w = args.in[4]; F.P.conv_b = args.in[5]; F.P.cn_g = args.in[6]; F.P.cn_b = args.in[7]; F.P.w_a = args.in[8];
    F.P.gn_g = args.in[9]; F.P.w_s = args.in[10]; F.P.b_s = args.in[11]; F.P.w_b = args.in[12]; F.P.qn_g = args.in[13]; F.P.kn_g = args.in[14]; F.P.b_f = args.in[15]; F.P.w_c = args.in[16]; F.P.w_out = args.in[17];
    F.P.out = args.out; F.P.ws = args.ws;
    gu32* ctl = (gu32*)(args.ws + WS_CTL);
    for (int u = F.tid; u < (LDS_BYTES - LDSCTL_OFF) / 4; u += NWAVES * 64) ((LAS unsigned*)(F.lds + LDSCTL_OFF))[u] = 0u;
    __syncthreads();
    XcdBarrier bar = xcd_barrier_post((unsigned*)(ctl + CW_BAR) + args.li * XCD_BAR_WORDS, MISC + 8);

    bool dup_done = false;
    for (int ph = args.ph_lo; ph < args.ph_hi;) {
        const int l = ph / 5, p = ph % 5;
        const bool dummy = (PROBE_DUP >= 0) && p == PROBE_DUP && !dup_done;
        asm volatile("" : "+v"(F.tid)); F.lane = F.tid & 63;
        int bid = (int)blockIdx.x; asm volatile("" : "+s"(bid));
        unsigned char* ws = F.P.ws; unsigned char* wl = ws + WS_W + (size_t)l * W_LAYER;
        const float* xin = l == 0 ? F.P.x : F.P.out;
        if (p == 0) {
            if (l > 0) { ++ph; continue; }
            if (l == 0 && (!dummy || (PROBE_SUB & 1))) p0_weights(F);
            if (!dummy || (PROBE_SUB & 2)) p0_ln(F, l, xin);
        } else if (p == 1) {
            if (bid < NB * NH) p1_scan(F, bid, l);
            { pg8::TileOrder T0; T0.init(M, N1, F.G, bid); int pm_ = 0, pn_ = 0; (void)T0.tile(0, pm_, pn_);
              LAS float* Rt = (LAS float*)(F.lds + RT_OFF);
              if (F.tid < 256) { float r = 1.f; if (l > 0) { const f32x4 q = *(const f32x4*)((const float*)(ws + WS_SSP) + ((size_t)pm_ * 256 + F.tid) * 4); r = rsqrtf(((q.x + q.y) + (q.z + q.w)) * (1.f / D) + EPS); } Rt[F.tid] = r; }
              __syncthreads(); }
            pg8::SchedG1 S; S.T.init(M, N1, F.G, bid); S.A = (const char*)(ws + WS_H); S.B = (const char*)(wl + WO_W1);
            pg8::EpiG1 E{(bf16_t*)(ws + WS_B0), (bf16_t*)(ws + WS_B1), (bf16_t*)(ws + WS_B2), (bf16_t*)(ws + WS_B3), (bf16_t*)(ws + WS_B4), (float*)(ws + WS_VSS), F.P.qn_g + l * HD, F.P.kn_g + l * HD, (const LAS float*)(F.lds + RT_OFF)};
            pg8::gemm_phase<pg8::EpiG1, pg8::SchedG1>(F.lds + RING_OFF, S, E);
        } else if (p == 2) {
            for (int part = 0; part < 2; ++part) {
              asm volatile("" : "+v"(F.tid)); F.lane = F.tid & 63; asm volatile("" : "+s"(bid));
              if ((part == 0) == ((F.vcu & 1) == 0)) {
            if (!dummy || (PROBE_SUB & 1)) p2_conv(F, l, bid, dummy ? (bf16_t*)(ws + WS_DUMMY) : (bf16_t*)(ws + WS_B0), dummy);
            if (!dummy || (PROBE_SUB & 2)) { bf16_t* ob = dummy ? (bf16_t*)(ws + WS_DUMMY) : (bf16_t*)(ws + WS_B0); p2_gmlp(F, l, bid, ob); }
              } else {
            if (!dummy || (PROBE_SUB & 4)) { const int bh = F.vcu >> 3, sq = F.vcu & 7; const attn_body::bf16* b1 = (const attn_body::bf16*)(ws + WS_B1); const attn_body::bf16* b2 = (const attn_body::bf16*)(ws + WS_B2);
              const float* c2g = (const float*)(ws + WS_CS) + (size_t)bh * SEQ; const int* tsg = (const int*)(ws + WS_TS) + bh * 16;
              float gqm = fabsf(F.P.qn_g[l * HD + F.lane]), gkm = fabsf(F.P.kn_g[l * HD + F.lane]);
#pragma unroll
              for (int o_ = 1; o_ < 64; o_ <<= 1) { gqm = fmaxf(gqm, __shfl_xor(gqm, o_)); gkm = fmaxf(gkm, __shfl_xor(gkm, o_)); }
              const float ub = 64.f * C2 * gqm * gkm * 1.01f;
              for (int i = 0; i < 2; ++i) { const int qb = i == 0 ? 15 - sq : sq; const int ts = __builtin_amdgcn_readfirstlane(tsg[qb]); attn_body::attn_unit<8>(bh / NH, bh % NH, qb, b1, b1 + 512, b2, b2 + 512, dummy ? (attn_body::bf16*)(ws + WS_DUMMY) : (attn_body::bf16*)(ws + WS_B1), c2g, ts, ub, (char*)lds + RING_OFF); } }
              }
            }
        } else if (p == 3) {
            pg8::TileOrder T; T.init(M, D, F.G, bid);
            pg8::SchedMerge S; { int pm_ = 0, pn_ = 0; S.ok = T.tile(0, pm_, pn_); S.pm = pm_; S.pn = pn_; }
            S.ws = (const char*)ws; S.wl = (const char*)wl;
            S.cls = F.vcu & 1;
            pg8::EpiMerge E{ws + WS_GT + (size_t)bid * 131072, (bf16_t*)(ws + WS_MG), F.P.b_gate + (size_t)l * 3072, (const LAS float*)(F.lds + RT_OFF), S.cls, (size_t)(WS_B4 - WS_GT)};
            pg8::gemm_phase<pg8::EpiMerge, pg8::SchedMerge>(F.lds + RING_OFF, S, E);
        } else {
            pg8::SchedG1 S; S.T.init(M, D, F.G, bid); S.A = (const char*)(ws + WS_MG); S.B = (const char*)(wl + WO_WO);
            if (l + 1 < NL) {
                pg8::EpiOutLN E{xin, dummy ? (float*)(ws + WS_B0) : F.P.out, (bf16_t*)(ws + WS_H), F.P.norm_g + (size_t)(l + 1) * D, F.P.w_in + (size_t)(l + 1) * D * NIN + OC_F, (float*)(ws + WS_SSP), (float*)(ws + WS_FP)};
                pg8::gemm_phase<pg8::EpiOutLN, pg8::SchedG1>(F.lds + RING_OFF, S, E);
            } else {
                pg8::EpiOut E{xin, dummy ? (float*)(ws + WS_B0) : F.P.out};
                pg8::gemm_phase<pg8::EpiOut, pg8::SchedG1>(F.lds + RING_OFF, S, E);
            }
        }
        if (dummy) { dup_done = true; continue; }
        dup_done = false; ++ph;
        if (ph < args.ph_hi) xcd_barrier(bar);
    }
}

#ifndef MK_MODE
#define MK_MODE 2
#endif
extern "C" void kernel_launch(void* const* d_in, const int* in_sizes, int n_in, void* d_out, int out_size, void* d_ws, size_t ws_size, hipStream_t stream) {
    static int ok = 0;
    if (ok == 0) {
        if (n_in != 18 || in_sizes[0] != M * D || out_size != M * D || ws_size < WS_END) { fprintf(stderr, "kernel_launch: unexpected shapes (n_in %d in0 %d out %d ws %zu)\n", n_in, n_in > 0 ? in_sizes[0] : -1, out_size, ws_size); ok = -1; return; }
        const int tl = 64 * TLD * 4;
        (void)hipFuncSetAttribute((const void*)nv_gemm1, hipFuncAttributeMaxDynamicSharedMemorySize, tl);
        (void)hipFuncSetAttribute((const void*)nv_merge, hipFuncAttributeMaxDynamicSharedMemorySize, 2 * 64 * 256 * 4);
        (void)hipFuncSetAttribute((const void*)nv_gmlp, hipFuncAttributeMaxDynamicSharedMemorySize, 128 * 129 * 4);
        (void)hipFuncSetAttribute((const void*)nv_attn, hipFuncAttributeMaxDynamicSharedMemorySize, 4 * SEQ * 4);
        if (hipFuncSetAttribute((const void*)mk_fwd, hipFuncAttributeMaxDynamicSharedMemorySize, LDS_BYTES) != hipSuccess) { fprintf(stderr, "kernel_launch: hipFuncSetAttribute(mk_fwd) failed\n"); ok = -1; return; }
        int dev = 0, cus = 0; (void)hipGetDevice(&dev); (void)hipDeviceGetAttribute(&cus, hipDeviceAttributeMultiprocessorCount, dev);
        if (cus != 256) fprintf(stderr, "kernel_launch: note: %d CUs (built for 256)\n", cus);
        (void)hipGetLastError();
        ok = 1;
    }
    if (ok < 0) return;
    Ptrs P{};
    const float** pp = (const float**)&P;
    for (int i = 0; i < 18; ++i) pp[i] = (const float*)d_in[i];
    P.out = (float*)d_out; P.ws = (unsigned char*)d_ws;
    const int tl = 64 * TLD * 4;
#if MK_MODE == 0
    nv_prep<<<2048, 256, 0, stream>>>(P);
    for (int l = 0; l < NL; ++l) {
        const float* xin = l == 0 ? P.x : P.out;
        nv_ln<<<M / 4, 256, 0, stream>>>(P, l, xin);
        nv_scan<<<NB * NH, 256, 0, stream>>>(P);
        nv_gemm1<<<dim3(20, 256), 256, tl, stream>>>(P, l);
        nv_conv<<<M, 512, 0, stream>>>(P, l);
        nv_gmlp<<<dim3(128, 4), 256, 128 * 129 * 4, stream>>>(P, l);
        nv_attn<<<M * NH / 4, 256, 4 * SEQ * 4, stream>>>(P);
        nv_merge<<<dim3(4, 256), 256, 2 * 64 * 256 * 4, stream>>>(P, l);
        nv_out<<<dim3(4, 256), 256, 0, stream>>>(P, l, xin, P.out);
    }
#else
    (void)tl;
    if (hipMemsetAsync((char*)d_ws + WS_CTL, 0, CTL_ZERO_BYTES, stream) != hipSuccess) { fprintf(stderr, "kernel_launch: memset failed\n"); return; }
    Args a{};
    for (int i = 0; i < 18; ++i) a.in[i] = (const float*)d_in[i];
    a.out = (float*)d_out; a.ws = (unsigned char*)d_ws;
    auto mk = [&](int lo, int hi, int li) { a.ph_lo = lo; a.ph_hi = hi; a.li = li; hipLaunchKernelGGL(mk_fwd, dim3(256), dim3(NWAVES * 64), LDS_BYTES, stream, a);
        const hipError_t le = hipPeekAtLastError(); if (le != hipSuccess) fprintf(stderr, "kernel_launch: mk launch [%d,%d) failed: %s\n", lo, hi, hipGetErrorName(le)); };
#if MK_MODE == 1
    auto mixers = [&](int l) { nv_conv<<<M, 512, 0, stream>>>(P, l); nv_gmlp<<<dim3(128, 4), 256, 128 * 129 * 4, stream>>>(P, l); nv_attn<<<M * NH / 4, 256, 4 * SEQ * 4, stream>>>(P); };
    mk(0, 2, 0); mixers(0); mk(3, 7, 1); mixers(1); mk(8, 10, 2);
#else
    mk(0, NPH, 0);
#endif
#endif
}
```

```cpp
#include <hip/hip_runtime.h>
#include <cstdio>
#include <cstdint>
#include <cmath>

constexpr int NL = 2, NB = 4, SEQ = 4096, M = NB * SEQ, D = 1024;
constexpr int DA = 512, DB = 512, NH = 8, HD = 64, DC = 512, CW = 31, CHK = 128, NG = 4, GD = 128, NIN = 8200;
constexpr float EPS = 1e-6f;
constexpr float LOG2E = 1.4426950408889634f;
constexpr float C2 = 0.125f * LOG2E;
constexpr int N1 = 5120;
constexpr int OC_GATE = 0, OC_AIN = 3072, OC_AZ = 4096, OC_U = 4608, OC_V = 5120, OC_BZ = 5632, OC_Q = 6144, OC_K = 6656, OC_VA = 7168, OC_CZ = 7680, OC_F = 8192;

constexpr size_t MiB = 1u << 20;
constexpr size_t WS_CTL = 0, CTL_ZERO_BYTES = 1 * MiB;
constexpr size_t WS_VSS = 1 * MiB;
constexpr size_t WS_LOGF = WS_VSS + 512 * 1024;
constexpr size_t WS_CS = 2 * MiB;
constexpr size_t WS_WSB = WS_CS + 512 * 1024;
constexpr size_t WS_TS = 3 * MiB;
constexpr size_t WS_W = 4 * MiB, W_LAYER = 22 * MiB;
constexpr size_t WO_W1 = 0, WO_WG = 10 * MiB, WO_WAB = 16 * MiB, WO_WC = 18 * MiB, WO_WO = 20 * MiB;
constexpr size_t WS_H = 48 * MiB;
constexpr size_t WS_B0 = 80 * MiB;
constexpr size_t WS_B1 = 112 * MiB;
constexpr size_t WS_B2 = 144 * MiB;
constexpr size_t WS_B3 = 176 * MiB;
constexpr size_t WS_B4 = 208 * MiB;
constexpr size_t WS_GT = WS_B2, WS_MG = WS_B3;
constexpr size_t WS_FP = 240 * MiB;
constexpr size_t WS_SSP = 242 * MiB;
constexpr size_t WS_DUMMY = 224 * MiB;
constexpr size_t WS_END = 256 * MiB;
#ifndef PROBE_P3
#define PROBE_P3 0
#endif
#ifndef PROBE_CONV
#define PROBE_CONV 0
#endif
#ifndef PROBE_SUB
#define PROBE_SUB 7
#endif
#ifndef PROBE_DUP
#define PROBE_DUP -1
#endif

typedef unsigned short bf16_t;
typedef short bf16x8 __attribute__((ext_vector_type(8)));
typedef float f32x4 __attribute__((ext_vector_type(4)));
typedef unsigned u32x4 __attribute__((ext_vector_type(4)));

__host__ __device__ __forceinline__ float bf2f(bf16_t v) { union { unsigned u; float f; } c; c.u = (unsigned)v << 16; return c.f; }
__host__ __device__ __forceinline__ bf16_t f2bf(float f) { union { unsigned u; float f; } c; c.f = f; unsigned u = c.u; return (bf16_t)((u + 0x7fffu + ((u >> 16) & 1u)) >> 16); }
__device__ __forceinline__ float bfr(float f) { return bf2f(f2bf(f)); }
__device__ __forceinline__ float sigm(float x) { return 1.f / (1.f + __expf(-x)); }
__device__ __forceinline__ float siluf(float x) { return x * sigm(x); }

__host__ __device__ __forceinline__ int g1_col(int n) {
    const int j = n >> 8, lc = n & 255;
    if (j < 4) return lc < 128 ? OC_AIN + 128 * j + lc : OC_AIN + 512 + 128 * j + (lc - 128);
    if (j < 6) return OC_AZ + 256 * (j - 4) + lc;
    if (j < 8) return OC_U + 256 * (j - 6) + lc;
    if (j < 10) return OC_V + 256 * (j - 8) + lc;
    if (j < 12) return OC_BZ + 256 * (j - 10) + lc;
    if (j < 16) { const int isk = j >= 14, jj = (j - 12) & 1, head = 4 * jj + ((lc >> 5) & 3), d = 32 * (lc >> 7) + (lc & 31); return (isk ? OC_K : OC_Q) + 64 * head + d; }
    if (j < 18) return OC_VA + 256 * (j - 16) + lc;
    return OC_CZ + 256 * (j - 18) + lc;
}

struct Ptrs {
    const float *x, *norm_g, *w_in, *b_gate, *conv_w, *conv_b, *cn_g, *cn_b, *w_a, *gn_g, *w_s, *b_s, *w_b, *qn_g, *kn_g, *b_f, *w_c, *w_out;
    float* out; unsigned char* ws;
};

__global__ void nv_prep(Ptrs P) {
    const size_t gid = (size_t)blockIdx.x * blockDim.x + threadIdx.x, gsz = (size_t)gridDim.x * blockDim.x;
    for (int l = 0; l < NL; ++l) {
        unsigned char* wl = P.ws + WS_W + (size_t)l * W_LAYER;
        bf16_t* W1 = (bf16_t*)(wl + WO_W1); bf16_t* WG = (bf16_t*)(wl + WO_WG); bf16_t* WAB = (bf16_t*)(wl + WO_WAB); bf16_t* WC = (bf16_t*)(wl + WO_WC); bf16_t* WO = (bf16_t*)(wl + WO_WO);
        const float* win = P.w_in + (size_t)l * D * NIN;
        for (size_t i = gid; i < (size_t)N1 * D; i += gsz) { const int n = (int)(i >> 10), k = (int)(i & 1023); W1[i] = f2bf(win[(size_t)k * NIN + g1_col(n)]); }
        for (size_t i = gid; i < (size_t)3072 * D; i += gsz) { const int n = (int)(i >> 10), k = (int)(i & 1023); WG[i] = f2bf(win[(size_t)k * NIN + n]); }
        for (size_t i = gid; i < (size_t)1024 * 1024; i += gsz) { const int n = (int)(i >> 10), k = (int)(i & 1023);
            WAB[i] = f2bf(k < 512 ? P.w_a[((size_t)l * DA + k) * D + n] : P.w_b[((size_t)l * DB + (k - 512)) * D + n]);
            WC[i] = k < 512 ? f2bf(P.w_c[((size_t)l * DC + k) * D + n]) : (bf16_t)0;
            WO[i] = f2bf(P.w_out[((size_t)l * D + k) * D + n]); }
        bf16_t* WSB = (bf16_t*)(P.ws + WS_WSB) + (size_t)l * NG * CHK * CHK;
        for (size_t i = gid; i < (size_t)NG * CHK * CHK; i += gsz) { const int s = (int)(i & 127), t = (int)((i >> 7) & 127); WSB[i] = s <= t ? f2bf(P.w_s[(size_t)l * NG * CHK * CHK + i]) : (bf16_t)0; }
    }
}

__device__ __forceinline__ float wave_sum(float v) {
#pragma unroll
    for (int o = 1; o < 64; o <<= 1) v += __shfl_xor(v, o);
    return v;
}

__global__ void nv_ln(Ptrs P, int l, const float* xin) {
    const int lane = threadIdx.x & 63, row = blockIdx.x * 4 + (threadIdx.x >> 6);
    const float* xr = xin + (size_t)row * D; const float* g = P.norm_g + (size_t)l * D; const float* win = P.w_in + (size_t)l * D * NIN;
    float v[16]; float ss = 0.f;
#pragma unroll
    for (int j = 0; j < 16; ++j) { v[j] = xr[lane + 64 * j]; ss += v[j] * v[j]; }
    ss = wave_sum(ss);
    const float r = rsqrtf(ss * (1.f / D) + EPS);
    bf16_t* h = (bf16_t*)(P.ws + WS_H) + (size_t)row * D;
    float f[8] = {0, 0, 0, 0, 0, 0, 0, 0};
#pragma unroll
    for (int j = 0; j < 16; ++j) { const int k = lane + 64 * j; const float hv = v[j] * r * g[k]; h[k] = f2bf(hv);
#pragma unroll
        for (int e = 0; e < 8; ++e) f[e] += hv * win[(size_t)k * NIN + OC_F + e]; }
#pragma unroll
    for (int e = 0; e < 8; ++e) f[e] = wave_sum(f[e]);
    if (lane < 8) { float z = 0.f;
#pragma unroll
        for (int e = 0; e < 8; ++e) if (lane == e) z = f[e];
        z += P.b_f[l * NH + lane];
        const float lf = fminf(z, 0.f) - log1pf(expf(-fabsf(z)));
        ((float*)(P.ws + WS_LOGF))[(size_t)row * 8 + lane] = lf; }
}

__global__ void nv_scan(Ptrs P) {
    __shared__ float buf[SEQ];
    const int bh = blockIdx.x, b = bh / NH, h = bh % NH;
    const float* lf = (const float*)(P.ws + WS_LOGF);
    for (int t = threadIdx.x; t < SEQ; t += blockDim.x) buf[t] = lf[((size_t)b * SEQ + t) * 8 + h];
    __syncthreads();
    if (threadIdx.x == 0) { float c = 0.f; for (int t = 0; t < SEQ; ++t) { c += buf[t]; buf[t] = c * LOG2E; } }
    __syncthreads();
    float* cs = (float*)(P.ws + WS_CS) + (size_t)bh * SEQ;
    for (int t = threadIdx.x; t < SEQ; t += blockDim.x) cs[t] = buf[t];
}

constexpr int TLD = 257;
__device__ __forceinline__ void nv_gemm_acc(const bf16_t* A, int lda, const bf16_t* Bt, int ldb, int K, f32x4 (&acc)[4][4]) {
    const int tid = threadIdx.x, w = tid >> 6, l = tid & 63, fr = l & 15, fq = l >> 4;
#pragma unroll
    for (int m = 0; m < 4; ++m)
#pragma unroll
        for (int n = 0; n < 4; ++n) acc[m][n] = (f32x4){0.f, 0.f, 0.f, 0.f};
    for (int k0 = 0; k0 < K; k0 += 32) {
        bf16x8 a[4], b[4];
#pragma unroll
        for (int m = 0; m < 4; ++m) a[m] = *(const bf16x8*)(A + (size_t)(16 * m + fr) * lda + k0 + 8 * fq);
#pragma unroll
        for (int n = 0; n < 4; ++n) b[n] = *(const bf16x8*)(Bt + (size_t)(64 * w + 16 * n + fr) * ldb + k0 + 8 * fq);
#pragma unroll
        for (int m = 0; m < 4; ++m)
#pragma unroll
            for (int n = 0; n < 4; ++n) acc[m][n] = __builtin_amdgcn_mfma_f32_16x16x32_bf16(a[m], b[n], acc[m][n], 0, 0, 0);
    }
}
__device__ __forceinline__ void nv_gemm_tile(const bf16_t* A, int lda, const bf16_t* Bt, int ldb, int K, float* T) {
    const int tid = threadIdx.x, w = tid >> 6, l = tid & 63, fr = l & 15, fq = l >> 4;
    f32x4 acc[4][4];
    nv_gemm_acc(A, lda, Bt, ldb, K, acc);
#pragma unroll
    for (int m = 0; m < 4; ++m)
#pragma unroll
        for (int n = 0; n < 4; ++n)
#pragma unroll
            for (int r = 0; r < 4; ++r) T[(16 * m + 4 * fq + r) * TLD + 64 * w + 16 * n + fr] = acc[m][n][r];
}

__global__ void __launch_bounds__(256) nv_gemm1(Ptrs P, int l) {
    extern __shared__ float T[];
    __shared__ float R[64 * 4];
    const int j = blockIdx.x, row0 = blockIdx.y * 64, tid = threadIdx.x;
    const bf16_t* H = (const bf16_t*)(P.ws + WS_H);
    const bf16_t* W1 = (const bf16_t*)(P.ws + WS_W + (size_t)l * W_LAYER + WO_W1);
    nv_gemm_tile(H + (size_t)row0 * D, D, W1 + (size_t)j * 256 * D, D, D, T);
    __syncthreads();
    bf16_t* B0 = (bf16_t*)(P.ws + WS_B0); bf16_t* B1 = (bf16_t*)(P.ws + WS_B1); bf16_t* B2 = (bf16_t*)(P.ws + WS_B2); bf16_t* B3 = (bf16_t*)(P.ws + WS_B3); bf16_t* B4 = (bf16_t*)(P.ws + WS_B4);
    if (j < 4) {
        for (int e = tid; e < 64 * 128; e += 256) { const int r = e >> 7, c = e & 127; B3[(size_t)(row0 + r) * 1024 + 128 * j + c] = f2bf(T[r * TLD + c] * sigm(T[r * TLD + c + 128])); }
    } else if (j < 12 || j >= 16) {
        bf16_t* dst; int pitch, coff; bool act;
        if (j < 6) { dst = B0; pitch = 1024; coff = 256 * (j - 4); act = true; }
        else if (j < 8) { dst = B0; pitch = 1024; coff = 512 + 256 * (j - 6); act = false; }
        else if (j < 10) { dst = B3; pitch = 1024; coff = 512 + 256 * (j - 8); act = false; }
        else if (j < 12) { dst = B4; pitch = 512; coff = 256 * (j - 10); act = true; }
        else if (j < 18) { dst = B2; pitch = 1024; coff = 256 * (j - 16); act = false; }
        else { dst = B2; pitch = 1024; coff = 512 + 256 * (j - 18); act = true; }
        for (int e = tid; e < 64 * 256; e += 256) { const int r = e >> 8, c = e & 255; const float v = T[r * TLD + c]; dst[(size_t)(row0 + r) * pitch + coff + c] = f2bf(act ? siluf(v) : v); }
        if (j == 8 || j == 9) { const int r = tid >> 2, wc = tid & 3; float s = 0.f;
            for (int bj = 0; bj < 2; ++bj) for (int i = 0; i < 32; ++i) { const float v = T[r * TLD + 128 * bj + 32 * wc + i]; s += v * v; }
            ((float*)(P.ws + WS_VSS))[(size_t)(row0 + r) * 8 + (j - 8) * 4 + wc] = s; }
    } else {
        const bool isk = j >= 14; const int jj = (j - 12) & 1;
        { const int r = tid >> 2, hh = tid & 3; float s = 0.f;
          for (int d = 0; d < 64; ++d) { const float v = T[r * TLD + 128 * (d >> 5) + 32 * hh + (d & 31)]; s += v * v; }
          R[r * 4 + hh] = rsqrtf(s * (1.f / 64.f) + EPS); }
        __syncthreads();
        const float* gq = (isk ? P.kn_g : P.qn_g) + (size_t)l * HD;
        for (int e = tid; e < 64 * 256; e += 256) { const int r = e >> 8, c = e & 255, hh = (c >> 5) & 3, d = 32 * (c >> 7) + (c & 31);
            float v = T[r * TLD + c] * R[r * 4 + hh] * gq[d]; if (!isk) v *= C2;
            B1[(size_t)(row0 + r) * 1024 + (isk ? 512 : 0) + 64 * (4 * jj + hh) + d] = f2bf(v); }
    }
}

__global__ void __launch_bounds__(512) nv_conv(Ptrs P, int l) {
    __shared__ float red[16];
    const int row = blockIdx.x, t = row % SEQ, c = threadIdx.x, lane = c & 63, w = c >> 6;
    const bf16_t* AG = (const bf16_t*)(P.ws + WS_B3); bf16_t* B0 = (bf16_t*)(P.ws + WS_B0);
    const float* cw = P.conv_w + (size_t)l * CW * DA;
    float a = P.conv_b[l * DA + c];
    for (int j = 0; j < CW; ++j) { const int tt = t - (CW - 1) + j; if (tt >= 0) a += cw[j * DA + c] * bf2f(AG[(size_t)(row - (CW - 1) + j) * 1024 + c]); }
    float s = wave_sum(a); if (lane == 0) red[w] = s; __syncthreads();
    float mu = 0.f; for (int i = 0; i < 8; ++i) mu += red[i]; mu *= (1.f / DA);
    const float d = a - mu; s = wave_sum(d * d); if (lane == 0) red[8 + w] = s; __syncthreads();
    float var = 0.f; for (int i = 0; i < 8; ++i) var += red[8 + i]; var *= (1.f / DA);
    const float y = d * rsqrtf(var + EPS) * P.cn_g[l * DA + c] + P.cn_b[l * DA + c];
    const float az = bf2f(B0[(size_t)row * 1024 + c]);
    B0[(size_t)row * 1024 + c] = f2bf(siluf(y) * az);
}

__global__ void __launch_bounds__(256) nv_gmlp(Ptrs P, int l) {
    extern __shared__ float vn[];
    const int ch = blockIdx.x, g = blockIdx.y, tid = threadIdx.x; const size_t row0 = (size_t)ch * CHK;
    const bf16_t* V = (const bf16_t*)(P.ws + WS_B3); bf16_t* B0 = (bf16_t*)(P.ws + WS_B0); const bf16_t* BZ = (const bf16_t*)(P.ws + WS_B4);
    const float* vss = (const float*)(P.ws + WS_VSS);
    const bf16_t* WSB = (const bf16_t*)(P.ws + WS_WSB) + ((size_t)l * NG + g) * CHK * CHK;
    for (int e = tid; e < 128 * 128; e += 256) { const int s = e >> 7, c = e & 127; const float* q = vss + (row0 + s) * 8;
        const float ss = ((q[0] + q[1]) + (q[2] + q[3])) + ((q[4] + q[5]) + (q[6] + q[7])); const float rv = rsqrtf(ss * (1.f / DB) + EPS);
        vn[s * 129 + c] = bfr(bf2f(V[(row0 + s) * 1024 + 512 + 128 * g + c]) * rv * P.gn_g[l * DB + 128 * g + c]); }
    __syncthreads();
    for (int e = tid; e < 128 * 128; e += 256) { const int t = e >> 7, c = e & 127; float acc = 0.f;
        for (int s = 0; s <= t; ++s) acc += bf2f(WSB[t * 128 + s]) * vn[s * 129 + c];
        acc += P.b_s[((size_t)l * NG + g) * CHK + t];
        const size_t o = (row0 + t) * 1024 + 512 + 128 * g + c;
        B0[o] = f2bf(bf2f(B0[o]) * acc * bf2f(BZ[(row0 + t) * 512 + 128 * g + c])); }
}

__global__ void __launch_bounds__(256) nv_attn(Ptrs P) {
    extern __shared__ float sc[];
    const int lane = threadIdx.x & 63, w = threadIdx.x >> 6; const int item = blockIdx.x * 4 + w, row = item >> 3, h = item & 7, b = row / SEQ, t = row % SEQ;
    float* s = sc + w * SEQ;
    bf16_t* B1 = (bf16_t*)(P.ws + WS_B1); const bf16_t* B2 = (const bf16_t*)(P.ws + WS_B2);
    const float* cs = (const float*)(P.ws + WS_CS) + (size_t)(b * NH + h) * SEQ;
    float q[64];
#pragma unroll
    for (int d = 0; d < 64; ++d) q[d] = bf2f(B1[(size_t)row * 1024 + 64 * h + d]);
    const float cq = cs[t]; float mx = -INFINITY;
    for (int k = lane; k <= t; k += 64) { const bf16_t* kr = B1 + ((size_t)b * SEQ + k) * 1024 + 512 + 64 * h; float dot = 0.f;
#pragma unroll
        for (int d8 = 0; d8 < 8; ++d8) { const bf16x8 kv = *(const bf16x8*)(kr + 8 * d8);
#pragma unroll
            for (int e = 0; e < 8; ++e) dot += q[8 * d8 + e] * bf2f((bf16_t)kv[e]); }
        const float v = dot + (cq - cs[k]); s[k] = v; mx = fmaxf(mx, v); }
#pragma unroll
    for (int o = 1; o < 64; o <<= 1) mx = fmaxf(mx, __shfl_xor(mx, o));
    float lsum = 0.f;
    for (int k = lane; k <= t; k += 64) { const float p = exp2f(s[k] - mx); lsum += p; s[k] = bfr(p); }
    lsum = wave_sum(lsum);
    __builtin_amdgcn_s_waitcnt(0); __builtin_amdgcn_wave_barrier();
    float o = 0.f; const bf16_t* vb = B2 + (size_t)b * SEQ * 1024 + 64 * h + lane;
    for (int k = 0; k <= t; ++k) o += s[k] * bf2f(vb[(size_t)k * 1024]);
    const float cz = bf2f(B2[(size_t)row * 1024 + 512 + 64 * h + lane]);
    B1[(size_t)row * 1024 + 64 * h + lane] = f2bf(o / lsum * cz);
}

__global__ void __launch_bounds__(256) nv_merge(Ptrs P, int l) {
    extern __shared__ float T[];
    const int pn = blockIdx.x, row0 = blockIdx.y * 64, tid = threadIdx.x, w = tid >> 6, ln = tid & 63, fr = ln & 15, fq = ln >> 4;
    const unsigned char* wl = P.ws + WS_W + (size_t)l * W_LAYER;
    const bf16_t* H = (const bf16_t*)(P.ws + WS_H); const bf16_t* WG = (const bf16_t*)(wl + WO_WG); const bf16_t* WAB = (const bf16_t*)(wl + WO_WAB); const bf16_t* WC = (const bf16_t*)(wl + WO_WC);
    const bf16_t* B0 = (const bf16_t*)(P.ws + WS_B0); const bf16_t* B1 = (const bf16_t*)(P.ws + WS_B1);
    float* G = T; float* MGs = T + 64 * 256;
    f32x4 acc[4][4];
    for (int br = 0; br < 3; ++br) {
        nv_gemm_acc(H + (size_t)row0 * D, D, WG + ((size_t)br * 1024 + 256 * pn) * D, D, D, acc);
#pragma unroll
        for (int m = 0; m < 4; ++m)
#pragma unroll
            for (int n = 0; n < 4; ++n)
#pragma unroll
                for (int r = 0; r < 4; ++r) { const int c = 64 * w + 16 * n + fr; G[((m * 4 + n) * 4 + r) * 256 + tid] = bfr(sigm(acc[m][n][r] + P.b_gate[(size_t)l * 3072 + br * 1024 + 256 * pn + c])); }
        const bf16_t* A = br == 0 ? B0 : (br == 1 ? B0 + 512 : B1); const bf16_t* Bt = br == 0 ? WAB : (br == 1 ? WAB + 512 : WC);
        nv_gemm_acc(A + (size_t)row0 * 1024, 1024, Bt + (size_t)256 * pn * 1024, 1024, 512, acc);
#pragma unroll
        for (int m = 0; m < 4; ++m)
#pragma unroll
            for (int n = 0; n < 4; ++n)
#pragma unroll
                for (int r = 0; r < 4; ++r) { const int s = ((m * 4 + n) * 4 + r) * 256 + tid; const float v = G[s] * acc[m][n][r]; MGs[s] = bfr(br == 0 ? v : MGs[s] + v); }
    }
    bf16_t* MG = (bf16_t*)(P.ws + WS_MG);
#pragma unroll
    for (int m = 0; m < 4; ++m)
#pragma unroll
        for (int n = 0; n < 4; ++n)
#pragma unroll
            for (int r = 0; r < 4; ++r) MG[(size_t)(row0 + 16 * m + 4 * fq + r) * 1024 + 256 * pn + 64 * w + 16 * n + fr] = f2bf(MGs[((m * 4 + n) * 4 + r) * 256 + tid]);
}

__global__ void __launch_bounds__(256) nv_out(Ptrs P, int l, const float* xin, float* xout) {
    const int pn = blockIdx.x, row0 = blockIdx.y * 64, tid = threadIdx.x, w = tid >> 6, ln = tid & 63, fr = ln & 15, fq = ln >> 4;
    const bf16_t* MG = (const bf16_t*)(P.ws + WS_MG); const bf16_t* WO = (const bf16_t*)(P.ws + WS_W + (size_t)l * W_LAYER + WO_WO);
    f32x4 acc[4][4];
    nv_gemm_acc(MG + (size_t)row0 * 1024, 1024, WO + (size_t)256 * pn * 1024, 1024, 1024, acc);
#pragma unroll
    for (int m = 0; m < 4; ++m)
#pragma unroll
        for (int n = 0; n < 4; ++n)
#pragma unroll
            for (int r = 0; r < 4; ++r) { const size_t o = (size_t)(row0 + 16 * m + 4 * fq + r) * D + 256 * pn + 64 * w + 16 * n + fr; xout[o] = xin[o] + acc[m][n][r]; }
}


#define LAS __attribute__((address_space(3)))
#define GAS __attribute__((address_space(1)))
__device__ __forceinline__ float wsum(float v) {
    v += __builtin_bit_cast(float, __builtin_amdgcn_update_dpp(0, __builtin_bit_cast(int, v), 0xB1, 0xF, 0xF, true));
    v += __builtin_bit_cast(float, __builtin_amdgcn_update_dpp(0, __builtin_bit_cast(int, v), 0x4E, 0xF, 0xF, true));
    v += __builtin_bit_cast(float, __builtin_amdgcn_update_dpp(0, __builtin_bit_cast(int, v), 0x141, 0xF, 0xF, true));
    v += __builtin_bit_cast(float, __builtin_amdgcn_update_dpp(0, __builtin_bit_cast(int, v), 0x140, 0xF, 0xF, true));
    const int iv = __builtin_bit_cast(int, v);
    return (__builtin_bit_cast(float, __builtin_amdgcn_readlane(iv, 0)) + __builtin_bit_cast(float, __builtin_amdgcn_readlane(iv, 16))) + (__builtin_bit_cast(float, __builtin_amdgcn_readlane(iv, 32)) + __builtin_bit_cast(float, __builtin_amdgcn_readlane(iv, 48)));
}
typedef GAS unsigned gu32;
#define RLX_AGENT __ATOMIC_RELAXED, __HIP_MEMORY_SCOPE_AGENT
#define LDS_WAIT() asm volatile("s_waitcnt lgkmcnt(0)" ::: "memory")
#define VM_WAIT() asm volatile("s_waitcnt vmcnt(0)" ::: "memory")
constexpr int NWAVES = 8;
constexpr int RING_OFF = 0, RING_BYTES = 131072;
constexpr int LDS_BYTES = 163840;
constexpr int LDSCTL_OFF = LDS_BYTES - 512, MISC_OFF = LDSCTL_OFF + 320;
constexpr int RT_OFF = LDSCTL_OFF - 1024;
constexpr int CW_TMO = 0, CW_CODE = 1, CW_BAR = 4096;
constexpr float SKIP_L2 = 160.f;
constexpr int NPH = 10;

__device__ __forceinline__ unsigned cvt_pk_bf16(float lo, float hi) { unsigned r; asm volatile("v_cvt_pk_bf16_f32 %0, %1, %2" : "=v"(r) : "v"(lo), "v"(hi)); return r; }
__device__ __forceinline__ float fsigm(float x) { return __builtin_amdgcn_rcpf(1.f + __builtin_amdgcn_exp2f(-LOG2E * x)); }
__device__ __forceinline__ u32x4 pack8(const f32x4& a, const f32x4& b) { u32x4 w; w.x = cvt_pk_bf16(a[0], a[1]); w.y = cvt_pk_bf16(a[2], a[3]); w.z = cvt_pk_bf16(b[0], b[1]); w.w = cvt_pk_bf16(b[2], b[3]); return w; }
__device__ __forceinline__ void unpack8(const u32x4& w, f32x4& a, f32x4& b) {
    a[0] = __uint_as_float(w.x << 16); a[1] = __uint_as_float(w.x & 0xffff0000u); a[2] = __uint_as_float(w.y << 16); a[3] = __uint_as_float(w.y & 0xffff0000u);
    b[0] = __uint_as_float(w.z << 16); b[1] = __uint_as_float(w.z & 0xffff0000u); b[2] = __uint_as_float(w.w << 16); b[3] = __uint_as_float(w.w & 0xffff0000u); }

namespace pg8 {
constexpr int BM = 256, BK = 64, HALF = 128, HTB = HALF * BK * 2, STAGE_BYTES = 8 * HTB, NXCD = 8, WGM = 8, PITCH = 1024;
__host__ __device__ __forceinline__ int lds_byte(int r, int c) { const int st = (r >> 4) * 2 + (c >> 5), rr = r & 15, cc = c & 31, ob = rr * 64 + cc * 2; return st * 1024 + (ob ^ (((ob >> 9) & 1) << 5)); }
__host__ __device__ __forceinline__ void stage_rc(int b, int& R, int& C) { const int st = b / 1024, sb = b % 1024, swz = sb ^ (((sb >> 9) & 1) << 5); R = (st >> 1) * 16 + swz / 64; C = (st & 1) * 32 + (swz % 64) / 2; }
__host__ __device__ __forceinline__ int perm32(int rho) { const int n = rho >> 4, i = rho & 15; return 8 * (i >> 2) + 4 * n + (i & 3); }

struct Unit { const char* A; const char* B; int nt, pm, pn, tag; };

struct TileOrder {
    int nM, nN, nwg, G, c;
    __device__ __forceinline__ void init(int Mr, int N, int G_, int c_) { nM = Mr / BM; nN = N / BM; nwg = nM * nN; G = G_; c = c_; }
    __device__ __forceinline__ bool tile(int i, int& pm, int& pn) const {
        const long L = (long)i * G + c; if (L >= nwg) return false;
        int wgid = (int)L; { const int q = nwg / NXCD, r = nwg % NXCD, xcd = wgid % NXCD, off = wgid / NXCD; wgid = (xcd < r ? xcd * (q + 1) : r * (q + 1) + (xcd - r) * q) + off; }
        const int nig = WGM * nN, gid = wgid / nig, fm = gid * WGM, gsz = (nM - fm) < WGM ? (nM - fm) : WGM;
        pm = fm + ((wgid % nig) % gsz); pn = (wgid % nig) / gsz; return true;
    }
};

template <class Epi, class Sched>
__device__ __forceinline__ void gemm_phase(LAS unsigned char* lds, const Sched& S, const Epi& E) {
    int tid = threadIdx.x; asm volatile("" : "+v"(tid));
    const int wid = __builtin_amdgcn_readfirstlane(tid >> 6), lane = tid & 63, wr = wid >> 2, wc = wid & 3, fr = lane & 15, fq = lane >> 4;
    unsigned voffA[2], voffB[2];
#pragma unroll
    for (int i = 0; i < 2; ++i) { int R, C; stage_rc(tid * 16 + i * 8192, R, C); const int Rb = (R & ~31) + perm32(R & 31);
        voffA[i] = (unsigned)(R * PITCH + C) * 2u; voffB[i] = (unsigned)(Rb * PITCH + C) * 2u; }
    const size_t kstep = (size_t)(BK * 2);
    const size_t hstep = (size_t)HALF * PITCH * 2;
    const unsigned ldsw = (unsigned)wid * 1024u;
    const int aoff = lds_byte(wr * 64 + fr, fq * 8), boff = lds_byte(wc * 32 + fr, fq * 8);
#define PG8_SA(b, h) (((b) * 2 + (h)) * HTB)
#define PG8_SB(b, h) ((4 + (b) * 2 + (h)) * HTB)
#define PG8_STAGE(bufoff, gbase, voff) do { _Pragma("unroll") for (int _i = 0; _i < 2; ++_i) \
        __builtin_amdgcn_global_load_lds((const unsigned*)((const char*)(gbase) + (voff)[_i]), (LAS unsigned*)(lds + (bufoff) + ldsw + _i * 8192), 16, 0, 0); } while (0)
#define PG8_LDA(dst, b, h) do { _Pragma("unroll") for (int m = 0; m < 4; ++m) _Pragma("unroll") for (int k = 0; k < 2; ++k) dst[m][k] = *(const LAS bf16x8*)(lds + PG8_SA(b, h) + aoff + m * 2048 + k * 1024); } while (0)
#define PG8_LDB(dst, b, h) do { _Pragma("unroll") for (int n = 0; n < 2; ++n) _Pragma("unroll") for (int k = 0; k < 2; ++k) dst[n][k] = *(const LAS bf16x8*)(lds + PG8_SB(b, h) + boff + n * 2048 + k * 1024); } while (0)
#define PG8_MMA(ai, bj, At, Bt) do { __builtin_amdgcn_s_setprio(1); _Pragma("unroll") for (int m = 0; m < 4; ++m) _Pragma("unroll") for (int n = 0; n < 2; ++n) _Pragma("unroll") for (int k = 0; k < 2; ++k) \
        acc[ai][bj][m][n] = __builtin_amdgcn_mfma_f32_16x16x32_bf16(Bt[n][k], At[m][k], acc[ai][bj][m][n], 0, 0, 0); __builtin_amdgcn_s_setprio(0); } while (0)
#define PG8_WAIT_V(n) asm volatile("s_waitcnt vmcnt(" #n ")" ::: "memory")
#define PG8_WAIT_L(n) asm volatile("s_waitcnt lgkmcnt(" #n ")" ::: "memory")
#define PG8_BAR __builtin_amdgcn_s_barrier()
#define PG8_SCHED __builtin_amdgcn_sched_barrier(0)
    Unit cur, nxt; int ui = 0;
    if (!S.next(0, cur)) return;
    f32x4 acc[2][2][4][2];
#pragma unroll
    for (int a = 0; a < 2; ++a)
#pragma unroll
        for (int b = 0; b < 2; ++b)
#pragma unroll
            for (int m = 0; m < 4; ++m)
#pragma unroll
                for (int n = 0; n < 2; ++n) acc[a][b][m][n] = (f32x4){0.f, 0.f, 0.f, 0.f};
    bf16x8 At[4][2], B0[2][2], B1[2][2];
    const char* cA = cur.A; const char* cB = cur.B;
    PG8_STAGE(PG8_SB(0, 0), cB, voffB); PG8_STAGE(PG8_SB(0, 1), cB + hstep, voffB); PG8_STAGE(PG8_SA(0, 0), cA, voffA); PG8_STAGE(PG8_SA(0, 1), cA + hstep, voffA);
    if (wr == 1) PG8_BAR;
    PG8_WAIT_V(2); PG8_BAR;
    PG8_STAGE(PG8_SB(1, 0), cB + kstep, voffB); PG8_STAGE(PG8_SA(1, 0), cA + kstep, voffA); PG8_STAGE(PG8_SB(1, 1), cB + hstep + kstep, voffB);
    PG8_WAIT_V(6); PG8_BAR;
    for (;;) {
        const bool has_next = S.next(ui + 1, nxt);
        const char* nA = has_next ? nxt.A : cA; const char* nB = has_next ? nxt.B : cB;
        const int nt = cur.nt;
        for (int t = 0; t < nt; t += 2) {
            const bool last = (t == nt - 2);
            const char* a1 = cA + (size_t)(t + 1) * kstep;
            const char* a2 = last ? nA : cA + (size_t)(t + 2) * kstep; const char* b2 = last ? nB : cB + (size_t)(t + 2) * kstep;
            const char* a3 = a2 + kstep; const char* b3 = b2 + kstep;
            PG8_LDB(B0, 0, 0); PG8_LDB(B1, 0, 1); PG8_SCHED; PG8_LDA(At, 0, 0); PG8_STAGE(PG8_SA(1, 1), a1 + hstep, voffA);
            PG8_WAIT_V(8); PG8_WAIT_L(0); PG8_BAR; PG8_MMA(0, 0, At, B0); PG8_MMA(0, 1, At, B1); PG8_BAR; PG8_SCHED;
            PG8_LDA(At, 0, 1); PG8_STAGE(PG8_SB(0, 0), b2, voffB); PG8_STAGE(PG8_SB(0, 1), b2 + hstep, voffB); PG8_STAGE(PG8_SA(0, 0), a2, voffA);
            PG8_WAIT_V(8); PG8_WAIT_L(0); PG8_BAR; PG8_MMA(1, 0, At, B0); PG8_MMA(1, 1, At, B1); PG8_BAR; PG8_SCHED;
            PG8_LDB(B0, 1, 0); PG8_LDB(B1, 1, 1); PG8_SCHED; PG8_LDA(At, 1, 0); PG8_STAGE(PG8_SA(0, 1), a2 + hstep, voffA);
            PG8_WAIT_V(8); PG8_WAIT_L(0); PG8_BAR; PG8_MMA(0, 0, At, B0); PG8_MMA(0, 1, At, B1); PG8_BAR; PG8_SCHED;
            PG8_LDA(At, 1, 1); PG8_STAGE(PG8_SB(1, 0), b3, voffB); PG8_STAGE(PG8_SB(1, 1), b3 + hstep, voffB); PG8_STAGE(PG8_SA(1, 0), a3, voffA);
            PG8_WAIT_V(8); PG8_WAIT_L(0); PG8_BAR; PG8_MMA(1, 0, At, B0); PG8_MMA(1, 1, At, B1); PG8_BAR; PG8_SCHED;
        }
        if (wr == 0) PG8_BAR;
        E(acc, cur, wr, wc, fr, fq);
        if (!has_next) break;
#pragma unroll
        for (int a = 0; a < 2; ++a)
#pragma unroll
            for (int b = 0; b < 2; ++b)
#pragma unroll
                for (int m = 0; m < 4; ++m)
#pragma unroll
                    for (int n = 0; n < 2; ++n) acc[a][b][m][n] = (f32x4){0.f, 0.f, 0.f, 0.f};
        cur = nxt; cA = nA; cB = nB; ++ui;
        if (wr == 1) PG8_BAR;
    }
    PG8_WAIT_V(0);
    PG8_BAR;
    E.after(acc, cur, lds, wr, wc, fr, fq);
#undef PG8_SA
#undef PG8_SB
#undef PG8_STAGE
#undef PG8_LDA
#undef PG8_LDB
#undef PG8_MMA
#undef PG8_WAIT_V
#undef PG8_WAIT_L
#undef PG8_BAR
#undef PG8_SCHED
}

struct EpiG1 {
    bf16_t *B0, *B1, *B2, *B3, *B4; float* vss; const float *gq, *gk; const LAS float* R;
    __device__ __forceinline__ void after(f32x4 (&)[2][2][4][2], const Unit&, LAS unsigned char*, int, int, int, int) const {}
    __device__ __forceinline__ void operator()(f32x4 (&acc)[2][2][4][2], const Unit& u, int wr, int wc, int fr, int fq) const {
        const int j = u.pn; const size_t rowb = (size_t)u.pm * BM + wr * 64 + fr; const int cl = 32 * wc + 8 * fq;
#pragma unroll
        for (int ai = 0; ai < 2; ++ai)
#pragma unroll
            for (int m = 0; m < 4; ++m) { const float rs = R[ai * HALF + wr * 64 + m * 16 + fr];
#pragma unroll
                for (int bj = 0; bj < 2; ++bj) { acc[ai][bj][m][0] *= rs; acc[ai][bj][m][1] *= rs; } }
        if (j < 4) {
#pragma unroll
            for (int ai = 0; ai < 2; ++ai)
#pragma unroll
                for (int m = 0; m < 4; ++m) { f32x4 o0, o1;
#pragma unroll
                    for (int e = 0; e < 4; ++e) { o0[e] = acc[ai][0][m][0][e] * fsigm(acc[ai][1][m][0][e]); o1[e] = acc[ai][0][m][1][e] * fsigm(acc[ai][1][m][1][e]); }
                    *(u32x4*)(B3 + (rowb + ai * HALF + m * 16) * 1024 + 128 * j + cl) = pack8(o0, o1); }
        } else if (j < 12 || j >= 16) {
            bf16_t* dst; int pitch, coff; bool act;
            if (j < 6) { dst = B0; pitch = 1024; coff = 256 * (j - 4); act = true; }
            else if (j < 8) { dst = B0; pitch = 1024; coff = 512 + 256 * (j - 6); act = false; }
            else if (j < 10) { dst = B3; pitch = 1024; coff = 512 + 256 * (j - 8); act = false; }
            else if (j < 12) { dst = B4; pitch = 512; coff = 256 * (j - 10); act = true; }
            else if (j < 18) { dst = B2; pitch = 1024; coff = 256 * (j - 16); act = false; }
            else { dst = B2; pitch = 1024; coff = 512 + 256 * (j - 18); act = true; }
            const bool stat = (j == 8 || j == 9);
#pragma unroll
            for (int ai = 0; ai < 2; ++ai)
#pragma unroll
                for (int m = 0; m < 4; ++m) { const size_t row = rowb + ai * HALF + m * 16; float s = 0.f;
#pragma unroll
                    for (int bj = 0; bj < 2; ++bj) { f32x4 v0 = acc[ai][bj][m][0], v1 = acc[ai][bj][m][1];
                        if (act) {
#pragma unroll
                            for (int e = 0; e < 4; ++e) { v0[e] = v0[e] * fsigm(v0[e]); v1[e] = v1[e] * fsigm(v1[e]); } }
                        s += (v0[0] * v0[0] + v0[1] * v0[1]) + (v0[2] * v0[2] + v0[3] * v0[3]) + (v1[0] * v1[0] + v1[1] * v1[1]) + (v1[2] * v1[2] + v1[3] * v1[3]);
                        *(u32x4*)(dst + row * pitch + coff + 128 * bj + cl) = pack8(v0, v1); }
                    if (stat) { s += __shfl_xor(s, 16); s += __shfl_xor(s, 32); if (fq == 0) vss[row * 8 + (j - 8) * 4 + wc] = s; } }
        } else {
            const bool isk = j >= 14; const int jj = (j - 12) & 1; const float* g = isk ? gk : gq; const float sc = isk ? 1.f : C2;
            f32x4 gv[2][2];
#pragma unroll
            for (int bj = 0; bj < 2; ++bj) { gv[bj][0] = *(const f32x4*)(g + 32 * bj + 8 * fq) * sc; gv[bj][1] = *(const f32x4*)(g + 32 * bj + 8 * fq + 4) * sc; }
            bf16_t* dst = B1 + (isk ? 512 : 0) + 64 * (4 * jj + wc) + 8 * fq;
#pragma unroll
            for (int ai = 0; ai < 2; ++ai)
#pragma unroll
                for (int m = 0; m < 4; ++m) { const size_t row = rowb + ai * HALF + m * 16; float s = 0.f;
#pragma unroll
                    for (int bj = 0; bj < 2; ++bj) { const f32x4 v0 = acc[ai][bj][m][0], v1 = acc[ai][bj][m][1];
                        s += (v0[0] * v0[0] + v0[1] * v0[1]) + (v0[2] * v0[2] + v0[3] * v0[3]) + (v1[0] * v1[0] + v1[1] * v1[1]) + (v1[2] * v1[2] + v1[3] * v1[3]); }
                    s += __shfl_xor(s, 16); s += __shfl_xor(s, 32);
                    const float r = __builtin_amdgcn_rsqf(s * (1.f / 64.f) + EPS);
#pragma unroll
                    for (int bj = 0; bj < 2; ++bj) *(u32x4*)(dst + row * 1024 + 32 * bj) = pack8(acc[ai][bj][m][0] * r * gv[bj][0], acc[ai][bj][m][1] * r * gv[bj][1]); }
        }
    }
};
struct EpiMerge {
    unsigned char* gt; bf16_t* MG; const float* bgate; const LAS float* R; int cls; size_t gt2off; bool pv_;
    __device__ __forceinline__ void after(f32x4 (&)[2][2][4][2], const Unit&, LAS unsigned char*, int, int, int, int) const {}
    __device__ __forceinline__ void operator()(f32x4 (&acc)[2][2][4][2], const Unit& u, int wr, int wc, int fr, int fq) const {
        const int tag = u.tag, br = tag >> 1; const size_t rowb = (size_t)u.pm * BM + wr * 64 + fr; const int col0 = u.pn * BM + 32 * wc + 8 * fq;
        if (PROBE_P3 == 2 && pv_) return;
        if (PROBE_P3 == 1 && pv_ && (tag & 1)) return;
        u32x4* slots_ = (u32x4*)(gt + ((cls && br == 1) ? gt2off : (size_t)0)) + ((wr * 4 + wc) * 64 + fq * 16 + fr); asm volatile("" : "+v"(slots_)); __attribute__((address_space(1))) u32x4* slots = (__attribute__((address_space(1))) u32x4*)slots_;
        if ((tag & 1) == 0) {
            f32x4 bv[2][2];
#pragma unroll
            for (int bj = 0; bj < 2; ++bj) { bv[bj][0] = *(const f32x4*)(bgate + br * 1024 + col0 + 128 * bj); bv[bj][1] = *(const f32x4*)(bgate + br * 1024 + col0 + 128 * bj + 4); }
#pragma unroll
            for (int ai = 0; ai < 2; ++ai)
#pragma unroll
                for (int m = 0; m < 4; ++m)
#pragma unroll
                    for (int bj = 0; bj < 2; ++bj) { const float rs = R[ai * HALF + wr * 64 + m * 16 + fr]; f32x4 v0 = acc[ai][bj][m][0] * rs + bv[bj][0], v1 = acc[ai][bj][m][1] * rs + bv[bj][1];
#pragma unroll
                        for (int e = 0; e < 4; ++e) { v0[e] = fsigm(v0[e]); v1[e] = fsigm(v1[e]); }
                        slots[(size_t)(((ai * 4 + m) * 2 + bj) * 512)] = pack8(v0, v1); }
        } else {
#pragma unroll
            for (int ai = 0; ai < 2; ++ai)
#pragma unroll
                for (int m = 0; m < 4; ++m) {
#pragma unroll
                    for (int bj = 0; bj < 2; ++bj) { const u32x4 gw = slots[(size_t)(((ai * 4 + m) * 2 + bj) * 512)]; f32x4 g0, g1; unpack8(gw, g0, g1);
                        f32x4 v0 = g0 * acc[ai][bj][m][0], v1 = g1 * acc[ai][bj][m][1];
                        u32x4* p = (u32x4*)(MG + (rowb + ai * HALF + m * 16) * 1024 + col0 + 128 * bj);
                        if (br > 0) { const u32x4 ow = *p; f32x4 p0, p1; unpack8(ow, p0, p1); v0 += p0; v1 += p1; }
                        *p = pack8(v0, v1); }
                    if (m & 1) asm volatile("" ::: "memory"); }
        }
    }
};
struct EpiOutB {
    const bf16_t* base; float* out;
    __device__ __forceinline__ void after(f32x4 (&)[2][2][4][2], const Unit&, LAS unsigned char*, int, int, int, int) const {}
    __device__ __forceinline__ void operator()(f32x4 (&acc)[2][2][4][2], const Unit& u, int wr, int wc, int fr, int fq) const {
        const size_t rowb = (size_t)u.pm * BM + wr * 64 + fr; const int col0 = u.pn * BM + 32 * wc + 8 * fq;
#pragma unroll
        for (int ai = 0; ai < 2; ++ai)
#pragma unroll
            for (int m = 0; m < 4; ++m) {
#pragma unroll
                for (int bj = 0; bj < 2; ++bj) { const size_t o = (rowb + ai * HALF + m * 16) * D + col0 + 128 * bj;
                    f32x4 b0, b1; unpack8(*(const u32x4*)(base + o), b0, b1);
                    *(f32x4*)(out + o) = b0 + acc[ai][bj][m][0]; *(f32x4*)(out + o + 4) = b1 + acc[ai][bj][m][1]; }
                if (m & 1) asm volatile("" ::: "memory"); }
    }
};
struct EpiOut {
    const float* base; float* out;
    __device__ __forceinline__ void after(f32x4 (&)[2][2][4][2], const Unit&, LAS unsigned char*, int, int, int, int) const {}
    __device__ __forceinline__ void operator()(f32x4 (&acc)[2][2][4][2], const Unit& u, int wr, int wc, int fr, int fq) const {
        const size_t rowb = (size_t)u.pm * BM + wr * 64 + fr; const int col0 = u.pn * BM + 32 * wc + 8 * fq;
#pragma unroll
        for (int ai = 0; ai < 2; ++ai)
#pragma unroll
            for (int m = 0; m < 4; ++m) {
#pragma unroll
                for (int bj = 0; bj < 2; ++bj) { const size_t o = (rowb + ai * HALF + m * 16) * D + col0 + 128 * bj;
                    const f32x4 b0 = *(const f32x4*)(base + o), b1 = *(const f32x4*)(base + o + 4);
                    *(f32x4*)(out + o) = b0 + acc[ai][bj][m][0]; *(f32x4*)(out + o + 4) = b1 + acc[ai][bj][m][1]; }
                if (m & 1) asm volatile("" ::: "memory"); }
    }
};
struct EpiOutLN {
    const float* base; bf16_t* XG; const float* gnext; const float* wfnext; float* SSP; float* FP;
    __device__ __forceinline__ void operator()(f32x4 (&)[2][2][4][2], const Unit&, int, int, int, int) const {}
    __device__ __forceinline__ void after(f32x4 (&acc)[2][2][4][2], const Unit& u, LAS unsigned char* lds, int wr, int wc, int fr, int fq) const {
        const int tid = ((wr * 4 + wc) * 64) + fq * 16 + fr;
        const size_t rowb = (size_t)u.pm * BM + wr * 64 + fr; const int cl = 32 * wc + 8 * fq, col0 = u.pn * BM + cl;
        LAS float* FL = (LAS float*)lds;
        LAS float* WL = (LAS float*)(lds + 512 * 72 * 4);
        for (int i = tid; i < 256 * 8; i += 512) { const int c = i >> 3, e = i & 7; WL[i] = gnext[u.pn * BM + c] * wfnext[(size_t)(u.pn * BM + c) * NIN + e]; }
#pragma unroll
        for (int ai = 0; ai < 2; ++ai)
#pragma unroll
            for (int m = 0; m < 4; ++m) { float ss = 0.f;
#pragma unroll
                for (int bj = 0; bj < 2; ++bj) { const size_t o = (rowb + ai * HALF + m * 16) * D + col0 + 128 * bj;
                    const f32x4 x0 = *(const f32x4*)(base + o) + acc[ai][bj][m][0], x1 = *(const f32x4*)(base + o + 4) + acc[ai][bj][m][1];
                    ss += (x0[0] * x0[0] + x0[1] * x0[1]) + (x0[2] * x0[2] + x0[3] * x0[3]) + (x1[0] * x1[0] + x1[1] * x1[1]) + (x1[2] * x1[2] + x1[3] * x1[3]);
                    *(u32x4*)(XG + o) = pack8(x0, x1);
                    acc[ai][bj][m][0] = x0; acc[ai][bj][m][1] = x1; }
                FL[tid * 72 + 64 + ai * 4 + m] = ss;
                if (m & 1) asm volatile("" ::: "memory"); }
        asm volatile("s_waitcnt lgkmcnt(0)" ::: "memory"); __builtin_amdgcn_s_barrier(); asm volatile("" ::: "memory");
#pragma unroll
        for (int hh = 0; hh < 2; ++hh) {
            f32x4 f[8];
#pragma unroll
            for (int rg = 0; rg < 8; ++rg) f[rg] = (f32x4){0.f, 0.f, 0.f, 0.f};
#pragma unroll
            for (int bj = 0; bj < 2; ++bj)
#pragma unroll
                for (int n = 0; n < 2; ++n)
#pragma unroll
                    for (int i = 0; i < 4; ++i) { const f32x4 wv = *(const LAS f32x4*)(WL + (128 * bj + cl + 4 * n + i) * 8 + 4 * hh);
#pragma unroll
                        for (int ai = 0; ai < 2; ++ai)
#pragma unroll
                            for (int m = 0; m < 4; ++m) f[ai * 4 + m] += acc[ai][bj][m][n][i] * wv; }
#pragma unroll
            for (int rg = 0; rg < 8; ++rg) *(LAS f32x4*)(FL + tid * 72 + rg * 8 + 4 * hh) = f[rg];
            asm volatile("" ::: "memory");
        }
        asm volatile("s_waitcnt lgkmcnt(0)" ::: "memory"); __builtin_amdgcn_s_barrier(); asm volatile("" ::: "memory");
        { const int row = tid & 255, hb = (tid >> 8) * 4, ai_ = row >> 7, wr_ = (row >> 6) & 1, m_ = (row >> 4) & 3, fr_ = row & 15, rg = ai_ * 4 + m_;
          f32x4 sum = (f32x4){0.f, 0.f, 0.f, 0.f}; float ssum = 0.f;
#pragma unroll
          for (int wc_ = 0; wc_ < 4; ++wc_)
#pragma unroll
              for (int fq_ = 0; fq_ < 4; ++fq_) { const LAS float* src = FL + (((wr_ * 4 + wc_) * 64) + fq_ * 16 + fr_) * 72; sum += *(const LAS f32x4*)(src + rg * 8 + hb); ssum += src[64 + rg]; }
          const size_t grow = (size_t)u.pm * BM + row;
          *(f32x4*)(FP + (grow * 4 + u.pn) * 8 + hb) = sum;
          if (hb == 0) SSP[grow * 4 + u.pn] = ssum; }
    }
};
struct SchedG1 { TileOrder T; const char* A; const char* B;
    __device__ __forceinline__ bool next(int i, Unit& u) const { int pm, pn; if (!T.tile(i, pm, pn)) return false; u.pm = pm; u.pn = pn; u.tag = 0; u.nt = 16; u.A = A + (size_t)pm * (BM * PITCH * 2); u.B = B + (size_t)pn * (BM * PITCH * 2); return true; } };
struct SchedMerge { int pm, pn; bool ok; int cls; const char *ws, *wl;
    __device__ __forceinline__ bool next(int i, Unit& u) const { if (!ok || i >= 6) return false;
        const int tag = cls == 0 ? i : (i == 0 ? 0 : i == 1 ? 2 : i == 2 ? 1 : i == 3 ? 4 : i == 4 ? 3 : 5);
        const int br = tag >> 1; u.pm = pm; u.pn = pn; u.tag = tag;
        const size_t ro = (size_t)pm * (BM * PITCH * 2), co = (size_t)pn * (BM * PITCH * 2);
        if ((tag & 1) == 0) { u.nt = 16; u.A = ws + WS_H + ro; u.B = wl + WO_WG + (size_t)br * (1024 * PITCH * 2) + co; }
        else { u.nt = 8; const size_t ao = br == 0 ? WS_B0 : (br == 1 ? WS_B0 + 1024 : WS_B1), bo = br == 0 ? WO_WAB : (br == 1 ? WO_WAB + 1024 : WO_WC); u.A = ws + ao + ro; u.B = wl + bo + co; }
        return true; } };
}

#define XB_TMO      128
#define XB_XCNT(j)  (256  + 64 * (j))
#define XB_XSUB(j)  (1280 + 64 * (j))
#define XB_XGEN(j)  (2304 + 64 * (j))
#define XB_TOP      3328
#define XB_TOPGEN   3392
#define XCD_BAR_WORDS 3456
#define XB_SPIN_CAP (1u << 18)
__device__ __forceinline__ unsigned xb_ld(unsigned* p)              { return __hip_atomic_load(p, __ATOMIC_RELAXED, __HIP_MEMORY_SCOPE_AGENT); }
__device__ __forceinline__ unsigned xb_add(unsigned* p, unsigned v) { return __hip_atomic_fetch_add(p, v, __ATOMIC_RELAXED, __HIP_MEMORY_SCOPE_AGENT); }
__device__ __forceinline__ unsigned xb_xcc_id() { return (unsigned)__builtin_amdgcn_s_getreg((3 << 11) | 20) & 0xFu; }
#define XB_SPIN(cond, bar) do { unsigned _sp = 0; while (cond) { __builtin_amdgcn_s_sleep(1); \
    if ((++_sp & 255u) == 0u) { if (xb_ld(&(bar)[XB_TMO])) break; if (_sp > XB_SPIN_CAP) { atomicAdd(&(bar)[XB_TMO], 1u); break; } } } } while (0)
struct XcdBarrier { unsigned* bar; unsigned x; volatile LAS unsigned* st; };
__device__ __forceinline__ XcdBarrier xcd_barrier_post(unsigned* bar, volatile LAS unsigned* st) {
    XcdBarrier b; b.bar = bar; b.x = xb_xcc_id(); b.st = st;
    if (threadIdx.x == 0) (void)xb_add(&bar[XB_XCNT(b.x)], 1u);
    return b;
}
__device__ __forceinline__ void xcd_barrier_complete(unsigned* bar, unsigned x, unsigned& nloc, unsigned& nx) {
    const unsigned G = gridDim.x * gridDim.y * gridDim.z;
    unsigned sum, cnt, mine, sp = 0u;
    for (;;) {
        sum = 0u; cnt = 0u; mine = 0u;
#pragma unroll
        for (unsigned j = 0; j < 16; ++j) { const unsigned c = xb_ld(&bar[XB_XCNT(j)]); sum += c; cnt += (c > 0u) ? 1u : 0u; mine = (j == x) ? c : mine; }
        if (sum == G) break;
        __builtin_amdgcn_s_sleep(1);
        if ((++sp & 255u) == 0u) { if (xb_ld(&bar[XB_TMO])) break; if (sp > XB_SPIN_CAP) { atomicAdd(&bar[XB_TMO], 1u); break; } }
    }
    nloc = mine > 0u ? mine : 1u; nx = cnt > 0u ? cnt : 1u;
}
__device__ __forceinline__ void xcd_barrier(const XcdBarrier& b) {
    asm volatile("s_waitcnt vmcnt(0)" ::: "memory");
    __syncthreads();
    if (threadIdx.x == 0) {
        unsigned* bar = b.bar;
        __builtin_amdgcn_s_waitcnt(0);
        unsigned nloc = b.st[0], nx = b.st[1];
        if (nloc == 0u) { xcd_barrier_complete(bar, b.x, nloc, nx); b.st[0] = nloc; b.st[1] = nx; }
        const unsigned old = xb_add(&bar[XB_XSUB(b.x)], 1u);
        const unsigned gen = old / nloc;
        if (old + 1u == (gen + 1u) * nloc) {
            __builtin_amdgcn_fence(__ATOMIC_RELEASE, "agent");
            asm volatile("s_waitcnt vmcnt(0)" ::: "memory");
            const unsigned og = xb_add(&bar[XB_TOP], 1u);
            const unsigned tg = og / nx;
            if (og + 1u == (tg + 1u) * nx) xb_add(&bar[XB_TOPGEN], 1u);
            else XB_SPIN(xb_ld(&bar[XB_TOPGEN]) == tg, bar);
            __builtin_amdgcn_fence(__ATOMIC_ACQUIRE, "agent");
            xb_add(&bar[XB_XGEN(b.x)], 1u);
            asm volatile("s_waitcnt vmcnt(0)" ::: "memory");
        } else {
            XB_SPIN(xb_ld(&bar[XB_XGEN(b.x)]) == gen, bar);
            __builtin_amdgcn_fence(__ATOMIC_ACQUIRE, "agent");
            asm volatile("s_waitcnt vmcnt(0)" ::: "memory");
        }
    }
    __syncthreads();
}

struct Args { const float* in[18]; float* out; unsigned char* ws; int ph_lo, ph_hi, li, pad; };
struct Frame { LAS unsigned char* lds; int tid, lane, wave, vcu, G; Ptrs P; };

__device__ __forceinline__ unsigned pk2(float lo, float hi) { return (unsigned)f2bf(lo) | ((unsigned)f2bf(hi) << 16); }
__device__ __forceinline__ void p0_transpose_item(const float* W, int ldw, int src_col, int k0, bf16_t* WT, size_t dst_row, int dst_col, LAS float* scr, int lane, const float* kgain = nullptr) {
#pragma unroll 8
    for (int i = 0; i < 32; ++i) { const int kk = 2 * i + (lane >> 5); scr[kk * 33 + (lane & 31)] = W[(size_t)(k0 + kk) * ldw + src_col + (lane & 31)]; }
    LDS_WAIT(); asm volatile("" ::: "memory");
    const int c = lane & 7;
    f32x4 ga = (f32x4){1.f, 1.f, 1.f, 1.f}, gb = ga; if (kgain) { ga = *(const f32x4*)(kgain + k0 + 8 * c); gb = *(const f32x4*)(kgain + k0 + 8 * c + 4); }
#pragma unroll
    for (int j = 0; j < 4; ++j) { const int n = (lane >> 3) + 8 * j; const LAS float* s = scr + (8 * c) * 33 + n;
        u32x4 o; o.x = pk2(s[0 * 33] * ga.x, s[1 * 33] * ga.y); o.y = pk2(s[2 * 33] * ga.z, s[3 * 33] * ga.w); o.z = pk2(s[4 * 33] * gb.x, s[5 * 33] * gb.y); o.w = pk2(s[6 * 33] * gb.z, s[7 * 33] * gb.w);
        *(GAS u32x4*)(WT + (dst_row + n) * 1024 + dst_col + k0 + 8 * c) = o; }
    LDS_WAIT(); asm volatile("" ::: "memory");
}
__device__ __forceinline__ void p0_weights(Frame& F) {
    LAS float* scr = (LAS float*)(F.lds + RING_OFF + F.wave * 16384);
    const int gw = F.vcu * NWAVES + F.wave, NGW = F.G * NWAVES;
    constexpr int I_W1 = 16 * (N1 / 32), I_WG = 16 * 96, I_Y = 8 * 32, I_WO = 16 * 32, I_L = I_W1 + I_WG + 3 * I_Y + I_WO;
    for (int it = gw; it < NL * I_L; it += NGW) {
        const int l = it / I_L; int r = it % I_L;
        unsigned char* wl = F.P.ws + WS_W + (size_t)l * W_LAYER; const float* win = F.P.w_in + (size_t)l * D * NIN;
        const float* kg = l > 0 ? F.P.norm_g + (size_t)l * D : nullptr;
        if (r < I_W1) { const int kb = r / (N1 / 32), nb = r % (N1 / 32); p0_transpose_item(win, NIN, g1_col(32 * nb), 64 * kb, (bf16_t*)(wl + WO_W1), 32 * nb, 0, scr, F.lane, kg); continue; } r -= I_W1;
        if (r < I_WG) { const int kb = r / 96, nb = r % 96; p0_transpose_item(win, NIN, 32 * nb, 64 * kb, (bf16_t*)(wl + WO_WG), 32 * nb, 0, scr, F.lane, kg); continue; } r -= I_WG;
        if (r < I_Y) { const int kb = r / 32, nb = r % 32; p0_transpose_item(F.P.w_a + (size_t)l * DA * D, D, 32 * nb, 64 * kb, (bf16_t*)(wl + WO_WAB), 32 * nb, 0, scr, F.lane); continue; } r -= I_Y;
        if (r < I_Y) { const int kb = r / 32, nb = r % 32; p0_transpose_item(F.P.w_b + (size_t)l * DB * D, D, 32 * nb, 64 * kb, (bf16_t*)(wl + WO_WAB), 32 * nb, 512, scr, F.lane); continue; } r -= I_Y;
        if (r < I_Y) { const int kb = r / 32, nb = r % 32; p0_transpose_item(F.P.w_c + (size_t)l * DC * D, D, 32 * nb, 64 * kb, (bf16_t*)(wl + WO_WC), 32 * nb, 0, scr, F.lane); continue; } r -= I_Y;
        { const int kb = r / 32, nb = r % 32; p0_transpose_item(F.P.w_out + (size_t)l * D * D, D, 32 * nb, 64 * kb, (bf16_t*)(wl + WO_WO), 32 * nb, 0, scr, F.lane); }
    }
    bf16_t* WSB = (bf16_t*)(F.P.ws + WS_WSB);
    for (int i = (int)blockIdx.x * 512 + F.tid; i < NL * NG * CHK * CHK; i += F.G * 512) { const int s = i & 127, t = (i >> 7) & 127; WSB[i] = s <= t ? f2bf(F.P.w_s[i]) : (bf16_t)0; }
}
__device__ __forceinline__ void p0_ln(Frame& F, int l, const float* xin) {
    LAS float* wf = (LAS float*)(F.lds + RING_OFF);
    const float* g = F.P.norm_g + (size_t)l * D; const float* win = F.P.w_in + (size_t)l * D * NIN;
    __syncthreads();
    for (int i = F.tid; i < D * 8; i += 512) { const int k = i >> 3, e = i & 7; wf[i] = g[k] * win[(size_t)k * NIN + OC_F + e]; }
    __syncthreads();
    const int gw = F.vcu * NWAVES + F.wave, NGW = F.G * NWAVES;
    bf16_t* H = (bf16_t*)(F.P.ws + WS_H); float* LOGF = (float*)(F.P.ws + WS_LOGF);
    f32x4 gv[4];
#pragma unroll
    for (int j = 0; j < 4; ++j) gv[j] = ((const f32x4*)g)[64 * j + F.lane];
    static_assert(M == 8 * 256 * NWAVES, "p0_ln: 8 rows per wave on a 256-workgroup grid");
    float zrow[8];
#pragma unroll
    for (int k = 0; k < 8; ++k) zrow[k] = 0.f;
    f32x4 v[8][4];
#pragma unroll
    for (int bt = 0; bt < 4; ++bt) {
        asm volatile("" ::: "memory");
        if ((bt & 1) == 0) {
#pragma unroll
            for (int k = 2 * bt; k < 2 * bt + 4; ++k) { const GAS f32x4* xr = (const GAS f32x4*)(xin + (size_t)(gw + k * NGW) * D) + F.lane;
#pragma unroll
                for (int j = 0; j < 4; ++j) v[k][j] = xr[64 * j]; }
            asm volatile("" ::: "memory"); }
        float r[2]; float f[2][8];
#pragma unroll
        for (int q = 0; q < 2; ++q) { float ss = 0.f;
#pragma unroll
            for (int j = 0; j < 4; ++j) { const f32x4 x = v[2 * bt + q][j]; ss += (x.x * x.x + x.y * x.y) + (x.z * x.z + x.w * x.w); }
            r[q] = rsqrtf(wsum(ss) * (1.f / D) + EPS);
#pragma unroll
            for (int e = 0; e < 8; ++e) f[q][e] = 0.f; }
#pragma unroll
        for (int j = 0; j < 4; ++j) {
#pragma unroll
            for (int q = 0; q < 2; ++q) { const f32x4 hv = v[2 * bt + q][j] * r[q] * gv[j];
                GAS unsigned long long* o8 = (GAS unsigned long long*)(H + (size_t)(gw + (2 * bt + q) * NGW) * D) + F.lane;
                o8[64 * j] = (unsigned long long)pk2(hv.x, hv.y) | ((unsigned long long)pk2(hv.z, hv.w) << 32); }
#pragma unroll
            for (int i = 0; i < 4; ++i) { const LAS f32x4* w4 = (const LAS f32x4*)(wf + (256 * j + 4 * F.lane + i) * 8); const f32x4 wa = w4[0], wb = w4[1];
#pragma unroll
                for (int q = 0; q < 2; ++q) { const float xv = v[2 * bt + q][j][i];
                    f[q][0] += xv * wa.x; f[q][1] += xv * wa.y; f[q][2] += xv * wa.z; f[q][3] += xv * wa.w; f[q][4] += xv * wb.x; f[q][5] += xv * wb.y; f[q][6] += xv * wb.z; f[q][7] += xv * wb.w; } }
        }
#pragma unroll
        for (int q = 0; q < 2; ++q) {
#pragma unroll
            for (int e = 0; e < 8; ++e) f[q][e] = wsum(f[q][e]);
            if (F.lane < 8) { float z = 0.f;
#pragma unroll
                for (int e = 0; e < 8; ++e) if (F.lane == e) z = f[q][e];
                zrow[2 * bt + q] = z * r[q]; } }
    }
    if (F.lane < 8) { const float bfv = F.P.b_f[l * NH + F.lane];
#pragma unroll
        for (int k = 0; k < 8; ++k) { const float z = zrow[k] + bfv; LOGF[(size_t)(gw + k * NGW) * 8 + F.lane] = fminf(z, 0.f) - log1pf(expf(-fabsf(z))); } }
    __syncthreads();
}
__device__ __forceinline__ void p1_scan(Frame& F, int bh, int l) {
    LAS float* sh = (LAS float*)(F.lds + RING_OFF);
    const int b = bh / NH, h = bh % NH, t0 = F.tid * 8;
    float c[8]; float run = 0.f;
    if (l == 0) { const float* lf = (const float*)(F.P.ws + WS_LOGF) + ((size_t)b * SEQ + t0) * 8 + h;
#pragma unroll
        for (int i = 0; i < 8; ++i) { run += lf[i * 8]; c[i] = run; }
    } else {
        const float* fp = (const float*)(F.P.ws + WS_FP) + ((size_t)b * SEQ + t0) * 32 + h; const float* sp = (const float*)(F.P.ws + WS_SSP) + ((size_t)b * SEQ + t0) * 4; const float bfv = F.P.b_f[l * NH + h];
        float z[8];
#pragma unroll
        for (int i = 0; i < 8; ++i) { const f32x4 q = *(const f32x4*)(sp + i * 4); const float r = rsqrtf(((q.x + q.y) + (q.z + q.w)) * (1.f / D) + EPS);
            z[i] = r * ((fp[i * 32] + fp[i * 32 + 8]) + (fp[i * 32 + 16] + fp[i * 32 + 24])) + bfv; }
#pragma unroll
        for (int i = 0; i < 8; ++i) { run += fminf(z[i], 0.f) - log1pf(expf(-fabsf(z[i]))); c[i] = run; }
    }
    float inc = run;
#pragma unroll
    for (int o = 1; o < 64; o <<= 1) { const float n = __shfl_up(inc, o); if (F.lane >= o) inc += n; }
    if (F.lane == 63) sh[F.wave] = inc;
    __syncthreads();
    float base = inc - run;
    for (int w = 0; w < F.wave; ++w) base += sh[w];
    float* cs = (float*)(F.P.ws + WS_CS) + (size_t)bh * SEQ + t0;
    *(f32x4*)cs = (f32x4){(base + c[0]) * LOG2E, (base + c[1]) * LOG2E, (base + c[2]) * LOG2E, (base + c[3]) * LOG2E};
    *(f32x4*)(cs + 4) = (f32x4){(base + c[4]) * LOG2E, (base + c[5]) * LOG2E, (base + c[6]) * LOG2E, (base + c[7]) * LOG2E};
    __syncthreads();
    LAS float* c2s = sh + 16;
#pragma unroll
    for (int i = 0; i < 8; ++i) c2s[t0 + i] = (base + c[i]) * LOG2E;
    __syncthreads();
    if (F.tid < SEQ / 256) { const int qb = F.tid, nt = 4 * qb + 4; const float cq = c2s[256 * qb]; int lo = 0, hi = nt - 4;
        while (lo < hi) { const int mid = (lo + hi) >> 1; if (cq - c2s[64 * mid + 63] >= -SKIP_L2) hi = mid; else lo = mid + 1; }
        ((int*)(F.P.ws + WS_TS))[bh * 16 + qb] = lo & ~1; }
    __syncthreads();
}


#include <hip/hip_bf16.h>
namespace attn_body {
using bf16=__hip_bfloat16;
using s16x4=__attribute__((ext_vector_type(4)))short;
using f32x16=__attribute__((ext_vector_type(16)))float;
constexpr int NHEAD=NH,D=64,DM=1024;
constexpr int NW=8,QBLK=32,QB=QBLK*NW,KVBLK=64,NQB=SEQ/QB;
__device__ __forceinline__ int crow(int r,int hi){return (r&3)+8*(r>>2)+4*hi;}
#define SBAR() __builtin_amdgcn_sched_barrier(0)
__device__ __forceinline__ void cmask(f32x16&p0,f32x16&p1,int jb,int qrel,int hi){
  const float NEG=-INFINITY; int kb=64*jb+4*hi;
  #pragma unroll
  for(int r=0;r<16;++r){int kv=kb+(r&3)+8*(r>>2); if(kv>qrel)p0[r]=NEG; if(kv+32>qrel)p1[r]=NEG;}
}
constexpr int NSLOT=3, SLOTB=8192;
constexpr int LDS_K=0, LDS_V=NSLOT*SLOTB, LDS_WS=2*NSLOT*SLOTB, LDS_OST=LDS_WS+NW*64*4, LDS_C2=LDS_OST+NW*4096, LDS_BYTES=LDS_C2+SEQ*4+512;
__device__ __forceinline__ void glds16(const void*gsrc,unsigned lds_dst){unsigned keep;
  asm volatile("s_mov_b32 %0, m0\n\ts_mov_b32 m0, %2\n\ts_nop 0\n\tglobal_load_lds_dwordx4 %1, off\n\ts_mov_b32 m0, %0":"=&s"(keep):"v"(gsrc),"s"(lds_dst):"memory");}
__device__ __forceinline__ float max3f(float a,float b,float c){float r;asm("v_max3_f32 %0, %1, %2, %3":"=v"(r):"v"(a),"v"(b),"v"(c));return r;}
__device__ __forceinline__ float max2f(float a,float b){float r;asm("v_max_f32_e32 %0, %1, %2":"=v"(r):"v"(a),"v"(b));return r;}
__device__ __forceinline__ float fadd_s(float a,float b){float r;asm("v_add_f32_e32 %0, %1, %2":"=v"(r):"v"(a),"v"(b));return r;}
__device__ __forceinline__ float fsub_s(float a,float b){float r;asm("v_sub_f32_e32 %0, %1, %2":"=v"(r):"v"(a),"v"(b));return r;}
typedef float f32x2_t __attribute__((ext_vector_type(2))); typedef __bf16 bf16x2_t __attribute__((ext_vector_type(2)));
__device__ __forceinline__ unsigned cvtpk_s(float lo,float hi){f32x2_t v={lo,hi};bf16x2_t b=__builtin_convertvector(v,bf16x2_t);return __builtin_bit_cast(unsigned,b);}
#define WAIT_BAR(N) asm volatile("s_waitcnt vmcnt(" #N ") lgkmcnt(0)\n\ts_barrier":::"memory")
__device__ __forceinline__ void split3(float x,unsigned&h,unsigned&m,unsigned&l){
  const unsigned u=__float_as_uint(x)&0xffff0000u; const float r1=x-__uint_as_float(u);
  const unsigned u1=__float_as_uint(r1)&0xffff0000u; const float r2=r1-__uint_as_float(u1);
  h=u>>16; m=u1>>16; l=__float_as_uint(r2)>>16; }
__device__ __forceinline__ bf16x8 make_qx(float base,int hi){ unsigned h,m,l; split3(base,h,m,l); u32x4 w; w.x=h|(m<<16); w.y=l|0x3f800000u; w.z=0x3f803f80u; w.w=0u; if(hi){w.x=0u;w.y=0u;w.z=0u;} return __builtin_bit_cast(bf16x8,w); }
__device__ __forceinline__ bf16x8 make_kx(float ck,int hi){ unsigned h,m,l; split3(-ck,h,m,l); u32x4 w; w.x=0x3f803f80u; w.y=0x3f80u|(h<<16); w.z=m|(l<<16); w.w=0u; if(hi){w.x=0u;w.y=0u;w.z=0u;} return __builtin_bit_cast(bf16x8,w); }

__device__ __forceinline__ void qkt(f32x16&p0,f32x16&p1,const char*Kslot,const bf16x8*qr,bf16x8 qx,bf16x8 kx0,bf16x8 kx1,int r32,int hi){
  const char*kb=Kslot+hi*1024+r32*16; const f32x16 z=f32x16{};
  p0=__builtin_amdgcn_mfma_f32_32x32x16_bf16(kx0,qx,z,0,0,0);p1=__builtin_amdgcn_mfma_f32_32x32x16_bf16(kx1,qx,z,0,0,0);
  #pragma unroll
  for(int d0=0;d0<4;++d0){
    const bf16x8 b0=*reinterpret_cast<const bf16x8*>(kb+d0*2048);
    const bf16x8 b1=*reinterpret_cast<const bf16x8*>(kb+d0*2048+512);
    p0=__builtin_amdgcn_mfma_f32_32x32x16_bf16(b0,qr[d0],p0,0,0,0);p1=__builtin_amdgcn_mfma_f32_32x32x16_bf16(b1,qr[d0],p1,0,0,0);}
}
typedef __attribute__((address_space(3))) const char* lds_cptr;
typedef short v4i16_t __attribute__((ext_vector_type(4)));
__device__ __forceinline__ void kload8(bf16x8*kf,lds_cptr kp){
  kf[0]=*(const __attribute__((address_space(3))) bf16x8*)(kp);      kf[1]=*(const __attribute__((address_space(3))) bf16x8*)(kp+512);
  kf[2]=*(const __attribute__((address_space(3))) bf16x8*)(kp+2048); kf[3]=*(const __attribute__((address_space(3))) bf16x8*)(kp+2560);
  kf[4]=*(const __attribute__((address_space(3))) bf16x8*)(kp+4096); kf[5]=*(const __attribute__((address_space(3))) bf16x8*)(kp+4608);
  kf[6]=*(const __attribute__((address_space(3))) bf16x8*)(kp+6144); kf[7]=*(const __attribute__((address_space(3))) bf16x8*)(kp+6656);
}
__device__ __forceinline__ void kload2(bf16x8*kf,lds_cptr kp,int j){ kf[2*j]=*(const __attribute__((address_space(3))) bf16x8*)(kp+j*2048); kf[2*j+1]=*(const __attribute__((address_space(3))) bf16x8*)(kp+j*2048+512); }
__device__ __forceinline__ s16x4 vtr(lds_cptr p){ return __builtin_bit_cast(s16x4,__builtin_amdgcn_ds_read_tr16_b64_v4i16((__attribute__((address_space(3))) v4i16_t*)p)); }
__device__ __forceinline__ float rowmax(const f32x16&p0,const f32x16&p1){
  float a=max3f(p0[0],p0[1],p1[0]),b=max3f(p0[2],p0[3],p1[1]);a=max3f(a,p1[2],p1[3]);
  #pragma unroll
  for(int r=4;r<16;r+=4){a=max3f(a,p0[r],p0[r+1]);b=max3f(b,p0[r+2],p0[r+3]);a=max3f(a,p1[r],p1[r+1]);b=max3f(b,p1[r+2],p1[r+3]);}
  const float m=max2f(a,b);
  auto rr=__builtin_amdgcn_permlane32_swap(__float_as_uint(m),__float_as_uint(m),false,false);
  return max2f(__uint_as_float(rr[0]),__uint_as_float(rr[1]));
}
__device__ __forceinline__ void pv(f32x16*o,int vb,bf16x8 pa0,bf16x8 pa1,bf16x8 pa2,bf16x8 pa3){
  #pragma unroll
  for(int d0=0;d0<2;++d0){s16x4 lo[4],hi[4];
    #pragma unroll
    for(int ks=0;ks<4;++ks){
      asm volatile("ds_read_b64_tr_b16 %0,%1 offset:%c2":"=&v"(lo[ks]):"v"(vb),"i"(d0*4096+ks*1024):"memory");
      asm volatile("ds_read_b64_tr_b16 %0,%1 offset:%c2":"=&v"(hi[ks]):"v"(vb),"i"(d0*4096+ks*1024+512):"memory");}
    asm volatile("s_waitcnt lgkmcnt(0)":::"memory");SBAR();
    #define PK(k) (bf16x8){lo[k][0],lo[k][1],lo[k][2],lo[k][3],hi[k][0],hi[k][1],hi[k][2],hi[k][3]}
    o[d0]=__builtin_amdgcn_mfma_f32_32x32x16_bf16(pa0,PK(0),o[d0],0,0,0);
    o[d0]=__builtin_amdgcn_mfma_f32_32x32x16_bf16(pa1,PK(1),o[d0],0,0,0);
    o[d0]=__builtin_amdgcn_mfma_f32_32x32x16_bf16(pa2,PK(2),o[d0],0,0,0);
    o[d0]=__builtin_amdgcn_mfma_f32_32x32x16_bf16(pa3,PK(3),o[d0],0,0,0);
    #undef PK
  }
}
#define ATTN_STORE16(p,v) (*(u32x4*)(p)=(v))
template<int THRL> __device__ __forceinline__ void attn_unit(int b,int h,int qb,const bf16*Q,const bf16*__restrict__ K,const bf16*__restrict__ V,const bf16*__restrict__ CZ,bf16*O,const float*__restrict__ c2g,int ts,float ub,char*shm){
  int tid=threadIdx.x; asm volatile("":"+v"(tid));
  const int lane=tid&63,r32=lane&31,hi=lane>>5; const int wid=__builtin_amdgcn_readfirstlane(tid>>6);
  const long rowbase=(long)b*SEQ; const int q0=qb*QB;
  const bf16*Qw=Q+(rowbase+q0+wid*QBLK)*DM+h*D;
  const bf16*Kh=K+(rowbase+(long)ts*KVBLK)*DM+h*D,*Vh=V+(rowbase+(long)ts*KVBLK)*DM+h*D;
  const unsigned lds0=(unsigned)(uintptr_t)shm;
  float*wsf=(float*)(shm+LDS_WS)+wid*64;
  float*c2l=(float*)(shm+LDS_C2);
  const bf16*ksrc=Kh+(long)lane*DM+wid*8;
  const bf16*vsrc=Vh+(long)(16*(wid&3)+(lane>>2))*DM+(wid>>2)*32+(lane&3)*8;
  const unsigned kdst=lds0+LDS_K+wid*1024, vdst=lds0+LDS_V+wid*1024;
  #define DMA_K(t,slot) glds16(ksrc+(long)(t)*KVBLK*DM,(unsigned)__builtin_amdgcn_readfirstlane(kdst+(slot)))
  #define DMA_V(t,slot) glds16(vsrc+(long)(t)*KVBLK*DM,(unsigned)__builtin_amdgcn_readfirstlane(vdst+(slot)))
  const int vb0=(int)(lds0+LDS_V)+((lane>>4)&1)*32+(lane&3)*8+(4*hi+((lane&15)>>2))*64;
  const char*Kbase=shm+LDS_K; bf16x8 kf[8];
  const lds_cptr shm3=(lds_cptr)shm; const lds_cptr kp0=shm3+LDS_K+hi*1024+r32*16; const lds_cptr vp0=shm3+LDS_V+((lane>>4)&1)*32+(lane&3)*8+(4*hi+((lane&15)>>2))*64;
  const int NT=(q0+QB)/KVBLK-ts;
  DMA_K(0,0);DMA_V(0,0);DMA_K(1,SLOTB);
  { const int kb0=ts*KVBLK; for(int i=tid*4;i<q0+QB-kb0;i+=NW*64*4)*(f32x4*)(c2l+i)=*(const f32x4*)(c2g+kb0+i); }
  bf16x8 qr[4];
  #pragma unroll
  for(int d0=0;d0<4;++d0)qr[d0]=*reinterpret_cast<const bf16x8*>(&Qw[(long)r32*DM+d0*16+hi*8]);
    float mhat=ub,l_reg=0.f;f32x16 o[2];o[0]=f32x16{};o[1]=f32x16{};
  const int qrel=wid*QBLK+r32;
  #define CMASK(P0,P1,t) do{int jb_=(t)-(NT-4); if(jb_>=0)cmask(P0,P1,jb_,qrel,hi);}while(0)
  bool resc=false;
  bf16x8 qx; float cq2;
  #define START(P0,P1) do{ resc=false; \
    _Pragma("unroll") for(int r=0;r<16;++r)P0[r]=__builtin_amdgcn_exp2f(P0[r]); }while(0)
  #define RESC() do{}while(0)
  f32x16 pA0,pA1,pB0,pB1;
  int sl_prev=0,sl_cur=0,sl_next=SLOTB;
  #define ROT() do{sl_prev=sl_cur;sl_cur=sl_next;sl_next=(sl_next==(NSLOT-1)*SLOTB)?0:sl_next+SLOTB;}while(0)
  DMA_K(2,2*SLOTB);
  WAIT_BAR(3);
  cq2=c2l[q0+qrel-ts*KVBLK]; qx=make_qx(cq2-mhat,hi);
  float ck0=c2l[r32],ck1=c2l[32+r32];
  { const bf16x8 kx0=make_kx(ck0,hi),kx1=make_kx(ck1,hi);
    qkt(pA0,pA1,Kbase,qr,qx,kx0,kx1,r32,hi); }
  asm volatile("s_nop 15\n\ts_nop 7":"+v"(pA0),"+v"(pA1));CMASK(pA0,pA1,0);
  ck0=c2l[64+r32];ck1=c2l[96+r32];
  START(pA0,pA1);
  _Pragma("unroll") for(int r=0;r<16;++r)pA1[r]=__builtin_amdgcn_exp2f(pA1[r]);
  WAIT_BAR(0);
  DMA_K(3,0);DMA_V(1,SLOTB);
  ROT();
  kload8(kf,kp0+sl_cur);
  WAIT_BAR(2);
  s16x4 vlo[8],vhi[8]; u32x4 pw0,pw1,pw2,pw3;
  #define PKW(P,B) cvtpk_s(P[B],P[B+1])
  #define PAF(k) __builtin_bit_cast(bf16x8,pw##k)
  #define VFR(i) (bf16x8){vlo[i][0],vlo[i][1],vlo[i][2],vlo[i][3],vhi[i][0],vhi[i][1],vhi[i][2],vhi[i][3]}
  #define PIN(x) asm volatile("":"+v"(x))
  #define MX3(a,b,c) __builtin_fmaxf(__builtin_fmaxf((a),(b)),(c))
  #define GAPA(MF,A0,A1,A2,A3,W0,W1,PW) do{ MF; sacc+=A0; sacc+=A1; sacc+=A2; sacc+=A3; PIN(sacc); W0; W1; PIN(PW); SBAR(); }while(0)
  #define EX(v) __builtin_amdgcn_exp2f(v)
  #define GAPB(MF,X,B) do{ MF; X[B]=EX(X[B]); X[B+1]=EX(X[B+1]); X[B+2]=EX(X[B+2]); X[B+3]=EX(X[B+3]); PIN(X); SBAR(); }while(0)
  #define VRD(i) do{ vlo[i]=vtr(vp_+(((i)>>2)*4096+((i)&3)*1024)); vhi[i]=vtr(vp_+(((i)>>2)*4096+((i)&3)*1024+512)); }while(0)
  #define KRD(G,j) do{ if(G){ kload2(kf,kp0+sl_next,j); SBAR(); } }while(0)
  #define STEP(C0,C1,P0,P1,t,GK,GV,GL) do{ SBAR(); \
    const lds_cptr vp_=vp0+sl_prev; \
    { const bf16x8 kx0_=make_kx(ck0,hi),kx1_=make_kx(ck1,hi); const f32x16 z_=f32x16{}; \
      C0=__builtin_amdgcn_mfma_f32_32x32x16_bf16(kx0_,qx,z_,0,0,0); C1=__builtin_amdgcn_mfma_f32_32x32x16_bf16(kx1_,qx,z_,0,0,0); } SBAR(); \
    VRD(0); SBAR(); float sacc=(P0[0]+P0[1]); \
    GAPA(C0=__builtin_amdgcn_mfma_f32_32x32x16_bf16(kf[0],qr[0],C0,0,0,0), P0[2],P0[3],P0[4],P0[5],     pw0[0]=PKW(P0,0), pw0[1]=PKW(P0,2), pw0); \
    VRD(4); SBAR(); GAPA(C1=__builtin_amdgcn_mfma_f32_32x32x16_bf16(kf[1],qr[0],C1,0,0,0), P0[6],P0[7],P0[8],P0[9],     pw0[2]=PKW(P0,4), pw0[3]=PKW(P0,6), pw0); \
    VRD(1); SBAR(); GAPA(C0=__builtin_amdgcn_mfma_f32_32x32x16_bf16(kf[2],qr[1],C0,0,0,0),   P0[10],P0[11],P0[12],P0[13], pw1[0]=PKW(P0,8), pw1[1]=PKW(P0,10), pw1); \
    VRD(5); SBAR(); GAPA(C1=__builtin_amdgcn_mfma_f32_32x32x16_bf16(kf[3],qr[1],C1,0,0,0),   P0[14],P0[15],P1[0],P1[1],   pw1[2]=PKW(P0,12),pw1[3]=PKW(P0,14), pw1); \
    VRD(2); SBAR(); GAPA(C0=__builtin_amdgcn_mfma_f32_32x32x16_bf16(kf[4],qr[2],C0,0,0,0),   P1[2],P1[3],P1[4],P1[5],     pw2[0]=PKW(P1,0), pw2[1]=PKW(P1,2), pw2); \
    VRD(6); SBAR(); GAPA(C1=__builtin_amdgcn_mfma_f32_32x32x16_bf16(kf[5],qr[2],C1,0,0,0),   P1[6],P1[7],P1[8],P1[9],     pw2[2]=PKW(P1,4), pw2[3]=PKW(P1,6), pw2); \
    VRD(3); SBAR(); GAPA(C0=__builtin_amdgcn_mfma_f32_32x32x16_bf16(kf[6],qr[3],C0,0,0,0),   P1[10],P1[11],P1[12],P1[13], pw3[0]=PKW(P1,8), pw3[1]=PKW(P1,10), pw3); \
    VRD(7); SBAR(); GAPA(C1=__builtin_amdgcn_mfma_f32_32x32x16_bf16(kf[7],qr[3],C1,0,0,0),   P1[14],P1[15],0.f,0.f,       pw3[2]=PKW(P1,12),pw3[3]=PKW(P1,14), pw3); \
    l_reg+=sacc; \
    if(GK){DMA_K((t)+3,sl_cur);} if(GV){DMA_V((t)+1,sl_next);} \
    if(GL){ ck0=c2l[64*((t)+1)+r32]; ck1=c2l[64*((t)+1)+32+r32]; } \
    CMASK(C0,C1,t); \
    SBAR(); \
    GAPB(o[0]=__builtin_amdgcn_mfma_f32_32x32x16_bf16(PAF(0),VFR(0),o[0],0,0,0), C0,0); \
    GAPB(o[1]=__builtin_amdgcn_mfma_f32_32x32x16_bf16(PAF(0),VFR(4),o[1],0,0,0), C0,4); \
    KRD(GL,0); GAPB(o[0]=__builtin_amdgcn_mfma_f32_32x32x16_bf16(PAF(1),VFR(1),o[0],0,0,0), C0,8); \
    KRD(GL,1); GAPB(o[1]=__builtin_amdgcn_mfma_f32_32x32x16_bf16(PAF(1),VFR(5),o[1],0,0,0), C0,12); \
    KRD(GL,2); GAPB(o[0]=__builtin_amdgcn_mfma_f32_32x32x16_bf16(PAF(2),VFR(2),o[0],0,0,0), C1,0); \
    KRD(GL,3); GAPB(o[1]=__builtin_amdgcn_mfma_f32_32x32x16_bf16(PAF(2),VFR(6),o[1],0,0,0), C1,4); \
    GAPB(o[0]=__builtin_amdgcn_mfma_f32_32x32x16_bf16(PAF(3),VFR(3),o[0],0,0,0), C1,8); \
    GAPB(o[1]=__builtin_amdgcn_mfma_f32_32x32x16_bf16(PAF(3),VFR(7),o[1],0,0,0), C1,12); \
    }while(0)
  int t=1;
  #undef CMASK
  #define CMASK(P0,P1,t) do{}while(0)
  for(;t+5<NT;t+=2){
    STEP(pB0,pB1,pA0,pA1,t,true,true,true);     WAIT_BAR(2); RESC(); ROT();
    STEP(pA0,pA1,pB0,pB1,t+1,true,true,true);   WAIT_BAR(2); RESC(); ROT();
  }
  #undef CMASK
  #define CMASK(P0,P1,t) do{int jb_=(t)-(NT-4); if(jb_>=0)cmask(P0,P1,jb_,qrel,hi);}while(0)
  #define ENDW(tt) do{ if((tt)+3<NT){WAIT_BAR(2);} else if((tt)+2<NT){WAIT_BAR(1);} else {WAIT_BAR(0);} }while(0)
  for(;t+1<NT;t+=2){
    STEP(pB0,pB1,pA0,pA1,t,(t+3<NT),(t+1<NT),(t+1<NT));       ENDW(t);   RESC(); ROT();
    STEP(pA0,pA1,pB0,pB1,t+1,(t+4<NT),(t+2<NT),(t+2<NT));     ENDW(t+1); RESC(); ROT();
  }
  STEP(pB0,pB1,pA0,pA1,NT-1,false,false,false); RESC();
  { float sacc=pB0[0]+pB0[1]; _Pragma("unroll") for(int r=2;r<16;++r)sacc+=pB0[r]; _Pragma("unroll") for(int r=0;r<16;++r)sacc+=pB1[r]; l_reg+=sacc;
    pw0=(u32x4){PKW(pB0,0),PKW(pB0,2),PKW(pB0,4),PKW(pB0,6)};pw1=(u32x4){PKW(pB0,8),PKW(pB0,10),PKW(pB0,12),PKW(pB0,14)};pw2=(u32x4){PKW(pB1,0),PKW(pB1,2),PKW(pB1,4),PKW(pB1,6)};pw3=(u32x4){PKW(pB1,8),PKW(pB1,10),PKW(pB1,12),PKW(pB1,14)};
    SBAR(); pv(o,vb0+sl_cur,PAF(0),PAF(1),PAF(2),PAF(3)); }
  #undef PKW
  #undef PAF
  #undef VFR
  #undef PIN
  #undef MX3
  #undef GAPA
  #undef GAPB
  #undef EX
  #undef VRD
  #undef KRD
  #undef STEP
  #undef ENDW
  {auto rr=__builtin_amdgcn_permlane32_swap(__float_as_uint(l_reg),__float_as_uint(l_reg),false,false);l_reg=__uint_as_float(rr[0])+__uint_as_float(rr[1]);}
  if(hi==0)wsf[32+r32]=l_reg;asm volatile("s_waitcnt lgkmcnt(0)":::"memory");
  bf16*Ow=O+(rowbase+q0+wid*QBLK)*DM+h*D;
  const unsigned short*Cw=(const unsigned short*)(CZ+(rowbase+q0+wid*QBLK)*DM+h*D);
  { bf16*stg=(bf16*)(shm+LDS_OST)+wid*2048;
    #pragma unroll
    for(int r=0;r<16;++r){const int orow=crow(r,hi); const float rl=__builtin_amdgcn_rcpf(wsf[32+orow]);
      #pragma unroll
      for(int d0=0;d0<2;++d0){ const float cz=__uint_as_float((unsigned)Cw[(long)orow*DM+d0*32+r32]<<16); stg[orow*64+d0*32+r32]=__float2bfloat16(o[d0][r]*rl*cz);} }
    asm volatile("s_waitcnt lgkmcnt(0)":::"memory");
    #pragma unroll
    for(int i=0;i<4;++i){const int row=i*8+(lane>>3),ch=lane&7; const u32x4 v=*(const u32x4*)(stg+row*64+ch*8); ATTN_STORE16(Ow+(long)row*DM+ch*8,v);} }
  asm volatile("s_waitcnt lgkmcnt(0)\n\ts_barrier":::"memory");
  #undef DMA_K
  #undef DMA_V
  #undef CMASK
  #undef START
  #undef RESC
  #undef ROT
}
#undef SBAR
#undef WAIT_BAR
}

typedef float f32x2 __attribute__((ext_vector_type(2)));
__device__ __forceinline__ void p2_conv(Frame& F, int l, int unit, bf16_t* outb, const bool pv_ = false) {
    const int tid = F.tid, lane = F.lane, w = F.wave;
    const size_t row0 = (size_t)unit * 64; const int tseq0 = (int)(row0 % SEQ);
    const bf16_t* AG = (const bf16_t*)(F.P.ws + WS_B3); const bf16_t* B0 = (const bf16_t*)(F.P.ws + WS_B0);
    LAS unsigned char* tile = F.lds + RING_OFF;
    for (int c = tid; c < 94 * 64; c += 512) { const int r = c >> 6, ch = c & 63, tr = r - (CW - 1); const bool valid = tseq0 + tr >= 0;
        u32x4 v = (u32x4){0u, 0u, 0u, 0u}; if (valid) v = *(const u32x4*)(AG + (size_t)((long)row0 + tr) * 1024 + ch * 8);
        *(LAS u32x4*)(tile + r * 1024 + ch * 16) = v; }
    LAS float* wl = (LAS float*)(tile + 94 * 1024);
    { const float* cwg = F.P.conv_w + (size_t)l * CW * DA; for (int c = tid; c < CW * DA / 4; c += 512) *(LAS f32x4*)(wl + 4 * c) = *(const f32x4*)(cwg + 4 * c); }
    __syncthreads();
    if (PROBE_CONV == 2 && pv_) { __syncthreads(); return; }
    f32x2 out[4][8]; float s1[8], s2[8];
#pragma unroll
    for (int o = 0; o < 8; ++o) { s1[o] = 0.f; s2[o] = 0.f; }
#pragma unroll
    for (int i = 0; i < 4; ++i) {
        __builtin_amdgcn_sched_barrier(0);
        int p = lane + 64 * i; asm volatile("" : "+v"(p));
        const LAS float* cw = wl + 2 * p;
        f32x2 wv[CW];
#pragma unroll
        for (int j = 0; j < CW; ++j) wv[j] = *(const LAS f32x2*)(cw + j * DA);
        const f32x2 cb = *(const f32x2*)(F.P.conv_b + l * DA + 2 * p);
        const LAS unsigned* tp = (const LAS unsigned*)(tile + (8 * w) * 1024 + 4 * p);
        f32x2 win[16];
#pragma unroll
        for (int k = 0; k < 16; ++k) { const unsigned u = tp[k * 256]; win[k] = (f32x2){__uint_as_float(u << 16), __uint_as_float(u & 0xffff0000u)}; }
#pragma unroll
        for (int o = 0; o < 8; ++o) out[i][o] = cb;
        __builtin_amdgcn_sched_barrier(0);
#pragma unroll
        for (int j = 0; j < CW; ++j) {
            if (!(PROBE_CONV == 1 && pv_))
#pragma unroll
            for (int o = 0; o < 8; ++o) out[i][o] += wv[j] * win[(j + o) & 15];
            asm volatile("" : "+v"(out[i][0]), "+v"(out[i][1]), "+v"(out[i][2]), "+v"(out[i][3]), "+v"(out[i][4]), "+v"(out[i][5]), "+v"(out[i][6]), "+v"(out[i][7]));
            if (j + 16 < 38) { const LAS unsigned* tq = tp; asm volatile("" : "+v"(tq)); const unsigned u = tq[(j + 16) * 256]; win[j & 15] = (f32x2){__uint_as_float(u << 16), __uint_as_float(u & 0xffff0000u)}; }
            __builtin_amdgcn_sched_barrier(0);
        }
#pragma unroll
        for (int o = 0; o < 8; ++o) { s1[o] += out[i][o].x + out[i][o].y; s2[o] += out[i][o].x * out[i][o].x + out[i][o].y * out[i][o].y; }
    }
    unsigned az[4][8];
#pragma unroll
    for (int i = 0; i < 4; ++i)
#pragma unroll
        for (int o = 0; o < 8; ++o) az[i][o] = *(const unsigned*)(B0 + (row0 + 8 * w + o) * 1024 + 2 * (lane + 64 * i));
#pragma unroll
    for (int o = 0; o < 8; ++o) { s1[o] = wsum(s1[o]); s2[o] = wsum(s2[o]); }
#pragma unroll
    for (int i = 0; i < 4; ++i) {
        const int p = lane + 64 * i;
        const f32x2 gg = *(const f32x2*)(F.P.cn_g + l * DA + 2 * p), be = *(const f32x2*)(F.P.cn_b + l * DA + 2 * p);
#pragma unroll
        for (int o = 0; o < 8; ++o) { const float mu = s1[o] * (1.f / DA), ex2 = s2[o] * (1.f / DA); const float rstd = rsqrtf(fmaxf(ex2 - mu * mu, 0.f) + EPS);
            f32x2 y = (out[i][o] - mu) * rstd * gg + be; y.x = y.x * fsigm(y.x); y.y = y.y * fsigm(y.y);
            *(unsigned*)(outb + (row0 + 8 * w + o) * 1024 + 2 * p) = cvt_pk_bf16(y.x * __uint_as_float(az[i][o] << 16), y.y * __uint_as_float(az[i][o] & 0xffff0000u)); }
    }
    __syncthreads();
}
__device__ __forceinline__ void p2_gmlp(Frame& F, int l, int unit, bf16_t* outb) {
    constexpr int VTP = 136;
    const int tid = F.tid, lane = F.lane, w = F.wave, fr = lane & 15, fq = lane >> 4, ch = unit >> 1, gp = unit & 1, c0 = 256 * gp; const size_t row0 = (size_t)ch * CHK;
    LAS bf16_t* vt = (LAS bf16_t*)(F.lds + RING_OFF);
    const bf16_t* V = (const bf16_t*)(F.P.ws + WS_B3) + 512 + c0; const bf16_t* U = (const bf16_t*)(F.P.ws + WS_B0) + 512 + c0; const bf16_t* BZ = (const bf16_t*)(F.P.ws + WS_B4) + c0;
    const float* vss = (const float*)(F.P.ws + WS_VSS); const float* gn = F.P.gn_g + l * DB + c0;
    const size_t t = row0 + 16 * w + fr;
    unsigned long long uu[16], zz[16];
#pragma unroll
    for (int n = 0; n < 16; ++n) { uu[n] = *(const unsigned long long*)(U + t * 1024 + 16 * n + 4 * fq); zz[n] = *(const unsigned long long*)(BZ + t * 512 + 16 * n + 4 * fq); }
    bf16x8 wf[2][4];
#pragma unroll
    for (int g2 = 0; g2 < 2; ++g2)
#pragma unroll
        for (int ks = 0; ks < 4; ++ks) wf[g2][ks] = *(const bf16x8*)((const bf16_t*)(F.P.ws + WS_WSB) + ((size_t)(l * NG + 2 * gp + g2) * CHK + 16 * w + fr) * CHK + 32 * ks + 8 * fq);
    const float bs0 = F.P.b_s[(size_t)(l * NG + 2 * gp) * CHK + 16 * w + fr], bs1 = F.P.b_s[(size_t)(l * NG + 2 * gp + 1) * CHK + 16 * w + fr];
    { const int sidx = tid & 127; const f32x4 qa = *(const f32x4*)(vss + (row0 + sidx) * 8), qb = *(const f32x4*)(vss + (row0 + sidx) * 8 + 4);
      const float ss = ((qa.x + qa.y) + (qa.z + qa.w)) + ((qb.x + qb.y) + (qb.z + qb.w)); const float rv = rsqrtf(ss * (1.f / DB) + EPS);
      u32x4 raw[8];
#pragma unroll
      for (int k = 0; k < 8; ++k) raw[k] = *(const u32x4*)(V + (row0 + sidx) * 1024 + ((tid >> 7) + 4 * k) * 8);
#pragma unroll
      for (int k = 0; k < 8; ++k) { const int c8 = ((tid >> 7) + 4 * k) * 8; f32x4 v0, v1; unpack8(raw[k], v0, v1); const f32x4 g0 = *(const f32x4*)(gn + c8), g1 = *(const f32x4*)(gn + c8 + 4);
          v0 = v0 * rv * g0; v1 = v1 * rv * g1;
#pragma unroll
          for (int e = 0; e < 4; ++e) { vt[(c8 + e) * VTP + sidx] = f2bf(v0[e]); vt[(c8 + 4 + e) * VTP + sidx] = f2bf(v1[e]); } } }
    __syncthreads();
    f32x4 acc[16];
#pragma unroll
    for (int n = 0; n < 16; ++n) acc[n] = (f32x4){0.f, 0.f, 0.f, 0.f};
#pragma unroll
    for (int ks = 0; ks < 4; ++ks) {
        if (32 * ks <= 16 * w + 15) {
#pragma unroll
            for (int n = 0; n < 16; ++n) { const bf16x8 vf = *(const LAS bf16x8*)(vt + (16 * n + fr) * VTP + 32 * ks + 8 * fq); acc[n] = __builtin_amdgcn_mfma_f32_16x16x32_bf16(vf, wf[n >> 3][ks], acc[n], 0, 0, 0); }
        }
    }
#pragma unroll
    for (int n = 0; n < 16; ++n) { const float bs = n < 8 ? bs0 : bs1;
        const unsigned u0 = (unsigned)uu[n], u1 = (unsigned)(uu[n] >> 32), z0 = (unsigned)zz[n], z1 = (unsigned)(zz[n] >> 32);
        const float o0 = __uint_as_float(u0 << 16) * (acc[n][0] + bs) * __uint_as_float(z0 << 16), o1 = __uint_as_float(u0 & 0xffff0000u) * (acc[n][1] + bs) * __uint_as_float(z0 & 0xffff0000u);
        const float o2 = __uint_as_float(u1 << 16) * (acc[n][2] + bs) * __uint_as_float(z1 << 16), o3 = __uint_as_float(u1 & 0xffff0000u) * (acc[n][3] + bs) * __uint_as_float(z1 & 0xffff0000u);
        *(unsigned long long*)(outb + 512 + c0 + t * 1024 + 16 * n + 4 * fq) = (unsigned long long)cvt_pk_bf16(o0, o1) | ((unsigned long long)cvt_pk_bf16(o2, o3) << 32); }
    __syncthreads();
}

__global__ void __launch_bounds__(NWAVES * 64, 2) mk_fwd(Args args) {
    extern __shared__ __attribute__((aligned(16))) unsigned char lds[];
    Frame F;
    F.lds = (LAS unsigned char*)lds;
    volatile LAS unsigned* MISC = (volatile LAS unsigned*)(F.lds + MISC_OFF);
    F.tid = threadIdx.x; F.lane = F.tid & 63; F.wave = __builtin_amdgcn_readfirstlane(F.tid >> 6);
    F.G = gridDim.x; { const int bx = blockIdx.x; F.vcu = (F.G % 8 == 0) ? (bx % 8) * (F.G / 8) + bx / 8 : bx; }
    F.P.x = args.in[0]; F.P.norm_g = args.in[1]; F.P.w_in = args.in[2]; F.P.b_gate = args.in[3]; F.P.conv_w = args.in[4]; F.P.conv_b = args.in[5]; F.P.cn_g = args.in[6]; F.P.cn_b = args.in[7]; F.P.w_a = args.in[8];
    F.P.gn_g = args.in[9]; F.P.w_s = args.in[10]; F.P.b_s = args.in[11]; F.P.w_b = args.in[12]; F.P.qn_g = args.in[13]; F.P.kn_g = args.in[14]; F.P.b_f = args.in[15]; F.P.w_c = args.in[16]; F.P.w_out = args.in[17];
    F.P.out = args.out; F.P.ws = args.ws;
    gu32* ctl = (gu32*)(args.ws + WS_CTL);
    for (int u = F.tid; u < (LDS_BYTES - LDSCTL_OFF) / 4; u += NWAVES * 64) ((LAS unsigned*)(F.lds + LDSCTL_OFF))[u] = 0u;
    __syncthreads();
    XcdBarrier bar = xcd_barrier_post((unsigned*)(ctl + CW_BAR) + args.li * XCD_BAR_WORDS, MISC + 8);

    bool dup_done = false;
    for (int ph = args.ph_lo; ph < args.ph_hi;) {
        const int l = ph / 5, p = ph % 5;
        const bool dummy = (PROBE_DUP >= 0) && p == PROBE_DUP && !dup_done;
        asm volatile("" : "+v"(F.tid)); F.lane = F.tid & 63;
        int bid = (int)blockIdx.x; asm volatile("" : "+s"(bid));
        unsigned char* ws = F.P.ws; unsigned char* wl = ws + WS_W + (size_t)l * W_LAYER;
        const float* xin = l == 0 ? F.P.x : F.P.out;
        if (p == 0) {
            if (l > 0) { ++ph; continue; }
            if (l == 0 && (!dummy || (PROBE_SUB & 1))) p0_weights(F);
            if (!dummy || (PROBE_SUB & 2)) p0_ln(F, l, xin);
        } else if (p == 1) {
            if (bid < NB * NH) p1_scan(F, bid, l);
            { pg8::TileOrder T0; T0.init(M, N1, F.G, bid); int pm_ = 0, pn_ = 0; (void)T0.tile(0, pm_, pn_);
              LAS float* Rt = (LAS float*)(F.lds + RT_OFF);
              if (F.tid < 256) { float r = 1.f; if (l > 0) { const f32x4 q = *(const f32x4*)((const float*)(ws + WS_SSP) + ((size_t)pm_ * 256 + F.tid) * 4); r = rsqrtf(((q.x + q.y) + (q.z + q.w)) * (1.f / D) + EPS); } Rt[F.tid] = r; }
              __syncthreads(); }
            pg8::SchedG1 S; S.T.init(M, N1, F.G, bid); S.A = (const char*)(ws + WS_H); S.B = (const char*)(wl + WO_W1);
            pg8::EpiG1 E{(bf16_t*)(ws + WS_B0), (bf16_t*)(ws + WS_B1), (bf16_t*)(ws + WS_B2), (bf16_t*)(ws + WS_B3), (bf16_t*)(ws + WS_B4), (float*)(ws + WS_VSS), F.P.qn_g + l * HD, F.P.kn_g + l * HD, (const LAS float*)(F.lds + RT_OFF)};
            pg8::gemm_phase<pg8::EpiG1, pg8::SchedG1>(F.lds + RING_OFF, S, E);
        } else if (p == 2) {
            for (int part = 0; part < 2; ++part) {
              asm volatile("" : "+v"(F.tid)); F.lane = F.tid & 63; asm volatile("" : "+s"(bid));
              if ((part == 0) == ((F.vcu & 1) == 0)) {
            if (!dummy || (PROBE_SUB & 1)) p2_conv(F, l, bid, dummy ? (bf16_t*)(ws + WS_DUMMY) : (bf16_t*)(ws + WS_B0), dummy);
            if (!dummy || (PROBE_SUB & 2)) { bf16_t* ob = dummy ? (bf16_t*)(ws + WS_DUMMY) : (bf16_t*)(ws + WS_B0); p2_gmlp(F, l, bid, ob); }
              } else {
            if (!dummy || (PROBE_SUB & 4)) { const int bh = F.vcu >> 3, sq = F.vcu & 7; const attn_body::bf16* b1 = (const attn_body::bf16*)(ws + WS_B1); const attn_body::bf16* b2 = (const attn_body::bf16*)(ws + WS_B2);
              const float* c2g = (const float*)(ws + WS_CS) + (size_t)bh * SEQ; const int* tsg = (const int*)(ws + WS_TS) + bh * 16;
              float gqm = fabsf(F.P.qn_g[l * HD + F.lane]), gkm = fabsf(F.P.kn_g[l * HD + F.lane]);
#pragma unroll
              for (int o_ = 1; o_ < 64; o_ <<= 1) { gqm = fmaxf(gqm, __shfl_xor(gqm, o_)); gkm = fmaxf(gkm, __shfl_xor(gkm, o_)); }
              const float ub = 64.f * C2 * gqm * gkm * 1.01f;
              for (int i = 0; i < 2; ++i) { const int qb = i == 0 ? 15 - sq : sq; const int ts = __builtin_amdgcn_readfirstlane(tsg[qb]); attn_body::attn_unit<8>(bh / NH, bh % NH, qb, b1, b1 + 512, b2, b2 + 512, dummy ? (attn_body::bf16*)(ws + WS_DUMMY) : (attn_body::bf16*)(ws + WS_B1), c2g, ts, ub, (char*)lds + RING_OFF); } }
              }
            }
        } else if (p == 3) {
            pg8::TileOrder T; T.init(M, D, F.G, bid);
            pg8::SchedMerge S; { int pm_ = 0, pn_ = 0; S.ok = T.tile(0, pm_, pn_); S.pm = pm_; S.pn = pn_; }
            S.ws = (const char*)ws; S.wl = (const char*)wl;
            S.cls = F.vcu & 1;
            pg8::EpiMerge E{ws + WS_GT + (size_t)bid * 131072, (bf16_t*)(ws + WS_MG), F.P.b_gate + (size_t)l * 3072, (const LAS float*)(F.lds + RT_OFF), S.cls, (size_t)(WS_B4 - WS_GT), dummy};
            pg8::gemm_phase<pg8::EpiMerge, pg8::SchedMerge>(F.lds + RING_OFF, S, E);
        } else {
            pg8::SchedG1 S; S.T.init(M, D, F.G, bid); S.A = (const char*)(ws + WS_MG); S.B = (const char*)(wl + WO_WO);
            if (l + 1 < NL) {
                pg8::EpiOutLN E{xin, (bf16_t*)(ws + WS_H), F.P.norm_g + (size_t)(l + 1) * D, F.P.w_in + (size_t)(l + 1) * D * NIN + OC_F, (float*)(ws + WS_SSP), (float*)(ws + WS_FP)};
                pg8::gemm_phase<pg8::EpiOutLN, pg8::SchedG1>(F.lds + RING_OFF, S, E);
            } else {
                pg8::EpiOutB E{(const bf16_t*)(ws + WS_H), dummy ? (float*)(ws + WS_B0) : F.P.out};
                pg8::gemm_phase<pg8::EpiOutB, pg8::SchedG1>(F.lds + RING_OFF, S, E);
            }
        }
        if (dummy) { dup_done = true; continue; }
        dup_done = false; ++ph;
        if (ph < args.ph_hi) xcd_barrier(bar);
    }
}

#ifndef MK_MODE
#define MK_MODE 2
#endif
extern "C" void kernel_launch(void* const* d_in, const int* in_sizes, int n_in, void* d_out, int out_size, void* d_ws, size_t ws_size, hipStream_t stream) {
    static int ok = 0;
    if (ok == 0) {
        if (n_in != 18 || in_sizes[0] != M * D || out_size != M * D || ws_size < WS_END) { fprintf(stderr, "kernel_launch: unexpected shapes (n_in %d in0 %d out %d ws %zu)\n", n_in, n_in > 0 ? in_sizes[0] : -1, out_size, ws_size); ok = -1; return; }
        const int tl = 64 * TLD * 4;
        (void)hipFuncSetAttribute((const void*)nv_gemm1, hipFuncAttributeMaxDynamicSharedMemorySize, tl);
        (void)hipFuncSetAttribute((const void*)nv_merge, hipFuncAttributeMaxDynamicSharedMemorySize, 2 * 64 * 256 * 4);
        (void)hipFuncSetAttribute((const void*)nv_gmlp, hipFuncAttributeMaxDynamicSharedMemorySize, 128 * 129 * 4);
        (void)hipFuncSetAttribute((const void*)nv_attn, hipFuncAttributeMaxDynamicSharedMemorySize, 4 * SEQ * 4);
        if (hipFuncSetAttribute((const void*)mk_fwd, hipFuncAttributeMaxDynamicSharedMemorySize, LDS_BYTES) != hipSuccess) { fprintf(stderr, "kernel_launch: hipFuncSetAttribute(mk_fwd) failed\n"); ok = -1; return; }
        int dev = 0, cus = 0; (void)hipGetDevice(&dev); (void)hipDeviceGetAttribute(&cus, hipDeviceAttributeMultiprocessorCount, dev);
        if (cus != 256) fprintf(stderr, "kernel_launch: note: %d CUs (built for 256)\n", cus);
        (void)hipGetLastError();
        ok = 1;
    }
    if (ok < 0) return;
    Ptrs P{};
    const float** pp = (const float**)&P;
    for (int i = 0; i < 18; ++i) pp[i] = (const float*)d_in[i];
    P.out = (float*)d_out; P.ws = (unsigned char*)d_ws;
    const int tl = 64 * TLD * 4;
#if MK_MODE == 0
    nv_prep<<<2048, 256, 0, stream>>>(P);
    for (int l = 0; l < NL; ++l) {
        const float* xin = l == 0 ? P.x : P.out;
        nv_ln<<<M / 4, 256, 0, stream>>>(P, l, xin);
        nv_scan<<<NB * NH, 256, 0, stream>>>(P);
        nv_gemm1<<<dim3(20, 256), 256, tl, stream>>>(P, l);
        nv_conv<<<M, 512, 0, stream>>>(P, l);
        nv_gmlp<<<dim3(128, 4), 256, 128 * 129 * 4, stream>>>(P, l);
        nv_attn<<<M * NH / 4, 256, 4 * SEQ * 4, stream>>>(P);
        nv_merge<<<dim3(4, 256), 256, 2 * 64 * 256 * 4, stream>>>(P, l);
        nv_out<<<dim3(4, 256), 256, 0, stream>>>(P, l, xin, P.out);
    }
#else
    (void)tl;
    if (hipMemsetAsync((char*)d_ws + WS_CTL, 0, CTL_ZERO_BYTES, stream) != hipSuccess) { fprintf(stderr, "kernel_launch: memset failed\n"); return; }
    Args a{};
    for (int i = 0; i < 18; ++i) a.in[i] = (const float*)d_in[i];
    a.out = (float*)d_out; a.ws = (unsigned char*)d_ws;
    auto mk = [&](int lo, int hi, int li) { a.ph_lo = lo; a.ph_hi = hi; a.li = li; hipLaunchKernelGGL(mk_fwd, dim3(256), dim3(NWAVES * 64), LDS_BYTES, stream, a);
        const hipError_t le = hipPeekAtLastError(); if (le != hipSuccess) fprintf(stderr, "kernel_launch: mk launch [%d,%d) failed: %s\n", lo, hi, hipGetErrorName(le)); };
#if MK_MODE == 1
    auto mixers = [&](int l) { nv_conv<<<M, 512, 0, stream>>>(P, l); nv_gmlp<<<dim3(128, 4), 256, 128 * 129 * 4, stream>>>(P, l); nv_attn<<<M * NH / 4, 256, 4 * SEQ * 4, stream>>>(P); };
    mk(0, 2, 0); mixers(0); mk(3, 7, 1); mixers(1); mk(8, 10, 2);
#else
    mk(0, NPH, 0);
#endif
#endif
}
```

```cpp
#include <hip/hip_runtime.h>
#include <cstdio>
#include <cstdint>
#include <cmath>

constexpr int NL = 2, NB = 4, SEQ = 4096, M = NB * SEQ, D = 1024;
constexpr int DA = 512, DB = 512, NH = 8, HD = 64, DC = 512, CW = 31, CHK = 128, NG = 4, GD = 128, NIN = 8200;
constexpr float EPS = 1e-6f;
constexpr float LOG2E = 1.4426950408889634f;
constexpr float C2 = 0.125f * LOG2E;
constexpr int N1 = 5120;
constexpr int OC_GATE = 0, OC_AIN = 3072, OC_AZ = 4096, OC_U = 4608, OC_V = 5120, OC_BZ = 5632, OC_Q = 6144, OC_K = 6656, OC_VA = 7168, OC_CZ = 7680, OC_F = 8192;

constexpr size_t MiB = 1u << 20;
constexpr size_t WS_CTL = 0, CTL_ZERO_BYTES = 1 * MiB;
constexpr size_t WS_VSS = 1 * MiB;
constexpr size_t WS_LOGF = WS_VSS + 512 * 1024;
constexpr size_t WS_CS = 2 * MiB;
constexpr size_t WS_WSB = WS_CS + 512 * 1024;
constexpr size_t WS_TS = 3 * MiB;
constexpr size_t WS_W = 4 * MiB, W_LAYER = 22 * MiB;
constexpr size_t WO_W1 = 0, WO_WG = 10 * MiB, WO_WAB = 16 * MiB, WO_WC = 18 * MiB, WO_WO = 20 * MiB;
constexpr size_t WS_H = 48 * MiB;
constexpr size_t WS_B0 = 80 * MiB;
constexpr size_t WS_B1 = 112 * MiB;
constexpr size_t WS_B2 = 144 * MiB;
constexpr size_t WS_B3 = 176 * MiB;
constexpr size_t WS_B4 = 208 * MiB;
constexpr size_t WS_GT = WS_B2, WS_MG = WS_B3;
constexpr size_t WS_FP = 240 * MiB;
constexpr size_t WS_SSP = 242 * MiB;
constexpr size_t WS_DUMMY = 224 * MiB;
constexpr size_t WS_END = 256 * MiB;
#ifndef PROBE_P3
#define PROBE_P3 0
#endif
#ifndef PROBE_CONV
#define PROBE_CONV 0
#endif
#ifndef PROBE_SUB
#define PROBE_SUB 7
#endif
#ifndef PROBE_DUP
#define PROBE_DUP -1
#endif

typedef unsigned short bf16_t;
typedef short bf16x8 __attribute__((ext_vector_type(8)));
typedef float f32x4 __attribute__((ext_vector_type(4)));
typedef unsigned u32x4 __attribute__((ext_vector_type(4)));

__host__ __device__ __forceinline__ float bf2f(bf16_t v) { union { unsigned u; float f; } c; c.u = (unsigned)v << 16; return c.f; }
__host__ __device__ __forceinline__ bf16_t f2bf(float f) { union { unsigned u; float f; } c; c.f = f; unsigned u = c.u; return (bf16_t)((u + 0x7fffu + ((u >> 16) & 1u)) >> 16); }
__device__ __forceinline__ float bfr(float f) { return bf2f(f2bf(f)); }
__device__ __forceinline__ float sigm(float x) { return 1.f / (1.f + __expf(-x)); }
__device__ __forceinline__ float siluf(float x) { return x * sigm(x); }

__host__ __device__ __forceinline__ int g1_col(int n) {
    const int j = n >> 8, lc = n & 255;
    if (j < 4) return lc < 128 ? OC_AIN + 128 * j + lc : OC_AIN + 512 + 128 * j + (lc - 128);
    if (j < 6) return OC_AZ + 256 * (j - 4) + lc;
    if (j < 8 || (j >= 10 && j < 12)) { const int k = j < 8 ? j - 6 : j - 8; return lc < 128 ? OC_U + 128 * k + lc : OC_BZ + 128 * k + (lc - 128); }
    if (j < 10) return OC_V + 256 * (j - 8) + lc;
    if (j < 16) { const int isk = j >= 14, jj = (j - 12) & 1, head = 4 * jj + ((lc >> 5) & 3), d = 32 * (lc >> 7) + (lc & 31); return (isk ? OC_K : OC_Q) + 64 * head + d; }
    if (j < 18) return OC_VA + 256 * (j - 16) + lc;
    return OC_CZ + 256 * (j - 18) + lc;
}

struct Ptrs {
    const float *x, *norm_g, *w_in, *b_gate, *conv_w, *conv_b, *cn_g, *cn_b, *w_a, *gn_g, *w_s, *b_s, *w_b, *qn_g, *kn_g, *b_f, *w_c, *w_out;
    float* out; unsigned char* ws;
};

__global__ void nv_prep(Ptrs P) {
    const size_t gid = (size_t)blockIdx.x * blockDim.x + threadIdx.x, gsz = (size_t)gridDim.x * blockDim.x;
    for (int l = 0; l < NL; ++l) {
        unsigned char* wl = P.ws + WS_W + (size_t)l * W_LAYER;
        bf16_t* W1 = (bf16_t*)(wl + WO_W1); bf16_t* WG = (bf16_t*)(wl + WO_WG); bf16_t* WAB = (bf16_t*)(wl + WO_WAB); bf16_t* WC = (bf16_t*)(wl + WO_WC); bf16_t* WO = (bf16_t*)(wl + WO_WO);
        const float* win = P.w_in + (size_t)l * D * NIN;
        for (size_t i = gid; i < (size_t)N1 * D; i += gsz) { const int n = (int)(i >> 10), k = (int)(i & 1023); W1[i] = f2bf(win[(size_t)k * NIN + g1_col(n)]); }
        for (size_t i = gid; i < (size_t)3072 * D; i += gsz) { const int n = (int)(i >> 10), k = (int)(i & 1023); WG[i] = f2bf(win[(size_t)k * NIN + n]); }
        for (size_t i = gid; i < (size_t)1024 * 1024; i += gsz) { const int n = (int)(i >> 10), k = (int)(i & 1023);
            WAB[i] = f2bf(k < 512 ? P.w_a[((size_t)l * DA + k) * D + n] : P.w_b[((size_t)l * DB + (k - 512)) * D + n]);
            WC[i] = k < 512 ? f2bf(P.w_c[((size_t)l * DC + k) * D + n]) : (bf16_t)0;
            WO[i] = f2bf(P.w_out[((size_t)l * D + k) * D + n]); }
        bf16_t* WSB = (bf16_t*)(P.ws + WS_WSB) + (size_t)l * NG * CHK * CHK;
        for (size_t i = gid; i < (size_t)NG * CHK * CHK; i += gsz) { const int s = (int)(i & 127), t = (int)((i >> 7) & 127); WSB[i] = s <= t ? f2bf(P.w_s[(size_t)l * NG * CHK * CHK + i]) : (bf16_t)0; }
    }
}

__device__ __forceinline__ float wave_sum(float v) {
#pragma unroll
    for (int o = 1; o < 64; o <<= 1) v += __shfl_xor(v, o);
    return v;
}

__global__ void nv_ln(Ptrs P, int l, const float* xin) {
    const int lane = threadIdx.x & 63, row = blockIdx.x * 4 + (threadIdx.x >> 6);
    const float* xr = xin + (size_t)row * D; const float* g = P.norm_g + (size_t)l * D; const float* win = P.w_in + (size_t)l * D * NIN;
    float v[16]; float ss = 0.f;
#pragma unroll
    for (int j = 0; j < 16; ++j) { v[j] = xr[lane + 64 * j]; ss += v[j] * v[j]; }
    ss = wave_sum(ss);
    const float r = rsqrtf(ss * (1.f / D) + EPS);
    bf16_t* h = (bf16_t*)(P.ws + WS_H) + (size_t)row * D;
    float f[8] = {0, 0, 0, 0, 0, 0, 0, 0};
#pragma unroll
    for (int j = 0; j < 16; ++j) { const int k = lane + 64 * j; const float hv = v[j] * r * g[k]; h[k] = f2bf(hv);
#pragma unroll
        for (int e = 0; e < 8; ++e) f[e] += hv * win[(size_t)k * NIN + OC_F + e]; }
#pragma unroll
    for (int e = 0; e < 8; ++e) f[e] = wave_sum(f[e]);
    if (lane < 8) { float z = 0.f;
#pragma unroll
        for (int e = 0; e < 8; ++e) if (lane == e) z = f[e];
        z += P.b_f[l * NH + lane];
        const float lf = fminf(z, 0.f) - log1pf(expf(-fabsf(z)));
        ((float*)(P.ws + WS_LOGF))[(size_t)row * 8 + lane] = lf; }
}

__global__ void nv_scan(Ptrs P) {
    __shared__ float buf[SEQ];
    const int bh = blockIdx.x, b = bh / NH, h = bh % NH;
    const float* lf = (const float*)(P.ws + WS_LOGF);
    for (int t = threadIdx.x; t < SEQ; t += blockDim.x) buf[t] = lf[((size_t)b * SEQ + t) * 8 + h];
    __syncthreads();
    if (threadIdx.x == 0) { float c = 0.f; for (int t = 0; t < SEQ; ++t) { c += buf[t]; buf[t] = c * LOG2E; } }
    __syncthreads();
    float* cs = (float*)(P.ws + WS_CS) + (size_t)bh * SEQ;
    for (int t = threadIdx.x; t < SEQ; t += blockDim.x) cs[t] = buf[t];
}

constexpr int TLD = 257;
__device__ __forceinline__ void nv_gemm_acc(const bf16_t* A, int lda, const bf16_t* Bt, int ldb, int K, f32x4 (&acc)[4][4]) {
    const int tid = threadIdx.x, w = tid >> 6, l = tid & 63, fr = l & 15, fq = l >> 4;
#pragma unroll
    for (int m = 0; m < 4; ++m)
#pragma unroll
        for (int n = 0; n < 4; ++n) acc[m][n] = (f32x4){0.f, 0.f, 0.f, 0.f};
    for (int k0 = 0; k0 < K; k0 += 32) {
        bf16x8 a[4], b[4];
#pragma unroll
        for (int m = 0; m < 4; ++m) a[m] = *(const bf16x8*)(A + (size_t)(16 * m + fr) * lda + k0 + 8 * fq);
#pragma unroll
        for (int n = 0; n < 4; ++n) b[n] = *(const bf16x8*)(Bt + (size_t)(64 * w + 16 * n + fr) * ldb + k0 + 8 * fq);
#pragma unroll
        for (int m = 0; m < 4; ++m)
#pragma unroll
            for (int n = 0; n < 4; ++n) acc[m][n] = __builtin_amdgcn_mfma_f32_16x16x32_bf16(a[m], b[n], acc[m][n], 0, 0, 0);
    }
}
__device__ __forceinline__ void nv_gemm_tile(const bf16_t* A, int lda, const bf16_t* Bt, int ldb, int K, float* T) {
    const int tid = threadIdx.x, w = tid >> 6, l = tid & 63, fr = l & 15, fq = l >> 4;
    f32x4 acc[4][4];
    nv_gemm_acc(A, lda, Bt, ldb, K, acc);
#pragma unroll
    for (int m = 0; m < 4; ++m)
#pragma unroll
        for (int n = 0; n < 4; ++n)
#pragma unroll
            for (int r = 0; r < 4; ++r) T[(16 * m + 4 * fq + r) * TLD + 64 * w + 16 * n + fr] = acc[m][n][r];
}

__global__ void __launch_bounds__(256) nv_gemm1(Ptrs P, int l) {
    extern __shared__ float T[];
    __shared__ float R[64 * 4];
    const int j = blockIdx.x, row0 = blockIdx.y * 64, tid = threadIdx.x;
    const bf16_t* H = (const bf16_t*)(P.ws + WS_H);
    const bf16_t* W1 = (const bf16_t*)(P.ws + WS_W + (size_t)l * W_LAYER + WO_W1);
    nv_gemm_tile(H + (size_t)row0 * D, D, W1 + (size_t)j * 256 * D, D, D, T);
    __syncthreads();
    bf16_t* B0 = (bf16_t*)(P.ws + WS_B0); bf16_t* B1 = (bf16_t*)(P.ws + WS_B1); bf16_t* B2 = (bf16_t*)(P.ws + WS_B2); bf16_t* B3 = (bf16_t*)(P.ws + WS_B3); bf16_t* B4 = (bf16_t*)(P.ws + WS_B4);
    if (j < 4) {
        for (int e = tid; e < 64 * 128; e += 256) { const int r = e >> 7, c = e & 127; B3[(size_t)(row0 + r) * 1024 + 128 * j + c] = f2bf(T[r * TLD + c] * sigm(T[r * TLD + c + 128])); }
    } else if (j < 12 || j >= 16) {
        bf16_t* dst; int pitch, coff; bool act;
        if (j < 6) { dst = B0; pitch = 1024; coff = 256 * (j - 4); act = true; }
        else if (j < 8) { dst = B0; pitch = 1024; coff = 512 + 256 * (j - 6); act = false; }
        else if (j < 10) { dst = B3; pitch = 1024; coff = 512 + 256 * (j - 8); act = false; }
        else if (j < 12) { dst = B4; pitch = 512; coff = 256 * (j - 10); act = true; }
        else if (j < 18) { dst = B2; pitch = 1024; coff = 256 * (j - 16); act = false; }
        else { dst = B2; pitch = 1024; coff = 512 + 256 * (j - 18); act = true; }
        for (int e = tid; e < 64 * 256; e += 256) { const int r = e >> 8, c = e & 255; const float v = T[r * TLD + c]; dst[(size_t)(row0 + r) * pitch + coff + c] = f2bf(act ? siluf(v) : v); }
        if (j == 8 || j == 9) { const int r = tid >> 2, wc = tid & 3; float s = 0.f;
            for (int bj = 0; bj < 2; ++bj) for (int i = 0; i < 32; ++i) { const float v = T[r * TLD + 128 * bj + 32 * wc + i]; s += v * v; }
            ((float*)(P.ws + WS_VSS))[(size_t)(row0 + r) * 8 + (j - 8) * 4 + wc] = s; }
    } else {
        const bool isk = j >= 14; const int jj = (j - 12) & 1;
        { const int r = tid >> 2, hh = tid & 3; float s = 0.f;
          for (int d = 0; d < 64; ++d) { const float v = T[r * TLD + 128 * (d >> 5) + 32 * hh + (d & 31)]; s += v * v; }
          R[r * 4 + hh] = rsqrtf(s * (1.f / 64.f) + EPS); }
        __syncthreads();
        const float* gq = (isk ? P.kn_g : P.qn_g) + (size_t)l * HD;
        for (int e = tid; e < 64 * 256; e += 256) { const int r = e >> 8, c = e & 255, hh = (c >> 5) & 3, d = 32 * (c >> 7) + (c & 31);
            float v = T[r * TLD + c] * R[r * 4 + hh] * gq[d]; if (!isk) v *= C2;
            B1[(size_t)(row0 + r) * 1024 + (isk ? 512 : 0) + 64 * (4 * jj + hh) + d] = f2bf(v); }
    }
}

__global__ void __launch_bounds__(512) nv_conv(Ptrs P, int l) {
    __shared__ float red[16];
    const int row = blockIdx.x, t = row % SEQ, c = threadIdx.x, lane = c & 63, w = c >> 6;
    const bf16_t* AG = (const bf16_t*)(P.ws + WS_B3); bf16_t* B0 = (bf16_t*)(P.ws + WS_B0);
    const float* cw = P.conv_w + (size_t)l * CW * DA;
    float a = P.conv_b[l * DA + c];
    for (int j = 0; j < CW; ++j) { const int tt = t - (CW - 1) + j; if (tt >= 0) a += cw[j * DA + c] * bf2f(AG[(size_t)(row - (CW - 1) + j) * 1024 + c]); }
    float s = wave_sum(a); if (lane == 0) red[w] = s; __syncthreads();
    float mu = 0.f; for (int i = 0; i < 8; ++i) mu += red[i]; mu *= (1.f / DA);
    const float d = a - mu; s = wave_sum(d * d); if (lane == 0) red[8 + w] = s; __syncthreads();
    float var = 0.f; for (int i = 0; i < 8; ++i) var += red[8 + i]; var *= (1.f / DA);
    const float y = d * rsqrtf(var + EPS) * P.cn_g[l * DA + c] + P.cn_b[l * DA + c];
    const float az = bf2f(B0[(size_t)row * 1024 + c]);
    B0[(size_t)row * 1024 + c] = f2bf(siluf(y) * az);
}

__global__ void __launch_bounds__(256) nv_gmlp(Ptrs P, int l) {
    extern __shared__ float vn[];
    const int ch = blockIdx.x, g = blockIdx.y, tid = threadIdx.x; const size_t row0 = (size_t)ch * CHK;
    const bf16_t* V = (const bf16_t*)(P.ws + WS_B3); bf16_t* B0 = (bf16_t*)(P.ws + WS_B0); const bf16_t* BZ = (const bf16_t*)(P.ws + WS_B4);
    const float* vss = (const float*)(P.ws + WS_VSS);
    const bf16_t* WSB = (const bf16_t*)(P.ws + WS_WSB) + ((size_t)l * NG + g) * CHK * CHK;
    for (int e = tid; e < 128 * 128; e += 256) { const int s = e >> 7, c = e & 127; const float* q = vss + (row0 + s) * 8;
        const float ss = ((q[0] + q[1]) + (q[2] + q[3])) + ((q[4] + q[5]) + (q[6] + q[7])); const float rv = rsqrtf(ss * (1.f / DB) + EPS);
        vn[s * 129 + c] = bfr(bf2f(V[(row0 + s) * 1024 + 512 + 128 * g + c]) * rv * P.gn_g[l * DB + 128 * g + c]); }
    __syncthreads();
    for (int e = tid; e < 128 * 128; e += 256) { const int t = e >> 7, c = e & 127; float acc = 0.f;
        for (int s = 0; s <= t; ++s) acc += bf2f(WSB[t * 128 + s]) * vn[s * 129 + c];
        acc += P.b_s[((size_t)l * NG + g) * CHK + t];
        const size_t o = (row0 + t) * 1024 + 512 + 128 * g + c;
        B0[o] = f2bf(bf2f(B0[o]) * acc * bf2f(BZ[(row0 + t) * 512 + 128 * g + c])); }
}

__global__ void __launch_bounds__(256) nv_attn(Ptrs P) {
    extern __shared__ float sc[];
    const int lane = threadIdx.x & 63, w = threadIdx.x >> 6; const int item = blockIdx.x * 4 + w, row = item >> 3, h = item & 7, b = row / SEQ, t = row % SEQ;
    float* s = sc + w * SEQ;
    bf16_t* B1 = (bf16_t*)(P.ws + WS_B1); const bf16_t* B2 = (const bf16_t*)(P.ws + WS_B2);
    const float* cs = (const float*)(P.ws + WS_CS) + (size_t)(b * NH + h) * SEQ;
    float q[64];
#pragma unroll
    for (int d = 0; d < 64; ++d) q[d] = bf2f(B1[(size_t)row * 1024 + 64 * h + d]);
    const float cq = cs[t]; float mx = -INFINITY;
    for (int k = lane; k <= t; k += 64) { const bf16_t* kr = B1 + ((size_t)b * SEQ + k) * 1024 + 512 + 64 * h; float dot = 0.f;
#pragma unroll
        for (int d8 = 0; d8 < 8; ++d8) { const bf16x8 kv = *(const bf16x8*)(kr + 8 * d8);
#pragma unroll
            for (int e = 0; e < 8; ++e) dot += q[8 * d8 + e] * bf2f((bf16_t)kv[e]); }
        const float v = dot + (cq - cs[k]); s[k] = v; mx = fmaxf(mx, v); }
#pragma unroll
    for (int o = 1; o < 64; o <<= 1) mx = fmaxf(mx, __shfl_xor(mx, o));
    float lsum = 0.f;
    for (int k = lane; k <= t; k += 64) { const float p = exp2f(s[k] - mx); lsum += p; s[k] = bfr(p); }
    lsum = wave_sum(lsum);
    __builtin_amdgcn_s_waitcnt(0); __builtin_amdgcn_wave_barrier();
    float o = 0.f; const bf16_t* vb = B2 + (size_t)b * SEQ * 1024 + 64 * h + lane;
    for (int k = 0; k <= t; ++k) o += s[k] * bf2f(vb[(size_t)k * 1024]);
    const float cz = bf2f(B2[(size_t)row * 1024 + 512 + 64 * h + lane]);
    B1[(size_t)row * 1024 + 64 * h + lane] = f2bf(o / lsum * cz);
}

__global__ void __launch_bounds__(256) nv_merge(Ptrs P, int l) {
    extern __shared__ float T[];
    const int pn = blockIdx.x, row0 = blockIdx.y * 64, tid = threadIdx.x, w = tid >> 6, ln = tid & 63, fr = ln & 15, fq = ln >> 4;
    const unsigned char* wl = P.ws + WS_W + (size_t)l * W_LAYER;
    const bf16_t* H = (const bf16_t*)(P.ws + WS_H); const bf16_t* WG = (const bf16_t*)(wl + WO_WG); const bf16_t* WAB = (const bf16_t*)(wl + WO_WAB); const bf16_t* WC = (const bf16_t*)(wl + WO_WC);
    const bf16_t* B0 = (const bf16_t*)(P.ws + WS_B0); const bf16_t* B1 = (const bf16_t*)(P.ws + WS_B1);
    float* G = T; float* MGs = T + 64 * 256;
    f32x4 acc[4][4];
    for (int br = 0; br < 3; ++br) {
        nv_gemm_acc(H + (size_t)row0 * D, D, WG + ((size_t)br * 1024 + 256 * pn) * D, D, D, acc);
#pragma unroll
        for (int m = 0; m < 4; ++m)
#pragma unroll
            for (int n = 0; n < 4; ++n)
#pragma unroll
                for (int r = 0; r < 4; ++r) { const int c = 64 * w + 16 * n + fr; G[((m * 4 + n) * 4 + r) * 256 + tid] = bfr(sigm(acc[m][n][r] + P.b_gate[(size_t)l * 3072 + br * 1024 + 256 * pn + c])); }
        const bf16_t* A = br == 0 ? B0 : (br == 1 ? B0 + 512 : B1); const bf16_t* Bt = br == 0 ? WAB : (br == 1 ? WAB + 512 : WC);
        nv_gemm_acc(A + (size_t)row0 * 1024, 1024, Bt + (size_t)256 * pn * 1024, 1024, 512, acc);
#pragma unroll
        for (int m = 0; m < 4; ++m)
#pragma unroll
            for (int n = 0; n < 4; ++n)
#pragma unroll
                for (int r = 0; r < 4; ++r) { const int s = ((m * 4 + n) * 4 + r) * 256 + tid; const float v = G[s] * acc[m][n][r]; MGs[s] = bfr(br == 0 ? v : MGs[s] + v); }
    }
    bf16_t* MG = (bf16_t*)(P.ws + WS_MG);
#pragma unroll
    for (int m = 0; m < 4; ++m)
#pragma unroll
        for (int n = 0; n < 4; ++n)
#pragma unroll
            for (int r = 0; r < 4; ++r) MG[(size_t)(row0 + 16 * m + 4 * fq + r) * 1024 + 256 * pn + 64 * w + 16 * n + fr] = f2bf(MGs[((m * 4 + n) * 4 + r) * 256 + tid]);
}

__global__ void __launch_bounds__(256) nv_out(Ptrs P, int l, const float* xin, float* xout) {
    const int pn = blockIdx.x, row0 = blockIdx.y * 64, tid = threadIdx.x, w = tid >> 6, ln = tid & 63, fr = ln & 15, fq = ln >> 4;
    const bf16_t* MG = (const bf16_t*)(P.ws + WS_MG); const bf16_t* WO = (const bf16_t*)(P.ws + WS_W + (size_t)l * W_LAYER + WO_WO);
    f32x4 acc[4][4];
    nv_gemm_acc(MG + (size_t)row0 * 1024, 1024, WO + (size_t)256 * pn * 1024, 1024, 1024, acc);
#pragma unroll
    for (int m = 0; m < 4; ++m)
#pragma unroll
        for (int n = 0; n < 4; ++n)
#pragma unroll
            for (int r = 0; r < 4; ++r) { const size_t o = (size_t)(row0 + 16 * m + 4 * fq + r) * D + 256 * pn + 64 * w + 16 * n + fr; xout[o] = xin[o] + acc[m][n][r]; }
}


#define LAS __attribute__((address_space(3)))
#define GAS __attribute__((address_space(1)))
__device__ __forceinline__ float wsum(float v) {
    v += __builtin_bit_cast(float, __builtin_amdgcn_update_dpp(0, __builtin_bit_cast(int, v), 0xB1, 0xF, 0xF, true));
    v += __builtin_bit_cast(float, __builtin_amdgcn_update_dpp(0, __builtin_bit_cast(int, v), 0x4E, 0xF, 0xF, true));
    v += __builtin_bit_cast(float, __builtin_amdgcn_update_dpp(0, __builtin_bit_cast(int, v), 0x141, 0xF, 0xF, true));
    v += __builtin_bit_cast(float, __builtin_amdgcn_update_dpp(0, __builtin_bit_cast(int, v), 0x140, 0xF, 0xF, true));
    const int iv = __builtin_bit_cast(int, v);
    return (__builtin_bit_cast(float, __builtin_amdgcn_readlane(iv, 0)) + __builtin_bit_cast(float, __builtin_amdgcn_readlane(iv, 16))) + (__builtin_bit_cast(float, __builtin_amdgcn_readlane(iv, 32)) + __builtin_bit_cast(float, __builtin_amdgcn_readlane(iv, 48)));
}
typedef GAS unsigned gu32;
#define RLX_AGENT __ATOMIC_RELAXED, __HIP_MEMORY_SCOPE_AGENT
#define LDS_WAIT() asm volatile("s_waitcnt lgkmcnt(0)" ::: "memory")
#define VM_WAIT() asm volatile("s_waitcnt vmcnt(0)" ::: "memory")
constexpr int NWAVES = 8;
constexpr int RING_OFF = 0, RING_BYTES = 131072;
constexpr int LDS_BYTES = 163840;
constexpr int LDSCTL_OFF = LDS_BYTES - 512, MISC_OFF = LDSCTL_OFF + 320;
constexpr int RT_OFF = LDSCTL_OFF - 1024;
constexpr int CW_TMO = 0, CW_CODE = 1, CW_BAR = 4096;
constexpr float SKIP_L2 = 160.f;
constexpr int NPH = 10;

__device__ __forceinline__ unsigned cvt_pk_bf16(float lo, float hi) { unsigned r; asm volatile("v_cvt_pk_bf16_f32 %0, %1, %2" : "=v"(r) : "v"(lo), "v"(hi)); return r; }
__device__ __forceinline__ float fsigm(float x) { return __builtin_amdgcn_rcpf(1.f + __builtin_amdgcn_exp2f(-LOG2E * x)); }
__device__ __forceinline__ u32x4 pack8(const f32x4& a, const f32x4& b) { u32x4 w; w.x = cvt_pk_bf16(a[0], a[1]); w.y = cvt_pk_bf16(a[2], a[3]); w.z = cvt_pk_bf16(b[0], b[1]); w.w = cvt_pk_bf16(b[2], b[3]); return w; }
__device__ __forceinline__ void unpack8(const u32x4& w, f32x4& a, f32x4& b) {
    a[0] = __uint_as_float(w.x << 16); a[1] = __uint_as_float(w.x & 0xffff0000u); a[2] = __uint_as_float(w.y << 16); a[3] = __uint_as_float(w.y & 0xffff0000u);
    b[0] = __uint_as_float(w.z << 16); b[1] = __uint_as_float(w.z & 0xffff0000u); b[2] = __uint_as_float(w.w << 16); b[3] = __uint_as_float(w.w & 0xffff0000u); }

namespace pg8 {
constexpr int BM = 256, BK = 64, HALF = 128, HTB = HALF * BK * 2, STAGE_BYTES = 8 * HTB, NXCD = 8, WGM = 8, PITCH = 1024;
__host__ __device__ __forceinline__ int lds_byte(int r, int c) { const int st = (r >> 4) * 2 + (c >> 5), rr = r & 15, cc = c & 31, ob = rr * 64 + cc * 2; return st * 1024 + (ob ^ (((ob >> 9) & 1) << 5)); }
__host__ __device__ __forceinline__ void stage_rc(int b, int& R, int& C) { const int st = b / 1024, sb = b % 1024, swz = sb ^ (((sb >> 9) & 1) << 5); R = (st >> 1) * 16 + swz / 64; C = (st & 1) * 32 + (swz % 64) / 2; }
__host__ __device__ __forceinline__ int perm32(int rho) { const int n = rho >> 4, i = rho & 15; return 8 * (i >> 2) + 4 * n + (i & 3); }

struct Unit { const char* A; const char* B; int nt, pm, pn, tag; };

struct TileOrder {
    int nM, nN, nwg, G, c;
    __device__ __forceinline__ void init(int Mr, int N, int G_, int c_) { nM = Mr / BM; nN = N / BM; nwg = nM * nN; G = G_; c = c_; }
    __device__ __forceinline__ bool tile(int i, int& pm, int& pn) const {
        const long L = (long)i * G + c; if (L >= nwg) return false;
        int wgid = (int)L; { const int q = nwg / NXCD, r = nwg % NXCD, xcd = wgid % NXCD, off = wgid / NXCD; wgid = (xcd < r ? xcd * (q + 1) : r * (q + 1) + (xcd - r) * q) + off; }
        const int nig = WGM * nN, gid = wgid / nig, fm = gid * WGM, gsz = (nM - fm) < WGM ? (nM - fm) : WGM;
        pm = fm + ((wgid % nig) % gsz); pn = (wgid % nig) / gsz; return true;
    }
};

template <class Epi, class Sched>
__device__ __forceinline__ void gemm_phase(LAS unsigned char* lds, const Sched& S, const Epi& E) {
    int tid = threadIdx.x; asm volatile("" : "+v"(tid));
    const int wid = __builtin_amdgcn_readfirstlane(tid >> 6), lane = tid & 63, wr = wid >> 2, wc = wid & 3, fr = lane & 15, fq = lane >> 4;
    unsigned voffA[2], voffB[2];
#pragma unroll
    for (int i = 0; i < 2; ++i) { int R, C; stage_rc(tid * 16 + i * 8192, R, C); const int Rb = (R & ~31) + perm32(R & 31);
        voffA[i] = (unsigned)(R * PITCH + C) * 2u; voffB[i] = (unsigned)(Rb * PITCH + C) * 2u; }
    const size_t kstep = (size_t)(BK * 2);
    const size_t hstep = (size_t)HALF * PITCH * 2;
    const unsigned ldsw = (unsigned)wid * 1024u;
    const int aoff = lds_byte(wr * 64 + fr, fq * 8), boff = lds_byte(wc * 32 + fr, fq * 8);
#define PG8_SA(b, h) (((b) * 2 + (h)) * HTB)
#define PG8_SB(b, h) ((4 + (b) * 2 + (h)) * HTB)
#define PG8_STAGE(bufoff, gbase, voff) do { _Pragma("unroll") for (int _i = 0; _i < 2; ++_i) \
        __builtin_amdgcn_global_load_lds((const unsigned*)((const char*)(gbase) + (voff)[_i]), (LAS unsigned*)(lds + (bufoff) + ldsw + _i * 8192), 16, 0, 0); } while (0)
#define PG8_LDA(dst, b, h) do { _Pragma("unroll") for (int m = 0; m < 4; ++m) _Pragma("unroll") for (int k = 0; k < 2; ++k) dst[m][k] = *(const LAS bf16x8*)(lds + PG8_SA(b, h) + aoff + m * 2048 + k * 1024); } while (0)
#define PG8_LDB(dst, b, h) do { _Pragma("unroll") for (int n = 0; n < 2; ++n) _Pragma("unroll") for (int k = 0; k < 2; ++k) dst[n][k] = *(const LAS bf16x8*)(lds + PG8_SB(b, h) + boff + n * 2048 + k * 1024); } while (0)
#define PG8_MMA(ai, bj, At, Bt) do { __builtin_amdgcn_s_setprio(1); _Pragma("unroll") for (int m = 0; m < 4; ++m) _Pragma("unroll") for (int n = 0; n < 2; ++n) _Pragma("unroll") for (int k = 0; k < 2; ++k) \
        acc[ai][bj][m][n] = __builtin_amdgcn_mfma_f32_16x16x32_bf16(Bt[n][k], At[m][k], acc[ai][bj][m][n], 0, 0, 0); __builtin_amdgcn_s_setprio(0); } while (0)
#define PG8_WAIT_V(n) asm volatile("s_waitcnt vmcnt(" #n ")" ::: "memory")
#define PG8_WAIT_L(n) asm volatile("s_waitcnt lgkmcnt(" #n ")" ::: "memory")
#define PG8_BAR __builtin_amdgcn_s_barrier()
#define PG8_SCHED __builtin_amdgcn_sched_barrier(0)
    Unit cur, nxt; int ui = 0;
    if (!S.next(0, cur)) return;
    f32x4 acc[2][2][4][2];
#pragma unroll
    for (int a = 0; a < 2; ++a)
#pragma unroll
        for (int b = 0; b < 2; ++b)
#pragma unroll
            for (int m = 0; m < 4; ++m)
#pragma unroll
                for (int n = 0; n < 2; ++n) acc[a][b][m][n] = (f32x4){0.f, 0.f, 0.f, 0.f};
    bf16x8 At[4][2], B0[2][2], B1[2][2];
    const char* cA = cur.A; const char* cB = cur.B;
    PG8_STAGE(PG8_SB(0, 0), cB, voffB); PG8_STAGE(PG8_SB(0, 1), cB + hstep, voffB); PG8_STAGE(PG8_SA(0, 0), cA, voffA); PG8_STAGE(PG8_SA(0, 1), cA + hstep, voffA);
    if (wr == 1) PG8_BAR;
    PG8_WAIT_V(2); PG8_BAR;
    PG8_STAGE(PG8_SB(1, 0), cB + kstep, voffB); PG8_STAGE(PG8_SA(1, 0), cA + kstep, voffA); PG8_STAGE(PG8_SB(1, 1), cB + hstep + kstep, voffB);
    PG8_WAIT_V(6); PG8_BAR;
    for (;;) {
        const bool has_next = S.next(ui + 1, nxt);
        const char* nA = has_next ? nxt.A : cA; const char* nB = has_next ? nxt.B : cB;
        const int nt = cur.nt;
        for (int t = 0; t < nt; t += 2) {
            const bool last = (t == nt - 2);
            const char* a1 = cA + (size_t)(t + 1) * kstep;
            const char* a2 = last ? nA : cA + (size_t)(t + 2) * kstep; const char* b2 = last ? nB : cB + (size_t)(t + 2) * kstep;
            const char* a3 = a2 + kstep; const char* b3 = b2 + kstep;
            PG8_LDB(B0, 0, 0); PG8_LDB(B1, 0, 1); PG8_SCHED; PG8_LDA(At, 0, 0); PG8_STAGE(PG8_SA(1, 1), a1 + hstep, voffA);
            PG8_WAIT_V(8); PG8_WAIT_L(0); PG8_BAR; PG8_MMA(0, 0, At, B0); PG8_MMA(0, 1, At, B1); PG8_BAR; PG8_SCHED;
            PG8_LDA(At, 0, 1); PG8_STAGE(PG8_SB(0, 0), b2, voffB); PG8_STAGE(PG8_SB(0, 1), b2 + hstep, voffB); PG8_STAGE(PG8_SA(0, 0), a2, voffA);
            PG8_WAIT_V(8); PG8_WAIT_L(0); PG8_BAR; PG8_MMA(1, 0, At, B0); PG8_MMA(1, 1, At, B1); PG8_BAR; PG8_SCHED;
            PG8_LDB(B0, 1, 0); PG8_LDB(B1, 1, 1); PG8_SCHED; PG8_LDA(At, 1, 0); PG8_STAGE(PG8_SA(0, 1), a2 + hstep, voffA);
            PG8_WAIT_V(8); PG8_WAIT_L(0); PG8_BAR; PG8_MMA(0, 0, At, B0); PG8_MMA(0, 1, At, B1); PG8_BAR; PG8_SCHED;
            PG8_LDA(At, 1, 1); PG8_STAGE(PG8_SB(1, 0), b3, voffB); PG8_STAGE(PG8_SB(1, 1), b3 + hstep, voffB); PG8_STAGE(PG8_SA(1, 0), a3, voffA);
            PG8_WAIT_V(8); PG8_WAIT_L(0); PG8_BAR; PG8_MMA(1, 0, At, B0); PG8_MMA(1, 1, At, B1); PG8_BAR; PG8_SCHED;
        }
        if (wr == 0) PG8_BAR;
        E(acc, cur, wr, wc, fr, fq);
        if (!has_next) break;
#pragma unroll
        for (int a = 0; a < 2; ++a)
#pragma unroll
            for (int b = 0; b < 2; ++b)
#pragma unroll
                for (int m = 0; m < 4; ++m)
#pragma unroll
                    for (int n = 0; n < 2; ++n) acc[a][b][m][n] = (f32x4){0.f, 0.f, 0.f, 0.f};
        cur = nxt; cA = nA; cB = nB; ++ui;
        if (wr == 1) PG8_BAR;
    }
    PG8_WAIT_V(0);
    PG8_BAR;
    E.after(acc, cur, lds, wr, wc, fr, fq);
#undef PG8_SA
#undef PG8_SB
#undef PG8_STAGE
#undef PG8_LDA
#undef PG8_LDB
#undef PG8_MMA
#undef PG8_WAIT_V
#undef PG8_WAIT_L
#undef PG8_BAR
#undef PG8_SCHED
}

struct EpiG1 {
    bf16_t *B0, *B1, *B2, *B3, *B4; float* vss; const float *gq, *gk; const LAS float* R;
    __device__ __forceinline__ void after(f32x4 (&)[2][2][4][2], const Unit&, LAS unsigned char*, int, int, int, int) const {}
    __device__ __forceinline__ void operator()(f32x4 (&acc)[2][2][4][2], const Unit& u, int wr, int wc, int fr, int fq) const {
        const int j = u.pn; const size_t rowb = (size_t)u.pm * BM + wr * 64 + fr; const int cl = 32 * wc + 8 * fq;
#pragma unroll
        for (int ai = 0; ai < 2; ++ai)
#pragma unroll
            for (int m = 0; m < 4; ++m) { const float rs = R[ai * HALF + wr * 64 + m * 16 + fr];
#pragma unroll
                for (int bj = 0; bj < 2; ++bj) { acc[ai][bj][m][0] *= rs; acc[ai][bj][m][1] *= rs; } }
        const bool ubz = (j == 6 || j == 7 || j == 10 || j == 11);
        if (j < 4 || ubz) {
            bf16_t* dst = ubz ? B0 + 512 + 128 * (j < 8 ? j - 6 : j - 8) : B3 + 128 * j;
#pragma unroll
            for (int ai = 0; ai < 2; ++ai)
#pragma unroll
                for (int m = 0; m < 4; ++m) { f32x4 o0, o1;
#pragma unroll
                    for (int e = 0; e < 4; ++e) { const float g0 = acc[ai][1][m][0][e], g1 = acc[ai][1][m][1][e]; const float s0 = fsigm(g0), s1 = fsigm(g1);
                        o0[e] = acc[ai][0][m][0][e] * (ubz ? g0 * s0 : s0); o1[e] = acc[ai][0][m][1][e] * (ubz ? g1 * s1 : s1); }
                    *(u32x4*)(dst + (rowb + ai * HALF + m * 16) * 1024 + cl) = pack8(o0, o1); }
        } else if (j < 12 || j >= 16) {
            bf16_t* dst; int pitch, coff; bool act;
            if (j < 6) { dst = B0; pitch = 1024; coff = 256 * (j - 4); act = true; }
            else if (j < 8) { dst = B0; pitch = 1024; coff = 512 + 256 * (j - 6); act = false; }
            else if (j < 10) { dst = B3; pitch = 1024; coff = 512 + 256 * (j - 8); act = false; }
            else if (j < 12) { dst = B4; pitch = 512; coff = 256 * (j - 10); act = true; }
            else if (j < 18) { dst = B2; pitch = 1024; coff = 256 * (j - 16); act = false; }
            else { dst = B2; pitch = 1024; coff = 512 + 256 * (j - 18); act = true; }
            const bool stat = (j == 8 || j == 9);
#pragma unroll
            for (int ai = 0; ai < 2; ++ai)
#pragma unroll
                for (int m = 0; m < 4; ++m) { const size_t row = rowb + ai * HALF + m * 16; float s = 0.f;
#pragma unroll
                    for (int bj = 0; bj < 2; ++bj) { f32x4 v0 = acc[ai][bj][m][0], v1 = acc[ai][bj][m][1];
                        if (act) {
#pragma unroll
                            for (int e = 0; e < 4; ++e) { v0[e] = v0[e] * fsigm(v0[e]); v1[e] = v1[e] * fsigm(v1[e]); } }
                        s += (v0[0] * v0[0] + v0[1] * v0[1]) + (v0[2] * v0[2] + v0[3] * v0[3]) + (v1[0] * v1[0] + v1[1] * v1[1]) + (v1[2] * v1[2] + v1[3] * v1[3]);
                        *(u32x4*)(dst + row * pitch + coff + 128 * bj + cl) = pack8(v0, v1); }
                    if (stat) { s += __shfl_xor(s, 16); s += __shfl_xor(s, 32); if (fq == 0) vss[row * 8 + (j - 8) * 4 + wc] = s; } }
        } else {
            const bool isk = j >= 14; const int jj = (j - 12) & 1; const float* g = isk ? gk : gq; const float sc = isk ? 1.f : C2;
            f32x4 gv[2][2];
#pragma unroll
            for (int bj = 0; bj < 2; ++bj) { gv[bj][0] = *(const f32x4*)(g + 32 * bj + 8 * fq) * sc; gv[bj][1] = *(const f32x4*)(g + 32 * bj + 8 * fq + 4) * sc; }
            bf16_t* dst = B1 + (isk ? 512 : 0) + 64 * (4 * jj + wc) + 8 * fq;
#pragma unroll
            for (int ai = 0; ai < 2; ++ai)
#pragma unroll
                for (int m = 0; m < 4; ++m) { const size_t row = rowb + ai * HALF + m * 16; float s = 0.f;
#pragma unroll
                    for (int bj = 0; bj < 2; ++bj) { const f32x4 v0 = acc[ai][bj][m][0], v1 = acc[ai][bj][m][1];
                        s += (v0[0] * v0[0] + v0[1] * v0[1]) + (v0[2] * v0[2] + v0[3] * v0[3]) + (v1[0] * v1[0] + v1[1] * v1[1]) + (v1[2] * v1[2] + v1[3] * v1[3]); }
                    s += __shfl_xor(s, 16); s += __shfl_xor(s, 32);
                    const float r = __builtin_amdgcn_rsqf(s * (1.f / 64.f) + EPS);
#pragma unroll
                    for (int bj = 0; bj < 2; ++bj) *(u32x4*)(dst + row * 1024 + 32 * bj) = pack8(acc[ai][bj][m][0] * r * gv[bj][0], acc[ai][bj][m][1] * r * gv[bj][1]); }
        }
    }
};
struct EpiMerge {
    unsigned char* gt; bf16_t* MG; const float* bgate; const LAS float* R; int cls; size_t gt2off; bool pv_;
    __device__ __forceinline__ void after(f32x4 (&)[2][2][4][2], const Unit&, LAS unsigned char*, int, int, int, int) const {}
    __device__ __forceinline__ void operator()(f32x4 (&acc)[2][2][4][2], const Unit& u, int wr, int wc, int fr, int fq) const {
        const int tag = u.tag, br = tag >> 1; const size_t rowb = (size_t)u.pm * BM + wr * 64 + fr; const int col0 = u.pn * BM + 32 * wc + 8 * fq;
        if (PROBE_P3 == 2 && pv_) return;
        if (PROBE_P3 == 1 && pv_ && (tag & 1)) return;
        u32x4* slots_ = (u32x4*)(gt + ((cls && br == 1) ? gt2off : (size_t)0)) + ((wr * 4 + wc) * 64 + fq * 16 + fr); asm volatile("" : "+v"(slots_)); __attribute__((address_space(1))) u32x4* slots = (__attribute__((address_space(1))) u32x4*)slots_;
        if ((tag & 1) == 0) {
            f32x4 bv[2][2];
#pragma unroll
            for (int bj = 0; bj < 2; ++bj) { bv[bj][0] = *(const f32x4*)(bgate + br * 1024 + col0 + 128 * bj); bv[bj][1] = *(const f32x4*)(bgate + br * 1024 + col0 + 128 * bj + 4); }
#pragma unroll
            for (int ai = 0; ai < 2; ++ai)
#pragma unroll
                for (int m = 0; m < 4; ++m)
#pragma unroll
                    for (int bj = 0; bj < 2; ++bj) { const float rs = R[ai * HALF + wr * 64 + m * 16 + fr]; f32x4 v0 = acc[ai][bj][m][0] * rs + bv[bj][0], v1 = acc[ai][bj][m][1] * rs + bv[bj][1];
#pragma unroll
                        for (int e = 0; e < 4; ++e) { v0[e] = fsigm(v0[e]); v1[e] = fsigm(v1[e]); }
                        slots[(size_t)(((ai * 4 + m) * 2 + bj) * 512)] = pack8(v0, v1); }
        } else {
#pragma unroll
            for (int ai = 0; ai < 2; ++ai)
#pragma unroll
                for (int m = 0; m < 4; ++m) {
#pragma unroll
                    for (int bj = 0; bj < 2; ++bj) { const u32x4 gw = slots[(size_t)(((ai * 4 + m) * 2 + bj) * 512)]; f32x4 g0, g1; unpack8(gw, g0, g1);
                        f32x4 v0 = g0 * acc[ai][bj][m][0], v1 = g1 * acc[ai][bj][m][1];
                        u32x4* p = (u32x4*)(MG + (rowb + ai * HALF + m * 16) * 1024 + col0 + 128 * bj);
                        if (br > 0) { const u32x4 ow = *p; f32x4 p0, p1; unpack8(ow, p0, p1); v0 += p0; v1 += p1; }
                        *p = pack8(v0, v1); }
                    if (m & 1) asm volatile("" ::: "memory"); }
        }
    }
};
struct EpiOutB {
    const bf16_t* base; float* out;
    __device__ __forceinline__ void after(f32x4 (&)[2][2][4][2], const Unit&, LAS unsigned char*, int, int, int, int) const {}
    __device__ __forceinline__ void operator()(f32x4 (&acc)[2][2][4][2], const Unit& u, int wr, int wc, int fr, int fq) const {
        const size_t rowb = (size_t)u.pm * BM + wr * 64 + fr; const int col0 = u.pn * BM + 32 * wc + 8 * fq;
#pragma unroll
        for (int ai = 0; ai < 2; ++ai)
#pragma unroll
            for (int m = 0; m < 4; ++m) {
#pragma unroll
                for (int bj = 0; bj < 2; ++bj) { const size_t o = (rowb + ai * HALF + m * 16) * D + col0 + 128 * bj;
                    f32x4 b0, b1; unpack8(*(const u32x4*)(base + o), b0, b1);
                    *(f32x4*)(out + o) = b0 + acc[ai][bj][m][0]; *(f32x4*)(out + o + 4) = b1 + acc[ai][bj][m][1]; }
                if (m & 1) asm volatile("" ::: "memory"); }
    }
};
struct EpiOut {
    const float* base; float* out;
    __device__ __forceinline__ void after(f32x4 (&)[2][2][4][2], const Unit&, LAS unsigned char*, int, int, int, int) const {}
    __device__ __forceinline__ void operator()(f32x4 (&acc)[2][2][4][2], const Unit& u, int wr, int wc, int fr, int fq) const {
        const size_t rowb = (size_t)u.pm * BM + wr * 64 + fr; const int col0 = u.pn * BM + 32 * wc + 8 * fq;
#pragma unroll
        for (int ai = 0; ai < 2; ++ai)
#pragma unroll
            for (int m = 0; m < 4; ++m) {
#pragma unroll
                for (int bj = 0; bj < 2; ++bj) { const size_t o = (rowb + ai * HALF + m * 16) * D + col0 + 128 * bj;
                    const f32x4 b0 = *(const f32x4*)(base + o), b1 = *(const f32x4*)(base + o + 4);
                    *(f32x4*)(out + o) = b0 + acc[ai][bj][m][0]; *(f32x4*)(out + o + 4) = b1 + acc[ai][bj][m][1]; }
                if (m & 1) asm volatile("" ::: "memory"); }
    }
};
struct EpiOutLN {
    const float* base; bf16_t* XG; const float* gnext; const float* wfnext; float* SSP; float* FP;
    __device__ __forceinline__ void operator()(f32x4 (&)[2][2][4][2], const Unit&, int, int, int, int) const {}
    __device__ __forceinline__ void after(f32x4 (&acc)[2][2][4][2], const Unit& u, LAS unsigned char* lds, int wr, int wc, int fr, int fq) const {
        const int tid = ((wr * 4 + wc) * 64) + fq * 16 + fr;
        const size_t rowb = (size_t)u.pm * BM + wr * 64 + fr; const int cl = 32 * wc + 8 * fq, col0 = u.pn * BM + cl;
        LAS float* FL = (LAS float*)lds;
        LAS float* WL = (LAS float*)(lds + 512 * 72 * 4);
        for (int i = tid; i < 256 * 8; i += 512) { const int c = i >> 3, e = i & 7; WL[i] = gnext[u.pn * BM + c] * wfnext[(size_t)(u.pn * BM + c) * NIN + e]; }
#pragma unroll
        for (int ai = 0; ai < 2; ++ai)
#pragma unroll
            for (int m = 0; m < 4; ++m) { float ss = 0.f;
#pragma unroll
                for (int bj = 0; bj < 2; ++bj) { const size_t o = (rowb + ai * HALF + m * 16) * D + col0 + 128 * bj;
                    const f32x4 x0 = *(const f32x4*)(base + o) + acc[ai][bj][m][0], x1 = *(const f32x4*)(base + o + 4) + acc[ai][bj][m][1];
                    ss += (x0[0] * x0[0] + x0[1] * x0[1]) + (x0[2] * x0[2] + x0[3] * x0[3]) + (x1[0] * x1[0] + x1[1] * x1[1]) + (x1[2] * x1[2] + x1[3] * x1[3]);
                    *(u32x4*)(XG + o) = pack8(x0, x1);
                    acc[ai][bj][m][0] = x0; acc[ai][bj][m][1] = x1; }
                FL[tid * 72 + 64 + ai * 4 + m] = ss;
                if (m & 1) asm volatile("" ::: "memory"); }
        asm volatile("s_waitcnt lgkmcnt(0)" ::: "memory"); __builtin_amdgcn_s_barrier(); asm volatile("" ::: "memory");
#pragma unroll
        for (int hh = 0; hh < 2; ++hh) {
            f32x4 f[8];
#pragma unroll
            for (int rg = 0; rg < 8; ++rg) f[rg] = (f32x4){0.f, 0.f, 0.f, 0.f};
#pragma unroll
            for (int bj = 0; bj < 2; ++bj)
#pragma unroll
                for (int n = 0; n < 2; ++n)
#pragma unroll
                    for (int i = 0; i < 4; ++i) { const f32x4 wv = *(const LAS f32x4*)(WL + (128 * bj + cl + 4 * n + i) * 8 + 4 * hh);
#pragma unroll
                        for (int ai = 0; ai < 2; ++ai)
#pragma unroll
                            for (int m = 0; m < 4; ++m) f[ai * 4 + m] += acc[ai][bj][m][n][i] * wv; }
#pragma unroll
            for (int rg = 0; rg < 8; ++rg) *(LAS f32x4*)(FL + tid * 72 + rg * 8 + 4 * hh) = f[rg];
            asm volatile("" ::: "memory");
        }
        asm volatile("s_waitcnt lgkmcnt(0)" ::: "memory"); __builtin_amdgcn_s_barrier(); asm volatile("" ::: "memory");
        { const int row = tid & 255, hb = (tid >> 8) * 4, ai_ = row >> 7, wr_ = (row >> 6) & 1, m_ = (row >> 4) & 3, fr_ = row & 15, rg = ai_ * 4 + m_;
          f32x4 sum = (f32x4){0.f, 0.f, 0.f, 0.f}; float ssum = 0.f;
#pragma unroll
          for (int wc_ = 0; wc_ < 4; ++wc_)
#pragma unroll
              for (int fq_ = 0; fq_ < 4; ++fq_) { const LAS float* src = FL + (((wr_ * 4 + wc_) * 64) + fq_ * 16 + fr_) * 72; sum += *(const LAS f32x4*)(src + rg * 8 + hb); ssum += src[64 + rg]; }
          const size_t grow = (size_t)u.pm * BM + row;
          *(f32x4*)(FP + (grow * 4 + u.pn) * 8 + hb) = sum;
          if (hb == 0) SSP[grow * 4 + u.pn] = ssum; }
    }
};
struct SchedG1 { TileOrder T; const char* A; const char* B;
    __device__ __forceinline__ bool next(int i, Unit& u) const { int pm, pn; if (!T.tile(i, pm, pn)) return false; u.pm = pm; u.pn = pn; u.tag = 0; u.nt = 16; u.A = A + (size_t)pm * (BM * PITCH * 2); u.B = B + (size_t)pn * (BM * PITCH * 2); return true; } };
struct SchedMerge { int pm, pn; bool ok; int cls; const char *ws, *wl;
    __device__ __forceinline__ bool next(int i, Unit& u) const { if (!ok || i >= 6) return false;
        const int tag = cls == 0 ? i : (i == 0 ? 0 : i == 1 ? 2 : i == 2 ? 1 : i == 3 ? 4 : i == 4 ? 3 : 5);
        const int br = tag >> 1; u.pm = pm; u.pn = pn; u.tag = tag;
        const size_t ro = (size_t)pm * (BM * PITCH * 2), co = (size_t)pn * (BM * PITCH * 2);
        if ((tag & 1) == 0) { u.nt = 16; u.A = ws + WS_H + ro; u.B = wl + WO_WG + (size_t)br * (1024 * PITCH * 2) + co; }
        else { u.nt = 8; const size_t ao = br == 0 ? WS_B0 : (br == 1 ? WS_B0 + 1024 : WS_B1), bo = br == 0 ? WO_WAB : (br == 1 ? WO_WAB + 1024 : WO_WC); u.A = ws + ao + ro; u.B = wl + bo + co; }
        return true; } };
}

#define XB_TMO      128
#define XB_XCNT(j)  (256  + 64 * (j))
#define XB_XSUB(j)  (1280 + 64 * (j))
#define XB_XGEN(j)  (2304 + 64 * (j))
#define XB_TOP      3328
#define XB_TOPGEN   3392
#define XCD_BAR_WORDS 3456
#define XB_SPIN_CAP (1u << 18)
__device__ __forceinline__ unsigned xb_ld(unsigned* p)              { return __hip_atomic_load(p, __ATOMIC_RELAXED, __HIP_MEMORY_SCOPE_AGENT); }
__device__ __forceinline__ unsigned xb_add(unsigned* p, unsigned v) { return __hip_atomic_fetch_add(p, v, __ATOMIC_RELAXED, __HIP_MEMORY_SCOPE_AGENT); }
__device__ __forceinline__ unsigned xb_xcc_id() { return (unsigned)__builtin_amdgcn_s_getreg((3 << 11) | 20) & 0xFu; }
#define XB_SPIN(cond, bar) do { unsigned _sp = 0; while (cond) { __builtin_amdgcn_s_sleep(1); \
    if ((++_sp & 255u) == 0u) { if (xb_ld(&(bar)[XB_TMO])) break; if (_sp > XB_SPIN_CAP) { atomicAdd(&(bar)[XB_TMO], 1u); break; } } } } while (0)
struct XcdBarrier { unsigned* bar; unsigned x; volatile LAS unsigned* st; };
__device__ __forceinline__ XcdBarrier xcd_barrier_post(unsigned* bar, volatile LAS unsigned* st) {
    XcdBarrier b; b.bar = bar; b.x = xb_xcc_id(); b.st = st;
    if (threadIdx.x == 0) (void)xb_add(&bar[XB_XCNT(b.x)], 1u);
    return b;
}
__device__ __forceinline__ void xcd_barrier_complete(unsigned* bar, unsigned x, unsigned& nloc, unsigned& nx) {
    const unsigned G = gridDim.x * gridDim.y * gridDim.z;
    unsigned sum, cnt, mine, sp = 0u;
    for (;;) {
        sum = 0u; cnt = 0u; mine = 0u;
#pragma unroll
        for (unsigned j = 0; j < 16; ++j) { const unsigned c = xb_ld(&bar[XB_XCNT(j)]); sum += c; cnt += (c > 0u) ? 1u : 0u; mine = (j == x) ? c : mine; }
        if (sum == G) break;
        __builtin_amdgcn_s_sleep(1);
        if ((++sp & 255u) == 0u) { if (xb_ld(&bar[XB_TMO])) break; if (sp > XB_SPIN_CAP) { atomicAdd(&bar[XB_TMO], 1u); break; } }
    }
    nloc = mine > 0u ? mine : 1u; nx = cnt > 0u ? cnt : 1u;
}
__device__ __forceinline__ void xcd_barrier(const XcdBarrier& b) {
    asm volatile("s_waitcnt vmcnt(0)" ::: "memory");
    __syncthreads();
    if (threadIdx.x == 0) {
        unsigned* bar = b.bar;
        __builtin_amdgcn_s_waitcnt(0);
        unsigned nloc = b.st[0], nx = b.st[1];
        if (nloc == 0u) { xcd_barrier_complete(bar, b.x, nloc, nx); b.st[0] = nloc; b.st[1] = nx; }
        const unsigned old = xb_add(&bar[XB_XSUB(b.x)], 1u);
        const unsigned gen = old / nloc;
        if (old + 1u == (gen + 1u) * nloc) {
            __builtin_amdgcn_fence(__ATOMIC_RELEASE, "agent");
            asm volatile("s_waitcnt vmcnt(0)" ::: "memory");
            const unsigned og = xb_add(&bar[XB_TOP], 1u);
            const unsigned tg = og / nx;
            if (og + 1u == (tg + 1u) * nx) xb_add(&bar[XB_TOPGEN], 1u);
            else XB_SPIN(xb_ld(&bar[XB_TOPGEN]) == tg, bar);
            __builtin_amdgcn_fence(__ATOMIC_ACQUIRE, "agent");
            xb_add(&bar[XB_XGEN(b.x)], 1u);
            asm volatile("s_waitcnt vmcnt(0)" ::: "memory");
        } else {
            XB_SPIN(xb_ld(&bar[XB_XGEN(b.x)]) == gen, bar);
            __builtin_amdgcn_fence(__ATOMIC_ACQUIRE, "agent");
            asm volatile("s_waitcnt vmcnt(0)" ::: "memory");
        }
    }
    __syncthreads();
}

struct Args { const float* in[18]; float* out; unsigned char* ws; int ph_lo, ph_hi, li, pad; };
struct Frame { LAS unsigned char* lds; int tid, lane, wave, vcu, G; Ptrs P; };

__device__ __forceinline__ unsigned pk2(float lo, float hi) { return (unsigned)f2bf(lo) | ((unsigned)f2bf(hi) << 16); }
__device__ __forceinline__ void p0_transpose_item(const float* W, int ldw, int src_col, int k0, bf16_t* WT, size_t dst_row, int dst_col, LAS float* scr, int lane, const float* kgain = nullptr) {
#pragma unroll 8
    for (int i = 0; i < 32; ++i) { const int kk = 2 * i + (lane >> 5); scr[kk * 33 + (lane & 31)] = W[(size_t)(k0 + kk) * ldw + src_col + (lane & 31)]; }
    LDS_WAIT(); asm volatile("" ::: "memory");
    const int c = lane & 7;
    f32x4 ga = (f32x4){1.f, 1.f, 1.f, 1.f}, gb = ga; if (kgain) { ga = *(const f32x4*)(kgain + k0 + 8 * c); gb = *(const f32x4*)(kgain + k0 + 8 * c + 4); }
#pragma unroll
    for (int j = 0; j < 4; ++j) { const int n = (lane >> 3) + 8 * j; const LAS float* s = scr + (8 * c) * 33 + n;
        u32x4 o; o.x = pk2(s[0 * 33] * ga.x, s[1 * 33] * ga.y); o.y = pk2(s[2 * 33] * ga.z, s[3 * 33] * ga.w); o.z = pk2(s[4 * 33] * gb.x, s[5 * 33] * gb.y); o.w = pk2(s[6 * 33] * gb.z, s[7 * 33] * gb.w);
        *(GAS u32x4*)(WT + (dst_row + n) * 1024 + dst_col + k0 + 8 * c) = o; }
    LDS_WAIT(); asm volatile("" ::: "memory");
}
__device__ __forceinline__ void p0_weights(Frame& F) {
    LAS float* scr = (LAS float*)(F.lds + RING_OFF + F.wave * 16384);
    const int gw = F.vcu * NWAVES + F.wave, NGW = F.G * NWAVES;
    constexpr int I_W1 = 16 * (N1 / 32), I_WG = 16 * 96, I_Y = 8 * 32, I_WO = 16 * 32, I_L = I_W1 + I_WG + 3 * I_Y + I_WO;
    for (int it = gw; it < NL * I_L; it += NGW) {
        const int l = it / I_L; int r = it % I_L;
        unsigned char* wl = F.P.ws + WS_W + (size_t)l * W_LAYER; const float* win = F.P.w_in + (size_t)l * D * NIN;
        const float* kg = l > 0 ? F.P.norm_g + (size_t)l * D : nullptr;
        if (r < I_W1) { const int kb = r / (N1 / 32), nb = r % (N1 / 32); p0_transpose_item(win, NIN, g1_col(32 * nb), 64 * kb, (bf16_t*)(wl + WO_W1), 32 * nb, 0, scr, F.lane, kg); continue; } r -= I_W1;
        if (r < I_WG) { const int kb = r / 96, nb = r % 96; p0_transpose_item(win, NIN, 32 * nb, 64 * kb, (bf16_t*)(wl + WO_WG), 32 * nb, 0, scr, F.lane, kg); continue; } r -= I_WG;
        if (r < I_Y) { const int kb = r / 32, nb = r % 32; p0_transpose_item(F.P.w_a + (size_t)l * DA * D, D, 32 * nb, 64 * kb, (bf16_t*)(wl + WO_WAB), 32 * nb, 0, scr, F.lane); continue; } r -= I_Y;
        if (r < I_Y) { const int kb = r / 32, nb = r % 32; p0_transpose_item(F.P.w_b + (size_t)l * DB * D, D, 32 * nb, 64 * kb, (bf16_t*)(wl + WO_WAB), 32 * nb, 512, scr, F.lane); continue; } r -= I_Y;
        if (r < I_Y) { const int kb = r / 32, nb = r % 32; p0_transpose_item(F.P.w_c + (size_t)l * DC * D, D, 32 * nb, 64 * kb, (bf16_t*)(wl + WO_WC), 32 * nb, 0, scr, F.lane); continue; } r -= I_Y;
        { const int kb = r / 32, nb = r % 32; p0_transpose_item(F.P.w_out + (size_t)l * D * D, D, 32 * nb, 64 * kb, (bf16_t*)(wl + WO_WO), 32 * nb, 0, scr, F.lane); }
    }
    bf16_t* WSB = (bf16_t*)(F.P.ws + WS_WSB);
    for (int i = (int)blockIdx.x * 512 + F.tid; i < NL * NG * CHK * CHK; i += F.G * 512) { const int s = i & 127, t = (i >> 7) & 127; WSB[i] = s <= t ? f2bf(F.P.w_s[i]) : (bf16_t)0; }
}
__device__ __forceinline__ void p0_ln(Frame& F, int l, const float* xin) {
    LAS float* wf = (LAS float*)(F.lds + RING_OFF);
    const float* g = F.P.norm_g + (size_t)l * D; const float* win = F.P.w_in + (size_t)l * D * NIN;
    __syncthreads();
    for (int i = F.tid; i < D * 8; i += 512) { const int k = i >> 3, e = i & 7; wf[i] = g[k] * win[(size_t)k * NIN + OC_F + e]; }
    __syncthreads();
    const int gw = F.vcu * NWAVES + F.wave, NGW = F.G * NWAVES;
    bf16_t* H = (bf16_t*)(F.P.ws + WS_H); float* LOGF = (float*)(F.P.ws + WS_LOGF);
    f32x4 gv[4];
#pragma unroll
    for (int j = 0; j < 4; ++j) gv[j] = ((const f32x4*)g)[64 * j + F.lane];
    static_assert(M == 8 * 256 * NWAVES, "p0_ln: 8 rows per wave on a 256-workgroup grid");
    float zrow[8];
#pragma unroll
    for (int k = 0; k < 8; ++k) zrow[k] = 0.f;
    f32x4 v[8][4];
#pragma unroll
    for (int bt = 0; bt < 4; ++bt) {
        asm volatile("" ::: "memory");
        if ((bt & 1) == 0) {
#pragma unroll
            for (int k = 2 * bt; k < 2 * bt + 4; ++k) { const GAS f32x4* xr = (const GAS f32x4*)(xin + (size_t)(gw + k * NGW) * D) + F.lane;
#pragma unroll
                for (int j = 0; j < 4; ++j) v[k][j] = xr[64 * j]; }
            asm volatile("" ::: "memory"); }
        float r[2]; float f[2][8];
#pragma unroll
        for (int q = 0; q < 2; ++q) { float ss = 0.f;
#pragma unroll
            for (int j = 0; j < 4; ++j) { const f32x4 x = v[2 * bt + q][j]; ss += (x.x * x.x + x.y * x.y) + (x.z * x.z + x.w * x.w); }
            r[q] = rsqrtf(wsum(ss) * (1.f / D) + EPS);
#pragma unroll
            for (int e = 0; e < 8; ++e) f[q][e] = 0.f; }
#pragma unroll
        for (int j = 0; j < 4; ++j) {
#pragma unroll
            for (int q = 0; q < 2; ++q) { const f32x4 hv = v[2 * bt + q][j] * r[q] * gv[j];
                GAS unsigned long long* o8 = (GAS unsigned long long*)(H + (size_t)(gw + (2 * bt + q) * NGW) * D) + F.lane;
                o8[64 * j] = (unsigned long long)pk2(hv.x, hv.y) | ((unsigned long long)pk2(hv.z, hv.w) << 32); }
#pragma unroll
            for (int i = 0; i < 4; ++i) { const LAS f32x4* w4 = (const LAS f32x4*)(wf + (256 * j + 4 * F.lane + i) * 8); const f32x4 wa = w4[0], wb = w4[1];
#pragma unroll
                for (int q = 0; q < 2; ++q) { const float xv = v[2 * bt + q][j][i];
                    f[q][0] += xv * wa.x; f[q][1] += xv * wa.y; f[q][2] += xv * wa.z; f[q][3] += xv * wa.w; f[q][4] += xv * wb.x; f[q][5] += xv * wb.y; f[q][6] += xv * wb.z; f[q][7] += xv * wb.w; } }
        }
#pragma unroll
        for (int q = 0; q < 2; ++q) {
#pragma unroll
            for (int e = 0; e < 8; ++e) f[q][e] = wsum(f[q][e]);
            if (F.lane < 8) { float z = 0.f;
#pragma unroll
                for (int e = 0; e < 8; ++e) if (F.lane == e) z = f[q][e];
                zrow[2 * bt + q] = z * r[q]; } }
    }
    if (F.lane < 8) { const float bfv = F.P.b_f[l * NH + F.lane];
#pragma unroll
        for (int k = 0; k < 8; ++k) { const float z = zrow[k] + bfv; LOGF[(size_t)(gw + k * NGW) * 8 + F.lane] = fminf(z, 0.f) - log1pf(expf(-fabsf(z))); } }
    __syncthreads();
}
__device__ __forceinline__ void p1_scan(Frame& F, int bh, int l) {
    LAS float* sh = (LAS float*)(F.lds + RING_OFF);
    const int b = bh / NH, h = bh % NH, t0 = F.tid * 8;
    float c[8]; float run = 0.f;
    if (l == 0) { const float* lf = (const float*)(F.P.ws + WS_LOGF) + ((size_t)b * SEQ + t0) * 8 + h;
#pragma unroll
        for (int i = 0; i < 8; ++i) { run += lf[i * 8]; c[i] = run; }
    } else {
        const float* fp = (const float*)(F.P.ws + WS_FP) + ((size_t)b * SEQ + t0) * 32 + h; const float* sp = (const float*)(F.P.ws + WS_SSP) + ((size_t)b * SEQ + t0) * 4; const float bfv = F.P.b_f[l * NH + h];
        float z[8];
#pragma unroll
        for (int i = 0; i < 8; ++i) { const f32x4 q = *(const f32x4*)(sp + i * 4); const float r = rsqrtf(((q.x + q.y) + (q.z + q.w)) * (1.f / D) + EPS);
            z[i] = r * ((fp[i * 32] + fp[i * 32 + 8]) + (fp[i * 32 + 16] + fp[i * 32 + 24])) + bfv; }
#pragma unroll
        for (int i = 0; i < 8; ++i) { run += fminf(z[i], 0.f) - log1pf(expf(-fabsf(z[i]))); c[i] = run; }
    }
    float inc = run;
#pragma unroll
    for (int o = 1; o < 64; o <<= 1) { const float n = __shfl_up(inc, o); if (F.lane >= o) inc += n; }
    if (F.lane == 63) sh[F.wave] = inc;
    __syncthreads();
    float base = inc - run;
    for (int w = 0; w < F.wave; ++w) base += sh[w];
    float* cs = (float*)(F.P.ws + WS_CS) + (size_t)bh * SEQ + t0;
    *(f32x4*)cs = (f32x4){(base + c[0]) * LOG2E, (base + c[1]) * LOG2E, (base + c[2]) * LOG2E, (base + c[3]) * LOG2E};
    *(f32x4*)(cs + 4) = (f32x4){(base + c[4]) * LOG2E, (base + c[5]) * LOG2E, (base + c[6]) * LOG2E, (base + c[7]) * LOG2E};
    __syncthreads();
    LAS float* c2s = sh + 16;
#pragma unroll
    for (int i = 0; i < 8; ++i) c2s[t0 + i] = (base + c[i]) * LOG2E;
    __syncthreads();
    if (F.tid < SEQ / 256) { const int qb = F.tid, nt = 4 * qb + 4; const float cq = c2s[256 * qb]; int lo = 0, hi = nt - 4;
        while (lo < hi) { const int mid = (lo + hi) >> 1; if (cq - c2s[64 * mid + 63] >= -SKIP_L2) hi = mid; else lo = mid + 1; }
        ((int*)(F.P.ws + WS_TS))[bh * 16 + qb] = lo & ~1; }
    __syncthreads();
}


#include <hip/hip_bf16.h>
namespace attn_body {
using bf16=__hip_bfloat16;
using s16x4=__attribute__((ext_vector_type(4)))short;
using f32x16=__attribute__((ext_vector_type(16)))float;
constexpr int NHEAD=NH,D=64,DM=1024;
constexpr int NW=8,QBLK=32,QB=QBLK*NW,KVBLK=64,NQB=SEQ/QB;
__device__ __forceinline__ int crow(int r,int hi){return (r&3)+8*(r>>2)+4*hi;}
#define SBAR() __builtin_amdgcn_sched_barrier(0)
__device__ __forceinline__ void cmask(f32x16&p0,f32x16&p1,int jb,int qrel,int hi){
  const float NEG=-INFINITY; int kb=64*jb+4*hi;
  #pragma unroll
  for(int r=0;r<16;++r){int kv=kb+(r&3)+8*(r>>2); if(kv>qrel)p0[r]=NEG; if(kv+32>qrel)p1[r]=NEG;}
}
constexpr int NSLOT=3, SLOTB=8192;
constexpr int LDS_K=0, LDS_V=NSLOT*SLOTB, LDS_WS=2*NSLOT*SLOTB, LDS_OST=LDS_WS+NW*64*4, LDS_C2=LDS_OST+NW*4096, LDS_BYTES=LDS_C2+SEQ*4+512;
__device__ __forceinline__ void glds16(const void*gsrc,unsigned lds_dst){unsigned keep;
  asm volatile("s_mov_b32 %0, m0\n\ts_mov_b32 m0, %2\n\ts_nop 0\n\tglobal_load_lds_dwordx4 %1, off\n\ts_mov_b32 m0, %0":"=&s"(keep):"v"(gsrc),"s"(lds_dst):"memory");}
__device__ __forceinline__ float max3f(float a,float b,float c){float r;asm("v_max3_f32 %0, %1, %2, %3":"=v"(r):"v"(a),"v"(b),"v"(c));return r;}
__device__ __forceinline__ float max2f(float a,float b){float r;asm("v_max_f32_e32 %0, %1, %2":"=v"(r):"v"(a),"v"(b));return r;}
__device__ __forceinline__ float fadd_s(float a,float b){float r;asm("v_add_f32_e32 %0, %1, %2":"=v"(r):"v"(a),"v"(b));return r;}
__device__ __forceinline__ float fsub_s(float a,float b){float r;asm("v_sub_f32_e32 %0, %1, %2":"=v"(r):"v"(a),"v"(b));return r;}
typedef float f32x2_t __attribute__((ext_vector_type(2))); typedef __bf16 bf16x2_t __attribute__((ext_vector_type(2)));
__device__ __forceinline__ unsigned cvtpk_s(float lo,float hi){f32x2_t v={lo,hi};bf16x2_t b=__builtin_convertvector(v,bf16x2_t);return __builtin_bit_cast(unsigned,b);}
#define WAIT_BAR(N) asm volatile("s_waitcnt vmcnt(" #N ") lgkmcnt(0)\n\ts_barrier":::"memory")
__device__ __forceinline__ void split3(float x,unsigned&h,unsigned&m,unsigned&l){
  const unsigned u=__float_as_uint(x)&0xffff0000u; const float r1=x-__uint_as_float(u);
  const unsigned u1=__float_as_uint(r1)&0xffff0000u; const float r2=r1-__uint_as_float(u1);
  h=u>>16; m=u1>>16; l=__float_as_uint(r2)>>16; }
__device__ __forceinline__ bf16x8 make_qx(float base,int hi){ unsigned h,m,l; split3(base,h,m,l); u32x4 w; w.x=h|(m<<16); w.y=l|0x3f800000u; w.z=0x3f803f80u; w.w=0u; if(hi){w.x=0u;w.y=0u;w.z=0u;} return __builtin_bit_cast(bf16x8,w); }
__device__ __forceinline__ bf16x8 make_kx(float ck,int hi){ unsigned h,m,l; split3(-ck,h,m,l); u32x4 w; w.x=0x3f803f80u; w.y=0x3f80u|(h<<16); w.z=m|(l<<16); w.w=0u; if(hi){w.x=0u;w.y=0u;w.z=0u;} return __builtin_bit_cast(bf16x8,w); }

__device__ __forceinline__ void qkt(f32x16&p0,f32x16&p1,const char*Kslot,const bf16x8*qr,bf16x8 qx,bf16x8 kx0,bf16x8 kx1,int r32,int hi){
  const char*kb=Kslot+hi*1024+r32*16; const f32x16 z=f32x16{};
  p0=__builtin_amdgcn_mfma_f32_32x32x16_bf16(kx0,qx,z,0,0,0);p1=__builtin_amdgcn_mfma_f32_32x32x16_bf16(kx1,qx,z,0,0,0);
  #pragma unroll
  for(int d0=0;d0<4;++d0){
    const bf16x8 b0=*reinterpret_cast<const bf16x8*>(kb+d0*2048);
    const bf16x8 b1=*reinterpret_cast<const bf16x8*>(kb+d0*2048+512);
    p0=__builtin_amdgcn_mfma_f32_32x32x16_bf16(b0,qr[d0],p0,0,0,0);p1=__builtin_amdgcn_mfma_f32_32x32x16_bf16(b1,qr[d0],p1,0,0,0);}
}
typedef __attribute__((address_space(3))) const char* lds_cptr;
typedef short v4i16_t __attribute__((ext_vector_type(4)));
__device__ __forceinline__ void kload8(bf16x8*kf,lds_cptr kp){
  kf[0]=*(const __attribute__((address_space(3))) bf16x8*)(kp);      kf[1]=*(const __attribute__((address_space(3))) bf16x8*)(kp+512);
  kf[2]=*(const __attribute__((address_space(3))) bf16x8*)(kp+2048); kf[3]=*(const __attribute__((address_space(3))) bf16x8*)(kp+2560);
  kf[4]=*(const __attribute__((address_space(3))) bf16x8*)(kp+4096); kf[5]=*(const __attribute__((address_space(3))) bf16x8*)(kp+4608);
  kf[6]=*(const __attribute__((address_space(3))) bf16x8*)(kp+6144); kf[7]=*(const __attribute__((address_space(3))) bf16x8*)(kp+6656);
}
__device__ __forceinline__ void kload2(bf16x8*kf,lds_cptr kp,int j){ kf[2*j]=*(const __attribute__((address_space(3))) bf16x8*)(kp+j*2048); kf[2*j+1]=*(const __attribute__((address_space(3))) bf16x8*)(kp+j*2048+512); }
__device__ __forceinline__ s16x4 vtr(lds_cptr p){ return __builtin_bit_cast(s16x4,__builtin_amdgcn_ds_read_tr16_b64_v4i16((__attribute__((address_space(3))) v4i16_t*)p)); }
__device__ __forceinline__ float rowmax(const f32x16&p0,const f32x16&p1){
  float a=max3f(p0[0],p0[1],p1[0]),b=max3f(p0[2],p0[3],p1[1]);a=max3f(a,p1[2],p1[3]);
  #pragma unroll
  for(int r=4;r<16;r+=4){a=max3f(a,p0[r],p0[r+1]);b=max3f(b,p0[r+2],p0[r+3]);a=max3f(a,p1[r],p1[r+1]);b=max3f(b,p1[r+2],p1[r+3]);}
  const float m=max2f(a,b);
  auto rr=__builtin_amdgcn_permlane32_swap(__float_as_uint(m),__float_as_uint(m),false,false);
  return max2f(__uint_as_float(rr[0]),__uint_as_float(rr[1]));
}
__device__ __forceinline__ void pv(f32x16*o,int vb,bf16x8 pa0,bf16x8 pa1,bf16x8 pa2,bf16x8 pa3){
  #pragma unroll
  for(int d0=0;d0<2;++d0){s16x4 lo[4],hi[4];
    #pragma unroll
    for(int ks=0;ks<4;++ks){
      asm volatile("ds_read_b64_tr_b16 %0,%1 offset:%c2":"=&v"(lo[ks]):"v"(vb),"i"(d0*4096+ks*1024):"memory");
      asm volatile("ds_read_b64_tr_b16 %0,%1 offset:%c2":"=&v"(hi[ks]):"v"(vb),"i"(d0*4096+ks*1024+512):"memory");}
    asm volatile("s_waitcnt lgkmcnt(0)":::"memory");SBAR();
    #define PK(k) (bf16x8){lo[k][0],lo[k][1],lo[k][2],lo[k][3],hi[k][0],hi[k][1],hi[k][2],hi[k][3]}
    o[d0]=__builtin_amdgcn_mfma_f32_32x32x16_bf16(pa0,PK(0),o[d0],0,0,0);
    o[d0]=__builtin_amdgcn_mfma_f32_32x32x16_bf16(pa1,PK(1),o[d0],0,0,0);
    o[d0]=__builtin_amdgcn_mfma_f32_32x32x16_bf16(pa2,PK(2),o[d0],0,0,0);
    o[d0]=__builtin_amdgcn_mfma_f32_32x32x16_bf16(pa3,PK(3),o[d0],0,0,0);
    #undef PK
  }
}
#define ATTN_STORE16(p,v) (*(u32x4*)(p)=(v))
template<int THRL> __device__ __forceinline__ void attn_unit(int b,int h,int qb,const bf16*Q,const bf16*__restrict__ K,const bf16*__restrict__ V,const bf16*__restrict__ CZ,bf16*O,const float*__restrict__ c2g,int ts,float ub,char*shm){
  int tid=threadIdx.x; asm volatile("":"+v"(tid));
  const int lane=tid&63,r32=lane&31,hi=lane>>5; const int wid=__builtin_amdgcn_readfirstlane(tid>>6);
  const long rowbase=(long)b*SEQ; const int q0=qb*QB;
  const bf16*Qw=Q+(rowbase+q0+wid*QBLK)*DM+h*D;
  const bf16*Kh=K+(rowbase+(long)ts*KVBLK)*DM+h*D,*Vh=V+(rowbase+(long)ts*KVBLK)*DM+h*D;
  const unsigned lds0=(unsigned)(uintptr_t)shm;
  float*wsf=(float*)(shm+LDS_WS)+wid*64;
  float*c2l=(float*)(shm+LDS_C2);
  const bf16*ksrc=Kh+(long)lane*DM+wid*8;
  const bf16*vsrc=Vh+(long)(16*(wid&3)+(lane>>2))*DM+(wid>>2)*32+(lane&3)*8;
  const unsigned kdst=lds0+LDS_K+wid*1024, vdst=lds0+LDS_V+wid*1024;
  #define DMA_K(t,slot) glds16(ksrc+(long)(t)*KVBLK*DM,(unsigned)__builtin_amdgcn_readfirstlane(kdst+(slot)))
  #define DMA_V(t,slot) glds16(vsrc+(long)(t)*KVBLK*DM,(unsigned)__builtin_amdgcn_readfirstlane(vdst+(slot)))
  const int vb0=(int)(lds0+LDS_V)+((lane>>4)&1)*32+(lane&3)*8+(4*hi+((lane&15)>>2))*64;
  const char*Kbase=shm+LDS_K; bf16x8 kf[8];
  const lds_cptr shm3=(lds_cptr)shm; const lds_cptr kp0=shm3+LDS_K+hi*1024+r32*16; const lds_cptr vp0=shm3+LDS_V+((lane>>4)&1)*32+(lane&3)*8+(4*hi+((lane&15)>>2))*64;
  const int NT=(q0+QB)/KVBLK-ts;
  DMA_K(0,0);DMA_V(0,0);DMA_K(1,SLOTB);
  { const int kb0=ts*KVBLK; for(int i=tid*4;i<q0+QB-kb0;i+=NW*64*4)*(f32x4*)(c2l+i)=*(const f32x4*)(c2g+kb0+i); }
  bf16x8 qr[4];
  #pragma unroll
  for(int d0=0;d0<4;++d0)qr[d0]=*reinterpret_cast<const bf16x8*>(&Qw[(long)r32*DM+d0*16+hi*8]);
    float mhat=ub,l_reg=0.f;f32x16 o[2];o[0]=f32x16{};o[1]=f32x16{};
  const int qrel=wid*QBLK+r32;
  #define CMASK(P0,P1,t) do{int jb_=(t)-(NT-4); if(jb_>=0)cmask(P0,P1,jb_,qrel,hi);}while(0)
  bool resc=false;
  bf16x8 qx; float cq2;
  #define START(P0,P1) do{ resc=false; \
    _Pragma("unroll") for(int r=0;r<16;++r)P0[r]=__builtin_amdgcn_exp2f(P0[r]); }while(0)
  #define RESC() do{}while(0)
  f32x16 pA0,pA1,pB0,pB1;
  int sl_prev=0,sl_cur=0,sl_next=SLOTB;
  #define ROT() do{sl_prev=sl_cur;sl_cur=sl_next;sl_next=(sl_next==(NSLOT-1)*SLOTB)?0:sl_next+SLOTB;}while(0)
  DMA_K(2,2*SLOTB);
  WAIT_BAR(3);
  cq2=c2l[q0+qrel-ts*KVBLK]; qx=make_qx(cq2-mhat,hi);
  float ck0=c2l[r32],ck1=c2l[32+r32];
  { const bf16x8 kx0=make_kx(ck0,hi),kx1=make_kx(ck1,hi);
    qkt(pA0,pA1,Kbase,qr,qx,kx0,kx1,r32,hi); }
  asm volatile("s_nop 15\n\ts_nop 7":"+v"(pA0),"+v"(pA1));CMASK(pA0,pA1,0);
  ck0=c2l[64+r32];ck1=c2l[96+r32];
  START(pA0,pA1);
  _Pragma("unroll") for(int r=0;r<16;++r)pA1[r]=__builtin_amdgcn_exp2f(pA1[r]);
  WAIT_BAR(0);
  DMA_K(3,0);DMA_V(1,SLOTB);
  ROT();
  kload8(kf,kp0+sl_cur);
  WAIT_BAR(2);
  s16x4 vlo[8],vhi[8]; u32x4 pw0,pw1,pw2,pw3;
  #define PKW(P,B) cvtpk_s(P[B],P[B+1])
  #define PAF(k) __builtin_bit_cast(bf16x8,pw##k)
  #define VFR(i) (bf16x8){vlo[i][0],vlo[i][1],vlo[i][2],vlo[i][3],vhi[i][0],vhi[i][1],vhi[i][2],vhi[i][3]}
  #define PIN(x) asm volatile("":"+v"(x))
  #define MX3(a,b,c) __builtin_fmaxf(__builtin_fmaxf((a),(b)),(c))
  #define GAPA(MF,A0,A1,A2,A3,W0,W1,PW) do{ MF; sacc+=A0; sacc+=A1; sacc+=A2; sacc+=A3; PIN(sacc); W0; W1; PIN(PW); SBAR(); }while(0)
  #define EX(v) __builtin_amdgcn_exp2f(v)
  #define GAPB(MF,X,B) do{ MF; X[B]=EX(X[B]); X[B+1]=EX(X[B+1]); X[B+2]=EX(X[B+2]); X[B+3]=EX(X[B+3]); PIN(X); SBAR(); }while(0)
  #define VRD(i) do{ vlo[i]=vtr(vp_+(((i)>>2)*4096+((i)&3)*1024)); vhi[i]=vtr(vp_+(((i)>>2)*4096+((i)&3)*1024+512)); }while(0)
  #define KRD(G,j) do{ if(G){ kload2(kf,kp0+sl_next,j); SBAR(); } }while(0)
  #define STEP(C0,C1,P0,P1,t,GK,GV,GL) do{ SBAR(); \
    const lds_cptr vp_=vp0+sl_prev; \
    { const bf16x8 kx0_=make_kx(ck0,hi),kx1_=make_kx(ck1,hi); const f32x16 z_=f32x16{}; \
      C0=__builtin_amdgcn_mfma_f32_32x32x16_bf16(kx0_,qx,z_,0,0,0); C1=__builtin_amdgcn_mfma_f32_32x32x16_bf16(kx1_,qx,z_,0,0,0); } SBAR(); \
    VRD(0); SBAR(); float sacc=(P0[0]+P0[1]); \
    GAPA(C0=__builtin_amdgcn_mfma_f32_32x32x16_bf16(kf[0],qr[0],C0,0,0,0), P0[2],P0[3],P0[4],P0[5],     pw0[0]=PKW(P0,0), pw0[1]=PKW(P0,2), pw0); \
    VRD(4); SBAR(); GAPA(C1=__builtin_amdgcn_mfma_f32_32x32x16_bf16(kf[1],qr[0],C1,0,0,0), P0[6],P0[7],P0[8],P0[9],     pw0[2]=PKW(P0,4), pw0[3]=PKW(P0,6), pw0); \
    VRD(1); SBAR(); GAPA(C0=__builtin_amdgcn_mfma_f32_32x32x16_bf16(kf[2],qr[1],C0,0,0,0),   P0[10],P0[11],P0[12],P0[13], pw1[0]=PKW(P0,8), pw1[1]=PKW(P0,10), pw1); \
    VRD(5); SBAR(); GAPA(C1=__builtin_amdgcn_mfma_f32_32x32x16_bf16(kf[3],qr[1],C1,0,0,0),   P0[14],P0[15],P1[0],P1[1],   pw1[2]=PKW(P0,12),pw1[3]=PKW(P0,14), pw1); \
    VRD(2); SBAR(); GAPA(C0=__builtin_amdgcn_mfma_f32_32x32x16_bf16(kf[4],qr[2],C0,0,0,0),   P1[2],P1[3],P1[4],P1[5],     pw2[0]=PKW(P1,0), pw2[1]=PKW(P1,2), pw2); \
    VRD(6); SBAR(); GAPA(C1=__builtin_amdgcn_mfma_f32_32x32x16_bf16(kf[5],qr[2],C1,0,0,0),   P1[6],P1[7],P1[8],P1[9],     pw2[2]=PKW(P1,4), pw2[3]=PKW(P1,6), pw2); \
    VRD(3); SBAR(); GAPA(C0=__builtin_amdgcn_mfma_f32_32x32x16_bf16(kf[6],qr[3],C0,0,0,0),   P1[10],P1[11],P1[12],P1[13], pw3[0]=PKW(P1,8), pw3[1]=PKW(P1,10), pw3); \
    VRD(7); SBAR(); GAPA(C1=__builtin_amdgcn_mfma_f32_32x32x16_bf16(kf[7],qr[3],C1,0,0,0),   P1[14],P1[15],0.f,0.f,       pw3[2]=PKW(P1,12),pw3[3]=PKW(P1,14), pw3); \
    l_reg+=sacc; \
    if(GK){DMA_K((t)+3,sl_cur);} if(GV){DMA_V((t)+1,sl_next);} \
    if(GL){ ck0=c2l[64*((t)+1)+r32]; ck1=c2l[64*((t)+1)+32+r32]; } \
    CMASK(C0,C1,t); \
    SBAR(); \
    GAPB(o[0]=__builtin_amdgcn_mfma_f32_32x32x16_bf16(PAF(0),VFR(0),o[0],0,0,0), C0,0); \
    GAPB(o[1]=__builtin_amdgcn_mfma_f32_32x32x16_bf16(PAF(0),VFR(4),o[1],0,0,0), C0,4); \
    KRD(GL,0); GAPB(o[0]=__builtin_amdgcn_mfma_f32_32x32x16_bf16(PAF(1),VFR(1),o[0],0,0,0), C0,8); \
    KRD(GL,1); GAPB(o[1]=__builtin_amdgcn_mfma_f32_32x32x16_bf16(PAF(1),VFR(5),o[1],0,0,0), C0,12); \
    KRD(GL,2); GAPB(o[0]=__builtin_amdgcn_mfma_f32_32x32x16_bf16(PAF(2),VFR(2),o[0],0,0,0), C1,0); \
    KRD(GL,3); GAPB(o[1]=__builtin_amdgcn_mfma_f32_32x32x16_bf16(PAF(2),VFR(6),o[1],0,0,0), C1,4); \
    GAPB(o[0]=__builtin_amdgcn_mfma_f32_32x32x16_bf16(PAF(3),VFR(3),o[0],0,0,0), C1,8); \
    GAPB(o[1]=__builtin_amdgcn_mfma_f32_32x32x16_bf16(PAF(3),VFR(7),o[1],0,0,0), C1,12); \
    }while(0)
  int t=1;
  #undef CMASK
  #define CMASK(P0,P1,t) do{}while(0)
  for(;t+5<NT;t+=2){
    STEP(pB0,pB1,pA0,pA1,t,true,true,true);     WAIT_BAR(2); RESC(); ROT();
    STEP(pA0,pA1,pB0,pB1,t+1,true,true,true);   WAIT_BAR(2); RESC(); ROT();
  }
  #undef CMASK
  #define CMASK(P0,P1,t) do{int jb_=(t)-(NT-4); if(jb_>=0)cmask(P0,P1,jb_,qrel,hi);}while(0)
  #define ENDW(tt) do{ if((tt)+3<NT){WAIT_BAR(2);} else if((tt)+2<NT){WAIT_BAR(1);} else {WAIT_BAR(0);} }while(0)
  for(;t+1<NT;t+=2){
    STEP(pB0,pB1,pA0,pA1,t,(t+3<NT),(t+1<NT),(t+1<NT));       ENDW(t);   RESC(); ROT();
    STEP(pA0,pA1,pB0,pB1,t+1,(t+4<NT),(t+2<NT),(t+2<NT));     ENDW(t+1); RESC(); ROT();
  }
  STEP(pB0,pB1,pA0,pA1,NT-1,false,false,false); RESC();
  { float sacc=pB0[0]+pB0[1]; _Pragma("unroll") for(int r=2;r<16;++r)sacc+=pB0[r]; _Pragma("unroll") for(int r=0;r<16;++r)sacc+=pB1[r]; l_reg+=sacc;
    pw0=(u32x4){PKW(pB0,0),PKW(pB0,2),PKW(pB0,4),PKW(pB0,6)};pw1=(u32x4){PKW(pB0,8),PKW(pB0,10),PKW(pB0,12),PKW(pB0,14)};pw2=(u32x4){PKW(pB1,0),PKW(pB1,2),PKW(pB1,4),PKW(pB1,6)};pw3=(u32x4){PKW(pB1,8),PKW(pB1,10),PKW(pB1,12),PKW(pB1,14)};
    SBAR(); pv(o,vb0+sl_cur,PAF(0),PAF(1),PAF(2),PAF(3)); }
  #undef PKW
  #undef PAF
  #undef VFR
  #undef PIN
  #undef MX3
  #undef GAPA
  #undef GAPB
  #undef EX
  #undef VRD
  #undef KRD
  #undef STEP
  #undef ENDW
  {auto rr=__builtin_amdgcn_permlane32_swap(__float_as_uint(l_reg),__float_as_uint(l_reg),false,false);l_reg=__uint_as_float(rr[0])+__uint_as_float(rr[1]);}
  if(hi==0)wsf[32+r32]=l_reg;asm volatile("s_waitcnt lgkmcnt(0)":::"memory");
  bf16*Ow=O+(rowbase+q0+wid*QBLK)*DM+h*D;
  const unsigned short*Cw=(const unsigned short*)(CZ+(rowbase+q0+wid*QBLK)*DM+h*D);
  { bf16*stg=(bf16*)(shm+LDS_OST)+wid*2048;
    #pragma unroll
    for(int r=0;r<16;++r){const int orow=crow(r,hi); const float rl=__builtin_amdgcn_rcpf(wsf[32+orow]);
      #pragma unroll
      for(int d0=0;d0<2;++d0){ const float cz=__uint_as_float((unsigned)Cw[(long)orow*DM+d0*32+r32]<<16); stg[orow*64+d0*32+r32]=__float2bfloat16(o[d0][r]*rl*cz);} }
    asm volatile("s_waitcnt lgkmcnt(0)":::"memory");
    #pragma unroll
    for(int i=0;i<4;++i){const int row=i*8+(lane>>3),ch=lane&7; const u32x4 v=*(const u32x4*)(stg+row*64+ch*8); ATTN_STORE16(Ow+(long)row*DM+ch*8,v);} }
  asm volatile("s_waitcnt lgkmcnt(0)\n\ts_barrier":::"memory");
  #undef DMA_K
  #undef DMA_V
  #undef CMASK
  #undef START
  #undef RESC
  #undef ROT
}
#undef SBAR
#undef WAIT_BAR
}

typedef float f32x2 __attribute__((ext_vector_type(2)));
__device__ __forceinline__ void p2_conv(Frame& F, int l, int unit, bf16_t* outb, const bool pv_ = false) {
    const int tid = F.tid, lane = F.lane, w = F.wave;
    const size_t row0 = (size_t)unit * 64; const int tseq0 = (int)(row0 % SEQ);
    const bf16_t* AG = (const bf16_t*)(F.P.ws + WS_B3); const bf16_t* B0 = (const bf16_t*)(F.P.ws + WS_B0);
    LAS unsigned char* tile = F.lds + RING_OFF;
    for (int c = tid; c < 94 * 64; c += 512) { const int r = c >> 6, ch = c & 63, tr = r - (CW - 1); const bool valid = tseq0 + tr >= 0;
        u32x4 v = (u32x4){0u, 0u, 0u, 0u}; if (valid) v = *(const u32x4*)(AG + (size_t)((long)row0 + tr) * 1024 + ch * 8);
        *(LAS u32x4*)(tile + r * 1024 + ch * 16) = v; }
    LAS float* wl = (LAS float*)(tile + 94 * 1024);
    { const float* cwg = F.P.conv_w + (size_t)l * CW * DA; for (int c = tid; c < CW * DA / 4; c += 512) *(LAS f32x4*)(wl + 4 * c) = *(const f32x4*)(cwg + 4 * c); }
    __syncthreads();
    if (PROBE_CONV == 2 && pv_) { __syncthreads(); return; }
    f32x2 out[4][8]; float s1[8], s2[8];
#pragma unroll
    for (int o = 0; o < 8; ++o) { s1[o] = 0.f; s2[o] = 0.f; }
#pragma unroll
    for (int i = 0; i < 4; ++i) {
        __builtin_amdgcn_sched_barrier(0);
        int p = lane + 64 * i; asm volatile("" : "+v"(p));
        const LAS float* cw = wl + 2 * p;
        f32x2 wv[CW];
#pragma unroll
        for (int j = 0; j < CW; ++j) wv[j] = *(const LAS f32x2*)(cw + j * DA);
        const f32x2 cb = *(const f32x2*)(F.P.conv_b + l * DA + 2 * p);
        const LAS unsigned* tp = (const LAS unsigned*)(tile + (8 * w) * 1024 + 4 * p);
        f32x2 win[16];
#pragma unroll
        for (int k = 0; k < 16; ++k) { const unsigned u = tp[k * 256]; win[k] = (f32x2){__uint_as_float(u << 16), __uint_as_float(u & 0xffff0000u)}; }
#pragma unroll
        for (int o = 0; o < 8; ++o) out[i][o] = cb;
        __builtin_amdgcn_sched_barrier(0);
#pragma unroll
        for (int j = 0; j < CW; ++j) {
            if (!(PROBE_CONV == 1 && pv_))
#pragma unroll
            for (int o = 0; o < 8; ++o) out[i][o] += wv[j] * win[(j + o) & 15];
            asm volatile("" : "+v"(out[i][0]), "+v"(out[i][1]), "+v"(out[i][2]), "+v"(out[i][3]), "+v"(out[i][4]), "+v"(out[i][5]), "+v"(out[i][6]), "+v"(out[i][7]));
            if (j + 16 < 38) { const LAS unsigned* tq = tp; asm volatile("" : "+v"(tq)); const unsigned u = tq[(j + 16) * 256]; win[j & 15] = (f32x2){__uint_as_float(u << 16), __uint_as_float(u & 0xffff0000u)}; }
            __builtin_amdgcn_sched_barrier(0);
        }
#pragma unroll
        for (int o = 0; o < 8; ++o) { s1[o] += out[i][o].x + out[i][o].y; s2[o] += out[i][o].x * out[i][o].x + out[i][o].y * out[i][o].y; }
    }
    unsigned az[4][8];
#pragma unroll
    for (int i = 0; i < 4; ++i)
#pragma unroll
        for (int o = 0; o < 8; ++o) az[i][o] = *(const unsigned*)(B0 + (row0 + 8 * w + o) * 1024 + 2 * (lane + 64 * i));
#pragma unroll
    for (int o = 0; o < 8; ++o) { s1[o] = wsum(s1[o]); s2[o] = wsum(s2[o]); }
#pragma unroll
    for (int i = 0; i < 4; ++i) {
        const int p = lane + 64 * i;
        const f32x2 gg = *(const f32x2*)(F.P.cn_g + l * DA + 2 * p), be = *(const f32x2*)(F.P.cn_b + l * DA + 2 * p);
#pragma unroll
        for (int o = 0; o < 8; ++o) { const float mu = s1[o] * (1.f / DA), ex2 = s2[o] * (1.f / DA); const float rstd = rsqrtf(fmaxf(ex2 - mu * mu, 0.f) + EPS);
            f32x2 y = (out[i][o] - mu) * rstd * gg + be; y.x = y.x * fsigm(y.x); y.y = y.y * fsigm(y.y);
            *(unsigned*)(outb + (row0 + 8 * w + o) * 1024 + 2 * p) = cvt_pk_bf16(y.x * __uint_as_float(az[i][o] << 16), y.y * __uint_as_float(az[i][o] & 0xffff0000u)); }
    }
    __syncthreads();
}
__device__ __forceinline__ void p2_gmlp(Frame& F, int l, int unit, bf16_t* outb) {
    constexpr int VTP = 136;
    const int tid = F.tid, lane = F.lane, w = F.wave, fr = lane & 15, fq = lane >> 4, ch = unit >> 1, gp = unit & 1, c0 = 256 * gp; const size_t row0 = (size_t)ch * CHK;
    LAS bf16_t* vt = (LAS bf16_t*)(F.lds + RING_OFF);
    const bf16_t* V = (const bf16_t*)(F.P.ws + WS_B3) + 512 + c0; const bf16_t* U = (const bf16_t*)(F.P.ws + WS_B0) + 512 + c0;
    const float* vss = (const float*)(F.P.ws + WS_VSS); const float* gn = F.P.gn_g + l * DB + c0;
    const size_t t = row0 + 16 * w + fr;
    unsigned long long uu[16];
#pragma unroll
    for (int n = 0; n < 16; ++n) uu[n] = *(const unsigned long long*)(U + t * 1024 + 16 * n + 4 * fq);
    bf16x8 wf[2][4];
#pragma unroll
    for (int g2 = 0; g2 < 2; ++g2)
#pragma unroll
        for (int ks = 0; ks < 4; ++ks) wf[g2][ks] = *(const bf16x8*)((const bf16_t*)(F.P.ws + WS_WSB) + ((size_t)(l * NG + 2 * gp + g2) * CHK + 16 * w + fr) * CHK + 32 * ks + 8 * fq);
    const float bs0 = F.P.b_s[(size_t)(l * NG + 2 * gp) * CHK + 16 * w + fr], bs1 = F.P.b_s[(size_t)(l * NG + 2 * gp + 1) * CHK + 16 * w + fr];
    { const int sidx = tid & 127; const f32x4 qa = *(const f32x4*)(vss + (row0 + sidx) * 8), qb = *(const f32x4*)(vss + (row0 + sidx) * 8 + 4);
      const float ss = ((qa.x + qa.y) + (qa.z + qa.w)) + ((qb.x + qb.y) + (qb.z + qb.w)); const float rv = rsqrtf(ss * (1.f / DB) + EPS);
      u32x4 raw[8];
#pragma unroll
      for (int k = 0; k < 8; ++k) raw[k] = *(const u32x4*)(V + (row0 + sidx) * 1024 + ((tid >> 7) + 4 * k) * 8);
#pragma unroll
      for (int k = 0; k < 8; ++k) { const int c8 = ((tid >> 7) + 4 * k) * 8; f32x4 v0, v1; unpack8(raw[k], v0, v1); const f32x4 g0 = *(const f32x4*)(gn + c8), g1 = *(const f32x4*)(gn + c8 + 4);
          v0 = v0 * rv * g0; v1 = v1 * rv * g1;
#pragma unroll
          for (int e = 0; e < 4; ++e) { vt[(c8 + e) * VTP + sidx] = f2bf(v0[e]); vt[(c8 + 4 + e) * VTP + sidx] = f2bf(v1[e]); } } }
    __syncthreads();
    f32x4 acc[16];
#pragma unroll
    for (int n = 0; n < 16; ++n) acc[n] = (f32x4){0.f, 0.f, 0.f, 0.f};
#pragma unroll
    for (int ks = 0; ks < 4; ++ks) {
        if (32 * ks <= 16 * w + 15) {
#pragma unroll
            for (int n = 0; n < 16; ++n) { const bf16x8 vf = *(const LAS bf16x8*)(vt + (16 * n + fr) * VTP + 32 * ks + 8 * fq); acc[n] = __builtin_amdgcn_mfma_f32_16x16x32_bf16(vf, wf[n >> 3][ks], acc[n], 0, 0, 0); }
        }
    }
#pragma unroll
    for (int n = 0; n < 16; ++n) { const float bs = n < 8 ? bs0 : bs1;
        const unsigned u0 = (unsigned)uu[n], u1 = (unsigned)(uu[n] >> 32);
        const float o0 = __uint_as_float(u0 << 16) * (acc[n][0] + bs), o1 = __uint_as_float(u0 & 0xffff0000u) * (acc[n][1] + bs);
        const float o2 = __uint_as_float(u1 << 16) * (acc[n][2] + bs), o3 = __uint_as_float(u1 & 0xffff0000u) * (acc[n][3] + bs);
        *(unsigned long long*)(outb + 512 + c0 + t * 1024 + 16 * n + 4 * fq) = (unsigned long long)cvt_pk_bf16(o0, o1) | ((unsigned long long)cvt_pk_bf16(o2, o3) << 32); }
    __syncthreads();
}

__global__ void __launch_bounds__(NWAVES * 64, 2) mk_fwd(Args args) {
    extern __shared__ __attribute__((aligned(16))) unsigned char lds[];
    Frame F;
    F.lds = (LAS unsigned char*)lds;
    volatile LAS unsigned* MISC = (volatile LAS unsigned*)(F.lds + MISC_OFF);
    F.tid = threadIdx.x; F.lane = F.tid & 63; F.wave = __builtin_amdgcn_readfirstlane(F.tid >> 6);
    F.G = gridDim.x; { const int bx = blockIdx.x; F.vcu = (F.G % 8 == 0) ? (bx % 8) * (F.G / 8) + bx / 8 : bx; }
    F.P.x = args.in[0]; F.P.norm_g = args.in[1]; F.P.w_in = args.in[2]; F.P.b_gate = args.in[3]; F.P.conv_w = args.in[4]; F.P.conv_b = args.in[5]; F.P.cn_g = args.in[6]; F.P.cn_b = args.in[7]; F.P.w_a = args.in[8];
    F.P.gn_g = args.in[9]; F.P.w_s = args.in[10]; F.P.b_s = args.in[11]; F.P.w_b = args.in[12]; F.P.qn_g = args.in[13]; F.P.kn_g = args.in[14]; F.P.b_f = args.in[15]; F.P.w_c = args.in[16]; F.P.w_out = args.in[17];
    F.P.out = args.out; F.P.ws = args.ws;
    gu32* ctl = (gu32*)(args.ws + WS_CTL);
    for (int u = F.tid; u < (LDS_BYTES - LDSCTL_OFF) / 4; u += NWAVES * 64) ((LAS unsigned*)(F.lds + LDSCTL_OFF))[u] = 0u;
    __syncthreads();
    XcdBarrier bar = xcd_barrier_post((unsigned*)(ctl + CW_BAR) + args.li * XCD_BAR_WORDS, MISC + 8);

    bool dup_done = false;
    for (int ph = args.ph_lo; ph < args.ph_hi;) {
        const int l = ph / 5, p = ph % 5;
        const bool dummy = (PROBE_DUP >= 0) && p == PROBE_DUP && !dup_done;
        asm volatile("" : "+v"(F.tid)); F.lane = F.tid & 63;
        int bid = (int)blockIdx.x; asm volatile("" : "+s"(bid));
        unsigned char* ws = F.P.ws; unsigned char* wl = ws + WS_W + (size_t)l * W_LAYER;
        const float* xin = l == 0 ? F.P.x : F.P.out;
        if (p == 0) {
            if (l > 0) { ++ph; continue; }
            if (l == 0 && (!dummy || (PROBE_SUB & 1))) p0_weights(F);
            if (!dummy || (PROBE_SUB & 2)) p0_ln(F, l, xin);
        } else if (p == 1) {
            if (bid < NB * NH) p1_scan(F, bid, l);
            { pg8::TileOrder T0; T0.init(M, N1, F.G, bid); int pm_ = 0, pn_ = 0; (void)T0.tile(0, pm_, pn_);
              LAS float* Rt = (LAS float*)(F.lds + RT_OFF);
              if (F.tid < 256) { float r = 1.f; if (l > 0) { const f32x4 q = *(const f32x4*)((const float*)(ws + WS_SSP) + ((size_t)pm_ * 256 + F.tid) * 4); r = rsqrtf(((q.x + q.y) + (q.z + q.w)) * (1.f / D) + EPS); } Rt[F.tid] = r; }
              __syncthreads(); }
            pg8::SchedG1 S; S.T.init(M, N1, F.G, bid); S.A = (const char*)(ws + WS_H); S.B = (const char*)(wl + WO_W1);
            pg8::EpiG1 E{(bf16_t*)(ws + WS_B0), (bf16_t*)(ws + WS_B1), (bf16_t*)(ws + WS_B2), (bf16_t*)(ws + WS_B3), (bf16_t*)(ws + WS_B4), (float*)(ws + WS_VSS), F.P.qn_g + l * HD, F.P.kn_g + l * HD, (const LAS float*)(F.lds + RT_OFF)};
            pg8::gemm_phase<pg8::EpiG1, pg8::SchedG1>(F.lds + RING_OFF, S, E);
        } else if (p == 2) {
            for (int part = 0; part < 2; ++part) {
              asm volatile("" : "+v"(F.tid)); F.lane = F.tid & 63; asm volatile("" : "+s"(bid));
              if ((part == 0) == ((F.vcu & 1) == 0)) {
            if (!dummy || (PROBE_SUB & 1)) p2_conv(F, l, bid, dummy ? (bf16_t*)(ws + WS_DUMMY) : (bf16_t*)(ws + WS_B0), dummy);
            if (!dummy || (PROBE_SUB & 2)) { bf16_t* ob = dummy ? (bf16_t*)(ws + WS_DUMMY) : (bf16_t*)(ws + WS_B0); p2_gmlp(F, l, bid, ob); }
              } else {
            if (!dummy || (PROBE_SUB & 4)) { const int bh = F.vcu >> 3, sq = F.vcu & 7; const attn_body::bf16* b1 = (const attn_body::bf16*)(ws + WS_B1); const attn_body::bf16* b2 = (const attn_body::bf16*)(ws + WS_B2);
              const float* c2g = (const float*)(ws + WS_CS) + (size_t)bh * SEQ; const int* tsg = (const int*)(ws + WS_TS) + bh * 16;
              float gqm = fabsf(F.P.qn_g[l * HD + F.lane]), gkm = fabsf(F.P.kn_g[l * HD + F.lane]);
#pragma unroll
              for (int o_ = 1; o_ < 64; o_ <<= 1) { gqm = fmaxf(gqm, __shfl_xor(gqm, o_)); gkm = fmaxf(gkm, __shfl_xor(gkm, o_)); }
              const float ub = 64.f * C2 * gqm * gkm * 1.01f;
              for (int i = 0; i < 2; ++i) { const int qb = i == 0 ? 15 - sq : sq; const int ts = __builtin_amdgcn_readfirstlane(tsg[qb]); attn_body::attn_unit<8>(bh / NH, bh % NH, qb, b1, b1 + 512, b2, b2 + 512, dummy ? (attn_body::bf16*)(ws + WS_DUMMY) : (attn_body::bf16*)(ws + WS_B1), c2g, ts, ub, (char*)lds + RING_OFF); } }
              }
            }
        } else if (p == 3) {
            pg8::TileOrder T; T.init(M, D, F.G, bid);
            pg8::SchedMerge S; { int pm_ = 0, pn_ = 0; S.ok = T.tile(0, pm_, pn_); S.pm = pm_; S.pn = pn_; }
            S.ws = (const char*)ws; S.wl = (const char*)wl;
            S.cls = F.vcu & 1;
            pg8::EpiMerge E{ws + WS_GT + (size_t)bid * 131072, (bf16_t*)(ws + WS_MG), F.P.b_gate + (size_t)l * 3072, (const LAS float*)(F.lds + RT_OFF), S.cls, (size_t)(WS_B4 - WS_GT), dummy};
            pg8::gemm_phase<pg8::EpiMerge, pg8::SchedMerge>(F.lds + RING_OFF, S, E);
        } else {
            pg8::SchedG1 S; S.T.init(M, D, F.G, bid); S.A = (const char*)(ws + WS_MG); S.B = (const char*)(wl + WO_WO);
            if (l + 1 < NL) {
                pg8::EpiOutLN E{xin, (bf16_t*)(ws + WS_H), F.P.norm_g + (size_t)(l + 1) * D, F.P.w_in + (size_t)(l + 1) * D * NIN + OC_F, (float*)(ws + WS_SSP), (float*)(ws + WS_FP)};
                pg8::gemm_phase<pg8::EpiOutLN, pg8::SchedG1>(F.lds + RING_OFF, S, E);
            } else {
                pg8::EpiOutB E{(const bf16_t*)(ws + WS_H), dummy ? (float*)(ws + WS_B0) : F.P.out};
                pg8::gemm_phase<pg8::EpiOutB, pg8::SchedG1>(F.lds + RING_OFF, S, E);
            }
        }
        if (dummy) { dup_done = true; continue; }
        dup_done = false; ++ph;
        if (ph < args.ph_hi) xcd_barrier(bar);
    }
}

#ifndef MK_MODE
#define MK_MODE 2
#endif
extern "C" void kernel_launch(void* const* d_in, const int* in_sizes, int n_in, void* d_out, int out_size, void* d_ws, size_t ws_size, hipStream_t stream) {
    static int ok = 0;
    if (ok == 0) {
        if (n_in != 18 || in_sizes[0] != M * D || out_size != M * D || ws_size < WS_END) { fprintf(stderr, "kernel_launch: unexpected shapes (n_in %d in0 %d out %d ws %zu)\n", n_in, n_in > 0 ? in_sizes[0] : -1, out_size, ws_size); ok = -1; return; }
        const int tl = 64 * TLD * 4;
        (void)hipFuncSetAttribute((const void*)nv_gemm1, hipFuncAttributeMaxDynamicSharedMemorySize, tl);
        (void)hipFuncSetAttribute((const void*)nv_merge, hipFuncAttributeMaxDynamicSharedMemorySize, 2 * 64 * 256 * 4);
        (void)hipFuncSetAttribute((const void*)nv_gmlp, hipFuncAttributeMaxDynamicSharedMemorySize, 128 * 129 * 4);
        (void)hipFuncSetAttribute((const void*)nv_attn, hipFuncAttributeMaxDynamicSharedMemorySize, 4 * SEQ * 4);
        if (hipFuncSetAttribute((const void*)mk_fwd, hipFuncAttributeMaxDynamicSharedMemorySize, LDS_BYTES) != hipSuccess) { fprintf(stderr, "kernel_launch: hipFuncSetAttribute(mk_fwd) failed\n"); ok = -1; return; }
        int dev = 0, cus = 0; (void)hipGetDevice(&dev); (void)hipDeviceGetAttribute(&cus, hipDeviceAttributeMultiprocessorCount, dev);
        if (cus != 256) fprintf(stderr, "kernel_launch: note: %d CUs (built for 256)\n", cus);
        (void)hipGetLastError();
        ok = 1;
    }
    if (ok < 0) return;
    Ptrs P{};
    const float** pp = (const float**)&P;
    for (int i = 0; i < 18; ++i) pp[i] = (const float*)d_in[i];
    P.out = (float*)d_out; P.ws = (unsigned char*)d_ws;
    const int tl = 64 * TLD * 4;
#if MK_MODE == 0
    nv_prep<<<2048, 256, 0, stream>>>(P);
    for (int l = 0; l < NL; ++l) {
        const float* xin = l == 0 ? P.x : P.out;
        nv_ln<<<M / 4, 256, 0, stream>>>(P, l, xin);
        nv_scan<<<NB * NH, 256, 0, stream>>>(P);
        nv_gemm1<<<dim3(20, 256), 256, tl, stream>>>(P, l);
        nv_conv<<<M, 512, 0, stream>>>(P, l);
        nv_gmlp<<<dim3(128, 4), 256, 128 * 129 * 4, stream>>>(P, l);
        nv_attn<<<M * NH / 4, 256, 4 * SEQ * 4, stream>>>(P);
        nv_merge<<<dim3(4, 256), 256, 2 * 64 * 256 * 4, stream>>>(P, l);
        nv_out<<<dim3(4, 256), 256, 0, stream>>>(P, l, xin, P.out);
    }
#else
    (void)tl;
    if (hipMemsetAsync((char*)d_ws + WS_CTL, 0, CTL_ZERO_BYTES, stream) != hipSuccess) { fprintf(stderr, "kernel_launch: memset failed\n"); return; }
    Args a{};
    for (int i = 0; i < 18; ++i) a.in[i] = (const float*)d_in[i];
    a.out = (float*)d_out; a.ws = (unsigned char*)d_ws;
    auto mk = [&](int lo, int hi, int li) { a.ph_lo = lo; a.ph_hi = hi; a.li = li; hipLaunchKernelGGL(mk_fwd, dim3(256), dim3(NWAVES * 64), LDS_BYTES, stream, a);
        const hipError_t le = hipPeekAtLastError(); if (le != hipSuccess) fprintf(stderr, "kernel_launch: mk launch [%d,%d) failed: %s\n", lo, hi, hipGetErrorName(le)); };
#if MK_MODE == 1
    auto mixers = [&](int l) { nv_conv<<<M, 512, 0, stream>>>(P, l); nv_gmlp<<<dim3(128, 4), 256, 128 * 129 * 4, stream>>>(P, l); nv_attn<<<M * NH / 4, 256, 4 * SEQ * 4, stream>>>(P); };
    mk(0, 2, 0); mixers(0); mk(3, 7, 1); mixers(1); mk(8, 10, 2);
#else
    mk(0, NPH, 0);
#endif
#endif
}
```

```cpp
#include <hip/hip_runtime.h>
#include <cstdio>
#include <cstdint>
#include <cmath>

constexpr int NL = 2, NB = 4, SEQ = 4096, M = NB * SEQ, D = 1024;
constexpr int DA = 512, DB = 512, NH = 8, HD = 64, DC = 512, CW = 31, CHK = 128, NG = 4, GD = 128, NIN = 8200;
constexpr float EPS = 1e-6f;
constexpr float LOG2E = 1.4426950408889634f;
constexpr float C2 = 0.125f * LOG2E;
constexpr int N1 = 5120;
constexpr int OC_GATE = 0, OC_AIN = 3072, OC_AZ = 4096, OC_U = 4608, OC_V = 5120, OC_BZ = 5632, OC_Q = 6144, OC_K = 6656, OC_VA = 7168, OC_CZ = 7680, OC_F = 8192;

constexpr size_t MiB = 1u << 20;
constexpr size_t WS_CTL = 0, CTL_ZERO_BYTES = 1 * MiB;
constexpr size_t WS_VSS = 1 * MiB;
constexpr size_t WS_LOGF = WS_VSS + 512 * 1024;
constexpr size_t WS_CS = 2 * MiB;
constexpr size_t WS_WSB = WS_CS + 512 * 1024;
constexpr size_t WS_TS = 3 * MiB;
constexpr size_t WS_W = 4 * MiB, W_LAYER = 22 * MiB;
constexpr size_t WO_W1 = 0, WO_WG = 10 * MiB, WO_WAB = 16 * MiB, WO_WC = 18 * MiB, WO_WO = 20 * MiB;
constexpr size_t WS_H = 48 * MiB;
constexpr size_t WS_B0 = 80 * MiB;
constexpr size_t WS_B1 = 112 * MiB;
constexpr size_t WS_B2 = 144 * MiB;
constexpr size_t WS_B3 = 176 * MiB;
constexpr size_t WS_B4 = 208 * MiB;
constexpr size_t WS_GT = WS_B2, WS_MG = WS_B3;
constexpr size_t WS_FP = 240 * MiB;
constexpr size_t WS_SSP = 242 * MiB;
constexpr size_t WS_DUMMY = 224 * MiB;
constexpr size_t WS_END = 256 * MiB;
#ifndef PROBE_P3
#define PROBE_P3 0
#endif
#ifndef PROBE_CONV
#define PROBE_CONV 0
#endif
#ifndef PROBE_SUB
#define PROBE_SUB 7
#endif
#ifndef PROBE_DUP
#define PROBE_DUP -1
#endif

typedef unsigned short bf16_t;
typedef short bf16x8 __attribute__((ext_vector_type(8)));
typedef float f32x4 __attribute__((ext_vector_type(4)));
typedef unsigned u32x4 __attribute__((ext_vector_type(4)));

__host__ __device__ __forceinline__ float bf2f(bf16_t v) { union { unsigned u; float f; } c; c.u = (unsigned)v << 16; return c.f; }
__host__ __device__ __forceinline__ bf16_t f2bf(float f) { union { unsigned u; float f; } c; c.f = f; unsigned u = c.u; return (bf16_t)((u + 0x7fffu + ((u >> 16) & 1u)) >> 16); }
__device__ __forceinline__ float bfr(float f) { return bf2f(f2bf(f)); }
__device__ __forceinline__ float sigm(float x) { return 1.f / (1.f + __expf(-x)); }
__device__ __forceinline__ float siluf(float x) { return x * sigm(x); }

__host__ __device__ __forceinline__ int g1_col(int n) {
    const int j = n >> 8, lc = n & 255;
    if (j < 4) return lc < 128 ? OC_AIN + 128 * j + lc : OC_AIN + 512 + 128 * j + (lc - 128);
    if (j < 6) return OC_AZ + 256 * (j - 4) + lc;
    if (j < 8 || (j >= 10 && j < 12)) { const int k = j < 8 ? j - 6 : j - 8; return lc < 128 ? OC_U + 128 * k + lc : OC_BZ + 128 * k + (lc - 128); }
    if (j < 10) return OC_V + 256 * (j - 8) + lc;
    if (j < 16) { const int isk = j >= 14, jj = (j - 12) & 1, head = 4 * jj + ((lc >> 5) & 3), d = 32 * (lc >> 7) + (lc & 31); return (isk ? OC_K : OC_Q) + 64 * head + d; }
    if (j < 18) return OC_VA + 256 * (j - 16) + lc;
    return OC_CZ + 256 * (j - 18) + lc;
}

struct Ptrs {
    const float *x, *norm_g, *w_in, *b_gate, *conv_w, *conv_b, *cn_g, *cn_b, *w_a, *gn_g, *w_s, *b_s, *w_b, *qn_g, *kn_g, *b_f, *w_c, *w_out;
    float* out; unsigned char* ws;
};

__global__ void nv_prep(Ptrs P) {
    const size_t gid = (size_t)blockIdx.x * blockDim.x + threadIdx.x, gsz = (size_t)gridDim.x * blockDim.x;
    for (int l = 0; l < NL; ++l) {
        unsigned char* wl = P.ws + WS_W + (size_t)l * W_LAYER;
        bf16_t* W1 = (bf16_t*)(wl + WO_W1); bf16_t* WG = (bf16_t*)(wl + WO_WG); bf16_t* WAB = (bf16_t*)(wl + WO_WAB); bf16_t* WC = (bf16_t*)(wl + WO_WC); bf16_t* WO = (bf16_t*)(wl + WO_WO);
        const float* win = P.w_in + (size_t)l * D * NIN;
        for (size_t i = gid; i < (size_t)N1 * D; i += gsz) { const int n = (int)(i >> 10), k = (int)(i & 1023); W1[i] = f2bf(win[(size_t)k * NIN + g1_col(n)]); }
        for (size_t i = gid; i < (size_t)3072 * D; i += gsz) { const int n = (int)(i >> 10), k = (int)(i & 1023); WG[i] = f2bf(win[(size_t)k * NIN + n]); }
        for (size_t i = gid; i < (size_t)1024 * 1024; i += gsz) { const int n = (int)(i >> 10), k = (int)(i & 1023);
            WAB[i] = f2bf(k < 512 ? P.w_a[((size_t)l * DA + k) * D + n] : P.w_b[((size_t)l * DB + (k - 512)) * D + n]);
            WC[i] = k < 512 ? f2bf(P.w_c[((size_t)l * DC + k) * D + n]) : (bf16_t)0;
            WO[i] = f2bf(P.w_out[((size_t)l * D + k) * D + n]); }
        bf16_t* WSB = (bf16_t*)(P.ws + WS_WSB) + (size_t)l * NG * CHK * CHK;
        for (size_t i = gid; i < (size_t)NG * CHK * CHK; i += gsz) { const int s = (int)(i & 127), t = (int)((i >> 7) & 127); WSB[i] = s <= t ? f2bf(P.w_s[(size_t)l * NG * CHK * CHK + i]) : (bf16_t)0; }
    }
}

__device__ __forceinline__ float wave_sum(float v) {
#pragma unroll
    for (int o = 1; o < 64; o <<= 1) v += __shfl_xor(v, o);
    return v;
}

__global__ void nv_ln(Ptrs P, int l, const float* xin) {
    const int lane = threadIdx.x & 63, row = blockIdx.x * 4 + (threadIdx.x >> 6);
    const float* xr = xin + (size_t)row * D; const float* g = P.norm_g + (size_t)l * D; const float* win = P.w_in + (size_t)l * D * NIN;
    float v[16]; float ss = 0.f;
#pragma unroll
    for (int j = 0; j < 16; ++j) { v[j] = xr[lane + 64 * j]; ss += v[j] * v[j]; }
    ss = wave_sum(ss);
    const float r = rsqrtf(ss * (1.f / D) + EPS);
    bf16_t* h = (bf16_t*)(P.ws + WS_H) + (size_t)row * D;
    float f[8] = {0, 0, 0, 0, 0, 0, 0, 0};
#pragma unroll
    for (int j = 0; j < 16; ++j) { const int k = lane + 64 * j; const float hv = v[j] * r * g[k]; h[k] = f2bf(hv);
#pragma unroll
        for (int e = 0; e < 8; ++e) f[e] += hv * win[(size_t)k * NIN + OC_F + e]; }
#pragma unroll
    for (int e = 0; e < 8; ++e) f[e] = wave_sum(f[e]);
    if (lane < 8) { float z = 0.f;
#pragma unroll
        for (int e = 0; e < 8; ++e) if (lane == e) z = f[e];
        z += P.b_f[l * NH + lane];
        const float lf = fminf(z, 0.f) - log1pf(expf(-fabsf(z)));
        ((float*)(P.ws + WS_LOGF))[(size_t)row * 8 + lane] = lf; }
}

__global__ void nv_scan(Ptrs P) {
    __shared__ float buf[SEQ];
    const int bh = blockIdx.x, b = bh / NH, h = bh % NH;
    const float* lf = (const float*)(P.ws + WS_LOGF);
    for (int t = threadIdx.x; t < SEQ; t += blockDim.x) buf[t] = lf[((size_t)b * SEQ + t) * 8 + h];
    __syncthreads();
    if (threadIdx.x == 0) { float c = 0.f; for (int t = 0; t < SEQ; ++t) { c += buf[t]; buf[t] = c * LOG2E; } }
    __syncthreads();
    float* cs = (float*)(P.ws + WS_CS) + (size_t)bh * SEQ;
    for (int t = threadIdx.x; t < SEQ; t += blockDim.x) cs[t] = buf[t];
}

constexpr int TLD = 257;
__device__ __forceinline__ void nv_gemm_acc(const bf16_t* A, int lda, const bf16_t* Bt, int ldb, int K, f32x4 (&acc)[4][4]) {
    const int tid = threadIdx.x, w = tid >> 6, l = tid & 63, fr = l & 15, fq = l >> 4;
#pragma unroll
    for (int m = 0; m < 4; ++m)
#pragma unroll
        for (int n = 0; n < 4; ++n) acc[m][n] = (f32x4){0.f, 0.f, 0.f, 0.f};
    for (int k0 = 0; k0 < K; k0 += 32) {
        bf16x8 a[4], b[4];
#pragma unroll
        for (int m = 0; m < 4; ++m) a[m] = *(const bf16x8*)(A + (size_t)(16 * m + fr) * lda + k0 + 8 * fq);
#pragma unroll
        for (int n = 0; n < 4; ++n) b[n] = *(const bf16x8*)(Bt + (size_t)(64 * w + 16 * n + fr) * ldb + k0 + 8 * fq);
#pragma unroll
        for (int m = 0; m < 4; ++m)
#pragma unroll
            for (int n = 0; n < 4; ++n) acc[m][n] = __builtin_amdgcn_mfma_f32_16x16x32_bf16(a[m], b[n], acc[m][n], 0, 0, 0);
    }
}
__device__ __forceinline__ void nv_gemm_tile(const bf16_t* A, int lda, const bf16_t* Bt, int ldb, int K, float* T) {
    const int tid = threadIdx.x, w = tid >> 6, l = tid & 63, fr = l & 15, fq = l >> 4;
    f32x4 acc[4][4];
    nv_gemm_acc(A, lda, Bt, ldb, K, acc);
#pragma unroll
    for (int m = 0; m < 4; ++m)
#pragma unroll
        for (int n = 0; n < 4; ++n)
#pragma unroll
            for (int r = 0; r < 4; ++r) T[(16 * m + 4 * fq + r) * TLD + 64 * w + 16 * n + fr] = acc[m][n][r];
}

__global__ void __launch_bounds__(256) nv_gemm1(Ptrs P, int l) {
    extern __shared__ float T[];
    __shared__ float R[64 * 4];
    const int j = blockIdx.x, row0 = blockIdx.y * 64, tid = threadIdx.x;
    const bf16_t* H = (const bf16_t*)(P.ws + WS_H);
    const bf16_t* W1 = (const bf16_t*)(P.ws + WS_W + (size_t)l * W_LAYER + WO_W1);
    nv_gemm_tile(H + (size_t)row0 * D, D, W1 + (size_t)j * 256 * D, D, D, T);
    __syncthreads();
    bf16_t* B0 = (bf16_t*)(P.ws + WS_B0); bf16_t* B1 = (bf16_t*)(P.ws + WS_B1); bf16_t* B2 = (bf16_t*)(P.ws + WS_B2); bf16_t* B3 = (bf16_t*)(P.ws + WS_B3); bf16_t* B4 = (bf16_t*)(P.ws + WS_B4);
    if (j < 4) {
        for (int e = tid; e < 64 * 128; e += 256) { const int r = e >> 7, c = e & 127; B3[(size_t)(row0 + r) * 1024 + 128 * j + c] = f2bf(T[r * TLD + c] * sigm(T[r * TLD + c + 128])); }
    } else if (j < 12 || j >= 16) {
        bf16_t* dst; int pitch, coff; bool act;
        if (j < 6) { dst = B0; pitch = 1024; coff = 256 * (j - 4); act = true; }
        else if (j < 8) { dst = B0; pitch = 1024; coff = 512 + 256 * (j - 6); act = false; }
        else if (j < 10) { dst = B3; pitch = 1024; coff = 512 + 256 * (j - 8); act = false; }
        else if (j < 12) { dst = B4; pitch = 512; coff = 256 * (j - 10); act = true; }
        else if (j < 18) { dst = B2; pitch = 1024; coff = 256 * (j - 16); act = false; }
        else { dst = B2; pitch = 1024; coff = 512 + 256 * (j - 18); act = true; }
        for (int e = tid; e < 64 * 256; e += 256) { const int r = e >> 8, c = e & 255; const float v = T[r * TLD + c]; dst[(size_t)(row0 + r) * pitch + coff + c] = f2bf(act ? siluf(v) : v); }
        if (j == 8 || j == 9) { const int r = tid >> 2, wc = tid & 3; float s = 0.f;
            for (int bj = 0; bj < 2; ++bj) for (int i = 0; i < 32; ++i) { const float v = T[r * TLD + 128 * bj + 32 * wc + i]; s += v * v; }
            ((float*)(P.ws + WS_VSS))[(size_t)(row0 + r) * 8 + (j - 8) * 4 + wc] = s; }
    } else {
        const bool isk = j >= 14; const int jj = (j - 12) & 1;
        { const int r = tid >> 2, hh = tid & 3; float s = 0.f;
          for (int d = 0; d < 64; ++d) { const float v = T[r * TLD + 128 * (d >> 5) + 32 * hh + (d & 31)]; s += v * v; }
          R[r * 4 + hh] = rsqrtf(s * (1.f / 64.f) + EPS); }
        __syncthreads();
        const float* gq = (isk ? P.kn_g : P.qn_g) + (size_t)l * HD;
        for (int e = tid; e < 64 * 256; e += 256) { const int r = e >> 8, c = e & 255, hh = (c >> 5) & 3, d = 32 * (c >> 7) + (c & 31);
            float v = T[r * TLD + c] * R[r * 4 + hh] * gq[d]; if (!isk) v *= C2;
            B1[(size_t)(row0 + r) * 1024 + (isk ? 512 : 0) + 64 * (4 * jj + hh) + d] = f2bf(v); }
    }
}

__global__ void __launch_bounds__(512) nv_conv(Ptrs P, int l) {
    __shared__ float red[16];
    const int row = blockIdx.x, t = row % SEQ, c = threadIdx.x, lane = c & 63, w = c >> 6;
    const bf16_t* AG = (const bf16_t*)(P.ws + WS_B3); bf16_t* B0 = (bf16_t*)(P.ws + WS_B0);
    const float* cw = P.conv_w + (size_t)l * CW * DA;
    float a = P.conv_b[l * DA + c];
    for (int j = 0; j < CW; ++j) { const int tt = t - (CW - 1) + j; if (tt >= 0) a += cw[j * DA + c] * bf2f(AG[(size_t)(row - (CW - 1) + j) * 1024 + c]); }
    float s = wave_sum(a); if (lane == 0) red[w] = s; __syncthreads();
    float mu = 0.f; for (int i = 0; i < 8; ++i) mu += red[i]; mu *= (1.f / DA);
    const float d = a - mu; s = wave_sum(d * d); if (lane == 0) red[8 + w] = s; __syncthreads();
    float var = 0.f; for (int i = 0; i < 8; ++i) var += red[8 + i]; var *= (1.f / DA);
    const float y = d * rsqrtf(var + EPS) * P.cn_g[l * DA + c] + P.cn_b[l * DA + c];
    const float az = bf2f(B0[(size_t)row * 1024 + c]);
    B0[(size_t)row * 1024 + c] = f2bf(siluf(y) * az);
}

__global__ void __launch_bounds__(256) nv_gmlp(Ptrs P, int l) {
    extern __shared__ float vn[];
    const int ch = blockIdx.x, g = blockIdx.y, tid = threadIdx.x; const size_t row0 = (size_t)ch * CHK;
    const bf16_t* V = (const bf16_t*)(P.ws + WS_B3); bf16_t* B0 = (bf16_t*)(P.ws + WS_B0); const bf16_t* BZ = (const bf16_t*)(P.ws + WS_B4);
    const float* vss = (const float*)(P.ws + WS_VSS);
    const bf16_t* WSB = (const bf16_t*)(P.ws + WS_WSB) + ((size_t)l * NG + g) * CHK * CHK;
    for (int e = tid; e < 128 * 128; e += 256) { const int s = e >> 7, c = e & 127; const float* q = vss + (row0 + s) * 8;
        const float ss = ((q[0] + q[1]) + (q[2] + q[3])) + ((q[4] + q[5]) + (q[6] + q[7])); const float rv = rsqrtf(ss * (1.f / DB) + EPS);
        vn[s * 129 + c] = bfr(bf2f(V[(row0 + s) * 1024 + 512 + 128 * g + c]) * rv * P.gn_g[l * DB + 128 * g + c]); }
    __syncthreads();
    for (int e = tid; e < 128 * 128; e += 256) { const int t = e >> 7, c = e & 127; float acc = 0.f;
        for (int s = 0; s <= t; ++s) acc += bf2f(WSB[t * 128 + s]) * vn[s * 129 + c];
        acc += P.b_s[((size_t)l * NG + g) * CHK + t];
        const size_t o = (row0 + t) * 1024 + 512 + 128 * g + c;
        B0[o] = f2bf(bf2f(B0[o]) * acc * bf2f(BZ[(row0 + t) * 512 + 128 * g + c])); }
}

__global__ void __launch_bounds__(256) nv_attn(Ptrs P) {
    extern __shared__ float sc[];
    const int lane = threadIdx.x & 63, w = threadIdx.x >> 6; const int item = blockIdx.x * 4 + w, row = item >> 3, h = item & 7, b = row / SEQ, t = row % SEQ;
    float* s = sc + w * SEQ;
    bf16_t* B1 = (bf16_t*)(P.ws + WS_B1); const bf16_t* B2 = (const bf16_t*)(P.ws + WS_B2);
    const float* cs = (const float*)(P.ws + WS_CS) + (size_t)(b * NH + h) * SEQ;
    float q[64];
#pragma unroll
    for (int d = 0; d < 64; ++d) q[d] = bf2f(B1[(size_t)row * 1024 + 64 * h + d]);
    const float cq = cs[t]; float mx = -INFINITY;
    for (int k = lane; k <= t; k += 64) { const bf16_t* kr = B1 + ((size_t)b * SEQ + k) * 1024 + 512 + 64 * h; float dot = 0.f;
#pragma unroll
        for (int d8 = 0; d8 < 8; ++d8) { const bf16x8 kv = *(const bf16x8*)(kr + 8 * d8);
#pragma unroll
            for (int e = 0; e < 8; ++e) dot += q[8 * d8 + e] * bf2f((bf16_t)kv[e]); }
        const float v = dot + (cq - cs[k]); s[k] = v; mx = fmaxf(mx, v); }
#pragma unroll
    for (int o = 1; o < 64; o <<= 1) mx = fmaxf(mx, __shfl_xor(mx, o));
    float lsum = 0.f;
    for (int k = lane; k <= t; k += 64) { const float p = exp2f(s[k] - mx); lsum += p; s[k] = bfr(p); }
    lsum = wave_sum(lsum);
    __builtin_amdgcn_s_waitcnt(0); __builtin_amdgcn_wave_barrier();
    float o = 0.f; const bf16_t* vb = B2 + (size_t)b * SEQ * 1024 + 64 * h + lane;
    for (int k = 0; k <= t; ++k) o += s[k] * bf2f(vb[(size_t)k * 1024]);
    const float cz = bf2f(B2[(size_t)row * 1024 + 512 + 64 * h + lane]);
    B1[(size_t)row * 1024 + 64 * h + lane] = f2bf(o / lsum * cz);
}

__global__ void __launch_bounds__(256) nv_merge(Ptrs P, int l) {
    extern __shared__ float T[];
    const int pn = blockIdx.x, row0 = blockIdx.y * 64, tid = threadIdx.x, w = tid >> 6, ln = tid & 63, fr = ln & 15, fq = ln >> 4;
    const unsigned char* wl = P.ws + WS_W + (size_t)l * W_LAYER;
    const bf16_t* H = (const bf16_t*)(P.ws + WS_H); const bf16_t* WG = (const bf16_t*)(wl + WO_WG); const bf16_t* WAB = (const bf16_t*)(wl + WO_WAB); const bf16_t* WC = (const bf16_t*)(wl + WO_WC);
    const bf16_t* B0 = (const bf16_t*)(P.ws + WS_B0); const bf16_t* B1 = (const bf16_t*)(P.ws + WS_B1);
    float* G = T; float* MGs = T + 64 * 256;
    f32x4 acc[4][4];
    for (int br = 0; br < 3; ++br) {
        nv_gemm_acc(H + (size_t)row0 * D, D, WG + ((size_t)br * 1024 + 256 * pn) * D, D, D, acc);
#pragma unroll
        for (int m = 0; m < 4; ++m)
#pragma unroll
            for (int n = 0; n < 4; ++n)
#pragma unroll
                for (int r = 0; r < 4; ++r) { const int c = 64 * w + 16 * n + fr; G[((m * 4 + n) * 4 + r) * 256 + tid] = bfr(sigm(acc[m][n][r] + P.b_gate[(size_t)l * 3072 + br * 1024 + 256 * pn + c])); }
        const bf16_t* A = br == 0 ? B0 : (br == 1 ? B0 + 512 : B1); const bf16_t* Bt = br == 0 ? WAB : (br == 1 ? WAB + 512 : WC);
        nv_gemm_acc(A + (size_t)row0 * 1024, 1024, Bt + (size_t)256 * pn * 1024, 1024, 512, acc);
#pragma unroll
        for (int m = 0; m < 4; ++m)
#pragma unroll
            for (int n = 0; n < 4; ++n)
#pragma unroll
                for (int r = 0; r < 4; ++r) { const int s = ((m * 4 + n) * 4 + r) * 256 + tid; const float v = G[s] * acc[m][n][r]; MGs[s] = bfr(br == 0 ? v : MGs[s] + v); }
    }
    bf16_t* MG = (bf16_t*)(P.ws + WS_MG);
#pragma unroll
    for (int m = 0; m < 4; ++m)
#pragma unroll
        for (int n = 0; n < 4; ++n)
#pragma unroll
            for (int r = 0; r < 4; ++r) MG[(size_t)(row0 + 16 * m + 4 * fq + r) * 1024 + 256 * pn + 64 * w + 16 * n + fr] = f2bf(MGs[((m * 4 + n) * 4 + r) * 256 + tid]);
}

__global__ void __launch_bounds__(256) nv_out(Ptrs P, int l, const float* xin, float* xout) {
    const int pn = blockIdx.x, row0 = blockIdx.y * 64, tid = threadIdx.x, w = tid >> 6, ln = tid & 63, fr = ln & 15, fq = ln >> 4;
    const bf16_t* MG = (const bf16_t*)(P.ws + WS_MG); const bf16_t* WO = (const bf16_t*)(P.ws + WS_W + (size_t)l * W_LAYER + WO_WO);
    f32x4 acc[4][4];
    nv_gemm_acc(MG + (size_t)row0 * 1024, 1024, WO + (size_t)256 * pn * 1024, 1024, 1024, acc);
#pragma unroll
    for (int m = 0; m < 4; ++m)
#pragma unroll
        for (int n = 0; n < 4; ++n)
#pragma unroll
            for (int r = 0; r < 4; ++r) { const size_t o = (size_t)(row0 + 16 * m + 4 * fq + r) * D + 256 * pn + 64 * w + 16 * n + fr; xout[o] = xin[o] + acc[m][n][r]; }
}


#define LAS __attribute__((address_space(3)))
#define GAS __attribute__((address_space(1)))
__device__ __forceinline__ float wsum(float v) {
    v += __builtin_bit_cast(float, __builtin_amdgcn_update_dpp(0, __builtin_bit_cast(int, v), 0xB1, 0xF, 0xF, true));
    v += __builtin_bit_cast(float, __builtin_amdgcn_update_dpp(0, __builtin_bit_cast(int, v), 0x4E, 0xF, 0xF, true));
    v += __builtin_bit_cast(float, __builtin_amdgcn_update_dpp(0, __builtin_bit_cast(int, v), 0x141, 0xF, 0xF, true));
    v += __builtin_bit_cast(float, __builtin_amdgcn_update_dpp(0, __builtin_bit_cast(int, v), 0x140, 0xF, 0xF, true));
    const int iv = __builtin_bit_cast(int, v);
    return (__builtin_bit_cast(float, __builtin_amdgcn_readlane(iv, 0)) + __builtin_bit_cast(float, __builtin_amdgcn_readlane(iv, 16))) + (__builtin_bit_cast(float, __builtin_amdgcn_readlane(iv, 32)) + __builtin_bit_cast(float, __builtin_amdgcn_readlane(iv, 48)));
}
typedef GAS unsigned gu32;
#define RLX_AGENT __ATOMIC_RELAXED, __HIP_MEMORY_SCOPE_AGENT
#define LDS_WAIT() asm volatile("s_waitcnt lgkmcnt(0)" ::: "memory")
#define VM_WAIT() asm volatile("s_waitcnt vmcnt(0)" ::: "memory")
constexpr int NWAVES = 8;
constexpr int RING_OFF = 0, RING_BYTES = 131072;
constexpr int LDS_BYTES = 163840;
constexpr int LDSCTL_OFF = LDS_BYTES - 512, MISC_OFF = LDSCTL_OFF + 320;
constexpr int RT_OFF = LDSCTL_OFF - 1024;
constexpr int CW_TMO = 0, CW_CODE = 1, CW_BAR = 4096;
constexpr float SKIP_L2 = 160.f;
constexpr int NPH = 10;

__device__ __forceinline__ unsigned cvt_pk_bf16(float lo, float hi) { unsigned r; asm volatile("v_cvt_pk_bf16_f32 %0, %1, %2" : "=v"(r) : "v"(lo), "v"(hi)); return r; }
__device__ __forceinline__ float fsigm(float x) { return __builtin_amdgcn_rcpf(1.f + __builtin_amdgcn_exp2f(-LOG2E * x)); }
__device__ __forceinline__ u32x4 pack8(const f32x4& a, const f32x4& b) { u32x4 w; w.x = cvt_pk_bf16(a[0], a[1]); w.y = cvt_pk_bf16(a[2], a[3]); w.z = cvt_pk_bf16(b[0], b[1]); w.w = cvt_pk_bf16(b[2], b[3]); return w; }
__device__ __forceinline__ void unpack8(const u32x4& w, f32x4& a, f32x4& b) {
    a[0] = __uint_as_float(w.x << 16); a[1] = __uint_as_float(w.x & 0xffff0000u); a[2] = __uint_as_float(w.y << 16); a[3] = __uint_as_float(w.y & 0xffff0000u);
    b[0] = __uint_as_float(w.z << 16); b[1] = __uint_as_float(w.z & 0xffff0000u); b[2] = __uint_as_float(w.w << 16); b[3] = __uint_as_float(w.w & 0xffff0000u); }

namespace pg8 {
constexpr int BM = 256, BK = 64, HALF = 128, HTB = HALF * BK * 2, STAGE_BYTES = 8 * HTB, NXCD = 8, WGM = 8, PITCH = 1024;
__host__ __device__ __forceinline__ int lds_byte(int r, int c) { const int st = (r >> 4) * 2 + (c >> 5), rr = r & 15, cc = c & 31, ob = rr * 64 + cc * 2; return st * 1024 + (ob ^ (((ob >> 9) & 1) << 5)); }
__host__ __device__ __forceinline__ void stage_rc(int b, int& R, int& C) { const int st = b / 1024, sb = b % 1024, swz = sb ^ (((sb >> 9) & 1) << 5); R = (st >> 1) * 16 + swz / 64; C = (st & 1) * 32 + (swz % 64) / 2; }
__host__ __device__ __forceinline__ int perm32(int rho) { const int n = rho >> 4, i = rho & 15; return 8 * (i >> 2) + 4 * n + (i & 3); }

struct Unit { const char* A; const char* B; int nt, pm, pn, tag; };

struct TileOrder {
    int nM, nN, nwg, G, c;
    __device__ __forceinline__ void init(int Mr, int N, int G_, int c_) { nM = Mr / BM; nN = N / BM; nwg = nM * nN; G = G_; c = c_; }
    __device__ __forceinline__ bool tile(int i, int& pm, int& pn) const {
        const long L = (long)i * G + c; if (L >= nwg) return false;
        int wgid = (int)L; { const int q = nwg / NXCD, r = nwg % NXCD, xcd = wgid % NXCD, off = wgid / NXCD; wgid = (xcd < r ? xcd * (q + 1) : r * (q + 1) + (xcd - r) * q) + off; }
        const int nig = WGM * nN, gid = wgid / nig, fm = gid * WGM, gsz = (nM - fm) < WGM ? (nM - fm) : WGM;
        pm = fm + ((wgid % nig) % gsz); pn = (wgid % nig) / gsz; return true;
    }
};

template <class Epi, class Sched>
__device__ __forceinline__ void gemm_phase(LAS unsigned char* lds, const Sched& S, const Epi& E) {
    int tid = threadIdx.x; asm volatile("" : "+v"(tid));
    const int wid = __builtin_amdgcn_readfirstlane(tid >> 6), lane = tid & 63, wr = wid >> 2, wc = wid & 3, fr = lane & 15, fq = lane >> 4;
    unsigned voffA[2], voffB[2];
#pragma unroll
    for (int i = 0; i < 2; ++i) { int R, C; stage_rc(tid * 16 + i * 8192, R, C); const int Rb = (R & ~31) + perm32(R & 31);
        voffA[i] = (unsigned)(R * PITCH + C) * 2u; voffB[i] = (unsigned)(Rb * PITCH + C) * 2u; }
    const size_t kstep = (size_t)(BK * 2);
    const size_t hstep = (size_t)HALF * PITCH * 2;
    const unsigned ldsw = (unsigned)wid * 1024u;
    const int aoff = lds_byte(wr * 64 + fr, fq * 8), boff = lds_byte(wc * 32 + fr, fq * 8);
#define PG8_SA(b, h) (((b) * 2 + (h)) * HTB)
#define PG8_SB(b, h) ((4 + (b) * 2 + (h)) * HTB)
#define PG8_STAGE(bufoff, gbase, voff) do { _Pragma("unroll") for (int _i = 0; _i < 2; ++_i) \
        __builtin_amdgcn_global_load_lds((const unsigned*)((const char*)(gbase) + (voff)[_i]), (LAS unsigned*)(lds + (bufoff) + ldsw + _i * 8192), 16, 0, 0); } while (0)
#define PG8_LDA(dst, b, h) do { _Pragma("unroll") for (int m = 0; m < 4; ++m) _Pragma("unroll") for (int k = 0; k < 2; ++k) dst[m][k] = *(const LAS bf16x8*)(lds + PG8_SA(b, h) + aoff + m * 2048 + k * 1024); } while (0)
#define PG8_LDB(dst, b, h) do { _Pragma("unroll") for (int n = 0; n < 2; ++n) _Pragma("unroll") for (int k = 0; k < 2; ++k) dst[n][k] = *(const LAS bf16x8*)(lds + PG8_SB(b, h) + boff + n * 2048 + k * 1024); } while (0)
#define PG8_MMA(ai, bj, At, Bt) do { __builtin_amdgcn_s_setprio(1); _Pragma("unroll") for (int m = 0; m < 4; ++m) _Pragma("unroll") for (int n = 0; n < 2; ++n) _Pragma("unroll") for (int k = 0; k < 2; ++k) \
        acc[ai][bj][m][n] = __builtin_amdgcn_mfma_f32_16x16x32_bf16(Bt[n][k], At[m][k], acc[ai][bj][m][n], 0, 0, 0); __builtin_amdgcn_s_setprio(0); } while (0)
#define PG8_WAIT_V(n) asm volatile("s_waitcnt vmcnt(" #n ")" ::: "memory")
#define PG8_WAIT_L(n) asm volatile("s_waitcnt lgkmcnt(" #n ")" ::: "memory")
#define PG8_BAR __builtin_amdgcn_s_barrier()
#define PG8_SCHED __builtin_amdgcn_sched_barrier(0)
    Unit cur, nxt; int ui = 0;
    if (!S.next(0, cur)) return;
    f32x4 acc[2][2][4][2];
#pragma unroll
    for (int a = 0; a < 2; ++a)
#pragma unroll
        for (int b = 0; b < 2; ++b)
#pragma unroll
            for (int m = 0; m < 4; ++m)
#pragma unroll
                for (int n = 0; n < 2; ++n) acc[a][b][m][n] = (f32x4){0.f, 0.f, 0.f, 0.f};
    bf16x8 At[4][2], B0[2][2], B1[2][2];
    const char* cA = cur.A; const char* cB = cur.B;
    PG8_STAGE(PG8_SB(0, 0), cB, voffB); PG8_STAGE(PG8_SB(0, 1), cB + hstep, voffB); PG8_STAGE(PG8_SA(0, 0), cA, voffA); PG8_STAGE(PG8_SA(0, 1), cA + hstep, voffA);
    if (wr == 1) PG8_BAR;
    PG8_WAIT_V(2); PG8_BAR;
    PG8_STAGE(PG8_SB(1, 0), cB + kstep, voffB); PG8_STAGE(PG8_SA(1, 0), cA + kstep, voffA); PG8_STAGE(PG8_SB(1, 1), cB + hstep + kstep, voffB);
    PG8_WAIT_V(6); PG8_BAR;
    for (;;) {
        const bool has_next = S.next(ui + 1, nxt);
        const char* nA = has_next ? nxt.A : cA; const char* nB = has_next ? nxt.B : cB;
        const int nt = cur.nt;
        for (int t = 0; t < nt; t += 2) {
            const bool last = (t == nt - 2);
            const char* a1 = cA + (size_t)(t + 1) * kstep;
            const char* a2 = last ? nA : cA + (size_t)(t + 2) * kstep; const char* b2 = last ? nB : cB + (size_t)(t + 2) * kstep;
            const char* a3 = a2 + kstep; const char* b3 = b2 + kstep;
            PG8_LDB(B0, 0, 0); PG8_LDB(B1, 0, 1); PG8_SCHED; PG8_LDA(At, 0, 0); PG8_STAGE(PG8_SA(1, 1), a1 + hstep, voffA);
            PG8_WAIT_V(8); PG8_WAIT_L(0); PG8_BAR; PG8_MMA(0, 0, At, B0); PG8_MMA(0, 1, At, B1); PG8_BAR; PG8_SCHED;
            PG8_LDA(At, 0, 1); PG8_STAGE(PG8_SB(0, 0), b2, voffB); PG8_STAGE(PG8_SB(0, 1), b2 + hstep, voffB); PG8_STAGE(PG8_SA(0, 0), a2, voffA);
            PG8_WAIT_V(8); PG8_WAIT_L(0); PG8_BAR; PG8_MMA(1, 0, At, B0); PG8_MMA(1, 1, At, B1); PG8_BAR; PG8_SCHED;
            PG8_LDB(B0, 1, 0); PG8_LDB(B1, 1, 1); PG8_SCHED; PG8_LDA(At, 1, 0); PG8_STAGE(PG8_SA(0, 1), a2 + hstep, voffA);
            PG8_WAIT_V(8); PG8_WAIT_L(0); PG8_BAR; PG8_MMA(0, 0, At, B0); PG8_MMA(0, 1, At, B1); PG8_BAR; PG8_SCHED;
            PG8_LDA(At, 1, 1); PG8_STAGE(PG8_SB(1, 0), b3, voffB); PG8_STAGE(PG8_SB(1, 1), b3 + hstep, voffB); PG8_STAGE(PG8_SA(1, 0), a3, voffA);
            PG8_WAIT_V(8); PG8_WAIT_L(0); PG8_BAR; PG8_MMA(1, 0, At, B0); PG8_MMA(1, 1, At, B1); PG8_BAR; PG8_SCHED;
        }
        if (wr == 0) PG8_BAR;
        E(acc, cur, wr, wc, fr, fq);
        if (!has_next) break;
#pragma unroll
        for (int a = 0; a < 2; ++a)
#pragma unroll
            for (int b = 0; b < 2; ++b)
#pragma unroll
                for (int m = 0; m < 4; ++m)
#pragma unroll
                    for (int n = 0; n < 2; ++n) acc[a][b][m][n] = (f32x4){0.f, 0.f, 0.f, 0.f};
        cur = nxt; cA = nA; cB = nB; ++ui;
        if (wr == 1) PG8_BAR;
    }
    PG8_WAIT_V(0);
    PG8_BAR;
    E.after(acc, cur, lds, wr, wc, fr, fq);
#undef PG8_SA
#undef PG8_SB
#undef PG8_STAGE
#undef PG8_LDA
#undef PG8_LDB
#undef PG8_MMA
#undef PG8_WAIT_V
#undef PG8_WAIT_L
#undef PG8_BAR
#undef PG8_SCHED
}

struct EpiG1 {
    bf16_t *B0, *B1, *B2, *B3, *B4; float* vss; const float *gq, *gk; const LAS float* R;
    __device__ __forceinline__ void after(f32x4 (&)[2][2][4][2], const Unit&, LAS unsigned char*, int, int, int, int) const {}
    __device__ __forceinline__ void operator()(f32x4 (&acc)[2][2][4][2], const Unit& u, int wr, int wc, int fr, int fq) const {
        const int j = u.pn; const size_t rowb = (size_t)u.pm * BM + wr * 64 + fr; const int cl = 32 * wc + 8 * fq;
#pragma unroll
        for (int ai = 0; ai < 2; ++ai)
#pragma unroll
            for (int m = 0; m < 4; ++m) { const float rs = R[ai * HALF + wr * 64 + m * 16 + fr];
#pragma unroll
                for (int bj = 0; bj < 2; ++bj) { acc[ai][bj][m][0] *= rs; acc[ai][bj][m][1] *= rs; } }
        const bool ubz = (j == 6 || j == 7 || j == 10 || j == 11);
        if (j < 4 || ubz) {
            bf16_t* dst = ubz ? B0 + 512 + 128 * (j < 8 ? j - 6 : j - 8) : B3 + 128 * j;
#pragma unroll
            for (int ai = 0; ai < 2; ++ai)
#pragma unroll
                for (int m = 0; m < 4; ++m) { f32x4 o0, o1;
#pragma unroll
                    for (int e = 0; e < 4; ++e) { const float g0 = acc[ai][1][m][0][e], g1 = acc[ai][1][m][1][e]; const float s0 = fsigm(g0), s1 = fsigm(g1);
                        o0[e] = acc[ai][0][m][0][e] * (ubz ? g0 * s0 : s0); o1[e] = acc[ai][0][m][1][e] * (ubz ? g1 * s1 : s1); }
                    *(u32x4*)(dst + (rowb + ai * HALF + m * 16) * 1024 + cl) = pack8(o0, o1); }
        } else if (j < 12 || j >= 16) {
            bf16_t* dst; int pitch, coff; bool act;
            if (j < 6) { dst = B0; pitch = 1024; coff = 256 * (j - 4); act = true; }
            else if (j < 8) { dst = B0; pitch = 1024; coff = 512 + 256 * (j - 6); act = false; }
            else if (j < 10) { dst = B3; pitch = 1024; coff = 512 + 256 * (j - 8); act = false; }
            else if (j < 12) { dst = B4; pitch = 512; coff = 256 * (j - 10); act = true; }
            else if (j < 18) { dst = B2; pitch = 1024; coff = 256 * (j - 16); act = false; }
            else { dst = B2; pitch = 1024; coff = 512 + 256 * (j - 18); act = true; }
            const bool stat = (j == 8 || j == 9);
#pragma unroll
            for (int ai = 0; ai < 2; ++ai)
#pragma unroll
                for (int m = 0; m < 4; ++m) { const size_t row = rowb + ai * HALF + m * 16; float s = 0.f;
#pragma unroll
                    for (int bj = 0; bj < 2; ++bj) { f32x4 v0 = acc[ai][bj][m][0], v1 = acc[ai][bj][m][1];
                        if (act) {
#pragma unroll
                            for (int e = 0; e < 4; ++e) { v0[e] = v0[e] * fsigm(v0[e]); v1[e] = v1[e] * fsigm(v1[e]); } }
                        s += (v0[0] * v0[0] + v0[1] * v0[1]) + (v0[2] * v0[2] + v0[3] * v0[3]) + (v1[0] * v1[0] + v1[1] * v1[1]) + (v1[2] * v1[2] + v1[3] * v1[3]);
                        *(u32x4*)(dst + row * pitch + coff + 128 * bj + cl) = pack8(v0, v1); }
                    if (stat) { s += __shfl_xor(s, 16); s += __shfl_xor(s, 32); if (fq == 0) vss[row * 8 + (j - 8) * 4 + wc] = s; } }
        } else {
            const bool isk = j >= 14; const int jj = (j - 12) & 1; const float* g = isk ? gk : gq; const float sc = isk ? 1.f : C2;
            f32x4 gv[2][2];
#pragma unroll
            for (int bj = 0; bj < 2; ++bj) { gv[bj][0] = *(const f32x4*)(g + 32 * bj + 8 * fq) * sc; gv[bj][1] = *(const f32x4*)(g + 32 * bj + 8 * fq + 4) * sc; }
            bf16_t* dst = B1 + (isk ? 512 : 0) + 64 * (4 * jj + wc) + 8 * fq;
#pragma unroll
            for (int ai = 0; ai < 2; ++ai)
#pragma unroll
                for (int m = 0; m < 4; ++m) { const size_t row = rowb + ai * HALF + m * 16; float s = 0.f;
#pragma unroll
                    for (int bj = 0; bj < 2; ++bj) { const f32x4 v0 = acc[ai][bj][m][0], v1 = acc[ai][bj][m][1];
                        s += (v0[0] * v0[0] + v0[1] * v0[1]) + (v0[2] * v0[2] + v0[3] * v0[3]) + (v1[0] * v1[0] + v1[1] * v1[1]) + (v1[2] * v1[2] + v1[3] * v1[3]); }
                    s += __shfl_xor(s, 16); s += __shfl_xor(s, 32);
                    const float r = __builtin_amdgcn_rsqf(s * (1.f / 64.f) + EPS);
#pragma unroll
                    for (int bj = 0; bj < 2; ++bj) *(u32x4*)(dst + row * 1024 + 32 * bj) = pack8(acc[ai][bj][m][0] * r * gv[bj][0], acc[ai][bj][m][1] * r * gv[bj][1]); }
        }
    }
};
struct EpiMerge {
    unsigned char* gt; bf16_t* MG; const float* bgate; const LAS float* R; int cls; size_t gt2off; bool pv_;
    __device__ __forceinline__ void after(f32x4 (&)[2][2][4][2], const Unit&, LAS unsigned char*, int, int, int, int) const {}
    __device__ __forceinline__ void operator()(f32x4 (&acc)[2][2][4][2], const Unit& u, int wr, int wc, int fr, int fq) const {
        const int tag = u.tag, br = tag >> 1; const size_t rowb = (size_t)u.pm * BM + wr * 64 + fr; const int col0 = u.pn * BM + 32 * wc + 8 * fq;
        if (PROBE_P3 == 2 && pv_) return;
        if (PROBE_P3 == 1 && pv_ && (tag & 1)) return;
        u32x4* slots_ = (u32x4*)(gt + ((cls && br == 1) ? gt2off : (size_t)0)) + ((wr * 4 + wc) * 64 + fq * 16 + fr); asm volatile("" : "+v"(slots_)); __attribute__((address_space(1))) u32x4* slots = (__attribute__((address_space(1))) u32x4*)slots_;
        if ((tag & 1) == 0) {
            f32x4 bv[2][2];
#pragma unroll
            for (int bj = 0; bj < 2; ++bj) { bv[bj][0] = *(const f32x4*)(bgate + br * 1024 + col0 + 128 * bj); bv[bj][1] = *(const f32x4*)(bgate + br * 1024 + col0 + 128 * bj + 4); }
#pragma unroll
            for (int ai = 0; ai < 2; ++ai)
#pragma unroll
                for (int m = 0; m < 4; ++m)
#pragma unroll
                    for (int bj = 0; bj < 2; ++bj) { const float rs = R[ai * HALF + wr * 64 + m * 16 + fr]; f32x4 v0 = acc[ai][bj][m][0] * rs + bv[bj][0], v1 = acc[ai][bj][m][1] * rs + bv[bj][1];
#pragma unroll
                        for (int e = 0; e < 4; ++e) { v0[e] = fsigm(v0[e]); v1[e] = fsigm(v1[e]); }
                        slots[(size_t)(((ai * 4 + m) * 2 + bj) * 512)] = pack8(v0, v1); }
        } else {
#pragma unroll
            for (int ai = 0; ai < 2; ++ai)
#pragma unroll
                for (int m = 0; m < 4; ++m) {
#pragma unroll
                    for (int bj = 0; bj < 2; ++bj) { const u32x4 gw = slots[(size_t)(((ai * 4 + m) * 2 + bj) * 512)]; f32x4 g0, g1; unpack8(gw, g0, g1);
                        f32x4 v0 = g0 * acc[ai][bj][m][0], v1 = g1 * acc[ai][bj][m][1];
                        u32x4* p = (u32x4*)(MG + (rowb + ai * HALF + m * 16) * 1024 + col0 + 128 * bj);
                        if (br > 0) { const u32x4 ow = *p; f32x4 p0, p1; unpack8(ow, p0, p1); v0 += p0; v1 += p1; }
                        *p = pack8(v0, v1); }
                    if (m & 1) asm volatile("" ::: "memory"); }
        }
    }
};
struct EpiOutB {
    const bf16_t* base; float* out;
    __device__ __forceinline__ void after(f32x4 (&)[2][2][4][2], const Unit&, LAS unsigned char*, int, int, int, int) const {}
    __device__ __forceinline__ void operator()(f32x4 (&acc)[2][2][4][2], const Unit& u, int wr, int wc, int fr, int fq) const {
        const size_t rowb = (size_t)u.pm * BM + wr * 64 + fr; const int col0 = u.pn * BM + 32 * wc + 8 * fq;
#pragma unroll
        for (int ai = 0; ai < 2; ++ai)
#pragma unroll
            for (int m = 0; m < 4; ++m) {
#pragma unroll
                for (int bj = 0; bj < 2; ++bj) { const size_t o = (rowb + ai * HALF + m * 16) * D + col0 + 128 * bj;
                    f32x4 b0, b1; unpack8(*(const u32x4*)(base + o), b0, b1);
                    *(f32x4*)(out + o) = b0 + acc[ai][bj][m][0]; *(f32x4*)(out + o + 4) = b1 + acc[ai][bj][m][1]; }
                if (m & 1) asm volatile("" ::: "memory"); }
    }
};
struct EpiOut {
    const float* base; float* out;
    __device__ __forceinline__ void after(f32x4 (&)[2][2][4][2], const Unit&, LAS unsigned char*, int, int, int, int) const {}
    __device__ __forceinline__ void operator()(f32x4 (&acc)[2][2][4][2], const Unit& u, int wr, int wc, int fr, int fq) const {
        const size_t rowb = (size_t)u.pm * BM + wr * 64 + fr; const int col0 = u.pn * BM + 32 * wc + 8 * fq;
#pragma unroll
        for (int ai = 0; ai < 2; ++ai)
#pragma unroll
            for (int m = 0; m < 4; ++m) {
#pragma unroll
                for (int bj = 0; bj < 2; ++bj) { const size_t o = (rowb + ai * HALF + m * 16) * D + col0 + 128 * bj;
                    const f32x4 b0 = *(const f32x4*)(base + o), b1 = *(const f32x4*)(base + o + 4);
                    *(f32x4*)(out + o) = b0 + acc[ai][bj][m][0]; *(f32x4*)(out + o + 4) = b1 + acc[ai][bj][m][1]; }
                if (m & 1) asm volatile("" ::: "memory"); }
    }
};
struct EpiOutLN {
    const float* base; bf16_t* XG; const float* gnext; const float* wfnext; float* SSP; float* FP;
    __device__ __forceinline__ void operator()(f32x4 (&)[2][2][4][2], const Unit&, int, int, int, int) const {}
    __device__ __forceinline__ void after(f32x4 (&acc)[2][2][4][2], const Unit& u, LAS unsigned char* lds, int wr, int wc, int fr, int fq) const {
        const int tid = ((wr * 4 + wc) * 64) + fq * 16 + fr;
        const size_t rowb = (size_t)u.pm * BM + wr * 64 + fr; const int cl = 32 * wc + 8 * fq, col0 = u.pn * BM + cl;
        LAS float* FL = (LAS float*)lds;
        LAS float* WL = (LAS float*)(lds + 512 * 72 * 4);
        for (int i = tid; i < 256 * 8; i += 512) { const int c = i >> 3, e = i & 7; WL[i] = gnext[u.pn * BM + c] * wfnext[(size_t)(u.pn * BM + c) * NIN + e]; }
#pragma unroll
        for (int ai = 0; ai < 2; ++ai)
#pragma unroll
            for (int m = 0; m < 4; ++m) { float ss = 0.f;
#pragma unroll
                for (int bj = 0; bj < 2; ++bj) { const size_t o = (rowb + ai * HALF + m * 16) * D + col0 + 128 * bj;
                    const f32x4 x0 = *(const f32x4*)(base + o) + acc[ai][bj][m][0], x1 = *(const f32x4*)(base + o + 4) + acc[ai][bj][m][1];
                    ss += (x0[0] * x0[0] + x0[1] * x0[1]) + (x0[2] * x0[2] + x0[3] * x0[3]) + (x1[0] * x1[0] + x1[1] * x1[1]) + (x1[2] * x1[2] + x1[3] * x1[3]);
                    *(u32x4*)(XG + o) = pack8(x0, x1);
                    acc[ai][bj][m][0] = x0; acc[ai][bj][m][1] = x1; }
                FL[tid * 72 + 64 + ai * 4 + m] = ss;
                if (m & 1) asm volatile("" ::: "memory"); }
        asm volatile("s_waitcnt lgkmcnt(0)" ::: "memory"); __builtin_amdgcn_s_barrier(); asm volatile("" ::: "memory");
#pragma unroll
        for (int hh = 0; hh < 2; ++hh) {
            f32x4 f[8];
#pragma unroll
            for (int rg = 0; rg < 8; ++rg) f[rg] = (f32x4){0.f, 0.f, 0.f, 0.f};
#pragma unroll
            for (int bj = 0; bj < 2; ++bj)
#pragma unroll
                for (int n = 0; n < 2; ++n)
#pragma unroll
                    for (int i = 0; i < 4; ++i) { const f32x4 wv = *(const LAS f32x4*)(WL + (128 * bj + cl + 4 * n + i) * 8 + 4 * hh);
#pragma unroll
                        for (int ai = 0; ai < 2; ++ai)
#pragma unroll
                            for (int m = 0; m < 4; ++m) f[ai * 4 + m] += acc[ai][bj][m][n][i] * wv; }
#pragma unroll
            for (int rg = 0; rg < 8; ++rg) *(LAS f32x4*)(FL + tid * 72 + rg * 8 + 4 * hh) = f[rg];
            asm volatile("" ::: "memory");
        }
        asm volatile("s_waitcnt lgkmcnt(0)" ::: "memory"); __builtin_amdgcn_s_barrier(); asm volatile("" ::: "memory");
        { const int row = tid & 255, hb = (tid >> 8) * 4, ai_ = row >> 7, wr_ = (row >> 6) & 1, m_ = (row >> 4) & 3, fr_ = row & 15, rg = ai_ * 4 + m_;
          f32x4 sum = (f32x4){0.f, 0.f, 0.f, 0.f}; float ssum = 0.f;
#pragma unroll
          for (int wc_ = 0; wc_ < 4; ++wc_)
#pragma unroll
              for (int fq_ = 0; fq_ < 4; ++fq_) { const LAS float* src = FL + (((wr_ * 4 + wc_) * 64) + fq_ * 16 + fr_) * 72; sum += *(const LAS f32x4*)(src + rg * 8 + hb); ssum += src[64 + rg]; }
          const size_t grow = (size_t)u.pm * BM + row;
          *(f32x4*)(FP + (grow * 4 + u.pn) * 8 + hb) = sum;
          if (hb == 0) SSP[grow * 4 + u.pn] = ssum; }
    }
};
struct SchedG1 { TileOrder T; const char* A; const char* B;
    __device__ __forceinline__ bool next(int i, Unit& u) const { int pm, pn; if (!T.tile(i, pm, pn)) return false; u.pm = pm; u.pn = pn; u.tag = 0; u.nt = 16; u.A = A + (size_t)pm * (BM * PITCH * 2); u.B = B + (size_t)pn * (BM * PITCH * 2); return true; } };
struct SchedMerge { int pm, pn; bool ok; int cls; const char *ws, *wl;
    __device__ __forceinline__ bool next(int i, Unit& u) const { if (!ok || i >= 6) return false;
        const int tag = cls == 0 ? i : (i == 0 ? 0 : i == 1 ? 2 : i == 2 ? 1 : i == 3 ? 4 : i == 4 ? 3 : 5);
        const int br = tag >> 1; u.pm = pm; u.pn = pn; u.tag = tag;
        const size_t ro = (size_t)pm * (BM * PITCH * 2), co = (size_t)pn * (BM * PITCH * 2);
        if ((tag & 1) == 0) { u.nt = 16; u.A = ws + WS_H + ro; u.B = wl + WO_WG + (size_t)br * (1024 * PITCH * 2) + co; }
        else { u.nt = 8; const size_t ao = br == 0 ? WS_B0 : (br == 1 ? WS_B0 + 1024 : WS_B1), bo = br == 0 ? WO_WAB : (br == 1 ? WO_WAB + 1024 : WO_WC); u.A = ws + ao + ro; u.B = wl + bo + co; }
        return true; } };
}

#define XB_TMO      128
#define XB_XCNT(j)  (256  + 64 * (j))
#define XB_XSUB(j)  (1280 + 64 * (j))
#define XB_XGEN(j)  (2304 + 64 * (j))
#define XB_TOP      3328
#define XB_TOPGEN   3392
#define XCD_BAR_WORDS 3456
#define XB_SPIN_CAP (1u << 18)
__device__ __forceinline__ unsigned xb_ld(unsigned* p)              { return __hip_atomic_load(p, __ATOMIC_RELAXED, __HIP_MEMORY_SCOPE_AGENT); }
__device__ __forceinline__ unsigned xb_add(unsigned* p, unsigned v) { return __hip_atomic_fetch_add(p, v, __ATOMIC_RELAXED, __HIP_MEMORY_SCOPE_AGENT); }
__device__ __forceinline__ unsigned xb_xcc_id() { return (unsigned)__builtin_amdgcn_s_getreg((3 << 11) | 20) & 0xFu; }
#define XB_SPIN(cond, bar) do { unsigned _sp = 0; while (cond) { __builtin_amdgcn_s_sleep(1); \
    if ((++_sp & 255u) == 0u) { if (xb_ld(&(bar)[XB_TMO])) break; if (_sp > XB_SPIN_CAP) { atomicAdd(&(bar)[XB_TMO], 1u); break; } } } } while (0)
struct XcdBarrier { unsigned* bar; unsigned x; volatile LAS unsigned* st; };
__device__ __forceinline__ XcdBarrier xcd_barrier_post(unsigned* bar, volatile LAS unsigned* st) {
    XcdBarrier b; b.bar = bar; b.x = xb_xcc_id(); b.st = st;
    if (threadIdx.x == 0) (void)xb_add(&bar[XB_XCNT(b.x)], 1u);
    return b;
}
__device__ __forceinline__ void xcd_barrier_complete(unsigned* bar, unsigned x, unsigned& nloc, unsigned& nx) {
    const unsigned G = gridDim.x * gridDim.y * gridDim.z;
    unsigned sum, cnt, mine, sp = 0u;
    for (;;) {
        sum = 0u; cnt = 0u; mine = 0u;
#pragma unroll
        for (unsigned j = 0; j < 16; ++j) { const unsigned c = xb_ld(&bar[XB_XCNT(j)]); sum += c; cnt += (c > 0u) ? 1u : 0u; mine = (j == x) ? c : mine; }
        if (sum == G) break;
        __builtin_amdgcn_s_sleep(1);
        if ((++sp & 255u) == 0u) { if (xb_ld(&bar[XB_TMO])) break; if (sp > XB_SPIN_CAP) { atomicAdd(&bar[XB_TMO], 1u); break; } }
    }
    nloc = mine > 0u ? mine : 1u; nx = cnt > 0u ? cnt : 1u;
}
__device__ __forceinline__ void xcd_barrier(const XcdBarrier& b) {
    asm volatile("s_waitcnt vmcnt(0)" ::: "memory");
    __syncthreads();
    if (threadIdx.x == 0) {
        unsigned* bar = b.bar;
        __builtin_amdgcn_s_waitcnt(0);
        unsigned nloc = b.st[0], nx = b.st[1];
        if (nloc == 0u) { xcd_barrier_complete(bar, b.x, nloc, nx); b.st[0] = nloc; b.st[1] = nx; }
        const unsigned old = xb_add(&bar[XB_XSUB(b.x)], 1u);
        const unsigned gen = old / nloc;
        if (old + 1u == (gen + 1u) * nloc) {
            __builtin_amdgcn_fence(__ATOMIC_RELEASE, "agent");
            asm volatile("s_waitcnt vmcnt(0)" ::: "memory");
            const unsigned og = xb_add(&bar[XB_TOP], 1u);
            const unsigned tg = og / nx;
            if (og + 1u == (tg + 1u) * nx) xb_add(&bar[XB_TOPGEN], 1u);
            else XB_SPIN(xb_ld(&bar[XB_TOPGEN]) == tg, bar);
            __builtin_amdgcn_fence(__ATOMIC_ACQUIRE, "agent");
            xb_add(&bar[XB_XGEN(b.x)], 1u);
            asm volatile("s_waitcnt vmcnt(0)" ::: "memory");
        } else {
            XB_SPIN(xb_ld(&bar[XB_XGEN(b.x)]) == gen, bar);
            __builtin_amdgcn_fence(__ATOMIC_ACQUIRE, "agent");
            asm volatile("s_waitcnt vmcnt(0)" ::: "memory");
        }
    }
    __syncthreads();
}

struct Args { const float* in[18]; float* out; unsigned char* ws; int ph_lo, ph_hi, li, pad; };
struct Frame { LAS unsigned char* lds; int tid, lane, wave, vcu, G; Ptrs P; };

__device__ __forceinline__ unsigned pk2(float lo, float hi) { return (unsigned)f2bf(lo) | ((unsigned)f2bf(hi) << 16); }
__device__ __forceinline__ void p0_transpose_item(const float* W, int ldw, int src_col, int k0, bf16_t* WT, size_t dst_row, int dst_col, LAS float* scr, int lane, const float* kgain = nullptr) {
#pragma unroll 8
    for (int i = 0; i < 32; ++i) { const int kk = 2 * i + (lane >> 5); scr[kk * 33 + (lane & 31)] = W[(size_t)(k0 + kk) * ldw + src_col + (lane & 31)]; }
    LDS_WAIT(); asm volatile("" ::: "memory");
    const int c = lane & 7;
    f32x4 ga = (f32x4){1.f, 1.f, 1.f, 1.f}, gb = ga; if (kgain) { ga = *(const f32x4*)(kgain + k0 + 8 * c); gb = *(const f32x4*)(kgain + k0 + 8 * c + 4); }
#pragma unroll
    for (int j = 0; j < 4; ++j) { const int n = (lane >> 3) + 8 * j; const LAS float* s = scr + (8 * c) * 33 + n;
        u32x4 o; o.x = pk2(s[0 * 33] * ga.x, s[1 * 33] * ga.y); o.y = pk2(s[2 * 33] * ga.z, s[3 * 33] * ga.w); o.z = pk2(s[4 * 33] * gb.x, s[5 * 33] * gb.y); o.w = pk2(s[6 * 33] * gb.z, s[7 * 33] * gb.w);
        *(GAS u32x4*)(WT + (dst_row + n) * 1024 + dst_col + k0 + 8 * c) = o; }
    LDS_WAIT(); asm volatile("" ::: "memory");
}
__device__ __forceinline__ void p0_weights(Frame& F) {
    LAS float* scr = (LAS float*)(F.lds + RING_OFF + F.wave * 16384);
    const int gw = F.vcu * NWAVES + F.wave, NGW = F.G * NWAVES;
    constexpr int I_W1 = 16 * (N1 / 32), I_WG = 16 * 96, I_Y = 8 * 32, I_WO = 16 * 32, I_L = I_W1 + I_WG + 3 * I_Y + I_WO;
    for (int it = gw; it < NL * I_L; it += NGW) {
        const int l = it / I_L; int r = it % I_L;
        unsigned char* wl = F.P.ws + WS_W + (size_t)l * W_LAYER; const float* win = F.P.w_in + (size_t)l * D * NIN;
        const float* kg = l > 0 ? F.P.norm_g + (size_t)l * D : nullptr;
        if (r < I_W1) { const int kb = r / (N1 / 32), nb = r % (N1 / 32); p0_transpose_item(win, NIN, g1_col(32 * nb), 64 * kb, (bf16_t*)(wl + WO_W1), 32 * nb, 0, scr, F.lane, kg); continue; } r -= I_W1;
        if (r < I_WG) { const int kb = r / 96, nb = r % 96; p0_transpose_item(win, NIN, 32 * nb, 64 * kb, (bf16_t*)(wl + WO_WG), 32 * nb, 0, scr, F.lane, kg); continue; } r -= I_WG;
        if (r < I_Y) { const int kb = r / 32, nb = r % 32; p0_transpose_item(F.P.w_a + (size_t)l * DA * D, D, 32 * nb, 64 * kb, (bf16_t*)(wl + WO_WAB), 32 * nb, 0, scr, F.lane); continue; } r -= I_Y;
        if (r < I_Y) { const int kb = r / 32, nb = r % 32; p0_transpose_item(F.P.w_b + (size_t)l * DB * D, D, 32 * nb, 64 * kb, (bf16_t*)(wl + WO_WAB), 32 * nb, 512, scr, F.lane); continue; } r -= I_Y;
        if (r < I_Y) { const int kb = r / 32, nb = r % 32; p0_transpose_item(F.P.w_c + (size_t)l * DC * D, D, 32 * nb, 64 * kb, (bf16_t*)(wl + WO_WC), 32 * nb, 0, scr, F.lane); continue; } r -= I_Y;
        { const int kb = r / 32, nb = r % 32; p0_transpose_item(F.P.w_out + (size_t)l * D * D, D, 32 * nb, 64 * kb, (bf16_t*)(wl + WO_WO), 32 * nb, 0, scr, F.lane); }
    }
    bf16_t* WSB = (bf16_t*)(F.P.ws + WS_WSB);
    for (int i = (int)blockIdx.x * 512 + F.tid; i < NL * NG * CHK * CHK; i += F.G * 512) { const int s = i & 127, t = (i >> 7) & 127; WSB[i] = s <= t ? f2bf(F.P.w_s[i]) : (bf16_t)0; }
}
__device__ __forceinline__ void p0_ln(Frame& F, int l, const float* xin) {
    LAS float* wf = (LAS float*)(F.lds + RING_OFF);
    const float* g = F.P.norm_g + (size_t)l * D; const float* win = F.P.w_in + (size_t)l * D * NIN;
    __syncthreads();
    for (int i = F.tid; i < D * 8; i += 512) { const int k = i >> 3, e = i & 7; wf[i] = g[k] * win[(size_t)k * NIN + OC_F + e]; }
    __syncthreads();
    const int gw = F.vcu * NWAVES + F.wave, NGW = F.G * NWAVES;
    bf16_t* H = (bf16_t*)(F.P.ws + WS_H); float* LOGF = (float*)(F.P.ws + WS_LOGF);
    f32x4 gv[4];
#pragma unroll
    for (int j = 0; j < 4; ++j) gv[j] = ((const f32x4*)g)[64 * j + F.lane];
    static_assert(M == 8 * 256 * NWAVES, "p0_ln: 8 rows per wave on a 256-workgroup grid");
    float zrow[8];
#pragma unroll
    for (int k = 0; k < 8; ++k) zrow[k] = 0.f;
    f32x4 v[8][4];
#pragma unroll
    for (int bt = 0; bt < 4; ++bt) {
        asm volatile("" ::: "memory");
        if ((bt & 1) == 0) {
#pragma unroll
            for (int k = 2 * bt; k < 2 * bt + 4; ++k) { const GAS f32x4* xr = (const GAS f32x4*)(xin + (size_t)(gw + k * NGW) * D) + F.lane;
#pragma unroll
                for (int j = 0; j < 4; ++j) v[k][j] = xr[64 * j]; }
            asm volatile("" ::: "memory"); }
        float r[2]; float f[2][8];
#pragma unroll
        for (int q = 0; q < 2; ++q) { float ss = 0.f;
#pragma unroll
            for (int j = 0; j < 4; ++j) { const f32x4 x = v[2 * bt + q][j]; ss += (x.x * x.x + x.y * x.y) + (x.z * x.z + x.w * x.w); }
            r[q] = rsqrtf(wsum(ss) * (1.f / D) + EPS);
#pragma unroll
            for (int e = 0; e < 8; ++e) f[q][e] = 0.f; }
#pragma unroll
        for (int j = 0; j < 4; ++j) {
#pragma unroll
            for (int q = 0; q < 2; ++q) { const f32x4 hv = v[2 * bt + q][j] * r[q] * gv[j];
                GAS unsigned long long* o8 = (GAS unsigned long long*)(H + (size_t)(gw + (2 * bt + q) * NGW) * D) + F.lane;
                o8[64 * j] = (unsigned long long)pk2(hv.x, hv.y) | ((unsigned long long)pk2(hv.z, hv.w) << 32); }
#pragma unroll
            for (int i = 0; i < 4; ++i) { const LAS f32x4* w4 = (const LAS f32x4*)(wf + (256 * j + 4 * F.lane + i) * 8); const f32x4 wa = w4[0], wb = w4[1];
#pragma unroll
                for (int q = 0; q < 2; ++q) { const float xv = v[2 * bt + q][j][i];
                    f[q][0] += xv * wa.x; f[q][1] += xv * wa.y; f[q][2] += xv * wa.z; f[q][3] += xv * wa.w; f[q][4] += xv * wb.x; f[q][5] += xv * wb.y; f[q][6] += xv * wb.z; f[q][7] += xv * wb.w; } }
        }
#pragma unroll
        for (int q = 0; q < 2; ++q) {
#pragma unroll
            for (int e = 0; e < 8; ++e) f[q][e] = wsum(f[q][e]);
            if (F.lane < 8) { float z = 0.f;
#pragma unroll
                for (int e = 0; e < 8; ++e) if (F.lane == e) z = f[q][e];
                zrow[2 * bt + q] = z * r[q]; } }
    }
    if (F.lane < 8) { const float bfv = F.P.b_f[l * NH + F.lane];
#pragma unroll
        for (int k = 0; k < 8; ++k) { const float z = zrow[k] + bfv; LOGF[(size_t)(gw + k * NGW) * 8 + F.lane] = fminf(z, 0.f) - log1pf(expf(-fabsf(z))); } }
    __syncthreads();
}
__device__ __forceinline__ void p1_scan(Frame& F, int bh, int l) {
    LAS float* sh = (LAS float*)(F.lds + RING_OFF);
    const int b = bh / NH, h = bh % NH, t0 = F.tid * 8;
    float c[8]; float run = 0.f;
    if (l == 0) { const float* lf = (const float*)(F.P.ws + WS_LOGF) + ((size_t)b * SEQ + t0) * 8 + h;
#pragma unroll
        for (int i = 0; i < 8; ++i) { run += lf[i * 8]; c[i] = run; }
    } else {
        const float* fp = (const float*)(F.P.ws + WS_FP) + ((size_t)b * SEQ + t0) * 32 + h; const float* sp = (const float*)(F.P.ws + WS_SSP) + ((size_t)b * SEQ + t0) * 4; const float bfv = F.P.b_f[l * NH + h];
        float z[8];
#pragma unroll
        for (int i = 0; i < 8; ++i) { const f32x4 q = *(const f32x4*)(sp + i * 4); const float r = rsqrtf(((q.x + q.y) + (q.z + q.w)) * (1.f / D) + EPS);
            z[i] = r * ((fp[i * 32] + fp[i * 32 + 8]) + (fp[i * 32 + 16] + fp[i * 32 + 24])) + bfv; }
#pragma unroll
        for (int i = 0; i < 8; ++i) { run += fminf(z[i], 0.f) - log1pf(expf(-fabsf(z[i]))); c[i] = run; }
    }
    float inc = run;
#pragma unroll
    for (int o = 1; o < 64; o <<= 1) { const float n = __shfl_up(inc, o); if (F.lane >= o) inc += n; }
    if (F.lane == 63) sh[F.wave] = inc;
    __syncthreads();
    float base = inc - run;
    for (int w = 0; w < F.wave; ++w) base += sh[w];
    float* cs = (float*)(F.P.ws + WS_CS) + (size_t)bh * SEQ + t0;
    *(f32x4*)cs = (f32x4){(base + c[0]) * LOG2E, (base + c[1]) * LOG2E, (base + c[2]) * LOG2E, (base + c[3]) * LOG2E};
    *(f32x4*)(cs + 4) = (f32x4){(base + c[4]) * LOG2E, (base + c[5]) * LOG2E, (base + c[6]) * LOG2E, (base + c[7]) * LOG2E};
    __syncthreads();
    LAS float* c2s = sh + 16;
#pragma unroll
    for (int i = 0; i < 8; ++i) c2s[t0 + i] = (base + c[i]) * LOG2E;
    __syncthreads();
    if (F.tid < SEQ / 256) { const int qb = F.tid, nt = 4 * qb + 4; const float cq = c2s[256 * qb]; int lo = 0, hi = nt - 4;
        while (lo < hi) { const int mid = (lo + hi) >> 1; if (cq - c2s[64 * mid + 63] >= -SKIP_L2) hi = mid; else lo = mid + 1; }
        ((int*)(F.P.ws + WS_TS))[bh * 16 + qb] = lo & ~1; }
    __syncthreads();
}


#include <hip/hip_bf16.h>
namespace attn_body {
using bf16=__hip_bfloat16;
using s16x4=__attribute__((ext_vector_type(4)))short;
using f32x16=__attribute__((ext_vector_type(16)))float;
constexpr int NHEAD=NH,D=64,DM=1024;
constexpr int NW=8,QBLK=32,QB=QBLK*NW,KVBLK=64,NQB=SEQ/QB;
__device__ __forceinline__ int crow(int r,int hi){return (r&3)+8*(r>>2)+4*hi;}
#define SBAR() __builtin_amdgcn_sched_barrier(0)
__device__ __forceinline__ void cmask(f32x16&p0,f32x16&p1,int jb,int qrel,int hi){
  const float NEG=-INFINITY; int kb=64*jb+4*hi;
  #pragma unroll
  for(int r=0;r<16;++r){int kv=kb+(r&3)+8*(r>>2); if(kv>qrel)p0[r]=NEG; if(kv+32>qrel)p1[r]=NEG;}
}
constexpr int NSLOT=3, SLOTB=8192;
constexpr int LDS_K=0, LDS_V=NSLOT*SLOTB, LDS_WS=2*NSLOT*SLOTB, LDS_OST=LDS_WS+NW*64*4, LDS_C2=LDS_OST+NW*4096, LDS_BYTES=LDS_C2+SEQ*4+512;
__device__ __forceinline__ void glds16(const void*gsrc,unsigned lds_dst){unsigned keep;
  asm volatile("s_mov_b32 %0, m0\n\ts_mov_b32 m0, %2\n\ts_nop 0\n\tglobal_load_lds_dwordx4 %1, off\n\ts_mov_b32 m0, %0":"=&s"(keep):"v"(gsrc),"s"(lds_dst):"memory");}
__device__ __forceinline__ float max3f(float a,float b,float c){float r;asm("v_max3_f32 %0, %1, %2, %3":"=v"(r):"v"(a),"v"(b),"v"(c));return r;}
__device__ __forceinline__ float max2f(float a,float b){float r;asm("v_max_f32_e32 %0, %1, %2":"=v"(r):"v"(a),"v"(b));return r;}
__device__ __forceinline__ float fadd_s(float a,float b){float r;asm("v_add_f32_e32 %0, %1, %2":"=v"(r):"v"(a),"v"(b));return r;}
__device__ __forceinline__ float fsub_s(float a,float b){float r;asm("v_sub_f32_e32 %0, %1, %2":"=v"(r):"v"(a),"v"(b));return r;}
typedef float f32x2_t __attribute__((ext_vector_type(2))); typedef __bf16 bf16x2_t __attribute__((ext_vector_type(2)));
__device__ __forceinline__ unsigned cvtpk_s(float lo,float hi){f32x2_t v={lo,hi};bf16x2_t b=__builtin_convertvector(v,bf16x2_t);return __builtin_bit_cast(unsigned,b);}
#define WAIT_BAR(N) asm volatile("s_waitcnt vmcnt(" #N ") lgkmcnt(0)\n\ts_barrier":::"memory")
__device__ __forceinline__ void split3(float x,unsigned&h,unsigned&m,unsigned&l){
  const unsigned u=__float_as_uint(x)&0xffff0000u; const float r1=x-__uint_as_float(u);
  const unsigned u1=__float_as_uint(r1)&0xffff0000u; const float r2=r1-__uint_as_float(u1);
  h=u>>16; m=u1>>16; l=__float_as_uint(r2)>>16; }
__device__ __forceinline__ bf16x8 make_qx(float base,int hi){ unsigned h,m,l; split3(base,h,m,l); u32x4 w; w.x=h|(m<<16); w.y=l|0x3f800000u; w.z=0x3f803f80u; w.w=0u; if(hi){w.x=0u;w.y=0u;w.z=0u;} return __builtin_bit_cast(bf16x8,w); }
__device__ __forceinline__ bf16x8 make_kx(float ck,int hi){ unsigned h,m,l; split3(-ck,h,m,l); u32x4 w; w.x=0x3f803f80u; w.y=0x3f80u|(h<<16); w.z=m|(l<<16); w.w=0u; if(hi){w.x=0u;w.y=0u;w.z=0u;} return __builtin_bit_cast(bf16x8,w); }

__device__ __forceinline__ void qkt(f32x16&p0,f32x16&p1,const char*Kslot,const bf16x8*qr,bf16x8 qx,bf16x8 kx0,bf16x8 kx1,int r32,int hi){
  const char*kb=Kslot+hi*1024+r32*16; const f32x16 z=f32x16{};
  p0=__builtin_amdgcn_mfma_f32_32x32x16_bf16(kx0,qx,z,0,0,0);p1=__builtin_amdgcn_mfma_f32_32x32x16_bf16(kx1,qx,z,0,0,0);
  #pragma unroll
  for(int d0=0;d0<4;++d0){
    const bf16x8 b0=*reinterpret_cast<const bf16x8*>(kb+d0*2048);
    const bf16x8 b1=*reinterpret_cast<const bf16x8*>(kb+d0*2048+512);
    p0=__builtin_amdgcn_mfma_f32_32x32x16_bf16(b0,qr[d0],p0,0,0,0);p1=__builtin_amdgcn_mfma_f32_32x32x16_bf16(b1,qr[d0],p1,0,0,0);}
}
typedef __attribute__((address_space(3))) const char* lds_cptr;
typedef short v4i16_t __attribute__((ext_vector_type(4)));
__device__ __forceinline__ void kload8(bf16x8*kf,lds_cptr kp){
  kf[0]=*(const __attribute__((address_space(3))) bf16x8*)(kp);      kf[1]=*(const __attribute__((address_space(3))) bf16x8*)(kp+512);
  kf[2]=*(const __attribute__((address_space(3))) bf16x8*)(kp+2048); kf[3]=*(const __attribute__((address_space(3))) bf16x8*)(kp+2560);
  kf[4]=*(const __attribute__((address_space(3))) bf16x8*)(kp+4096); kf[5]=*(const __attribute__((address_space(3))) bf16x8*)(kp+4608);
  kf[6]=*(const __attribute__((address_space(3))) bf16x8*)(kp+6144); kf[7]=*(const __attribute__((address_space(3))) bf16x8*)(kp+6656);
}
__device__ __forceinline__ void kload2(bf16x8*kf,lds_cptr kp,int j){ kf[2*j]=*(const __attribute__((address_space(3))) bf16x8*)(kp+j*2048); kf[2*j+1]=*(const __attribute__((address_space(3))) bf16x8*)(kp+j*2048+512); }
__device__ __forceinline__ s16x4 vtr(lds_cptr p){ return __builtin_bit_cast(s16x4,__builtin_amdgcn_ds_read_tr16_b64_v4i16((__attribute__((address_space(3))) v4i16_t*)p)); }
__device__ __forceinline__ float rowmax(const f32x16&p0,const f32x16&p1){
  float a=max3f(p0[0],p0[1],p1[0]),b=max3f(p0[2],p0[3],p1[1]);a=max3f(a,p1[2],p1[3]);
  #pragma unroll
  for(int r=4;r<16;r+=4){a=max3f(a,p0[r],p0[r+1]);b=max3f(b,p0[r+2],p0[r+3]);a=max3f(a,p1[r],p1[r+1]);b=max3f(b,p1[r+2],p1[r+3]);}
  const float m=max2f(a,b);
  auto rr=__builtin_amdgcn_permlane32_swap(__float_as_uint(m),__float_as_uint(m),false,false);
  return max2f(__uint_as_float(rr[0]),__uint_as_float(rr[1]));
}
__device__ __forceinline__ void pv(f32x16*o,int vb,bf16x8 pa0,bf16x8 pa1,bf16x8 pa2,bf16x8 pa3){
  #pragma unroll
  for(int d0=0;d0<2;++d0){s16x4 lo[4],hi[4];
    #pragma unroll
    for(int ks=0;ks<4;++ks){
      asm volatile("ds_read_b64_tr_b16 %0,%1 offset:%c2":"=&v"(lo[ks]):"v"(vb),"i"(d0*4096+ks*1024):"memory");
      asm volatile("ds_read_b64_tr_b16 %0,%1 offset:%c2":"=&v"(hi[ks]):"v"(vb),"i"(d0*4096+ks*1024+512):"memory");}
    asm volatile("s_waitcnt lgkmcnt(0)":::"memory");SBAR();
    #define PK(k) (bf16x8){lo[k][0],lo[k][1],lo[k][2],lo[k][3],hi[k][0],hi[k][1],hi[k][2],hi[k][3]}
    o[d0]=__builtin_amdgcn_mfma_f32_32x32x16_bf16(pa0,PK(0),o[d0],0,0,0);
    o[d0]=__builtin_amdgcn_mfma_f32_32x32x16_bf16(pa1,PK(1),o[d0],0,0,0);
    o[d0]=__builtin_amdgcn_mfma_f32_32x32x16_bf16(pa2,PK(2),o[d0],0,0,0);
    o[d0]=__builtin_amdgcn_mfma_f32_32x32x16_bf16(pa3,PK(3),o[d0],0,0,0);
    #undef PK
  }
}
#define ATTN_STORE16(p,v) (*(u32x4*)(p)=(v))
template<int THRL> __device__ __forceinline__ void attn_unit(int b,int h,int qb,const bf16*Q,const bf16*__restrict__ K,const bf16*__restrict__ V,const bf16*__restrict__ CZ,bf16*O,const float*__restrict__ c2g,int ts,float ub,char*shm){
  int tid=threadIdx.x; asm volatile("":"+v"(tid));
  const int lane=tid&63,r32=lane&31,hi=lane>>5; const int wid=__builtin_amdgcn_readfirstlane(tid>>6);
  const long rowbase=(long)b*SEQ; const int q0=qb*QB;
  const bf16*Qw=Q+(rowbase+q0+wid*QBLK)*DM+h*D;
  const bf16*Kh=K+(rowbase+(long)ts*KVBLK)*DM+h*D,*Vh=V+(rowbase+(long)ts*KVBLK)*DM+h*D;
  const unsigned lds0=(unsigned)(uintptr_t)shm;
  float*wsf=(float*)(shm+LDS_WS)+wid*64;
  float*c2l=(float*)(shm+LDS_C2);
  const bf16*ksrc=Kh+(long)lane*DM+wid*8;
  const bf16*vsrc=Vh+(long)(16*(wid&3)+(lane>>2))*DM+(wid>>2)*32+(lane&3)*8;
  const unsigned kdst=lds0+LDS_K+wid*1024, vdst=lds0+LDS_V+wid*1024;
  #define DMA_K(t,slot) glds16(ksrc+(long)(t)*KVBLK*DM,(unsigned)__builtin_amdgcn_readfirstlane(kdst+(slot)))
  #define DMA_V(t,slot) glds16(vsrc+(long)(t)*KVBLK*DM,(unsigned)__builtin_amdgcn_readfirstlane(vdst+(slot)))
  const int vb0=(int)(lds0+LDS_V)+((lane>>4)&1)*32+(lane&3)*8+(4*hi+((lane&15)>>2))*64;
  const char*Kbase=shm+LDS_K; bf16x8 kf[8];
  const lds_cptr shm3=(lds_cptr)shm; const lds_cptr kp0=shm3+LDS_K+hi*1024+r32*16; const lds_cptr vp0=shm3+LDS_V+((lane>>4)&1)*32+(lane&3)*8+(4*hi+((lane&15)>>2))*64;
  const int NT=(q0+QB)/KVBLK-ts;
  DMA_K(0,0);DMA_V(0,0);DMA_K(1,SLOTB);
  { const int kb0=ts*KVBLK; for(int i=tid*4;i<q0+QB-kb0;i+=NW*64*4)*(f32x4*)(c2l+i)=*(const f32x4*)(c2g+kb0+i); }
  bf16x8 qr[4];
  #pragma unroll
  for(int d0=0;d0<4;++d0)qr[d0]=*reinterpret_cast<const bf16x8*>(&Qw[(long)r32*DM+d0*16+hi*8]);
    float mhat=ub,l_reg=0.f;f32x16 o[2];o[0]=f32x16{};o[1]=f32x16{};
  const int qrel=wid*QBLK+r32;
  #define CMASK(P0,P1,t) do{int jb_=(t)-(NT-4); if(jb_>=0)cmask(P0,P1,jb_,qrel,hi);}while(0)
  bool resc=false;
  bf16x8 qx; float cq2;
  #define START(P0,P1) do{ resc=false; \
    _Pragma("unroll") for(int r=0;r<16;++r)P0[r]=__builtin_amdgcn_exp2f(P0[r]); }while(0)
  #define RESC() do{}while(0)
  f32x16 pA0,pA1,pB0,pB1;
  int sl_prev=0,sl_cur=0,sl_next=SLOTB;
  #define ROT() do{sl_prev=sl_cur;sl_cur=sl_next;sl_next=(sl_next==(NSLOT-1)*SLOTB)?0:sl_next+SLOTB;}while(0)
  DMA_K(2,2*SLOTB);
  WAIT_BAR(3);
  cq2=c2l[q0+qrel-ts*KVBLK]; qx=make_qx(cq2-mhat,hi);
  float ck0=c2l[r32],ck1=c2l[32+r32];
  { const bf16x8 kx0=make_kx(ck0,hi),kx1=make_kx(ck1,hi);
    qkt(pA0,pA1,Kbase,qr,qx,kx0,kx1,r32,hi); }
  asm volatile("s_nop 15\n\ts_nop 7":"+v"(pA0),"+v"(pA1));CMASK(pA0,pA1,0);
  ck0=c2l[64+r32];ck1=c2l[96+r32];
  START(pA0,pA1);
  _Pragma("unroll") for(int r=0;r<16;++r)pA1[r]=__builtin_amdgcn_exp2f(pA1[r]);
  WAIT_BAR(0);
  DMA_K(3,0);DMA_V(1,SLOTB);
  ROT();
  kload8(kf,kp0+sl_cur);
  WAIT_BAR(2);
  s16x4 vlo[8],vhi[8]; u32x4 pw0,pw1,pw2,pw3;
  #define PKW(P,B) cvtpk_s(P[B],P[B+1])
  #define PAF(k) __builtin_bit_cast(bf16x8,pw##k)
  #define VFR(i) (bf16x8){vlo[i][0],vlo[i][1],vlo[i][2],vlo[i][3],vhi[i][0],vhi[i][1],vhi[i][2],vhi[i][3]}
  #define PIN(x) asm volatile("":"+v"(x))
  #define MX3(a,b,c) __builtin_fmaxf(__builtin_fmaxf((a),(b)),(c))
  #define GAPA(MF,A0,A1,A2,A3,W0,W1,PW) do{ MF; sacc+=A0; sacc+=A1; sacc+=A2; sacc+=A3; PIN(sacc); W0; W1; PIN(PW); SBAR(); }while(0)
  #define EX(v) __builtin_amdgcn_exp2f(v)
  #define GAPB(MF,X,B) do{ MF; X[B]=EX(X[B]); X[B+1]=EX(X[B+1]); X[B+2]=EX(X[B+2]); X[B+3]=EX(X[B+3]); PIN(X); SBAR(); }while(0)
  #define VRD(i) do{ vlo[i]=vtr(vp_+(((i)>>2)*4096+((i)&3)*1024)); vhi[i]=vtr(vp_+(((i)>>2)*4096+((i)&3)*1024+512)); }while(0)
  #define KRD(G,j) do{ if(G){ kload2(kf,kp0+sl_next,j); SBAR(); } }while(0)
  #define STEP(C0,C1,P0,P1,t,GK,GV,GL) do{ SBAR(); \
    const lds_cptr vp_=vp0+sl_prev; \
    { const bf16x8 kx0_=make_kx(ck0,hi),kx1_=make_kx(ck1,hi); const f32x16 z_=f32x16{}; \
      C0=__builtin_amdgcn_mfma_f32_32x32x16_bf16(kx0_,qx,z_,0,0,0); C1=__builtin_amdgcn_mfma_f32_32x32x16_bf16(kx1_,qx,z_,0,0,0); } SBAR(); \
    VRD(0); SBAR(); float sacc=(P0[0]+P0[1]); \
    GAPA(C0=__builtin_amdgcn_mfma_f32_32x32x16_bf16(kf[0],qr[0],C0,0,0,0), P0[2],P0[3],P0[4],P0[5],     pw0[0]=PKW(P0,0), pw0[1]=PKW(P0,2), pw0); \
    VRD(4); SBAR(); GAPA(C1=__builtin_amdgcn_mfma_f32_32x32x16_bf16(kf[1],qr[0],C1,0,0,0), P0[6],P0[7],P0[8],P0[9],     pw0[2]=PKW(P0,4), pw0[3]=PKW(P0,6), pw0); \
    VRD(1); SBAR(); GAPA(C0=__builtin_amdgcn_mfma_f32_32x32x16_bf16(kf[2],qr[1],C0,0,0,0),   P0[10],P0[11],P0[12],P0[13], pw1[0]=PKW(P0,8), pw1[1]=PKW(P0,10), pw1); \
    VRD(5); SBAR(); GAPA(C1=__builtin_amdgcn_mfma_f32_32x32x16_bf16(kf[3],qr[1],C1,0,0,0),   P0[14],P0[15],P1[0],P1[1],   pw1[2]=PKW(P0,12),pw1[3]=PKW(P0,14), pw1); \
    VRD(2); SBAR(); GAPA(C0=__builtin_amdgcn_mfma_f32_32x32x16_bf16(kf[4],qr[2],C0,0,0,0),   P1[2],P1[3],P1[4],P1[5],     pw2[0]=PKW(P1,0), pw2[1]=PKW(P1,2), pw2); \
    VRD(6); SBAR(); GAPA(C1=__builtin_amdgcn_mfma_f32_32x32x16_bf16(kf[5],qr[2],C1,0,0,0),   P1[6],P1[7],P1[8],P1[9],     pw2[2]=PKW(P1,4), pw2[3]=PKW(P1,6), pw2); \
    VRD(3); SBAR(); GAPA(C0=__builtin_amdgcn_mfma_f32_32x32x16_bf16(kf[6],qr[3],C0,0,0,0),   P1[10],P1[11],P1[12],P1[13], pw3[0]=PKW(P1,8), pw3[1]=PKW(P1,10), pw3); \
    VRD(7); SBAR(); GAPA(C1=__builtin_amdgcn_mfma_f32_32x32x16_bf16(kf[7],qr[3],C1,0,0,0),   P1[14],P1[15],0.f,0.f,       pw3[2]=PKW(P1,12),pw3[3]=PKW(P1,14), pw3); \
    l_reg+=sacc; \
    if(GK){DMA_K((t)+3,sl_cur);} if(GV){DMA_V((t)+1,sl_next);} \
    if(GL){ ck0=c2l[64*((t)+1)+r32]; ck1=c2l[64*((t)+1)+32+r32]; } \
    CMASK(C0,C1,t); \
    SBAR(); \
    GAPB(o[0]=__builtin_amdgcn_mfma_f32_32x32x16_bf16(PAF(0),VFR(0),o[0],0,0,0), C0,0); \
    GAPB(o[1]=__builtin_amdgcn_mfma_f32_32x32x16_bf16(PAF(0),VFR(4),o[1],0,0,0), C0,4); \
    KRD(GL,0); GAPB(o[0]=__builtin_amdgcn_mfma_f32_32x32x16_bf16(PAF(1),VFR(1),o[0],0,0,0), C0,8); \
    KRD(GL,1); GAPB(o[1]=__builtin_amdgcn_mfma_f32_32x32x16_bf16(PAF(1),VFR(5),o[1],0,0,0), C0,12); \
    KRD(GL,2); GAPB(o[0]=__builtin_amdgcn_mfma_f32_32x32x16_bf16(PAF(2),VFR(2),o[0],0,0,0), C1,0); \
    KRD(GL,3); GAPB(o[1]=__builtin_amdgcn_mfma_f32_32x32x16_bf16(PAF(2),VFR(6),o[1],0,0,0), C1,4); \
    GAPB(o[0]=__builtin_amdgcn_mfma_f32_32x32x16_bf16(PAF(3),VFR(3),o[0],0,0,0), C1,8); \
    GAPB(o[1]=__builtin_amdgcn_mfma_f32_32x32x16_bf16(PAF(3),VFR(7),o[1],0,0,0), C1,12); \
    }while(0)
  int t=1;
  #undef CMASK
  #define CMASK(P0,P1,t) do{}while(0)
  for(;t+5<NT;t+=2){
    STEP(pB0,pB1,pA0,pA1,t,true,true,true);     WAIT_BAR(2); RESC(); ROT();
    STEP(pA0,pA1,pB0,pB1,t+1,true,true,true);   WAIT_BAR(2); RESC(); ROT();
  }
  #undef CMASK
  #define CMASK(P0,P1,t) do{int jb_=(t)-(NT-4); if(jb_>=0)cmask(P0,P1,jb_,qrel,hi);}while(0)
  #define ENDW(tt) do{ if((tt)+3<NT){WAIT_BAR(2);} else if((tt)+2<NT){WAIT_BAR(1);} else {WAIT_BAR(0);} }while(0)
  for(;t+1<NT;t+=2){
    STEP(pB0,pB1,pA0,pA1,t,(t+3<NT),(t+1<NT),(t+1<NT));       ENDW(t);   RESC(); ROT();
    STEP(pA0,pA1,pB0,pB1,t+1,(t+4<NT),(t+2<NT),(t+2<NT));     ENDW(t+1); RESC(); ROT();
  }
  { const bf16*czs=CZ+(rowbase+q0+wid*QBLK+(lane>>3))*DM+h*D+(lane&7)*8; const unsigned czd=lds0+LDS_OST+wid*4096;
    _Pragma("unroll") for(int k=0;k<4;++k)glds16(czs+(long)(8*k)*DM,(unsigned)__builtin_amdgcn_readfirstlane(czd+k*1024)); }
  STEP(pB0,pB1,pA0,pA1,NT-1,false,false,false); RESC();
  { float sacc=pB0[0]+pB0[1]; _Pragma("unroll") for(int r=2;r<16;++r)sacc+=pB0[r]; _Pragma("unroll") for(int r=0;r<16;++r)sacc+=pB1[r]; l_reg+=sacc;
    pw0=(u32x4){PKW(pB0,0),PKW(pB0,2),PKW(pB0,4),PKW(pB0,6)};pw1=(u32x4){PKW(pB0,8),PKW(pB0,10),PKW(pB0,12),PKW(pB0,14)};pw2=(u32x4){PKW(pB1,0),PKW(pB1,2),PKW(pB1,4),PKW(pB1,6)};pw3=(u32x4){PKW(pB1,8),PKW(pB1,10),PKW(pB1,12),PKW(pB1,14)};
    SBAR(); pv(o,vb0+sl_cur,PAF(0),PAF(1),PAF(2),PAF(3)); }
  #undef PKW
  #undef PAF
  #undef VFR
  #undef PIN
  #undef MX3
  #undef GAPA
  #undef GAPB
  #undef EX
  #undef VRD
  #undef KRD
  #undef STEP
  #undef ENDW
  {auto rr=__builtin_amdgcn_permlane32_swap(__float_as_uint(l_reg),__float_as_uint(l_reg),false,false);l_reg=__uint_as_float(rr[0])+__uint_as_float(rr[1]);}
  if(hi==0)wsf[32+r32]=l_reg;asm volatile("s_waitcnt lgkmcnt(0)":::"memory");
  bf16*Ow=O+(rowbase+q0+wid*QBLK)*DM+h*D;
  { bf16*stg=(bf16*)(shm+LDS_OST)+wid*2048; const unsigned short*Cw=(const unsigned short*)stg;
    asm volatile("s_waitcnt vmcnt(0)":::"memory");
    #pragma unroll
    for(int r=0;r<16;++r){const int orow=crow(r,hi); const float rl=__builtin_amdgcn_rcpf(wsf[32+orow]);
      #pragma unroll
      for(int d0=0;d0<2;++d0){ const float cz=__uint_as_float((unsigned)Cw[orow*64+d0*32+r32]<<16); stg[orow*64+d0*32+r32]=__float2bfloat16(o[d0][r]*rl*cz);} }
    asm volatile("s_waitcnt lgkmcnt(0)":::"memory");
    #pragma unroll
    for(int i=0;i<4;++i){const int row=i*8+(lane>>3),ch=lane&7; const u32x4 v=*(const u32x4*)(stg+row*64+ch*8); ATTN_STORE16(Ow+(long)row*DM+ch*8,v);} }
  asm volatile("s_waitcnt lgkmcnt(0)\n\ts_barrier":::"memory");
  #undef DMA_K
  #undef DMA_V
  #undef CMASK
  #undef START
  #undef RESC
  #undef ROT
}
#undef SBAR
#undef WAIT_BAR
}

typedef float f32x2 __attribute__((ext_vector_type(2)));
__device__ __forceinline__ void p2_conv(Frame& F, int l, int unit, bf16_t* outb, const bool pv_ = false) {
    const int tid = F.tid, lane = F.lane, w = F.wave;
    const size_t row0 = (size_t)unit * 64; const int tseq0 = (int)(row0 % SEQ);
    const bf16_t* AG = (const bf16_t*)(F.P.ws + WS_B3); const bf16_t* B0 = (const bf16_t*)(F.P.ws + WS_B0);
    LAS unsigned char* tile = F.lds + RING_OFF;
    for (int c = tid; c < 94 * 64; c += 512) { const int r = c >> 6, ch = c & 63, tr = r - (CW - 1); const bool valid = tseq0 + tr >= 0;
        u32x4 v = (u32x4){0u, 0u, 0u, 0u}; if (valid) v = *(const u32x4*)(AG + (size_t)((long)row0 + tr) * 1024 + ch * 8);
        *(LAS u32x4*)(tile + r * 1024 + ch * 16) = v; }
    LAS float* wl = (LAS float*)(tile + 94 * 1024);
    { const float* cwg = F.P.conv_w + (size_t)l * CW * DA; for (int c = tid; c < CW * DA / 4; c += 512) *(LAS f32x4*)(wl + 4 * c) = *(const f32x4*)(cwg + 4 * c); }
    __syncthreads();
    if (PROBE_CONV == 2 && pv_) { __syncthreads(); return; }
    f32x2 out[4][8]; float s1[8], s2[8];
#pragma unroll
    for (int o = 0; o < 8; ++o) { s1[o] = 0.f; s2[o] = 0.f; }
#pragma unroll
    for (int i = 0; i < 4; ++i) {
        __builtin_amdgcn_sched_barrier(0);
        int p = lane + 64 * i; asm volatile("" : "+v"(p));
        const LAS float* cw = wl + 2 * p;
        f32x2 wv[CW];
#pragma unroll
        for (int j = 0; j < CW; ++j) wv[j] = *(const LAS f32x2*)(cw + j * DA);
        const f32x2 cb = *(const f32x2*)(F.P.conv_b + l * DA + 2 * p);
        const LAS unsigned* tp = (const LAS unsigned*)(tile + (8 * w) * 1024 + 4 * p);
        f32x2 win[16];
#pragma unroll
        for (int k = 0; k < 16; ++k) { const unsigned u = tp[k * 256]; win[k] = (f32x2){__uint_as_float(u << 16), __uint_as_float(u & 0xffff0000u)}; }
#pragma unroll
        for (int o = 0; o < 8; ++o) out[i][o] = cb;
        __builtin_amdgcn_sched_barrier(0);
#pragma unroll
        for (int j = 0; j < CW; ++j) {
            if (!(PROBE_CONV == 1 && pv_))
#pragma unroll
            for (int o = 0; o < 8; ++o) out[i][o] += wv[j] * win[(j + o) & 15];
            asm volatile("" : "+v"(out[i][0]), "+v"(out[i][1]), "+v"(out[i][2]), "+v"(out[i][3]), "+v"(out[i][4]), "+v"(out[i][5]), "+v"(out[i][6]), "+v"(out[i][7]));
            if (j + 16 < 38) { const LAS unsigned* tq = tp; asm volatile("" : "+v"(tq)); const unsigned u = tq[(j + 16) * 256]; win[j & 15] = (f32x2){__uint_as_float(u << 16), __uint_as_float(u & 0xffff0000u)}; }
            __builtin_amdgcn_sched_barrier(0);
        }
#pragma unroll
        for (int o = 0; o < 8; ++o) { s1[o] += out[i][o].x + out[i][o].y; s2[o] += out[i][o].x * out[i][o].x + out[i][o].y * out[i][o].y; }
    }
    unsigned az[4][8];
#pragma unroll
    for (int i = 0; i < 4; ++i)
#pragma unroll
        for (int o = 0; o < 8; ++o) az[i][o] = *(const unsigned*)(B0 + (row0 + 8 * w + o) * 1024 + 2 * (lane + 64 * i));
#pragma unroll
    for (int o = 0; o < 8; ++o) { s1[o] = wsum(s1[o]); s2[o] = wsum(s2[o]); }
#pragma unroll
    for (int i = 0; i < 4; ++i) {
        const int p = lane + 64 * i;
        const f32x2 gg = *(const f32x2*)(F.P.cn_g + l * DA + 2 * p), be = *(const f32x2*)(F.P.cn_b + l * DA + 2 * p);
#pragma unroll
        for (int o = 0; o < 8; ++o) { const float mu = s1[o] * (1.f / DA), ex2 = s2[o] * (1.f / DA); const float rstd = rsqrtf(fmaxf(ex2 - mu * mu, 0.f) + EPS);
            f32x2 y = (out[i][o] - mu) * rstd * gg + be; y.x = y.x * fsigm(y.x); y.y = y.y * fsigm(y.y);
            *(unsigned*)(outb + (row0 + 8 * w + o) * 1024 + 2 * p) = cvt_pk_bf16(y.x * __uint_as_float(az[i][o] << 16), y.y * __uint_as_float(az[i][o] & 0xffff0000u)); }
    }
    __syncthreads();
}
__device__ __forceinline__ void p2_gmlp(Frame& F, int l, int unit, bf16_t* outb) {
    constexpr int VTP = 136;
    const int tid = F.tid, lane = F.lane, w = F.wave, fr = lane & 15, fq = lane >> 4, ch = unit >> 1, gp = unit & 1, c0 = 256 * gp; const size_t row0 = (size_t)ch * CHK;
    LAS bf16_t* vt = (LAS bf16_t*)(F.lds + RING_OFF);
    const bf16_t* V = (const bf16_t*)(F.P.ws + WS_B3) + 512 + c0; const bf16_t* U = (const bf16_t*)(F.P.ws + WS_B0) + 512 + c0;
    const float* vss = (const float*)(F.P.ws + WS_VSS); const float* gn = F.P.gn_g + l * DB + c0;
    const size_t t = row0 + 16 * w + fr;
    unsigned long long uu[16];
#pragma unroll
    for (int n = 0; n < 16; ++n) uu[n] = *(const unsigned long long*)(U + t * 1024 + 16 * n + 4 * fq);
    bf16x8 wf[2][4];
#pragma unroll
    for (int g2 = 0; g2 < 2; ++g2)
#pragma unroll
        for (int ks = 0; ks < 4; ++ks) wf[g2][ks] = *(const bf16x8*)((const bf16_t*)(F.P.ws + WS_WSB) + ((size_t)(l * NG + 2 * gp + g2) * CHK + 16 * w + fr) * CHK + 32 * ks + 8 * fq);
    const float bs0 = F.P.b_s[(size_t)(l * NG + 2 * gp) * CHK + 16 * w + fr], bs1 = F.P.b_s[(size_t)(l * NG + 2 * gp + 1) * CHK + 16 * w + fr];
    { const int sidx = tid & 127; const f32x4 qa = *(const f32x4*)(vss + (row0 + sidx) * 8), qb = *(const f32x4*)(vss + (row0 + sidx) * 8 + 4);
      const float ss = ((qa.x + qa.y) + (qa.z + qa.w)) + ((qb.x + qb.y) + (qb.z + qb.w)); const float rv = rsqrtf(ss * (1.f / DB) + EPS);
      u32x4 raw[8];
#pragma unroll
      for (int k = 0; k < 8; ++k) raw[k] = *(const u32x4*)(V + (row0 + sidx) * 1024 + ((tid >> 7) + 4 * k) * 8);
#pragma unroll
      for (int k = 0; k < 8; ++k) { const int c8 = ((tid >> 7) + 4 * k) * 8; f32x4 v0, v1; unpack8(raw[k], v0, v1); const f32x4 g0 = *(const f32x4*)(gn + c8), g1 = *(const f32x4*)(gn + c8 + 4);
          v0 = v0 * rv * g0; v1 = v1 * rv * g1;
#pragma unroll
          for (int e = 0; e < 4; ++e) { vt[(c8 + e) * VTP + sidx] = f2bf(v0[e]); vt[(c8 + 4 + e) * VTP + sidx] = f2bf(v1[e]); } } }
    __syncthreads();
    f32x4 acc[16];
#pragma unroll
    for (int n = 0; n < 16; ++n) acc[n] = (f32x4){0.f, 0.f, 0.f, 0.f};
#pragma unroll
    for (int ks = 0; ks < 4; ++ks) {
        if (32 * ks <= 16 * w + 15) {
#pragma unroll
            for (int n = 0; n < 16; ++n) { const bf16x8 vf = *(const LAS bf16x8*)(vt + (16 * n + fr) * VTP + 32 * ks + 8 * fq); acc[n] = __builtin_amdgcn_mfma_f32_16x16x32_bf16(vf, wf[n >> 3][ks], acc[n], 0, 0, 0); }
        }
    }
#pragma unroll
    for (int n = 0; n < 16; ++n) { const float bs = n < 8 ? bs0 : bs1;
        const unsigned u0 = (unsigned)uu[n], u1 = (unsigned)(uu[n] >> 32);
        const float o0 = __uint_as_float(u0 << 16) * (acc[n][0] + bs), o1 = __uint_as_float(u0 & 0xffff0000u) * (acc[n][1] + bs);
        const float o2 = __uint_as_float(u1 << 16) * (acc[n][2] + bs), o3 = __uint_as_float(u1 & 0xffff0000u) * (acc[n][3] + bs);
        *(unsigned long long*)(outb + 512 + c0 + t * 1024 + 16 * n + 4 * fq) = (unsigned long long)cvt_pk_bf16(o0, o1) | ((unsigned long long)cvt_pk_bf16(o2, o3) << 32); }
    __syncthreads();
}

__global__ void __launch_bounds__(NWAVES * 64, 2) mk_fwd(Args args) {
    extern __shared__ __attribute__((aligned(16))) unsigned char lds[];
    Frame F;
    F.lds = (LAS unsigned char*)lds;
    volatile LAS unsigned* MISC = (volatile LAS unsigned*)(F.lds + MISC_OFF);
    F.tid = threadIdx.x; F.lane = F.tid & 63; F.wave = __builtin_amdgcn_readfirstlane(F.tid >> 6);
    F.G = gridDim.x; { const int bx = blockIdx.x; F.vcu = (F.G % 8 == 0) ? (bx % 8) * (F.G / 8) + bx / 8 : bx; }
    F.P.x = args.in[0]; F.P.norm_g = args.in[1]; F.P.w_in = args.in[2]; F.P.b_gate = args.in[3]; F.P.conv_w = args.in[4]; F.P.conv_b = args.in[5]; F.P.cn_g = args.in[6]; F.P.cn_b = args.in[7]; F.P.w_a = args.in[8];
    F.P.gn_g = args.in[9]; F.P.w_s = args.in[10]; F.P.b_s = args.in[11]; F.P.w_b = args.in[12]; F.P.qn_g = args.in[13]; F.P.kn_g = args.in[14]; F.P.b_f = args.in[15]; F.P.w_c = args.in[16]; F.P.w_out = args.in[17];
    F.P.out = args.out; F.P.ws = args.ws;
    gu32* ctl = (gu32*)(args.ws + WS_CTL);
    for (int u = F.tid; u < (LDS_BYTES - LDSCTL_OFF) / 4; u += NWAVES * 64) ((LAS unsigned*)(F.lds + LDSCTL_OFF))[u] = 0u;
    __syncthreads();
    XcdBarrier bar = xcd_barrier_post((unsigned*)(ctl + CW_BAR) + args.li * XCD_BAR_WORDS, MISC + 8);

    bool dup_done = false;
    for (int ph = args.ph_lo; ph < args.ph_hi;) {
        const int l = ph / 5, p = ph % 5;
        const bool dummy = (PROBE_DUP >= 0) && p == PROBE_DUP && !dup_done;
        asm volatile("" : "+v"(F.tid)); F.lane = F.tid & 63;
        int bid = (int)blockIdx.x; asm volatile("" : "+s"(bid));
        unsigned char* ws = F.P.ws; unsigned char* wl = ws + WS_W + (size_t)l * W_LAYER;
        const float* xin = l == 0 ? F.P.x : F.P.out;
        if (p == 0) {
            if (l > 0) { ++ph; continue; }
            if (l == 0 && (!dummy || (PROBE_SUB & 1))) p0_weights(F);
            if (!dummy || (PROBE_SUB & 2)) p0_ln(F, l, xin);
        } else if (p == 1) {
            if (bid < NB * NH) p1_scan(F, bid, l);
            { pg8::TileOrder T0; T0.init(M, N1, F.G, bid); int pm_ = 0, pn_ = 0; (void)T0.tile(0, pm_, pn_);
              LAS float* Rt = (LAS float*)(F.lds + RT_OFF);
              if (F.tid < 256) { float r = 1.f; if (l > 0) { const f32x4 q = *(const f32x4*)((const float*)(ws + WS_SSP) + ((size_t)pm_ * 256 + F.tid) * 4); r = rsqrtf(((q.x + q.y) + (q.z + q.w)) * (1.f / D) + EPS); } Rt[F.tid] = r; }
              __syncthreads(); }
            pg8::SchedG1 S; S.T.init(M, N1, F.G, bid); S.A = (const char*)(ws + WS_H); S.B = (const char*)(wl + WO_W1);
            pg8::EpiG1 E{(bf16_t*)(ws + WS_B0), (bf16_t*)(ws + WS_B1), (bf16_t*)(ws + WS_B2), (bf16_t*)(ws + WS_B3), (bf16_t*)(ws + WS_B4), (float*)(ws + WS_VSS), F.P.qn_g + l * HD, F.P.kn_g + l * HD, (const LAS float*)(F.lds + RT_OFF)};
            pg8::gemm_phase<pg8::EpiG1, pg8::SchedG1>(F.lds + RING_OFF, S, E);
        } else if (p == 2) {
            for (int part = 0; part < 2; ++part) {
              asm volatile("" : "+v"(F.tid)); F.lane = F.tid & 63; asm volatile("" : "+s"(bid));
              if ((part == 0) == ((F.vcu & 1) == 0)) {
            if (!dummy || (PROBE_SUB & 1)) p2_conv(F, l, bid, dummy ? (bf16_t*)(ws + WS_DUMMY) : (bf16_t*)(ws + WS_B0), dummy);
            if (!dummy || (PROBE_SUB & 2)) { bf16_t* ob = dummy ? (bf16_t*)(ws + WS_DUMMY) : (bf16_t*)(ws + WS_B0); p2_gmlp(F, l, bid, ob); }
              } else {
            if (!dummy || (PROBE_SUB & 4)) { const int bh = F.vcu >> 3, sq = F.vcu & 7; const attn_body::bf16* b1 = (const attn_body::bf16*)(ws + WS_B1); const attn_body::bf16* b2 = (const attn_body::bf16*)(ws + WS_B2);
              const float* c2g = (const float*)(ws + WS_CS) + (size_t)bh * SEQ; const int* tsg = (const int*)(ws + WS_TS) + bh * 16;
              float gqm = fabsf(F.P.qn_g[l * HD + F.lane]), gkm = fabsf(F.P.kn_g[l * HD + F.lane]);
#pragma unroll
              for (int o_ = 1; o_ < 64; o_ <<= 1) { gqm = fmaxf(gqm, __shfl_xor(gqm, o_)); gkm = fmaxf(gkm, __shfl_xor(gkm, o_)); }
              const float ub = 64.f * C2 * gqm * gkm * 1.01f;
              for (int i = 0; i < 2; ++i) { const int qb = i == 0 ? 15 - sq : sq; const int ts = __builtin_amdgcn_readfirstlane(tsg[qb]); attn_body::attn_unit<8>(bh / NH, bh % NH, qb, b1, b1 + 512, b2, b2 + 512, dummy ? (attn_body::bf16*)(ws + WS_DUMMY) : (attn_body::bf16*)(ws + WS_B1), c2g, ts, ub, (char*)lds + RING_OFF); } }
              }
            }
        } else if (p == 3) {
            pg8::TileOrder T; T.init(M, D, F.G, bid);
            pg8::SchedMerge S; { int pm_ = 0, pn_ = 0; S.ok = T.tile(0, pm_, pn_); S.pm = pm_; S.pn = pn_; }
            S.ws = (const char*)ws; S.wl = (const char*)wl;
            S.cls = F.vcu & 1;
            pg8::EpiMerge E{ws + WS_GT + (size_t)bid * 131072, (bf16_t*)(ws + WS_MG), F.P.b_gate + (size_t)l * 3072, (const LAS float*)(F.lds + RT_OFF), S.cls, (size_t)(WS_B4 - WS_GT), dummy};
            pg8::gemm_phase<pg8::EpiMerge, pg8::SchedMerge>(F.lds + RING_OFF, S, E);
        } else {
            pg8::SchedG1 S; S.T.init(M, D, F.G, bid); S.A = (const char*)(ws + WS_MG); S.B = (const char*)(wl + WO_WO);
            if (l + 1 < NL) {
                pg8::EpiOutLN E{xin, (bf16_t*)(ws + WS_H), F.P.norm_g + (size_t)(l + 1) * D, F.P.w_in + (size_t)(l + 1) * D * NIN + OC_F, (float*)(ws + WS_SSP), (float*)(ws + WS_FP)};
                pg8::gemm_phase<pg8::EpiOutLN, pg8::SchedG1>(F.lds + RING_OFF, S, E);
            } else {
                pg8::EpiOutB E{(const bf16_t*)(ws + WS_H), dummy ? (float*)(ws + WS_B0) : F.P.out};
                pg8::gemm_phase<pg8::EpiOutB, pg8::SchedG1>(F.lds + RING_OFF, S, E);
            }
        }
        if (dummy) { dup_done = true; continue; }
        dup_done = false; ++ph;
        if (ph < args.ph_hi) xcd_barrier(bar);
    }
}

#ifndef MK_MODE
#define MK_MODE 2
#endif
extern "C" void kernel_launch(void* const* d_in, const int* in_sizes, int n_in, void* d_out, int out_size, void* d_ws, size_t ws_size, hipStream_t stream) {
    static int ok = 0;
    if (ok == 0) {
        if (n_in != 18 || in_sizes[0] != M * D || out_size != M * D || ws_size < WS_END) { fprintf(stderr, "kernel_launch: unexpected shapes (n_in %d in0 %d out %d ws %zu)\n", n_in, n_in > 0 ? in_sizes[0] : -1, out_size, ws_size); ok = -1; return; }
        const int tl = 64 * TLD * 4;
        (void)hipFuncSetAttribute((const void*)nv_gemm1, hipFuncAttributeMaxDynamicSharedMemorySize, tl);
        (void)hipFuncSetAttribute((const void*)nv_merge, hipFuncAttributeMaxDynamicSharedMemorySize, 2 * 64 * 256 * 4);
        (void)hipFuncSetAttribute((const void*)nv_gmlp, hipFuncAttributeMaxDynamicSharedMemorySize, 128 * 129 * 4);
        (void)hipFuncSetAttribute((const void*)nv_attn, hipFuncAttributeMaxDynamicSharedMemorySize, 4 * SEQ * 4);
        if (hipFuncSetAttribute((const void*)mk_fwd, hipFuncAttributeMaxDynamicSharedMemorySize, LDS_BYTES) != hipSuccess) { fprintf(stderr, "kernel_launch: hipFuncSetAttribute(mk_fwd) failed\n"); ok = -1; return; }
        int dev = 0, cus = 0; (void)hipGetDevice(&dev); (void)hipDeviceGetAttribute(&cus, hipDeviceAttributeMultiprocessorCount, dev);
        if (cus != 256) fprintf(stderr, "kernel_launch: note: %d CUs (built for 256)\n", cus);
        (void)hipGetLastError();
        ok = 1;
    }
    if (ok < 0) return;
    Ptrs P{};
    const float** pp = (const float**)&P;
    for (int i = 0; i < 18; ++i) pp[i] = (const float*)d_in[i];
    P.out = (float*)d_out; P.ws = (unsigned char*)d_ws;
    const int tl = 64 * TLD * 4;
#if MK_MODE == 0
    nv_prep<<<2048, 256, 0, stream>>>(P);
    for (int l = 0; l < NL; ++l) {
        const float* xin = l == 0 ? P.x : P.out;
        nv_ln<<<M / 4, 256, 0, stream>>>(P, l, xin);
        nv_scan<<<NB * NH, 256, 0, stream>>>(P);
        nv_gemm1<<<dim3(20, 256), 256, tl, stream>>>(P, l);
        nv_conv<<<M, 512, 0, stream>>>(P, l);
        nv_gmlp<<<dim3(128, 4), 256, 128 * 129 * 4, stream>>>(P, l);
        nv_attn<<<M * NH / 4, 256, 4 * SEQ * 4, stream>>>(P);
        nv_merge<<<dim3(4, 256), 256, 2 * 64 * 256 * 4, stream>>>(P, l);
        nv_out<<<dim3(4, 256), 256, 0, stream>>>(P, l, xin, P.out);
    }
#else
    (void)tl;
    if (hipMemsetAsync((char*)d_ws + WS_CTL, 0, CTL_ZERO_BYTES, stream) != hipSuccess) { fprintf(stderr, "kernel_launch: memset failed\n"); return; }
    Args a{};
    for (int i = 0; i < 18; ++i) a.in[i] = (const float*)d_in[i];
    a.out = (float*)d_out; a.ws = (unsigned char*)d_ws;
    auto mk = [&](int lo, int hi, int li) { a.ph_lo = lo; a.ph_hi = hi; a.li = li; hipLaunchKernelGGL(mk_fwd, dim3(256), dim3(NWAVES * 64), LDS_BYTES, stream, a);
        const hipError_t le = hipPeekAtLastError(); if (le != hipSuccess) fprintf(stderr, "kernel_launch: mk launch [%d,%d) failed: %s\n", lo, hi, hipGetErrorName(le)); };
#if MK_MODE == 1
    auto mixers = [&](int l) { nv_conv<<<M, 512, 0, stream>>>(P, l); nv_gmlp<<<dim3(128, 4), 256, 128 * 129 * 4, stream>>>(P, l); nv_attn<<<M * NH / 4, 256, 4 * SEQ * 4, stream>>>(P); };
    mk(0, 2, 0); mixers(0); mk(3, 7, 1); mixers(1); mk(8, 10, 2);
#else
    mk(0, NPH, 0);
#endif
#endif
}
```

```cpp
#include <hip/hip_runtime.h>
#include <cstdio>
#include <cstdint>
#include <cmath>

constexpr int NL = 2, NB = 4, SEQ = 4096, M = NB * SEQ, D = 1024;
constexpr int DA = 512, DB = 512, NH = 8, HD = 64, DC = 512, CW = 31, CHK = 128, NG = 4, GD = 128, NIN = 8200;
constexpr float EPS = 1e-6f;
constexpr float LOG2E = 1.4426950408889634f;
constexpr float C2 = 0.125f * LOG2E;
constexpr int N1 = 5120;
constexpr int OC_GATE = 0, OC_AIN = 3072, OC_AZ = 4096, OC_U = 4608, OC_V = 5120, OC_BZ = 5632, OC_Q = 6144, OC_K = 6656, OC_VA = 7168, OC_CZ = 7680, OC_F = 8192;

constexpr size_t MiB = 1u << 20;
constexpr size_t WS_CTL = 0, CTL_ZERO_BYTES = 64 * 1024;
constexpr size_t WS_VSS = 1 * MiB;
constexpr size_t WS_LOGF = WS_VSS + 512 * 1024;
constexpr size_t WS_CS = 2 * MiB;
constexpr size_t WS_WSB = WS_CS + 512 * 1024;
constexpr size_t WS_TS = 3 * MiB;
constexpr size_t WS_W = 4 * MiB, W_LAYER = 22 * MiB;
constexpr size_t WO_W1 = 0, WO_WG = 10 * MiB, WO_WAB = 16 * MiB, WO_WC = 18 * MiB, WO_WO = 20 * MiB;
constexpr size_t WS_H = 48 * MiB;
constexpr size_t WS_B0 = 80 * MiB;
constexpr size_t WS_B1 = 112 * MiB;
constexpr size_t WS_B2 = 144 * MiB;
constexpr size_t WS_B3 = 176 * MiB;
constexpr size_t WS_B4 = 208 * MiB;
constexpr size_t WS_GT = WS_B2, WS_MG = WS_B3;
constexpr size_t WS_FP = 240 * MiB;
constexpr size_t WS_SSP = 242 * MiB;
constexpr size_t WS_DUMMY = 224 * MiB;
constexpr size_t WS_END = 256 * MiB;
#ifndef PROBE_P3
#define PROBE_P3 0
#endif
#ifndef PROBE_CONV
#define PROBE_CONV 0
#endif
#ifndef PROBE_SUB
#define PROBE_SUB 7
#endif
#ifndef PROBE_DUP
#define PROBE_DUP -1
#endif

typedef unsigned short bf16_t;
typedef short bf16x8 __attribute__((ext_vector_type(8)));
typedef float f32x4 __attribute__((ext_vector_type(4)));
typedef unsigned u32x4 __attribute__((ext_vector_type(4)));

__host__ __device__ __forceinline__ float bf2f(bf16_t v) { union { unsigned u; float f; } c; c.u = (unsigned)v << 16; return c.f; }
__host__ __device__ __forceinline__ bf16_t f2bf(float f) { union { unsigned u; float f; } c; c.f = f; unsigned u = c.u; return (bf16_t)((u + 0x7fffu + ((u >> 16) & 1u)) >> 16); }
__device__ __forceinline__ float bfr(float f) { return bf2f(f2bf(f)); }
__device__ __forceinline__ float sigm(float x) { return 1.f / (1.f + __expf(-x)); }
__device__ __forceinline__ float siluf(float x) { return x * sigm(x); }

__host__ __device__ __forceinline__ int g1_col(int n) {
    const int j = n >> 8, lc = n & 255;
    if (j < 4) return lc < 128 ? OC_AIN + 128 * j + lc : OC_AIN + 512 + 128 * j + (lc - 128);
    if (j < 6) return OC_AZ + 256 * (j - 4) + lc;
    if (j < 8 || (j >= 10 && j < 12)) { const int k = j < 8 ? j - 6 : j - 8; return lc < 128 ? OC_U + 128 * k + lc : OC_BZ + 128 * k + (lc - 128); }
    if (j < 10) return OC_V + 256 * (j - 8) + lc;
    if (j < 16) { const int isk = j >= 14, jj = (j - 12) & 1, head = 4 * jj + ((lc >> 5) & 3), d = 32 * (lc >> 7) + (lc & 31); return (isk ? OC_K : OC_Q) + 64 * head + d; }
    if (j < 18) return OC_VA + 256 * (j - 16) + lc;
    return OC_CZ + 256 * (j - 18) + lc;
}

struct Ptrs {
    const float *x, *norm_g, *w_in, *b_gate, *conv_w, *conv_b, *cn_g, *cn_b, *w_a, *gn_g, *w_s, *b_s, *w_b, *qn_g, *kn_g, *b_f, *w_c, *w_out;
    float* out; unsigned char* ws;
};

__global__ void nv_prep(Ptrs P) {
    const size_t gid = (size_t)blockIdx.x * blockDim.x + threadIdx.x, gsz = (size_t)gridDim.x * blockDim.x;
    for (int l = 0; l < NL; ++l) {
        unsigned char* wl = P.ws + WS_W + (size_t)l * W_LAYER;
        bf16_t* W1 = (bf16_t*)(wl + WO_W1); bf16_t* WG = (bf16_t*)(wl + WO_WG); bf16_t* WAB = (bf16_t*)(wl + WO_WAB); bf16_t* WC = (bf16_t*)(wl + WO_WC); bf16_t* WO = (bf16_t*)(wl + WO_WO);
        const float* win = P.w_in + (size_t)l * D * NIN;
        for (size_t i = gid; i < (size_t)N1 * D; i += gsz) { const int n = (int)(i >> 10), k = (int)(i & 1023); W1[i] = f2bf(win[(size_t)k * NIN + g1_col(n)]); }
        for (size_t i = gid; i < (size_t)3072 * D; i += gsz) { const int n = (int)(i >> 10), k = (int)(i & 1023); WG[i] = f2bf(win[(size_t)k * NIN + n]); }
        for (size_t i = gid; i < (size_t)1024 * 1024; i += gsz) { const int n = (int)(i >> 10), k = (int)(i & 1023);
            WAB[i] = f2bf(k < 512 ? P.w_a[((size_t)l * DA + k) * D + n] : P.w_b[((size_t)l * DB + (k - 512)) * D + n]);
            WC[i] = k < 512 ? f2bf(P.w_c[((size_t)l * DC + k) * D + n]) : (bf16_t)0;
            WO[i] = f2bf(P.w_out[((size_t)l * D + k) * D + n]); }
        bf16_t* WSB = (bf16_t*)(P.ws + WS_WSB) + (size_t)l * NG * CHK * CHK;
        for (size_t i = gid; i < (size_t)NG * CHK * CHK; i += gsz) { const int s = (int)(i & 127), t = (int)((i >> 7) & 127); WSB[i] = s <= t ? f2bf(P.w_s[(size_t)l * NG * CHK * CHK + i]) : (bf16_t)0; }
    }
}

__device__ __forceinline__ float wave_sum(float v) {
#pragma unroll
    for (int o = 1; o < 64; o <<= 1) v += __shfl_xor(v, o);
    return v;
}

__global__ void nv_ln(Ptrs P, int l, const float* xin) {
    const int lane = threadIdx.x & 63, row = blockIdx.x * 4 + (threadIdx.x >> 6);
    const float* xr = xin + (size_t)row * D; const float* g = P.norm_g + (size_t)l * D; const float* win = P.w_in + (size_t)l * D * NIN;
    float v[16]; float ss = 0.f;
#pragma unroll
    for (int j = 0; j < 16; ++j) { v[j] = xr[lane + 64 * j]; ss += v[j] * v[j]; }
    ss = wave_sum(ss);
    const float r = rsqrtf(ss * (1.f / D) + EPS);
    bf16_t* h = (bf16_t*)(P.ws + WS_H) + (size_t)row * D;
    float f[8] = {0, 0, 0, 0, 0, 0, 0, 0};
#pragma unroll
    for (int j = 0; j < 16; ++j) { const int k = lane + 64 * j; const float hv = v[j] * r * g[k]; h[k] = f2bf(hv);
#pragma unroll
        for (int e = 0; e < 8; ++e) f[e] += hv * win[(size_t)k * NIN + OC_F + e]; }
#pragma unroll
    for (int e = 0; e < 8; ++e) f[e] = wave_sum(f[e]);
    if (lane < 8) { float z = 0.f;
#pragma unroll
        for (int e = 0; e < 8; ++e) if (lane == e) z = f[e];
        z += P.b_f[l * NH + lane];
        const float lf = fminf(z, 0.f) - log1pf(expf(-fabsf(z)));
        ((float*)(P.ws + WS_LOGF))[(size_t)row * 8 + lane] = lf; }
}

__global__ void nv_scan(Ptrs P) {
    __shared__ float buf[SEQ];
    const int bh = blockIdx.x, b = bh / NH, h = bh % NH;
    const float* lf = (const float*)(P.ws + WS_LOGF);
    for (int t = threadIdx.x; t < SEQ; t += blockDim.x) buf[t] = lf[((size_t)b * SEQ + t) * 8 + h];
    __syncthreads();
    if (threadIdx.x == 0) { float c = 0.f; for (int t = 0; t < SEQ; ++t) { c += buf[t]; buf[t] = c * LOG2E; } }
    __syncthreads();
    float* cs = (float*)(P.ws + WS_CS) + (size_t)bh * SEQ;
    for (int t = threadIdx.x; t < SEQ; t += blockDim.x) cs[t] = buf[t];
}

constexpr int TLD = 257;
__device__ __forceinline__ void nv_gemm_acc(const bf16_t* A, int lda, const bf16_t* Bt, int ldb, int K, f32x4 (&acc)[4][4]) {
    const int tid = threadIdx.x, w = tid >> 6, l = tid & 63, fr = l & 15, fq = l >> 4;
#pragma unroll
    for (int m = 0; m < 4; ++m)
#pragma unroll
        for (int n = 0; n < 4; ++n) acc[m][n] = (f32x4){0.f, 0.f, 0.f, 0.f};
    for (int k0 = 0; k0 < K; k0 += 32) {
        bf16x8 a[4], b[4];
#pragma unroll
        for (int m = 0; m < 4; ++m) a[m] = *(const bf16x8*)(A + (size_t)(16 * m + fr) * lda + k0 + 8 * fq);
#pragma unroll
        for (int n = 0; n < 4; ++n) b[n] = *(const bf16x8*)(Bt + (size_t)(64 * w + 16 * n + fr) * ldb + k0 + 8 * fq);
#pragma unroll
        for (int m = 0; m < 4; ++m)
#pragma unroll
            for (int n = 0; n < 4; ++n) acc[m][n] = __builtin_amdgcn_mfma_f32_16x16x32_bf16(a[m], b[n], acc[m][n], 0, 0, 0);
    }
}
__device__ __forceinline__ void nv_gemm_tile(const bf16_t* A, int lda, const bf16_t* Bt, int ldb, int K, float* T) {
    const int tid = threadIdx.x, w = tid >> 6, l = tid & 63, fr = l & 15, fq = l >> 4;
    f32x4 acc[4][4];
    nv_gemm_acc(A, lda, Bt, ldb, K, acc);
#pragma unroll
    for (int m = 0; m < 4; ++m)
#pragma unroll
        for (int n = 0; n < 4; ++n)
#pragma unroll
            for (int r = 0; r < 4; ++r) T[(16 * m + 4 * fq + r) * TLD + 64 * w + 16 * n + fr] = acc[m][n][r];
}

__global__ void __launch_bounds__(256) nv_gemm1(Ptrs P, int l) {
    extern __shared__ float T[];
    __shared__ float R[64 * 4];
    const int j = blockIdx.x, row0 = blockIdx.y * 64, tid = threadIdx.x;
    const bf16_t* H = (const bf16_t*)(P.ws + WS_H);
    const bf16_t* W1 = (const bf16_t*)(P.ws + WS_W + (size_t)l * W_LAYER + WO_W1);
    nv_gemm_tile(H + (size_t)row0 * D, D, W1 + (size_t)j * 256 * D, D, D, T);
    __syncthreads();
    bf16_t* B0 = (bf16_t*)(P.ws + WS_B0); bf16_t* B1 = (bf16_t*)(P.ws + WS_B1); bf16_t* B2 = (bf16_t*)(P.ws + WS_B2); bf16_t* B3 = (bf16_t*)(P.ws + WS_B3); bf16_t* B4 = (bf16_t*)(P.ws + WS_B4);
    if (j < 4) {
        for (int e = tid; e < 64 * 128; e += 256) { const int r = e >> 7, c = e & 127; B3[(size_t)(row0 + r) * 1024 + 128 * j + c] = f2bf(T[r * TLD + c] * sigm(T[r * TLD + c + 128])); }
    } else if (j < 12 || j >= 16) {
        bf16_t* dst; int pitch, coff; bool act;
        if (j < 6) { dst = B0; pitch = 1024; coff = 256 * (j - 4); act = true; }
        else if (j < 8) { dst = B0; pitch = 1024; coff = 512 + 256 * (j - 6); act = false; }
        else if (j < 10) { dst = B3; pitch = 1024; coff = 512 + 256 * (j - 8); act = false; }
        else if (j < 12) { dst = B4; pitch = 512; coff = 256 * (j - 10); act = true; }
        else if (j < 18) { dst = B2; pitch = 1024; coff = 256 * (j - 16); act = false; }
        else { dst = B2; pitch = 1024; coff = 512 + 256 * (j - 18); act = true; }
        for (int e = tid; e < 64 * 256; e += 256) { const int r = e >> 8, c = e & 255; const float v = T[r * TLD + c]; dst[(size_t)(row0 + r) * pitch + coff + c] = f2bf(act ? siluf(v) : v); }
        if (j == 8 || j == 9) { const int r = tid >> 2, wc = tid & 3; float s = 0.f;
            for (int bj = 0; bj < 2; ++bj) for (int i = 0; i < 32; ++i) { const float v = T[r * TLD + 128 * bj + 32 * wc + i]; s += v * v; }
            ((float*)(P.ws + WS_VSS))[(size_t)(row0 + r) * 8 + (j - 8) * 4 + wc] = s; }
    } else {
        const bool isk = j >= 14; const int jj = (j - 12) & 1;
        { const int r = tid >> 2, hh = tid & 3; float s = 0.f;
          for (int d = 0; d < 64; ++d) { const float v = T[r * TLD + 128 * (d >> 5) + 32 * hh + (d & 31)]; s += v * v; }
          R[r * 4 + hh] = rsqrtf(s * (1.f / 64.f) + EPS); }
        __syncthreads();
        const float* gq = (isk ? P.kn_g : P.qn_g) + (size_t)l * HD;
        for (int e = tid; e < 64 * 256; e += 256) { const int r = e >> 8, c = e & 255, hh = (c >> 5) & 3, d = 32 * (c >> 7) + (c & 31);
            float v = T[r * TLD + c] * R[r * 4 + hh] * gq[d]; if (!isk) v *= C2;
            B1[(size_t)(row0 + r) * 1024 + (isk ? 512 : 0) + 64 * (4 * jj + hh) + d] = f2bf(v); }
    }
}

__global__ void __launch_bounds__(512) nv_conv(Ptrs P, int l) {
    __shared__ float red[16];
    const int row = blockIdx.x, t = row % SEQ, c = threadIdx.x, lane = c & 63, w = c >> 6;
    const bf16_t* AG = (const bf16_t*)(P.ws + WS_B3); bf16_t* B0 = (bf16_t*)(P.ws + WS_B0);
    const float* cw = P.conv_w + (size_t)l * CW * DA;
    float a = P.conv_b[l * DA + c];
    for (int j = 0; j < CW; ++j) { const int tt = t - (CW - 1) + j; if (tt >= 0) a += cw[j * DA + c] * bf2f(AG[(size_t)(row - (CW - 1) + j) * 1024 + c]); }
    float s = wave_sum(a); if (lane == 0) red[w] = s; __syncthreads();
    float mu = 0.f; for (int i = 0; i < 8; ++i) mu += red[i]; mu *= (1.f / DA);
    const float d = a - mu; s = wave_sum(d * d); if (lane == 0) red[8 + w] = s; __syncthreads();
    float var = 0.f; for (int i = 0; i < 8; ++i) var += red[8 + i]; var *= (1.f / DA);
    const float y = d * rsqrtf(var + EPS) * P.cn_g[l * DA + c] + P.cn_b[l * DA + c];
    const float az = bf2f(B0[(size_t)row * 1024 + c]);
    B0[(size_t)row * 1024 + c] = f2bf(siluf(y) * az);
}

__global__ void __launch_bounds__(256) nv_gmlp(Ptrs P, int l) {
    extern __shared__ float vn[];
    const int ch = blockIdx.x, g = blockIdx.y, tid = threadIdx.x; const size_t row0 = (size_t)ch * CHK;
    const bf16_t* V = (const bf16_t*)(P.ws + WS_B3); bf16_t* B0 = (bf16_t*)(P.ws + WS_B0); const bf16_t* BZ = (const bf16_t*)(P.ws + WS_B4);
    const float* vss = (const float*)(P.ws + WS_VSS);
    const bf16_t* WSB = (const bf16_t*)(P.ws + WS_WSB) + ((size_t)l * NG + g) * CHK * CHK;
    for (int e = tid; e < 128 * 128; e += 256) { const int s = e >> 7, c = e & 127; const float* q = vss + (row0 + s) * 8;
        const float ss = ((q[0] + q[1]) + (q[2] + q[3])) + ((q[4] + q[5]) + (q[6] + q[7])); const float rv = rsqrtf(ss * (1.f / DB) + EPS);
        vn[s * 129 + c] = bfr(bf2f(V[(row0 + s) * 1024 + 512 + 128 * g + c]) * rv * P.gn_g[l * DB + 128 * g + c]); }
    __syncthreads();
    for (int e = tid; e < 128 * 128; e += 256) { const int t = e >> 7, c = e & 127; float acc = 0.f;
        for (int s = 0; s <= t; ++s) acc += bf2f(WSB[t * 128 + s]) * vn[s * 129 + c];
        acc += P.b_s[((size_t)l * NG + g) * CHK + t];
        const size_t o = (row0 + t) * 1024 + 512 + 128 * g + c;
        B0[o] = f2bf(bf2f(B0[o]) * acc * bf2f(BZ[(row0 + t) * 512 + 128 * g + c])); }
}

__global__ void __launch_bounds__(256) nv_attn(Ptrs P) {
    extern __shared__ float sc[];
    const int lane = threadIdx.x & 63, w = threadIdx.x >> 6; const int item = blockIdx.x * 4 + w, row = item >> 3, h = item & 7, b = row / SEQ, t = row % SEQ;
    float* s = sc + w * SEQ;
    bf16_t* B1 = (bf16_t*)(P.ws + WS_B1); const bf16_t* B2 = (const bf16_t*)(P.ws + WS_B2);
    const float* cs = (const float*)(P.ws + WS_CS) + (size_t)(b * NH + h) * SEQ;
    float q[64];
#pragma unroll
    for (int d = 0; d < 64; ++d) q[d] = bf2f(B1[(size_t)row * 1024 + 64 * h + d]);
    const float cq = cs[t]; float mx = -INFINITY;
    for (int k = lane; k <= t; k += 64) { const bf16_t* kr = B1 + ((size_t)b * SEQ + k) * 1024 + 512 + 64 * h; float dot = 0.f;
#pragma unroll
        for (int d8 = 0; d8 < 8; ++d8) { const bf16x8 kv = *(const bf16x8*)(kr + 8 * d8);
#pragma unroll
            for (int e = 0; e < 8; ++e) dot += q[8 * d8 + e] * bf2f((bf16_t)kv[e]); }
        const float v = dot + (cq - cs[k]); s[k] = v; mx = fmaxf(mx, v); }
#pragma unroll
    for (int o = 1; o < 64; o <<= 1) mx = fmaxf(mx, __shfl_xor(mx, o));
    float lsum = 0.f;
    for (int k = lane; k <= t; k += 64) { const float p = exp2f(s[k] - mx); lsum += p; s[k] = bfr(p); }
    lsum = wave_sum(lsum);
    __builtin_amdgcn_s_waitcnt(0); __builtin_amdgcn_wave_barrier();
    float o = 0.f; const bf16_t* vb = B2 + (size_t)b * SEQ * 1024 + 64 * h + lane;
    for (int k = 0; k <= t; ++k) o += s[k] * bf2f(vb[(size_t)k * 1024]);
    const float cz = bf2f(B2[(size_t)row * 1024 + 512 + 64 * h + lane]);
    B1[(size_t)row * 1024 + 64 * h + lane] = f2bf(o / lsum * cz);
}

__global__ void __launch_bounds__(256) nv_merge(Ptrs P, int l) {
    extern __shared__ float T[];
    const int pn = blockIdx.x, row0 = blockIdx.y * 64, tid = threadIdx.x, w = tid >> 6, ln = tid & 63, fr = ln & 15, fq = ln >> 4;
    const unsigned char* wl = P.ws + WS_W + (size_t)l * W_LAYER;
    const bf16_t* H = (const bf16_t*)(P.ws + WS_H); const bf16_t* WG = (const bf16_t*)(wl + WO_WG); const bf16_t* WAB = (const bf16_t*)(wl + WO_WAB); const bf16_t* WC = (const bf16_t*)(wl + WO_WC);
    const bf16_t* B0 = (const bf16_t*)(P.ws + WS_B0); const bf16_t* B1 = (const bf16_t*)(P.ws + WS_B1);
    float* G = T; float* MGs = T + 64 * 256;
    f32x4 acc[4][4];
    for (int br = 0; br < 3; ++br) {
        nv_gemm_acc(H + (size_t)row0 * D, D, WG + ((size_t)br * 1024 + 256 * pn) * D, D, D, acc);
#pragma unroll
        for (int m = 0; m < 4; ++m)
#pragma unroll
            for (int n = 0; n < 4; ++n)
#pragma unroll
                for (int r = 0; r < 4; ++r) { const int c = 64 * w + 16 * n + fr; G[((m * 4 + n) * 4 + r) * 256 + tid] = bfr(sigm(acc[m][n][r] + P.b_gate[(size_t)l * 3072 + br * 1024 + 256 * pn + c])); }
        const bf16_t* A = br == 0 ? B0 : (br == 1 ? B0 + 512 : B1); const bf16_t* Bt = br == 0 ? WAB : (br == 1 ? WAB + 512 : WC);
        nv_gemm_acc(A + (size_t)row0 * 1024, 1024, Bt + (size_t)256 * pn * 1024, 1024, 512, acc);
#pragma unroll
        for (int m = 0; m < 4; ++m)
#pragma unroll
            for (int n = 0; n < 4; ++n)
#pragma unroll
                for (int r = 0; r < 4; ++r) { const int s = ((m * 4 + n) * 4 + r) * 256 + tid; const float v = G[s] * acc[m][n][r]; MGs[s] = bfr(br == 0 ? v : MGs[s] + v); }
    }
    bf16_t* MG = (bf16_t*)(P.ws + WS_MG);
#pragma unroll
    for (int m = 0; m < 4; ++m)
#pragma unroll
        for (int n = 0; n < 4; ++n)
#pragma unroll
            for (int r = 0; r < 4; ++r) MG[(size_t)(row0 + 16 * m + 4 * fq + r) * 1024 + 256 * pn + 64 * w + 16 * n + fr] = f2bf(MGs[((m * 4 + n) * 4 + r) * 256 + tid]);
}

__global__ void __launch_bounds__(256) nv_out(Ptrs P, int l, const float* xin, float* xout) {
    const int pn = blockIdx.x, row0 = blockIdx.y * 64, tid = threadIdx.x, w = tid >> 6, ln = tid & 63, fr = ln & 15, fq = ln >> 4;
    const bf16_t* MG = (const bf16_t*)(P.ws + WS_MG); const bf16_t* WO = (const bf16_t*)(P.ws + WS_W + (size_t)l * W_LAYER + WO_WO);
    f32x4 acc[4][4];
    nv_gemm_acc(MG + (size_t)row0 * 1024, 1024, WO + (size_t)256 * pn * 1024, 1024, 1024, acc);
#pragma unroll
    for (int m = 0; m < 4; ++m)
#pragma unroll
        for (int n = 0; n < 4; ++n)
#pragma unroll
            for (int r = 0; r < 4; ++r) { const size_t o = (size_t)(row0 + 16 * m + 4 * fq + r) * D + 256 * pn + 64 * w + 16 * n + fr; xout[o] = xin[o] + acc[m][n][r]; }
}


#define LAS __attribute__((address_space(3)))
#define GAS __attribute__((address_space(1)))
__device__ __forceinline__ float wsum(float v) {
    v += __builtin_bit_cast(float, __builtin_amdgcn_update_dpp(0, __builtin_bit_cast(int, v), 0xB1, 0xF, 0xF, true));
    v += __builtin_bit_cast(float, __builtin_amdgcn_update_dpp(0, __builtin_bit_cast(int, v), 0x4E, 0xF, 0xF, true));
    v += __builtin_bit_cast(float, __builtin_amdgcn_update_dpp(0, __builtin_bit_cast(int, v), 0x141, 0xF, 0xF, true));
    v += __builtin_bit_cast(float, __builtin_amdgcn_update_dpp(0, __builtin_bit_cast(int, v), 0x140, 0xF, 0xF, true));
    const int iv = __builtin_bit_cast(int, v);
    return (__builtin_bit_cast(float, __builtin_amdgcn_readlane(iv, 0)) + __builtin_bit_cast(float, __builtin_amdgcn_readlane(iv, 16))) + (__builtin_bit_cast(float, __builtin_amdgcn_readlane(iv, 32)) + __builtin_bit_cast(float, __builtin_amdgcn_readlane(iv, 48)));
}
typedef GAS unsigned gu32;
#define RLX_AGENT __ATOMIC_RELAXED, __HIP_MEMORY_SCOPE_AGENT
#define LDS_WAIT() asm volatile("s_waitcnt lgkmcnt(0)" ::: "memory")
#define VM_WAIT() asm volatile("s_waitcnt vmcnt(0)" ::: "memory")
constexpr int NWAVES = 8;
constexpr int RING_OFF = 0, RING_BYTES = 131072;
constexpr int LDS_BYTES = 163840;
constexpr int LDSCTL_OFF = LDS_BYTES - 512, MISC_OFF = LDSCTL_OFF + 320;
constexpr int RT_OFF = LDSCTL_OFF - 1024;
constexpr int CW_TMO = 0, CW_CODE = 1, CW_BAR = 4096;
constexpr float SKIP_L2 = 160.f;
constexpr int NPH = 10;

__device__ __forceinline__ unsigned cvt_pk_bf16(float lo, float hi) { unsigned r; asm volatile("v_cvt_pk_bf16_f32 %0, %1, %2" : "=v"(r) : "v"(lo), "v"(hi)); return r; }
__device__ __forceinline__ float fsigm(float x) { return __builtin_amdgcn_rcpf(1.f + __builtin_amdgcn_exp2f(-LOG2E * x)); }
__device__ __forceinline__ u32x4 pack8(const f32x4& a, const f32x4& b) { u32x4 w; w.x = cvt_pk_bf16(a[0], a[1]); w.y = cvt_pk_bf16(a[2], a[3]); w.z = cvt_pk_bf16(b[0], b[1]); w.w = cvt_pk_bf16(b[2], b[3]); return w; }
__device__ __forceinline__ void unpack8(const u32x4& w, f32x4& a, f32x4& b) {
    a[0] = __uint_as_float(w.x << 16); a[1] = __uint_as_float(w.x & 0xffff0000u); a[2] = __uint_as_float(w.y << 16); a[3] = __uint_as_float(w.y & 0xffff0000u);
    b[0] = __uint_as_float(w.z << 16); b[1] = __uint_as_float(w.z & 0xffff0000u); b[2] = __uint_as_float(w.w << 16); b[3] = __uint_as_float(w.w & 0xffff0000u); }

namespace pg8 {
constexpr int BM = 256, BK = 64, HALF = 128, HTB = HALF * BK * 2, STAGE_BYTES = 8 * HTB, NXCD = 8, WGM = 8, PITCH = 1024;
__host__ __device__ __forceinline__ int lds_byte(int r, int c) { const int st = (r >> 4) * 2 + (c >> 5), rr = r & 15, cc = c & 31, ob = rr * 64 + cc * 2; return st * 1024 + (ob ^ (((ob >> 9) & 1) << 5)); }
__host__ __device__ __forceinline__ void stage_rc(int b, int& R, int& C) { const int st = b / 1024, sb = b % 1024, swz = sb ^ (((sb >> 9) & 1) << 5); R = (st >> 1) * 16 + swz / 64; C = (st & 1) * 32 + (swz % 64) / 2; }
__host__ __device__ __forceinline__ int perm32(int rho) { const int n = rho >> 4, i = rho & 15; return 8 * (i >> 2) + 4 * n + (i & 3); }

struct Unit { const char* A; const char* B; int nt, pm, pn, tag; };

struct TileOrder {
    int nM, nN, nwg, G, c;
    __device__ __forceinline__ void init(int Mr, int N, int G_, int c_) { nM = Mr / BM; nN = N / BM; nwg = nM * nN; G = G_; c = c_; }
    __device__ __forceinline__ bool tile(int i, int& pm, int& pn) const {
        const long L = (long)i * G + c; if (L >= nwg) return false;
        int wgid = (int)L; { const int q = nwg / NXCD, r = nwg % NXCD, xcd = wgid % NXCD, off = wgid / NXCD; wgid = (xcd < r ? xcd * (q + 1) : r * (q + 1) + (xcd - r) * q) + off; }
        const int nig = WGM * nN, gid = wgid / nig, fm = gid * WGM, gsz = (nM - fm) < WGM ? (nM - fm) : WGM;
        pm = fm + ((wgid % nig) % gsz); pn = (wgid % nig) / gsz; return true;
    }
};

template <class Epi, class Sched>
__device__ __forceinline__ void gemm_phase(LAS unsigned char* lds, const Sched& S, const Epi& E) {
    int tid = threadIdx.x; asm volatile("" : "+v"(tid));
    const int wid = __builtin_amdgcn_readfirstlane(tid >> 6), lane = tid & 63, wr = wid >> 2, wc = wid & 3, fr = lane & 15, fq = lane >> 4;
    unsigned voffA[2], voffB[2];
#pragma unroll
    for (int i = 0; i < 2; ++i) { int R, C; stage_rc(tid * 16 + i * 8192, R, C); const int Rb = (R & ~31) + perm32(R & 31);
        voffA[i] = (unsigned)(R * PITCH + C) * 2u; voffB[i] = (unsigned)(Rb * PITCH + C) * 2u; }
    const size_t kstep = (size_t)(BK * 2);
    const size_t hstep = (size_t)HALF * PITCH * 2;
    const unsigned ldsw = (unsigned)wid * 1024u;
    const int aoff = lds_byte(wr * 64 + fr, fq * 8), boff = lds_byte(wc * 32 + fr, fq * 8);
#define PG8_SA(b, h) (((b) * 2 + (h)) * HTB)
#define PG8_SB(b, h) ((4 + (b) * 2 + (h)) * HTB)
#define PG8_STAGE(bufoff, gbase, voff) do { _Pragma("unroll") for (int _i = 0; _i < 2; ++_i) \
        __builtin_amdgcn_global_load_lds((const unsigned*)((const char*)(gbase) + (voff)[_i]), (LAS unsigned*)(lds + (bufoff) + ldsw + _i * 8192), 16, 0, 0); } while (0)
#define PG8_LDA(dst, b, h) do { _Pragma("unroll") for (int m = 0; m < 4; ++m) _Pragma("unroll") for (int k = 0; k < 2; ++k) dst[m][k] = *(const LAS bf16x8*)(lds + PG8_SA(b, h) + aoff + m * 2048 + k * 1024); } while (0)
#define PG8_LDB(dst, b, h) do { _Pragma("unroll") for (int n = 0; n < 2; ++n) _Pragma("unroll") for (int k = 0; k < 2; ++k) dst[n][k] = *(const LAS bf16x8*)(lds + PG8_SB(b, h) + boff + n * 2048 + k * 1024); } while (0)
#define PG8_MMA(ai, bj, At, Bt) do { __builtin_amdgcn_s_setprio(1); _Pragma("unroll") for (int m = 0; m < 4; ++m) _Pragma("unroll") for (int n = 0; n < 2; ++n) _Pragma("unroll") for (int k = 0; k < 2; ++k) \
        acc[ai][bj][m][n] = __builtin_amdgcn_mfma_f32_16x16x32_bf16(Bt[n][k], At[m][k], acc[ai][bj][m][n], 0, 0, 0); __builtin_amdgcn_s_setprio(0); } while (0)
#define PG8_WAIT_V(n) asm volatile("s_waitcnt vmcnt(" #n ")" ::: "memory")
#define PG8_WAIT_L(n) asm volatile("s_waitcnt lgkmcnt(" #n ")" ::: "memory")
#define PG8_BAR __builtin_amdgcn_s_barrier()
#define PG8_SCHED __builtin_amdgcn_sched_barrier(0)
    Unit cur, nxt; int ui = 0;
    if (!S.next(0, cur)) return;
    f32x4 acc[2][2][4][2];
#pragma unroll
    for (int a = 0; a < 2; ++a)
#pragma unroll
        for (int b = 0; b < 2; ++b)
#pragma unroll
            for (int m = 0; m < 4; ++m)
#pragma unroll
                for (int n = 0; n < 2; ++n) acc[a][b][m][n] = (f32x4){0.f, 0.f, 0.f, 0.f};
    bf16x8 At[4][2], B0[2][2], B1[2][2];
    const char* cA = cur.A; const char* cB = cur.B;
    PG8_STAGE(PG8_SB(0, 0), cB, voffB); PG8_STAGE(PG8_SB(0, 1), cB + hstep, voffB); PG8_STAGE(PG8_SA(0, 0), cA, voffA); PG8_STAGE(PG8_SA(0, 1), cA + hstep, voffA);
    if (wr == 1) PG8_BAR;
    PG8_WAIT_V(2); PG8_BAR;
    PG8_STAGE(PG8_SB(1, 0), cB + kstep, voffB); PG8_STAGE(PG8_SA(1, 0), cA + kstep, voffA); PG8_STAGE(PG8_SB(1, 1), cB + hstep + kstep, voffB);
    PG8_WAIT_V(6); PG8_BAR;
    for (;;) {
        const bool has_next = S.next(ui + 1, nxt);
        const char* nA = has_next ? nxt.A : cA; const char* nB = has_next ? nxt.B : cB;
        const int nt = cur.nt;
        for (int t = 0; t < nt; t += 2) {
            const bool last = (t == nt - 2);
            const char* a1 = cA + (size_t)(t + 1) * kstep;
            const char* a2 = last ? nA : cA + (size_t)(t + 2) * kstep; const char* b2 = last ? nB : cB + (size_t)(t + 2) * kstep;
            const char* a3 = a2 + kstep; const char* b3 = b2 + kstep;
            PG8_LDB(B0, 0, 0); PG8_LDB(B1, 0, 1); PG8_SCHED; PG8_LDA(At, 0, 0); PG8_STAGE(PG8_SA(1, 1), a1 + hstep, voffA);
            PG8_WAIT_V(8); PG8_WAIT_L(0); PG8_BAR; PG8_MMA(0, 0, At, B0); PG8_MMA(0, 1, At, B1); PG8_BAR; PG8_SCHED;
            PG8_LDA(At, 0, 1); PG8_STAGE(PG8_SB(0, 0), b2, voffB); PG8_STAGE(PG8_SB(0, 1), b2 + hstep, voffB); PG8_STAGE(PG8_SA(0, 0), a2, voffA);
            PG8_WAIT_V(8); PG8_WAIT_L(0); PG8_BAR; PG8_MMA(1, 0, At, B0); PG8_MMA(1, 1, At, B1); PG8_BAR; PG8_SCHED;
            PG8_LDB(B0, 1, 0); PG8_LDB(B1, 1, 1); PG8_SCHED; PG8_LDA(At, 1, 0); PG8_STAGE(PG8_SA(0, 1), a2 + hstep, voffA);
            PG8_WAIT_V(8); PG8_WAIT_L(0); PG8_BAR; PG8_MMA(0, 0, At, B0); PG8_MMA(0, 1, At, B1); PG8_BAR; PG8_SCHED;
            PG8_LDA(At, 1, 1); PG8_STAGE(PG8_SB(1, 0), b3, voffB); PG8_STAGE(PG8_SB(1, 1), b3 + hstep, voffB); PG8_STAGE(PG8_SA(1, 0), a3, voffA);
            PG8_WAIT_V(8); PG8_WAIT_L(0); PG8_BAR; PG8_MMA(1, 0, At, B0); PG8_MMA(1, 1, At, B1); PG8_BAR; PG8_SCHED;
        }
        if (wr == 0) PG8_BAR;
        E(acc, cur, wr, wc, fr, fq);
        if (!has_next) break;
#pragma unroll
        for (int a = 0; a < 2; ++a)
#pragma unroll
            for (int b = 0; b < 2; ++b)
#pragma unroll
                for (int m = 0; m < 4; ++m)
#pragma unroll
                    for (int n = 0; n < 2; ++n) acc[a][b][m][n] = (f32x4){0.f, 0.f, 0.f, 0.f};
        cur = nxt; cA = nA; cB = nB; ++ui;
        if (wr == 1) PG8_BAR;
    }
    PG8_WAIT_V(0);
    PG8_BAR;
    E.after(acc, cur, lds, wr, wc, fr, fq);
#undef PG8_SA
#undef PG8_SB
#undef PG8_STAGE
#undef PG8_LDA
#undef PG8_LDB
#undef PG8_MMA
#undef PG8_WAIT_V
#undef PG8_WAIT_L
#undef PG8_BAR
#undef PG8_SCHED
}

struct EpiG1 {
    bf16_t *B0, *B1, *B2, *B3, *B4; float* vss; const float *gq, *gk; const LAS float* R;
    __device__ __forceinline__ void after(f32x4 (&)[2][2][4][2], const Unit&, LAS unsigned char*, int, int, int, int) const {}
    __device__ __forceinline__ void operator()(f32x4 (&acc)[2][2][4][2], const Unit& u, int wr, int wc, int fr, int fq) const {
        const int j = u.pn; const size_t rowb = (size_t)u.pm * BM + wr * 64 + fr; const int cl = 32 * wc + 8 * fq;
#pragma unroll
        for (int ai = 0; ai < 2; ++ai)
#pragma unroll
            for (int m = 0; m < 4; ++m) { const float rs = R[ai * HALF + wr * 64 + m * 16 + fr];
#pragma unroll
                for (int bj = 0; bj < 2; ++bj) { acc[ai][bj][m][0] *= rs; acc[ai][bj][m][1] *= rs; } }
        const bool ubz = (j == 6 || j == 7 || j == 10 || j == 11);
        if (j < 4 || ubz) {
            bf16_t* dst = ubz ? B0 + 512 + 128 * (j < 8 ? j - 6 : j - 8) : B3 + 128 * j;
#pragma unroll
            for (int ai = 0; ai < 2; ++ai)
#pragma unroll
                for (int m = 0; m < 4; ++m) { f32x4 o0, o1;
#pragma unroll
                    for (int e = 0; e < 4; ++e) { const float g0 = acc[ai][1][m][0][e], g1 = acc[ai][1][m][1][e]; const float s0 = fsigm(g0), s1 = fsigm(g1);
                        o0[e] = acc[ai][0][m][0][e] * (ubz ? g0 * s0 : s0); o1[e] = acc[ai][0][m][1][e] * (ubz ? g1 * s1 : s1); }
                    *(u32x4*)(dst + (rowb + ai * HALF + m * 16) * 1024 + cl) = pack8(o0, o1); }
        } else if (j < 12 || j >= 16) {
            bf16_t* dst; int pitch, coff; bool act;
            if (j < 6) { dst = B0; pitch = 1024; coff = 256 * (j - 4); act = true; }
            else if (j < 8) { dst = B0; pitch = 1024; coff = 512 + 256 * (j - 6); act = false; }
            else if (j < 10) { dst = B3; pitch = 1024; coff = 512 + 256 * (j - 8); act = false; }
            else if (j < 12) { dst = B4; pitch = 512; coff = 256 * (j - 10); act = true; }
            else if (j < 18) { dst = B2; pitch = 1024; coff = 256 * (j - 16); act = false; }
            else { dst = B2; pitch = 1024; coff = 512 + 256 * (j - 18); act = true; }
            const bool stat = (j == 8 || j == 9);
#pragma unroll
            for (int ai = 0; ai < 2; ++ai)
#pragma unroll
                for (int m = 0; m < 4; ++m) { const size_t row = rowb + ai * HALF + m * 16; float s = 0.f;
#pragma unroll
                    for (int bj = 0; bj < 2; ++bj) { f32x4 v0 = acc[ai][bj][m][0], v1 = acc[ai][bj][m][1];
                        if (act) {
#pragma unroll
                            for (int e = 0; e < 4; ++e) { v0[e] = v0[e] * fsigm(v0[e]); v1[e] = v1[e] * fsigm(v1[e]); } }
                        s += (v0[0] * v0[0] + v0[1] * v0[1]) + (v0[2] * v0[2] + v0[3] * v0[3]) + (v1[0] * v1[0] + v1[1] * v1[1]) + (v1[2] * v1[2] + v1[3] * v1[3]);
                        *(u32x4*)(dst + row * pitch + coff + 128 * bj + cl) = pack8(v0, v1); }
                    if (stat) { s += __shfl_xor(s, 16); s += __shfl_xor(s, 32); if (fq == 0) vss[row * 8 + (j - 8) * 4 + wc] = s; } }
        } else {
            const bool isk = j >= 14; const int jj = (j - 12) & 1; const float* g = isk ? gk : gq; const float sc = isk ? 1.f : C2;
            f32x4 gv[2][2];
#pragma unroll
            for (int bj = 0; bj < 2; ++bj) { gv[bj][0] = *(const f32x4*)(g + 32 * bj + 8 * fq) * sc; gv[bj][1] = *(const f32x4*)(g + 32 * bj + 8 * fq + 4) * sc; }
            bf16_t* dst = B1 + (isk ? 512 : 0) + 64 * (4 * jj + wc) + 8 * fq;
#pragma unroll
            for (int ai = 0; ai < 2; ++ai)
#pragma unroll
                for (int m = 0; m < 4; ++m) { const size_t row = rowb + ai * HALF + m * 16; float s = 0.f;
#pragma unroll
                    for (int bj = 0; bj < 2; ++bj) { const f32x4 v0 = acc[ai][bj][m][0], v1 = acc[ai][bj][m][1];
                        s += (v0[0] * v0[0] + v0[1] * v0[1]) + (v0[2] * v0[2] + v0[3] * v0[3]) + (v1[0] * v1[0] + v1[1] * v1[1]) + (v1[2] * v1[2] + v1[3] * v1[3]); }
                    s += __shfl_xor(s, 16); s += __shfl_xor(s, 32);
                    const float r = __builtin_amdgcn_rsqf(s * (1.f / 64.f) + EPS);
#pragma unroll
                    for (int bj = 0; bj < 2; ++bj) *(u32x4*)(dst + row * 1024 + 32 * bj) = pack8(acc[ai][bj][m][0] * r * gv[bj][0], acc[ai][bj][m][1] * r * gv[bj][1]); }
        }
    }
};
struct EpiMerge {
    unsigned char* gt; bf16_t* MG; const float* bgate; const LAS float* R; int cls; size_t gt2off; bool pv_;
    __device__ __forceinline__ void after(f32x4 (&)[2][2][4][2], const Unit&, LAS unsigned char*, int, int, int, int) const {}
    __device__ __forceinline__ void operator()(f32x4 (&acc)[2][2][4][2], const Unit& u, int wr, int wc, int fr, int fq) const {
        const int tag = u.tag, br = tag >> 1; const size_t rowb = (size_t)u.pm * BM + wr * 64 + fr; const int col0 = u.pn * BM + 32 * wc + 8 * fq;
        if (PROBE_P3 == 2 && pv_) return;
        if (PROBE_P3 == 1 && pv_ && (tag & 1)) return;
        u32x4* slots_ = (u32x4*)(gt + ((cls && br == 1) ? gt2off : (size_t)0)) + ((wr * 4 + wc) * 64 + fq * 16 + fr); asm volatile("" : "+v"(slots_)); __attribute__((address_space(1))) u32x4* slots = (__attribute__((address_space(1))) u32x4*)slots_;
        if ((tag & 1) == 0) {
            f32x4 bv[2][2];
#pragma unroll
            for (int bj = 0; bj < 2; ++bj) { bv[bj][0] = *(const f32x4*)(bgate + br * 1024 + col0 + 128 * bj); bv[bj][1] = *(const f32x4*)(bgate + br * 1024 + col0 + 128 * bj + 4); }
#pragma unroll
            for (int ai = 0; ai < 2; ++ai)
#pragma unroll
                for (int m = 0; m < 4; ++m)
#pragma unroll
                    for (int bj = 0; bj < 2; ++bj) { const float rs = R[ai * HALF + wr * 64 + m * 16 + fr]; f32x4 v0 = acc[ai][bj][m][0] * rs + bv[bj][0], v1 = acc[ai][bj][m][1] * rs + bv[bj][1];
#pragma unroll
                        for (int e = 0; e < 4; ++e) { v0[e] = fsigm(v0[e]); v1[e] = fsigm(v1[e]); }
                        slots[(size_t)(((ai * 4 + m) * 2 + bj) * 512)] = pack8(v0, v1); }
        } else {
#pragma unroll
            for (int ai = 0; ai < 2; ++ai)
#pragma unroll
                for (int m = 0; m < 4; ++m) {
#pragma unroll
                    for (int bj = 0; bj < 2; ++bj) { const u32x4 gw = slots[(size_t)(((ai * 4 + m) * 2 + bj) * 512)]; f32x4 g0, g1; unpack8(gw, g0, g1);
                        f32x4 v0 = g0 * acc[ai][bj][m][0], v1 = g1 * acc[ai][bj][m][1];
                        u32x4* p = (u32x4*)(MG + (rowb + ai * HALF + m * 16) * 1024 + col0 + 128 * bj);
                        if (br > 0) { const u32x4 ow = *p; f32x4 p0, p1; unpack8(ow, p0, p1); v0 += p0; v1 += p1; }
                        *p = pack8(v0, v1); }
                    if (m & 1) asm volatile("" ::: "memory"); }
        }
    }
};
struct EpiOutB {
    const bf16_t* base; float* out;
    __device__ __forceinline__ void after(f32x4 (&)[2][2][4][2], const Unit&, LAS unsigned char*, int, int, int, int) const {}
    __device__ __forceinline__ void operator()(f32x4 (&acc)[2][2][4][2], const Unit& u, int wr, int wc, int fr, int fq) const {
        const size_t rowb = (size_t)u.pm * BM + wr * 64 + fr; const int col0 = u.pn * BM + 32 * wc + 8 * fq;
#pragma unroll
        for (int ai = 0; ai < 2; ++ai)
#pragma unroll
            for (int m = 0; m < 4; ++m) {
#pragma unroll
                for (int bj = 0; bj < 2; ++bj) { const size_t o = (rowb + ai * HALF + m * 16) * D + col0 + 128 * bj;
                    f32x4 b0, b1; unpack8(*(const u32x4*)(base + o), b0, b1);
                    *(f32x4*)(out + o) = b0 + acc[ai][bj][m][0]; *(f32x4*)(out + o + 4) = b1 + acc[ai][bj][m][1]; }
                if (m & 1) asm volatile("" ::: "memory"); }
    }
};
struct EpiOut {
    const float* base; float* out;
    __device__ __forceinline__ void after(f32x4 (&)[2][2][4][2], const Unit&, LAS unsigned char*, int, int, int, int) const {}
    __device__ __forceinline__ void operator()(f32x4 (&acc)[2][2][4][2], const Unit& u, int wr, int wc, int fr, int fq) const {
        const size_t rowb = (size_t)u.pm * BM + wr * 64 + fr; const int col0 = u.pn * BM + 32 * wc + 8 * fq;
#pragma unroll
        for (int ai = 0; ai < 2; ++ai)
#pragma unroll
            for (int m = 0; m < 4; ++m) {
#pragma unroll
                for (int bj = 0; bj < 2; ++bj) { const size_t o = (rowb + ai * HALF + m * 16) * D + col0 + 128 * bj;
                    const f32x4 b0 = *(const f32x4*)(base + o), b1 = *(const f32x4*)(base + o + 4);
                    *(f32x4*)(out + o) = b0 + acc[ai][bj][m][0]; *(f32x4*)(out + o + 4) = b1 + acc[ai][bj][m][1]; }
                if (m & 1) asm volatile("" ::: "memory"); }
    }
};
struct EpiOutLN {
    const float* base; bf16_t* XG; const float* gnext; const float* wfnext; float* SSP; float* FP;
    __device__ __forceinline__ void operator()(f32x4 (&)[2][2][4][2], const Unit&, int, int, int, int) const {}
    __device__ __forceinline__ void after(f32x4 (&acc)[2][2][4][2], const Unit& u, LAS unsigned char* lds, int wr, int wc, int fr, int fq) const {
        const int tid = ((wr * 4 + wc) * 64) + fq * 16 + fr;
        const size_t rowb = (size_t)u.pm * BM + wr * 64 + fr; const int cl = 32 * wc + 8 * fq, col0 = u.pn * BM + cl;
        LAS float* FL = (LAS float*)lds;
        LAS float* WL = (LAS float*)(lds + 512 * 72 * 4);
        for (int i = tid; i < 256 * 8; i += 512) { const int c = i >> 3, e = i & 7; WL[i] = gnext[u.pn * BM + c] * wfnext[(size_t)(u.pn * BM + c) * NIN + e]; }
#pragma unroll
        for (int ai = 0; ai < 2; ++ai)
#pragma unroll
            for (int m = 0; m < 4; ++m) { float ss = 0.f;
#pragma unroll
                for (int bj = 0; bj < 2; ++bj) { const size_t o = (rowb + ai * HALF + m * 16) * D + col0 + 128 * bj;
                    const f32x4 x0 = *(const f32x4*)(base + o) + acc[ai][bj][m][0], x1 = *(const f32x4*)(base + o + 4) + acc[ai][bj][m][1];
                    ss += (x0[0] * x0[0] + x0[1] * x0[1]) + (x0[2] * x0[2] + x0[3] * x0[3]) + (x1[0] * x1[0] + x1[1] * x1[1]) + (x1[2] * x1[2] + x1[3] * x1[3]);
                    *(u32x4*)(XG + o) = pack8(x0, x1);
                    acc[ai][bj][m][0] = x0; acc[ai][bj][m][1] = x1; }
                FL[tid * 72 + 64 + ai * 4 + m] = ss;
                if (m & 1) asm volatile("" ::: "memory"); }
        asm volatile("s_waitcnt lgkmcnt(0)" ::: "memory"); __builtin_amdgcn_s_barrier(); asm volatile("" ::: "memory");
#pragma unroll
        for (int hh = 0; hh < 2; ++hh) {
            f32x4 f[8];
#pragma unroll
            for (int rg = 0; rg < 8; ++rg) f[rg] = (f32x4){0.f, 0.f, 0.f, 0.f};
#pragma unroll
            for (int bj = 0; bj < 2; ++bj)
#pragma unroll
                for (int n = 0; n < 2; ++n)
#pragma unroll
                    for (int i = 0; i < 4; ++i) { const f32x4 wv = *(const LAS f32x4*)(WL + (128 * bj + cl + 4 * n + i) * 8 + 4 * hh);
#pragma unroll
                        for (int ai = 0; ai < 2; ++ai)
#pragma unroll
                            for (int m = 0; m < 4; ++m) f[ai * 4 + m] += acc[ai][bj][m][n][i] * wv; }
#pragma unroll
            for (int rg = 0; rg < 8; ++rg) *(LAS f32x4*)(FL + tid * 72 + rg * 8 + 4 * hh) = f[rg];
            asm volatile("" ::: "memory");
        }
        asm volatile("s_waitcnt lgkmcnt(0)" ::: "memory"); __builtin_amdgcn_s_barrier(); asm volatile("" ::: "memory");
        { const int row = tid & 255, hb = (tid >> 8) * 4, ai_ = row >> 7, wr_ = (row >> 6) & 1, m_ = (row >> 4) & 3, fr_ = row & 15, rg = ai_ * 4 + m_;
          f32x4 sum = (f32x4){0.f, 0.f, 0.f, 0.f}; float ssum = 0.f;
#pragma unroll
          for (int wc_ = 0; wc_ < 4; ++wc_)
#pragma unroll
              for (int fq_ = 0; fq_ < 4; ++fq_) { const LAS float* src = FL + (((wr_ * 4 + wc_) * 64) + fq_ * 16 + fr_) * 72; sum += *(const LAS f32x4*)(src + rg * 8 + hb); ssum += src[64 + rg]; }
          const size_t grow = (size_t)u.pm * BM + row;
          *(f32x4*)(FP + (grow * 4 + u.pn) * 8 + hb) = sum;
          if (hb == 0) SSP[grow * 4 + u.pn] = ssum; }
    }
};
struct SchedG1 { TileOrder T; const char* A; const char* B;
    __device__ __forceinline__ bool next(int i, Unit& u) const { int pm, pn; if (!T.tile(i, pm, pn)) return false; u.pm = pm; u.pn = pn; u.tag = 0; u.nt = 16; u.A = A + (size_t)pm * (BM * PITCH * 2); u.B = B + (size_t)pn * (BM * PITCH * 2); return true; } };
struct SchedMerge { int pm, pn; bool ok; int cls; const char *ws, *wl;
    __device__ __forceinline__ bool next(int i, Unit& u) const { if (!ok || i >= 6) return false;
        const int tag = cls == 0 ? i : (i == 0 ? 0 : i == 1 ? 2 : i == 2 ? 1 : i == 3 ? 4 : i == 4 ? 3 : 5);
        const int br = tag >> 1; u.pm = pm; u.pn = pn; u.tag = tag;
        const size_t ro = (size_t)pm * (BM * PITCH * 2), co = (size_t)pn * (BM * PITCH * 2);
        if ((tag & 1) == 0) { u.nt = 16; u.A = ws + WS_H + ro; u.B = wl + WO_WG + (size_t)br * (1024 * PITCH * 2) + co; }
        else { u.nt = 8; const size_t ao = br == 0 ? WS_B0 : (br == 1 ? WS_B0 + 1024 : WS_B1), bo = br == 0 ? WO_WAB : (br == 1 ? WO_WAB + 1024 : WO_WC); u.A = ws + ao + ro; u.B = wl + bo + co; }
        return true; } };
}

#define XB_TMO      128
#define XB_XCNT(j)  (256  + 64 * (j))
#define XB_XSUB(j)  (1280 + 64 * (j))
#define XB_XGEN(j)  (2304 + 64 * (j))
#define XB_TOP      3328
#define XB_TOPGEN   3392
#define XCD_BAR_WORDS 3456
#define XB_SPIN_CAP (1u << 18)
__device__ __forceinline__ unsigned xb_ld(unsigned* p)              { return __hip_atomic_load(p, __ATOMIC_RELAXED, __HIP_MEMORY_SCOPE_AGENT); }
__device__ __forceinline__ unsigned xb_add(unsigned* p, unsigned v) { return __hip_atomic_fetch_add(p, v, __ATOMIC_RELAXED, __HIP_MEMORY_SCOPE_AGENT); }
__device__ __forceinline__ unsigned xb_xcc_id() { return (unsigned)__builtin_amdgcn_s_getreg((3 << 11) | 20) & 0xFu; }
#define XB_SPIN(cond, bar) do { unsigned _sp = 0; while (cond) { __builtin_amdgcn_s_sleep(1); \
    if ((++_sp & 255u) == 0u) { if (xb_ld(&(bar)[XB_TMO])) break; if (_sp > XB_SPIN_CAP) { atomicAdd(&(bar)[XB_TMO], 1u); break; } } } } while (0)
struct XcdBarrier { unsigned* bar; unsigned x; volatile LAS unsigned* st; };
__device__ __forceinline__ XcdBarrier xcd_barrier_post(unsigned* bar, volatile LAS unsigned* st) {
    XcdBarrier b; b.bar = bar; b.x = xb_xcc_id(); b.st = st;
    if (threadIdx.x == 0) (void)xb_add(&bar[XB_XCNT(b.x)], 1u);
    return b;
}
__device__ __forceinline__ void xcd_barrier_complete(unsigned* bar, unsigned x, unsigned& nloc, unsigned& nx) {
    const unsigned G = gridDim.x * gridDim.y * gridDim.z;
    unsigned sum, cnt, mine, sp = 0u;
    for (;;) {
        sum = 0u; cnt = 0u; mine = 0u;
#pragma unroll
        for (unsigned j = 0; j < 16; ++j) { const unsigned c = xb_ld(&bar[XB_XCNT(j)]); sum += c; cnt += (c > 0u) ? 1u : 0u; mine = (j == x) ? c : mine; }
        if (sum == G) break;
        __builtin_amdgcn_s_sleep(1);
        if ((++sp & 255u) == 0u) { if (xb_ld(&bar[XB_TMO])) break; if (sp > XB_SPIN_CAP) { atomicAdd(&bar[XB_TMO], 1u); break; } }
    }
    nloc = mine > 0u ? mine : 1u; nx = cnt > 0u ? cnt : 1u;
}
__device__ __forceinline__ void xcd_barrier(const XcdBarrier& b) {
    asm volatile("s_waitcnt vmcnt(0)" ::: "memory");
    __syncthreads();
    if (threadIdx.x == 0) {
        unsigned* bar = b.bar;
        __builtin_amdgcn_s_waitcnt(0);
        unsigned nloc = b.st[0], nx = b.st[1];
        if (nloc == 0u) { xcd_barrier_complete(bar, b.x, nloc, nx); b.st[0] = nloc; b.st[1] = nx; }
        const unsigned old = xb_add(&bar[XB_XSUB(b.x)], 1u);
        const unsigned gen = old / nloc;
        if (old + 1u == (gen + 1u) * nloc) {
            __builtin_amdgcn_fence(__ATOMIC_RELEASE, "agent");
            asm volatile("s_waitcnt vmcnt(0)" ::: "memory");
            const unsigned og = xb_add(&bar[XB_TOP], 1u);
            const unsigned tg = og / nx;
            if (og + 1u == (tg + 1u) * nx) xb_add(&bar[XB_TOPGEN], 1u);
            else XB_SPIN(xb_ld(&bar[XB_TOPGEN]) == tg, bar);
            __builtin_amdgcn_fence(__ATOMIC_ACQUIRE, "agent");
            xb_add(&bar[XB_XGEN(b.x)], 1u);
            asm volatile("s_waitcnt vmcnt(0)" ::: "memory");
        } else {
            XB_SPIN(xb_ld(&bar[XB_XGEN(b.x)]) == gen, bar);
            __builtin_amdgcn_fence(__ATOMIC_ACQUIRE, "agent");
            asm volatile("s_waitcnt vmcnt(0)" ::: "memory");
        }
    }
    __syncthreads();
}

struct Args { const float* in[18]; float* out; unsigned char* ws; int ph_lo, ph_hi, li, pad; };
struct Frame { LAS unsigned char* lds; int tid, lane, wave, vcu, G; Ptrs P; };

__device__ __forceinline__ unsigned pk2(float lo, float hi) { return (unsigned)f2bf(lo) | ((unsigned)f2bf(hi) << 16); }
__device__ __forceinline__ void p0_transpose_item(const float* W, int ldw, int src_col, int k0, bf16_t* WT, size_t dst_row, int dst_col, LAS float* scr, int lane, const float* kgain = nullptr) {
#pragma unroll 8
    for (int i = 0; i < 32; ++i) { const int kk = 2 * i + (lane >> 5); scr[kk * 33 + (lane & 31)] = W[(size_t)(k0 + kk) * ldw + src_col + (lane & 31)]; }
    LDS_WAIT(); asm volatile("" ::: "memory");
    const int c = lane & 7;
    f32x4 ga = (f32x4){1.f, 1.f, 1.f, 1.f}, gb = ga; if (kgain) { ga = *(const f32x4*)(kgain + k0 + 8 * c); gb = *(const f32x4*)(kgain + k0 + 8 * c + 4); }
#pragma unroll
    for (int j = 0; j < 4; ++j) { const int n = (lane >> 3) + 8 * j; const LAS float* s = scr + (8 * c) * 33 + n;
        u32x4 o; o.x = pk2(s[0 * 33] * ga.x, s[1 * 33] * ga.y); o.y = pk2(s[2 * 33] * ga.z, s[3 * 33] * ga.w); o.z = pk2(s[4 * 33] * gb.x, s[5 * 33] * gb.y); o.w = pk2(s[6 * 33] * gb.z, s[7 * 33] * gb.w);
        *(GAS u32x4*)(WT + (dst_row + n) * 1024 + dst_col + k0 + 8 * c) = o; }
    LDS_WAIT(); asm volatile("" ::: "memory");
}
__device__ __forceinline__ void p0_weights(Frame& F) {
    LAS float* scr = (LAS float*)(F.lds + RING_OFF + F.wave * 16384);
    const int gw = F.vcu * NWAVES + F.wave, NGW = F.G * NWAVES;
    constexpr int I_W1 = 16 * (N1 / 32), I_WG = 16 * 96, I_Y = 8 * 32, I_WO = 16 * 32, I_L = I_W1 + I_WG + 3 * I_Y + I_WO;
    for (int it = gw; it < NL * I_L; it += NGW) {
        const int l = it / I_L; int r = it % I_L;
        unsigned char* wl = F.P.ws + WS_W + (size_t)l * W_LAYER; const float* win = F.P.w_in + (size_t)l * D * NIN;
        const float* kg = l > 0 ? F.P.norm_g + (size_t)l * D : nullptr;
        if (r < I_W1) { const int kb = r / (N1 / 32), nb = r % (N1 / 32); p0_transpose_item(win, NIN, g1_col(32 * nb), 64 * kb, (bf16_t*)(wl + WO_W1), 32 * nb, 0, scr, F.lane, kg); continue; } r -= I_W1;
        if (r < I_WG) { const int kb = r / 96, nb = r % 96; p0_transpose_item(win, NIN, 32 * nb, 64 * kb, (bf16_t*)(wl + WO_WG), 32 * nb, 0, scr, F.lane, kg); continue; } r -= I_WG;
        if (r < I_Y) { const int kb = r / 32, nb = r % 32; p0_transpose_item(F.P.w_a + (size_t)l * DA * D, D, 32 * nb, 64 * kb, (bf16_t*)(wl + WO_WAB), 32 * nb, 0, scr, F.lane); continue; } r -= I_Y;
        if (r < I_Y) { const int kb = r / 32, nb = r % 32; p0_transpose_item(F.P.w_b + (size_t)l * DB * D, D, 32 * nb, 64 * kb, (bf16_t*)(wl + WO_WAB), 32 * nb, 512, scr, F.lane); continue; } r -= I_Y;
        if (r < I_Y) { const int kb = r / 32, nb = r % 32; p0_transpose_item(F.P.w_c + (size_t)l * DC * D, D, 32 * nb, 64 * kb, (bf16_t*)(wl + WO_WC), 32 * nb, 0, scr, F.lane); continue; } r -= I_Y;
        { const int kb = r / 32, nb = r % 32; p0_transpose_item(F.P.w_out + (size_t)l * D * D, D, 32 * nb, 64 * kb, (bf16_t*)(wl + WO_WO), 32 * nb, 0, scr, F.lane); }
    }
    bf16_t* WSB = (bf16_t*)(F.P.ws + WS_WSB);
    for (int i = (int)blockIdx.x * 512 + F.tid; i < NL * NG * CHK * CHK; i += F.G * 512) { const int s = i & 127, t = (i >> 7) & 127; WSB[i] = s <= t ? f2bf(F.P.w_s[i]) : (bf16_t)0; }
}
__device__ __forceinline__ void p0_ln(Frame& F, int l, const float* xin) {
    LAS float* wf = (LAS float*)(F.lds + RING_OFF);
    const float* g = F.P.norm_g + (size_t)l * D; const float* win = F.P.w_in + (size_t)l * D * NIN;
    __syncthreads();
    for (int i = F.tid; i < D * 8; i += 512) { const int k = i >> 3, e = i & 7; wf[i] = g[k] * win[(size_t)k * NIN + OC_F + e]; }
    __syncthreads();
    const int gw = F.vcu * NWAVES + F.wave, NGW = F.G * NWAVES;
    bf16_t* H = (bf16_t*)(F.P.ws + WS_H); float* LOGF = (float*)(F.P.ws + WS_LOGF);
    f32x4 gv[4];
#pragma unroll
    for (int j = 0; j < 4; ++j) gv[j] = ((const f32x4*)g)[64 * j + F.lane];
    static_assert(M == 8 * 256 * NWAVES, "p0_ln: 8 rows per wave on a 256-workgroup grid");
    float zrow[8];
#pragma unroll
    for (int k = 0; k < 8; ++k) zrow[k] = 0.f;
    f32x4 v[8][4];
#pragma unroll
    for (int bt = 0; bt < 4; ++bt) {
        asm volatile("" ::: "memory");
        if ((bt & 1) == 0) {
#pragma unroll
            for (int k = 2 * bt; k < 2 * bt + 4; ++k) { const GAS f32x4* xr = (const GAS f32x4*)(xin + (size_t)(gw + k * NGW) * D) + F.lane;
#pragma unroll
                for (int j = 0; j < 4; ++j) v[k][j] = xr[64 * j]; }
            asm volatile("" ::: "memory"); }
        float r[2]; float f[2][8];
#pragma unroll
        for (int q = 0; q < 2; ++q) { float ss = 0.f;
#pragma unroll
            for (int j = 0; j < 4; ++j) { const f32x4 x = v[2 * bt + q][j]; ss += (x.x * x.x + x.y * x.y) + (x.z * x.z + x.w * x.w); }
            r[q] = rsqrtf(wsum(ss) * (1.f / D) + EPS);
#pragma unroll
            for (int e = 0; e < 8; ++e) f[q][e] = 0.f; }
#pragma unroll
        for (int j = 0; j < 4; ++j) {
#pragma unroll
            for (int q = 0; q < 2; ++q) { const f32x4 hv = v[2 * bt + q][j] * r[q] * gv[j];
                GAS unsigned long long* o8 = (GAS unsigned long long*)(H + (size_t)(gw + (2 * bt + q) * NGW) * D) + F.lane;
                o8[64 * j] = (unsigned long long)pk2(hv.x, hv.y) | ((unsigned long long)pk2(hv.z, hv.w) << 32); }
#pragma unroll
            for (int i = 0; i < 4; ++i) { const LAS f32x4* w4 = (const LAS f32x4*)(wf + (256 * j + 4 * F.lane + i) * 8); const f32x4 wa = w4[0], wb = w4[1];
#pragma unroll
                for (int q = 0; q < 2; ++q) { const float xv = v[2 * bt + q][j][i];
                    f[q][0] += xv * wa.x; f[q][1] += xv * wa.y; f[q][2] += xv * wa.z; f[q][3] += xv * wa.w; f[q][4] += xv * wb.x; f[q][5] += xv * wb.y; f[q][6] += xv * wb.z; f[q][7] += xv * wb.w; } }
        }
#pragma unroll
        for (int q = 0; q < 2; ++q) {
#pragma unroll
            for (int e = 0; e < 8; ++e) f[q][e] = wsum(f[q][e]);
            if (F.lane < 8) { float z = 0.f;
#pragma unroll
                for (int e = 0; e < 8; ++e) if (F.lane == e) z = f[q][e];
                zrow[2 * bt + q] = z * r[q]; } }
    }
    if (F.lane < 8) { const float bfv = F.P.b_f[l * NH + F.lane];
#pragma unroll
        for (int k = 0; k < 8; ++k) { const float z = zrow[k] + bfv; LOGF[(size_t)(gw + k * NGW) * 8 + F.lane] = fminf(z, 0.f) - log1pf(expf(-fabsf(z))); } }
    __syncthreads();
}
__device__ __forceinline__ void p1_scan(Frame& F, int bh, int l) {
    LAS float* sh = (LAS float*)(F.lds + RING_OFF);
    const int b = bh / NH, h = bh % NH, t0 = F.tid * 8;
    float c[8]; float run = 0.f;
    if (l == 0) { const float* lf = (const float*)(F.P.ws + WS_LOGF) + ((size_t)b * SEQ + t0) * 8 + h;
#pragma unroll
        for (int i = 0; i < 8; ++i) { run += lf[i * 8]; c[i] = run; }
    } else {
        const float* fp = (const float*)(F.P.ws + WS_FP) + ((size_t)b * SEQ + t0) * 32 + h; const float* sp = (const float*)(F.P.ws + WS_SSP) + ((size_t)b * SEQ + t0) * 4; const float bfv = F.P.b_f[l * NH + h];
        float z[8];
#pragma unroll
        for (int i = 0; i < 8; ++i) { const f32x4 q = *(const f32x4*)(sp + i * 4); const float r = rsqrtf(((q.x + q.y) + (q.z + q.w)) * (1.f / D) + EPS);
            z[i] = r * ((fp[i * 32] + fp[i * 32 + 8]) + (fp[i * 32 + 16] + fp[i * 32 + 24])) + bfv; }
#pragma unroll
        for (int i = 0; i < 8; ++i) { run += fminf(z[i], 0.f) - log1pf(expf(-fabsf(z[i]))); c[i] = run; }
    }
    float inc = run;
#pragma unroll
    for (int o = 1; o < 64; o <<= 1) { const float n = __shfl_up(inc, o); if (F.lane >= o) inc += n; }
    if (F.lane == 63) sh[F.wave] = inc;
    __syncthreads();
    float base = inc - run;
    for (int w = 0; w < F.wave; ++w) base += sh[w];
    float* cs = (float*)(F.P.ws + WS_CS) + (size_t)bh * SEQ + t0;
    *(f32x4*)cs = (f32x4){(base + c[0]) * LOG2E, (base + c[1]) * LOG2E, (base + c[2]) * LOG2E, (base + c[3]) * LOG2E};
    *(f32x4*)(cs + 4) = (f32x4){(base + c[4]) * LOG2E, (base + c[5]) * LOG2E, (base + c[6]) * LOG2E, (base + c[7]) * LOG2E};
    __syncthreads();
    LAS float* c2s = sh + 16;
#pragma unroll
    for (int i = 0; i < 8; ++i) c2s[t0 + i] = (base + c[i]) * LOG2E;
    __syncthreads();
    if (F.tid < SEQ / 256) { const int qb = F.tid, nt = 4 * qb + 4; const float cq = c2s[256 * qb]; int lo = 0, hi = nt - 4;
        while (lo < hi) { const int mid = (lo + hi) >> 1; if (cq - c2s[64 * mid + 63] >= -SKIP_L2) hi = mid; else lo = mid + 1; }
        ((int*)(F.P.ws + WS_TS))[bh * 16 + qb] = lo & ~1; }
    __syncthreads();
}


#include <hip/hip_bf16.h>
namespace attn_body {
using bf16=__hip_bfloat16;
using s16x4=__attribute__((ext_vector_type(4)))short;
using f32x16=__attribute__((ext_vector_type(16)))float;
constexpr int NHEAD=NH,D=64,DM=1024;
constexpr int NW=8,QBLK=32,QB=QBLK*NW,KVBLK=64,NQB=SEQ/QB;
__device__ __forceinline__ int crow(int r,int hi){return (r&3)+8*(r>>2)+4*hi;}
#define SBAR() __builtin_amdgcn_sched_barrier(0)
__device__ __forceinline__ void cmask(f32x16&p0,f32x16&p1,int jb,int qrel,int hi){
  const float NEG=-INFINITY; int kb=64*jb+4*hi;
  #pragma unroll
  for(int r=0;r<16;++r){int kv=kb+(r&3)+8*(r>>2); if(kv>qrel)p0[r]=NEG; if(kv+32>qrel)p1[r]=NEG;}
}
constexpr int NSLOT=3, SLOTB=8192;
constexpr int LDS_K=0, LDS_V=NSLOT*SLOTB, LDS_WS=2*NSLOT*SLOTB, LDS_OST=LDS_WS+NW*64*4, LDS_C2=LDS_OST+NW*4096, LDS_BYTES=LDS_C2+SEQ*4+512;
__device__ __forceinline__ void glds16(const void*gsrc,unsigned lds_dst){unsigned keep;
  asm volatile("s_mov_b32 %0, m0\n\ts_mov_b32 m0, %2\n\ts_nop 0\n\tglobal_load_lds_dwordx4 %1, off\n\ts_mov_b32 m0, %0":"=&s"(keep):"v"(gsrc),"s"(lds_dst):"memory");}
__device__ __forceinline__ float max3f(float a,float b,float c){float r;asm("v_max3_f32 %0, %1, %2, %3":"=v"(r):"v"(a),"v"(b),"v"(c));return r;}
__device__ __forceinline__ float max2f(float a,float b){float r;asm("v_max_f32_e32 %0, %1, %2":"=v"(r):"v"(a),"v"(b));return r;}
__device__ __forceinline__ float fadd_s(float a,float b){float r;asm("v_add_f32_e32 %0, %1, %2":"=v"(r):"v"(a),"v"(b));return r;}
__device__ __forceinline__ float fsub_s(float a,float b){float r;asm("v_sub_f32_e32 %0, %1, %2":"=v"(r):"v"(a),"v"(b));return r;}
typedef float f32x2_t __attribute__((ext_vector_type(2))); typedef __bf16 bf16x2_t __attribute__((ext_vector_type(2)));
__device__ __forceinline__ unsigned cvtpk_s(float lo,float hi){f32x2_t v={lo,hi};bf16x2_t b=__builtin_convertvector(v,bf16x2_t);return __builtin_bit_cast(unsigned,b);}
#define WAIT_BAR(N) asm volatile("s_waitcnt vmcnt(" #N ") lgkmcnt(0)\n\ts_barrier":::"memory")
__device__ __forceinline__ void split3(float x,unsigned&h,unsigned&m,unsigned&l){
  const unsigned u=__float_as_uint(x)&0xffff0000u; const float r1=x-__uint_as_float(u);
  const unsigned u1=__float_as_uint(r1)&0xffff0000u; const float r2=r1-__uint_as_float(u1);
  h=u>>16; m=u1>>16; l=__float_as_uint(r2)>>16; }
__device__ __forceinline__ bf16x8 make_qx(float base,int hi){ unsigned h,m,l; split3(base,h,m,l); u32x4 w; w.x=h|(m<<16); w.y=l|0x3f800000u; w.z=0x3f803f80u; w.w=0u; if(hi){w.x=0u;w.y=0u;w.z=0u;} return __builtin_bit_cast(bf16x8,w); }
__device__ __forceinline__ bf16x8 make_kx(float ck,int hi){ unsigned h,m,l; split3(-ck,h,m,l); u32x4 w; w.x=0x3f803f80u; w.y=0x3f80u|(h<<16); w.z=m|(l<<16); w.w=0u; if(hi){w.x=0u;w.y=0u;w.z=0u;} return __builtin_bit_cast(bf16x8,w); }

__device__ __forceinline__ void qkt(f32x16&p0,f32x16&p1,const char*Kslot,const bf16x8*qr,bf16x8 qx,bf16x8 kx0,bf16x8 kx1,int r32,int hi){
  const char*kb=Kslot+hi*1024+r32*16; const f32x16 z=f32x16{};
  p0=__builtin_amdgcn_mfma_f32_32x32x16_bf16(kx0,qx,z,0,0,0);p1=__builtin_amdgcn_mfma_f32_32x32x16_bf16(kx1,qx,z,0,0,0);
  #pragma unroll
  for(int d0=0;d0<4;++d0){
    const bf16x8 b0=*reinterpret_cast<const bf16x8*>(kb+d0*2048);
    const bf16x8 b1=*reinterpret_cast<const bf16x8*>(kb+d0*2048+512);
    p0=__builtin_amdgcn_mfma_f32_32x32x16_bf16(b0,qr[d0],p0,0,0,0);p1=__builtin_amdgcn_mfma_f32_32x32x16_bf16(b1,qr[d0],p1,0,0,0);}
}
typedef __attribute__((address_space(3))) const char* lds_cptr;
typedef short v4i16_t __attribute__((ext_vector_type(4)));
__device__ __forceinline__ void kload8(bf16x8*kf,lds_cptr kp){
  kf[0]=*(const __attribute__((address_space(3))) bf16x8*)(kp);      kf[1]=*(const __attribute__((address_space(3))) bf16x8*)(kp+512);
  kf[2]=*(const __attribute__((address_space(3))) bf16x8*)(kp+2048); kf[3]=*(const __attribute__((address_space(3))) bf16x8*)(kp+2560);
  kf[4]=*(const __attribute__((address_space(3))) bf16x8*)(kp+4096); kf[5]=*(const __attribute__((address_space(3))) bf16x8*)(kp+4608);
  kf[6]=*(const __attribute__((address_space(3))) bf16x8*)(kp+6144); kf[7]=*(const __attribute__((address_space(3))) bf16x8*)(kp+6656);
}
__device__ __forceinline__ void kload2(bf16x8*kf,lds_cptr kp,int j){ kf[2*j]=*(const __attribute__((address_space(3))) bf16x8*)(kp+j*2048); kf[2*j+1]=*(const __attribute__((address_space(3))) bf16x8*)(kp+j*2048+512); }
__device__ __forceinline__ s16x4 vtr(lds_cptr p){ return __builtin_bit_cast(s16x4,__builtin_amdgcn_ds_read_tr16_b64_v4i16((__attribute__((address_space(3))) v4i16_t*)p)); }
__device__ __forceinline__ float rowmax(const f32x16&p0,const f32x16&p1){
  float a=max3f(p0[0],p0[1],p1[0]),b=max3f(p0[2],p0[3],p1[1]);a=max3f(a,p1[2],p1[3]);
  #pragma unroll
  for(int r=4;r<16;r+=4){a=max3f(a,p0[r],p0[r+1]);b=max3f(b,p0[r+2],p0[r+3]);a=max3f(a,p1[r],p1[r+1]);b=max3f(b,p1[r+2],p1[r+3]);}
  const float m=max2f(a,b);
  auto rr=__builtin_amdgcn_permlane32_swap(__float_as_uint(m),__float_as_uint(m),false,false);
  return max2f(__uint_as_float(rr[0]),__uint_as_float(rr[1]));
}
__device__ __forceinline__ void pv(f32x16*o,int vb,bf16x8 pa0,bf16x8 pa1,bf16x8 pa2,bf16x8 pa3){
  #pragma unroll
  for(int d0=0;d0<2;++d0){s16x4 lo[4],hi[4];
    #pragma unroll
    for(int ks=0;ks<4;++ks){
      asm volatile("ds_read_b64_tr_b16 %0,%1 offset:%c2":"=&v"(lo[ks]):"v"(vb),"i"(d0*4096+ks*1024):"memory");
      asm volatile("ds_read_b64_tr_b16 %0,%1 offset:%c2":"=&v"(hi[ks]):"v"(vb),"i"(d0*4096+ks*1024+512):"memory");}
    asm volatile("s_waitcnt lgkmcnt(0)":::"memory");SBAR();
    #define PK(k) (bf16x8){lo[k][0],lo[k][1],lo[k][2],lo[k][3],hi[k][0],hi[k][1],hi[k][2],hi[k][3]}
    o[d0]=__builtin_amdgcn_mfma_f32_32x32x16_bf16(pa0,PK(0),o[d0],0,0,0);
    o[d0]=__builtin_amdgcn_mfma_f32_32x32x16_bf16(pa1,PK(1),o[d0],0,0,0);
    o[d0]=__builtin_amdgcn_mfma_f32_32x32x16_bf16(pa2,PK(2),o[d0],0,0,0);
    o[d0]=__builtin_amdgcn_mfma_f32_32x32x16_bf16(pa3,PK(3),o[d0],0,0,0);
    #undef PK
  }
}
#define ATTN_STORE16(p,v) (*(u32x4*)(p)=(v))
template<int THRL> __device__ __forceinline__ void attn_unit(int b,int h,int qb,const bf16*Q,const bf16*__restrict__ K,const bf16*__restrict__ V,const bf16*__restrict__ CZ,bf16*O,const float*__restrict__ c2g,int ts,float ub,char*shm){
  int tid=threadIdx.x; asm volatile("":"+v"(tid));
  const int lane=tid&63,r32=lane&31,hi=lane>>5; const int wid=__builtin_amdgcn_readfirstlane(tid>>6);
  const long rowbase=(long)b*SEQ; const int q0=qb*QB;
  const bf16*Qw=Q+(rowbase+q0+wid*QBLK)*DM+h*D;
  const bf16*Kh=K+(rowbase+(long)ts*KVBLK)*DM+h*D,*Vh=V+(rowbase+(long)ts*KVBLK)*DM+h*D;
  const unsigned lds0=(unsigned)(uintptr_t)shm;
  float*wsf=(float*)(shm+LDS_WS)+wid*64;
  float*c2l=(float*)(shm+LDS_C2);
  const bf16*ksrc=Kh+(long)lane*DM+wid*8;
  const bf16*vsrc=Vh+(long)(16*(wid&3)+(lane>>2))*DM+(wid>>2)*32+(lane&3)*8;
  const unsigned kdst=lds0+LDS_K+wid*1024, vdst=lds0+LDS_V+wid*1024;
  #define DMA_K(t,slot) glds16(ksrc+(long)(t)*KVBLK*DM,(unsigned)__builtin_amdgcn_readfirstlane(kdst+(slot)))
  #define DMA_V(t,slot) glds16(vsrc+(long)(t)*KVBLK*DM,(unsigned)__builtin_amdgcn_readfirstlane(vdst+(slot)))
  const int vb0=(int)(lds0+LDS_V)+((lane>>4)&1)*32+(lane&3)*8+(4*hi+((lane&15)>>2))*64;
  const char*Kbase=shm+LDS_K; bf16x8 kf[8];
  const lds_cptr shm3=(lds_cptr)shm; const lds_cptr kp0=shm3+LDS_K+hi*1024+r32*16; const lds_cptr vp0=shm3+LDS_V+((lane>>4)&1)*32+(lane&3)*8+(4*hi+((lane&15)>>2))*64;
  const int NT=(q0+QB)/KVBLK-ts;
  DMA_K(0,0);DMA_V(0,0);DMA_K(1,SLOTB);
  { const int kb0=ts*KVBLK; for(int i=tid*4;i<q0+QB-kb0;i+=NW*64*4)*(f32x4*)(c2l+i)=*(const f32x4*)(c2g+kb0+i); }
  bf16x8 qr[4];
  #pragma unroll
  for(int d0=0;d0<4;++d0)qr[d0]=*reinterpret_cast<const bf16x8*>(&Qw[(long)r32*DM+d0*16+hi*8]);
    float mhat=ub,l_reg=0.f;f32x16 o[2];o[0]=f32x16{};o[1]=f32x16{};
  const int qrel=wid*QBLK+r32;
  #define CMASK(P0,P1,t) do{int jb_=(t)-(NT-4); if(jb_>=0)cmask(P0,P1,jb_,qrel,hi);}while(0)
  bool resc=false;
  bf16x8 qx; float cq2;
  #define START(P0,P1) do{ resc=false; \
    _Pragma("unroll") for(int r=0;r<16;++r)P0[r]=__builtin_amdgcn_exp2f(P0[r]); }while(0)
  #define RESC() do{}while(0)
  f32x16 pA0,pA1,pB0,pB1;
  int sl_prev=0,sl_cur=0,sl_next=SLOTB;
  #define ROT() do{sl_prev=sl_cur;sl_cur=sl_next;sl_next=(sl_next==(NSLOT-1)*SLOTB)?0:sl_next+SLOTB;}while(0)
  DMA_K(2,2*SLOTB);
  WAIT_BAR(3);
  cq2=c2l[q0+qrel-ts*KVBLK]; qx=make_qx(cq2-mhat,hi);
  float ck0=c2l[r32],ck1=c2l[32+r32];
  { const bf16x8 kx0=make_kx(ck0,hi),kx1=make_kx(ck1,hi);
    qkt(pA0,pA1,Kbase,qr,qx,kx0,kx1,r32,hi); }
  asm volatile("s_nop 15\n\ts_nop 7":"+v"(pA0),"+v"(pA1));CMASK(pA0,pA1,0);
  ck0=c2l[64+r32];ck1=c2l[96+r32];
  START(pA0,pA1);
  _Pragma("unroll") for(int r=0;r<16;++r)pA1[r]=__builtin_amdgcn_exp2f(pA1[r]);
  WAIT_BAR(0);
  DMA_K(3,0);DMA_V(1,SLOTB);
  ROT();
  kload8(kf,kp0+sl_cur);
  WAIT_BAR(2);
  s16x4 vlo[8],vhi[8]; u32x4 pw0,pw1,pw2,pw3;
  #define PKW(P,B) cvtpk_s(P[B],P[B+1])
  #define PAF(k) __builtin_bit_cast(bf16x8,pw##k)
  #define VFR(i) (bf16x8){vlo[i][0],vlo[i][1],vlo[i][2],vlo[i][3],vhi[i][0],vhi[i][1],vhi[i][2],vhi[i][3]}
  #define PIN(x) asm volatile("":"+v"(x))
  #define MX3(a,b,c) __builtin_fmaxf(__builtin_fmaxf((a),(b)),(c))
  #define GAPA(MF,A0,A1,A2,A3,W0,W1,PW) do{ MF; sacc+=A0; sacc+=A1; sacc+=A2; sacc+=A3; PIN(sacc); W0; W1; PIN(PW); SBAR(); }while(0)
  #define EX(v) __builtin_amdgcn_exp2f(v)
  #define GAPB(MF,X,B) do{ MF; X[B]=EX(X[B]); X[B+1]=EX(X[B+1]); X[B+2]=EX(X[B+2]); X[B+3]=EX(X[B+3]); PIN(X); SBAR(); }while(0)
  #define VRD(i) do{ vlo[i]=vtr(vp_+(((i)>>2)*4096+((i)&3)*1024)); vhi[i]=vtr(vp_+(((i)>>2)*4096+((i)&3)*1024+512)); }while(0)
  #define KRD(G,j) do{ if(G){ kload2(kf,kp0+sl_next,j); SBAR(); } }while(0)
  #define STEP(C0,C1,P0,P1,t,GK,GV,GL) do{ SBAR(); \
    const lds_cptr vp_=vp0+sl_prev; \
    { const bf16x8 kx0_=make_kx(ck0,hi),kx1_=make_kx(ck1,hi); const f32x16 z_=f32x16{}; \
      C0=__builtin_amdgcn_mfma_f32_32x32x16_bf16(kx0_,qx,z_,0,0,0); C1=__builtin_amdgcn_mfma_f32_32x32x16_bf16(kx1_,qx,z_,0,0,0); } SBAR(); \
    VRD(0); SBAR(); float sacc=(P0[0]+P0[1]); \
    GAPA(C0=__builtin_amdgcn_mfma_f32_32x32x16_bf16(kf[0],qr[0],C0,0,0,0), P0[2],P0[3],P0[4],P0[5],     pw0[0]=PKW(P0,0), pw0[1]=PKW(P0,2), pw0); \
    VRD(4); SBAR(); GAPA(C1=__builtin_amdgcn_mfma_f32_32x32x16_bf16(kf[1],qr[0],C1,0,0,0), P0[6],P0[7],P0[8],P0[9],     pw0[2]=PKW(P0,4), pw0[3]=PKW(P0,6), pw0); \
    VRD(1); SBAR(); GAPA(C0=__builtin_amdgcn_mfma_f32_32x32x16_bf16(kf[2],qr[1],C0,0,0,0),   P0[10],P0[11],P0[12],P0[13], pw1[0]=PKW(P0,8), pw1[1]=PKW(P0,10), pw1); \
    VRD(5); SBAR(); GAPA(C1=__builtin_amdgcn_mfma_f32_32x32x16_bf16(kf[3],qr[1],C1,0,0,0),   P0[14],P0[15],P1[0],P1[1],   pw1[2]=PKW(P0,12),pw1[3]=PKW(P0,14), pw1); \
    VRD(2); SBAR(); GAPA(C0=__builtin_amdgcn_mfma_f32_32x32x16_bf16(kf[4],qr[2],C0,0,0,0),   P1[2],P1[3],P1[4],P1[5],     pw2[0]=PKW(P1,0), pw2[1]=PKW(P1,2), pw2); \
    VRD(6); SBAR(); GAPA(C1=__builtin_amdgcn_mfma_f32_32x32x16_bf16(kf[5],qr[2],C1,0,0,0),   P1[6],P1[7],P1[8],P1[9],     pw2[2]=PKW(P1,4), pw2[3]=PKW(P1,6), pw2); \
    VRD(3); SBAR(); GAPA(C0=__builtin_amdgcn_mfma_f32_32x32x16_bf16(kf[6],qr[3],C0,0,0,0),   P1[10],P1[11],P1[12],P1[13], pw3[0]=PKW(P1,8), pw3[1]=PKW(P1,10), pw3); \
    VRD(7); SBAR(); GAPA(C1=__builtin_amdgcn_mfma_f32_32x32x16_bf16(kf[7],qr[3],C1,0,0,0),   P1[14],P1[15],0.f,0.f,       pw3[2]=PKW(P1,12),pw3[3]=PKW(P1,14), pw3); \
    l_reg+=sacc; \
    if(GK){DMA_K((t)+3,sl_cur);} if(GV){DMA_V((t)+1,sl_next);} \
    if(GL){ ck0=c2l[64*((t)+1)+r32]; ck1=c2l[64*((t)+1)+32+r32]; } \
    CMASK(C0,C1,t); \
    SBAR(); \
    GAPB(o[0]=__builtin_amdgcn_mfma_f32_32x32x16_bf16(PAF(0),VFR(0),o[0],0,0,0), C0,0); \
    GAPB(o[1]=__builtin_amdgcn_mfma_f32_32x32x16_bf16(PAF(0),VFR(4),o[1],0,0,0), C0,4); \
    KRD(GL,0); GAPB(o[0]=__builtin_amdgcn_mfma_f32_32x32x16_bf16(PAF(1),VFR(1),o[0],0,0,0), C0,8); \
    KRD(GL,1); GAPB(o[1]=__builtin_amdgcn_mfma_f32_32x32x16_bf16(PAF(1),VFR(5),o[1],0,0,0), C0,12); \
    KRD(GL,2); GAPB(o[0]=__builtin_amdgcn_mfma_f32_32x32x16_bf16(PAF(2),VFR(2),o[0],0,0,0), C1,0); \
    KRD(GL,3); GAPB(o[1]=__builtin_amdgcn_mfma_f32_32x32x16_bf16(PAF(2),VFR(6),o[1],0,0,0), C1,4); \
    GAPB(o[0]=__builtin_amdgcn_mfma_f32_32x32x16_bf16(PAF(3),VFR(3),o[0],0,0,0), C1,8); \
    GAPB(o[1]=__builtin_amdgcn_mfma_f32_32x32x16_bf16(PAF(3),VFR(7),o[1],0,0,0), C1,12); \
    }while(0)
  int t=1;
  #undef CMASK
  #define CMASK(P0,P1,t) do{}while(0)
  for(;t+5<NT;t+=2){
    STEP(pB0,pB1,pA0,pA1,t,true,true,true);     WAIT_BAR(2); RESC(); ROT();
    STEP(pA0,pA1,pB0,pB1,t+1,true,true,true);   WAIT_BAR(2); RESC(); ROT();
  }
  #undef CMASK
  #define CMASK(P0,P1,t) do{int jb_=(t)-(NT-4); if(jb_>=0)cmask(P0,P1,jb_,qrel,hi);}while(0)
  #define ENDW(tt) do{ if((tt)+3<NT){WAIT_BAR(2);} else if((tt)+2<NT){WAIT_BAR(1);} else {WAIT_BAR(0);} }while(0)
  for(;t+1<NT;t+=2){
    STEP(pB0,pB1,pA0,pA1,t,(t+3<NT),(t+1<NT),(t+1<NT));       ENDW(t);   RESC(); ROT();
    STEP(pA0,pA1,pB0,pB1,t+1,(t+4<NT),(t+2<NT),(t+2<NT));     ENDW(t+1); RESC(); ROT();
  }
  { const bf16*czs=CZ+(rowbase+q0+wid*QBLK+(lane>>3))*DM+h*D+(lane&7)*8; const unsigned czd=lds0+LDS_OST+wid*4096;
    _Pragma("unroll") for(int k=0;k<4;++k)glds16(czs+(long)(8*k)*DM,(unsigned)__builtin_amdgcn_readfirstlane(czd+k*1024)); }
  STEP(pB0,pB1,pA0,pA1,NT-1,false,false,false); RESC();
  { float sacc=pB0[0]+pB0[1]; _Pragma("unroll") for(int r=2;r<16;++r)sacc+=pB0[r]; _Pragma("unroll") for(int r=0;r<16;++r)sacc+=pB1[r]; l_reg+=sacc;
    pw0=(u32x4){PKW(pB0,0),PKW(pB0,2),PKW(pB0,4),PKW(pB0,6)};pw1=(u32x4){PKW(pB0,8),PKW(pB0,10),PKW(pB0,12),PKW(pB0,14)};pw2=(u32x4){PKW(pB1,0),PKW(pB1,2),PKW(pB1,4),PKW(pB1,6)};pw3=(u32x4){PKW(pB1,8),PKW(pB1,10),PKW(pB1,12),PKW(pB1,14)};
    SBAR(); pv(o,vb0+sl_cur,PAF(0),PAF(1),PAF(2),PAF(3)); }
  #undef PKW
  #undef PAF
  #undef VFR
  #undef PIN
  #undef MX3
  #undef GAPA
  #undef GAPB
  #undef EX
  #undef VRD
  #undef KRD
  #undef STEP
  #undef ENDW
  {auto rr=__builtin_amdgcn_permlane32_swap(__float_as_uint(l_reg),__float_as_uint(l_reg),false,false);l_reg=__uint_as_float(rr[0])+__uint_as_float(rr[1]);}
  if(hi==0)wsf[32+r32]=l_reg;asm volatile("s_waitcnt lgkmcnt(0)":::"memory");
  bf16*Ow=O+(rowbase+q0+wid*QBLK)*DM+h*D;
  { bf16*stg=(bf16*)(shm+LDS_OST)+wid*2048; const unsigned short*Cw=(const unsigned short*)stg;
    asm volatile("s_waitcnt vmcnt(0)":::"memory");
    #pragma unroll
    for(int r=0;r<16;++r){const int orow=crow(r,hi); const float rl=__builtin_amdgcn_rcpf(wsf[32+orow]);
      #pragma unroll
      for(int d0=0;d0<2;++d0){ const float cz=__uint_as_float((unsigned)Cw[orow*64+d0*32+r32]<<16); stg[orow*64+d0*32+r32]=__float2bfloat16(o[d0][r]*rl*cz);} }
    asm volatile("s_waitcnt lgkmcnt(0)":::"memory");
    #pragma unroll
    for(int i=0;i<4;++i){const int row=i*8+(lane>>3),ch=lane&7; const u32x4 v=*(const u32x4*)(stg+row*64+ch*8); ATTN_STORE16(Ow+(long)row*DM+ch*8,v);} }
  asm volatile("s_waitcnt lgkmcnt(0)\n\ts_barrier":::"memory");
  #undef DMA_K
  #undef DMA_V
  #undef CMASK
  #undef START
  #undef RESC
  #undef ROT
}
#undef SBAR
#undef WAIT_BAR
}

typedef float f32x2 __attribute__((ext_vector_type(2)));
__device__ __forceinline__ void p2_conv(Frame& F, int l, int unit, bf16_t* outb, const bool pv_ = false) {
    const int tid = F.tid, lane = F.lane, w = F.wave;
    const size_t row0 = (size_t)unit * 64; const int tseq0 = (int)(row0 % SEQ);
    const bf16_t* AG = (const bf16_t*)(F.P.ws + WS_B3); const bf16_t* B0 = (const bf16_t*)(F.P.ws + WS_B0);
    LAS unsigned char* tile = F.lds + RING_OFF;
    for (int c = tid; c < 94 * 64; c += 512) { const int r = c >> 6, ch = c & 63, tr = r - (CW - 1); const bool valid = tseq0 + tr >= 0;
        u32x4 v = (u32x4){0u, 0u, 0u, 0u}; if (valid) v = *(const u32x4*)(AG + (size_t)((long)row0 + tr) * 1024 + ch * 8);
        *(LAS u32x4*)(tile + r * 1024 + ch * 16) = v; }
    LAS float* wl = (LAS float*)(tile + 94 * 1024);
    { const float* cwg = F.P.conv_w + (size_t)l * CW * DA; for (int c = tid; c < CW * DA / 4; c += 512) *(LAS f32x4*)(wl + 4 * c) = *(const f32x4*)(cwg + 4 * c); }
    __syncthreads();
    if (PROBE_CONV == 2 && pv_) { __syncthreads(); return; }
    f32x2 out[4][8]; float s1[8], s2[8];
#pragma unroll
    for (int o = 0; o < 8; ++o) { s1[o] = 0.f; s2[o] = 0.f; }
#pragma unroll
    for (int i = 0; i < 4; ++i) {
        __builtin_amdgcn_sched_barrier(0);
        int p = lane + 64 * i; asm volatile("" : "+v"(p));
        const LAS float* cw = wl + 2 * p;
        f32x2 wv[CW];
#pragma unroll
        for (int j = 0; j < CW; ++j) wv[j] = *(const LAS f32x2*)(cw + j * DA);
        const f32x2 cb = *(const f32x2*)(F.P.conv_b + l * DA + 2 * p);
        const LAS unsigned* tp = (const LAS unsigned*)(tile + (8 * w) * 1024 + 4 * p);
        f32x2 win[16];
#pragma unroll
        for (int k = 0; k < 16; ++k) { const unsigned u = tp[k * 256]; win[k] = (f32x2){__uint_as_float(u << 16), __uint_as_float(u & 0xffff0000u)}; }
#pragma unroll
        for (int o = 0; o < 8; ++o) out[i][o] = cb;
        __builtin_amdgcn_sched_barrier(0);
#pragma unroll
        for (int j = 0; j < CW; ++j) {
            if (!(PROBE_CONV == 1 && pv_))
#pragma unroll
            for (int o = 0; o < 8; ++o) out[i][o] += wv[j] * win[(j + o) & 15];
            asm volatile("" : "+v"(out[i][0]), "+v"(out[i][1]), "+v"(out[i][2]), "+v"(out[i][3]), "+v"(out[i][4]), "+v"(out[i][5]), "+v"(out[i][6]), "+v"(out[i][7]));
            if (j + 16 < 38) { const LAS unsigned* tq = tp; asm volatile("" : "+v"(tq)); const unsigned u = tq[(j + 16) * 256]; win[j & 15] = (f32x2){__uint_as_float(u << 16), __uint_as_float(u & 0xffff0000u)}; }
            __builtin_amdgcn_sched_barrier(0);
        }
#pragma unroll
        for (int o = 0; o < 8; ++o) { s1[o] += out[i][o].x + out[i][o].y; s2[o] += out[i][o].x * out[i][o].x + out[i][o].y * out[i][o].y; }
    }
    unsigned az[4][8];
#pragma unroll
    for (int i = 0; i < 4; ++i)
#pragma unroll
        for (int o = 0; o < 8; ++o) az[i][o] = *(const unsigned*)(B0 + (row0 + 8 * w + o) * 1024 + 2 * (lane + 64 * i));
#pragma unroll
    for (int o = 0; o < 8; ++o) { s1[o] = wsum(s1[o]); s2[o] = wsum(s2[o]); }
#pragma unroll
    for (int i = 0; i < 4; ++i) {
        const int p = lane + 64 * i;
        const f32x2 gg = *(const f32x2*)(F.P.cn_g + l * DA + 2 * p), be = *(const f32x2*)(F.P.cn_b + l * DA + 2 * p);
#pragma unroll
        for (int o = 0; o < 8; ++o) { const float mu = s1[o] * (1.f / DA), ex2 = s2[o] * (1.f / DA); const float rstd = rsqrtf(fmaxf(ex2 - mu * mu, 0.f) + EPS);
            f32x2 y = (out[i][o] - mu) * rstd * gg + be; y.x = y.x * fsigm(y.x); y.y = y.y * fsigm(y.y);
            *(unsigned*)(outb + (row0 + 8 * w + o) * 1024 + 2 * p) = cvt_pk_bf16(y.x * __uint_as_float(az[i][o] << 16), y.y * __uint_as_float(az[i][o] & 0xffff0000u)); }
    }
    __syncthreads();
}
__device__ __forceinline__ void p2_gmlp(Frame& F, int l, int unit, bf16_t* outb) {
    constexpr int VP = 528;
    const int tid = F.tid, lane = F.lane, w = F.wave, fr = lane & 15, fq = lane >> 4, ch = unit >> 1, gp = unit & 1, c0 = 256 * gp; const size_t row0 = (size_t)ch * CHK;
    LAS unsigned char* vr = F.lds + RING_OFF;
    const bf16_t* V = (const bf16_t*)(F.P.ws + WS_B3) + 512 + c0; const bf16_t* U = (const bf16_t*)(F.P.ws + WS_B0) + 512 + c0;
    const float* vss = (const float*)(F.P.ws + WS_VSS); const float* gn = F.P.gn_g + l * DB + c0;
    const size_t t = row0 + 16 * w + fr;
    unsigned long long uu[16];
#pragma unroll
    for (int n = 0; n < 16; ++n) uu[n] = *(const unsigned long long*)(U + t * 1024 + 16 * n + 4 * fq);
    bf16x8 wf[2][4];
#pragma unroll
    for (int g2 = 0; g2 < 2; ++g2)
#pragma unroll
        for (int ks = 0; ks < 4; ++ks) wf[g2][ks] = *(const bf16x8*)((const bf16_t*)(F.P.ws + WS_WSB) + ((size_t)(l * NG + 2 * gp + g2) * CHK + 16 * w + fr) * CHK + 32 * ks + 8 * fq);
    const float bs0 = F.P.b_s[(size_t)(l * NG + 2 * gp) * CHK + 16 * w + fr], bs1 = F.P.b_s[(size_t)(l * NG + 2 * gp + 1) * CHK + 16 * w + fr];
    { const int c8 = (tid & 31) * 8, sb = tid >> 5;
      const f32x4 g0 = *(const f32x4*)(gn + c8), g1 = *(const f32x4*)(gn + c8 + 4);
      u32x4 raw[8]; f32x4 qa[8], qb[8];
#pragma unroll
      for (int k = 0; k < 8; ++k) { const size_t s = row0 + sb + 16 * k; raw[k] = *(const u32x4*)(V + s * 1024 + c8); qa[k] = *(const f32x4*)(vss + s * 8); qb[k] = *(const f32x4*)(vss + s * 8 + 4); }
#pragma unroll
      for (int k = 0; k < 8; ++k) { const float ss = ((qa[k].x + qa[k].y) + (qa[k].z + qa[k].w)) + ((qb[k].x + qb[k].y) + (qb[k].z + qb[k].w)); const float rv = rsqrtf(ss * (1.f / DB) + EPS);
          f32x4 v0, v1; unpack8(raw[k], v0, v1); v0 = v0 * rv * g0; v1 = v1 * rv * g1;
          *(LAS u32x4*)(vr + (sb + 16 * k) * VP + c8 * 2) = pack8(v0, v1); } }
    __syncthreads();
    f32x4 acc[16];
#pragma unroll
    for (int n = 0; n < 16; ++n) acc[n] = (f32x4){0.f, 0.f, 0.f, 0.f};
    typedef short v4i16_t __attribute__((ext_vector_type(4)));
    const LAS unsigned char* tb = vr + (8 * fq + (fr >> 2)) * VP + (fr & 3) * 8;
#pragma unroll
    for (int ks = 0; ks < 4; ++ks) {
        if (32 * ks <= 16 * w + 15) {
#pragma unroll
            for (int n = 0; n < 16; ++n) {
                const v4i16_t lo = __builtin_amdgcn_ds_read_tr16_b64_v4i16((LAS v4i16_t*)(tb + (32 * ks) * VP + 32 * n));
                const v4i16_t hi = __builtin_amdgcn_ds_read_tr16_b64_v4i16((LAS v4i16_t*)(tb + (32 * ks + 4) * VP + 32 * n));
                const bf16x8 vf = (bf16x8){lo[0], lo[1], lo[2], lo[3], hi[0], hi[1], hi[2], hi[3]};
                acc[n] = __builtin_amdgcn_mfma_f32_16x16x32_bf16(vf, wf[n >> 3][ks], acc[n], 0, 0, 0); }
        }
    }
#pragma unroll
    for (int n = 0; n < 16; ++n) { const float bs = n < 8 ? bs0 : bs1;
        const unsigned u0 = (unsigned)uu[n], u1 = (unsigned)(uu[n] >> 32);
        const float o0 = __uint_as_float(u0 << 16) * (acc[n][0] + bs), o1 = __uint_as_float(u0 & 0xffff0000u) * (acc[n][1] + bs);
        const float o2 = __uint_as_float(u1 << 16) * (acc[n][2] + bs), o3 = __uint_as_float(u1 & 0xffff0000u) * (acc[n][3] + bs);
        *(unsigned long long*)(outb + 512 + c0 + t * 1024 + 16 * n + 4 * fq) = (unsigned long long)cvt_pk_bf16(o0, o1) | ((unsigned long long)cvt_pk_bf16(o2, o3) << 32); }
    __syncthreads();
}

__global__ void __launch_bounds__(NWAVES * 64, 2) mk_fwd(Args args) {
    extern __shared__ __attribute__((aligned(16))) unsigned char lds[];
    Frame F;
    F.lds = (LAS unsigned char*)lds;
    volatile LAS unsigned* MISC = (volatile LAS unsigned*)(F.lds + MISC_OFF);
    F.tid = threadIdx.x; F.lane = F.tid & 63; F.wave = __builtin_amdgcn_readfirstlane(F.tid >> 6);
    F.G = gridDim.x; { const int bx = blockIdx.x; F.vcu = (F.G % 8 == 0) ? (bx % 8) * (F.G / 8) + bx / 8 : bx; }
    F.P.x = args.in[0]; F.P.norm_g = args.in[1]; F.P.w_in = args.in[2]; F.P.b_gate = args.in[3]; F.P.conv_w = args.in[4]; F.P.conv_b = args.in[5]; F.P.cn_g = args.in[6]; F.P.cn_b = args.in[7]; F.P.w_a = args.in[8];
    F.P.gn_g = args.in[9]; F.P.w_s = args.in[10]; F.P.b_s = args.in[11]; F.P.w_b = args.in[12]; F.P.qn_g = args.in[13]; F.P.kn_g = args.in[14]; F.P.b_f = args.in[15]; F.P.w_c = args.in[16]; F.P.w_out = args.in[17];
    F.P.out = args.out; F.P.ws = args.ws;
    gu32* ctl = (gu32*)(args.ws + WS_CTL);
    for (int u = F.tid; u < (LDS_BYTES - LDSCTL_OFF) / 4; u += NWAVES * 64) ((LAS unsigned*)(F.lds + LDSCTL_OFF))[u] = 0u;
    __syncthreads();
    XcdBarrier bar = xcd_barrier_post((unsigned*)(ctl + CW_BAR) + args.li * XCD_BAR_WORDS, MISC + 8);

    bool dup_done = false;
    for (int ph = args.ph_lo; ph < args.ph_hi;) {
        const int l = ph / 5, p = ph % 5;
        const bool dummy = (PROBE_DUP >= 0) && p == PROBE_DUP && !dup_done;
        asm volatile("" : "+v"(F.tid)); F.lane = F.tid & 63;
        int bid = (int)blockIdx.x; asm volatile("" : "+s"(bid));
        unsigned char* ws = F.P.ws; unsigned char* wl = ws + WS_W + (size_t)l * W_LAYER;
        const float* xin = l == 0 ? F.P.x : F.P.out;
        if (p == 0) {
            if (l > 0) { ++ph; continue; }
            if (l == 0 && (!dummy || (PROBE_SUB & 1))) p0_weights(F);
            if (!dummy || (PROBE_SUB & 2)) p0_ln(F, l, xin);
        } else if (p == 1) {
            if (bid < NB * NH) p1_scan(F, bid, l);
            { pg8::TileOrder T0; T0.init(M, N1, F.G, bid); int pm_ = 0, pn_ = 0; (void)T0.tile(0, pm_, pn_);
              LAS float* Rt = (LAS float*)(F.lds + RT_OFF);
              if (F.tid < 256) { float r = 1.f; if (l > 0) { const f32x4 q = *(const f32x4*)((const float*)(ws + WS_SSP) + ((size_t)pm_ * 256 + F.tid) * 4); r = rsqrtf(((q.x + q.y) + (q.z + q.w)) * (1.f / D) + EPS); } Rt[F.tid] = r; }
              __syncthreads(); }
            pg8::SchedG1 S; S.T.init(M, N1, F.G, bid); S.A = (const char*)(ws + WS_H); S.B = (const char*)(wl + WO_W1);
            pg8::EpiG1 E{(bf16_t*)(ws + WS_B0), (bf16_t*)(ws + WS_B1), (bf16_t*)(ws + WS_B2), (bf16_t*)(ws + WS_B3), (bf16_t*)(ws + WS_B4), (float*)(ws + WS_VSS), F.P.qn_g + l * HD, F.P.kn_g + l * HD, (const LAS float*)(F.lds + RT_OFF)};
            pg8::gemm_phase<pg8::EpiG1, pg8::SchedG1>(F.lds + RING_OFF, S, E);
        } else if (p == 2) {
            for (int part = 0; part < 2; ++part) {
              asm volatile("" : "+v"(F.tid)); F.lane = F.tid & 63; asm volatile("" : "+s"(bid));
              if ((part == 0) == ((F.vcu & 1) == 0)) {
            if (!dummy || (PROBE_SUB & 1)) p2_conv(F, l, bid, dummy ? (bf16_t*)(ws + WS_DUMMY) : (bf16_t*)(ws + WS_B0), dummy);
            if (!dummy || (PROBE_SUB & 2)) { bf16_t* ob = dummy ? (bf16_t*)(ws + WS_DUMMY) : (bf16_t*)(ws + WS_B0); p2_gmlp(F, l, bid, ob); }
              } else {
            if (!dummy || (PROBE_SUB & 4)) { const int bh = F.vcu >> 3, sq = F.vcu & 7; const attn_body::bf16* b1 = (const attn_body::bf16*)(ws + WS_B1); const attn_body::bf16* b2 = (const attn_body::bf16*)(ws + WS_B2);
              const float* c2g = (const float*)(ws + WS_CS) + (size_t)bh * SEQ; const int* tsg = (const int*)(ws + WS_TS) + bh * 16;
              float gqm = fabsf(F.P.qn_g[l * HD + F.lane]), gkm = fabsf(F.P.kn_g[l * HD + F.lane]);
#pragma unroll
              for (int o_ = 1; o_ < 64; o_ <<= 1) { gqm = fmaxf(gqm, __shfl_xor(gqm, o_)); gkm = fmaxf(gkm, __shfl_xor(gkm, o_)); }
              const float ub = 64.f * C2 * gqm * gkm * 1.01f;
              for (int i = 0; i < 2; ++i) { const int qb = i == 0 ? 15 - sq : sq; const int ts = __builtin_amdgcn_readfirstlane(tsg[qb]); attn_body::attn_unit<8>(bh / NH, bh % NH, qb, b1, b1 + 512, b2, b2 + 512, dummy ? (attn_body::bf16*)(ws + WS_DUMMY) : (attn_body::bf16*)(ws + WS_B1), c2g, ts, ub, (char*)lds + RING_OFF); } }
              }
            }
        } else if (p == 3) {
            pg8::TileOrder T; T.init(M, D, F.G, bid);
            pg8::SchedMerge S; { int pm_ = 0, pn_ = 0; S.ok = T.tile(0, pm_, pn_); S.pm = pm_; S.pn = pn_; }
            S.ws = (const char*)ws; S.wl = (const char*)wl;
            S.cls = F.vcu & 1;
            pg8::EpiMerge E{ws + WS_GT + (size_t)bid * 131072, (bf16_t*)(ws + WS_MG), F.P.b_gate + (size_t)l * 3072, (const LAS float*)(F.lds + RT_OFF), S.cls, (size_t)(WS_B4 - WS_GT), dummy};
            pg8::gemm_phase<pg8::EpiMerge, pg8::SchedMerge>(F.lds + RING_OFF, S, E);
        } else {
            pg8::SchedG1 S; S.T.init(M, D, F.G, bid); S.A = (const char*)(ws + WS_MG); S.B = (const char*)(wl + WO_WO);
            if (l + 1 < NL) {
                pg8::EpiOutLN E{xin, (bf16_t*)(ws + WS_H), F.P.norm_g + (size_t)(l + 1) * D, F.P.w_in + (size_t)(l + 1) * D * NIN + OC_F, (float*)(ws + WS_SSP), (float*)(ws + WS_FP)};
                pg8::gemm_phase<pg8::EpiOutLN, pg8::SchedG1>(F.lds + RING_OFF, S, E);
            } else {
                pg8::EpiOutB E{(const bf16_t*)(ws + WS_H), dummy ? (float*)(ws + WS_B0) : F.P.out};
                pg8::gemm_phase<pg8::EpiOutB, pg8::SchedG1>(F.lds + RING_OFF, S, E);
            }
        }
        if (dummy) { dup_done = true; continue; }
        dup_done = false; ++ph;
        if (ph < args.ph_hi) xcd_barrier(bar);
    }
}

#ifndef MK_MODE
#define MK_MODE 2
#endif
extern "C" void kernel_launch(void* const* d_in, const int* in_sizes, int n_in, void* d_out, int out_size, void* d_ws, size_t ws_size, hipStream_t stream) {
    static int ok = 0;
    if (ok == 0) {
        if (n_in != 18 || in_sizes[0] != M * D || out_size != M * D || ws_size < WS_END) { fprintf(stderr, "kernel_launch: unexpected shapes (n_in %d in0 %d out %d ws %zu)\n", n_in, n_in > 0 ? in_sizes[0] : -1, out_size, ws_size); ok = -1; return; }
        const int tl = 64 * TLD * 4;
        (void)hipFuncSetAttribute((const void*)nv_gemm1, hipFuncAttributeMaxDynamicSharedMemorySize, tl);
        (void)hipFuncSetAttribute((const void*)nv_merge, hipFuncAttributeMaxDynamicSharedMemorySize, 2 * 64 * 256 * 4);
        (void)hipFuncSetAttribute((const void*)nv_gmlp, hipFuncAttributeMaxDynamicSharedMemorySize, 128 * 129 * 4);
        (void)hipFuncSetAttribute((const void*)nv_attn, hipFuncAttributeMaxDynamicSharedMemorySize, 4 * SEQ * 4);
        if (hipFuncSetAttribute((const void*)mk_fwd, hipFuncAttributeMaxDynamicSharedMemorySize, LDS_BYTES) != hipSuccess) { fprintf(stderr, "kernel_launch: hipFuncSetAttribute(mk_fwd) failed\n"); ok = -1; return; }
        int dev = 0, cus = 0; (void)hipGetDevice(&dev); (void)hipDeviceGetAttribute(&cus, hipDeviceAttributeMultiprocessorCount, dev);
        if (cus != 256) fprintf(stderr, "kernel_launch: note: %d CUs (built for 256)\n", cus);
        (void)hipGetLastError();
        ok = 1;
    }
    if (ok < 0) return;
    Ptrs P{};
    const float** pp = (const float**)&P;
    for (int i = 0; i < 18; ++i) pp[i] = (const float*)d_in[i];
    P.out = (float*)d_out; P.ws = (unsigned char*)d_ws;
    const int tl = 64 * TLD * 4;
#if MK_MODE == 0
    nv_prep<<<2048, 256, 0, stream>>>(P);
    for (int l = 0; l < NL; ++l) {
        const float* xin = l == 0 ? P.x : P.out;
        nv_ln<<<M / 4, 256, 0, stream>>>(P, l, xin);
        nv_scan<<<NB * NH, 256, 0, stream>>>(P);
        nv_gemm1<<<dim3(20, 256), 256, tl, stream>>>(P, l);
        nv_conv<<<M, 512, 0, stream>>>(P, l);
        nv_gmlp<<<dim3(128, 4), 256, 128 * 129 * 4, stream>>>(P, l);
        nv_attn<<<M * NH / 4, 256, 4 * SEQ * 4, stream>>>(P);
        nv_merge<<<dim3(4, 256), 256, 2 * 64 * 256 * 4, stream>>>(P, l);
        nv_out<<<dim3(4, 256), 256, 0, stream>>>(P, l, xin, P.out);
    }
#else
    (void)tl;
    if (hipMemsetAsync((char*)d_ws + WS_CTL, 0, CTL_ZERO_BYTES, stream) != hipSuccess) { fprintf(stderr, "kernel_launch: memset failed\n"); return; }
    Args a{};
    for (int i = 0; i < 18; ++i) a.in[i] = (const float*)d_in[i];
    a.out = (float*)d_out; a.ws = (unsigned char*)d_ws;
    auto mk = [&](int lo, int hi, int li) { a.ph_lo = lo; a.ph_hi = hi; a.li = li; hipLaunchKernelGGL(mk_fwd, dim3(256), dim3(NWAVES * 64), LDS_BYTES, stream, a);
        const hipError_t le = hipPeekAtLastError(); if (le != hipSuccess) fprintf(stderr, "kernel_launch: mk launch [%d,%d) failed: %s\n", lo, hi, hipGetErrorName(le)); };
#if MK_MODE == 1
    auto mixers = [&](int l) { nv_conv<<<M, 512, 0, stream>>>(P, l); nv_gmlp<<<dim3(128, 4), 256, 128 * 129 * 4, stream>>>(P, l); nv_attn<<<M * NH / 4, 256, 4 * SEQ * 4, stream>>>(P); };
    mk(0, 2, 0); mixers(0); mk(3, 7, 1); mixers(1); mk(8, 10, 2);
#else
    mk(0, NPH, 0);
#endif
#endif
}
```

```cpp
#include <hip/hip_runtime.h>
#include <cstdio>
#include <cstdint>
#include <cmath>

constexpr int NL = 2, NB = 4, SEQ = 4096, M = NB * SEQ, D = 1024;
constexpr int DA = 512, DB = 512, NH = 8, HD = 64, DC = 512, CW = 31, CHK = 128, NG = 4, GD = 128, NIN = 8200;
constexpr float EPS = 1e-6f;
constexpr float LOG2E = 1.4426950408889634f;
constexpr float C2 = 0.125f * LOG2E;
constexpr int N1 = 5120;
constexpr int OC_GATE = 0, OC_AIN = 3072, OC_AZ = 4096, OC_U = 4608, OC_V = 5120, OC_BZ = 5632, OC_Q = 6144, OC_K = 6656, OC_VA = 7168, OC_CZ = 7680, OC_F = 8192;

constexpr size_t MiB = 1u << 20;
constexpr size_t WS_CTL = 0, CTL_ZERO_BYTES = 64 * 1024;
constexpr size_t WS_VSS = 1 * MiB;
constexpr size_t WS_LOGF = WS_VSS + 512 * 1024;
constexpr size_t WS_CS = 2 * MiB;
constexpr size_t WS_WSB = WS_CS + 512 * 1024;
constexpr size_t WS_TS = 3 * MiB;
constexpr size_t WS_W = 4 * MiB, W_LAYER = 22 * MiB;
constexpr size_t WO_W1 = 0, WO_WG = 10 * MiB, WO_WAB = 16 * MiB, WO_WC = 18 * MiB, WO_WO = 20 * MiB;
constexpr size_t WS_H = 48 * MiB;
constexpr size_t WS_B0 = 80 * MiB;
constexpr size_t WS_B1 = 112 * MiB;
constexpr size_t WS_B2 = 144 * MiB;
constexpr size_t WS_B3 = 176 * MiB;
constexpr size_t WS_B4 = 208 * MiB;
constexpr size_t WS_GT = WS_B2, WS_MG = WS_B3;
constexpr size_t WS_FP = 240 * MiB;
constexpr size_t WS_SSP = 242 * MiB;
constexpr size_t WS_DUMMY = 224 * MiB;
constexpr size_t WS_END = 256 * MiB;
#ifndef PROBE_TSW
#define PROBE_TSW 0
#endif
#ifndef PROBE_TSQ
#define PROBE_TSQ 8
#endif
#ifndef PROBE_TS
#define PROBE_TS -1
#endif
#define PROBE_ANY (PROBE_DUP >= 0)
#ifndef PROBE_P3
#define PROBE_P3 0
#endif
#ifndef PROBE_CONV
#define PROBE_CONV 0
#endif
#ifndef PROBE_SUB
#define PROBE_SUB 7
#endif
#ifndef PROBE_DUP
#define PROBE_DUP -1
#endif

typedef unsigned short bf16_t;
typedef short bf16x8 __attribute__((ext_vector_type(8)));
typedef float f32x4 __attribute__((ext_vector_type(4)));
typedef unsigned u32x4 __attribute__((ext_vector_type(4)));
typedef unsigned u32x2 __attribute__((ext_vector_type(2)));
typedef int i32x4 __attribute__((ext_vector_type(4)));
typedef int i32x8 __attribute__((ext_vector_type(8)));
#define F8_WSCALE 64.f
__device__ __forceinline__ unsigned pk4f8(float a, float b, float c, float d) { int w = __builtin_amdgcn_cvt_pk_fp8_f32(a, b, 0, false); w = __builtin_amdgcn_cvt_pk_fp8_f32(c, d, w, true); return (unsigned)w; }

__host__ __device__ __forceinline__ float bf2f(bf16_t v) { union { unsigned u; float f; } c; c.u = (unsigned)v << 16; return c.f; }
__host__ __device__ __forceinline__ bf16_t f2bf(float f) { union { unsigned u; float f; } c; c.f = f; unsigned u = c.u; return (bf16_t)((u + 0x7fffu + ((u >> 16) & 1u)) >> 16); }
__device__ __forceinline__ float bfr(float f) { return bf2f(f2bf(f)); }
__device__ __forceinline__ float sigm(float x) { return 1.f / (1.f + __expf(-x)); }
__device__ __forceinline__ float siluf(float x) { return x * sigm(x); }

__host__ __device__ __forceinline__ int g1_col(int n) {
    const int j = n >> 8, lc = n & 255;
    if (j < 4) return lc < 128 ? OC_AIN + 128 * j + lc : OC_AIN + 512 + 128 * j + (lc - 128);
    if (j < 6) return OC_AZ + 256 * (j - 4) + lc;
    if (j < 8 || (j >= 10 && j < 12)) { const int k = j < 8 ? j - 6 : j - 8; return lc < 128 ? OC_U + 128 * k + lc : OC_BZ + 128 * k + (lc - 128); }
    if (j < 10) return OC_V + 256 * (j - 8) + lc;
    if (j < 16) { const int isk = j >= 14, jj = (j - 12) & 1, head = 4 * jj + ((lc >> 5) & 3), d = 32 * (lc >> 7) + (lc & 31); return (isk ? OC_K : OC_Q) + 64 * head + d; }
    if (j < 18) return OC_VA + 256 * (j - 16) + lc;
    return OC_CZ + 256 * (j - 18) + lc;
}

struct Ptrs {
    const float *x, *norm_g, *w_in, *b_gate, *conv_w, *conv_b, *cn_g, *cn_b, *w_a, *gn_g, *w_s, *b_s, *w_b, *qn_g, *kn_g, *b_f, *w_c, *w_out;
    float* out; unsigned char* ws;
};

__global__ void nv_prep(Ptrs P) {
    const size_t gid = (size_t)blockIdx.x * blockDim.x + threadIdx.x, gsz = (size_t)gridDim.x * blockDim.x;
    for (int l = 0; l < NL; ++l) {
        unsigned char* wl = P.ws + WS_W + (size_t)l * W_LAYER;
        bf16_t* W1 = (bf16_t*)(wl + WO_W1); bf16_t* WG = (bf16_t*)(wl + WO_WG); bf16_t* WAB = (bf16_t*)(wl + WO_WAB); bf16_t* WC = (bf16_t*)(wl + WO_WC); bf16_t* WO = (bf16_t*)(wl + WO_WO);
        const float* win = P.w_in + (size_t)l * D * NIN;
        for (size_t i = gid; i < (size_t)N1 * D; i += gsz) { const int n = (int)(i >> 10), k = (int)(i & 1023); W1[i] = f2bf(win[(size_t)k * NIN + g1_col(n)]); }
        for (size_t i = gid; i < (size_t)3072 * D; i += gsz) { const int n = (int)(i >> 10), k = (int)(i & 1023); WG[i] = f2bf(win[(size_t)k * NIN + n]); }
        for (size_t i = gid; i < (size_t)1024 * 1024; i += gsz) { const int n = (int)(i >> 10), k = (int)(i & 1023);
            WAB[i] = f2bf(k < 512 ? P.w_a[((size_t)l * DA + k) * D + n] : P.w_b[((size_t)l * DB + (k - 512)) * D + n]);
            WC[i] = k < 512 ? f2bf(P.w_c[((size_t)l * DC + k) * D + n]) : (bf16_t)0;
            WO[i] = f2bf(P.w_out[((size_t)l * D + k) * D + n]); }
        bf16_t* WSB = (bf16_t*)(P.ws + WS_WSB) + (size_t)l * NG * CHK * CHK;
        for (size_t i = gid; i < (size_t)NG * CHK * CHK; i += gsz) { const int s = (int)(i & 127), t = (int)((i >> 7) & 127); WSB[i] = s <= t ? f2bf(P.w_s[(size_t)l * NG * CHK * CHK + i]) : (bf16_t)0; }
    }
}

__device__ __forceinline__ float wave_sum(float v) {
#pragma unroll
    for (int o = 1; o < 64; o <<= 1) v += __shfl_xor(v, o);
    return v;
}

__global__ void nv_ln(Ptrs P, int l, const float* xin) {
    const int lane = threadIdx.x & 63, row = blockIdx.x * 4 + (threadIdx.x >> 6);
    const float* xr = xin + (size_t)row * D; const float* g = P.norm_g + (size_t)l * D; const float* win = P.w_in + (size_t)l * D * NIN;
    float v[16]; float ss = 0.f;
#pragma unroll
    for (int j = 0; j < 16; ++j) { v[j] = xr[lane + 64 * j]; ss += v[j] * v[j]; }
    ss = wave_sum(ss);
    const float r = rsqrtf(ss * (1.f / D) + EPS);
    bf16_t* h = (bf16_t*)(P.ws + WS_H) + (size_t)row * D;
    float f[8] = {0, 0, 0, 0, 0, 0, 0, 0};
#pragma unroll
    for (int j = 0; j < 16; ++j) { const int k = lane + 64 * j; const float hv = v[j] * r * g[k]; h[k] = f2bf(hv);
#pragma unroll
        for (int e = 0; e < 8; ++e) f[e] += hv * win[(size_t)k * NIN + OC_F + e]; }
#pragma unroll
    for (int e = 0; e < 8; ++e) f[e] = wave_sum(f[e]);
    if (lane < 8) { float z = 0.f;
#pragma unroll
        for (int e = 0; e < 8; ++e) if (lane == e) z = f[e];
        z += P.b_f[l * NH + lane];
        const float lf = fminf(z, 0.f) - log1pf(expf(-fabsf(z)));
        ((float*)(P.ws + WS_LOGF))[(size_t)row * 8 + lane] = lf; }
}

__global__ void nv_scan(Ptrs P) {
    __shared__ float buf[SEQ];
    const int bh = blockIdx.x, b = bh / NH, h = bh % NH;
    const float* lf = (const float*)(P.ws + WS_LOGF);
    for (int t = threadIdx.x; t < SEQ; t += blockDim.x) buf[t] = lf[((size_t)b * SEQ + t) * 8 + h];
    __syncthreads();
    if (threadIdx.x == 0) { float c = 0.f; for (int t = 0; t < SEQ; ++t) { c += buf[t]; buf[t] = c * LOG2E; } }
    __syncthreads();
    float* cs = (float*)(P.ws + WS_CS) + (size_t)bh * SEQ;
    for (int t = threadIdx.x; t < SEQ; t += blockDim.x) cs[t] = buf[t];
}

constexpr int TLD = 257;
__device__ __forceinline__ void nv_gemm_acc(const bf16_t* A, int lda, const bf16_t* Bt, int ldb, int K, f32x4 (&acc)[4][4]) {
    const int tid = threadIdx.x, w = tid >> 6, l = tid & 63, fr = l & 15, fq = l >> 4;
#pragma unroll
    for (int m = 0; m < 4; ++m)
#pragma unroll
        for (int n = 0; n < 4; ++n) acc[m][n] = (f32x4){0.f, 0.f, 0.f, 0.f};
    for (int k0 = 0; k0 < K; k0 += 32) {
        bf16x8 a[4], b[4];
#pragma unroll
        for (int m = 0; m < 4; ++m) a[m] = *(const bf16x8*)(A + (size_t)(16 * m + fr) * lda + k0 + 8 * fq);
#pragma unroll
        for (int n = 0; n < 4; ++n) b[n] = *(const bf16x8*)(Bt + (size_t)(64 * w + 16 * n + fr) * ldb + k0 + 8 * fq);
#pragma unroll
        for (int m = 0; m < 4; ++m)
#pragma unroll
            for (int n = 0; n < 4; ++n) acc[m][n] = __builtin_amdgcn_mfma_f32_16x16x32_bf16(a[m], b[n], acc[m][n], 0, 0, 0);
    }
}
__device__ __forceinline__ void nv_gemm_tile(const bf16_t* A, int lda, const bf16_t* Bt, int ldb, int K, float* T) {
    const int tid = threadIdx.x, w = tid >> 6, l = tid & 63, fr = l & 15, fq = l >> 4;
    f32x4 acc[4][4];
    nv_gemm_acc(A, lda, Bt, ldb, K, acc);
#pragma unroll
    for (int m = 0; m < 4; ++m)
#pragma unroll
        for (int n = 0; n < 4; ++n)
#pragma unroll
            for (int r = 0; r < 4; ++r) T[(16 * m + 4 * fq + r) * TLD + 64 * w + 16 * n + fr] = acc[m][n][r];
}

__global__ void __launch_bounds__(256) nv_gemm1(Ptrs P, int l) {
    extern __shared__ float T[];
    __shared__ float R[64 * 4];
    const int j = blockIdx.x, row0 = blockIdx.y * 64, tid = threadIdx.x;
    const bf16_t* H = (const bf16_t*)(P.ws + WS_H);
    const bf16_t* W1 = (const bf16_t*)(P.ws + WS_W + (size_t)l * W_LAYER + WO_W1);
    nv_gemm_tile(H + (size_t)row0 * D, D, W1 + (size_t)j * 256 * D, D, D, T);
    __syncthreads();
    bf16_t* B0 = (bf16_t*)(P.ws + WS_B0); bf16_t* B1 = (bf16_t*)(P.ws + WS_B1); bf16_t* B2 = (bf16_t*)(P.ws + WS_B2); bf16_t* B3 = (bf16_t*)(P.ws + WS_B3); bf16_t* B4 = (bf16_t*)(P.ws + WS_B4);
    if (j < 4) {
        for (int e = tid; e < 64 * 128; e += 256) { const int r = e >> 7, c = e & 127; B3[(size_t)(row0 + r) * 1024 + 128 * j + c] = f2bf(T[r * TLD + c] * sigm(T[r * TLD + c + 128])); }
    } else if (j < 12 || j >= 16) {
        bf16_t* dst; int pitch, coff; bool act;
        if (j < 6) { dst = B0; pitch = 1024; coff = 256 * (j - 4); act = true; }
        else if (j < 8) { dst = B0; pitch = 1024; coff = 512 + 256 * (j - 6); act = false; }
        else if (j < 10) { dst = B3; pitch = 1024; coff = 512 + 256 * (j - 8); act = false; }
        else if (j < 12) { dst = B4; pitch = 512; coff = 256 * (j - 10); act = true; }
        else if (j < 18) { dst = B2; pitch = 1024; coff = 256 * (j - 16); act = false; }
        else { dst = B2; pitch = 1024; coff = 512 + 256 * (j - 18); act = true; }
        for (int e = tid; e < 64 * 256; e += 256) { const int r = e >> 8, c = e & 255; const float v = T[r * TLD + c]; dst[(size_t)(row0 + r) * pitch + coff + c] = f2bf(act ? siluf(v) : v); }
        if (j == 8 || j == 9) { const int r = tid >> 2, wc = tid & 3; float s = 0.f;
            for (int bj = 0; bj < 2; ++bj) for (int i = 0; i < 32; ++i) { const float v = T[r * TLD + 128 * bj + 32 * wc + i]; s += v * v; }
            ((float*)(P.ws + WS_VSS))[(size_t)(row0 + r) * 8 + (j - 8) * 4 + wc] = s; }
    } else {
        const bool isk = j >= 14; const int jj = (j - 12) & 1;
        { const int r = tid >> 2, hh = tid & 3; float s = 0.f;
          for (int d = 0; d < 64; ++d) { const float v = T[r * TLD + 128 * (d >> 5) + 32 * hh + (d & 31)]; s += v * v; }
          R[r * 4 + hh] = rsqrtf(s * (1.f / 64.f) + EPS); }
        __syncthreads();
        const float* gq = (isk ? P.kn_g : P.qn_g) + (size_t)l * HD;
        for (int e = tid; e < 64 * 256; e += 256) { const int r = e >> 8, c = e & 255, hh = (c >> 5) & 3, d = 32 * (c >> 7) + (c & 31);
            float v = T[r * TLD + c] * R[r * 4 + hh] * gq[d]; if (!isk) v *= C2;
            B1[(size_t)(row0 + r) * 1024 + (isk ? 512 : 0) + 64 * (4 * jj + hh) + d] = f2bf(v); }
    }
}

__global__ void __launch_bounds__(512) nv_conv(Ptrs P, int l) {
    __shared__ float red[16];
    const int row = blockIdx.x, t = row % SEQ, c = threadIdx.x, lane = c & 63, w = c >> 6;
    const bf16_t* AG = (const bf16_t*)(P.ws + WS_B3); bf16_t* B0 = (bf16_t*)(P.ws + WS_B0);
    const float* cw = P.conv_w + (size_t)l * CW * DA;
    float a = P.conv_b[l * DA + c];
    for (int j = 0; j < CW; ++j) { const int tt = t - (CW - 1) + j; if (tt >= 0) a += cw[j * DA + c] * bf2f(AG[(size_t)(row - (CW - 1) + j) * 1024 + c]); }
    float s = wave_sum(a); if (lane == 0) red[w] = s; __syncthreads();
    float mu = 0.f; for (int i = 0; i < 8; ++i) mu += red[i]; mu *= (1.f / DA);
    const float d = a - mu; s = wave_sum(d * d); if (lane == 0) red[8 + w] = s; __syncthreads();
    float var = 0.f; for (int i = 0; i < 8; ++i) var += red[8 + i]; var *= (1.f / DA);
    const float y = d * rsqrtf(var + EPS) * P.cn_g[l * DA + c] + P.cn_b[l * DA + c];
    const float az = bf2f(B0[(size_t)row * 1024 + c]);
    B0[(size_t)row * 1024 + c] = f2bf(siluf(y) * az);
}

__global__ void __launch_bounds__(256) nv_gmlp(Ptrs P, int l) {
    extern __shared__ float vn[];
    const int ch = blockIdx.x, g = blockIdx.y, tid = threadIdx.x; const size_t row0 = (size_t)ch * CHK;
    const bf16_t* V = (const bf16_t*)(P.ws + WS_B3); bf16_t* B0 = (bf16_t*)(P.ws + WS_B0); const bf16_t* BZ = (const bf16_t*)(P.ws + WS_B4);
    const float* vss = (const float*)(P.ws + WS_VSS);
    const bf16_t* WSB = (const bf16_t*)(P.ws + WS_WSB) + ((size_t)l * NG + g) * CHK * CHK;
    for (int e = tid; e < 128 * 128; e += 256) { const int s = e >> 7, c = e & 127; const float* q = vss + (row0 + s) * 8;
        const float ss = ((q[0] + q[1]) + (q[2] + q[3])) + ((q[4] + q[5]) + (q[6] + q[7])); const float rv = rsqrtf(ss * (1.f / DB) + EPS);
        vn[s * 129 + c] = bfr(bf2f(V[(row0 + s) * 1024 + 512 + 128 * g + c]) * rv * P.gn_g[l * DB + 128 * g + c]); }
    __syncthreads();
    for (int e = tid; e < 128 * 128; e += 256) { const int t = e >> 7, c = e & 127; float acc = 0.f;
        for (int s = 0; s <= t; ++s) acc += bf2f(WSB[t * 128 + s]) * vn[s * 129 + c];
        acc += P.b_s[((size_t)l * NG + g) * CHK + t];
        const size_t o = (row0 + t) * 1024 + 512 + 128 * g + c;
        B0[o] = f2bf(bf2f(B0[o]) * acc * bf2f(BZ[(row0 + t) * 512 + 128 * g + c])); }
}

__global__ void __launch_bounds__(256) nv_attn(Ptrs P) {
    extern __shared__ float sc[];
    const int lane = threadIdx.x & 63, w = threadIdx.x >> 6; const int item = blockIdx.x * 4 + w, row = item >> 3, h = item & 7, b = row / SEQ, t = row % SEQ;
    float* s = sc + w * SEQ;
    bf16_t* B1 = (bf16_t*)(P.ws + WS_B1); const bf16_t* B2 = (const bf16_t*)(P.ws + WS_B2);
    const float* cs = (const float*)(P.ws + WS_CS) + (size_t)(b * NH + h) * SEQ;
    float q[64];
#pragma unroll
    for (int d = 0; d < 64; ++d) q[d] = bf2f(B1[(size_t)row * 1024 + 64 * h + d]);
    const float cq = cs[t]; float mx = -INFINITY;
    for (int k = lane; k <= t; k += 64) { const bf16_t* kr = B1 + ((size_t)b * SEQ + k) * 1024 + 512 + 64 * h; float dot = 0.f;
#pragma unroll
        for (int d8 = 0; d8 < 8; ++d8) { const bf16x8 kv = *(const bf16x8*)(kr + 8 * d8);
#pragma unroll
            for (int e = 0; e < 8; ++e) dot += q[8 * d8 + e] * bf2f((bf16_t)kv[e]); }
        const float v = dot + (cq - cs[k]); s[k] = v; mx = fmaxf(mx, v); }
#pragma unroll
    for (int o = 1; o < 64; o <<= 1) mx = fmaxf(mx, __shfl_xor(mx, o));
    float lsum = 0.f;
    for (int k = lane; k <= t; k += 64) { const float p = exp2f(s[k] - mx); lsum += p; s[k] = bfr(p); }
    lsum = wave_sum(lsum);
    __builtin_amdgcn_s_waitcnt(0); __builtin_amdgcn_wave_barrier();
    float o = 0.f; const bf16_t* vb = B2 + (size_t)b * SEQ * 1024 + 64 * h + lane;
    for (int k = 0; k <= t; ++k) o += s[k] * bf2f(vb[(size_t)k * 1024]);
    const float cz = bf2f(B2[(size_t)row * 1024 + 512 + 64 * h + lane]);
    B1[(size_t)row * 1024 + 64 * h + lane] = f2bf(o / lsum * cz);
}

__global__ void __launch_bounds__(256) nv_merge(Ptrs P, int l) {
    extern __shared__ float T[];
    const int pn = blockIdx.x, row0 = blockIdx.y * 64, tid = threadIdx.x, w = tid >> 6, ln = tid & 63, fr = ln & 15, fq = ln >> 4;
    const unsigned char* wl = P.ws + WS_W + (size_t)l * W_LAYER;
    const bf16_t* H = (const bf16_t*)(P.ws + WS_H); const bf16_t* WG = (const bf16_t*)(wl + WO_WG); const bf16_t* WAB = (const bf16_t*)(wl + WO_WAB); const bf16_t* WC = (const bf16_t*)(wl + WO_WC);
    const bf16_t* B0 = (const bf16_t*)(P.ws + WS_B0); const bf16_t* B1 = (const bf16_t*)(P.ws + WS_B1);
    float* G = T; float* MGs = T + 64 * 256;
    f32x4 acc[4][4];
    for (int br = 0; br < 3; ++br) {
        nv_gemm_acc(H + (size_t)row0 * D, D, WG + ((size_t)br * 1024 + 256 * pn) * D, D, D, acc);
#pragma unroll
        for (int m = 0; m < 4; ++m)
#pragma unroll
            for (int n = 0; n < 4; ++n)
#pragma unroll
                for (int r = 0; r < 4; ++r) { const int c = 64 * w + 16 * n + fr; G[((m * 4 + n) * 4 + r) * 256 + tid] = bfr(sigm(acc[m][n][r] + P.b_gate[(size_t)l * 3072 + br * 1024 + 256 * pn + c])); }
        const bf16_t* A = br == 0 ? B0 : (br == 1 ? B0 + 512 : B1); const bf16_t* Bt = br == 0 ? WAB : (br == 1 ? WAB + 512 : WC);
        nv_gemm_acc(A + (size_t)row0 * 1024, 1024, Bt + (size_t)256 * pn * 1024, 1024, 512, acc);
#pragma unroll
        for (int m = 0; m < 4; ++m)
#pragma unroll
            for (int n = 0; n < 4; ++n)
#pragma unroll
                for (int r = 0; r < 4; ++r) { const int s = ((m * 4 + n) * 4 + r) * 256 + tid; const float v = G[s] * acc[m][n][r]; MGs[s] = bfr(br == 0 ? v : MGs[s] + v); }
    }
    bf16_t* MG = (bf16_t*)(P.ws + WS_MG);
#pragma unroll
    for (int m = 0; m < 4; ++m)
#pragma unroll
        for (int n = 0; n < 4; ++n)
#pragma unroll
            for (int r = 0; r < 4; ++r) MG[(size_t)(row0 + 16 * m + 4 * fq + r) * 1024 + 256 * pn + 64 * w + 16 * n + fr] = f2bf(MGs[((m * 4 + n) * 4 + r) * 256 + tid]);
}

__global__ void __launch_bounds__(256) nv_out(Ptrs P, int l, const float* xin, float* xout) {
    const int pn = blockIdx.x, row0 = blockIdx.y * 64, tid = threadIdx.x, w = tid >> 6, ln = tid & 63, fr = ln & 15, fq = ln >> 4;
    const bf16_t* MG = (const bf16_t*)(P.ws + WS_MG); const bf16_t* WO = (const bf16_t*)(P.ws + WS_W + (size_t)l * W_LAYER + WO_WO);
    f32x4 acc[4][4];
    nv_gemm_acc(MG + (size_t)row0 * 1024, 1024, WO + (size_t)256 * pn * 1024, 1024, 1024, acc);
#pragma unroll
    for (int m = 0; m < 4; ++m)
#pragma unroll
        for (int n = 0; n < 4; ++n)
#pragma unroll
            for (int r = 0; r < 4; ++r) { const size_t o = (size_t)(row0 + 16 * m + 4 * fq + r) * D + 256 * pn + 64 * w + 16 * n + fr; xout[o] = xin[o] + acc[m][n][r]; }
}


#define LAS __attribute__((address_space(3)))
#define GAS __attribute__((address_space(1)))
__device__ __forceinline__ float wsum(float v) {
    v += __builtin_bit_cast(float, __builtin_amdgcn_update_dpp(0, __builtin_bit_cast(int, v), 0xB1, 0xF, 0xF, true));
    v += __builtin_bit_cast(float, __builtin_amdgcn_update_dpp(0, __builtin_bit_cast(int, v), 0x4E, 0xF, 0xF, true));
    v += __builtin_bit_cast(float, __builtin_amdgcn_update_dpp(0, __builtin_bit_cast(int, v), 0x141, 0xF, 0xF, true));
    v += __builtin_bit_cast(float, __builtin_amdgcn_update_dpp(0, __builtin_bit_cast(int, v), 0x140, 0xF, 0xF, true));
    const int iv = __builtin_bit_cast(int, v);
    return (__builtin_bit_cast(float, __builtin_amdgcn_readlane(iv, 0)) + __builtin_bit_cast(float, __builtin_amdgcn_readlane(iv, 16))) + (__builtin_bit_cast(float, __builtin_amdgcn_readlane(iv, 32)) + __builtin_bit_cast(float, __builtin_amdgcn_readlane(iv, 48)));
}
typedef GAS unsigned gu32;
#define RLX_AGENT __ATOMIC_RELAXED, __HIP_MEMORY_SCOPE_AGENT
#define LDS_WAIT() asm volatile("s_waitcnt lgkmcnt(0)" ::: "memory")
#define VM_WAIT() asm volatile("s_waitcnt vmcnt(0)" ::: "memory")
constexpr int NWAVES = 8;
constexpr int RING_OFF = 0, RING_BYTES = 131072;
constexpr int LDS_BYTES = 163840;
constexpr int LDSCTL_OFF = LDS_BYTES - 512, MISC_OFF = LDSCTL_OFF + 320;
constexpr int RT_OFF = LDSCTL_OFF - 1024;
constexpr int CW_TMO = 0, CW_CODE = 1, CW_BAR = 4096;
constexpr float SKIP_L2 = 160.f;
constexpr int NPH = 10;

__device__ __forceinline__ unsigned cvt_pk_bf16(float lo, float hi) { unsigned r; asm volatile("s_nop 0\n\tv_cvt_pk_bf16_f32 %0, %1, %2" : "=v"(r) : "v"(lo), "v"(hi)); return r; }
__device__ __forceinline__ float fsigm(float x) { return __builtin_amdgcn_rcpf(1.f + __builtin_amdgcn_exp2f(-LOG2E * x)); }
__device__ __forceinline__ float fsigm256(float x) { return __builtin_amdgcn_rcpf(0.00390625f + __builtin_amdgcn_exp2f(-LOG2E * x - 8.f)); }
__device__ __forceinline__ unsigned pk4u8(const f32x4& v) { unsigned w = __builtin_amdgcn_cvt_pk_u8_f32(v[0], 0, 0u); w = __builtin_amdgcn_cvt_pk_u8_f32(v[1], 1, w); w = __builtin_amdgcn_cvt_pk_u8_f32(v[2], 2, w); return __builtin_amdgcn_cvt_pk_u8_f32(v[3], 3, w); }
__device__ __forceinline__ f32x4 un4u8(unsigned w) { return (f32x4){(float)(w & 0xffu), (float)((w >> 8) & 0xffu), (float)((w >> 16) & 0xffu), (float)(w >> 24)}; }
__device__ __forceinline__ u32x4 pack8(const f32x4& a, const f32x4& b) { u32x4 w; w.x = cvt_pk_bf16(a[0], a[1]); w.y = cvt_pk_bf16(a[2], a[3]); w.z = cvt_pk_bf16(b[0], b[1]); w.w = cvt_pk_bf16(b[2], b[3]); return w; }
__device__ __forceinline__ void unpack8(const u32x4& w, f32x4& a, f32x4& b) {
    a[0] = __uint_as_float(w.x << 16); a[1] = __uint_as_float(w.x & 0xffff0000u); a[2] = __uint_as_float(w.y << 16); a[3] = __uint_as_float(w.y & 0xffff0000u);
    b[0] = __uint_as_float(w.z << 16); b[1] = __uint_as_float(w.z & 0xffff0000u); b[2] = __uint_as_float(w.w << 16); b[3] = __uint_as_float(w.w & 0xffff0000u); }

namespace pg8 {
constexpr int BM = 256, BK = 64, HALF = 128, HTB = HALF * BK * 2, STAGE_BYTES = 8 * HTB, NXCD = 8, WGM = 8, PITCH = 1024;
__host__ __device__ __forceinline__ int lds_byte(int r, int c) { const int st = (r >> 4) * 2 + (c >> 5), rr = r & 15, cc = c & 31, ob = rr * 64 + cc * 2; return st * 1024 + (ob ^ (((ob >> 9) & 1) << 5)); }
__host__ __device__ __forceinline__ void stage_rc(int b, int& R, int& C) { const int st = b / 1024, sb = b % 1024, swz = sb ^ (((sb >> 9) & 1) << 5); R = (st >> 1) * 16 + swz / 64; C = (st & 1) * 32 + (swz % 64) / 2; }
__host__ __device__ __forceinline__ int perm32(int rho) { const int n = rho >> 4, i = rho & 15; return 8 * (i >> 2) + 4 * n + (i & 3); }

struct Unit { const char* A; const char* B; int nt, pm, pn, tag; };

struct TileOrder {
    int nM, nN, nwg, G, c;
    __device__ __forceinline__ void init(int Mr, int N, int G_, int c_) { nM = Mr / BM; nN = N / BM; nwg = nM * nN; G = G_; c = c_; }
    __device__ __forceinline__ bool tile(int i, int& pm, int& pn) const {
        const long L = (long)i * G + c; if (L >= nwg) return false;
        int wgid = (int)L; { const int q = nwg / NXCD, r = nwg % NXCD, xcd = wgid % NXCD, off = wgid / NXCD; wgid = (xcd < r ? xcd * (q + 1) : r * (q + 1) + (xcd - r) * q) + off; }
        const int nig = WGM * nN, gid = wgid / nig, fm = gid * WGM, gsz = (nM - fm) < WGM ? (nM - fm) : WGM;
        pm = fm + ((wgid % nig) % gsz); pn = (wgid % nig) / gsz; return true;
    }
};

template <class Epi, class Sched, bool F8 = false, int RP = PITCH * 2, bool KEEP = false>
__device__ __forceinline__ void gemm_phase(LAS unsigned char* lds, const Sched& S, const Epi& E) {
    int tid = threadIdx.x; asm volatile("" : "+v"(tid));
    const int wid = __builtin_amdgcn_readfirstlane(tid >> 6), lane = tid & 63, wr = wid >> 2, wc = wid & 3, fr = lane & 15, fq = lane >> 4;
    unsigned voffA[2], voffB[2];
#pragma unroll
    for (int i = 0; i < 2; ++i) { int R, C; stage_rc(tid * 16 + i * 8192, R, C); const int Rb = (R & ~31) + perm32(R & 31);
        voffA[i] = (unsigned)(R * RP + C * 2); voffB[i] = (unsigned)(Rb * RP + C * 2); }
    const size_t kstep = (size_t)(BK * 2);
    const size_t hstep = (size_t)HALF * RP;
    const unsigned ldsw = (unsigned)wid * 1024u;
    const int aoff = lds_byte(wr * 64 + fr, fq * 8), boff = lds_byte(wc * 32 + fr, fq * 8);
#define PG8_SA(b, h) (((b) * 2 + (h)) * HTB)
#define PG8_SB(b, h) ((4 + (b) * 2 + (h)) * HTB)
#define PG8_STAGE(bufoff, gbase, voff) do { _Pragma("unroll") for (int _i = 0; _i < 2; ++_i) \
        __builtin_amdgcn_global_load_lds((const unsigned*)((const char*)(gbase) + (voff)[_i]), (LAS unsigned*)(lds + (bufoff) + ldsw + _i * 8192), 16, 0, 0); } while (0)
#define PG8_LDA(dst, b, h) do { _Pragma("unroll") for (int m = 0; m < 4; ++m) dst[m] = __builtin_shufflevector(*(const LAS i32x4*)(lds + PG8_SA(b, h) + aoff + m * 2048), *(const LAS i32x4*)(lds + PG8_SA(b, h) + aoff + m * 2048 + 1024), 0, 1, 2, 3, 4, 5, 6, 7); } while (0)
#define PG8_LDB(dst, b, h) do { _Pragma("unroll") for (int n = 0; n < 2; ++n) dst[n] = __builtin_shufflevector(*(const LAS i32x4*)(lds + PG8_SB(b, h) + boff + n * 2048), *(const LAS i32x4*)(lds + PG8_SB(b, h) + boff + n * 2048 + 1024), 0, 1, 2, 3, 4, 5, 6, 7); } while (0)
#define PG8_H0(v) __builtin_bit_cast(bf16x8, __builtin_shufflevector(v, v, 0, 1, 2, 3))
#define PG8_H1(v) __builtin_bit_cast(bf16x8, __builtin_shufflevector(v, v, 4, 5, 6, 7))
#define PG8_MMA(ai, bj, At, Bt) do { __builtin_amdgcn_s_setprio(1); _Pragma("unroll") for (int m = 0; m < 4; ++m) _Pragma("unroll") for (int n = 0; n < 2; ++n) { \
        if (F8) asm volatile("v_mfma_f32_16x16x128_f8f6f4 %0, %1, %2, %0" : "+v"(acc[ai][bj][m][n]) : "v"(Bt[n]), "v"(At[m])); \
        else { acc[ai][bj][m][n] = __builtin_amdgcn_mfma_f32_16x16x32_bf16(PG8_H0(Bt[n]), PG8_H0(At[m]), acc[ai][bj][m][n], 0, 0, 0); \
               acc[ai][bj][m][n] = __builtin_amdgcn_mfma_f32_16x16x32_bf16(PG8_H1(Bt[n]), PG8_H1(At[m]), acc[ai][bj][m][n], 0, 0, 0); } } __builtin_amdgcn_s_setprio(0); } while (0)
#define PG8_WAIT_V(n) asm volatile("s_waitcnt vmcnt(" #n ")" ::: "memory")
#define PG8_WAIT_L(n) asm volatile("s_waitcnt lgkmcnt(" #n ")" ::: "memory")
#define PG8_BAR __builtin_amdgcn_s_barrier()
#define PG8_SCHED __builtin_amdgcn_sched_barrier(0)
    Unit cur, nxt; int ui = 0;
    if (!S.next(0, cur)) return;
    f32x4 acc[2][2][4][2];
#pragma unroll
    for (int a = 0; a < 2; ++a)
#pragma unroll
        for (int b = 0; b < 2; ++b)
#pragma unroll
            for (int m = 0; m < 4; ++m)
#pragma unroll
                for (int n = 0; n < 2; ++n) acc[a][b][m][n] = (f32x4){0.f, 0.f, 0.f, 0.f};
    i32x8 At[4], B0[2], B1[2];
    const char* cA = cur.A; const char* cB = cur.B;
    S.a_ready(cur);
    PG8_STAGE(PG8_SB(0, 0), cB, voffB); PG8_STAGE(PG8_SB(0, 1), cB + hstep, voffB); PG8_STAGE(PG8_SA(0, 0), cA, voffA); PG8_STAGE(PG8_SA(0, 1), cA + hstep, voffA);
    if (wr == 1) PG8_BAR;
    PG8_WAIT_V(2); PG8_BAR;
    PG8_STAGE(PG8_SB(1, 0), cB + kstep, voffB); PG8_STAGE(PG8_SA(1, 0), cA + kstep, voffA); PG8_STAGE(PG8_SB(1, 1), cB + hstep + kstep, voffB);
    PG8_WAIT_V(6); PG8_BAR;
    for (;;) {
        const bool has_next = S.next(ui + 1, nxt);
        const char* nA = has_next ? nxt.A : cA; const char* nB = has_next ? nxt.B : cB;
        asm volatile("" : "+s"(nA), "+s"(nB));
        int nt = cur.nt; asm volatile("" : "+s"(nt));
#pragma nounroll
        for (int t = 0; t < nt; t += 2) {
            const bool last = (t == nt - 2);
            asm volatile("" : "+v"(voffA[0]), "+v"(voffA[1]), "+v"(voffB[0]), "+v"(voffB[1]));
            if (last && has_next) S.a_ready(nxt);
            const char* a1 = cA + (size_t)(t + 1) * kstep;
            const char* a2 = last ? nA : cA + (size_t)(t + 2) * kstep; const char* b2 = last ? nB : cB + (size_t)(t + 2) * kstep;
            const char* a3 = a2 + kstep; const char* b3 = b2 + kstep;
            PG8_LDB(B0, 0, 0); PG8_LDB(B1, 0, 1); PG8_SCHED; PG8_LDA(At, 0, 0); PG8_STAGE(PG8_SA(1, 1), a1 + hstep, voffA);
            PG8_WAIT_V(8); PG8_WAIT_L(0); PG8_BAR; PG8_MMA(0, 0, At, B0); PG8_MMA(0, 1, At, B1); PG8_BAR; PG8_SCHED;
            PG8_LDA(At, 0, 1); PG8_STAGE(PG8_SB(0, 0), b2, voffB); PG8_STAGE(PG8_SB(0, 1), b2 + hstep, voffB); PG8_STAGE(PG8_SA(0, 0), a2, voffA);
            PG8_WAIT_V(8); PG8_WAIT_L(0); PG8_BAR; PG8_MMA(1, 0, At, B0); PG8_MMA(1, 1, At, B1); PG8_BAR; PG8_SCHED;
            PG8_LDB(B0, 1, 0); PG8_LDB(B1, 1, 1); PG8_SCHED; PG8_LDA(At, 1, 0); PG8_STAGE(PG8_SA(0, 1), a2 + hstep, voffA);
            PG8_WAIT_V(8); PG8_WAIT_L(0); PG8_BAR; PG8_MMA(0, 0, At, B0); PG8_MMA(0, 1, At, B1); PG8_BAR; PG8_SCHED;
            PG8_LDA(At, 1, 1); PG8_STAGE(PG8_SB(1, 0), b3, voffB); PG8_STAGE(PG8_SB(1, 1), b3 + hstep, voffB); PG8_STAGE(PG8_SA(1, 0), a3, voffA);
            PG8_WAIT_V(8); PG8_WAIT_L(0); PG8_BAR; PG8_MMA(1, 0, At, B0); PG8_MMA(1, 1, At, B1); PG8_BAR; PG8_SCHED;
        }
        if (F8) asm volatile("s_nop 15\n\ts_nop 15" ::: "memory");
        if (wr == 0) PG8_BAR;
        PG8_SCHED; E(acc, cur, wr, wc, fr, fq); PG8_SCHED;
        if (!has_next) break;
        if (!KEEP) {
#pragma unroll
        for (int a = 0; a < 2; ++a)
#pragma unroll
            for (int b = 0; b < 2; ++b)
#pragma unroll
                for (int m = 0; m < 4; ++m)
#pragma unroll
                    for (int n = 0; n < 2; ++n) acc[a][b][m][n] = (f32x4){0.f, 0.f, 0.f, 0.f};
        }
        cur = nxt; cA = nA; cB = nB; ++ui;
        if (wr == 1) PG8_BAR;
    }
    PG8_WAIT_V(0);
    PG8_BAR;
    E.after(acc, cur, lds, wr, wc, fr, fq);
#undef PG8_SA
#undef PG8_SB
#undef PG8_STAGE
#undef PG8_LDA
#undef PG8_LDB
#undef PG8_MMA
#undef PG8_H0
#undef PG8_H1
#undef PG8_WAIT_V
#undef PG8_WAIT_L
#undef PG8_BAR
#undef PG8_SCHED
}

struct EpiG1 {
    bf16_t *B0, *B1, *B2, *B3, *B4; float* vss; const float *gq, *gk; const LAS float* R;
    __device__ __forceinline__ void after(f32x4 (&)[2][2][4][2], const Unit&, LAS unsigned char*, int, int, int, int) const {}
    __device__ __forceinline__ void operator()(f32x4 (&acc)[2][2][4][2], const Unit& u, int wr, int wc, int fr, int fq) const {
        const int j = u.pn; const size_t rowb = (size_t)u.pm * BM + wr * 64 + fr; const int cl = 32 * wc + 8 * fq;
#pragma unroll
        for (int ai = 0; ai < 2; ++ai)
#pragma unroll
            for (int m = 0; m < 4; ++m) { const float rs = R[ai * HALF + wr * 64 + m * 16 + fr];
#pragma unroll
                for (int bj = 0; bj < 2; ++bj) { acc[ai][bj][m][0] *= rs; acc[ai][bj][m][1] *= rs; } }
        const bool ubz = (j == 6 || j == 7 || j == 10 || j == 11);
        if (j < 4 || ubz) {
            bf16_t* dst = ubz ? B0 + 512 + 128 * (j < 8 ? j - 6 : j - 8) : B3 + 128 * j;
#pragma unroll
            for (int ai = 0; ai < 2; ++ai)
#pragma unroll
                for (int m = 0; m < 4; ++m) { f32x4 o0, o1;
#pragma unroll
                    for (int e = 0; e < 4; ++e) { const float g0 = acc[ai][1][m][0][e], g1 = acc[ai][1][m][1][e]; const float s0 = fsigm(g0), s1 = fsigm(g1);
                        o0[e] = acc[ai][0][m][0][e] * (ubz ? g0 * s0 : s0); o1[e] = acc[ai][0][m][1][e] * (ubz ? g1 * s1 : s1); }
                    *(u32x4*)(dst + (rowb + ai * HALF + m * 16) * 1024 + cl) = pack8(o0, o1); }
        } else if (j < 12 || j >= 16) {
            bf16_t* dst; int pitch, coff; bool act;
            if (j < 6) { dst = B0; pitch = 1024; coff = 256 * (j - 4); act = true; }
            else if (j < 8) { dst = B0; pitch = 1024; coff = 512 + 256 * (j - 6); act = false; }
            else if (j < 10) { dst = B3; pitch = 1024; coff = 512 + 256 * (j - 8); act = false; }
            else if (j < 12) { dst = B4; pitch = 512; coff = 256 * (j - 10); act = true; }
            else if (j < 18) { dst = B2; pitch = 1024; coff = 256 * (j - 16); act = false; }
            else { dst = B2; pitch = 1024; coff = 512 + 256 * (j - 18); act = true; }
            const bool stat = (j == 8 || j == 9);
#pragma unroll
            for (int ai = 0; ai < 2; ++ai)
#pragma unroll
                for (int m = 0; m < 4; ++m) { const size_t row = rowb + ai * HALF + m * 16; float s = 0.f;
#pragma unroll
                    for (int bj = 0; bj < 2; ++bj) { f32x4 v0 = acc[ai][bj][m][0], v1 = acc[ai][bj][m][1];
                        if (act) {
#pragma unroll
                            for (int e = 0; e < 4; ++e) { v0[e] = v0[e] * fsigm(v0[e]); v1[e] = v1[e] * fsigm(v1[e]); } }
                        s += (v0[0] * v0[0] + v0[1] * v0[1]) + (v0[2] * v0[2] + v0[3] * v0[3]) + (v1[0] * v1[0] + v1[1] * v1[1]) + (v1[2] * v1[2] + v1[3] * v1[3]);
                        *(u32x4*)(dst + row * pitch + coff + 128 * bj + cl) = pack8(v0, v1); }
                    if (stat) { s += __shfl_xor(s, 16); s += __shfl_xor(s, 32); if (fq == 0) vss[row * 8 + (j - 8) * 4 + wc] = s; } }
        } else {
            const bool isk = j >= 14; const int jj = (j - 12) & 1; const float* g = isk ? gk : gq; const float sc = isk ? 1.f : C2;
            f32x4 gv[2][2];
#pragma unroll
            for (int bj = 0; bj < 2; ++bj) { gv[bj][0] = *(const f32x4*)(g + 32 * bj + 8 * fq) * sc; gv[bj][1] = *(const f32x4*)(g + 32 * bj + 8 * fq + 4) * sc; }
            bf16_t* dst = B1 + (isk ? 512 : 0) + 64 * (4 * jj + wc) + 8 * fq;
#pragma unroll
            for (int ai = 0; ai < 2; ++ai)
#pragma unroll
                for (int m = 0; m < 4; ++m) { const size_t row = rowb + ai * HALF + m * 16; float s = 0.f;
#pragma unroll
                    for (int bj = 0; bj < 2; ++bj) { const f32x4 v0 = acc[ai][bj][m][0], v1 = acc[ai][bj][m][1];
                        s += (v0[0] * v0[0] + v0[1] * v0[1]) + (v0[2] * v0[2] + v0[3] * v0[3]) + (v1[0] * v1[0] + v1[1] * v1[1]) + (v1[2] * v1[2] + v1[3] * v1[3]); }
                    s += __shfl_xor(s, 16); s += __shfl_xor(s, 32);
                    const float r = __builtin_amdgcn_rsqf(s * (1.f / 64.f) + EPS);
#pragma unroll
                    for (int bj = 0; bj < 2; ++bj) *(u32x4*)(dst + row * 1024 + 32 * bj) = pack8(acc[ai][bj][m][0] * r * gv[bj][0], acc[ai][bj][m][1] * r * gv[bj][1]); }
        }
    }
};
template <bool GATE> struct EpiMergeT {
    unsigned char *gta, *gtb; bf16_t* MG; const float* bgate; const LAS float* R; mutable u32x4 cq[4];
    __device__ __forceinline__ void after(f32x4 (&)[2][2][4][2], const Unit&, LAS unsigned char*, int, int, int, int) const {}
    __device__ __forceinline__ void operator()(f32x4 (&acc)[2][2][4][2], const Unit& u, int wr, int wc, int fr, int fq) const {
        const int tag = u.tag, br = tag >> 1; const size_t rowb = (size_t)u.pm * BM + wr * 64 + fr; const int col0 = u.pn * BM + 32 * wc + 8 * fq;
        u32x4* slots_ = (u32x4*)((br == 1 ? gtb : gta) + (br == 2 ? (long)WS_GT : (long)WS_B4)) + ((wr * 4 + wc) * 64 + fq * 16 + fr); asm volatile("" : "+v"(slots_)); __attribute__((address_space(1))) u32x4* slots = (__attribute__((address_space(1))) u32x4*)slots_;
        if (GATE) {
            f32x4 bv[2][2];
#pragma unroll
            for (int bj = 0; bj < 2; ++bj) { bv[bj][0] = *(const f32x4*)(bgate + br * 1024 + col0 + 128 * bj); bv[bj][1] = *(const f32x4*)(bgate + br * 1024 + col0 + 128 * bj + 4); }
#pragma unroll
            for (int ai = 0; ai < 2; ++ai)
#pragma unroll
                for (int m = 0; m < 4; ++m) { const float rs = R[ai * HALF + wr * 64 + m * 16 + fr] * (1.f / F8_WSCALE); u32x4 w;
#pragma unroll
                    for (int bj = 0; bj < 2; ++bj) { f32x4 v0 = acc[ai][bj][m][0] * rs + bv[bj][0], v1 = acc[ai][bj][m][1] * rs + bv[bj][1];
#pragma unroll
                        for (int e = 0; e < 4; ++e) { v0[e] = fmaxf(fsigm256(v0[e]), 1.f); v1[e] = fmaxf(fsigm256(v1[e]), 1.f); }
                        if (bj == 0) { w.x = pk4u8(v0); w.y = pk4u8(v1); } else { w.z = pk4u8(v0); w.w = pk4u8(v1); } }
                    slots[(size_t)((ai * 4 + m) * 512)] = w; }
        } else {
            const int nb = br + 1;
            u32x4* sl2_ = (u32x4*)((nb == 1 ? gtb : gta) + (nb == 2 ? (long)WS_GT : (long)WS_B4)) + ((wr * 4 + wc) * 64 + fq * 16 + fr); asm volatile("" : "+v"(sl2_)); const __attribute__((address_space(1))) u32x4* sl2 = (const __attribute__((address_space(1))) u32x4*)sl2_;
            if (br < 2) {
                u32x4 gn[2][4], gd[2][4];
#pragma unroll
                for (int ai = 0; ai < 2; ++ai)
#pragma unroll
                    for (int m = 0; m < 4; ++m) { if (br == 0 || ai == 1) gn[ai][m] = slots[(size_t)((ai * 4 + m) * 512)]; else gn[ai][m] = cq[m]; gd[ai][m] = sl2[(size_t)((ai * 4 + m) * 512)]; }
#pragma unroll
                for (int ai = 0; ai < 2; ++ai)
#pragma unroll
                    for (int m = 0; m < 4; ++m) { asm volatile("" : "+v"(gn[ai][m]), "+v"(gd[ai][m]));
#pragma unroll
                        for (int bj = 0; bj < 2; ++bj) { f32x4 n0 = un4u8(bj ? gn[ai][m].z : gn[ai][m].x), n1 = un4u8(bj ? gn[ai][m].w : gn[ai][m].y); const f32x4 d0 = un4u8(bj ? gd[ai][m].z : gd[ai][m].x), d1 = un4u8(bj ? gd[ai][m].w : gd[ai][m].y);
#pragma unroll
                            for (int e = 0; e < 4; ++e) { n0[e] *= __builtin_amdgcn_rcpf(d0[e]); n1[e] *= __builtin_amdgcn_rcpf(d1[e]); }
                            acc[ai][bj][m][0] *= n0; acc[ai][bj][m][1] *= n1; }
                        if (ai == 0) cq[m] = gd[ai][m]; }
                asm volatile("" ::: "memory");
            } else {
                u32x4 gn[2][4];
#pragma unroll
                for (int ai = 0; ai < 2; ++ai)
#pragma unroll
                    for (int m = 0; m < 4; ++m) { if (ai == 0) gn[ai][m] = cq[m]; else gn[ai][m] = slots[(size_t)((ai * 4 + m) * 512)]; }
#pragma unroll
                for (int ai = 0; ai < 2; ++ai)
#pragma unroll
                    for (int m = 0; m < 4; ++m) { asm volatile("" : "+v"(gn[ai][m]));
#pragma unroll
                        for (int bj = 0; bj < 2; ++bj) { const f32x4 n0 = un4u8(bj ? gn[ai][m].z : gn[ai][m].x), n1 = un4u8(bj ? gn[ai][m].w : gn[ai][m].y);
                            *(u32x4*)(MG + (rowb + ai * HALF + m * 16) * 1024 + col0 + 128 * bj) = pack8(n0 * acc[ai][bj][m][0], n1 * acc[ai][bj][m][1]); } }
                asm volatile("" ::: "memory");
            }
        }
    }
    static __device__ __forceinline__ void yepi0(f32x4 (&acc)[2][2][4][2], const __attribute__((address_space(1))) u32x4* slots, bf16_t* MG, size_t rowb, int col0) {
        u32x4 gw[2][4];
#pragma unroll
        for (int ai = 0; ai < 2; ++ai)
#pragma unroll
            for (int m = 0; m < 4; ++m) gw[ai][m] = slots[(size_t)((ai * 4 + m) * 512)];
#pragma unroll
        for (int ai = 0; ai < 2; ++ai)
#pragma unroll
            for (int m = 0; m < 4; ++m) { asm volatile("" : "+v"(gw[ai][m]));
#pragma unroll
                for (int bj = 0; bj < 2; ++bj) { const f32x4 g0 = un4u8(bj ? gw[ai][m].z : gw[ai][m].x), g1 = un4u8(bj ? gw[ai][m].w : gw[ai][m].y);
                    *(u32x4*)(MG + (rowb + ai * HALF + m * 16) * 1024 + col0 + 128 * bj) = pack8(g0 * acc[ai][bj][m][0], g1 * acc[ai][bj][m][1]); } }
    }
    template <bool RMW> static __device__ __forceinline__ void yepi(f32x4 (&acc)[2][2][4][2], const __attribute__((address_space(1))) u32x4* slots, bf16_t* MG, size_t rowb, int col0) {
#pragma unroll
        for (int ai = 0; ai < 2; ++ai) {
            u32x4 gw[4], ow[4][2];
#pragma unroll
            for (int m = 0; m < 4; ++m) { gw[m] = slots[(size_t)((ai * 4 + m) * 512)];
#pragma unroll
                for (int bj = 0; bj < 2; ++bj) if (RMW) ow[m][bj] = *(const u32x4*)(MG + (rowb + ai * HALF + m * 16) * 1024 + col0 + 128 * bj); }
#pragma unroll
            for (int m = 0; m < 4; ++m)
#pragma unroll
                for (int bj = 0; bj < 2; ++bj) { asm volatile("" : "+v"(gw[m]));
                    const f32x4 g0 = un4u8(bj ? gw[m].z : gw[m].x), g1 = un4u8(bj ? gw[m].w : gw[m].y);
                    f32x4 v0 = g0 * acc[ai][bj][m][0], v1 = g1 * acc[ai][bj][m][1];
                    if (RMW) { asm volatile("" : "+v"(ow[m][bj])); f32x4 p0, p1; unpack8(ow[m][bj], p0, p1); v0 += p0; v1 += p1; }
                    *(u32x4*)(MG + (rowb + ai * HALF + m * 16) * 1024 + col0 + 128 * bj) = pack8(v0, v1); }
            asm volatile("" ::: "memory");
        }
    }
};
struct EpiOutB {
    const bf16_t* base; float* out;
    __device__ __forceinline__ void after(f32x4 (&)[2][2][4][2], const Unit&, LAS unsigned char*, int, int, int, int) const {}
    __device__ __forceinline__ void operator()(f32x4 (&acc)[2][2][4][2], const Unit& u, int wr, int wc, int fr, int fq) const {
        const size_t rowb = (size_t)u.pm * BM + wr * 64 + fr; const int col0 = u.pn * BM + 32 * wc + 8 * fq;
        u32x4 bw[2][4][2];
#pragma unroll
        for (int ai = 0; ai < 2; ++ai)
#pragma unroll
            for (int m = 0; m < 4; ++m)
#pragma unroll
                for (int bj = 0; bj < 2; ++bj) bw[ai][m][bj] = *(const u32x4*)(base + (rowb + ai * HALF + m * 16) * D + col0 + 128 * bj);
#pragma unroll
        for (int ai = 0; ai < 2; ++ai)
#pragma unroll
            for (int m = 0; m < 4; ++m)
#pragma unroll
                for (int bj = 0; bj < 2; ++bj) { const size_t o = (rowb + ai * HALF + m * 16) * D + col0 + 128 * bj;
                    asm volatile("" : "+v"(bw[ai][m][bj])); f32x4 b0, b1; unpack8(bw[ai][m][bj], b0, b1);
                    *(f32x4*)(out + o) = b0 + acc[ai][bj][m][0]; *(f32x4*)(out + o + 4) = b1 + acc[ai][bj][m][1]; }
    }
};
struct EpiOut {
    const float* base; float* out;
    __device__ __forceinline__ void after(f32x4 (&)[2][2][4][2], const Unit&, LAS unsigned char*, int, int, int, int) const {}
    __device__ __forceinline__ void operator()(f32x4 (&acc)[2][2][4][2], const Unit& u, int wr, int wc, int fr, int fq) const {
        const size_t rowb = (size_t)u.pm * BM + wr * 64 + fr; const int col0 = u.pn * BM + 32 * wc + 8 * fq;
#pragma unroll
        for (int ai = 0; ai < 2; ++ai)
#pragma unroll
            for (int m = 0; m < 4; ++m) {
#pragma unroll
                for (int bj = 0; bj < 2; ++bj) { const size_t o = (rowb + ai * HALF + m * 16) * D + col0 + 128 * bj;
                    const f32x4 b0 = *(const f32x4*)(base + o), b1 = *(const f32x4*)(base + o + 4);
                    *(f32x4*)(out + o) = b0 + acc[ai][bj][m][0]; *(f32x4*)(out + o + 4) = b1 + acc[ai][bj][m][1]; }
                if (m & 1) asm volatile("" ::: "memory"); }
    }
};
struct EpiOutLN {
    const bf16_t* base; bf16_t* XG; const float* gnext; const float* wfnext; float* SSP; float* FP; unsigned char* H8;
    __device__ __forceinline__ void operator()(f32x4 (&)[2][2][4][2], const Unit&, int, int, int, int) const {}
    __device__ __forceinline__ void after(f32x4 (&acc)[2][2][4][2], const Unit& u, LAS unsigned char* lds, int wr, int wc, int fr, int fq) const {
        const int tid = ((wr * 4 + wc) * 64) + fq * 16 + fr;
        const size_t rowb = (size_t)u.pm * BM + wr * 64 + fr; const int cl = 32 * wc + 8 * fq, col0 = u.pn * BM + cl;
        LAS float* FL = (LAS float*)lds;
        LAS float* WL = (LAS float*)(lds + 512 * 72 * 4);
        { float gk[4], wk[4];
#pragma unroll
          for (int q = 0; q < 4; ++q) { const int i = tid + 512 * q, c = i >> 3, e = i & 7; gk[q] = gnext[u.pn * BM + c]; wk[q] = wfnext[(size_t)(u.pn * BM + c) * NIN + e]; }
#pragma unroll
          for (int q = 0; q < 4; ++q) WL[tid + 512 * q] = gk[q] * wk[q]; }
#pragma unroll
        for (int ai = 0; ai < 2; ++ai) {
            u32x4 bw[4][2];
#pragma unroll
            for (int m = 0; m < 4; ++m)
#pragma unroll
                for (int bj = 0; bj < 2; ++bj) bw[m][bj] = *(const u32x4*)(base + (rowb + ai * HALF + m * 16) * D + col0 + 128 * bj);
#pragma unroll
            for (int m = 0; m < 4; ++m) { float ss = 0.f;
#pragma unroll
                for (int bj = 0; bj < 2; ++bj) { const size_t o = (rowb + ai * HALF + m * 16) * D + col0 + 128 * bj;
                    asm volatile("" : "+v"(bw[m][bj])); f32x4 b0_, b1_; unpack8(bw[m][bj], b0_, b1_);
                    const f32x4 x0 = b0_ + acc[ai][bj][m][0], x1 = b1_ + acc[ai][bj][m][1];
                    ss += (x0[0] * x0[0] + x0[1] * x0[1]) + (x0[2] * x0[2] + x0[3] * x0[3]) + (x1[0] * x1[0] + x1[1] * x1[1]) + (x1[2] * x1[2] + x1[3] * x1[3]);
                    *(u32x4*)(XG + o) = pack8(x0, x1);
                    { u32x2 o8; o8.x = pk4f8(x0[0], x0[1], x0[2], x0[3]); o8.y = pk4f8(x1[0], x1[1], x1[2], x1[3]); *(u32x2*)(H8 + (rowb + ai * HALF + m * 16) * 1024 + col0 + 128 * bj) = o8; }
                    acc[ai][bj][m][0] = x0; acc[ai][bj][m][1] = x1; }
                FL[tid * 72 + 64 + ai * 4 + m] = ss; }
            asm volatile("" ::: "memory"); }
        asm volatile("s_waitcnt lgkmcnt(0)" ::: "memory"); __builtin_amdgcn_s_barrier(); asm volatile("" ::: "memory");
#pragma unroll
        for (int hh = 0; hh < 2; ++hh) {
            f32x4 f[8];
#pragma unroll
            for (int rg = 0; rg < 8; ++rg) f[rg] = (f32x4){0.f, 0.f, 0.f, 0.f};
#pragma unroll
            for (int bj = 0; bj < 2; ++bj)
#pragma unroll
                for (int n = 0; n < 2; ++n)
#pragma unroll
                    for (int i = 0; i < 4; ++i) { const f32x4 wv = *(const LAS f32x4*)(WL + (128 * bj + cl + 4 * n + i) * 8 + 4 * hh);
#pragma unroll
                        for (int ai = 0; ai < 2; ++ai)
#pragma unroll
                            for (int m = 0; m < 4; ++m) f[ai * 4 + m] += acc[ai][bj][m][n][i] * wv; }
#pragma unroll
            for (int rg = 0; rg < 8; ++rg) *(LAS f32x4*)(FL + tid * 72 + rg * 8 + 4 * hh) = f[rg];
            asm volatile("" ::: "memory");
        }
        asm volatile("s_waitcnt lgkmcnt(0)" ::: "memory"); __builtin_amdgcn_s_barrier(); asm volatile("" ::: "memory");
        { const int row = tid & 255, hb = (tid >> 8) * 4, ai_ = row >> 7, wr_ = (row >> 6) & 1, m_ = (row >> 4) & 3, fr_ = row & 15, rg = ai_ * 4 + m_;
          f32x4 sum = (f32x4){0.f, 0.f, 0.f, 0.f}; float ssum = 0.f;
#pragma unroll
          for (int wc_ = 0; wc_ < 4; ++wc_)
#pragma unroll
              for (int fq_ = 0; fq_ < 4; ++fq_) { const LAS float* src = FL + (((wr_ * 4 + wc_) * 64) + fq_ * 16 + fr_) * 72; sum += *(const LAS f32x4*)(src + rg * 8 + hb); ssum += src[64 + rg]; }
          const size_t grow = (size_t)u.pm * BM + row;
#pragma unroll
          for (int e = 0; e < 4; ++e) FP[((size_t)(hb + e) * M + grow) * 4 + u.pn] = sum[e];
          if (hb == 0) SSP[grow * 4 + u.pn] = ssum; }
    }
};
struct SchedG1 { TileOrder T; const char* A; const char* B;
    __device__ __forceinline__ void a_ready(const Unit&) const {}
    __device__ __forceinline__ bool next(int i, Unit& u) const { int pm, pn; if (!T.tile(i, pm, pn)) return false; u.pm = pm; u.pn = pn; u.tag = 0; u.nt = 16; u.A = A + (size_t)pm * (BM * PITCH * 2); u.B = B + (size_t)pn * (BM * PITCH * 2); return true; } };
struct SchedGate { int pm, pn; bool ok; const char *h8, *wl; unsigned* sbtop; unsigned want; unsigned* tmo;
    __device__ __forceinline__ bool next(int i, Unit& u) const { if (!ok || i >= 3) return false;
        u.pm = pm; u.pn = pn; u.tag = 2 * i; u.nt = 8;
        u.A = h8 + (size_t)pm * (BM * 1024); u.B = wl + WO_WG + (size_t)i * (1024 * 1024) + (size_t)pn * (BM * 1024); return true; }
    __device__ __forceinline__ void a_ready(const Unit& u) const {
        if (u.tag != 4) return;
        if (threadIdx.x < 64) {
            unsigned sp = 0;
            while ((unsigned)__builtin_amdgcn_readfirstlane((int)__hip_atomic_load(sbtop, __ATOMIC_RELAXED, __HIP_MEMORY_SCOPE_AGENT)) < want) {
                __builtin_amdgcn_s_sleep(1);
                if (++sp > (1u << 20)) { if (threadIdx.x == 0) __hip_atomic_store(tmo, 1u, __ATOMIC_RELAXED, __HIP_MEMORY_SCOPE_AGENT); break; } }
            __builtin_amdgcn_fence(__ATOMIC_ACQUIRE, "agent");
            asm volatile("s_waitcnt vmcnt(0)" ::: "memory");
        }
        asm volatile("" ::: "memory"); __builtin_amdgcn_s_barrier(); asm volatile("" ::: "memory");
    } };
struct SchedY { int pm, pn; bool ok; const char *ws, *wl;
    __device__ __forceinline__ bool next(int br, Unit& u) const { if (!ok || br >= 3) return false;
        u.pm = pm; u.pn = pn; u.tag = 2 * br + 1; u.nt = 8;
        const size_t ro = (size_t)pm * (BM * PITCH * 2), co = (size_t)pn * (BM * PITCH * 2);
        const size_t ao = br == 0 ? WS_B0 : (br == 1 ? WS_B0 + 1024 : WS_B1), bo = br == 0 ? WO_WAB : (br == 1 ? WO_WAB + 1024 : WO_WC); u.A = ws + ao + ro; u.B = wl + bo + co;
        return true; }
    __device__ __forceinline__ void a_ready(const Unit&) const {} };
}

#define XB_TMO      128
#define XB_XCNT(j)  (256  + 64 * (j))
#define XB_XSUB(j)  (1280 + 64 * (j))
#define XB_XGEN(j)  (2304 + 64 * (j))
#define XB_TOP      3328
#define XB_TOPGEN   3392
#define XCD_BAR_WORDS 3456
#define XB_SPIN_CAP (1u << 18)
__device__ __forceinline__ unsigned xb_ld(unsigned* p)              { return __hip_atomic_load(p, __ATOMIC_RELAXED, __HIP_MEMORY_SCOPE_AGENT); }
__device__ __forceinline__ unsigned xb_add(unsigned* p, unsigned v) { return __hip_atomic_fetch_add(p, v, __ATOMIC_RELAXED, __HIP_MEMORY_SCOPE_AGENT); }
__device__ __forceinline__ unsigned xb_xcc_id() { return (unsigned)__builtin_amdgcn_s_getreg((3 << 11) | 20) & 0xFu; }
#define XB_SPIN(cond, bar) do { unsigned _sp = 0; while (cond) { __builtin_amdgcn_s_sleep(1); \
    if ((++_sp & 255u) == 0u) { if (xb_ld(&(bar)[XB_TMO])) break; if (_sp > XB_SPIN_CAP) { atomicAdd(&(bar)[XB_TMO], 1u); break; } } } } while (0)
struct XcdBarrier { unsigned* bar; unsigned x; volatile LAS unsigned* st; };
__device__ __forceinline__ XcdBarrier xcd_barrier_post(unsigned* bar, volatile LAS unsigned* st) {
    XcdBarrier b; b.bar = bar; b.x = xb_xcc_id(); b.st = st;
    if (threadIdx.x == 0) (void)xb_add(&bar[XB_XCNT(b.x)], 1u);
    return b;
}
__device__ __forceinline__ void xcd_barrier_complete(unsigned* bar, unsigned x, unsigned& nloc, unsigned& nx) {
    const unsigned G = gridDim.x * gridDim.y * gridDim.z;
    unsigned sum, cnt, mine, sp = 0u;
    for (;;) {
        sum = 0u; cnt = 0u; mine = 0u;
#pragma unroll
        for (unsigned j = 0; j < 16; ++j) { const unsigned c = xb_ld(&bar[XB_XCNT(j)]); sum += c; cnt += (c > 0u) ? 1u : 0u; mine = (j == x) ? c : mine; }
        if (sum == G) break;
        __builtin_amdgcn_s_sleep(1);
        if ((++sp & 255u) == 0u) { if (xb_ld(&bar[XB_TMO])) break; if (sp > XB_SPIN_CAP) { atomicAdd(&bar[XB_TMO], 1u); break; } }
    }
    nloc = mine > 0u ? mine : 1u; nx = cnt > 0u ? cnt : 1u;
}
__device__ __forceinline__ void xcd_barrier(const XcdBarrier& b) {
    asm volatile("s_waitcnt vmcnt(0)" ::: "memory");
    __syncthreads();
    if (threadIdx.x == 0) {
        unsigned* bar = b.bar;
        __builtin_amdgcn_s_waitcnt(0);
        asm volatile("buffer_inv sc1" ::: "memory");
        unsigned nloc = b.st[0], nx = b.st[1];
        if (nloc == 0u) { xcd_barrier_complete(bar, b.x, nloc, nx); b.st[0] = nloc; b.st[1] = nx; }
        const unsigned old = xb_add(&bar[XB_XSUB(b.x)], 1u);
        const unsigned gen = old / nloc;
        if (old + 1u == gen * nloc + (3u * nloc) / 4u) { __builtin_amdgcn_fence(__ATOMIC_RELEASE, "agent"); asm volatile("s_waitcnt vmcnt(0)" ::: "memory"); }
        if (old + 1u == (gen + 1u) * nloc) {
            __builtin_amdgcn_fence(__ATOMIC_RELEASE, "agent");
            asm volatile("s_waitcnt vmcnt(0)" ::: "memory");
            const unsigned og = xb_add(&bar[XB_TOP], 1u);
            const unsigned tg = og / nx;
            if (og + 1u == (tg + 1u) * nx) xb_add(&bar[XB_TOPGEN], 1u);
            else XB_SPIN(xb_ld(&bar[XB_TOPGEN]) == tg, bar);
            asm volatile("s_waitcnt vmcnt(0)" ::: "memory");
            xb_add(&bar[XB_XGEN(b.x)], 1u);
            asm volatile("s_waitcnt vmcnt(0)" ::: "memory");
        } else {
            XB_SPIN(xb_ld(&bar[XB_XGEN(b.x)]) == gen, bar);
            asm volatile("s_waitcnt vmcnt(0)" ::: "memory");
            asm volatile("s_waitcnt vmcnt(0)" ::: "memory");
        }
    }
    __syncthreads();
}

#define SB_XSUB(j)  (1024 + 64 * (j))
#define SB_TOP      2112
__device__ __forceinline__ void sb_arrive(const XcdBarrier& b, unsigned* ctlw, unsigned k) {
    asm volatile("s_waitcnt vmcnt(0)" ::: "memory");
    __syncthreads();
    if (threadIdx.x == 0) {
        __builtin_amdgcn_s_waitcnt(0);
        const unsigned nloc = b.st[0];
        const unsigned old = xb_add(&ctlw[SB_XSUB(b.x)], 1u);
        if (old + 1u == nloc * k) {
            __builtin_amdgcn_fence(__ATOMIC_RELEASE, "agent");
            asm volatile("s_waitcnt vmcnt(0)" ::: "memory");
            xb_add(&ctlw[SB_TOP], 1u);
        }
    }
}

struct Args { const float* in[18]; float* out; unsigned char* ws; int ph_lo, ph_hi, li, pad; };
struct Frame { LAS unsigned char* lds; int tid, lane, wave, vcu, G; Ptrs P; };

__device__ __forceinline__ unsigned pk2(float lo, float hi) { return (unsigned)f2bf(lo) | ((unsigned)f2bf(hi) << 16); }
__device__ __forceinline__ void p0_transpose_item(const float* W, int ldw, int src_col, int k0, bf16_t* WT, size_t dst_row, int dst_col, LAS float* scr, int lane, const float* kgain = nullptr, const bool f8 = false, const float wsc = 1.f) {
#pragma unroll 8
    for (int i = 0; i < 32; ++i) { const int kk = 2 * i + (lane >> 5); scr[kk * 33 + (lane & 31)] = W[(size_t)(k0 + kk) * ldw + src_col + (lane & 31)]; }
    LDS_WAIT(); asm volatile("" ::: "memory");
    const int c = lane & 7;
    f32x4 ga = (f32x4){wsc, wsc, wsc, wsc}, gb = ga; if (kgain) { ga = *(const f32x4*)(kgain + k0 + 8 * c); gb = *(const f32x4*)(kgain + k0 + 8 * c + 4); }
    if (f8) {
#pragma unroll
        for (int j = 0; j < 4; ++j) { const int n = (lane >> 3) + 8 * j; const LAS float* s = scr + (8 * c) * 33 + n; u32x2 o;
            o.x = pk4f8(s[0 * 33] * ga.x * F8_WSCALE, s[1 * 33] * ga.y * F8_WSCALE, s[2 * 33] * ga.z * F8_WSCALE, s[3 * 33] * ga.w * F8_WSCALE);
            o.y = pk4f8(s[4 * 33] * gb.x * F8_WSCALE, s[5 * 33] * gb.y * F8_WSCALE, s[6 * 33] * gb.z * F8_WSCALE, s[7 * 33] * gb.w * F8_WSCALE);
            *(GAS u32x2*)((GAS unsigned char*)WT + (dst_row + n) * 1024 + dst_col + k0 + 8 * c) = o; }
    } else
#pragma unroll
    for (int j = 0; j < 4; ++j) { const int n = (lane >> 3) + 8 * j; const LAS float* s = scr + (8 * c) * 33 + n;
        u32x4 o; o.x = pk2(s[0 * 33] * ga.x, s[1 * 33] * ga.y); o.y = pk2(s[2 * 33] * ga.z, s[3 * 33] * ga.w); o.z = pk2(s[4 * 33] * gb.x, s[5 * 33] * gb.y); o.w = pk2(s[6 * 33] * gb.z, s[7 * 33] * gb.w);
        *(GAS u32x4*)(WT + (dst_row + n) * 1024 + dst_col + k0 + 8 * c) = o; }
    LDS_WAIT(); asm volatile("" ::: "memory");
}
__device__ __forceinline__ void p0_weights(Frame& F) {
    LAS float* scr = (LAS float*)(F.lds + RING_OFF + F.wave * 16384);
    const int gw = F.vcu * NWAVES + F.wave, NGW = F.G * NWAVES;
    constexpr int I_W1 = 16 * (N1 / 32), I_WG = 16 * 96, I_Y = 8 * 32, I_WO = 16 * 32, I_L = I_W1 + I_WG + 3 * I_Y + I_WO;
    for (int it = gw; it < NL * I_L; it += NGW) {
        const int l = it / I_L; int r = it % I_L;
        unsigned char* wl = F.P.ws + WS_W + (size_t)l * W_LAYER; const float* win = F.P.w_in + (size_t)l * D * NIN;
        const float* kg = F.P.norm_g + (size_t)l * D;
        if (r < I_W1) { const int kb = r / (N1 / 32), nb = r % (N1 / 32); p0_transpose_item(win, NIN, g1_col(32 * nb), 64 * kb, (bf16_t*)(wl + WO_W1), 32 * nb, 0, scr, F.lane, kg); continue; } r -= I_W1;
        if (r < I_WG) { const int kb = r / 96, nb = r % 96; p0_transpose_item(win, NIN, 32 * nb, 64 * kb, (bf16_t*)(wl + WO_WG), 32 * nb, 0, scr, F.lane, kg, true); continue; } r -= I_WG;
        if (r < I_Y) { const int kb = r / 32, nb = r % 32; p0_transpose_item(F.P.w_a + (size_t)l * DA * D, D, 32 * nb, 64 * kb, (bf16_t*)(wl + WO_WAB), 32 * nb, 0, scr, F.lane, nullptr, false, 1.f / 256.f); continue; } r -= I_Y;
        if (r < I_Y) { const int kb = r / 32, nb = r % 32; p0_transpose_item(F.P.w_b + (size_t)l * DB * D, D, 32 * nb, 64 * kb, (bf16_t*)(wl + WO_WAB), 32 * nb, 512, scr, F.lane, nullptr, false, 1.f / 256.f); continue; } r -= I_Y;
        if (r < I_Y) { const int kb = r / 32, nb = r % 32; p0_transpose_item(F.P.w_c + (size_t)l * DC * D, D, 32 * nb, 64 * kb, (bf16_t*)(wl + WO_WC), 32 * nb, 0, scr, F.lane, nullptr, false, 1.f / 256.f); continue; } r -= I_Y;
        { const int kb = r / 32, nb = r % 32; p0_transpose_item(F.P.w_out + (size_t)l * D * D, D, 32 * nb, 64 * kb, (bf16_t*)(wl + WO_WO), 32 * nb, 0, scr, F.lane); }
    }
    bf16_t* WSB = (bf16_t*)(F.P.ws + WS_WSB);
    for (int i = (int)blockIdx.x * 512 + F.tid; i < NL * NG * CHK * CHK; i += F.G * 512) { const int s = i & 127, t = (i >> 7) & 127; WSB[i] = s <= t ? f2bf(F.P.w_s[i]) : (bf16_t)0; }
}
__device__ __forceinline__ void p0_ln(Frame& F, int l, const float* xin) {
    LAS float* wf = (LAS float*)(F.lds + RING_OFF);
    const float* g = F.P.norm_g + (size_t)l * D; const float* win = F.P.w_in + (size_t)l * D * NIN;
    __syncthreads();
    { float gk[16], wk[16];
#pragma unroll
      for (int q = 0; q < 16; ++q) { const int i = F.tid + 512 * q, k = i >> 3, e = i & 7; gk[q] = g[k]; wk[q] = win[(size_t)k * NIN + OC_F + e]; }
#pragma unroll
      for (int q = 0; q < 16; ++q) wf[F.tid + 512 * q] = gk[q] * wk[q]; }
    __syncthreads();
    const int gw = F.vcu * NWAVES + F.wave, NGW = F.G * NWAVES;
    bf16_t* H = (bf16_t*)(F.P.ws + WS_H); float* LOGF = (float*)(F.P.ws + WS_LOGF);
    f32x4 gv[4];
#pragma unroll
    for (int j = 0; j < 4; ++j) gv[j] = ((const f32x4*)g)[64 * j + F.lane];
    static_assert(M == 8 * 256 * NWAVES, "p0_ln: 8 rows per wave on a 256-workgroup grid");
    float zrow[8];
#pragma unroll
    for (int k = 0; k < 8; ++k) zrow[k] = 0.f;
    f32x4 v[8][4];
#pragma unroll
    for (int bt = 0; bt < 4; ++bt) {
        asm volatile("" ::: "memory");
        if ((bt & 1) == 0) {
#pragma unroll
            for (int k = 2 * bt; k < 2 * bt + 4; ++k) { const GAS f32x4* xr = (const GAS f32x4*)(xin + (size_t)(gw + k * NGW) * D) + F.lane;
#pragma unroll
                for (int j = 0; j < 4; ++j) v[k][j] = xr[64 * j]; }
            asm volatile("" ::: "memory"); }
        float r[2]; float f[2][8];
#pragma unroll
        for (int q = 0; q < 2; ++q) { float ss = 0.f;
#pragma unroll
            for (int j = 0; j < 4; ++j) { const f32x4 x = v[2 * bt + q][j]; ss += (x.x * x.x + x.y * x.y) + (x.z * x.z + x.w * x.w); }
            { const float sst = wsum(ss); r[q] = rsqrtf(sst * (1.f / D) + EPS); if (F.lane == 0) *(f32x4*)((float*)(F.P.ws + WS_SSP) + (size_t)(gw + (2 * bt + q) * NGW) * 4) = (f32x4){sst, 0.f, 0.f, 0.f}; }
#pragma unroll
            for (int e = 0; e < 8; ++e) f[q][e] = 0.f; }
#pragma unroll
        for (int j = 0; j < 4; ++j) {
#pragma unroll
            for (int q = 0; q < 2; ++q) { const f32x4 hv = v[2 * bt + q][j];
                GAS unsigned long long* o8 = (GAS unsigned long long*)(H + (size_t)(gw + (2 * bt + q) * NGW) * D) + F.lane;
                o8[64 * j] = (unsigned long long)pk2(hv.x, hv.y) | ((unsigned long long)pk2(hv.z, hv.w) << 32);
                ((GAS unsigned*)((GAS unsigned char*)F.P.out + (size_t)(gw + (2 * bt + q) * NGW) * 1024))[64 * j + F.lane] = pk4f8(hv.x, hv.y, hv.z, hv.w); }
#pragma unroll
            for (int i = 0; i < 4; ++i) { const LAS f32x4* w4 = (const LAS f32x4*)(wf + (256 * j + 4 * F.lane + i) * 8); const f32x4 wa = w4[0], wb = w4[1];
#pragma unroll
                for (int q = 0; q < 2; ++q) { const float xv = v[2 * bt + q][j][i];
                    f[q][0] += xv * wa.x; f[q][1] += xv * wa.y; f[q][2] += xv * wa.z; f[q][3] += xv * wa.w; f[q][4] += xv * wb.x; f[q][5] += xv * wb.y; f[q][6] += xv * wb.z; f[q][7] += xv * wb.w; } }
        }
#pragma unroll
        for (int q = 0; q < 2; ++q) {
#pragma unroll
            for (int e = 0; e < 8; ++e) f[q][e] = wsum(f[q][e]);
            if (F.lane < 8) { float z = 0.f;
#pragma unroll
                for (int e = 0; e < 8; ++e) if (F.lane == e) z = f[q][e];
                zrow[2 * bt + q] = z * r[q]; } }
    }
    if (F.lane < 8) { const float bfv = F.P.b_f[l * NH + F.lane];
#pragma unroll
        for (int k = 0; k < 8; ++k) { const float z = zrow[k] + bfv; LOGF[(size_t)F.lane * M + (gw + k * NGW)] = fminf(z, 0.f) - log1pf(expf(-fabsf(z))); } }
    __syncthreads();
}
__device__ __forceinline__ void p1_scan(Frame& F, int bh, int l) {
    LAS float* sh = (LAS float*)(F.lds + RING_OFF);
    LAS float* lfs = sh + 16 + SEQ;
    const int b = bh / NH, h = bh % NH, t0 = F.tid * 8;
    if (l == 0) { const float* lf = (const float*)(F.P.ws + WS_LOGF) + (size_t)h * M + (size_t)b * SEQ;
        { const f32x4 a0 = *(const f32x4*)(lf + F.tid * 4), a1 = *(const f32x4*)(lf + (F.tid + 512) * 4); *(LAS f32x4*)(lfs + F.tid * 4) = a0; *(LAS f32x4*)(lfs + (F.tid + 512) * 4) = a1; }
    } else {
        const float* fp = (const float*)(F.P.ws + WS_FP) + ((size_t)h * M + (size_t)b * SEQ) * 4; const float* sp = (const float*)(F.P.ws + WS_SSP) + (size_t)b * SEQ * 4; const float bfv = F.P.b_f[l * NH + h];
        f32x4 pv[8], qv[8];
#pragma unroll
        for (int k = 0; k < 8; ++k) { const int row = F.tid + 512 * k; pv[k] = *(const f32x4*)(fp + row * 4); qv[k] = *(const f32x4*)(sp + row * 4); }
#pragma unroll
        for (int k = 0; k < 8; ++k) { const float r = rsqrtf(((qv[k].x + qv[k].y) + (qv[k].z + qv[k].w)) * (1.f / D) + EPS); const float z = r * ((pv[k].x + pv[k].y) + (pv[k].z + pv[k].w)) + bfv;
            lfs[F.tid + 512 * k] = fminf(z, 0.f) - log1pf(expf(-fabsf(z))); }
    }
    __syncthreads();
    float c[8]; float run = 0.f;
    { const f32x4 a0 = *(const LAS f32x4*)(lfs + t0), a1 = *(const LAS f32x4*)(lfs + t0 + 4);
      run += a0.x; c[0] = run; run += a0.y; c[1] = run; run += a0.z; c[2] = run; run += a0.w; c[3] = run; run += a1.x; c[4] = run; run += a1.y; c[5] = run; run += a1.z; c[6] = run; run += a1.w; c[7] = run; }
    float inc = run;
#pragma unroll
    for (int o = 1; o < 64; o <<= 1) { const float n = __shfl_up(inc, o); if (F.lane >= o) inc += n; }
    if (F.lane == 63) sh[F.wave] = inc;
    __syncthreads();
    float base = inc - run;
    for (int w = 0; w < F.wave; ++w) base += sh[w];
    float* cs = (float*)(F.P.ws + WS_CS) + (size_t)bh * SEQ + t0;
    *(f32x4*)cs = (f32x4){(base + c[0]) * LOG2E, (base + c[1]) * LOG2E, (base + c[2]) * LOG2E, (base + c[3]) * LOG2E};
    *(f32x4*)(cs + 4) = (f32x4){(base + c[4]) * LOG2E, (base + c[5]) * LOG2E, (base + c[6]) * LOG2E, (base + c[7]) * LOG2E};
    __syncthreads();
    LAS float* c2s = sh + 16;
#pragma unroll
    for (int i = 0; i < 8; ++i) c2s[t0 + i] = (base + c[i]) * LOG2E;
    __syncthreads();
    if (F.tid < SEQ / 256) { const int qb = F.tid, nt = 4 * qb + 4; const float cq = c2s[256 * qb]; int lo = 0, hi = nt - 4;
        while (lo < hi) { const int mid = (lo + hi) >> 1; if (cq - c2s[64 * mid + 63] >= -SKIP_L2) hi = mid; else lo = mid + 1; }
        ((int*)(F.P.ws + WS_TS))[bh * 16 + qb] = lo & ~1; }
    __syncthreads();
}


#include <hip/hip_bf16.h>
namespace attn_body {
using bf16=__hip_bfloat16;
using s16x4=__attribute__((ext_vector_type(4)))short;
using f32x16=__attribute__((ext_vector_type(16)))float;
constexpr int NHEAD=NH,D=64,DM=1024;
constexpr int NW=8,QBLK=32,QB=QBLK*NW,KVBLK=64,NQB=SEQ/QB;
__device__ __forceinline__ int crow(int r,int hi){return (r&3)+8*(r>>2)+4*hi;}
#define SBAR() __builtin_amdgcn_sched_barrier(0)
__device__ __forceinline__ void cmask(f32x16&p0,f32x16&p1,int jb,int qrel,int hi){
  const float NEG=-INFINITY; int kb=64*jb+4*hi;
  #pragma unroll
  for(int r=0;r<16;++r){int kv=kb+(r&3)+8*(r>>2); if(kv>qrel)p0[r]=NEG; if(kv+32>qrel)p1[r]=NEG;}
}
constexpr int NSLOT=3, SLOTB=8192;
constexpr int LDS_K=0, LDS_V=NSLOT*SLOTB, LDS_WS=2*NSLOT*SLOTB, LDS_OST=LDS_WS+NW*64*4, LDS_C2=LDS_OST+NW*4096, LDS_BYTES=LDS_C2+SEQ*4+512;
__device__ __forceinline__ void glds16(const void*gsrc,unsigned lds_dst){unsigned keep;
  asm volatile("s_mov_b32 %0, m0\n\ts_mov_b32 m0, %2\n\ts_nop 0\n\tglobal_load_lds_dwordx4 %1, off\n\ts_mov_b32 m0, %0":"=&s"(keep):"v"(gsrc),"s"(lds_dst):"memory");}
__device__ __forceinline__ float max3f(float a,float b,float c){float r;asm("v_max3_f32 %0, %1, %2, %3":"=v"(r):"v"(a),"v"(b),"v"(c));return r;}
__device__ __forceinline__ float max2f(float a,float b){float r;asm("v_max_f32_e32 %0, %1, %2":"=v"(r):"v"(a),"v"(b));return r;}
__device__ __forceinline__ float fadd_s(float a,float b){float r;asm("v_add_f32_e32 %0, %1, %2":"=v"(r):"v"(a),"v"(b));return r;}
__device__ __forceinline__ float fsub_s(float a,float b){float r;asm("v_sub_f32_e32 %0, %1, %2":"=v"(r):"v"(a),"v"(b));return r;}
typedef float f32x2_t __attribute__((ext_vector_type(2))); typedef __bf16 bf16x2_t __attribute__((ext_vector_type(2)));
__device__ __forceinline__ unsigned cvtpk_s(float lo,float hi){f32x2_t v={lo,hi};bf16x2_t b=__builtin_convertvector(v,bf16x2_t);return __builtin_bit_cast(unsigned,b);}
#define WAIT_BAR(N) asm volatile("s_waitcnt vmcnt(" #N ") lgkmcnt(0)\n\ts_barrier":::"memory")
__device__ __forceinline__ void split3(float x,unsigned&h,unsigned&m,unsigned&l){
  const unsigned u=__float_as_uint(x)&0xffff0000u; const float r1=x-__uint_as_float(u);
  const unsigned u1=__float_as_uint(r1)&0xffff0000u; const float r2=r1-__uint_as_float(u1);
  h=u>>16; m=u1>>16; l=__float_as_uint(r2)>>16; }
__device__ __forceinline__ bf16x8 make_qx(float base,int hi){ unsigned h,m,l; split3(base,h,m,l); u32x4 w; w.x=h|(m<<16); w.y=l|0x3f800000u; w.z=0x3f803f80u; w.w=0u; if(hi){w.x=0u;w.y=0u;w.z=0u;} return __builtin_bit_cast(bf16x8,w); }
__device__ __forceinline__ bf16x8 make_kx(float ck,int hi){ unsigned h,m,l; split3(-ck,h,m,l); u32x4 w; w.x=0x3f803f80u; w.y=0x3f80u|(h<<16); w.z=m|(l<<16); w.w=0u; if(hi){w.x=0u;w.y=0u;w.z=0u;} return __builtin_bit_cast(bf16x8,w); }

__device__ __forceinline__ void qkt(f32x16&p0,f32x16&p1,const char*Kslot,const bf16x8*qr,bf16x8 qx,bf16x8 kx0,bf16x8 kx1,int r32,int hi){
  const char*kb=Kslot+hi*1024+r32*16; const f32x16 z=f32x16{};
  p0=__builtin_amdgcn_mfma_f32_32x32x16_bf16(kx0,qx,z,0,0,0);p1=__builtin_amdgcn_mfma_f32_32x32x16_bf16(kx1,qx,z,0,0,0);
  #pragma unroll
  for(int d0=0;d0<4;++d0){
    const bf16x8 b0=*reinterpret_cast<const bf16x8*>(kb+d0*2048);
    const bf16x8 b1=*reinterpret_cast<const bf16x8*>(kb+d0*2048+512);
    p0=__builtin_amdgcn_mfma_f32_32x32x16_bf16(b0,qr[d0],p0,0,0,0);p1=__builtin_amdgcn_mfma_f32_32x32x16_bf16(b1,qr[d0],p1,0,0,0);}
}
typedef __attribute__((address_space(3))) const char* lds_cptr;
typedef short v4i16_t __attribute__((ext_vector_type(4)));
__device__ __forceinline__ void kload8(bf16x8*kf,lds_cptr kp){
  kf[0]=*(const __attribute__((address_space(3))) bf16x8*)(kp);      kf[1]=*(const __attribute__((address_space(3))) bf16x8*)(kp+512);
  kf[2]=*(const __attribute__((address_space(3))) bf16x8*)(kp+2048); kf[3]=*(const __attribute__((address_space(3))) bf16x8*)(kp+2560);
  kf[4]=*(const __attribute__((address_space(3))) bf16x8*)(kp+4096); kf[5]=*(const __attribute__((address_space(3))) bf16x8*)(kp+4608);
  kf[6]=*(const __attribute__((address_space(3))) bf16x8*)(kp+6144); kf[7]=*(const __attribute__((address_space(3))) bf16x8*)(kp+6656);
}
__device__ __forceinline__ void kload2(bf16x8*kf,lds_cptr kp,int j){ kf[2*j]=*(const __attribute__((address_space(3))) bf16x8*)(kp+j*2048); kf[2*j+1]=*(const __attribute__((address_space(3))) bf16x8*)(kp+j*2048+512); }
__device__ __forceinline__ s16x4 vtr(lds_cptr p){ return __builtin_bit_cast(s16x4,__builtin_amdgcn_ds_read_tr16_b64_v4i16((__attribute__((address_space(3))) v4i16_t*)p)); }
__device__ __forceinline__ float rowmax(const f32x16&p0,const f32x16&p1){
  float a=max3f(p0[0],p0[1],p1[0]),b=max3f(p0[2],p0[3],p1[1]);a=max3f(a,p1[2],p1[3]);
  #pragma unroll
  for(int r=4;r<16;r+=4){a=max3f(a,p0[r],p0[r+1]);b=max3f(b,p0[r+2],p0[r+3]);a=max3f(a,p1[r],p1[r+1]);b=max3f(b,p1[r+2],p1[r+3]);}
  const float m=max2f(a,b);
  auto rr=__builtin_amdgcn_permlane32_swap(__float_as_uint(m),__float_as_uint(m),false,false);
  return max2f(__uint_as_float(rr[0]),__uint_as_float(rr[1]));
}
__device__ __forceinline__ void pv(f32x16*o,int vb,bf16x8 pa0,bf16x8 pa1,bf16x8 pa2,bf16x8 pa3){
  #pragma unroll
  for(int d0=0;d0<2;++d0){s16x4 lo[4],hi[4];
    #pragma unroll
    for(int ks=0;ks<4;++ks){
      asm volatile("ds_read_b64_tr_b16 %0,%1 offset:%c2":"=&v"(lo[ks]):"v"(vb),"i"(d0*4096+ks*1024):"memory");
      asm volatile("ds_read_b64_tr_b16 %0,%1 offset:%c2":"=&v"(hi[ks]):"v"(vb),"i"(d0*4096+ks*1024+512):"memory");}
    asm volatile("s_waitcnt lgkmcnt(0)":::"memory");SBAR();
    #define PK(k) (bf16x8){lo[k][0],lo[k][1],lo[k][2],lo[k][3],hi[k][0],hi[k][1],hi[k][2],hi[k][3]}
    o[d0]=__builtin_amdgcn_mfma_f32_32x32x16_bf16(pa0,PK(0),o[d0],0,0,0);
    o[d0]=__builtin_amdgcn_mfma_f32_32x32x16_bf16(pa1,PK(1),o[d0],0,0,0);
    o[d0]=__builtin_amdgcn_mfma_f32_32x32x16_bf16(pa2,PK(2),o[d0],0,0,0);
    o[d0]=__builtin_amdgcn_mfma_f32_32x32x16_bf16(pa3,PK(3),o[d0],0,0,0);
    #undef PK
  }
}
#define ATTN_STORE16(p,v) (*(u32x4*)(p)=(v))
template<int THRL> __device__ __forceinline__ void attn_unit(int b,int h,int qb,const bf16*Q,const bf16*__restrict__ K,const bf16*__restrict__ V,const bf16*__restrict__ CZ,bf16*O,const float*__restrict__ c2g,int ts,float ub,char*shm){
  int tid=threadIdx.x; asm volatile("":"+v"(tid));
  const int lane=tid&63,r32=lane&31,hi=lane>>5; const int wid=__builtin_amdgcn_readfirstlane(tid>>6);
  const long rowbase=(long)b*SEQ; const int q0=qb*QB;
  const bf16*Qw=Q+(rowbase+q0+wid*QBLK)*DM+h*D;
  const bf16*Kh=K+(rowbase+(long)ts*KVBLK)*DM+h*D,*Vh=V+(rowbase+(long)ts*KVBLK)*DM+h*D;
  const unsigned lds0=(unsigned)(uintptr_t)shm;
  float*wsf=(float*)(shm+LDS_WS)+wid*64;
  float*c2l=(float*)(shm+LDS_C2);
  const bf16*ksrc=Kh+(long)lane*DM+wid*8;
  const bf16*vsrc=Vh+(long)(16*(wid&3)+(lane>>2))*DM+(wid>>2)*32+(lane&3)*8;
  const unsigned kdst=lds0+LDS_K+wid*1024, vdst=lds0+LDS_V+wid*1024;
  #define DMA_K(t,slot) glds16(ksrc+(long)(t)*KVBLK*DM,(unsigned)__builtin_amdgcn_readfirstlane(kdst+(slot)))
  #define DMA_V(t,slot) glds16(vsrc+(long)(t)*KVBLK*DM,(unsigned)__builtin_amdgcn_readfirstlane(vdst+(slot)))
  const int vb0=(int)(lds0+LDS_V)+((lane>>4)&1)*32+(lane&3)*8+(4*hi+((lane&15)>>2))*64;
  const char*Kbase=shm+LDS_K; bf16x8 kf[8];
  const lds_cptr shm3=(lds_cptr)shm; const lds_cptr kp0=shm3+LDS_K+hi*1024+r32*16; const lds_cptr vp0=shm3+LDS_V+((lane>>4)&1)*32+(lane&3)*8+(4*hi+((lane&15)>>2))*64;
  const int NT=(q0+QB)/KVBLK-ts;
  DMA_K(0,0);DMA_V(0,0);DMA_K(1,SLOTB);
  { const int kb0=ts*KVBLK,n_=q0+QB-kb0,i0=tid*4,i1=tid*4+NW*64*4; f32x4 a0=f32x4{0.f,0.f,0.f,0.f},a1=a0; if(i0<n_)a0=*(const f32x4*)(c2g+kb0+i0); if(i1<n_)a1=*(const f32x4*)(c2g+kb0+i1); if(i0<n_)*(f32x4*)(c2l+i0)=a0; if(i1<n_)*(f32x4*)(c2l+i1)=a1; }
  bf16x8 qr[4];
  #pragma unroll
  for(int d0=0;d0<4;++d0)qr[d0]=*reinterpret_cast<const bf16x8*>(&Qw[(long)r32*DM+d0*16+hi*8]);
    float mhat=ub,l_reg=0.f;f32x16 o[2];o[0]=f32x16{};o[1]=f32x16{};
  const int qrel=wid*QBLK+r32;
  #define CMASK(P0,P1,t) do{int jb_=(t)-(NT-4); if(jb_>=0)cmask(P0,P1,jb_,qrel,hi);}while(0)
  bool resc=false;
  bf16x8 qx; float cq2;
  #define START(P0,P1) do{ resc=false; \
    _Pragma("unroll") for(int r=0;r<16;++r)P0[r]=__builtin_amdgcn_exp2f(P0[r]); }while(0)
  #define RESC() do{}while(0)
  f32x16 pA0,pA1,pB0,pB1;
  int sl_prev=0,sl_cur=0,sl_next=SLOTB;
  #define ROT() do{sl_prev=sl_cur;sl_cur=sl_next;sl_next=(sl_next==(NSLOT-1)*SLOTB)?0:sl_next+SLOTB;}while(0)
  DMA_K(2,2*SLOTB);
  WAIT_BAR(3);
  cq2=c2l[q0+qrel-ts*KVBLK]; qx=make_qx(cq2-mhat,hi);
  float ck0=c2l[r32],ck1=c2l[32+r32];
  { const bf16x8 kx0=make_kx(ck0,hi),kx1=make_kx(ck1,hi);
    qkt(pA0,pA1,Kbase,qr,qx,kx0,kx1,r32,hi); }
  asm volatile("s_nop 15\n\ts_nop 7":"+v"(pA0),"+v"(pA1));CMASK(pA0,pA1,0);
  ck0=c2l[64+r32];ck1=c2l[96+r32];
  START(pA0,pA1);
  _Pragma("unroll") for(int r=0;r<16;++r)pA1[r]=__builtin_amdgcn_exp2f(pA1[r]);
  WAIT_BAR(0);
  DMA_K(3,0);DMA_V(1,SLOTB);
  ROT();
  kload8(kf,kp0+sl_cur);
  WAIT_BAR(2);
  s16x4 vlo[8],vhi[8]; u32x4 pw0,pw1,pw2,pw3;
  #define PKW(P,B) cvtpk_s(P[B],P[B+1])
  #define PAF(k) __builtin_bit_cast(bf16x8,pw##k)
  #define VFR(i) (bf16x8){vlo[i][0],vlo[i][1],vlo[i][2],vlo[i][3],vhi[i][0],vhi[i][1],vhi[i][2],vhi[i][3]}
  #define PIN(x) asm volatile("":"+v"(x))
  #define MX3(a,b,c) __builtin_fmaxf(__builtin_fmaxf((a),(b)),(c))
  #define GAPA(MF,A0,A1,A2,A3,W0,W1,PW) do{ MF; sacc+=A0; sacc+=A1; sacc+=A2; sacc+=A3; PIN(sacc); W0; W1; PIN(PW); SBAR(); }while(0)
  #define EX(v) __builtin_amdgcn_exp2f(v)
  #define GAPB(MF,X,B) do{ MF; X[B]=EX(X[B]); X[B+1]=EX(X[B+1]); X[B+2]=EX(X[B+2]); X[B+3]=EX(X[B+3]); PIN(X); SBAR(); }while(0)
  #define VRD(i) do{ vlo[i]=vtr(vp_+(((i)>>2)*4096+((i)&3)*1024)); vhi[i]=vtr(vp_+(((i)>>2)*4096+((i)&3)*1024+512)); }while(0)
  #define KRD(G,j) do{ if(G){ kload2(kf,kp0+sl_next,j); SBAR(); } }while(0)
  #define STEP(C0,C1,P0,P1,t,GK,GV,GL) do{ SBAR(); \
    const lds_cptr vp_=vp0+sl_prev; \
    { const bf16x8 kx0_=make_kx(ck0,hi),kx1_=make_kx(ck1,hi); const f32x16 z_=f32x16{}; \
      C0=__builtin_amdgcn_mfma_f32_32x32x16_bf16(kx0_,qx,z_,0,0,0); C1=__builtin_amdgcn_mfma_f32_32x32x16_bf16(kx1_,qx,z_,0,0,0); } SBAR(); \
    VRD(0); SBAR(); float sacc=(P0[0]+P0[1]); \
    GAPA(C0=__builtin_amdgcn_mfma_f32_32x32x16_bf16(kf[0],qr[0],C0,0,0,0), P0[2],P0[3],P0[4],P0[5],     pw0[0]=PKW(P0,0), pw0[1]=PKW(P0,2), pw0); \
    VRD(4); SBAR(); GAPA(C1=__builtin_amdgcn_mfma_f32_32x32x16_bf16(kf[1],qr[0],C1,0,0,0), P0[6],P0[7],P0[8],P0[9],     pw0[2]=PKW(P0,4), pw0[3]=PKW(P0,6), pw0); \
    VRD(1); SBAR(); GAPA(C0=__builtin_amdgcn_mfma_f32_32x32x16_bf16(kf[2],qr[1],C0,0,0,0),   P0[10],P0[11],P0[12],P0[13], pw1[0]=PKW(P0,8), pw1[1]=PKW(P0,10), pw1); \
    VRD(5); SBAR(); GAPA(C1=__builtin_amdgcn_mfma_f32_32x32x16_bf16(kf[3],qr[1],C1,0,0,0),   P0[14],P0[15],P1[0],P1[1],   pw1[2]=PKW(P0,12),pw1[3]=PKW(P0,14), pw1); \
    VRD(2); SBAR(); GAPA(C0=__builtin_amdgcn_mfma_f32_32x32x16_bf16(kf[4],qr[2],C0,0,0,0),   P1[2],P1[3],P1[4],P1[5],     pw2[0]=PKW(P1,0), pw2[1]=PKW(P1,2), pw2); \
    VRD(6); SBAR(); GAPA(C1=__builtin_amdgcn_mfma_f32_32x32x16_bf16(kf[5],qr[2],C1,0,0,0),   P1[6],P1[7],P1[8],P1[9],     pw2[2]=PKW(P1,4), pw2[3]=PKW(P1,6), pw2); \
    VRD(3); SBAR(); GAPA(C0=__builtin_amdgcn_mfma_f32_32x32x16_bf16(kf[6],qr[3],C0,0,0,0),   P1[10],P1[11],P1[12],P1[13], pw3[0]=PKW(P1,8), pw3[1]=PKW(P1,10), pw3); \
    VRD(7); SBAR(); GAPA(C1=__builtin_amdgcn_mfma_f32_32x32x16_bf16(kf[7],qr[3],C1,0,0,0),   P1[14],P1[15],0.f,0.f,       pw3[2]=PKW(P1,12),pw3[3]=PKW(P1,14), pw3); \
    l_reg+=sacc; \
    if(GK){DMA_K((t)+3,sl_cur);} if(GV){DMA_V((t)+1,sl_next);} \
    if(GL){ ck0=c2l[64*((t)+1)+r32]; ck1=c2l[64*((t)+1)+32+r32]; } \
    CMASK(C0,C1,t); \
    SBAR(); \
    GAPB(o[0]=__builtin_amdgcn_mfma_f32_32x32x16_bf16(PAF(0),VFR(0),o[0],0,0,0), C0,0); \
    GAPB(o[1]=__builtin_amdgcn_mfma_f32_32x32x16_bf16(PAF(0),VFR(4),o[1],0,0,0), C0,4); \
    KRD(GL,0); GAPB(o[0]=__builtin_amdgcn_mfma_f32_32x32x16_bf16(PAF(1),VFR(1),o[0],0,0,0), C0,8); \
    KRD(GL,1); GAPB(o[1]=__builtin_amdgcn_mfma_f32_32x32x16_bf16(PAF(1),VFR(5),o[1],0,0,0), C0,12); \
    KRD(GL,2); GAPB(o[0]=__builtin_amdgcn_mfma_f32_32x32x16_bf16(PAF(2),VFR(2),o[0],0,0,0), C1,0); \
    KRD(GL,3); GAPB(o[1]=__builtin_amdgcn_mfma_f32_32x32x16_bf16(PAF(2),VFR(6),o[1],0,0,0), C1,4); \
    GAPB(o[0]=__builtin_amdgcn_mfma_f32_32x32x16_bf16(PAF(3),VFR(3),o[0],0,0,0), C1,8); \
    GAPB(o[1]=__builtin_amdgcn_mfma_f32_32x32x16_bf16(PAF(3),VFR(7),o[1],0,0,0), C1,12); \
    }while(0)
  int t=1;
  #undef CMASK
  #define CMASK(P0,P1,t) do{}while(0)
  for(;t+5<NT;t+=2){
    STEP(pB0,pB1,pA0,pA1,t,true,true,true);     WAIT_BAR(2); RESC(); ROT();
    STEP(pA0,pA1,pB0,pB1,t+1,true,true,true);   WAIT_BAR(2); RESC(); ROT();
  }
  #undef CMASK
  #define CMASK(P0,P1,t) do{int jb_=(t)-(NT-4); if(jb_>=0)cmask(P0,P1,jb_,qrel,hi);}while(0)
  #define ENDW(tt) do{ if((tt)+3<NT){WAIT_BAR(2);} else if((tt)+2<NT){WAIT_BAR(1);} else {WAIT_BAR(0);} }while(0)
  for(;t+1<NT;t+=2){
    STEP(pB0,pB1,pA0,pA1,t,(t+3<NT),(t+1<NT),(t+1<NT));       ENDW(t);   RESC(); ROT();
    STEP(pA0,pA1,pB0,pB1,t+1,(t+4<NT),(t+2<NT),(t+2<NT));     ENDW(t+1); RESC(); ROT();
  }
  { const bf16*czs=CZ+(rowbase+q0+wid*QBLK+(lane>>3))*DM+h*D+(lane&7)*8; const unsigned czd=lds0+LDS_OST+wid*4096;
    _Pragma("unroll") for(int k=0;k<4;++k)glds16(czs+(long)(8*k)*DM,(unsigned)__builtin_amdgcn_readfirstlane(czd+k*1024)); }
  STEP(pB0,pB1,pA0,pA1,NT-1,false,false,false); RESC();
  { float sacc=pB0[0]+pB0[1]; _Pragma("unroll") for(int r=2;r<16;++r)sacc+=pB0[r]; _Pragma("unroll") for(int r=0;r<16;++r)sacc+=pB1[r]; l_reg+=sacc;
    pw0=(u32x4){PKW(pB0,0),PKW(pB0,2),PKW(pB0,4),PKW(pB0,6)};pw1=(u32x4){PKW(pB0,8),PKW(pB0,10),PKW(pB0,12),PKW(pB0,14)};pw2=(u32x4){PKW(pB1,0),PKW(pB1,2),PKW(pB1,4),PKW(pB1,6)};pw3=(u32x4){PKW(pB1,8),PKW(pB1,10),PKW(pB1,12),PKW(pB1,14)};
    SBAR(); pv(o,vb0+sl_cur,PAF(0),PAF(1),PAF(2),PAF(3)); }
  #undef PKW
  #undef PAF
  #undef VFR
  #undef PIN
  #undef MX3
  #undef GAPA
  #undef GAPB
  #undef EX
  #undef VRD
  #undef KRD
  #undef STEP
  #undef ENDW
  {auto rr=__builtin_amdgcn_permlane32_swap(__float_as_uint(l_reg),__float_as_uint(l_reg),false,false);l_reg=__uint_as_float(rr[0])+__uint_as_float(rr[1]);}
  if(hi==0)wsf[32+r32]=l_reg;asm volatile("s_waitcnt lgkmcnt(0)":::"memory");
  bf16*Ow=O+(rowbase+q0+wid*QBLK)*DM+h*D;
  { bf16*stg=(bf16*)(shm+LDS_OST)+wid*2048; const unsigned short*Cw=(const unsigned short*)stg;
    asm volatile("s_waitcnt vmcnt(0)":::"memory");
    #pragma unroll
    for(int r=0;r<16;++r){const int orow=crow(r,hi); const float rl=__builtin_amdgcn_rcpf(wsf[32+orow]);
      #pragma unroll
      for(int d0=0;d0<2;++d0){ const float cz=__uint_as_float((unsigned)Cw[orow*64+d0*32+r32]<<16); stg[orow*64+d0*32+r32]=__float2bfloat16(o[d0][r]*rl*cz);} }
    asm volatile("s_waitcnt lgkmcnt(0)":::"memory");
    #pragma unroll
    for(int i=0;i<4;++i){const int row=i*8+(lane>>3),ch=lane&7; const u32x4 v=*(const u32x4*)(stg+row*64+ch*8); ATTN_STORE16(Ow+(long)row*DM+ch*8,v);} }
  asm volatile("s_waitcnt lgkmcnt(0)\n\ts_barrier":::"memory");
  #undef DMA_K
  #undef DMA_V
  #undef CMASK
  #undef START
  #undef RESC
  #undef ROT
}
#undef SBAR
#undef WAIT_BAR
}

typedef float f32x2 __attribute__((ext_vector_type(2)));
__device__ __forceinline__ void p2_conv(Frame& F, int l, int unit, bf16_t* outb, const bool pv_ = false) {
    const int tid = F.tid, lane = F.lane, w = F.wave;
    const size_t row0 = (size_t)unit * 64; const int tseq0 = (int)(row0 % SEQ);
    const bf16_t* AG = (const bf16_t*)(F.P.ws + WS_B3); const bf16_t* B0 = (const bf16_t*)(F.P.ws + WS_B0);
    LAS unsigned char* tile = F.lds + RING_OFF;
    LAS float* wl = (LAS float*)(tile + 94 * 1024);
    {
        const float* cwg = F.P.conv_w + (size_t)l * CW * DA;
        u32x4 tv[12]; f32x4 wv4[8];
#pragma unroll
        for (int k = 0; k < 12; ++k) { const int c = tid + 512 * k, r = c >> 6, ch = c & 63, tr = r - (CW - 1); const bool valid = (c < 94 * 64) && (tseq0 + tr >= 0);
            tv[k] = (u32x4){0u, 0u, 0u, 0u}; if (valid) tv[k] = *(const u32x4*)(AG + (size_t)((long)row0 + tr) * 1024 + ch * 8); }
#pragma unroll
        for (int k = 0; k < 8; ++k) { const int c = tid + 512 * k; wv4[k] = (f32x4){0.f, 0.f, 0.f, 0.f}; if (c < CW * DA / 4) wv4[k] = *(const f32x4*)(cwg + 4 * c); }
#pragma unroll
        for (int k = 0; k < 12; ++k) { const int c = tid + 512 * k, r = c >> 6, ch = c & 63; if (c < 94 * 64) *(LAS u32x4*)(tile + r * 1024 + ch * 16) = tv[k]; }
#pragma unroll
        for (int k = 0; k < 8; ++k) { const int c = tid + 512 * k; if (c < CW * DA / 4) *(LAS f32x4*)(wl + 4 * c) = wv4[k]; }
    }
    __syncthreads();
    if (PROBE_CONV == 2 && pv_) { __syncthreads(); return; }
    f32x2 out[4][8]; float s1[8], s2[8];
#pragma unroll
    for (int o = 0; o < 8; ++o) { s1[o] = 0.f; s2[o] = 0.f; }
#pragma unroll
    for (int i = 0; i < 4; ++i) {
        __builtin_amdgcn_sched_barrier(0);
        int p = lane + 64 * i; asm volatile("" : "+v"(p));
        const LAS float* cw = wl + 2 * p;
        f32x2 wv[CW];
#pragma unroll
        for (int j = 0; j < CW; ++j) wv[j] = *(const LAS f32x2*)(cw + j * DA);
        const f32x2 cb = *(const f32x2*)(F.P.conv_b + l * DA + 2 * p);
        const LAS unsigned* tp = (const LAS unsigned*)(tile + (8 * w) * 1024 + 4 * p);
        f32x2 win[16];
#pragma unroll
        for (int k = 0; k < 16; ++k) { const unsigned u = tp[k * 256]; win[k] = (f32x2){__uint_as_float(u << 16), __uint_as_float(u & 0xffff0000u)}; }
#pragma unroll
        for (int o = 0; o < 8; ++o) out[i][o] = cb;
        __builtin_amdgcn_sched_barrier(0);
#pragma unroll
        for (int j = 0; j < CW; ++j) {
            if (!(PROBE_CONV == 1 && pv_))
#pragma unroll
            for (int o = 0; o < 8; ++o) out[i][o] += wv[j] * win[(j + o) & 15];
            asm volatile("" : "+v"(out[i][0]), "+v"(out[i][1]), "+v"(out[i][2]), "+v"(out[i][3]), "+v"(out[i][4]), "+v"(out[i][5]), "+v"(out[i][6]), "+v"(out[i][7]));
            if (j + 16 < 38) { const LAS unsigned* tq = tp; asm volatile("" : "+v"(tq)); const unsigned u = tq[(j + 16) * 256]; win[j & 15] = (f32x2){__uint_as_float(u << 16), __uint_as_float(u & 0xffff0000u)}; }
            __builtin_amdgcn_sched_barrier(0);
        }
#pragma unroll
        for (int o = 0; o < 8; ++o) { s1[o] += out[i][o].x + out[i][o].y; s2[o] += out[i][o].x * out[i][o].x + out[i][o].y * out[i][o].y; }
    }
    unsigned az[4][8];
#pragma unroll
    for (int i = 0; i < 4; ++i)
#pragma unroll
        for (int o = 0; o < 8; ++o) az[i][o] = *(const unsigned*)(B0 + (row0 + 8 * w + o) * 1024 + 2 * (lane + 64 * i));
#pragma unroll
    for (int o = 0; o < 8; ++o) { s1[o] = wsum(s1[o]); s2[o] = wsum(s2[o]); }
#pragma unroll
    for (int i = 0; i < 4; ++i) {
        const int p = lane + 64 * i;
        const f32x2 gg = *(const f32x2*)(F.P.cn_g + l * DA + 2 * p), be = *(const f32x2*)(F.P.cn_b + l * DA + 2 * p);
#pragma unroll
        for (int o = 0; o < 8; ++o) { const float mu = s1[o] * (1.f / DA), ex2 = s2[o] * (1.f / DA); const float rstd = rsqrtf(fmaxf(ex2 - mu * mu, 0.f) + EPS);
            f32x2 y = (out[i][o] - mu) * rstd * gg + be; y.x = y.x * fsigm(y.x); y.y = y.y * fsigm(y.y);
            *(unsigned*)(outb + (row0 + 8 * w + o) * 1024 + 2 * p) = cvt_pk_bf16(y.x * __uint_as_float(az[i][o] << 16), y.y * __uint_as_float(az[i][o] & 0xffff0000u)); }
    }
    __syncthreads();
}
__device__ __forceinline__ void p2_gmlp(Frame& F, int l, int unit, bf16_t* outb) {
    constexpr int VP = 528;
    const int tid = F.tid, lane = F.lane, w = F.wave, fr = lane & 15, fq = lane >> 4, ch = unit >> 1, gp = unit & 1, c0 = 256 * gp; const size_t row0 = (size_t)ch * CHK;
    LAS unsigned char* vr = F.lds + RING_OFF;
    const bf16_t* V = (const bf16_t*)(F.P.ws + WS_B3) + 512 + c0; const bf16_t* U = (const bf16_t*)(F.P.ws + WS_B0) + 512 + c0;
    const float* vss = (const float*)(F.P.ws + WS_VSS); const float* gn = F.P.gn_g + l * DB + c0;
    const size_t t = row0 + 16 * w + fr;
    unsigned long long uu[16];
#pragma unroll
    for (int n = 0; n < 16; ++n) uu[n] = *(const unsigned long long*)(U + t * 1024 + 16 * n + 4 * fq);
    bf16x8 wf[2][4];
#pragma unroll
    for (int g2 = 0; g2 < 2; ++g2)
#pragma unroll
        for (int ks = 0; ks < 4; ++ks) wf[g2][ks] = *(const bf16x8*)((const bf16_t*)(F.P.ws + WS_WSB) + ((size_t)(l * NG + 2 * gp + g2) * CHK + 16 * w + fr) * CHK + 32 * ks + 8 * fq);
    const float bs0 = F.P.b_s[(size_t)(l * NG + 2 * gp) * CHK + 16 * w + fr], bs1 = F.P.b_s[(size_t)(l * NG + 2 * gp + 1) * CHK + 16 * w + fr];
    { const int c8 = (tid & 31) * 8, sb = tid >> 5;
      const f32x4 g0 = *(const f32x4*)(gn + c8), g1 = *(const f32x4*)(gn + c8 + 4);
      u32x4 raw[8]; f32x4 qa[8], qb[8];
#pragma unroll
      for (int k = 0; k < 8; ++k) { const size_t s = row0 + sb + 16 * k; raw[k] = *(const u32x4*)(V + s * 1024 + c8); qa[k] = *(const f32x4*)(vss + s * 8); qb[k] = *(const f32x4*)(vss + s * 8 + 4); }
#pragma unroll
      for (int k = 0; k < 8; ++k) { const float ss = ((qa[k].x + qa[k].y) + (qa[k].z + qa[k].w)) + ((qb[k].x + qb[k].y) + (qb[k].z + qb[k].w)); const float rv = rsqrtf(ss * (1.f / DB) + EPS);
          f32x4 v0, v1; unpack8(raw[k], v0, v1); v0 = v0 * rv * g0; v1 = v1 * rv * g1;
          *(LAS u32x4*)(vr + (sb + 16 * k) * VP + c8 * 2) = pack8(v0, v1); } }
    __syncthreads();
    f32x4 acc[16];
#pragma unroll
    for (int n = 0; n < 16; ++n) acc[n] = (f32x4){0.f, 0.f, 0.f, 0.f};
    typedef short v4i16_t __attribute__((ext_vector_type(4)));
    const LAS unsigned char* tb = vr + (8 * fq + (fr >> 2)) * VP + (fr & 3) * 8;
#pragma unroll
    for (int ks = 0; ks < 4; ++ks) {
        if (32 * ks <= 16 * w + 15) {
#pragma unroll
            for (int n = 0; n < 16; ++n) {
                const v4i16_t lo = __builtin_amdgcn_ds_read_tr16_b64_v4i16((LAS v4i16_t*)(tb + (32 * ks) * VP + 32 * n));
                const v4i16_t hi = __builtin_amdgcn_ds_read_tr16_b64_v4i16((LAS v4i16_t*)(tb + (32 * ks + 4) * VP + 32 * n));
                const bf16x8 vf = (bf16x8){lo[0], lo[1], lo[2], lo[3], hi[0], hi[1], hi[2], hi[3]};
                acc[n] = __builtin_amdgcn_mfma_f32_16x16x32_bf16(vf, wf[n >> 3][ks], acc[n], 0, 0, 0); }
        }
    }
#pragma unroll
    for (int n = 0; n < 16; ++n) { const float bs = n < 8 ? bs0 : bs1;
        const unsigned u0 = (unsigned)uu[n], u1 = (unsigned)(uu[n] >> 32);
        const float o0 = __uint_as_float(u0 << 16) * (acc[n][0] + bs), o1 = __uint_as_float(u0 & 0xffff0000u) * (acc[n][1] + bs);
        const float o2 = __uint_as_float(u1 << 16) * (acc[n][2] + bs), o3 = __uint_as_float(u1 & 0xffff0000u) * (acc[n][3] + bs);
        *(unsigned long long*)(outb + 512 + c0 + t * 1024 + 16 * n + 4 * fq) = (unsigned long long)cvt_pk_bf16(o0, o1) | ((unsigned long long)cvt_pk_bf16(o2, o3) << 32); }
    __syncthreads();
}

__global__ void __launch_bounds__(NWAVES * 64, 2) mk_fwd(Args args) {
    extern __shared__ __attribute__((aligned(16))) unsigned char lds[];
    Frame F;
    F.lds = (LAS unsigned char*)lds;
    volatile LAS unsigned* MISC = (volatile LAS unsigned*)(F.lds + MISC_OFF);
    F.tid = threadIdx.x; F.lane = F.tid & 63; F.wave = __builtin_amdgcn_readfirstlane(F.tid >> 6);
    F.G = gridDim.x; { const int bx = blockIdx.x; F.vcu = (F.G % 8 == 0) ? (bx % 8) * (F.G / 8) + bx / 8 : bx; }
    F.P.x = args.in[0]; F.P.norm_g = args.in[1]; F.P.w_in = args.in[2]; F.P.b_gate = args.in[3]; F.P.conv_w = args.in[4]; F.P.conv_b = args.in[5]; F.P.cn_g = args.in[6]; F.P.cn_b = args.in[7]; F.P.w_a = args.in[8];
    F.P.gn_g = args.in[9]; F.P.w_s = args.in[10]; F.P.b_s = args.in[11]; F.P.w_b = args.in[12]; F.P.qn_g = args.in[13]; F.P.kn_g = args.in[14]; F.P.b_f = args.in[15]; F.P.w_c = args.in[16]; F.P.w_out = args.in[17];
    F.P.out = args.out; F.P.ws = args.ws;
    gu32* ctl = (gu32*)(args.ws + WS_CTL);
    for (int u = F.tid; u < (LDS_BYTES - LDSCTL_OFF) / 4; u += NWAVES * 64) ((LAS unsigned*)(F.lds + LDSCTL_OFF))[u] = 0u;
    __syncthreads();
    XcdBarrier bar = xcd_barrier_post((unsigned*)(ctl + CW_BAR) + args.li * XCD_BAR_WORDS, MISC + 8);

#if PROBE_TS >= 0
    if (blockIdx.x == 0 && threadIdx.x == 0) { ((unsigned long long*)(args.ws + WS_TS + 4096))[2] = 0ull; if (PROBE_TS == 99) ((unsigned long long*)(args.ws + WS_TS + 4096))[0] = __builtin_amdgcn_s_memrealtime(); }
#endif
    bool dup_done = false;
    for (int ph = args.ph_lo; ph < args.ph_hi;) {
        const int l = ph / 5, p = ph % 5;
#if PROBE_TS >= 0
        if (blockIdx.x == 0 && threadIdx.x == 0 && ph == PROBE_TS) ((unsigned long long*)(args.ws + WS_TS + 4096))[0] = __builtin_amdgcn_s_memrealtime();
        if (PROBE_TSW && blockIdx.x == 0 && threadIdx.x == 0 && ph > PROBE_TS && ((unsigned long long*)(args.ws + WS_TS + 4096))[2] == 0ull) { ((unsigned long long*)(args.ws + WS_TS + 4096))[1] = __builtin_amdgcn_s_memrealtime(); ((unsigned long long*)(args.ws + WS_TS + 4096))[2] = 1ull; }
#endif
        const bool dummy = (PROBE_DUP >= 0) && p == PROBE_DUP && !dup_done;
        asm volatile("" : "+v"(F.tid)); F.lane = F.tid & 63;
        int bid = (int)blockIdx.x; asm volatile("" : "+s"(bid));
        unsigned char* ws = F.P.ws; unsigned char* wl = ws + WS_W + (size_t)l * W_LAYER;
        const float* xin = l == 0 ? F.P.x : F.P.out;
        if (p == 0) {
            if (l > 0) { ++ph; continue; }
            if (l == 0 && (!dummy || (PROBE_SUB & 1))) p0_weights(F);
            if (!dummy || (PROBE_SUB & 2)) p0_ln(F, l, xin);
        } else if (p == 1) {
            { pg8::TileOrder T0; T0.init(M, N1, F.G, bid); int pm_ = 0, pn_ = 0; (void)T0.tile(0, pm_, pn_);
              LAS float* Rt = (LAS float*)(F.lds + RT_OFF);
              if (F.tid < 256) { float r = 1.f; { const f32x4 q = *(const f32x4*)((const float*)(ws + WS_SSP) + ((size_t)pm_ * 256 + F.tid) * 4); r = rsqrtf(((q.x + q.y) + (q.z + q.w)) * (1.f / D) + EPS); } Rt[F.tid] = r; }
              __syncthreads(); }
            pg8::SchedG1 S; S.T.init(M, N1, F.G, bid); S.A = (const char*)(ws + WS_H); S.B = (const char*)(wl + WO_W1);
            pg8::EpiG1 E{(bf16_t*)(ws + WS_B0), (bf16_t*)(ws + WS_B1), (bf16_t*)(ws + WS_B2), (bf16_t*)(ws + WS_B3), (bf16_t*)(ws + WS_B4), (float*)(ws + WS_VSS), F.P.qn_g + l * HD, F.P.kn_g + l * HD, (const LAS float*)(F.lds + RT_OFF)};
            pg8::gemm_phase<pg8::EpiG1, pg8::SchedG1>(F.lds + RING_OFF, S, E);
            if (bid < NB * NH) { __syncthreads(); p1_scan(F, bid, l); }
        } else if (p == 2) {
            for (int part = 0; part < 2; ++part) {
              asm volatile("" : "+v"(F.tid)); F.lane = F.tid & 63; asm volatile("" : "+s"(bid));
              if ((part == 0) == (((F.vcu >> 5) & 1) == 0)) {
            if (!dummy || (PROBE_SUB & 1)) p2_conv(F, l, bid, dummy ? (bf16_t*)(ws + WS_DUMMY) : (bf16_t*)(ws + WS_B0), dummy);
            if (!dummy || (PROBE_SUB & 2)) { bf16_t* ob = dummy ? (bf16_t*)(ws + WS_DUMMY) : (bf16_t*)(ws + WS_B0); p2_gmlp(F, l, bid, ob); }
              } else {
            if (!dummy || (PROBE_SUB & 4)) { const int bh = F.vcu >> 3, sq = F.vcu & 7; const attn_body::bf16* b1 = (const attn_body::bf16*)(ws + WS_B1); const attn_body::bf16* b2 = (const attn_body::bf16*)(ws + WS_B2);
              const float* c2g = (const float*)(ws + WS_CS) + (size_t)bh * SEQ; const int* tsg = (const int*)(ws + WS_TS) + bh * 16;
              float gqm = fabsf(F.P.qn_g[l * HD + F.lane]), gkm = fabsf(F.P.kn_g[l * HD + F.lane]);
#pragma unroll
              for (int o_ = 1; o_ < 64; o_ <<= 1) { gqm = fmaxf(gqm, __shfl_xor(gqm, o_)); gkm = fmaxf(gkm, __shfl_xor(gkm, o_)); }
              const float ub = 64.f * C2 * gqm * gkm * 1.01f;
              for (int i = 0; i < 2; ++i) { const int qb = i == 0 ? 15 - sq : sq; const int ts = __builtin_amdgcn_readfirstlane(tsg[qb]); attn_body::attn_unit<8>(bh / NH, bh % NH, qb, b1, b1 + 512, b2, b2 + 512, dummy ? (attn_body::bf16*)(ws + WS_DUMMY) : (attn_body::bf16*)(ws + WS_B1), c2g, ts, ub, (char*)lds + RING_OFF); } }
              }
            }
        } else if (p == 3) {
            pg8::TileOrder T; T.init(M, D, F.G, bid); int pm_ = 0, pn_ = 0; const bool ok_ = T.tile(0, pm_, pn_);
            unsigned char* ga = ws + (size_t)bid * 131072;
            unsigned char* gb = (unsigned char*)F.P.out + 16 * MiB + (size_t)bid * 131072 - WS_B4;
            { pg8::SchedGate S; S.pm = pm_; S.pn = pn_; S.ok = ok_; S.h8 = (const char*)F.P.out; S.wl = (const char*)wl;
              S.sbtop = (unsigned*)(ctl) + SB_TOP; S.want = MISC[9] * (unsigned)(l + 1); S.tmo = (unsigned*)(ctl) + CW_TMO;
              pg8::EpiMergeT<true> E{ga, gb, (bf16_t*)(ws + WS_MG), F.P.b_gate + (size_t)l * 3072, (const LAS float*)(F.lds + RT_OFF)};
              pg8::gemm_phase<pg8::EpiMergeT<true>, pg8::SchedGate, true, 1024>(F.lds + RING_OFF, S, E); }
            { asm volatile("" : "+v"(F.tid)); F.lane = F.tid & 63; asm volatile("" : "+s"(bid));
              pg8::SchedY S; S.pm = pm_; S.pn = pn_; S.ok = ok_; S.ws = (const char*)ws; S.wl = (const char*)wl;
              pg8::EpiMergeT<false> E{ga, gb, (bf16_t*)(ws + WS_MG), F.P.b_gate + (size_t)l * 3072, (const LAS float*)(F.lds + RT_OFF)};
              pg8::gemm_phase<pg8::EpiMergeT<false>, pg8::SchedY, false, pg8::PITCH * 2, true>(F.lds + RING_OFF, S, E); }
        } else {
            pg8::SchedG1 S; S.T.init(M, D, F.G, bid); S.A = (const char*)(ws + WS_MG); S.B = (const char*)(wl + WO_WO);
            if (l + 1 < NL) {
                pg8::EpiOutLN E{(const bf16_t*)(ws + WS_H), (bf16_t*)(ws + WS_H), F.P.norm_g + (size_t)(l + 1) * D, F.P.w_in + (size_t)(l + 1) * D * NIN + OC_F, (float*)(ws + WS_SSP), (float*)(ws + WS_FP), (unsigned char*)F.P.out};
                pg8::gemm_phase<pg8::EpiOutLN, pg8::SchedG1>(F.lds + RING_OFF, S, E);
            } else {
                pg8::EpiOutB E{(const bf16_t*)(ws + WS_H), dummy ? (float*)(ws + WS_B0) : F.P.out};
                pg8::gemm_phase<pg8::EpiOutB, pg8::SchedG1>(F.lds + RING_OFF, S, E);
            }
        }
#if PROBE_TS >= 0
        if (!PROBE_TSW && blockIdx.x == 0 && threadIdx.x == 0 && ph == PROBE_TS) ((unsigned long long*)(args.ws + WS_TS + 4096))[1] = __builtin_amdgcn_s_memrealtime();
#endif
        if (dummy) { dup_done = true; continue; }
        dup_done = false; ++ph;
        if (ph < args.ph_hi) { if (p == 2 && !PROBE_ANY) sb_arrive(bar, (unsigned*)ctl, (unsigned)(l + 1)); else xcd_barrier(bar); }
    }
#if PROBE_TS >= 0
    if (PROBE_TS == 99 && blockIdx.x == 0 && threadIdx.x == 0) ((unsigned long long*)(args.ws + WS_TS + 4096))[1] = __builtin_amdgcn_s_memrealtime();
    if (blockIdx.x == 0 && threadIdx.x == 0) { asm volatile("s_waitcnt vmcnt(0)" ::: "memory"); const unsigned long long* tsp = (const unsigned long long*)(args.ws + WS_TS + 4096); const float us = (float)(tsp[1] - tsp[0]) * 0.01f; args.out[0] += floorf(us * (1.f / PROBE_TSQ)) * (float)PROBE_TSQ * 1000.f; }
#endif
}

#ifndef MK_MODE
#define MK_MODE 2
#endif
extern "C" void kernel_launch(void* const* d_in, const int* in_sizes, int n_in, void* d_out, int out_size, void* d_ws, size_t ws_size, hipStream_t stream) {
    static int ok = 0;
    if (ok == 0) {
        if (n_in != 18 || in_sizes[0] != M * D || out_size != M * D || ws_size < WS_END) { fprintf(stderr, "kernel_launch: unexpected shapes (n_in %d in0 %d out %d ws %zu)\n", n_in, n_in > 0 ? in_sizes[0] : -1, out_size, ws_size); ok = -1; return; }
        const int tl = 64 * TLD * 4;
        (void)hipFuncSetAttribute((const void*)nv_gemm1, hipFuncAttributeMaxDynamicSharedMemorySize, tl);
        (void)hipFuncSetAttribute((const void*)nv_merge, hipFuncAttributeMaxDynamicSharedMemorySize, 2 * 64 * 256 * 4);
        (void)hipFuncSetAttribute((const void*)nv_gmlp, hipFuncAttributeMaxDynamicSharedMemorySize, 128 * 129 * 4);
        (void)hipFuncSetAttribute((const void*)nv_attn, hipFuncAttributeMaxDynamicSharedMemorySize, 4 * SEQ * 4);
        if (hipFuncSetAttribute((const void*)mk_fwd, hipFuncAttributeMaxDynamicSharedMemorySize, LDS_BYTES) != hipSuccess) { fprintf(stderr, "kernel_launch: hipFuncSetAttribute(mk_fwd) failed\n"); ok = -1; return; }
        int dev = 0, cus = 0; (void)hipGetDevice(&dev); (void)hipDeviceGetAttribute(&cus, hipDeviceAttributeMultiprocessorCount, dev);
        if (cus != 256) fprintf(stderr, "kernel_launch: note: %d CUs (built for 256)\n", cus);
        (void)hipGetLastError();
        ok = 1;
    }
    if (ok < 0) return;
    Ptrs P{};
    const float** pp = (const float**)&P;
    for (int i = 0; i < 18; ++i) pp[i] = (const float*)d_in[i];
    P.out = (float*)d_out; P.ws = (unsigned char*)d_ws;
    const int tl = 64 * TLD * 4;
#if MK_MODE == 0
    nv_prep<<<2048, 256, 0, stream>>>(P);
    for (int l = 0; l < NL; ++l) {
        const float* xin = l == 0 ? P.x : P.out;
        nv_ln<<<M / 4, 256, 0, stream>>>(P, l, xin);
        nv_scan<<<NB * NH, 256, 0, stream>>>(P);
        nv_gemm1<<<dim3(20, 256), 256, tl, stream>>>(P, l);
        nv_conv<<<M, 512, 0, stream>>>(P, l);
        nv_gmlp<<<dim3(128, 4), 256, 128 * 129 * 4, stream>>>(P, l);
        nv_attn<<<M * NH / 4, 256, 4 * SEQ * 4, stream>>>(P);
        nv_merge<<<dim3(4, 256), 256, 2 * 64 * 256 * 4, stream>>>(P, l);
        nv_out<<<dim3(4, 256), 256, 0, stream>>>(P, l, xin, P.out);
    }
#else
    (void)tl;
    if (hipMemsetAsync((char*)d_ws + WS_CTL, 0, CTL_ZERO_BYTES, stream) != hipSuccess) { fprintf(stderr, "kernel_launch: memset failed\n"); return; }
    Args a{};
    for (int i = 0; i < 18; ++i) a.in[i] = (const float*)d_in[i];
    a.out = (float*)d_out; a.ws = (unsigned char*)d_ws;
    auto mk = [&](int lo, int hi, int li) { a.ph_lo = lo; a.ph_hi = hi; a.li = li; hipLaunchKernelGGL(mk_fwd, dim3(256), dim3(NWAVES * 64), LDS_BYTES, stream, a);
        const hipError_t le = hipPeekAtLastError(); if (le != hipSuccess) fprintf(stderr, "kernel_launch: mk launch [%d,%d) failed: %s\n", lo, hi, hipGetErrorName(le)); };
#if MK_MODE == 1
    auto mixers = [&](int l) { nv_conv<<<M, 512, 0, stream>>>(P, l); nv_gmlp<<<dim3(128, 4), 256, 128 * 129 * 4, stream>>>(P, l); nv_attn<<<M * NH / 4, 256, 4 * SEQ * 4, stream>>>(P); };
    mk(0, 2, 0); mixers(0); mk(3, 7, 1); mixers(1); mk(8, 10, 2);
#else
    mk(0, NPH, 0);
#endif
#endif
}
```

```cpp
#include <hip/hip_runtime.h>
#include <cstdio>
#include <cstdint>
#include <cmath>

constexpr int NL = 2, NB = 4, SEQ = 4096, M = NB * SEQ, D = 1024;
constexpr int DA = 512, DB = 512, NH = 8, HD = 64, DC = 512, CW = 31, CHK = 128, NG = 4, GD = 128, NIN = 8200;
constexpr float EPS = 1e-6f;
constexpr float LOG2E = 1.4426950408889634f;
constexpr float C2 = 0.125f * LOG2E;
constexpr int N1 = 5120;
constexpr int OC_GATE = 0, OC_AIN = 3072, OC_AZ = 4096, OC_U = 4608, OC_V = 5120, OC_BZ = 5632, OC_Q = 6144, OC_K = 6656, OC_VA = 7168, OC_CZ = 7680, OC_F = 8192;

constexpr size_t MiB = 1u << 20;
constexpr size_t WS_CTL = 0, CTL_ZERO_BYTES = 64 * 1024;
constexpr size_t WS_VSS = 1 * MiB;
constexpr size_t WS_LOGF = WS_VSS + 512 * 1024;
constexpr size_t WS_CS = 2 * MiB;
constexpr size_t WS_WSB = WS_CS + 512 * 1024;
constexpr size_t WS_TS = 3 * MiB;
constexpr size_t WS_W = 4 * MiB, W_LAYER = 22 * MiB;
constexpr size_t WO_W1 = 0, WO_WG = 10 * MiB, WO_WAB = 16 * MiB, WO_WC = 18 * MiB, WO_WO = 20 * MiB;
constexpr size_t WS_H = 48 * MiB;
constexpr size_t WS_B0 = 80 * MiB;
constexpr size_t WS_B1 = 112 * MiB;
constexpr size_t WS_B2 = 144 * MiB;
constexpr size_t WS_B3 = 176 * MiB;
constexpr size_t WS_B4 = 208 * MiB;
constexpr size_t WS_GT = WS_B2, WS_MG = WS_B3;
constexpr size_t WS_FP = 240 * MiB;
constexpr size_t WS_SSP = 242 * MiB;
constexpr size_t WS_DUMMY = 224 * MiB;
constexpr size_t WS_END = 256 * MiB;
#ifndef PROBE_TSW
#define PROBE_TSW 0
#endif
#ifndef PROBE_TSQ
#define PROBE_TSQ 8
#endif
#ifndef PROBE_TS
#define PROBE_TS -1
#endif
#define PROBE_ANY (PROBE_DUP >= 0)
#ifndef PROBE_P3
#define PROBE_P3 0
#endif
#ifndef PROBE_CONV
#define PROBE_CONV 0
#endif
#ifndef PROBE_SUB
#define PROBE_SUB 7
#endif
#ifndef PROBE_DUP
#define PROBE_DUP -1
#endif

typedef unsigned short bf16_t;
typedef short bf16x8 __attribute__((ext_vector_type(8)));
typedef float f32x4 __attribute__((ext_vector_type(4)));
typedef unsigned u32x4 __attribute__((ext_vector_type(4)));
typedef unsigned u32x2 __attribute__((ext_vector_type(2)));
typedef int i32x4 __attribute__((ext_vector_type(4)));
typedef int i32x8 __attribute__((ext_vector_type(8)));
#define F8_WSCALE 64.f
__device__ __forceinline__ unsigned pk4f8(float a, float b, float c, float d) { int w = __builtin_amdgcn_cvt_pk_fp8_f32(a, b, 0, false); w = __builtin_amdgcn_cvt_pk_fp8_f32(c, d, w, true); return (unsigned)w; }

__host__ __device__ __forceinline__ float bf2f(bf16_t v) { union { unsigned u; float f; } c; c.u = (unsigned)v << 16; return c.f; }
__host__ __device__ __forceinline__ bf16_t f2bf(float f) { union { unsigned u; float f; } c; c.f = f; unsigned u = c.u; return (bf16_t)((u + 0x7fffu + ((u >> 16) & 1u)) >> 16); }
__device__ __forceinline__ float bfr(float f) { return bf2f(f2bf(f)); }
__device__ __forceinline__ float sigm(float x) { return 1.f / (1.f + __expf(-x)); }
__device__ __forceinline__ float siluf(float x) { return x * sigm(x); }

__host__ __device__ __forceinline__ int g1_col(int n) {
    const int j = n >> 8, lc = n & 255;
    if (j < 4) return lc < 128 ? OC_AIN + 128 * j + lc : OC_AIN + 512 + 128 * j + (lc - 128);
    if (j < 6) return OC_AZ + 256 * (j - 4) + lc;
    if (j < 8 || (j >= 10 && j < 12)) { const int k = j < 8 ? j - 6 : j - 8; return lc < 128 ? OC_U + 128 * k + lc : OC_BZ + 128 * k + (lc - 128); }
    if (j < 10) return OC_V + 256 * (j - 8) + lc;
    if (j < 16) { const int isk = j >= 14, jj = (j - 12) & 1, head = 4 * jj + ((lc >> 5) & 3), d = 32 * (lc >> 7) + (lc & 31); return (isk ? OC_K : OC_Q) + 64 * head + d; }
    if (j < 18) return OC_VA + 256 * (j - 16) + lc;
    return OC_CZ + 256 * (j - 18) + lc;
}

struct Ptrs {
    const float *x, *norm_g, *w_in, *b_gate, *conv_w, *conv_b, *cn_g, *cn_b, *w_a, *gn_g, *w_s, *b_s, *w_b, *qn_g, *kn_g, *b_f, *w_c, *w_out;
    float* out; unsigned char* ws;
};

__global__ void nv_prep(Ptrs P) {
    const size_t gid = (size_t)blockIdx.x * blockDim.x + threadIdx.x, gsz = (size_t)gridDim.x * blockDim.x;
    for (int l = 0; l < NL; ++l) {
        unsigned char* wl = P.ws + WS_W + (size_t)l * W_LAYER;
        bf16_t* W1 = (bf16_t*)(wl + WO_W1); bf16_t* WG = (bf16_t*)(wl + WO_WG); bf16_t* WAB = (bf16_t*)(wl + WO_WAB); bf16_t* WC = (bf16_t*)(wl + WO_WC); bf16_t* WO = (bf16_t*)(wl + WO_WO);
        const float* win = P.w_in + (size_t)l * D * NIN;
        for (size_t i = gid; i < (size_t)N1 * D; i += gsz) { const int n = (int)(i >> 10), k = (int)(i & 1023); W1[i] = f2bf(win[(size_t)k * NIN + g1_col(n)]); }
        for (size_t i = gid; i < (size_t)3072 * D; i += gsz) { const int n = (int)(i >> 10), k = (int)(i & 1023); WG[i] = f2bf(win[(size_t)k * NIN + n]); }
        for (size_t i = gid; i < (size_t)1024 * 1024; i += gsz) { const int n = (int)(i >> 10), k = (int)(i & 1023);
            WAB[i] = f2bf(k < 512 ? P.w_a[((size_t)l * DA + k) * D + n] : P.w_b[((size_t)l * DB + (k - 512)) * D + n]);
            WC[i] = k < 512 ? f2bf(P.w_c[((size_t)l * DC + k) * D + n]) : (bf16_t)0;
            WO[i] = f2bf(P.w_out[((size_t)l * D + k) * D + n]); }
        bf16_t* WSB = (bf16_t*)(P.ws + WS_WSB) + (size_t)l * NG * CHK * CHK;
        for (size_t i = gid; i < (size_t)NG * CHK * CHK; i += gsz) { const int s = (int)(i & 127), t = (int)((i >> 7) & 127); WSB[i] = s <= t ? f2bf(P.w_s[(size_t)l * NG * CHK * CHK + i]) : (bf16_t)0; }
    }
}

__device__ __forceinline__ float wave_sum(float v) {
#pragma unroll
    for (int o = 1; o < 64; o <<= 1) v += __shfl_xor(v, o);
    return v;
}

__global__ void nv_ln(Ptrs P, int l, const float* xin) {
    const int lane = threadIdx.x & 63, row = blockIdx.x * 4 + (threadIdx.x >> 6);
    const float* xr = xin + (size_t)row * D; const float* g = P.norm_g + (size_t)l * D; const float* win = P.w_in + (size_t)l * D * NIN;
    float v[16]; float ss = 0.f;
#pragma unroll
    for (int j = 0; j < 16; ++j) { v[j] = xr[lane + 64 * j]; ss += v[j] * v[j]; }
    ss = wave_sum(ss);
    const float r = rsqrtf(ss * (1.f / D) + EPS);
    bf16_t* h = (bf16_t*)(P.ws + WS_H) + (size_t)row * D;
    float f[8] = {0, 0, 0, 0, 0, 0, 0, 0};
#pragma unroll
    for (int j = 0; j < 16; ++j) { const int k = lane + 64 * j; const float hv = v[j] * r * g[k]; h[k] = f2bf(hv);
#pragma unroll
        for (int e = 0; e < 8; ++e) f[e] += hv * win[(size_t)k * NIN + OC_F + e]; }
#pragma unroll
    for (int e = 0; e < 8; ++e) f[e] = wave_sum(f[e]);
    if (lane < 8) { float z = 0.f;
#pragma unroll
        for (int e = 0; e < 8; ++e) if (lane == e) z = f[e];
        z += P.b_f[l * NH + lane];
        const float lf = fminf(z, 0.f) - log1pf(expf(-fabsf(z)));
        ((float*)(P.ws + WS_LOGF))[(size_t)row * 8 + lane] = lf; }
}

__global__ void nv_scan(Ptrs P) {
    __shared__ float buf[SEQ];
    const int bh = blockIdx.x, b = bh / NH, h = bh % NH;
    const float* lf = (const float*)(P.ws + WS_LOGF);
    for (int t = threadIdx.x; t < SEQ; t += blockDim.x) buf[t] = lf[((size_t)b * SEQ + t) * 8 + h];
    __syncthreads();
    if (threadIdx.x == 0) { float c = 0.f; for (int t = 0; t < SEQ; ++t) { c += buf[t]; buf[t] = c * LOG2E; } }
    __syncthreads();
    float* cs = (float*)(P.ws + WS_CS) + (size_t)bh * SEQ;
    for (int t = threadIdx.x; t < SEQ; t += blockDim.x) cs[t] = buf[t];
}

constexpr int TLD = 257;
__device__ __forceinline__ void nv_gemm_acc(const bf16_t* A, int lda, const bf16_t* Bt, int ldb, int K, f32x4 (&acc)[4][4]) {
    const int tid = threadIdx.x, w = tid >> 6, l = tid & 63, fr = l & 15, fq = l >> 4;
#pragma unroll
    for (int m = 0; m < 4; ++m)
#pragma unroll
        for (int n = 0; n < 4; ++n) acc[m][n] = (f32x4){0.f, 0.f, 0.f, 0.f};
    for (int k0 = 0; k0 < K; k0 += 32) {
        bf16x8 a[4], b[4];
#pragma unroll
        for (int m = 0; m < 4; ++m) a[m] = *(const bf16x8*)(A + (size_t)(16 * m + fr) * lda + k0 + 8 * fq);
#pragma unroll
        for (int n = 0; n < 4; ++n) b[n] = *(const bf16x8*)(Bt + (size_t)(64 * w + 16 * n + fr) * ldb + k0 + 8 * fq);
#pragma unroll
        for (int m = 0; m < 4; ++m)
#pragma unroll
            for (int n = 0; n < 4; ++n) acc[m][n] = __builtin_amdgcn_mfma_f32_16x16x32_bf16(a[m], b[n], acc[m][n], 0, 0, 0);
    }
}
__device__ __forceinline__ void nv_gemm_tile(const bf16_t* A, int lda, const bf16_t* Bt, int ldb, int K, float* T) {
    const int tid = threadIdx.x, w = tid >> 6, l = tid & 63, fr = l & 15, fq = l >> 4;
    f32x4 acc[4][4];
    nv_gemm_acc(A, lda, Bt, ldb, K, acc);
#pragma unroll
    for (int m = 0; m < 4; ++m)
#pragma unroll
        for (int n = 0; n < 4; ++n)
#pragma unroll
            for (int r = 0; r < 4; ++r) T[(16 * m + 4 * fq + r) * TLD + 64 * w + 16 * n + fr] = acc[m][n][r];
}

__global__ void __launch_bounds__(256) nv_gemm1(Ptrs P, int l) {
    extern __shared__ float T[];
    __shared__ float R[64 * 4];
    const int j = blockIdx.x, row0 = blockIdx.y * 64, tid = threadIdx.x;
    const bf16_t* H = (const bf16_t*)(P.ws + WS_H);
    const bf16_t* W1 = (const bf16_t*)(P.ws + WS_W + (size_t)l * W_LAYER + WO_W1);
    nv_gemm_tile(H + (size_t)row0 * D, D, W1 + (size_t)j * 256 * D, D, D, T);
    __syncthreads();
    bf16_t* B0 = (bf16_t*)(P.ws + WS_B0); bf16_t* B1 = (bf16_t*)(P.ws + WS_B1); bf16_t* B2 = (bf16_t*)(P.ws + WS_B2); bf16_t* B3 = (bf16_t*)(P.ws + WS_B3); bf16_t* B4 = (bf16_t*)(P.ws + WS_B4);
    if (j < 4) {
        for (int e = tid; e < 64 * 128; e += 256) { const int r = e >> 7, c = e & 127; B3[(size_t)(row0 + r) * 1024 + 128 * j + c] = f2bf(T[r * TLD + c] * sigm(T[r * TLD + c + 128])); }
    } else if (j < 12 || j >= 16) {
        bf16_t* dst; int pitch, coff; bool act;
        if (j < 6) { dst = B0; pitch = 1024; coff = 256 * (j - 4); act = true; }
        else if (j < 8) { dst = B0; pitch = 1024; coff = 512 + 256 * (j - 6); act = false; }
        else if (j < 10) { dst = B3; pitch = 1024; coff = 512 + 256 * (j - 8); act = false; }
        else if (j < 12) { dst = B4; pitch = 512; coff = 256 * (j - 10); act = true; }
        else if (j < 18) { dst = B2; pitch = 1024; coff = 256 * (j - 16); act = false; }
        else { dst = B2; pitch = 1024; coff = 512 + 256 * (j - 18); act = true; }
        for (int e = tid; e < 64 * 256; e += 256) { const int r = e >> 8, c = e & 255; const float v = T[r * TLD + c]; dst[(size_t)(row0 + r) * pitch + coff + c] = f2bf(act ? siluf(v) : v); }
        if (j == 8 || j == 9) { const int r = tid >> 2, wc = tid & 3; float s = 0.f;
            for (int bj = 0; bj < 2; ++bj) for (int i = 0; i < 32; ++i) { const float v = T[r * TLD + 128 * bj + 32 * wc + i]; s += v * v; }
            ((float*)(P.ws + WS_VSS))[(size_t)(row0 + r) * 8 + (j - 8) * 4 + wc] = s; }
    } else {
        const bool isk = j >= 14; const int jj = (j - 12) & 1;
        { const int r = tid >> 2, hh = tid & 3; float s = 0.f;
          for (int d = 0; d < 64; ++d) { const float v = T[r * TLD + 128 * (d >> 5) + 32 * hh + (d & 31)]; s += v * v; }
          R[r * 4 + hh] = rsqrtf(s * (1.f / 64.f) + EPS); }
        __syncthreads();
        const float* gq = (isk ? P.kn_g : P.qn_g) + (size_t)l * HD;
        for (int e = tid; e < 64 * 256; e += 256) { const int r = e >> 8, c = e & 255, hh = (c >> 5) & 3, d = 32 * (c >> 7) + (c & 31);
            float v = T[r * TLD + c] * R[r * 4 + hh] * gq[d]; if (!isk) v *= C2;
            B1[(size_t)(row0 + r) * 1024 + (isk ? 512 : 0) + 64 * (4 * jj + hh) + d] = f2bf(v); }
    }
}

__global__ void __launch_bounds__(512) nv_conv(Ptrs P, int l) {
    __shared__ float red[16];
    const int row = blockIdx.x, t = row % SEQ, c = threadIdx.x, lane = c & 63, w = c >> 6;
    const bf16_t* AG = (const bf16_t*)(P.ws + WS_B3); bf16_t* B0 = (bf16_t*)(P.ws + WS_B0);
    const float* cw = P.conv_w + (size_t)l * CW * DA;
    float a = P.conv_b[l * DA + c];
    for (int j = 0; j < CW; ++j) { const int tt = t - (CW - 1) + j; if (tt >= 0) a += cw[j * DA + c] * bf2f(AG[(size_t)(row - (CW - 1) + j) * 1024 + c]); }
    float s = wave_sum(a); if (lane == 0) red[w] = s; __syncthreads();
    float mu = 0.f; for (int i = 0; i < 8; ++i) mu += red[i]; mu *= (1.f / DA);
    const float d = a - mu; s = wave_sum(d * d); if (lane == 0) red[8 + w] = s; __syncthreads();
    float var = 0.f; for (int i = 0; i < 8; ++i) var += red[8 + i]; var *= (1.f / DA);
    const float y = d * rsqrtf(var + EPS) * P.cn_g[l * DA + c] + P.cn_b[l * DA + c];
    const float az = bf2f(B0[(size_t)row * 1024 + c]);
    B0[(size_t)row * 1024 + c] = f2bf(siluf(y) * az);
}

__global__ void __launch_bounds__(256) nv_gmlp(Ptrs P, int l) {
    extern __shared__ float vn[];
    const int ch = blockIdx.x, g = blockIdx.y, tid = threadIdx.x; const size_t row0 = (size_t)ch * CHK;
    const bf16_t* V = (const bf16_t*)(P.ws + WS_B3); bf16_t* B0 = (bf16_t*)(P.ws + WS_B0); const bf16_t* BZ = (const bf16_t*)(P.ws + WS_B4);
    const float* vss = (const float*)(P.ws + WS_VSS);
    const bf16_t* WSB = (const bf16_t*)(P.ws + WS_WSB) + ((size_t)l * NG + g) * CHK * CHK;
    for (int e = tid; e < 128 * 128; e += 256) { const int s = e >> 7, c = e & 127; const float* q = vss + (row0 + s) * 8;
        const float ss = ((q[0] + q[1]) + (q[2] + q[3])) + ((q[4] + q[5]) + (q[6] + q[7])); const float rv = rsqrtf(ss * (1.f / DB) + EPS);
        vn[s * 129 + c] = bfr(bf2f(V[(row0 + s) * 1024 + 512 + 128 * g + c]) * rv * P.gn_g[l * DB + 128 * g + c]); }
    __syncthreads();
    for (int e = tid; e < 128 * 128; e += 256) { const int t = e >> 7, c = e & 127; float acc = 0.f;
        for (int s = 0; s <= t; ++s) acc += bf2f(WSB[t * 128 + s]) * vn[s * 129 + c];
        acc += P.b_s[((size_t)l * NG + g) * CHK + t];
        const size_t o = (row0 + t) * 1024 + 512 + 128 * g + c;
        B0[o] = f2bf(bf2f(B0[o]) * acc * bf2f(BZ[(row0 + t) * 512 + 128 * g + c])); }
}

__global__ void __launch_bounds__(256) nv_attn(Ptrs P) {
    extern __shared__ float sc[];
    const int lane = threadIdx.x & 63, w = threadIdx.x >> 6; const int item = blockIdx.x * 4 + w, row = item >> 3, h = item & 7, b = row / SEQ, t = row % SEQ;
    float* s = sc + w * SEQ;
    bf16_t* B1 = (bf16_t*)(P.ws + WS_B1); const bf16_t* B2 = (const bf16_t*)(P.ws + WS_B2);
    const float* cs = (const float*)(P.ws + WS_CS) + (size_t)(b * NH + h) * SEQ;
    float q[64];
#pragma unroll
    for (int d = 0; d < 64; ++d) q[d] = bf2f(B1[(size_t)row * 1024 + 64 * h + d]);
    const float cq = cs[t]; float mx = -INFINITY;
    for (int k = lane; k <= t; k += 64) { const bf16_t* kr = B1 + ((size_t)b * SEQ + k) * 1024 + 512 + 64 * h; float dot = 0.f;
#pragma unroll
        for (int d8 = 0; d8 < 8; ++d8) { const bf16x8 kv = *(const bf16x8*)(kr + 8 * d8);
#pragma unroll
            for (int e = 0; e < 8; ++e) dot += q[8 * d8 + e] * bf2f((bf16_t)kv[e]); }
        const float v = dot + (cq - cs[k]); s[k] = v; mx = fmaxf(mx, v); }
#pragma unroll
    for (int o = 1; o < 64; o <<= 1) mx = fmaxf(mx, __shfl_xor(mx, o));
    float lsum = 0.f;
    for (int k = lane; k <= t; k += 64) { const float p = exp2f(s[k] - mx); lsum += p; s[k] = bfr(p); }
    lsum = wave_sum(lsum);
    __builtin_amdgcn_s_waitcnt(0); __builtin_amdgcn_wave_barrier();
    float o = 0.f; const bf16_t* vb = B2 + (size_t)b * SEQ * 1024 + 64 * h + lane;
    for (int k = 0; k <= t; ++k) o += s[k] * bf2f(vb[(size_t)k * 1024]);
    const float cz = bf2f(B2[(size_t)row * 1024 + 512 + 64 * h + lane]);
    B1[(size_t)row * 1024 + 64 * h + lane] = f2bf(o / lsum * cz);
}

__global__ void __launch_bounds__(256) nv_merge(Ptrs P, int l) {
    extern __shared__ float T[];
    const int pn = blockIdx.x, row0 = blockIdx.y * 64, tid = threadIdx.x, w = tid >> 6, ln = tid & 63, fr = ln & 15, fq = ln >> 4;
    const unsigned char* wl = P.ws + WS_W + (size_t)l * W_LAYER;
    const bf16_t* H = (const bf16_t*)(P.ws + WS_H); const bf16_t* WG = (const bf16_t*)(wl + WO_WG); const bf16_t* WAB = (const bf16_t*)(wl + WO_WAB); const bf16_t* WC = (const bf16_t*)(wl + WO_WC);
    const bf16_t* B0 = (const bf16_t*)(P.ws + WS_B0); const bf16_t* B1 = (const bf16_t*)(P.ws + WS_B1);
    float* G = T; float* MGs = T + 64 * 256;
    f32x4 acc[4][4];
    for (int br = 0; br < 3; ++br) {
        nv_gemm_acc(H + (size_t)row0 * D, D, WG + ((size_t)br * 1024 + 256 * pn) * D, D, D, acc);
#pragma unroll
        for (int m = 0; m < 4; ++m)
#pragma unroll
            for (int n = 0; n < 4; ++n)
#pragma unroll
                for (int r = 0; r < 4; ++r) { const int c = 64 * w + 16 * n + fr; G[((m * 4 + n) * 4 + r) * 256 + tid] = bfr(sigm(acc[m][n][r] + P.b_gate[(size_t)l * 3072 + br * 1024 + 256 * pn + c])); }
        const bf16_t* A = br == 0 ? B0 : (br == 1 ? B0 + 512 : B1); const bf16_t* Bt = br == 0 ? WAB : (br == 1 ? WAB + 512 : WC);
        nv_gemm_acc(A + (size_t)row0 * 1024, 1024, Bt + (size_t)256 * pn * 1024, 1024, 512, acc);
#pragma unroll
        for (int m = 0; m < 4; ++m)
#pragma unroll
            for (int n = 0; n < 4; ++n)
#pragma unroll
                for (int r = 0; r < 4; ++r) { const int s = ((m * 4 + n) * 4 + r) * 256 + tid; const float v = G[s] * acc[m][n][r]; MGs[s] = bfr(br == 0 ? v : MGs[s] + v); }
    }
    bf16_t* MG = (bf16_t*)(P.ws + WS_MG);
#pragma unroll
    for (int m = 0; m < 4; ++m)
#pragma unroll
        for (int n = 0; n < 4; ++n)
#pragma unroll
            for (int r = 0; r < 4; ++r) MG[(size_t)(row0 + 16 * m + 4 * fq + r) * 1024 + 256 * pn + 64 * w + 16 * n + fr] = f2bf(MGs[((m * 4 + n) * 4 + r) * 256 + tid]);
}

__global__ void __launch_bounds__(256) nv_out(Ptrs P, int l, const float* xin, float* xout) {
    const int pn = blockIdx.x, row0 = blockIdx.y * 64, tid = threadIdx.x, w = tid >> 6, ln = tid & 63, fr = ln & 15, fq = ln >> 4;
    const bf16_t* MG = (const bf16_t*)(P.ws + WS_MG); const bf16_t* WO = (const bf16_t*)(P.ws + WS_W + (size_t)l * W_LAYER + WO_WO);
    f32x4 acc[4][4];
    nv_gemm_acc(MG + (size_t)row0 * 1024, 1024, WO + (size_t)256 * pn * 1024, 1024, 1024, acc);
#pragma unroll
    for (int m = 0; m < 4; ++m)
#pragma unroll
        for (int n = 0; n < 4; ++n)
#pragma unroll
            for (int r = 0; r < 4; ++r) { const size_t o = (size_t)(row0 + 16 * m + 4 * fq + r) * D + 256 * pn + 64 * w + 16 * n + fr; xout[o] = xin[o] + acc[m][n][r]; }
}


#define LAS __attribute__((address_space(3)))
#define GAS __attribute__((address_space(1)))
__device__ __forceinline__ float wsum(float v) {
    v += __builtin_bit_cast(float, __builtin_amdgcn_update_dpp(0, __builtin_bit_cast(int, v), 0xB1, 0xF, 0xF, true));
    v += __builtin_bit_cast(float, __builtin_amdgcn_update_dpp(0, __builtin_bit_cast(int, v), 0x4E, 0xF, 0xF, true));
    v += __builtin_bit_cast(float, __builtin_amdgcn_update_dpp(0, __builtin_bit_cast(int, v), 0x141, 0xF, 0xF, true));
    v += __builtin_bit_cast(float, __builtin_amdgcn_update_dpp(0, __builtin_bit_cast(int, v), 0x140, 0xF, 0xF, true));
    const int iv = __builtin_bit_cast(int, v);
    return (__builtin_bit_cast(float, __builtin_amdgcn_readlane(iv, 0)) + __builtin_bit_cast(float, __builtin_amdgcn_readlane(iv, 16))) + (__builtin_bit_cast(float, __builtin_amdgcn_readlane(iv, 32)) + __builtin_bit_cast(float, __builtin_amdgcn_readlane(iv, 48)));
}
typedef GAS unsigned gu32;
#define RLX_AGENT __ATOMIC_RELAXED, __HIP_MEMORY_SCOPE_AGENT
#define LDS_WAIT() asm volatile("s_waitcnt lgkmcnt(0)" ::: "memory")
#define VM_WAIT() asm volatile("s_waitcnt vmcnt(0)" ::: "memory")
constexpr int NWAVES = 8;
constexpr int RING_OFF = 0, RING_BYTES = 131072;
constexpr int LDS_BYTES = 163840;
constexpr int LDSCTL_OFF = LDS_BYTES - 512, MISC_OFF = LDSCTL_OFF + 320;
constexpr int RT_OFF = LDSCTL_OFF - 1024;
constexpr int CW_TMO = 0, CW_CODE = 1, CW_BAR = 4096;
constexpr float SKIP_L2 = 160.f;
constexpr int NPH = 10;

__device__ __forceinline__ unsigned cvt_pk_bf16(float lo, float hi) { unsigned r; asm volatile("s_nop 0\n\tv_cvt_pk_bf16_f32 %0, %1, %2" : "=v"(r) : "v"(lo), "v"(hi)); return r; }
__device__ __forceinline__ float fsigm(float x) { return __builtin_amdgcn_rcpf(1.f + __builtin_amdgcn_exp2f(-LOG2E * x)); }
__device__ __forceinline__ float fsigm256(float x) { return __builtin_amdgcn_rcpf(0.00390625f + __builtin_amdgcn_exp2f(-LOG2E * x - 8.f)); }
__device__ __forceinline__ unsigned pk4u8(const f32x4& v) { unsigned w = __builtin_amdgcn_cvt_pk_u8_f32(v[0], 0, 0u); w = __builtin_amdgcn_cvt_pk_u8_f32(v[1], 1, w); w = __builtin_amdgcn_cvt_pk_u8_f32(v[2], 2, w); return __builtin_amdgcn_cvt_pk_u8_f32(v[3], 3, w); }
__device__ __forceinline__ f32x4 un4u8(unsigned w) { return (f32x4){(float)(w & 0xffu), (float)((w >> 8) & 0xffu), (float)((w >> 16) & 0xffu), (float)(w >> 24)}; }
__device__ __forceinline__ u32x4 pack8(const f32x4& a, const f32x4& b) { u32x4 w; w.x = cvt_pk_bf16(a[0], a[1]); w.y = cvt_pk_bf16(a[2], a[3]); w.z = cvt_pk_bf16(b[0], b[1]); w.w = cvt_pk_bf16(b[2], b[3]); return w; }
__device__ __forceinline__ void unpack8(const u32x4& w, f32x4& a, f32x4& b) {
    a[0] = __uint_as_float(w.x << 16); a[1] = __uint_as_float(w.x & 0xffff0000u); a[2] = __uint_as_float(w.y << 16); a[3] = __uint_as_float(w.y & 0xffff0000u);
    b[0] = __uint_as_float(w.z << 16); b[1] = __uint_as_float(w.z & 0xffff0000u); b[2] = __uint_as_float(w.w << 16); b[3] = __uint_as_float(w.w & 0xffff0000u); }

namespace pg8 {
constexpr int BM = 256, BK = 64, HALF = 128, HTB = HALF * BK * 2, STAGE_BYTES = 8 * HTB, NXCD = 8, WGM = 8, PITCH = 1024;
__host__ __device__ __forceinline__ int lds_byte(int r, int c) { const int st = (r >> 4) * 2 + (c >> 5), rr = r & 15, cc = c & 31, ob = rr * 64 + cc * 2; return st * 1024 + (ob ^ (((ob >> 9) & 1) << 5)); }
__host__ __device__ __forceinline__ void stage_rc(int b, int& R, int& C) { const int st = b / 1024, sb = b % 1024, swz = sb ^ (((sb >> 9) & 1) << 5); R = (st >> 1) * 16 + swz / 64; C = (st & 1) * 32 + (swz % 64) / 2; }
__host__ __device__ __forceinline__ int perm32(int rho) { const int n = rho >> 4, i = rho & 15; return 8 * (i >> 2) + 4 * n + (i & 3); }

struct Unit { const char* A; const char* B; int nt, pm, pn, tag; };

struct TileOrder {
    int nM, nN, nwg, G, c;
    __device__ __forceinline__ void init(int Mr, int N, int G_, int c_) { nM = Mr / BM; nN = N / BM; nwg = nM * nN; G = G_; c = c_; }
    __device__ __forceinline__ bool tile(int i, int& pm, int& pn) const {
        const long L = (long)i * G + c; if (L >= nwg) return false;
        int wgid = (int)L; { const int q = nwg / NXCD, r = nwg % NXCD, xcd = wgid % NXCD, off = wgid / NXCD; wgid = (xcd < r ? xcd * (q + 1) : r * (q + 1) + (xcd - r) * q) + off; }
        const int nig = WGM * nN, gid = wgid / nig, fm = gid * WGM, gsz = (nM - fm) < WGM ? (nM - fm) : WGM;
        pm = fm + ((wgid % nig) % gsz); pn = (wgid % nig) / gsz; return true;
    }
};

struct NoHook { __device__ __forceinline__ void operator()() const {} };
template <class Epi, class Sched, bool F8 = false, int RP = PITCH * 2, bool KEEP = false, class Hook = NoHook>
__device__ __forceinline__ void gemm_phase(LAS unsigned char* lds, const Sched& S, const Epi& E, const Hook& hook = Hook()) {
    int tid = threadIdx.x; asm volatile("" : "+v"(tid));
    const int wid = __builtin_amdgcn_readfirstlane(tid >> 6), lane = tid & 63, wr = wid >> 2, wc = wid & 3, fr = lane & 15, fq = lane >> 4;
    unsigned voffA[2], voffB[2];
#pragma unroll
    for (int i = 0; i < 2; ++i) { int R, C; stage_rc(tid * 16 + i * 8192, R, C); const int Rb = (R & ~31) + perm32(R & 31);
        voffA[i] = (unsigned)(R * RP + C * 2); voffB[i] = (unsigned)(Rb * RP + C * 2); }
    const size_t kstep = (size_t)(BK * 2);
    const size_t hstep = (size_t)HALF * RP;
    const unsigned ldsw = (unsigned)wid * 1024u;
    const int aoff = lds_byte(wr * 64 + fr, fq * 8), boff = lds_byte(wc * 32 + fr, fq * 8);
#define PG8_SA(b, h) (((b) * 2 + (h)) * HTB)
#define PG8_SB(b, h) ((4 + (b) * 2 + (h)) * HTB)
#define PG8_STAGE(bufoff, gbase, voff) do { _Pragma("unroll") for (int _i = 0; _i < 2; ++_i) \
        __builtin_amdgcn_global_load_lds((const unsigned*)((const char*)(gbase) + (voff)[_i]), (LAS unsigned*)(lds + (bufoff) + ldsw + _i * 8192), 16, 0, 0); } while (0)
#define PG8_LDA(dst, b, h) do { _Pragma("unroll") for (int m = 0; m < 4; ++m) dst[m] = __builtin_shufflevector(*(const LAS i32x4*)(lds + PG8_SA(b, h) + aoff + m * 2048), *(const LAS i32x4*)(lds + PG8_SA(b, h) + aoff + m * 2048 + 1024), 0, 1, 2, 3, 4, 5, 6, 7); } while (0)
#define PG8_LDB(dst, b, h) do { _Pragma("unroll") for (int n = 0; n < 2; ++n) dst[n] = __builtin_shufflevector(*(const LAS i32x4*)(lds + PG8_SB(b, h) + boff + n * 2048), *(const LAS i32x4*)(lds + PG8_SB(b, h) + boff + n * 2048 + 1024), 0, 1, 2, 3, 4, 5, 6, 7); } while (0)
#define PG8_H0(v) __builtin_bit_cast(bf16x8, __builtin_shufflevector(v, v, 0, 1, 2, 3))
#define PG8_H1(v) __builtin_bit_cast(bf16x8, __builtin_shufflevector(v, v, 4, 5, 6, 7))
#define PG8_MMA(ai, bj, At, Bt) do { __builtin_amdgcn_s_setprio(1); _Pragma("unroll") for (int m = 0; m < 4; ++m) _Pragma("unroll") for (int n = 0; n < 2; ++n) { \
        if (F8) asm volatile("v_mfma_f32_16x16x128_f8f6f4 %0, %1, %2, %0" : "+v"(acc[ai][bj][m][n]) : "v"(Bt[n]), "v"(At[m])); \
        else { acc[ai][bj][m][n] = __builtin_amdgcn_mfma_f32_16x16x32_bf16(PG8_H0(Bt[n]), PG8_H0(At[m]), acc[ai][bj][m][n], 0, 0, 0); \
               acc[ai][bj][m][n] = __builtin_amdgcn_mfma_f32_16x16x32_bf16(PG8_H1(Bt[n]), PG8_H1(At[m]), acc[ai][bj][m][n], 0, 0, 0); } } __builtin_amdgcn_s_setprio(0); } while (0)
#define PG8_WAIT_V(n) asm volatile("s_waitcnt vmcnt(" #n ")" ::: "memory")
#define PG8_WAIT_L(n) asm volatile("s_waitcnt lgkmcnt(" #n ")" ::: "memory")
#define PG8_BAR __builtin_amdgcn_s_barrier()
#define PG8_SCHED __builtin_amdgcn_sched_barrier(0)
    Unit cur, nxt; int ui = 0;
    if (!S.next(0, cur)) return;
    f32x4 acc[2][2][4][2];
#pragma unroll
    for (int a = 0; a < 2; ++a)
#pragma unroll
        for (int b = 0; b < 2; ++b)
#pragma unroll
            for (int m = 0; m < 4; ++m)
#pragma unroll
                for (int n = 0; n < 2; ++n) acc[a][b][m][n] = (f32x4){0.f, 0.f, 0.f, 0.f};
    i32x8 At[4], B0[2], B1[2];
    const char* cA = cur.A; const char* cB = cur.B;
    S.a_ready(cur);
    PG8_STAGE(PG8_SB(0, 0), cB, voffB); PG8_STAGE(PG8_SB(0, 1), cB + hstep, voffB); PG8_STAGE(PG8_SA(0, 0), cA, voffA); PG8_STAGE(PG8_SA(0, 1), cA + hstep, voffA);
    hook();
    if (wr == 1) PG8_BAR;
    PG8_WAIT_V(2); PG8_BAR;
    PG8_STAGE(PG8_SB(1, 0), cB + kstep, voffB); PG8_STAGE(PG8_SA(1, 0), cA + kstep, voffA); PG8_STAGE(PG8_SB(1, 1), cB + hstep + kstep, voffB);
    PG8_WAIT_V(6); PG8_BAR;
    for (;;) {
        const bool has_next = S.next(ui + 1, nxt);
        const char* nA = has_next ? nxt.A : cA; const char* nB = has_next ? nxt.B : cB;
        asm volatile("" : "+s"(nA), "+s"(nB));
        int nt = cur.nt; asm volatile("" : "+s"(nt));
#pragma nounroll
        for (int t = 0; t < nt; t += 2) {
            const bool last = (t == nt - 2);
            asm volatile("" : "+v"(voffA[0]), "+v"(voffA[1]), "+v"(voffB[0]), "+v"(voffB[1]));
            if (last && has_next) S.a_ready(nxt);
            const char* a1 = cA + (size_t)(t + 1) * kstep;
            const char* a2 = last ? nA : cA + (size_t)(t + 2) * kstep; const char* b2 = last ? nB : cB + (size_t)(t + 2) * kstep;
            const char* a3 = a2 + kstep; const char* b3 = b2 + kstep;
            PG8_LDB(B0, 0, 0); PG8_LDB(B1, 0, 1); PG8_SCHED; PG8_LDA(At, 0, 0); PG8_STAGE(PG8_SA(1, 1), a1 + hstep, voffA);
            PG8_WAIT_V(8); PG8_WAIT_L(0); PG8_BAR; PG8_MMA(0, 0, At, B0); PG8_MMA(0, 1, At, B1); PG8_BAR; PG8_SCHED;
            PG8_LDA(At, 0, 1); PG8_STAGE(PG8_SB(0, 0), b2, voffB); PG8_STAGE(PG8_SB(0, 1), b2 + hstep, voffB); PG8_STAGE(PG8_SA(0, 0), a2, voffA);
            PG8_WAIT_V(8); PG8_WAIT_L(0); PG8_BAR; PG8_MMA(1, 0, At, B0); PG8_MMA(1, 1, At, B1); PG8_BAR; PG8_SCHED;
            PG8_LDB(B0, 1, 0); PG8_LDB(B1, 1, 1); PG8_SCHED; PG8_LDA(At, 1, 0); PG8_STAGE(PG8_SA(0, 1), a2 + hstep, voffA);
            PG8_WAIT_V(8); PG8_WAIT_L(0); PG8_BAR; PG8_MMA(0, 0, At, B0); PG8_MMA(0, 1, At, B1); PG8_BAR; PG8_SCHED;
            PG8_LDA(At, 1, 1); PG8_STAGE(PG8_SB(1, 0), b3, voffB); PG8_STAGE(PG8_SB(1, 1), b3 + hstep, voffB); PG8_STAGE(PG8_SA(1, 0), a3, voffA);
            PG8_WAIT_V(8); PG8_WAIT_L(0); PG8_BAR; PG8_MMA(1, 0, At, B0); PG8_MMA(1, 1, At, B1); PG8_BAR; PG8_SCHED;
        }
        if (F8) asm volatile("s_nop 15\n\ts_nop 15" ::: "memory");
        if (wr == 0) PG8_BAR;
        PG8_SCHED; E(acc, cur, wr, wc, fr, fq); PG8_SCHED;
        if (!has_next) break;
        if (!KEEP) {
#pragma unroll
        for (int a = 0; a < 2; ++a)
#pragma unroll
            for (int b = 0; b < 2; ++b)
#pragma unroll
                for (int m = 0; m < 4; ++m)
#pragma unroll
                    for (int n = 0; n < 2; ++n) acc[a][b][m][n] = (f32x4){0.f, 0.f, 0.f, 0.f};
        }
        cur = nxt; cA = nA; cB = nB; ++ui;
        if (wr == 1) PG8_BAR;
    }
    PG8_WAIT_V(0);
    PG8_BAR;
    E.after(acc, cur, lds, wr, wc, fr, fq);
#undef PG8_SA
#undef PG8_SB
#undef PG8_STAGE
#undef PG8_LDA
#undef PG8_LDB
#undef PG8_MMA
#undef PG8_H0
#undef PG8_H1
#undef PG8_WAIT_V
#undef PG8_WAIT_L
#undef PG8_BAR
#undef PG8_SCHED
}

struct EpiG1 {
    bf16_t *B0, *B1, *B2, *B3, *B4; float* vss; const float *gq, *gk; const LAS float* R;
    __device__ __forceinline__ void after(f32x4 (&)[2][2][4][2], const Unit&, LAS unsigned char*, int, int, int, int) const {}
    __device__ __forceinline__ void operator()(f32x4 (&acc)[2][2][4][2], const Unit& u, int wr, int wc, int fr, int fq) const {
        const int j = u.pn; const size_t rowb = (size_t)u.pm * BM + wr * 64 + fr; const int cl = 32 * wc + 8 * fq;
#pragma unroll
        for (int ai = 0; ai < 2; ++ai)
#pragma unroll
            for (int m = 0; m < 4; ++m) { const float rs = R[ai * HALF + wr * 64 + m * 16 + fr];
#pragma unroll
                for (int bj = 0; bj < 2; ++bj) { acc[ai][bj][m][0] *= rs; acc[ai][bj][m][1] *= rs; } }
        const bool ubz = (j == 6 || j == 7 || j == 10 || j == 11);
        if (j < 4 || ubz) {
            bf16_t* dst = ubz ? B0 + 512 + 128 * (j < 8 ? j - 6 : j - 8) : B3 + 128 * j;
#pragma unroll
            for (int ai = 0; ai < 2; ++ai)
#pragma unroll
                for (int m = 0; m < 4; ++m) { f32x4 o0, o1;
#pragma unroll
                    for (int e = 0; e < 4; ++e) { const float g0 = acc[ai][1][m][0][e], g1 = acc[ai][1][m][1][e]; const float s0 = fsigm(g0), s1 = fsigm(g1);
                        o0[e] = acc[ai][0][m][0][e] * (ubz ? g0 * s0 : s0); o1[e] = acc[ai][0][m][1][e] * (ubz ? g1 * s1 : s1); }
                    *(u32x4*)(dst + (rowb + ai * HALF + m * 16) * 1024 + cl) = pack8(o0, o1); }
        } else if (j < 12 || j >= 16) {
            bf16_t* dst; int pitch, coff; bool act;
            if (j < 6) { dst = B0; pitch = 1024; coff = 256 * (j - 4); act = true; }
            else if (j < 8) { dst = B0; pitch = 1024; coff = 512 + 256 * (j - 6); act = false; }
            else if (j < 10) { dst = B3; pitch = 1024; coff = 512 + 256 * (j - 8); act = false; }
            else if (j < 12) { dst = B4; pitch = 512; coff = 256 * (j - 10); act = true; }
            else if (j < 18) { dst = B2; pitch = 1024; coff = 256 * (j - 16); act = false; }
            else { dst = B2; pitch = 1024; coff = 512 + 256 * (j - 18); act = true; }
            const bool stat = (j == 8 || j == 9);
#pragma unroll
            for (int ai = 0; ai < 2; ++ai)
#pragma unroll
                for (int m = 0; m < 4; ++m) { const size_t row = rowb + ai * HALF + m * 16; float s = 0.f;
#pragma unroll
                    for (int bj = 0; bj < 2; ++bj) { f32x4 v0 = acc[ai][bj][m][0], v1 = acc[ai][bj][m][1];
                        if (act) {
#pragma unroll
                            for (int e = 0; e < 4; ++e) { v0[e] = v0[e] * fsigm(v0[e]); v1[e] = v1[e] * fsigm(v1[e]); } }
                        s += (v0[0] * v0[0] + v0[1] * v0[1]) + (v0[2] * v0[2] + v0[3] * v0[3]) + (v1[0] * v1[0] + v1[1] * v1[1]) + (v1[2] * v1[2] + v1[3] * v1[3]);
                        *(u32x4*)(dst + row * pitch + coff + 128 * bj + cl) = pack8(v0, v1); }
                    if (stat) { s += __shfl_xor(s, 16); s += __shfl_xor(s, 32); if (fq == 0) vss[row * 8 + (j - 8) * 4 + wc] = s; } }
        } else {
            const bool isk = j >= 14; const int jj = (j - 12) & 1; const float* g = isk ? gk : gq; const float sc = isk ? 1.f : C2;
            f32x4 gv[2][2];
#pragma unroll
            for (int bj = 0; bj < 2; ++bj) { gv[bj][0] = *(const f32x4*)(g + 32 * bj + 8 * fq) * sc; gv[bj][1] = *(const f32x4*)(g + 32 * bj + 8 * fq + 4) * sc; }
            bf16_t* dst = B1 + (isk ? 512 : 0) + 64 * (4 * jj + wc) + 8 * fq;
#pragma unroll
            for (int ai = 0; ai < 2; ++ai)
#pragma unroll
                for (int m = 0; m < 4; ++m) { const size_t row = rowb + ai * HALF + m * 16; float s = 0.f;
#pragma unroll
                    for (int bj = 0; bj < 2; ++bj) { const f32x4 v0 = acc[ai][bj][m][0], v1 = acc[ai][bj][m][1];
                        s += (v0[0] * v0[0] + v0[1] * v0[1]) + (v0[2] * v0[2] + v0[3] * v0[3]) + (v1[0] * v1[0] + v1[1] * v1[1]) + (v1[2] * v1[2] + v1[3] * v1[3]); }
                    s += __shfl_xor(s, 16); s += __shfl_xor(s, 32);
                    const float r = __builtin_amdgcn_rsqf(s * (1.f / 64.f) + EPS);
#pragma unroll
                    for (int bj = 0; bj < 2; ++bj) *(u32x4*)(dst + row * 1024 + 32 * bj) = pack8(acc[ai][bj][m][0] * r * gv[bj][0], acc[ai][bj][m][1] * r * gv[bj][1]); }
        }
    }
};
template <bool GATE> struct EpiMergeT {
    unsigned char *gta, *gtb; bf16_t* MG; const float* bgate; const LAS float* R; mutable u32x4 cq[4];
    __device__ __forceinline__ void after(f32x4 (&)[2][2][4][2], const Unit&, LAS unsigned char*, int, int, int, int) const {}
    __device__ __forceinline__ void operator()(f32x4 (&acc)[2][2][4][2], const Unit& u, int wr, int wc, int fr, int fq) const {
        const int tag = u.tag, br = tag >> 1; const size_t rowb = (size_t)u.pm * BM + wr * 64 + fr; const int col0 = u.pn * BM + 32 * wc + 8 * fq;
        u32x4* slots_ = (u32x4*)((br == 1 ? gtb : gta) + (br == 2 ? (long)WS_GT : (long)WS_B4)) + ((wr * 4 + wc) * 64 + fq * 16 + fr); asm volatile("" : "+v"(slots_)); __attribute__((address_space(1))) u32x4* slots = (__attribute__((address_space(1))) u32x4*)slots_;
        if (GATE) {
            f32x4 bv[2][2];
#pragma unroll
            for (int bj = 0; bj < 2; ++bj) { bv[bj][0] = *(const f32x4*)(bgate + br * 1024 + col0 + 128 * bj); bv[bj][1] = *(const f32x4*)(bgate + br * 1024 + col0 + 128 * bj + 4); }
#pragma unroll
            for (int ai = 0; ai < 2; ++ai)
#pragma unroll
                for (int m = 0; m < 4; ++m) { const float rs = R[ai * HALF + wr * 64 + m * 16 + fr] * (1.f / F8_WSCALE); u32x4 w;
#pragma unroll
                    for (int bj = 0; bj < 2; ++bj) { f32x4 v0 = acc[ai][bj][m][0] * rs + bv[bj][0], v1 = acc[ai][bj][m][1] * rs + bv[bj][1];
#pragma unroll
                        for (int e = 0; e < 4; ++e) { v0[e] = fmaxf(fsigm256(v0[e]), 1.f); v1[e] = fmaxf(fsigm256(v1[e]), 1.f); }
                        if (bj == 0) { w.x = pk4u8(v0); w.y = pk4u8(v1); } else { w.z = pk4u8(v0); w.w = pk4u8(v1); } }
                    slots[(size_t)((ai * 4 + m) * 512)] = w; }
        } else {
            const int nb = br + 1;
            u32x4* sl2_ = (u32x4*)((nb == 1 ? gtb : gta) + (nb == 2 ? (long)WS_GT : (long)WS_B4)) + ((wr * 4 + wc) * 64 + fq * 16 + fr); asm volatile("" : "+v"(sl2_)); const __attribute__((address_space(1))) u32x4* sl2 = (const __attribute__((address_space(1))) u32x4*)sl2_;
            if (br < 2) {
                u32x4 gn[2][4], gd[2][4];
#pragma unroll
                for (int ai = 0; ai < 2; ++ai)
#pragma unroll
                    for (int m = 0; m < 4; ++m) { if (br == 0 || ai == 1) gn[ai][m] = slots[(size_t)((ai * 4 + m) * 512)]; else gn[ai][m] = cq[m]; gd[ai][m] = sl2[(size_t)((ai * 4 + m) * 512)]; }
#pragma unroll
                for (int ai = 0; ai < 2; ++ai)
#pragma unroll
                    for (int m = 0; m < 4; ++m) { asm volatile("" : "+v"(gn[ai][m]), "+v"(gd[ai][m]));
#pragma unroll
                        for (int bj = 0; bj < 2; ++bj) { f32x4 n0 = un4u8(bj ? gn[ai][m].z : gn[ai][m].x), n1 = un4u8(bj ? gn[ai][m].w : gn[ai][m].y); const f32x4 d0 = un4u8(bj ? gd[ai][m].z : gd[ai][m].x), d1 = un4u8(bj ? gd[ai][m].w : gd[ai][m].y);
#pragma unroll
                            for (int e = 0; e < 4; ++e) { n0[e] *= __builtin_amdgcn_rcpf(d0[e]); n1[e] *= __builtin_amdgcn_rcpf(d1[e]); }
                            acc[ai][bj][m][0] *= n0; acc[ai][bj][m][1] *= n1; }
                        if (ai == 0) cq[m] = gd[ai][m]; }
                asm volatile("" ::: "memory");
            } else {
                u32x4 gn[2][4];
#pragma unroll
                for (int ai = 0; ai < 2; ++ai)
#pragma unroll
                    for (int m = 0; m < 4; ++m) { if (ai == 0) gn[ai][m] = cq[m]; else gn[ai][m] = slots[(size_t)((ai * 4 + m) * 512)]; }
#pragma unroll
                for (int ai = 0; ai < 2; ++ai)
#pragma unroll
                    for (int m = 0; m < 4; ++m) { asm volatile("" : "+v"(gn[ai][m]));
#pragma unroll
                        for (int bj = 0; bj < 2; ++bj) { const f32x4 n0 = un4u8(bj ? gn[ai][m].z : gn[ai][m].x), n1 = un4u8(bj ? gn[ai][m].w : gn[ai][m].y);
                            *(u32x4*)(MG + (rowb + ai * HALF + m * 16) * 1024 + col0 + 128 * bj) = pack8(n0 * acc[ai][bj][m][0], n1 * acc[ai][bj][m][1]); } }
                asm volatile("" ::: "memory");
            }
        }
    }
    static __device__ __forceinline__ void yepi0(f32x4 (&acc)[2][2][4][2], const __attribute__((address_space(1))) u32x4* slots, bf16_t* MG, size_t rowb, int col0) {
        u32x4 gw[2][4];
#pragma unroll
        for (int ai = 0; ai < 2; ++ai)
#pragma unroll
            for (int m = 0; m < 4; ++m) gw[ai][m] = slots[(size_t)((ai * 4 + m) * 512)];
#pragma unroll
        for (int ai = 0; ai < 2; ++ai)
#pragma unroll
            for (int m = 0; m < 4; ++m) { asm volatile("" : "+v"(gw[ai][m]));
#pragma unroll
                for (int bj = 0; bj < 2; ++bj) { const f32x4 g0 = un4u8(bj ? gw[ai][m].z : gw[ai][m].x), g1 = un4u8(bj ? gw[ai][m].w : gw[ai][m].y);
                    *(u32x4*)(MG + (rowb + ai * HALF + m * 16) * 1024 + col0 + 128 * bj) = pack8(g0 * acc[ai][bj][m][0], g1 * acc[ai][bj][m][1]); } }
    }
    template <bool RMW> static __device__ __forceinline__ void yepi(f32x4 (&acc)[2][2][4][2], const __attribute__((address_space(1))) u32x4* slots, bf16_t* MG, size_t rowb, int col0) {
#pragma unroll
        for (int ai = 0; ai < 2; ++ai) {
            u32x4 gw[4], ow[4][2];
#pragma unroll
            for (int m = 0; m < 4; ++m) { gw[m] = slots[(size_t)((ai * 4 + m) * 512)];
#pragma unroll
                for (int bj = 0; bj < 2; ++bj) if (RMW) ow[m][bj] = *(const u32x4*)(MG + (rowb + ai * HALF + m * 16) * 1024 + col0 + 128 * bj); }
#pragma unroll
            for (int m = 0; m < 4; ++m)
#pragma unroll
                for (int bj = 0; bj < 2; ++bj) { asm volatile("" : "+v"(gw[m]));
                    const f32x4 g0 = un4u8(bj ? gw[m].z : gw[m].x), g1 = un4u8(bj ? gw[m].w : gw[m].y);
                    f32x4 v0 = g0 * acc[ai][bj][m][0], v1 = g1 * acc[ai][bj][m][1];
                    if (RMW) { asm volatile("" : "+v"(ow[m][bj])); f32x4 p0, p1; unpack8(ow[m][bj], p0, p1); v0 += p0; v1 += p1; }
                    *(u32x4*)(MG + (rowb + ai * HALF + m * 16) * 1024 + col0 + 128 * bj) = pack8(v0, v1); }
            asm volatile("" ::: "memory");
        }
    }
};
struct EpiOutB {
    const bf16_t* base; float* out;
    __device__ __forceinline__ void after(f32x4 (&)[2][2][4][2], const Unit&, LAS unsigned char*, int, int, int, int) const {}
    __device__ __forceinline__ void operator()(f32x4 (&acc)[2][2][4][2], const Unit& u, int wr, int wc, int fr, int fq) const {
        const size_t rowb = (size_t)u.pm * BM + wr * 64 + fr; const int col0 = u.pn * BM + 32 * wc + 8 * fq;
        u32x4 bw[2][4][2];
#pragma unroll
        for (int ai = 0; ai < 2; ++ai)
#pragma unroll
            for (int m = 0; m < 4; ++m)
#pragma unroll
                for (int bj = 0; bj < 2; ++bj) bw[ai][m][bj] = *(const u32x4*)(base + (rowb + ai * HALF + m * 16) * D + col0 + 128 * bj);
#pragma unroll
        for (int ai = 0; ai < 2; ++ai)
#pragma unroll
            for (int m = 0; m < 4; ++m)
#pragma unroll
                for (int bj = 0; bj < 2; ++bj) { const size_t o = (rowb + ai * HALF + m * 16) * D + col0 + 128 * bj;
                    asm volatile("" : "+v"(bw[ai][m][bj])); f32x4 b0, b1; unpack8(bw[ai][m][bj], b0, b1);
                    *(f32x4*)(out + o) = b0 + acc[ai][bj][m][0]; *(f32x4*)(out + o + 4) = b1 + acc[ai][bj][m][1]; }
    }
};
struct EpiOut {
    const float* base; float* out;
    __device__ __forceinline__ void after(f32x4 (&)[2][2][4][2], const Unit&, LAS unsigned char*, int, int, int, int) const {}
    __device__ __forceinline__ void operator()(f32x4 (&acc)[2][2][4][2], const Unit& u, int wr, int wc, int fr, int fq) const {
        const size_t rowb = (size_t)u.pm * BM + wr * 64 + fr; const int col0 = u.pn * BM + 32 * wc + 8 * fq;
#pragma unroll
        for (int ai = 0; ai < 2; ++ai)
#pragma unroll
            for (int m = 0; m < 4; ++m) {
#pragma unroll
                for (int bj = 0; bj < 2; ++bj) { const size_t o = (rowb + ai * HALF + m * 16) * D + col0 + 128 * bj;
                    const f32x4 b0 = *(const f32x4*)(base + o), b1 = *(const f32x4*)(base + o + 4);
                    *(f32x4*)(out + o) = b0 + acc[ai][bj][m][0]; *(f32x4*)(out + o + 4) = b1 + acc[ai][bj][m][1]; }
                if (m & 1) asm volatile("" ::: "memory"); }
    }
};
struct EpiOutLN {
    const bf16_t* base; bf16_t* XG; const float* gnext; const float* wfnext; float* SSP; float* FP; unsigned char* H8;
    __device__ __forceinline__ void operator()(f32x4 (&)[2][2][4][2], const Unit&, int, int, int, int) const {}
    __device__ __forceinline__ void after(f32x4 (&acc)[2][2][4][2], const Unit& u, LAS unsigned char* lds, int wr, int wc, int fr, int fq) const {
        const int tid = ((wr * 4 + wc) * 64) + fq * 16 + fr;
        const size_t rowb = (size_t)u.pm * BM + wr * 64 + fr; const int cl = 32 * wc + 8 * fq, col0 = u.pn * BM + cl;
        LAS float* FL = (LAS float*)lds;
        LAS float* WL = (LAS float*)(lds + 512 * 72 * 4);
        { float gk[4], wk[4];
#pragma unroll
          for (int q = 0; q < 4; ++q) { const int i = tid + 512 * q, c = i >> 3, e = i & 7; gk[q] = gnext[u.pn * BM + c]; wk[q] = wfnext[(size_t)(u.pn * BM + c) * NIN + e]; }
#pragma unroll
          for (int q = 0; q < 4; ++q) WL[tid + 512 * q] = gk[q] * wk[q]; }
#pragma unroll
        for (int ai = 0; ai < 2; ++ai) {
            u32x4 bw[4][2];
#pragma unroll
            for (int m = 0; m < 4; ++m)
#pragma unroll
                for (int bj = 0; bj < 2; ++bj) bw[m][bj] = *(const u32x4*)(base + (rowb + ai * HALF + m * 16) * D + col0 + 128 * bj);
#pragma unroll
            for (int m = 0; m < 4; ++m) { float ss = 0.f;
#pragma unroll
                for (int bj = 0; bj < 2; ++bj) { const size_t o = (rowb + ai * HALF + m * 16) * D + col0 + 128 * bj;
                    asm volatile("" : "+v"(bw[m][bj])); f32x4 b0_, b1_; unpack8(bw[m][bj], b0_, b1_);
                    const f32x4 x0 = b0_ + acc[ai][bj][m][0], x1 = b1_ + acc[ai][bj][m][1];
                    ss += (x0[0] * x0[0] + x0[1] * x0[1]) + (x0[2] * x0[2] + x0[3] * x0[3]) + (x1[0] * x1[0] + x1[1] * x1[1]) + (x1[2] * x1[2] + x1[3] * x1[3]);
                    *(u32x4*)(XG + o) = pack8(x0, x1);
                    { u32x2 o8; o8.x = pk4f8(x0[0], x0[1], x0[2], x0[3]); o8.y = pk4f8(x1[0], x1[1], x1[2], x1[3]); *(u32x2*)(H8 + (rowb + ai * HALF + m * 16) * 1024 + col0 + 128 * bj) = o8; }
                    acc[ai][bj][m][0] = x0; acc[ai][bj][m][1] = x1; }
                FL[tid * 72 + 64 + ai * 4 + m] = ss; }
            asm volatile("" ::: "memory"); }
        asm volatile("s_waitcnt lgkmcnt(0)" ::: "memory"); __builtin_amdgcn_s_barrier(); asm volatile("" ::: "memory");
#pragma unroll
        for (int hh = 0; hh < 2; ++hh) {
            f32x4 f[8];
#pragma unroll
            for (int rg = 0; rg < 8; ++rg) f[rg] = (f32x4){0.f, 0.f, 0.f, 0.f};
#pragma unroll
            for (int bj = 0; bj < 2; ++bj)
#pragma unroll
                for (int n = 0; n < 2; ++n)
#pragma unroll
                    for (int i = 0; i < 4; ++i) { const f32x4 wv = *(const LAS f32x4*)(WL + (128 * bj + cl + 4 * n + i) * 8 + 4 * hh);
#pragma unroll
                        for (int ai = 0; ai < 2; ++ai)
#pragma unroll
                            for (int m = 0; m < 4; ++m) f[ai * 4 + m] += acc[ai][bj][m][n][i] * wv; }
#pragma unroll
            for (int rg = 0; rg < 8; ++rg) *(LAS f32x4*)(FL + tid * 72 + rg * 8 + 4 * hh) = f[rg];
            asm volatile("" ::: "memory");
        }
        asm volatile("s_waitcnt lgkmcnt(0)" ::: "memory"); __builtin_amdgcn_s_barrier(); asm volatile("" ::: "memory");
        { const int row = tid & 255, hb = (tid >> 8) * 4, ai_ = row >> 7, wr_ = (row >> 6) & 1, m_ = (row >> 4) & 3, fr_ = row & 15, rg = ai_ * 4 + m_;
          f32x4 sum = (f32x4){0.f, 0.f, 0.f, 0.f}; float ssum = 0.f;
#pragma unroll
          for (int wc_ = 0; wc_ < 4; ++wc_)
#pragma unroll
              for (int fq_ = 0; fq_ < 4; ++fq_) { const LAS float* src = FL + (((wr_ * 4 + wc_) * 64) + fq_ * 16 + fr_) * 72; sum += *(const LAS f32x4*)(src + rg * 8 + hb); ssum += src[64 + rg]; }
          const size_t grow = (size_t)u.pm * BM + row;
#pragma unroll
          for (int e = 0; e < 4; ++e) FP[((size_t)(hb + e) * M + grow) * 4 + u.pn] = sum[e];
          if (hb == 0) SSP[grow * 4 + u.pn] = ssum; }
    }
};
struct SchedG1 { TileOrder T; const char* A; const char* B;
    __device__ __forceinline__ void a_ready(const Unit&) const {}
    __device__ __forceinline__ bool next(int i, Unit& u) const { int pm, pn; if (!T.tile(i, pm, pn)) return false; u.pm = pm; u.pn = pn; u.tag = 0; u.nt = 16; u.A = A + (size_t)pm * (BM * PITCH * 2); u.B = B + (size_t)pn * (BM * PITCH * 2); return true; } };
struct SchedGate { int pm, pn; bool ok; const char *h8, *wl; unsigned* sbtop; unsigned want; unsigned* tmo;
    __device__ __forceinline__ bool next(int i, Unit& u) const { if (!ok || i >= 3) return false;
        u.pm = pm; u.pn = pn; u.tag = 2 * i; u.nt = 8;
        u.A = h8 + (size_t)pm * (BM * 1024); u.B = wl + WO_WG + (size_t)i * (1024 * 1024) + (size_t)pn * (BM * 1024); return true; }
    __device__ __forceinline__ void a_ready(const Unit& u) const {
        if (u.tag != 4) return;
        if (threadIdx.x < 64) {
            unsigned sp = 0;
            while ((unsigned)__builtin_amdgcn_readfirstlane((int)__hip_atomic_load(sbtop, __ATOMIC_RELAXED, __HIP_MEMORY_SCOPE_AGENT)) < want) {
                __builtin_amdgcn_s_sleep(1);
                if (++sp > (1u << 20)) { if (threadIdx.x == 0) __hip_atomic_store(tmo, 1u, __ATOMIC_RELAXED, __HIP_MEMORY_SCOPE_AGENT); break; } }
            __builtin_amdgcn_fence(__ATOMIC_ACQUIRE, "agent");
            asm volatile("s_waitcnt vmcnt(0)" ::: "memory");
        }
        asm volatile("" ::: "memory"); __builtin_amdgcn_s_barrier(); asm volatile("" ::: "memory");
    } };
struct SchedY { int pm, pn; bool ok; const char *ws, *wl;
    __device__ __forceinline__ bool next(int br, Unit& u) const { if (!ok || br >= 3) return false;
        u.pm = pm; u.pn = pn; u.tag = 2 * br + 1; u.nt = 8;
        const size_t ro = (size_t)pm * (BM * PITCH * 2), co = (size_t)pn * (BM * PITCH * 2);
        const size_t ao = br == 0 ? WS_B0 : (br == 1 ? WS_B0 + 1024 : WS_B1), bo = br == 0 ? WO_WAB : (br == 1 ? WO_WAB + 1024 : WO_WC); u.A = ws + ao + ro; u.B = wl + bo + co;
        return true; }
    __device__ __forceinline__ void a_ready(const Unit&) const {} };
}

#define XB_TMO      128
#define XB_XCNT(j)  (256  + 64 * (j))
#define XB_XSUB(j)  (1280 + 64 * (j))
#define XB_XGEN(j)  (2304 + 64 * (j))
#define XB_TOP      3328
#define XB_TOPGEN   3392
#define XCD_BAR_WORDS 3456
#define XB_SPIN_CAP (1u << 18)
__device__ __forceinline__ unsigned xb_ld(unsigned* p)              { return __hip_atomic_load(p, __ATOMIC_RELAXED, __HIP_MEMORY_SCOPE_AGENT); }
__device__ __forceinline__ unsigned xb_add(unsigned* p, unsigned v) { return __hip_atomic_fetch_add(p, v, __ATOMIC_RELAXED, __HIP_MEMORY_SCOPE_AGENT); }
__device__ __forceinline__ unsigned xb_xcc_id() { return (unsigned)__builtin_amdgcn_s_getreg((3 << 11) | 20) & 0xFu; }
#define XB_SPIN(cond, bar) do { unsigned _sp = 0; while (cond) { __builtin_amdgcn_s_sleep(1); \
    if ((++_sp & 255u) == 0u) { if (xb_ld(&(bar)[XB_TMO])) break; if (_sp > XB_SPIN_CAP) { atomicAdd(&(bar)[XB_TMO], 1u); break; } } } } while (0)
struct XcdBarrier { unsigned* bar; unsigned x; volatile LAS unsigned* st; };
__device__ __forceinline__ XcdBarrier xcd_barrier_post(unsigned* bar, volatile LAS unsigned* st) {
    XcdBarrier b; b.bar = bar; b.x = xb_xcc_id(); b.st = st;
    if (threadIdx.x == 0) (void)xb_add(&bar[XB_XCNT(b.x)], 1u);
    return b;
}
__device__ __forceinline__ void xcd_barrier_complete(unsigned* bar, unsigned x, unsigned& nloc, unsigned& nx) {
    const unsigned G = gridDim.x * gridDim.y * gridDim.z;
    unsigned sum, cnt, mine, sp = 0u;
    for (;;) {
        sum = 0u; cnt = 0u; mine = 0u;
#pragma unroll
        for (unsigned j = 0; j < 16; ++j) { const unsigned c = xb_ld(&bar[XB_XCNT(j)]); sum += c; cnt += (c > 0u) ? 1u : 0u; mine = (j == x) ? c : mine; }
        if (sum == G) break;
        __builtin_amdgcn_s_sleep(1);
        if ((++sp & 255u) == 0u) { if (xb_ld(&bar[XB_TMO])) break; if (sp > XB_SPIN_CAP) { atomicAdd(&bar[XB_TMO], 1u); break; } }
    }
    nloc = mine > 0u ? mine : 1u; nx = cnt > 0u ? cnt : 1u;
}
__device__ __forceinline__ void xcd_barrier(const XcdBarrier& b) {
    asm volatile("s_waitcnt vmcnt(0)" ::: "memory");
    __syncthreads();
    if (threadIdx.x == 0) {
        unsigned* bar = b.bar;
        __builtin_amdgcn_s_waitcnt(0);
        asm volatile("buffer_inv sc1" ::: "memory");
        unsigned nloc = b.st[0], nx = b.st[1];
        if (nloc == 0u) { xcd_barrier_complete(bar, b.x, nloc, nx); b.st[0] = nloc; b.st[1] = nx; }
        const unsigned old = xb_add(&bar[XB_XSUB(b.x)], 1u);
        const unsigned gen = old / nloc;
        if (old + 1u == gen * nloc + (3u * nloc) / 4u) { __builtin_amdgcn_fence(__ATOMIC_RELEASE, "agent"); asm volatile("s_waitcnt vmcnt(0)" ::: "memory"); }
        if (old + 1u == (gen + 1u) * nloc) {
            __builtin_amdgcn_fence(__ATOMIC_RELEASE, "agent");
            asm volatile("s_waitcnt vmcnt(0)" ::: "memory");
            const unsigned og = xb_add(&bar[XB_TOP], 1u);
            const unsigned tg = og / nx;
            if (og + 1u == (tg + 1u) * nx) xb_add(&bar[XB_TOPGEN], 1u);
            else XB_SPIN(xb_ld(&bar[XB_TOPGEN]) == tg, bar);
            asm volatile("s_waitcnt vmcnt(0)" ::: "memory");
            xb_add(&bar[XB_XGEN(b.x)], 1u);
            asm volatile("s_waitcnt vmcnt(0)" ::: "memory");
        } else {
            XB_SPIN(xb_ld(&bar[XB_XGEN(b.x)]) == gen, bar);
            asm volatile("s_waitcnt vmcnt(0)" ::: "memory");
            asm volatile("s_waitcnt vmcnt(0)" ::: "memory");
        }
    }
    __syncthreads();
}

#define SB_XSUB(j)  (1024 + 64 * (j))
#define SB_TOP      2112
__device__ __forceinline__ void sb_arrive(const XcdBarrier& b, unsigned* ctlw, unsigned k) {
    asm volatile("s_waitcnt vmcnt(0)" ::: "memory");
    __syncthreads();
    if (threadIdx.x == 0) {
        __builtin_amdgcn_s_waitcnt(0);
        const unsigned nloc = b.st[0];
        const unsigned old = xb_add(&ctlw[SB_XSUB(b.x)], 1u);
        if (old + 1u == nloc * k) {
            __builtin_amdgcn_fence(__ATOMIC_RELEASE, "agent");
            asm volatile("s_waitcnt vmcnt(0)" ::: "memory");
            xb_add(&ctlw[SB_TOP], 1u);
        }
    }
}

struct Args { const float* in[18]; float* out; unsigned char* ws; int ph_lo, ph_hi, li, pad; };
struct Frame { LAS unsigned char* lds; int tid, lane, wave, vcu, G; Ptrs P; };

__device__ __forceinline__ unsigned pk2(float lo, float hi) { return (unsigned)f2bf(lo) | ((unsigned)f2bf(hi) << 16); }
__device__ __forceinline__ void p0_transpose_item(const float* W, int ldw, int src_col, int k0, bf16_t* WT, size_t dst_row, int dst_col, LAS float* scr, int lane, const float* kgain = nullptr, const bool f8 = false, const float wsc = 1.f) {
#pragma unroll 8
    for (int i = 0; i < 32; ++i) { const int kk = 2 * i + (lane >> 5); scr[kk * 33 + (lane & 31)] = W[(size_t)(k0 + kk) * ldw + src_col + (lane & 31)]; }
    LDS_WAIT(); asm volatile("" ::: "memory");
    const int c = lane & 7;
    f32x4 ga = (f32x4){wsc, wsc, wsc, wsc}, gb = ga; if (kgain) { ga = *(const f32x4*)(kgain + k0 + 8 * c); gb = *(const f32x4*)(kgain + k0 + 8 * c + 4); }
    if (f8) {
#pragma unroll
        for (int j = 0; j < 4; ++j) { const int n = (lane >> 3) + 8 * j; const LAS float* s = scr + (8 * c) * 33 + n; u32x2 o;
            o.x = pk4f8(s[0 * 33] * ga.x * F8_WSCALE, s[1 * 33] * ga.y * F8_WSCALE, s[2 * 33] * ga.z * F8_WSCALE, s[3 * 33] * ga.w * F8_WSCALE);
            o.y = pk4f8(s[4 * 33] * gb.x * F8_WSCALE, s[5 * 33] * gb.y * F8_WSCALE, s[6 * 33] * gb.z * F8_WSCALE, s[7 * 33] * gb.w * F8_WSCALE);
            *(GAS u32x2*)((GAS unsigned char*)WT + (dst_row + n) * 1024 + dst_col + k0 + 8 * c) = o; }
    } else
#pragma unroll
    for (int j = 0; j < 4; ++j) { const int n = (lane >> 3) + 8 * j; const LAS float* s = scr + (8 * c) * 33 + n;
        u32x4 o; o.x = pk2(s[0 * 33] * ga.x, s[1 * 33] * ga.y); o.y = pk2(s[2 * 33] * ga.z, s[3 * 33] * ga.w); o.z = pk2(s[4 * 33] * gb.x, s[5 * 33] * gb.y); o.w = pk2(s[6 * 33] * gb.z, s[7 * 33] * gb.w);
        *(GAS u32x4*)(WT + (dst_row + n) * 1024 + dst_col + k0 + 8 * c) = o; }
    LDS_WAIT(); asm volatile("" ::: "memory");
}
__device__ __forceinline__ void p0_weights(Frame& F) {
    LAS float* scr = (LAS float*)(F.lds + RING_OFF + F.wave * 16384);
    const int gw = F.vcu * NWAVES + F.wave, NGW = F.G * NWAVES;
    constexpr int I_W1 = 16 * (N1 / 32), I_WG = 16 * 96, I_Y = 8 * 32, I_WO = 16 * 32, I_L = I_W1 + I_WG + 3 * I_Y + I_WO;
    for (int it = gw; it < NL * I_L; it += NGW) {
        const int l = it / I_L; int r = it % I_L;
        unsigned char* wl = F.P.ws + WS_W + (size_t)l * W_LAYER; const float* win = F.P.w_in + (size_t)l * D * NIN;
        const float* kg = F.P.norm_g + (size_t)l * D;
        if (r < I_W1) { const int kb = r / (N1 / 32), nb = r % (N1 / 32); p0_transpose_item(win, NIN, g1_col(32 * nb), 64 * kb, (bf16_t*)(wl + WO_W1), 32 * nb, 0, scr, F.lane, kg); continue; } r -= I_W1;
        if (r < I_WG) { const int kb = r / 96, nb = r % 96; p0_transpose_item(win, NIN, 32 * nb, 64 * kb, (bf16_t*)(wl + WO_WG), 32 * nb, 0, scr, F.lane, kg, true); continue; } r -= I_WG;
        if (r < I_Y) { const int kb = r / 32, nb = r % 32; p0_transpose_item(F.P.w_a + (size_t)l * DA * D, D, 32 * nb, 64 * kb, (bf16_t*)(wl + WO_WAB), 32 * nb, 0, scr, F.lane, nullptr, false, 1.f / 256.f); continue; } r -= I_Y;
        if (r < I_Y) { const int kb = r / 32, nb = r % 32; p0_transpose_item(F.P.w_b + (size_t)l * DB * D, D, 32 * nb, 64 * kb, (bf16_t*)(wl + WO_WAB), 32 * nb, 512, scr, F.lane, nullptr, false, 1.f / 256.f); continue; } r -= I_Y;
        if (r < I_Y) { const int kb = r / 32, nb = r % 32; p0_transpose_item(F.P.w_c + (size_t)l * DC * D, D, 32 * nb, 64 * kb, (bf16_t*)(wl + WO_WC), 32 * nb, 0, scr, F.lane, nullptr, false, 1.f / 256.f); continue; } r -= I_Y;
        { const int kb = r / 32, nb = r % 32; p0_transpose_item(F.P.w_out + (size_t)l * D * D, D, 32 * nb, 64 * kb, (bf16_t*)(wl + WO_WO), 32 * nb, 0, scr, F.lane); }
    }
    bf16_t* WSB = (bf16_t*)(F.P.ws + WS_WSB);
    for (int i = (int)blockIdx.x * 512 + F.tid; i < NL * NG * CHK * CHK; i += F.G * 512) { const int s = i & 127, t = (i >> 7) & 127; WSB[i] = s <= t ? f2bf(F.P.w_s[i]) : (bf16_t)0; }
}
__device__ __forceinline__ void p0_ln(Frame& F, int l, const float* xin) {
    LAS float* wf = (LAS float*)(F.lds + RING_OFF);
    const float* g = F.P.norm_g + (size_t)l * D; const float* win = F.P.w_in + (size_t)l * D * NIN;
    __syncthreads();
    { float gk[16], wk[16];
#pragma unroll
      for (int q = 0; q < 16; ++q) { const int i = F.tid + 512 * q, k = i >> 3, e = i & 7; gk[q] = g[k]; wk[q] = win[(size_t)k * NIN + OC_F + e]; }
#pragma unroll
      for (int q = 0; q < 16; ++q) wf[F.tid + 512 * q] = gk[q] * wk[q]; }
    __syncthreads();
    const int gw = F.vcu * NWAVES + F.wave, NGW = F.G * NWAVES;
    bf16_t* H = (bf16_t*)(F.P.ws + WS_H); float* LOGF = (float*)(F.P.ws + WS_LOGF);
    f32x4 gv[4];
#pragma unroll
    for (int j = 0; j < 4; ++j) gv[j] = ((const f32x4*)g)[64 * j + F.lane];
    static_assert(M == 8 * 256 * NWAVES, "p0_ln: 8 rows per wave on a 256-workgroup grid");
    float zrow[8];
#pragma unroll
    for (int k = 0; k < 8; ++k) zrow[k] = 0.f;
    f32x4 v[8][4];
#pragma unroll
    for (int bt = 0; bt < 4; ++bt) {
        asm volatile("" ::: "memory");
        if ((bt & 1) == 0) {
#pragma unroll
            for (int k = 2 * bt; k < 2 * bt + 4; ++k) { const GAS f32x4* xr = (const GAS f32x4*)(xin + (size_t)(gw + k * NGW) * D) + F.lane;
#pragma unroll
                for (int j = 0; j < 4; ++j) v[k][j] = xr[64 * j]; }
            asm volatile("" ::: "memory"); }
        float r[2]; float f[2][8];
#pragma unroll
        for (int q = 0; q < 2; ++q) { float ss = 0.f;
#pragma unroll
            for (int j = 0; j < 4; ++j) { const f32x4 x = v[2 * bt + q][j]; ss += (x.x * x.x + x.y * x.y) + (x.z * x.z + x.w * x.w); }
            { const float sst = wsum(ss); r[q] = rsqrtf(sst * (1.f / D) + EPS); if (F.lane == 0) *(f32x4*)((float*)(F.P.ws + WS_SSP) + (size_t)(gw + (2 * bt + q) * NGW) * 4) = (f32x4){sst, 0.f, 0.f, 0.f}; }
#pragma unroll
            for (int e = 0; e < 8; ++e) f[q][e] = 0.f; }
#pragma unroll
        for (int j = 0; j < 4; ++j) {
#pragma unroll
            for (int q = 0; q < 2; ++q) { const f32x4 hv = v[2 * bt + q][j];
                GAS unsigned long long* o8 = (GAS unsigned long long*)(H + (size_t)(gw + (2 * bt + q) * NGW) * D) + F.lane;
                o8[64 * j] = (unsigned long long)pk2(hv.x, hv.y) | ((unsigned long long)pk2(hv.z, hv.w) << 32);
                ((GAS unsigned*)((GAS unsigned char*)F.P.out + (size_t)(gw + (2 * bt + q) * NGW) * 1024))[64 * j + F.lane] = pk4f8(hv.x, hv.y, hv.z, hv.w); }
#pragma unroll
            for (int i = 0; i < 4; ++i) { const LAS f32x4* w4 = (const LAS f32x4*)(wf + (256 * j + 4 * F.lane + i) * 8); const f32x4 wa = w4[0], wb = w4[1];
#pragma unroll
                for (int q = 0; q < 2; ++q) { const float xv = v[2 * bt + q][j][i];
                    f[q][0] += xv * wa.x; f[q][1] += xv * wa.y; f[q][2] += xv * wa.z; f[q][3] += xv * wa.w; f[q][4] += xv * wb.x; f[q][5] += xv * wb.y; f[q][6] += xv * wb.z; f[q][7] += xv * wb.w; } }
        }
#pragma unroll
        for (int q = 0; q < 2; ++q) {
#pragma unroll
            for (int e = 0; e < 8; ++e) f[q][e] = wsum(f[q][e]);
            if (F.lane < 8) { float z = 0.f;
#pragma unroll
                for (int e = 0; e < 8; ++e) if (F.lane == e) z = f[q][e];
                zrow[2 * bt + q] = z * r[q]; } }
    }
    if (F.lane < 8) { const float bfv = F.P.b_f[l * NH + F.lane];
#pragma unroll
        for (int k = 0; k < 8; ++k) { const float z = zrow[k] + bfv; LOGF[(size_t)F.lane * M + (gw + k * NGW)] = fminf(z, 0.f) - log1pf(expf(-fabsf(z))); } }
    __syncthreads();
}
__device__ __forceinline__ void p1_scan(Frame& F, int bh, int l) {
    LAS float* sh = (LAS float*)(F.lds + RING_BYTES);
    LAS float* lfs = sh + 16;
    const int b = bh / NH, h = bh % NH, t0 = F.tid * 8;
    if (l == 0) { const float* lf = (const float*)(F.P.ws + WS_LOGF) + (size_t)h * M + (size_t)b * SEQ;
        { const f32x4 a0 = *(const f32x4*)(lf + F.tid * 4), a1 = *(const f32x4*)(lf + (F.tid + 512) * 4); *(LAS f32x4*)(lfs + F.tid * 4) = a0; *(LAS f32x4*)(lfs + (F.tid + 512) * 4) = a1; }
    } else {
        const float* fp = (const float*)(F.P.ws + WS_FP) + ((size_t)h * M + (size_t)b * SEQ) * 4; const float* sp = (const float*)(F.P.ws + WS_SSP) + (size_t)b * SEQ * 4; const float bfv = F.P.b_f[l * NH + h];
        f32x4 pv[8], qv[8];
#pragma unroll
        for (int k = 0; k < 8; ++k) { const int row = F.tid + 512 * k; pv[k] = *(const f32x4*)(fp + row * 4); qv[k] = *(const f32x4*)(sp + row * 4); }
#pragma unroll
        for (int k = 0; k < 8; ++k) { const float r = rsqrtf(((qv[k].x + qv[k].y) + (qv[k].z + qv[k].w)) * (1.f / D) + EPS); const float z = r * ((pv[k].x + pv[k].y) + (pv[k].z + pv[k].w)) + bfv;
            lfs[F.tid + 512 * k] = fminf(z, 0.f) - log1pf(expf(-fabsf(z))); }
    }
    __syncthreads();
    float c[8]; float run = 0.f;
    { const f32x4 a0 = *(const LAS f32x4*)(lfs + t0), a1 = *(const LAS f32x4*)(lfs + t0 + 4);
      run += a0.x; c[0] = run; run += a0.y; c[1] = run; run += a0.z; c[2] = run; run += a0.w; c[3] = run; run += a1.x; c[4] = run; run += a1.y; c[5] = run; run += a1.z; c[6] = run; run += a1.w; c[7] = run; }
    float inc = run;
#pragma unroll
    for (int o = 1; o < 64; o <<= 1) { const float n = __shfl_up(inc, o); if (F.lane >= o) inc += n; }
    if (F.lane == 63) sh[F.wave] = inc;
    __syncthreads();
    float base = inc - run;
    for (int w = 0; w < F.wave; ++w) base += sh[w];
    float* cs = (float*)(F.P.ws + WS_CS) + (size_t)bh * SEQ + t0;
    *(f32x4*)cs = (f32x4){(base + c[0]) * LOG2E, (base + c[1]) * LOG2E, (base + c[2]) * LOG2E, (base + c[3]) * LOG2E};
    *(f32x4*)(cs + 4) = (f32x4){(base + c[4]) * LOG2E, (base + c[5]) * LOG2E, (base + c[6]) * LOG2E, (base + c[7]) * LOG2E};
    __syncthreads();
    LAS float* c2s = lfs;
#pragma unroll
    for (int i = 0; i < 8; ++i) c2s[t0 + i] = (base + c[i]) * LOG2E;
    __syncthreads();
    if (F.tid < SEQ / 256) { const int qb = F.tid, nt = 4 * qb + 4; const float cq = c2s[256 * qb]; int lo = 0, hi = nt - 4;
        while (lo < hi) { const int mid = (lo + hi) >> 1; if (cq - c2s[64 * mid + 63] >= -SKIP_L2) hi = mid; else lo = mid + 1; }
        ((int*)(F.P.ws + WS_TS))[bh * 16 + qb] = lo & ~1; }
    __syncthreads();
}


#include <hip/hip_bf16.h>
namespace attn_body {
using bf16=__hip_bfloat16;
using s16x4=__attribute__((ext_vector_type(4)))short;
using f32x16=__attribute__((ext_vector_type(16)))float;
constexpr int NHEAD=NH,D=64,DM=1024;
constexpr int NW=8,QBLK=32,QB=QBLK*NW,KVBLK=64,NQB=SEQ/QB;
__device__ __forceinline__ int crow(int r,int hi){return (r&3)+8*(r>>2)+4*hi;}
#define SBAR() __builtin_amdgcn_sched_barrier(0)
__device__ __forceinline__ void cmask(f32x16&p0,f32x16&p1,int jb,int qrel,int hi){
  const float NEG=-INFINITY; int kb=64*jb+4*hi;
  #pragma unroll
  for(int r=0;r<16;++r){int kv=kb+(r&3)+8*(r>>2); if(kv>qrel)p0[r]=NEG; if(kv+32>qrel)p1[r]=NEG;}
}
constexpr int NSLOT=3, SLOTB=8192;
constexpr int LDS_K=0, LDS_V=NSLOT*SLOTB, LDS_WS=2*NSLOT*SLOTB, LDS_OST=LDS_WS+NW*64*4, LDS_C2=LDS_OST+NW*4096, LDS_BYTES=LDS_C2+SEQ*4+512;
__device__ __forceinline__ void glds16(const void*gsrc,unsigned lds_dst){unsigned keep;
  asm volatile("s_mov_b32 %0, m0\n\ts_mov_b32 m0, %2\n\ts_nop 0\n\tglobal_load_lds_dwordx4 %1, off\n\ts_mov_b32 m0, %0":"=&s"(keep):"v"(gsrc),"s"(lds_dst):"memory");}
__device__ __forceinline__ float max3f(float a,float b,float c){float r;asm("v_max3_f32 %0, %1, %2, %3":"=v"(r):"v"(a),"v"(b),"v"(c));return r;}
__device__ __forceinline__ float max2f(float a,float b){float r;asm("v_max_f32_e32 %0, %1, %2":"=v"(r):"v"(a),"v"(b));return r;}
__device__ __forceinline__ float fadd_s(float a,float b){float r;asm("v_add_f32_e32 %0, %1, %2":"=v"(r):"v"(a),"v"(b));return r;}
__device__ __forceinline__ float fsub_s(float a,float b){float r;asm("v_sub_f32_e32 %0, %1, %2":"=v"(r):"v"(a),"v"(b));return r;}
typedef float f32x2_t __attribute__((ext_vector_type(2))); typedef __bf16 bf16x2_t __attribute__((ext_vector_type(2)));
__device__ __forceinline__ unsigned cvtpk_s(float lo,float hi){f32x2_t v={lo,hi};bf16x2_t b=__builtin_convertvector(v,bf16x2_t);return __builtin_bit_cast(unsigned,b);}
#define WAIT_BAR(N) asm volatile("s_waitcnt vmcnt(" #N ") lgkmcnt(0)\n\ts_barrier":::"memory")
__device__ __forceinline__ void split3(float x,unsigned&h,unsigned&m,unsigned&l){
  const unsigned u=__float_as_uint(x)&0xffff0000u; const float r1=x-__uint_as_float(u);
  const unsigned u1=__float_as_uint(r1)&0xffff0000u; const float r2=r1-__uint_as_float(u1);
  h=u>>16; m=u1>>16; l=__float_as_uint(r2)>>16; }
__device__ __forceinline__ bf16x8 make_qx(float base,int hi){ unsigned h,m,l; split3(base,h,m,l); u32x4 w; w.x=h|(m<<16); w.y=l|0x3f800000u; w.z=0x3f803f80u; w.w=0u; if(hi){w.x=0u;w.y=0u;w.z=0u;} return __builtin_bit_cast(bf16x8,w); }
__device__ __forceinline__ bf16x8 make_kx(float ck,int hi){ unsigned h,m,l; split3(-ck,h,m,l); u32x4 w; w.x=0x3f803f80u; w.y=0x3f80u|(h<<16); w.z=m|(l<<16); w.w=0u; if(hi){w.x=0u;w.y=0u;w.z=0u;} return __builtin_bit_cast(bf16x8,w); }

__device__ __forceinline__ void qkt(f32x16&p0,f32x16&p1,const char*Kslot,const bf16x8*qr,bf16x8 qx,bf16x8 kx0,bf16x8 kx1,int r32,int hi){
  const char*kb=Kslot+hi*1024+r32*16; const f32x16 z=f32x16{};
  p0=__builtin_amdgcn_mfma_f32_32x32x16_bf16(kx0,qx,z,0,0,0);p1=__builtin_amdgcn_mfma_f32_32x32x16_bf16(kx1,qx,z,0,0,0);
  #pragma unroll
  for(int d0=0;d0<4;++d0){
    const bf16x8 b0=*reinterpret_cast<const bf16x8*>(kb+d0*2048);
    const bf16x8 b1=*reinterpret_cast<const bf16x8*>(kb+d0*2048+512);
    p0=__builtin_amdgcn_mfma_f32_32x32x16_bf16(b0,qr[d0],p0,0,0,0);p1=__builtin_amdgcn_mfma_f32_32x32x16_bf16(b1,qr[d0],p1,0,0,0);}
}
typedef __attribute__((address_space(3))) const char* lds_cptr;
typedef short v4i16_t __attribute__((ext_vector_type(4)));
__device__ __forceinline__ void kload8(bf16x8*kf,lds_cptr kp){
  kf[0]=*(const __attribute__((address_space(3))) bf16x8*)(kp);      kf[1]=*(const __attribute__((address_space(3))) bf16x8*)(kp+512);
  kf[2]=*(const __attribute__((address_space(3))) bf16x8*)(kp+2048); kf[3]=*(const __attribute__((address_space(3))) bf16x8*)(kp+2560);
  kf[4]=*(const __attribute__((address_space(3))) bf16x8*)(kp+4096); kf[5]=*(const __attribute__((address_space(3))) bf16x8*)(kp+4608);
  kf[6]=*(const __attribute__((address_space(3))) bf16x8*)(kp+6144); kf[7]=*(const __attribute__((address_space(3))) bf16x8*)(kp+6656);
}
__device__ __forceinline__ void kload2(bf16x8*kf,lds_cptr kp,int j){ kf[2*j]=*(const __attribute__((address_space(3))) bf16x8*)(kp+j*2048); kf[2*j+1]=*(const __attribute__((address_space(3))) bf16x8*)(kp+j*2048+512); }
__device__ __forceinline__ s16x4 vtr(lds_cptr p){ return __builtin_bit_cast(s16x4,__builtin_amdgcn_ds_read_tr16_b64_v4i16((__attribute__((address_space(3))) v4i16_t*)p)); }
__device__ __forceinline__ float rowmax(const f32x16&p0,const f32x16&p1){
  float a=max3f(p0[0],p0[1],p1[0]),b=max3f(p0[2],p0[3],p1[1]);a=max3f(a,p1[2],p1[3]);
  #pragma unroll
  for(int r=4;r<16;r+=4){a=max3f(a,p0[r],p0[r+1]);b=max3f(b,p0[r+2],p0[r+3]);a=max3f(a,p1[r],p1[r+1]);b=max3f(b,p1[r+2],p1[r+3]);}
  const float m=max2f(a,b);
  auto rr=__builtin_amdgcn_permlane32_swap(__float_as_uint(m),__float_as_uint(m),false,false);
  return max2f(__uint_as_float(rr[0]),__uint_as_float(rr[1]));
}
__device__ __forceinline__ void pv(f32x16*o,int vb,bf16x8 pa0,bf16x8 pa1,bf16x8 pa2,bf16x8 pa3){
  #pragma unroll
  for(int d0=0;d0<2;++d0){s16x4 lo[4],hi[4];
    #pragma unroll
    for(int ks=0;ks<4;++ks){
      asm volatile("ds_read_b64_tr_b16 %0,%1 offset:%c2":"=&v"(lo[ks]):"v"(vb),"i"(d0*4096+ks*1024):"memory");
      asm volatile("ds_read_b64_tr_b16 %0,%1 offset:%c2":"=&v"(hi[ks]):"v"(vb),"i"(d0*4096+ks*1024+512):"memory");}
    asm volatile("s_waitcnt lgkmcnt(0)":::"memory");SBAR();
    #define PK(k) (bf16x8){lo[k][0],lo[k][1],lo[k][2],lo[k][3],hi[k][0],hi[k][1],hi[k][2],hi[k][3]}
    o[d0]=__builtin_amdgcn_mfma_f32_32x32x16_bf16(pa0,PK(0),o[d0],0,0,0);
    o[d0]=__builtin_amdgcn_mfma_f32_32x32x16_bf16(pa1,PK(1),o[d0],0,0,0);
    o[d0]=__builtin_amdgcn_mfma_f32_32x32x16_bf16(pa2,PK(2),o[d0],0,0,0);
    o[d0]=__builtin_amdgcn_mfma_f32_32x32x16_bf16(pa3,PK(3),o[d0],0,0,0);
    #undef PK
  }
}
#define ATTN_STORE16(p,v) (*(u32x4*)(p)=(v))
template<int THRL> __device__ __forceinline__ void attn_unit(int b,int h,int qb,const bf16*Q,const bf16*__restrict__ K,const bf16*__restrict__ V,const bf16*__restrict__ CZ,bf16*O,const float*__restrict__ c2g,int ts,float ub,char*shm){
  int tid=threadIdx.x; asm volatile("":"+v"(tid));
  const int lane=tid&63,r32=lane&31,hi=lane>>5; const int wid=__builtin_amdgcn_readfirstlane(tid>>6);
  const long rowbase=(long)b*SEQ; const int q0=qb*QB;
  const bf16*Qw=Q+(rowbase+q0+wid*QBLK)*DM+h*D;
  const bf16*Kh=K+(rowbase+(long)ts*KVBLK)*DM+h*D,*Vh=V+(rowbase+(long)ts*KVBLK)*DM+h*D;
  const unsigned lds0=(unsigned)(uintptr_t)shm;
  float*wsf=(float*)(shm+LDS_WS)+wid*64;
  float*c2l=(float*)(shm+LDS_C2);
  const bf16*ksrc=Kh+(long)lane*DM+wid*8;
  const bf16*vsrc=Vh+(long)(16*(wid&3)+(lane>>2))*DM+(wid>>2)*32+(lane&3)*8;
  const unsigned kdst=lds0+LDS_K+wid*1024, vdst=lds0+LDS_V+wid*1024;
  #define DMA_K(t,slot) glds16(ksrc+(long)(t)*KVBLK*DM,(unsigned)__builtin_amdgcn_readfirstlane(kdst+(slot)))
  #define DMA_V(t,slot) glds16(vsrc+(long)(t)*KVBLK*DM,(unsigned)__builtin_amdgcn_readfirstlane(vdst+(slot)))
  const int vb0=(int)(lds0+LDS_V)+((lane>>4)&1)*32+(lane&3)*8+(4*hi+((lane&15)>>2))*64;
  const char*Kbase=shm+LDS_K; bf16x8 kf[8];
  const lds_cptr shm3=(lds_cptr)shm; const lds_cptr kp0=shm3+LDS_K+hi*1024+r32*16; const lds_cptr vp0=shm3+LDS_V+((lane>>4)&1)*32+(lane&3)*8+(4*hi+((lane&15)>>2))*64;
  const int NT=(q0+QB)/KVBLK-ts;
  DMA_K(0,0);DMA_V(0,0);DMA_K(1,SLOTB);
  { const int kb0=ts*KVBLK,n_=q0+QB-kb0,i0=tid*4,i1=tid*4+NW*64*4; f32x4 a0=f32x4{0.f,0.f,0.f,0.f},a1=a0; if(i0<n_)a0=*(const f32x4*)(c2g+kb0+i0); if(i1<n_)a1=*(const f32x4*)(c2g+kb0+i1); if(i0<n_)*(f32x4*)(c2l+i0)=a0; if(i1<n_)*(f32x4*)(c2l+i1)=a1; }
  bf16x8 qr[4];
  #pragma unroll
  for(int d0=0;d0<4;++d0)qr[d0]=*reinterpret_cast<const bf16x8*>(&Qw[(long)r32*DM+d0*16+hi*8]);
    float mhat=ub,l_reg=0.f;f32x16 o[2];o[0]=f32x16{};o[1]=f32x16{};
  const int qrel=wid*QBLK+r32;
  #define CMASK(P0,P1,t) do{int jb_=(t)-(NT-4); if(jb_>=0)cmask(P0,P1,jb_,qrel,hi);}while(0)
  bool resc=false;
  bf16x8 qx; float cq2;
  #define START(P0,P1) do{ resc=false; \
    _Pragma("unroll") for(int r=0;r<16;++r)P0[r]=__builtin_amdgcn_exp2f(P0[r]); }while(0)
  #define RESC() do{}while(0)
  f32x16 pA0,pA1,pB0,pB1;
  int sl_prev=0,sl_cur=0,sl_next=SLOTB;
  #define ROT() do{sl_prev=sl_cur;sl_cur=sl_next;sl_next=(sl_next==(NSLOT-1)*SLOTB)?0:sl_next+SLOTB;}while(0)
  DMA_K(2,2*SLOTB);
  WAIT_BAR(3);
  cq2=c2l[q0+qrel-ts*KVBLK]; qx=make_qx(cq2-mhat,hi);
  float ck0=c2l[r32],ck1=c2l[32+r32];
  { const bf16x8 kx0=make_kx(ck0,hi),kx1=make_kx(ck1,hi);
    qkt(pA0,pA1,Kbase,qr,qx,kx0,kx1,r32,hi); }
  asm volatile("s_nop 15\n\ts_nop 7":"+v"(pA0),"+v"(pA1));CMASK(pA0,pA1,0);
  ck0=c2l[64+r32];ck1=c2l[96+r32];
  START(pA0,pA1);
  _Pragma("unroll") for(int r=0;r<16;++r)pA1[r]=__builtin_amdgcn_exp2f(pA1[r]);
  WAIT_BAR(0);
  DMA_K(3,0);DMA_V(1,SLOTB);
  ROT();
  kload8(kf,kp0+sl_cur);
  WAIT_BAR(2);
  s16x4 vlo[8],vhi[8]; u32x4 pw0,pw1,pw2,pw3;
  #define PKW(P,B) cvtpk_s(P[B],P[B+1])
  #define PAF(k) __builtin_bit_cast(bf16x8,pw##k)
  #define VFR(i) (bf16x8){vlo[i][0],vlo[i][1],vlo[i][2],vlo[i][3],vhi[i][0],vhi[i][1],vhi[i][2],vhi[i][3]}
  #define PIN(x) asm volatile("":"+v"(x))
  #define MX3(a,b,c) __builtin_fmaxf(__builtin_fmaxf((a),(b)),(c))
  #define GAPA(MF,A0,A1,A2,A3,W0,W1,PW) do{ MF; sacc+=A0; sacc+=A1; sacc+=A2; sacc+=A3; PIN(sacc); W0; W1; PIN(PW); SBAR(); }while(0)
  #define EX(v) __builtin_amdgcn_exp2f(v)
  #define GAPB(MF,X,B) do{ MF; X[B]=EX(X[B]); X[B+1]=EX(X[B+1]); X[B+2]=EX(X[B+2]); X[B+3]=EX(X[B+3]); PIN(X); SBAR(); }while(0)
  #define VRD(i) do{ vlo[i]=vtr(vp_+(((i)>>2)*4096+((i)&3)*1024)); vhi[i]=vtr(vp_+(((i)>>2)*4096+((i)&3)*1024+512)); }while(0)
  #define KRD(G,j) do{ if(G){ kload2(kf,kp0+sl_next,j); SBAR(); } }while(0)
  #define STEP(C0,C1,P0,P1,t,GK,GV,GL) do{ SBAR(); \
    const lds_cptr vp_=vp0+sl_prev; \
    { const bf16x8 kx0_=make_kx(ck0,hi),kx1_=make_kx(ck1,hi); const f32x16 z_=f32x16{}; \
      C0=__builtin_amdgcn_mfma_f32_32x32x16_bf16(kx0_,qx,z_,0,0,0); C1=__builtin_amdgcn_mfma_f32_32x32x16_bf16(kx1_,qx,z_,0,0,0); } SBAR(); \
    VRD(0); SBAR(); float sacc=(P0[0]+P0[1]); \
    GAPA(C0=__builtin_amdgcn_mfma_f32_32x32x16_bf16(kf[0],qr[0],C0,0,0,0), P0[2],P0[3],P0[4],P0[5],     pw0[0]=PKW(P0,0), pw0[1]=PKW(P0,2), pw0); \
    VRD(4); SBAR(); GAPA(C1=__builtin_amdgcn_mfma_f32_32x32x16_bf16(kf[1],qr[0],C1,0,0,0), P0[6],P0[7],P0[8],P0[9],     pw0[2]=PKW(P0,4), pw0[3]=PKW(P0,6), pw0); \
    VRD(1); SBAR(); GAPA(C0=__builtin_amdgcn_mfma_f32_32x32x16_bf16(kf[2],qr[1],C0,0,0,0),   P0[10],P0[11],P0[12],P0[13], pw1[0]=PKW(P0,8), pw1[1]=PKW(P0,10), pw1); \
    VRD(5); SBAR(); GAPA(C1=__builtin_amdgcn_mfma_f32_32x32x16_bf16(kf[3],qr[1],C1,0,0,0),   P0[14],P0[15],P1[0],P1[1],   pw1[2]=PKW(P0,12),pw1[3]=PKW(P0,14), pw1); \
    VRD(2); SBAR(); GAPA(C0=__builtin_amdgcn_mfma_f32_32x32x16_bf16(kf[4],qr[2],C0,0,0,0),   P1[2],P1[3],P1[4],P1[5],     pw2[0]=PKW(P1,0), pw2[1]=PKW(P1,2), pw2); \
    VRD(6); SBAR(); GAPA(C1=__builtin_amdgcn_mfma_f32_32x32x16_bf16(kf[5],qr[2],C1,0,0,0),   P1[6],P1[7],P1[8],P1[9],     pw2[2]=PKW(P1,4), pw2[3]=PKW(P1,6), pw2); \
    VRD(3); SBAR(); GAPA(C0=__builtin_amdgcn_mfma_f32_32x32x16_bf16(kf[6],qr[3],C0,0,0,0),   P1[10],P1[11],P1[12],P1[13], pw3[0]=PKW(P1,8), pw3[1]=PKW(P1,10), pw3); \
    VRD(7); SBAR(); GAPA(C1=__builtin_amdgcn_mfma_f32_32x32x16_bf16(kf[7],qr[3],C1,0,0,0),   P1[14],P1[15],0.f,0.f,       pw3[2]=PKW(P1,12),pw3[3]=PKW(P1,14), pw3); \
    l_reg+=sacc; \
    if(GK){DMA_K((t)+3,sl_cur);} if(GV){DMA_V((t)+1,sl_next);} \
    if(GL){ ck0=c2l[64*((t)+1)+r32]; ck1=c2l[64*((t)+1)+32+r32]; } \
    CMASK(C0,C1,t); \
    SBAR(); \
    GAPB(o[0]=__builtin_amdgcn_mfma_f32_32x32x16_bf16(PAF(0),VFR(0),o[0],0,0,0), C0,0); \
    GAPB(o[1]=__builtin_amdgcn_mfma_f32_32x32x16_bf16(PAF(0),VFR(4),o[1],0,0,0), C0,4); \
    KRD(GL,0); GAPB(o[0]=__builtin_amdgcn_mfma_f32_32x32x16_bf16(PAF(1),VFR(1),o[0],0,0,0), C0,8); \
    KRD(GL,1); GAPB(o[1]=__builtin_amdgcn_mfma_f32_32x32x16_bf16(PAF(1),VFR(5),o[1],0,0,0), C0,12); \
    KRD(GL,2); GAPB(o[0]=__builtin_amdgcn_mfma_f32_32x32x16_bf16(PAF(2),VFR(2),o[0],0,0,0), C1,0); \
    KRD(GL,3); GAPB(o[1]=__builtin_amdgcn_mfma_f32_32x32x16_bf16(PAF(2),VFR(6),o[1],0,0,0), C1,4); \
    GAPB(o[0]=__builtin_amdgcn_mfma_f32_32x32x16_bf16(PAF(3),VFR(3),o[0],0,0,0), C1,8); \
    GAPB(o[1]=__builtin_amdgcn_mfma_f32_32x32x16_bf16(PAF(3),VFR(7),o[1],0,0,0), C1,12); \
    }while(0)
  int t=1;
  #undef CMASK
  #define CMASK(P0,P1,t) do{}while(0)
  for(;t+5<NT;t+=2){
    STEP(pB0,pB1,pA0,pA1,t,true,true,true);     WAIT_BAR(2); RESC(); ROT();
    STEP(pA0,pA1,pB0,pB1,t+1,true,true,true);   WAIT_BAR(2); RESC(); ROT();
  }
  #undef CMASK
  #define CMASK(P0,P1,t) do{int jb_=(t)-(NT-4); if(jb_>=0)cmask(P0,P1,jb_,qrel,hi);}while(0)
  #define ENDW(tt) do{ if((tt)+3<NT){WAIT_BAR(2);} else if((tt)+2<NT){WAIT_BAR(1);} else {WAIT_BAR(0);} }while(0)
  for(;t+1<NT;t+=2){
    STEP(pB0,pB1,pA0,pA1,t,(t+3<NT),(t+1<NT),(t+1<NT));       ENDW(t);   RESC(); ROT();
    STEP(pA0,pA1,pB0,pB1,t+1,(t+4<NT),(t+2<NT),(t+2<NT));     ENDW(t+1); RESC(); ROT();
  }
  { const bf16*czs=CZ+(rowbase+q0+wid*QBLK+(lane>>3))*DM+h*D+(lane&7)*8; const unsigned czd=lds0+LDS_OST+wid*4096;
    _Pragma("unroll") for(int k=0;k<4;++k)glds16(czs+(long)(8*k)*DM,(unsigned)__builtin_amdgcn_readfirstlane(czd+k*1024)); }
  STEP(pB0,pB1,pA0,pA1,NT-1,false,false,false); RESC();
  { float sacc=pB0[0]+pB0[1]; _Pragma("unroll") for(int r=2;r<16;++r)sacc+=pB0[r]; _Pragma("unroll") for(int r=0;r<16;++r)sacc+=pB1[r]; l_reg+=sacc;
    pw0=(u32x4){PKW(pB0,0),PKW(pB0,2),PKW(pB0,4),PKW(pB0,6)};pw1=(u32x4){PKW(pB0,8),PKW(pB0,10),PKW(pB0,12),PKW(pB0,14)};pw2=(u32x4){PKW(pB1,0),PKW(pB1,2),PKW(pB1,4),PKW(pB1,6)};pw3=(u32x4){PKW(pB1,8),PKW(pB1,10),PKW(pB1,12),PKW(pB1,14)};
    SBAR(); pv(o,vb0+sl_cur,PAF(0),PAF(1),PAF(2),PAF(3)); }
  #undef PKW
  #undef PAF
  #undef VFR
  #undef PIN
  #undef MX3
  #undef GAPA
  #undef GAPB
  #undef EX
  #undef VRD
  #undef KRD
  #undef STEP
  #undef ENDW
  {auto rr=__builtin_amdgcn_permlane32_swap(__float_as_uint(l_reg),__float_as_uint(l_reg),false,false);l_reg=__uint_as_float(rr[0])+__uint_as_float(rr[1]);}
  if(hi==0)wsf[32+r32]=l_reg;asm volatile("s_waitcnt lgkmcnt(0)":::"memory");
  bf16*Ow=O+(rowbase+q0+wid*QBLK)*DM+h*D;
  { bf16*stg=(bf16*)(shm+LDS_OST)+wid*2048; const unsigned short*Cw=(const unsigned short*)stg;
    asm volatile("s_waitcnt vmcnt(0)":::"memory");
    #pragma unroll
    for(int r=0;r<16;++r){const int orow=crow(r,hi); const float rl=__builtin_amdgcn_rcpf(wsf[32+orow]);
      #pragma unroll
      for(int d0=0;d0<2;++d0){ const float cz=__uint_as_float((unsigned)Cw[orow*64+d0*32+r32]<<16); stg[orow*64+d0*32+r32]=__float2bfloat16(o[d0][r]*rl*cz);} }
    asm volatile("s_waitcnt lgkmcnt(0)":::"memory");
    #pragma unroll
    for(int i=0;i<4;++i){const int row=i*8+(lane>>3),ch=lane&7; const u32x4 v=*(const u32x4*)(stg+row*64+ch*8); ATTN_STORE16(Ow+(long)row*DM+ch*8,v);} }
  asm volatile("s_waitcnt lgkmcnt(0)\n\ts_barrier":::"memory");
  #undef DMA_K
  #undef DMA_V
  #undef CMASK
  #undef START
  #undef RESC
  #undef ROT
}
#undef SBAR
#undef WAIT_BAR
}

typedef float f32x2 __attribute__((ext_vector_type(2)));
__device__ __forceinline__ void p2_conv(Frame& F, int l, int unit, bf16_t* outb, const bool pv_ = false) {
    const int tid = F.tid, lane = F.lane, w = F.wave;
    const size_t row0 = (size_t)unit * 64; const int tseq0 = (int)(row0 % SEQ);
    const bf16_t* AG = (const bf16_t*)(F.P.ws + WS_B3); const bf16_t* B0 = (const bf16_t*)(F.P.ws + WS_B0);
    LAS unsigned char* tile = F.lds + RING_OFF;
    LAS float* wl = (LAS float*)(tile + 94 * 1024);
    {
        const float* cwg = F.P.conv_w + (size_t)l * CW * DA;
        u32x4 tv[12]; f32x4 wv4[8];
#pragma unroll
        for (int k = 0; k < 12; ++k) { const int c = tid + 512 * k, r = c >> 6, ch = c & 63, tr = r - (CW - 1); const bool valid = (c < 94 * 64) && (tseq0 + tr >= 0);
            tv[k] = (u32x4){0u, 0u, 0u, 0u}; if (valid) tv[k] = *(const u32x4*)(AG + (size_t)((long)row0 + tr) * 1024 + ch * 8); }
#pragma unroll
        for (int k = 0; k < 8; ++k) { const int c = tid + 512 * k; wv4[k] = (f32x4){0.f, 0.f, 0.f, 0.f}; if (c < CW * DA / 4) wv4[k] = *(const f32x4*)(cwg + 4 * c); }
#pragma unroll
        for (int k = 0; k < 12; ++k) { const int c = tid + 512 * k, r = c >> 6, ch = c & 63; if (c < 94 * 64) *(LAS u32x4*)(tile + r * 1024 + ch * 16) = tv[k]; }
#pragma unroll
        for (int k = 0; k < 8; ++k) { const int c = tid + 512 * k; if (c < CW * DA / 4) *(LAS f32x4*)(wl + 4 * c) = wv4[k]; }
    }
    __syncthreads();
    if (PROBE_CONV == 2 && pv_) { __syncthreads(); return; }
    f32x2 out[4][8]; float s1[8], s2[8];
#pragma unroll
    for (int o = 0; o < 8; ++o) { s1[o] = 0.f; s2[o] = 0.f; }
#pragma unroll
    for (int i = 0; i < 4; ++i) {
        __builtin_amdgcn_sched_barrier(0);
        int p = lane + 64 * i; asm volatile("" : "+v"(p));
        const LAS float* cw = wl + 2 * p;
        f32x2 wv[CW];
#pragma unroll
        for (int j = 0; j < CW; ++j) wv[j] = *(const LAS f32x2*)(cw + j * DA);
        const f32x2 cb = *(const f32x2*)(F.P.conv_b + l * DA + 2 * p);
        const LAS unsigned* tp = (const LAS unsigned*)(tile + (8 * w) * 1024 + 4 * p);
        f32x2 win[16];
#pragma unroll
        for (int k = 0; k < 16; ++k) { const unsigned u = tp[k * 256]; win[k] = (f32x2){__uint_as_float(u << 16), __uint_as_float(u & 0xffff0000u)}; }
#pragma unroll
        for (int o = 0; o < 8; ++o) out[i][o] = cb;
        __builtin_amdgcn_sched_barrier(0);
#pragma unroll
        for (int j = 0; j < CW; ++j) {
            if (!(PROBE_CONV == 1 && pv_))
#pragma unroll
            for (int o = 0; o < 8; ++o) out[i][o] += wv[j] * win[(j + o) & 15];
            asm volatile("" : "+v"(out[i][0]), "+v"(out[i][1]), "+v"(out[i][2]), "+v"(out[i][3]), "+v"(out[i][4]), "+v"(out[i][5]), "+v"(out[i][6]), "+v"(out[i][7]));
            if (j + 16 < 38) { const LAS unsigned* tq = tp; asm volatile("" : "+v"(tq)); const unsigned u = tq[(j + 16) * 256]; win[j & 15] = (f32x2){__uint_as_float(u << 16), __uint_as_float(u & 0xffff0000u)}; }
            __builtin_amdgcn_sched_barrier(0);
        }
#pragma unroll
        for (int o = 0; o < 8; ++o) { s1[o] += out[i][o].x + out[i][o].y; s2[o] += out[i][o].x * out[i][o].x + out[i][o].y * out[i][o].y; }
    }
    unsigned az[4][8];
#pragma unroll
    for (int i = 0; i < 4; ++i)
#pragma unroll
        for (int o = 0; o < 8; ++o) az[i][o] = *(const unsigned*)(B0 + (row0 + 8 * w + o) * 1024 + 2 * (lane + 64 * i));
#pragma unroll
    for (int o = 0; o < 8; ++o) { s1[o] = wsum(s1[o]); s2[o] = wsum(s2[o]); }
#pragma unroll
    for (int i = 0; i < 4; ++i) {
        const int p = lane + 64 * i;
        const f32x2 gg = *(const f32x2*)(F.P.cn_g + l * DA + 2 * p), be = *(const f32x2*)(F.P.cn_b + l * DA + 2 * p);
#pragma unroll
        for (int o = 0; o < 8; ++o) { const float mu = s1[o] * (1.f / DA), ex2 = s2[o] * (1.f / DA); const float rstd = rsqrtf(fmaxf(ex2 - mu * mu, 0.f) + EPS);
            f32x2 y = (out[i][o] - mu) * rstd * gg + be; y.x = y.x * fsigm(y.x); y.y = y.y * fsigm(y.y);
            *(unsigned*)(outb + (row0 + 8 * w + o) * 1024 + 2 * p) = cvt_pk_bf16(y.x * __uint_as_float(az[i][o] << 16), y.y * __uint_as_float(az[i][o] & 0xffff0000u)); }
    }
    __syncthreads();
}
__device__ __forceinline__ void p2_gmlp(Frame& F, int l, int unit, bf16_t* outb) {
    constexpr int VP = 528;
    const int tid = F.tid, lane = F.lane, w = F.wave, fr = lane & 15, fq = lane >> 4, ch = unit >> 1, gp = unit & 1, c0 = 256 * gp; const size_t row0 = (size_t)ch * CHK;
    LAS unsigned char* vr = F.lds + RING_OFF;
    const bf16_t* V = (const bf16_t*)(F.P.ws + WS_B3) + 512 + c0; const bf16_t* U = (const bf16_t*)(F.P.ws + WS_B0) + 512 + c0;
    const float* vss = (const float*)(F.P.ws + WS_VSS); const float* gn = F.P.gn_g + l * DB + c0;
    const size_t t = row0 + 16 * w + fr;
    unsigned long long uu[16];
#pragma unroll
    for (int n = 0; n < 16; ++n) uu[n] = *(const unsigned long long*)(U + t * 1024 + 16 * n + 4 * fq);
    bf16x8 wf[2][4];
#pragma unroll
    for (int g2 = 0; g2 < 2; ++g2)
#pragma unroll
        for (int ks = 0; ks < 4; ++ks) wf[g2][ks] = *(const bf16x8*)((const bf16_t*)(F.P.ws + WS_WSB) + ((size_t)(l * NG + 2 * gp + g2) * CHK + 16 * w + fr) * CHK + 32 * ks + 8 * fq);
    const float bs0 = F.P.b_s[(size_t)(l * NG + 2 * gp) * CHK + 16 * w + fr], bs1 = F.P.b_s[(size_t)(l * NG + 2 * gp + 1) * CHK + 16 * w + fr];
    { const int c8 = (tid & 31) * 8, sb = tid >> 5;
      const f32x4 g0 = *(const f32x4*)(gn + c8), g1 = *(const f32x4*)(gn + c8 + 4);
      u32x4 raw[8]; f32x4 qa[8], qb[8];
#pragma unroll
      for (int k = 0; k < 8; ++k) { const size_t s = row0 + sb + 16 * k; raw[k] = *(const u32x4*)(V + s * 1024 + c8); qa[k] = *(const f32x4*)(vss + s * 8); qb[k] = *(const f32x4*)(vss + s * 8 + 4); }
#pragma unroll
      for (int k = 0; k < 8; ++k) { const float ss = ((qa[k].x + qa[k].y) + (qa[k].z + qa[k].w)) + ((qb[k].x + qb[k].y) + (qb[k].z + qb[k].w)); const float rv = rsqrtf(ss * (1.f / DB) + EPS);
          f32x4 v0, v1; unpack8(raw[k], v0, v1); v0 = v0 * rv * g0; v1 = v1 * rv * g1;
          *(LAS u32x4*)(vr + (sb + 16 * k) * VP + c8 * 2) = pack8(v0, v1); } }
    __syncthreads();
    f32x4 acc[16];
#pragma unroll
    for (int n = 0; n < 16; ++n) acc[n] = (f32x4){0.f, 0.f, 0.f, 0.f};
    typedef short v4i16_t __attribute__((ext_vector_type(4)));
    const LAS unsigned char* tb = vr + (8 * fq + (fr >> 2)) * VP + (fr & 3) * 8;
#pragma unroll
    for (int ks = 0; ks < 4; ++ks) {
        if (32 * ks <= 16 * w + 15) {
#pragma unroll
            for (int n = 0; n < 16; ++n) {
                const v4i16_t lo = __builtin_amdgcn_ds_read_tr16_b64_v4i16((LAS v4i16_t*)(tb + (32 * ks) * VP + 32 * n));
                const v4i16_t hi = __builtin_amdgcn_ds_read_tr16_b64_v4i16((LAS v4i16_t*)(tb + (32 * ks + 4) * VP + 32 * n));
                const bf16x8 vf = (bf16x8){lo[0], lo[1], lo[2], lo[3], hi[0], hi[1], hi[2], hi[3]};
                acc[n] = __builtin_amdgcn_mfma_f32_16x16x32_bf16(vf, wf[n >> 3][ks], acc[n], 0, 0, 0); }
        }
    }
#pragma unroll
    for (int n = 0; n < 16; ++n) { const float bs = n < 8 ? bs0 : bs1;
        const unsigned u0 = (unsigned)uu[n], u1 = (unsigned)(uu[n] >> 32);
        const float o0 = __uint_as_float(u0 << 16) * (acc[n][0] + bs), o1 = __uint_as_float(u0 & 0xffff0000u) * (acc[n][1] + bs);
        const float o2 = __uint_as_float(u1 << 16) * (acc[n][2] + bs), o3 = __uint_as_float(u1 & 0xffff0000u) * (acc[n][3] + bs);
        *(unsigned long long*)(outb + 512 + c0 + t * 1024 + 16 * n + 4 * fq) = (unsigned long long)cvt_pk_bf16(o0, o1) | ((unsigned long long)cvt_pk_bf16(o2, o3) << 32); }
    __syncthreads();
}

__global__ void __launch_bounds__(NWAVES * 64, 2) mk_fwd(Args args) {
    extern __shared__ __attribute__((aligned(16))) unsigned char lds[];
    Frame F;
    F.lds = (LAS unsigned char*)lds;
    volatile LAS unsigned* MISC = (volatile LAS unsigned*)(F.lds + MISC_OFF);
    F.tid = threadIdx.x; F.lane = F.tid & 63; F.wave = __builtin_amdgcn_readfirstlane(F.tid >> 6);
    F.G = gridDim.x; { const int bx = blockIdx.x; F.vcu = (F.G % 8 == 0) ? (bx % 8) * (F.G / 8) + bx / 8 : bx; }
    F.P.x = args.in[0]; F.P.norm_g = args.in[1]; F.P.w_in = args.in[2]; F.P.b_gate = args.in[3]; F.P.conv_w = args.in[4]; F.P.conv_b = args.in[5]; F.P.cn_g = args.in[6]; F.P.cn_b = args.in[7]; F.P.w_a = args.in[8];
    F.P.gn_g = args.in[9]; F.P.w_s = args.in[10]; F.P.b_s = args.in[11]; F.P.w_b = args.in[12]; F.P.qn_g = args.in[13]; F.P.kn_g = args.in[14]; F.P.b_f = args.in[15]; F.P.w_c = args.in[16]; F.P.w_out = args.in[17];
    F.P.out = args.out; F.P.ws = args.ws;
    gu32* ctl = (gu32*)(args.ws + WS_CTL);
    for (int u = F.tid; u < (LDS_BYTES - LDSCTL_OFF) / 4; u += NWAVES * 64) ((LAS unsigned*)(F.lds + LDSCTL_OFF))[u] = 0u;
    __syncthreads();
    XcdBarrier bar = xcd_barrier_post((unsigned*)(ctl + CW_BAR) + args.li * XCD_BAR_WORDS, MISC + 8);

#if PROBE_TS >= 0
    if (blockIdx.x == 0 && threadIdx.x == 0) { ((unsigned long long*)(args.ws + WS_TS + 4096))[2] = 0ull; if (PROBE_TS == 99) ((unsigned long long*)(args.ws + WS_TS + 4096))[0] = __builtin_amdgcn_s_memrealtime(); }
#endif
    bool dup_done = false;
    for (int ph = args.ph_lo; ph < args.ph_hi;) {
        const int l = ph / 5, p = ph % 5;
#if PROBE_TS >= 0
        if (blockIdx.x == 0 && threadIdx.x == 0 && ph == PROBE_TS) ((unsigned long long*)(args.ws + WS_TS + 4096))[0] = __builtin_amdgcn_s_memrealtime();
        if (PROBE_TSW && blockIdx.x == 0 && threadIdx.x == 0 && ph > PROBE_TS && ((unsigned long long*)(args.ws + WS_TS + 4096))[2] == 0ull) { ((unsigned long long*)(args.ws + WS_TS + 4096))[1] = __builtin_amdgcn_s_memrealtime(); ((unsigned long long*)(args.ws + WS_TS + 4096))[2] = 1ull; }
#endif
        const bool dummy = (PROBE_DUP >= 0) && p == PROBE_DUP && !dup_done;
        asm volatile("" : "+v"(F.tid)); F.lane = F.tid & 63;
        int bid = (int)blockIdx.x; asm volatile("" : "+s"(bid));
        unsigned char* ws = F.P.ws; unsigned char* wl = ws + WS_W + (size_t)l * W_LAYER;
        const float* xin = l == 0 ? F.P.x : F.P.out;
        if (p == 0) {
            if (l > 0) { ++ph; continue; }
            if (l == 0 && (!dummy || (PROBE_SUB & 1))) p0_weights(F);
            if (!dummy || (PROBE_SUB & 2)) p0_ln(F, l, xin);
        } else if (p == 1) {
            { pg8::TileOrder T0; T0.init(M, N1, F.G, bid); int pm_ = 0, pn_ = 0; (void)T0.tile(0, pm_, pn_);
              LAS float* Rt = (LAS float*)(F.lds + RT_OFF);
              if (F.tid < 256) { float r = 1.f; { const f32x4 q = *(const f32x4*)((const float*)(ws + WS_SSP) + ((size_t)pm_ * 256 + F.tid) * 4); r = rsqrtf(((q.x + q.y) + (q.z + q.w)) * (1.f / D) + EPS); } Rt[F.tid] = r; }
              __syncthreads(); }
            pg8::SchedG1 S; S.T.init(M, N1, F.G, bid); S.A = (const char*)(ws + WS_H); S.B = (const char*)(wl + WO_W1);
            pg8::EpiG1 E{(bf16_t*)(ws + WS_B0), (bf16_t*)(ws + WS_B1), (bf16_t*)(ws + WS_B2), (bf16_t*)(ws + WS_B3), (bf16_t*)(ws + WS_B4), (float*)(ws + WS_VSS), F.P.qn_g + l * HD, F.P.kn_g + l * HD, (const LAS float*)(F.lds + RT_OFF)};
            auto scan_hook = [&]() { if (bid < NB * NH) p1_scan(F, bid, l); };
            pg8::gemm_phase<pg8::EpiG1, pg8::SchedG1, false, pg8::PITCH * 2, false, decltype(scan_hook)>(F.lds + RING_OFF, S, E, scan_hook);
        } else if (p == 2) {
            for (int part = 0; part < 2; ++part) {
              asm volatile("" : "+v"(F.tid)); F.lane = F.tid & 63; asm volatile("" : "+s"(bid));
              if ((part == 0) == (((F.vcu >> 5) & 1) == 0)) {
            if (!dummy || (PROBE_SUB & 1)) p2_conv(F, l, bid, dummy ? (bf16_t*)(ws + WS_DUMMY) : (bf16_t*)(ws + WS_B0), dummy);
            if (!dummy || (PROBE_SUB & 2)) { bf16_t* ob = dummy ? (bf16_t*)(ws + WS_DUMMY) : (bf16_t*)(ws + WS_B0); p2_gmlp(F, l, bid, ob); }
              } else {
            if (!dummy || (PROBE_SUB & 4)) { const int bh = F.vcu >> 3, sq = F.vcu & 7; const attn_body::bf16* b1 = (const attn_body::bf16*)(ws + WS_B1); const attn_body::bf16* b2 = (const attn_body::bf16*)(ws + WS_B2);
              const float* c2g = (const float*)(ws + WS_CS) + (size_t)bh * SEQ; const int* tsg = (const int*)(ws + WS_TS) + bh * 16;
              float gqm = fabsf(F.P.qn_g[l * HD + F.lane]), gkm = fabsf(F.P.kn_g[l * HD + F.lane]);
#pragma unroll
              for (int o_ = 1; o_ < 64; o_ <<= 1) { gqm = fmaxf(gqm, __shfl_xor(gqm, o_)); gkm = fmaxf(gkm, __shfl_xor(gkm, o_)); }
              const float ub = 64.f * C2 * gqm * gkm * 1.01f;
              for (int i = 0; i < 2; ++i) { const int qb = i == 0 ? 15 - sq : sq; const int ts = __builtin_amdgcn_readfirstlane(tsg[qb]); attn_body::attn_unit<8>(bh / NH, bh % NH, qb, b1, b1 + 512, b2, b2 + 512, dummy ? (attn_body::bf16*)(ws + WS_DUMMY) : (attn_body::bf16*)(ws + WS_B1), c2g, ts, ub, (char*)lds + RING_OFF); } }
              }
            }
        } else if (p == 3) {
            pg8::TileOrder T; T.init(M, D, F.G, bid); int pm_ = 0, pn_ = 0; const bool ok_ = T.tile(0, pm_, pn_);
            unsigned char* ga = ws + (size_t)bid * 131072;
            unsigned char* gb = (unsigned char*)F.P.out + 16 * MiB + (size_t)bid * 131072 - WS_B4;
            { pg8::SchedGate S; S.pm = pm_; S.pn = pn_; S.ok = ok_; S.h8 = (const char*)F.P.out; S.wl = (const char*)wl;
              S.sbtop = (unsigned*)(ctl) + SB_TOP; S.want = MISC[9] * (unsigned)(l + 1); S.tmo = (unsigned*)(ctl) + CW_TMO;
              pg8::EpiMergeT<true> E{ga, gb, (bf16_t*)(ws + WS_MG), F.P.b_gate + (size_t)l * 3072, (const LAS float*)(F.lds + RT_OFF)};
              pg8::gemm_phase<pg8::EpiMergeT<true>, pg8::SchedGate, true, 1024>(F.lds + RING_OFF, S, E); }
            { asm volatile("" : "+v"(F.tid)); F.lane = F.tid & 63; asm volatile("" : "+s"(bid));
              pg8::SchedY S; S.pm = pm_; S.pn = pn_; S.ok = ok_; S.ws = (const char*)ws; S.wl = (const char*)wl;
              pg8::EpiMergeT<false> E{ga, gb, (bf16_t*)(ws + WS_MG), F.P.b_gate + (size_t)l * 3072, (const LAS float*)(F.lds + RT_OFF)};
              pg8::gemm_phase<pg8::EpiMergeT<false>, pg8::SchedY, false, pg8::PITCH * 2, true>(F.lds + RING_OFF, S, E); }
        } else {
            pg8::SchedG1 S; S.T.init(M, D, F.G, bid); S.A = (const char*)(ws + WS_MG); S.B = (const char*)(wl + WO_WO);
            if (l + 1 < NL) {
                pg8::EpiOutLN E{(const bf16_t*)(ws + WS_H), (bf16_t*)(ws + WS_H), F.P.norm_g + (size_t)(l + 1) * D, F.P.w_in + (size_t)(l + 1) * D * NIN + OC_F, (float*)(ws + WS_SSP), (float*)(ws + WS_FP), (unsigned char*)F.P.out};
                pg8::gemm_phase<pg8::EpiOutLN, pg8::SchedG1>(F.lds + RING_OFF, S, E);
            } else {
                pg8::EpiOutB E{(const bf16_t*)(ws + WS_H), dummy ? (float*)(ws + WS_B0) : F.P.out};
                pg8::gemm_phase<pg8::EpiOutB, pg8::SchedG1>(F.lds + RING_OFF, S, E);
            }
        }
#if PROBE_TS >= 0
        if (!PROBE_TSW && blockIdx.x == 0 && threadIdx.x == 0 && ph == PROBE_TS) ((unsigned long long*)(args.ws + WS_TS + 4096))[1] = __builtin_amdgcn_s_memrealtime();
#endif
        if (dummy) { dup_done = true; continue; }
        dup_done = false; ++ph;
        if (ph < args.ph_hi) { if (p == 2 && !PROBE_ANY) sb_arrive(bar, (unsigned*)ctl, (unsigned)(l + 1)); else xcd_barrier(bar); }
    }
#if PROBE_TS >= 0
    if (PROBE_TS == 99 && blockIdx.x == 0 && threadIdx.x == 0) ((unsigned long long*)(args.ws + WS_TS + 4096))[1] = __builtin_amdgcn_s_memrealtime();
    if (blockIdx.x == 0 && threadIdx.x == 0) { asm volatile("s_waitcnt vmcnt(0)" ::: "memory"); const unsigned long long* tsp = (const unsigned long long*)(args.ws + WS_TS + 4096); const float us = (float)(tsp[1] - tsp[0]) * 0.01f; args.out[0] += floorf(us * (1.f / PROBE_TSQ)) * (float)PROBE_TSQ * 1000.f; }
#endif
}

#ifndef MK_MODE
#define MK_MODE 2
#endif
extern "C" void kernel_launch(void* const* d_in, const int* in_sizes, int n_in, void* d_out, int out_size, void* d_ws, size_t ws_size, hipStream_t stream) {
    static int ok = 0;
    if (ok == 0) {
        if (n_in != 18 || in_sizes[0] != M * D || out_size != M * D || ws_size < WS_END) { fprintf(stderr, "kernel_launch: unexpected shapes (n_in %d in0 %d out %d ws %zu)\n", n_in, n_in > 0 ? in_sizes[0] : -1, out_size, ws_size); ok = -1; return; }
        const int tl = 64 * TLD * 4;
        (void)hipFuncSetAttribute((const void*)nv_gemm1, hipFuncAttributeMaxDynamicSharedMemorySize, tl);
        (void)hipFuncSetAttribute((const void*)nv_merge, hipFuncAttributeMaxDynamicSharedMemorySize, 2 * 64 * 256 * 4);
        (void)hipFuncSetAttribute((const void*)nv_gmlp, hipFuncAttributeMaxDynamicSharedMemorySize, 128 * 129 * 4);
        (void)hipFuncSetAttribute((const void*)nv_attn, hipFuncAttributeMaxDynamicSharedMemorySize, 4 * SEQ * 4);
        if (hipFuncSetAttribute((const void*)mk_fwd, hipFuncAttributeMaxDynamicSharedMemorySize, LDS_BYTES) != hipSuccess) { fprintf(stderr, "kernel_launch: hipFuncSetAttribute(mk_fwd) failed\n"); ok = -1; return; }
        int dev = 0, cus = 0; (void)hipGetDevice(&dev); (void)hipDeviceGetAttribute(&cus, hipDeviceAttributeMultiprocessorCount, dev);
        if (cus != 256) fprintf(stderr, "kernel_launch: note: %d CUs (built for 256)\n", cus);
        (void)hipGetLastError();
        ok = 1;
    }
    if (ok < 0) return;
    Ptrs P{};
    const float** pp = (const float**)&P;
    for (int i = 0; i < 18; ++i) pp[i] = (const float*)d_in[i];
    P.out = (float*)d_out; P.ws = (unsigned char*)d_ws;
    const int tl = 64 * TLD * 4;
#if MK_MODE == 0
    nv_prep<<<2048, 256, 0, stream>>>(P);
    for (int l = 0; l < NL; ++l) {
        const float* xin = l == 0 ? P.x : P.out;
        nv_ln<<<M / 4, 256, 0, stream>>>(P, l, xin);
        nv_scan<<<NB * NH, 256, 0, stream>>>(P);
        nv_gemm1<<<dim3(20, 256), 256, tl, stream>>>(P, l);
        nv_conv<<<M, 512, 0, stream>>>(P, l);
        nv_gmlp<<<dim3(128, 4), 256, 128 * 129 * 4, stream>>>(P, l);
        nv_attn<<<M * NH / 4, 256, 4 * SEQ * 4, stream>>>(P);
        nv_merge<<<dim3(4, 256), 256, 2 * 64 * 256 * 4, stream>>>(P, l);
        nv_out<<<dim3(4, 256), 256, 0, stream>>>(P, l, xin, P.out);
    }
#else
    (void)tl;
    if (hipMemsetAsync((char*)d_ws + WS_CTL, 0, CTL_ZERO_BYTES, stream) != hipSuccess) { fprintf(stderr, "kernel_launch: memset failed\n"); return; }
    Args a{};
    for (int i = 0; i < 18; ++i) a.in[i] = (const float*)d_in[i];
    a.out = (float*)d_out; a.ws = (unsigned char*)d_ws;
    auto mk = [&](int lo, int hi, int li) { a.ph_lo = lo; a.ph_hi = hi; a.li = li; hipLaunchKernelGGL(mk_fwd, dim3(256), dim3(NWAVES * 64), LDS_BYTES, stream, a);
        const hipError_t le = hipPeekAtLastError(); if (le != hipSuccess) fprintf(stderr, "kernel_launch: mk launch [%d,%d) failed: %s\n", lo, hi, hipGetErrorName(le)); };
#if MK_MODE == 1
    auto mixers = [&](int l) { nv_conv<<<M, 512, 0, stream>>>(P, l); nv_gmlp<<<dim3(128, 4), 256, 128 * 129 * 4, stream>>>(P, l); nv_attn<<<M * NH / 4, 256, 4 * SEQ * 4, stream>>>(P); };
    mk(0, 2, 0); mixers(0); mk(3, 7, 1); mixers(1); mk(8, 10, 2);
#else
    mk(0, NPH, 0);
#endif
#endif
}
```
